# Optimizing an MI355X kernel written in HIP

```python
import math
import jax, jax.numpy as jnp
from jax import lax
import numpy as np

D_MODEL = 1024
BATCH = 1
SEQ = 16384
DEPTH = 4
DEC_BATCH = 8
DEC_SEQ = 2048
PAST_LEN = 128

GRID_W = 64
HEAD_DIM = 64
A_HEADS = 4
A_KV_HEADS = 2
B_HEADS = 4
B_KV_HEADS = 2
WINDOW = 128
BAND_BLOCK = 128
C_HEADS = 4
C_NOPE = 64
C_ROPE = 32
C_V = 64
C_Q_LORA = 384
C_KV_LORA = 256
D_HEADS = 4
D_HEAD_DIM = 32
N_BRANCH = 4
BRANCH_W = 256
D_FF = 2816
Q_BLOCK = 128
ROPE_THETA = 10000.0
EPS = 1e-6
NEG_BIG = -1e30
PROJ_SIZES = (A_HEADS * HEAD_DIM, A_KV_HEADS * HEAD_DIM, A_KV_HEADS * HEAD_DIM,
              B_HEADS * HEAD_DIM, B_KV_HEADS * HEAD_DIM, B_KV_HEADS * HEAD_DIM,
              C_Q_LORA, C_KV_LORA, C_ROPE,
              2 * D_HEADS * D_HEAD_DIM, 2 * D_HEADS * D_HEAD_DIM, 2 * D_HEADS * D_HEAD_DIM,
              N_BRANCH * D_MODEL)
PROJ_COLS = sum(PROJ_SIZES)

kernel_name = "hybrid_gated_parallel_encoder"


def rms_norm(x, g):
    xf = x.astype(jnp.float32)
    y = xf * lax.rsqrt(jnp.mean(xf * xf, axis=-1, keepdims=True) + EPS)
    return (y * g.astype(jnp.float32)).astype(x.dtype)


def rope_cos_sin(pos, dim):
    inv = 1.0 / (ROPE_THETA ** (jnp.arange(0, dim, 2, dtype=jnp.float32) / dim))
    ang = pos[:, None] * inv[None, :]
    ang = jnp.concatenate([ang, ang], axis=-1)
    return jnp.cos(ang), jnp.sin(ang)


def rotate_half(x):
    x1, x2 = jnp.split(x, 2, axis=-1)
    return jnp.concatenate([-x2, x1], axis=-1)


def apply_rope(x, cos, sin):
    c = cos[:, None, :].astype(x.dtype)
    s = sin[:, None, :].astype(x.dtype)
    return x * c + rotate_half(x) * s


def axial_rope(x, row_cs, col_cs):
    half = x.shape[-1] // 2
    return jnp.concatenate([apply_rope(x[..., :half], *row_cs),
                            apply_rope(x[..., half:], *col_cs)], axis=-1)


def sweep_query_blocks(fn, q):
    b, s = q.shape[0], q.shape[1]
    nb = s // Q_BLOCK
    qb = jnp.moveaxis(q.reshape((b, nb, Q_BLOCK) + q.shape[2:]), 1, 0)
    out = jnp.moveaxis(lax.map(fn, qb), 0, 1)
    return out.reshape((b, s) + out.shape[3:])


def dense_gqa(q, k, v, scale):
    def block(qb):
        s = jnp.einsum('bqhgd,bkhd->bhgqk', qb, k).astype(jnp.float32) * scale
        p = jax.nn.softmax(s, axis=-1).astype(v.dtype)
        return jnp.einsum('bhgqk,bkhd->bqhgd', p, v)
    return sweep_query_blocks(block, q)


def banded_sink_gqa(q, k, v, sink, scale):
    b, s, hkv, g, d = q.shape
    nb = s // BAND_BLOCK
    qb = q.reshape(b, nb, BAND_BLOCK, hkv, g, d)
    pad = ((0, 0), (BAND_BLOCK, BAND_BLOCK), (0, 0), (0, 0))
    kp = jnp.pad(k, pad).reshape(b, nb + 2, BAND_BLOCK, hkv, d)
    vp = jnp.pad(v, pad).reshape(b, nb + 2, BAND_BLOCK, hkv, v.shape[-1])
    kw = jnp.concatenate([kp[:, :-2], kp[:, 1:-1], kp[:, 2:]], axis=2)
    vw = jnp.concatenate([vp[:, :-2], vp[:, 1:-1], vp[:, 2:]], axis=2)
    sc = jnp.einsum('bnqhgd,bnkhd->bnhgqk', qb, kw).astype(jnp.float32) * scale
    qpos = jnp.arange(BAND_BLOCK)[:, None]
    kpos = jnp.arange(3 * BAND_BLOCK)[None, :] - BAND_BLOCK
    in_window = jnp.abs(kpos - qpos) <= WINDOW
    abs_k = jnp.arange(nb)[:, None] * BAND_BLOCK + kpos
    in_range = (abs_k >= 0) & (abs_k < s)
    valid = in_window[None, :, :] & in_range[:, None, :]
    sc = jnp.where(valid[None, :, None, None, :, :], sc, NEG_BIG)
    sink_col = jnp.broadcast_to(sink.reshape(hkv, g)[None, None, :, :, None, None].astype(jnp.float32),
                                sc.shape[:-1] + (1,))
    p = jax.nn.softmax(jnp.concatenate([sc, sink_col], axis=-1), axis=-1)[..., :-1]
    o = jnp.einsum('bnhgqk,bnkhd->bnqhgd', p.astype(v.dtype), vw)
    return o.reshape(b, s, hkv, g, v.shape[-1])


def differential_attention(q, k, v, lam, scale):
    def block(qb):
        sc = jnp.einsum('bqhcd,bkhcd->bhcqk', qb, k).astype(jnp.float32) * scale
        p = jax.nn.softmax(sc, axis=-1)
        a = (p[:, :, 0] - lam * p[:, :, 1]).astype(v.dtype)
        return jnp.einsum('bhqk,bkhd->bqhd', a, v)
    return sweep_query_blocks(block, q)


def swiglu(x, wi, wo):
    gate, up = jnp.split(x @ wi, 2, axis=-1)
    return (jax.nn.silu(gate) * up) @ wo


def token_mixing(xn, w_in, a_qk_g, b_sink, c_q_g, c_kv_g, c_w_uq, c_w_ukv,
                 d_lam, d_sub_g, w_branch, w_out, lambda_init, ropes):
    row_cs, col_cs, rope64, rope32 = ropes
    b, s, _ = xn.shape
    proj = xn @ w_in
    offs = np.cumsum(PROJ_SIZES)[:-1].tolist()
    (aq, ak, av, bq, bk, bv, cq, ckv, ckpe, dq, dk, dv, gl) = jnp.split(proj, offs, axis=-1)

    aq = axial_rope(rms_norm(aq.reshape(b, s, A_HEADS, HEAD_DIM), a_qk_g[0]), row_cs, col_cs)
    ak = axial_rope(rms_norm(ak.reshape(b, s, A_KV_HEADS, HEAD_DIM), a_qk_g[1]), row_cs, col_cs)
    av = av.reshape(b, s, A_KV_HEADS, HEAD_DIM)
    oa = dense_gqa(aq.reshape(b, s, A_KV_HEADS, A_HEADS // A_KV_HEADS, HEAD_DIM), ak, av,
                   HEAD_DIM ** -0.5)

    bq = apply_rope(bq.reshape(b, s, B_HEADS, HEAD_DIM), *rope64)
    bk = apply_rope(bk.reshape(b, s, B_KV_HEADS, HEAD_DIM), *rope64)
    bv = bv.reshape(b, s, B_KV_HEADS, HEAD_DIM)
    ob = banded_sink_gqa(bq.reshape(b, s, B_KV_HEADS, B_HEADS // B_KV_HEADS, HEAD_DIM), bk, bv,
                         b_sink, HEAD_DIM ** -0.5)

    cqh = (rms_norm(cq, c_q_g) @ c_w_uq).reshape(b, s, C_HEADS, C_NOPE + C_ROPE)
    q_nope, q_pe = cqh[..., :C_NOPE], apply_rope(cqh[..., C_NOPE:], *rope32)
    kvh = (rms_norm(ckv, c_kv_g) @ c_w_ukv).reshape(b, s, C_HEADS, C_NOPE + C_V)
    k_nope, cv = kvh[..., :C_NOPE], kvh[..., C_NOPE:]
    k_pe = apply_rope(ckpe.reshape(b, s, 1, C_ROPE), *rope32)
    cq_full = jnp.concatenate([q_nope, q_pe], axis=-1)
    ck_full = jnp.concatenate([k_nope, jnp.broadcast_to(k_pe, (b, s, C_HEADS, C_ROPE))], axis=-1)
    oc = dense_gqa(cq_full[:, :, :, None, :], ck_full, cv, (C_NOPE + C_ROPE) ** -0.5)

    dq = apply_rope(dq.reshape(b, s, 2 * D_HEADS, D_HEAD_DIM), *rope32).reshape(b, s, D_HEADS, 2, D_HEAD_DIM)
    dk = apply_rope(dk.reshape(b, s, 2 * D_HEADS, D_HEAD_DIM), *rope32).reshape(b, s, D_HEADS, 2, D_HEAD_DIM)
    dv = dv.reshape(b, s, D_HEADS, 2 * D_HEAD_DIM)
    lf = d_lam.astype(jnp.float32)
    lam = jnp.exp(jnp.sum(lf[0] * lf[1])) - jnp.exp(jnp.sum(lf[2] * lf[3])) + lambda_init
    od = differential_attention(dq, dk, dv, lam, D_HEAD_DIM ** -0.5)
    od = rms_norm(od, d_sub_g) * (1.0 - lambda_init)

    branches = jnp.stack([oa.reshape(b, s, BRANCH_W), ob.reshape(b, s, BRANCH_W),
                          oc.reshape(b, s, BRANCH_W), od.reshape(b, s, BRANCH_W)], axis=2)
    gates = jax.nn.sigmoid(gl.reshape(b, s, N_BRANCH, D_MODEL))
    merged = jnp.sum(gates * jnp.einsum('bsnc,ncd->bsnd', branches, w_branch), axis=2)
    return merged @ w_out


def run_trunk(x, norm_g, w_in, a_qk_norm, b_sink, c_q_norm, c_kv_norm, c_w_uq, c_w_ukv,
              d_lambda, d_subln, w_branch, w_out, ffn_wi, ffn_wo):
    s = x.shape[1]
    rows = s // GRID_W
    row = jnp.repeat(jnp.arange(rows, dtype=jnp.float32), GRID_W)
    col = jnp.tile(jnp.arange(GRID_W, dtype=jnp.float32), rows)
    pos = jnp.arange(s, dtype=jnp.float32)
    ropes = (rope_cos_sin(row, HEAD_DIM // 2), rope_cos_sin(col, HEAD_DIM // 2),
             rope_cos_sin(pos, HEAD_DIM), rope_cos_sin(pos, C_ROPE))
    for l in range(DEPTH):
        g = norm_g[l]
        lambda_init = 0.8 - 0.6 * math.exp(-0.3 * l)
        x = x + 0.5 * rms_norm(swiglu(rms_norm(x, g[0]), ffn_wi[l, 0], ffn_wo[l, 0]), g[1])
        mix = token_mixing(rms_norm(x, g[2]), w_in[l], a_qk_norm[l], b_sink[l], c_q_norm[l],
                           c_kv_norm[l], c_w_uq[l], c_w_ukv[l], d_lambda[l], d_subln[l],
                           w_branch[l], w_out[l], lambda_init, ropes)
        x = x + rms_norm(mix, g[3])
        x = x + 0.5 * rms_norm(swiglu(rms_norm(x, g[4]), ffn_wi[l, 1], ffn_wo[l, 1]), g[5])
    return x


def setup_inputs(seed: int = 0) -> dict:
    key = jax.random.key(seed)
    ks = jax.random.split(key, 17)
    f32 = jnp.float32
    nrm = lambda k, shp, sc: jax.random.normal(k, shp, f32) * sc
    return {
        "x_prompt": nrm(ks[0], (BATCH, SEQ, D_MODEL), 1.0),
        "x_sample": nrm(ks[1], (DEC_BATCH, DEC_SEQ, D_MODEL), 1.0),
        "norm_g": 1.0 + nrm(ks[2], (DEPTH, 6, D_MODEL), 0.05),
        "w_in": nrm(ks[3], (DEPTH, D_MODEL, PROJ_COLS), D_MODEL ** -0.5),
        "a_qk_norm": 1.0 + nrm(ks[4], (DEPTH, 2, HEAD_DIM), 0.05),
        "b_sink": nrm(ks[5], (DEPTH, B_HEADS), 0.5),
        "c_q_norm": 1.0 + nrm(ks[6], (DEPTH, C_Q_LORA), 0.05),
        "c_kv_norm": 1.0 + nrm(ks[7], (DEPTH, C_KV_LORA), 0.05),
        "c_w_uq": nrm(ks[8], (DEPTH, C_Q_LORA, C_HEADS * (C_NOPE + C_ROPE)), C_Q_LORA ** -0.5),
        "c_w_ukv": nrm(ks[9], (DEPTH, C_KV_LORA, C_HEADS * (C_NOPE + C_V)), C_KV_LORA ** -0.5),
        "d_lambda": nrm(ks[10], (DEPTH, 4, D_HEAD_DIM), 0.1),
        "d_subln": 1.0 + nrm(ks[11], (DEPTH, 2 * D_HEAD_DIM), 0.05),
        "w_branch": nrm(ks[12], (DEPTH, N_BRANCH, BRANCH_W, D_MODEL), BRANCH_W ** -0.5),
        "w_out": nrm(ks[13], (DEPTH, D_MODEL, D_MODEL), D_MODEL ** -0.5),
        "ffn_wi": nrm(ks[14], (DEPTH, 2, D_MODEL, 2 * D_FF), D_MODEL ** -0.5),
        "ffn_wo": nrm(ks[15], (DEPTH, 2, D_FF, D_MODEL), D_FF ** -0.5),
    }


def reference(x_prompt, x_sample, norm_g, w_in, a_qk_norm, b_sink, c_q_norm, c_kv_norm,
              c_w_uq, c_w_ukv, d_lambda, d_subln, w_branch, w_out, ffn_wi, ffn_wo):
    y_prompt = run_trunk(x_prompt, norm_g, w_in, a_qk_norm, b_sink, c_q_norm, c_kv_norm,
                         c_w_uq, c_w_ukv, d_lambda, d_subln, w_branch, w_out, ffn_wi, ffn_wo)
    y_sample = run_trunk(x_sample, norm_g, w_in, a_qk_norm, b_sink, c_q_norm, c_kv_norm,
                         c_w_uq, c_w_ukv, d_lambda, d_subln, w_branch, w_out, ffn_wi, ffn_wo)
    return (y_prompt, y_sample)
```

```cpp
#include <hip/hip_runtime.h>
#include <hip/hip_cooperative_groups.h>
#include <cstdio>
#include <cstdint>
namespace cg = cooperative_groups;

#ifndef MULTI_LAUNCH
#define MULTI_LAUNCH 1
#endif

#define DI __device__ __forceinline__
typedef unsigned short u16;
typedef __attribute__((ext_vector_type(8))) short bf16x8;
typedef __attribute__((ext_vector_type(16))) float f32x16;
typedef __attribute__((ext_vector_type(2))) float f32x2_t;
typedef __attribute__((ext_vector_type(2))) __bf16 bf16x2_t;

constexpr int T = 32768;
constexpr int DM = 1024;
constexpr int DFF = 2816;
constexpr int NPROJ = 6560;
constexpr int SEQ0 = 16384;
constexpr int DSEQ = 2048;
constexpr float EPS = 1e-6f;
constexpr int NTHR = 512;
constexpr int LSTR = 72;
constexpr int SMEM_BYTES = 2 * 2 * 256 * LSTR * 2;

constexpr size_t W_WI = 0;
constexpr size_t W_WO = W_WI + 2ull * 5632 * 1024;
constexpr size_t W_WIN = W_WO + 2ull * 1024 * 2816;
constexpr size_t W_WUQ = W_WIN + 6656ull * 1024;
constexpr size_t W_WUKV = W_WUQ + 512ull * 384;
constexpr size_t W_WB = W_WUKV + 512ull * 256;
constexpr size_t W_WOUT = W_WB + 1024ull * 1024;
constexpr size_t W_TOTAL = W_WOUT + 1024ull * 1024;

constexpr size_t OFF_W = 0;
constexpr size_t OFF_XN = OFF_W + W_TOTAL * 2;
constexpr size_t OFF_R2 = OFF_XN + (size_t)T * 1024 * 2;
constexpr size_t OFF_QKV = OFF_R2 + (size_t)T * 4096 * 2;
constexpr size_t OFF_SS = OFF_QKV + (size_t)T * 3456 * 2;
constexpr size_t OFF_R64 = OFF_SS + (size_t)T * 20 * 4;
constexpr size_t OFF_R32 = OFF_R64 + 16384ull * 32 * 8;
constexpr size_t WS_NEEDED = OFF_R32 + 16384ull * 16 * 8;

constexpr size_t Q_QA = 0;
constexpr size_t Q_KA = (size_t)T * 256;
constexpr size_t Q_VTA = (size_t)T * 384;
constexpr size_t Q_QB = (size_t)T * 512;
constexpr size_t Q_KB = (size_t)T * 768;
constexpr size_t Q_VTB = (size_t)T * 896;
constexpr size_t Q_CQ = (size_t)T * 1024;
constexpr size_t Q_CKV = (size_t)T * 1408;
constexpr size_t Q_QC = (size_t)T * 1664;
constexpr size_t Q_KC = (size_t)T * 2048;
constexpr size_t Q_VTC = (size_t)T * 2432;
constexpr size_t Q_QD = (size_t)T * 2688;
constexpr size_t Q_KD = (size_t)T * 2944;
constexpr size_t Q_VTD = (size_t)T * 3200;
constexpr size_t Q_MERGED = 0;
constexpr size_t Q_Y = (size_t)T * 1024;

struct Params {
  const float* x_prompt; const float* x_sample; const float* norm_g; const float* w_in;
  const float* a_qk_norm; const float* b_sink; const float* c_q_norm; const float* c_kv_norm;
  const float* c_w_uq; const float* c_w_ukv; const float* d_lambda; const float* d_subln;
  const float* w_branch; const float* w_out; const float* ffn_wi; const float* ffn_wo;
  float* out; char* ws;
  int phase_lo; int phase_hi; int coop; int pad0;
};

DI unsigned pk2(float a, float b) {
  f32x2_t v = {a, b};
  bf16x2_t r = __builtin_convertvector(v, bf16x2_t);
  return __builtin_bit_cast(unsigned, r);
}
DI u16 f2bf(float a) { return (u16)(pk2(a, 0.f) & 0xffffu); }
DI float bf2f(unsigned bits16) { return __uint_as_float(bits16 << 16); }
DI int crow(int v, int h) { return (v & 3) + 8 * (v >> 2) + 4 * h; }
DI int pos_of(int tok) { return tok < SEQ0 ? tok : ((tok - SEQ0) & (DSEQ - 1)); }
#define MFMA32(a, b, c) __builtin_amdgcn_mfma_f32_32x32x16_bf16((a), (b), (c), 0, 0, 0)

DI int opaque_tid() { int t = threadIdx.x; asm volatile("" : "+v"(t)); return t; }
DI float wave_sum(float v) {
#pragma unroll
  for (int m = 32; m >= 1; m >>= 1) v += __shfl_xor(v, m);
  return v;
}

DI void rope32_blk(f32x16& a, const float2* __restrict__ tab, int h) {
#pragma unroll
  for (int v = 0; v < 8; ++v) {
    float2 cs = tab[crow(v, h)];
    float x1 = a[v], x2 = a[v + 8];
    a[v] = x1 * cs.x - x2 * cs.y;
    a[v + 8] = x2 * cs.x + x1 * cs.y;
  }
}
DI void rope64_blk(f32x16& a0, f32x16& a1, const float2* __restrict__ tab, int h) {
#pragma unroll
  for (int v = 0; v < 16; ++v) {
    float2 cs = tab[crow(v, h)];
    float x1 = a0[v], x2 = a1[v];
    a0[v] = x1 * cs.x - x2 * cs.y;
    a1[v] = x2 * cs.x + x1 * cs.y;
  }
}
DI void store_rows(u16* __restrict__ base, int ld, int col0, const f32x16& a, int tok, int h) {
#pragma unroll
  for (int vq = 0; vq < 4; ++vq) {
    uint2 pk;
    pk.x = pk2(a[4 * vq], a[4 * vq + 1]);
    pk.y = pk2(a[4 * vq + 2], a[4 * vq + 3]);
    *(uint2*)(base + (size_t)tok * ld + col0 + 8 * vq + 4 * h) = pk;
  }
}
DI void store_T(u16* __restrict__ base, int row0, const f32x16& a, int tok, int h) {
#pragma unroll
  for (int v = 0; v < 16; ++v) base[(size_t)(row0 + crow(v, h)) * T + tok] = f2bf(a[v]);
}

enum { M_FFNUP = 0, M_Y = 1, M_PROJ = 2, M_CUQ = 3, M_CUKV = 4, M_MERGE = 5, M_GATE = 6 };

template <int MODE, int NJ>
DI void gemm_epilogue(f32x16 (&acc)[2][NJ], int fbase, int tbase, int r, int h, const Params& P, int layer) {
  char* ws = P.ws;
  u16* qkv = (u16*)(ws + OFF_QKV);
  const float2* R64 = (const float2*)(ws + OFF_R64);
  const float2* R32 = (const float2*)(ws + OFF_R32);
  float* SS = (float*)(ws + OFF_SS);
  if constexpr (MODE == M_FFNUP) {
    u16* H = (u16*)(ws + OFF_R2);
    const int hf0 = (fbase >> 6) * 32;
#pragma unroll
    for (int j = 0; j < NJ; ++j) {
      const int tok = tbase + j * 32 + r;
      f32x16 o;
#pragma unroll
      for (int v = 0; v < 16; ++v) {
        float g = acc[0][j][v], u = acc[1][j][v];
        o[v] = g / (1.f + __expf(-g)) * u;
      }
      store_rows(H, DFF, hf0, o, tok, h);
    }
  } else if constexpr (MODE == M_Y) {
    float* Y = (float*)(qkv + Q_Y);
#pragma unroll
    for (int j = 0; j < NJ; ++j) {
      const int tok = tbase + j * 32 + r;
#pragma unroll
      for (int i = 0; i < 2; ++i)
#pragma unroll
        for (int vq = 0; vq < 4; ++vq) {
          float4 o = {acc[i][j][4 * vq], acc[i][j][4 * vq + 1], acc[i][j][4 * vq + 2], acc[i][j][4 * vq + 3]};
          *(float4*)(Y + (size_t)tok * DM + fbase + i * 32 + 8 * vq + 4 * h) = o;
        }
    }
  } else if constexpr (MODE == M_PROJ) {
    if (fbase < 384) {
      const bool isK = fbase >= 256;
      const float* g = P.a_qk_norm + layer * 128 + (isK ? 64 : 0);
      u16* dst = qkv + (isK ? Q_KA : Q_QA);
      const int ld = isK ? 128 : 256;
      const int c0 = isK ? fbase - 256 : fbase;
      float gv[2][16];
#pragma unroll
      for (int i = 0; i < 2; ++i)
#pragma unroll
        for (int v = 0; v < 16; ++v) gv[i][v] = g[i * 32 + crow(v, h)];
#pragma unroll
      for (int j = 0; j < NJ; ++j) {
        const int tok = tbase + j * 32 + r;
        const int pos = pos_of(tok);
        float ss = 0.f;
#pragma unroll
        for (int i = 0; i < 2; ++i)
#pragma unroll
          for (int v = 0; v < 16; ++v) ss += acc[i][j][v] * acc[i][j][v];
        ss += __shfl_xor(ss, 32);
        const float rs = rsqrtf(ss * (1.f / 64.f) + EPS);
#pragma unroll
        for (int i = 0; i < 2; ++i)
#pragma unroll
          for (int v = 0; v < 16; ++v) acc[i][j][v] *= rs * gv[i][v];
        rope32_blk(acc[0][j], R32 + (size_t)(pos >> 6) * 16, h);
        rope32_blk(acc[1][j], R32 + (size_t)(pos & 63) * 16, h);
        store_rows(dst, ld, c0, acc[0][j], tok, h);
        store_rows(dst, ld, c0 + 32, acc[1][j], tok, h);
      }
    } else if (fbase < 512) {
#pragma unroll
      for (int j = 0; j < NJ; ++j) {
        const int tok = tbase + j * 32 + r;
        store_T(qkv + Q_VTA, fbase - 384, acc[0][j], tok, h);
        store_T(qkv + Q_VTA, fbase - 384 + 32, acc[1][j], tok, h);
      }
    } else if (fbase < 896) {
      const bool isK = fbase >= 768;
      u16* dst = qkv + (isK ? Q_KB : Q_QB);
      const int ld = isK ? 128 : 256;
      const int c0 = isK ? fbase - 768 : fbase - 512;
#pragma unroll
      for (int j = 0; j < NJ; ++j) {
        const int tok = tbase + j * 32 + r;
        const int pos = pos_of(tok);
        rope64_blk(acc[0][j], acc[1][j], R64 + (size_t)pos * 32, h);
        store_rows(dst, ld, c0, acc[0][j], tok, h);
        store_rows(dst, ld, c0 + 32, acc[1][j], tok, h);
      }
    } else if (fbase < 1024) {
#pragma unroll
      for (int j = 0; j < NJ; ++j) {
        const int tok = tbase + j * 32 + r;
        store_T(qkv + Q_VTB, fbase - 896, acc[0][j], tok, h);
        store_T(qkv + Q_VTB, fbase - 896 + 32, acc[1][j], tok, h);
      }
    } else if (fbase < 1664) {
      const bool isKV = fbase >= 1408;
      u16* dst = qkv + (isKV ? Q_CKV : Q_CQ);
      const int ld = isKV ? 256 : 384;
      const int c0 = isKV ? fbase - 1408 : fbase - 1024;
      const int sb = (isKV ? 12 : 0) + (c0 >> 5);
#pragma unroll
      for (int j = 0; j < NJ; ++j) {
        const int tok = tbase + j * 32 + r;
#pragma unroll
        for (int i = 0; i < 2; ++i) {
          float ss = 0.f;
#pragma unroll
          for (int v = 0; v < 16; ++v) ss += acc[i][j][v] * acc[i][j][v];
          ss += __shfl_xor(ss, 32);
          if (h == 0) SS[(size_t)tok * 20 + sb + i] = ss;
          store_rows(dst, ld, c0 + i * 32, acc[i][j], tok, h);
        }
      }
    } else if (fbase < 2176) {
      const bool isK = fbase >= 1920;
      u16* dst = qkv + (isK ? Q_KD : Q_QD);
      const int c0 = isK ? fbase - 1920 : fbase - 1664;
#pragma unroll
      for (int j = 0; j < NJ; ++j) {
        const int tok = tbase + j * 32 + r;
        const int pos = pos_of(tok);
#pragma unroll
        for (int i = 0; i < 2; ++i) {
          rope32_blk(acc[i][j], R32 + (size_t)pos * 16, h);
          store_rows(dst, 256, c0 + i * 32, acc[i][j], tok, h);
        }
      }
    } else if (fbase < 2432) {
#pragma unroll
      for (int j = 0; j < NJ; ++j) {
        const int tok = tbase + j * 32 + r;
        store_T(qkv + Q_VTD, fbase - 2176, acc[0][j], tok, h);
        store_T(qkv + Q_VTD, fbase - 2176 + 32, acc[1][j], tok, h);
      }
    } else if (fbase == 2432) {
#pragma unroll
      for (int j = 0; j < NJ; ++j) {
        const int tok = tbase + j * 32 + r;
        const int pos = pos_of(tok);
        rope32_blk(acc[0][j], R32 + (size_t)pos * 16, h);
#pragma unroll
        for (int hd = 0; hd < 4; ++hd) store_rows(qkv + Q_KC, 384, hd * 96 + 64, acc[0][j], tok, h);
      }
    }
  } else if constexpr (MODE == M_GATE) {
    u16* G = (u16*)(ws + OFF_R2);
#pragma unroll
    for (int j = 0; j < NJ; ++j) {
      const int tok = tbase + j * 32 + r;
#pragma unroll
      for (int i = 0; i < 2; ++i) {
        f32x16 o;
#pragma unroll
        for (int v = 0; v < 16; ++v) o[v] = 1.f / (1.f + __expf(-acc[i][j][v]));
        store_rows(G, 4096, fbase + i * 32, o, tok, h);
      }
    }
  } else if constexpr (MODE == M_CUQ) {
    if (fbase >= 384) return;
#pragma unroll
    for (int j = 0; j < NJ; ++j) {
      const int tok = tbase + j * 32 + r;
      const int pos = pos_of(tok);
      float ss = 0.f;
#pragma unroll
      for (int b = 0; b < 12; ++b) ss += SS[(size_t)tok * 20 + b];
      const float rs = rsqrtf(ss * (1.f / 384.f) + EPS);
#pragma unroll
      for (int i = 0; i < 2; ++i) {
        const int blk = (fbase >> 5) + i;
#pragma unroll
        for (int v = 0; v < 16; ++v) acc[i][j][v] *= rs;
        if (blk % 3 == 2) rope32_blk(acc[i][j], R32 + (size_t)pos * 16, h);
        store_rows(qkv + Q_QC, 384, blk * 32, acc[i][j], tok, h);
      }
    }
  } else if constexpr (MODE == M_CUKV) {
#pragma unroll
    for (int j = 0; j < NJ; ++j) {
      const int tok = tbase + j * 32 + r;
      float ss = 0.f;
#pragma unroll
      for (int b = 0; b < 8; ++b) ss += SS[(size_t)tok * 20 + 12 + b];
      const float rs = rsqrtf(ss * (1.f / 256.f) + EPS);
#pragma unroll
      for (int i = 0; i < 2; ++i) {
        const int blk = (fbase >> 5) + i;
        const int hd = blk >> 2, q = blk & 3;
#pragma unroll
        for (int v = 0; v < 16; ++v) acc[i][j][v] *= rs;
        if (q < 2) store_rows(qkv + Q_KC, 384, hd * 96 + q * 32, acc[i][j], tok, h);
        else store_T(qkv + Q_VTC, hd * 64 + (q - 2) * 32, acc[i][j], tok, h);
      }
    }
  } else if constexpr (MODE == M_MERGE) {
#pragma unroll
    for (int j = 0; j < NJ; ++j) {
      const int tok = tbase + j * 32 + r;
      store_rows(qkv + Q_MERGED, 1024, fbase, acc[0][j], tok, h);
      store_rows(qkv + Q_MERGED, 1024, fbase + 32, acc[1][j], tok, h);
    }
  }
}

template <int MODE, int NJ>
DI void gemm_tile(const u16* __restrict__ Wt, const u16* __restrict__ X, int ldx, int K, int f0, int t0, char* smem,
                  const Params& P, int layer) {
  constexpr int XROWS = NJ * 64;
  u16* sW = (u16*)smem;
  u16* sX = sW + 2 * 256 * LSTR;
  const int tid = opaque_tid(), lane = tid & 63, wave = tid >> 6, r = lane & 31, h = lane >> 5;
  const int wf = wave & 3, wt = wave >> 2;
  f32x16 acc[2][NJ];
  f32x16 tot[2][MODE == M_MERGE ? NJ : 1];
#pragma unroll
  for (int i = 0; i < 2; ++i)
#pragma unroll
    for (int j = 0; j < NJ; ++j)
#pragma unroll
      for (int v = 0; v < 16; ++v) acc[i][j][v] = 0.f;
  if constexpr (MODE == M_MERGE) {
#pragma unroll
    for (int i = 0; i < 2; ++i)
#pragma unroll
      for (int j = 0; j < NJ; ++j)
#pragma unroll
        for (int v = 0; v < 16; ++v) tot[i][j][v] = 0.f;
  }
  const int nk = K >> 6;
  uint4 wreg[4], xreg[NJ];
  const int crow_ = tid >> 3, ccol = (tid & 7) * 8;
  const u16* wp = Wt + (size_t)(f0 + crow_) * K + ccol;
  const u16* xp = X + (size_t)(t0 + crow_) * ldx + ccol;

  auto gload = [&](int kt) {
#pragma unroll
    for (int i = 0; i < 4; ++i) wreg[i] = *(const uint4*)(wp + (size_t)(i * 64) * K + kt * 64);
#pragma unroll
    for (int i = 0; i < NJ; ++i) xreg[i] = *(const uint4*)(xp + (size_t)(i * 64) * ldx + kt * 64);
  };
  auto sstore = [&](int buf) {
#pragma unroll
    for (int i = 0; i < 4; ++i) *(uint4*)(sW + (buf * 256 + i * 64 + crow_) * LSTR + ccol) = wreg[i];
#pragma unroll
    for (int i = 0; i < NJ; ++i) *(uint4*)(sX + (buf * XROWS + i * 64 + crow_) * LSTR + ccol) = xreg[i];
  };
  const int fbase = f0 + wf * 64, tbase = t0 + wt * (NJ * 32);

  gload(0);
  sstore(0);
  __syncthreads();
  for (int kt = 0; kt < nk; ++kt) {
    const int buf = kt & 1;
    if (kt + 1 < nk) gload(kt + 1);
    const u16* aW = sW + (buf * 256 + wf * 64 + r) * LSTR + h * 8;
    const u16* aX = sX + (buf * XROWS + wt * (NJ * 32) + r) * LSTR + h * 8;
#pragma unroll
    for (int ks = 0; ks < 4; ++ks) {
      bf16x8 wfrag[2], xfrag[NJ];
#pragma unroll
      for (int i = 0; i < 2; ++i) wfrag[i] = *(const bf16x8*)(aW + i * 32 * LSTR + ks * 16);
#pragma unroll
      for (int j = 0; j < NJ; ++j) xfrag[j] = *(const bf16x8*)(aX + j * 32 * LSTR + ks * 16);
#pragma unroll
      for (int i = 0; i < 2; ++i)
#pragma unroll
        for (int j = 0; j < NJ; ++j) acc[i][j] = MFMA32(wfrag[i], xfrag[j], acc[i][j]);
    }
    if constexpr (MODE == M_MERGE) {
      if ((kt & 3) == 3) {
        const int br = kt >> 2;
        const u16* G = (const u16*)(P.ws + OFF_R2);
#pragma unroll
        for (int j = 0; j < NJ; ++j) {
          const int tok = tbase + j * 32 + r;
#pragma unroll
          for (int i = 0; i < 2; ++i)
#pragma unroll
            for (int vq = 0; vq < 4; ++vq) {
              uint2 gp = *(const uint2*)(G + (size_t)tok * 4096 + br * 1024 + fbase + i * 32 + 8 * vq + 4 * h);
              tot[i][j][4 * vq + 0] += bf2f(gp.x & 0xffffu) * acc[i][j][4 * vq + 0];
              tot[i][j][4 * vq + 1] += bf2f(gp.x >> 16) * acc[i][j][4 * vq + 1];
              tot[i][j][4 * vq + 2] += bf2f(gp.y & 0xffffu) * acc[i][j][4 * vq + 2];
              tot[i][j][4 * vq + 3] += bf2f(gp.y >> 16) * acc[i][j][4 * vq + 3];
              acc[i][j][4 * vq + 0] = 0.f; acc[i][j][4 * vq + 1] = 0.f;
              acc[i][j][4 * vq + 2] = 0.f; acc[i][j][4 * vq + 3] = 0.f;
            }
        }
      }
    }
    if (kt + 1 < nk) sstore(buf ^ 1);
    __syncthreads();
  }
  if constexpr (MODE == M_MERGE) gemm_epilogue<MODE, NJ>(tot, fbase, tbase, r, h, P, layer);
  else gemm_epilogue<MODE, NJ>(acc, fbase, tbase, r, h, P, layer);
}

template <int MODE, int NJ>
DI void gemm_phase(const u16* Wt, const u16* X, int ldx, int K, int nF, char* smem, const Params& P, int layer) {
  constexpr int TT = NJ * 64;
  const int nT = T / TT;
  const int ntiles = nF * nT;
  for (int idx = blockIdx.x; idx < ntiles; idx += gridDim.x) {
    const int tt_lo = idx & 15;
    const int rest = idx >> 4;
    const int ft = rest % nF;
    const int tt = (rest / nF) * 16 + tt_lo;
    gemm_tile<MODE, NJ>(Wt, X, ldx, K, ft * 256, tt * TT, smem, P, layer);
  }
}

template <int DQK, int NCOMP, bool BAND, bool DIFF>
DI void attn_item(const u16* __restrict__ Q, int ldq, const u16* __restrict__ Kp, int ldk, const u16* __restrict__ Vt,
                  int qtok0, int kbeg, int kend, float sc_l2, float sink_l2, float lam, float onorm,
                  const float* __restrict__ subg, u16* __restrict__ O, char* smem) {
  constexpr int DC = DQK / NCOMP;
  constexpr int KS = DC / 16;
  constexpr int KSTR = DQK + 8;
  constexpr int KCH = DQK / 8;
  u16* sK = (u16*)smem;
  u16* sV = sK + 2 * 64 * KSTR;
  const int tid = opaque_tid(), lane = tid & 63, wave = tid >> 6, r = lane & 31, h = lane >> 5;
  const int qtok = qtok0 + wave * 32 + r;

  bf16x8 qf[NCOMP][KS];
#pragma unroll
  for (int c = 0; c < NCOMP; ++c)
#pragma unroll
    for (int ks = 0; ks < KS; ++ks) qf[c][ks] = *(const bf16x8*)(Q + (size_t)qtok * ldq + c * DC + ks * 16 + 8 * h);

  f32x16 Oa[NCOMP][2];
  float m[NCOMP], l[NCOMP];
#pragma unroll
  for (int c = 0; c < NCOMP; ++c) {
#pragma unroll
    for (int d = 0; d < 2; ++d)
#pragma unroll
      for (int v = 0; v < 16; ++v) Oa[c][d][v] = 0.f;
    m[c] = BAND ? sink_l2 : -1e30f;
    l[c] = (BAND && h == 0) ? 1.f : 0.f;
  }

  constexpr bool K2 = (64 * KCH > NTHR);
  const int kc0 = tid, kc1 = (tid + NTHR < 64 * KCH) ? tid + NTHR : tid;
  const int krow0 = kc0 / KCH, kcc0 = kc0 % KCH, krow1 = kc1 / KCH, kcc1 = kc1 % KCH;
  const u16* kg0 = Kp + (size_t)krow0 * ldk + kcc0 * 8;
  const u16* kg1 = Kp + (size_t)krow1 * ldk + kcc1 * 8;
  const u16* vg = Vt + (size_t)(tid >> 3) * T + (tid & 7) * 8;
  const int ks0 = krow0 * KSTR + kcc0 * 8, ks1 = krow1 * KSTR + kcc1 * 8;
  const int vs0 = (tid >> 3) * LSTR + (tid & 7) * 8;
  uint4 kreg0, kreg1, vreg;
#define ATT_GLOAD(k0_)                                                   \
  do {                                                                   \
    kreg0 = *(const uint4*)(kg0 + (size_t)(k0_) * ldk);                  \
    if constexpr (K2) kreg1 = *(const uint4*)(kg1 + (size_t)(k0_) * ldk); \
    vreg = *(const uint4*)(vg + (k0_));                                  \
  } while (0)
#define ATT_SSTORE(buf_)                                                 \
  do {                                                                   \
    *(uint4*)(sK + (buf_) * 64 * KSTR + ks0) = kreg0;                    \
    if constexpr (K2) *(uint4*)(sK + (buf_) * 64 * KSTR + ks1) = kreg1;  \
    *(uint4*)(sV + (buf_) * 64 * LSTR + vs0) = vreg;                     \
  } while (0)

  const int ntl = (kend - kbeg) >> 6;
  ATT_GLOAD(kbeg);
  ATT_SSTORE(0);
  __syncthreads();
  for (int t = 0; t < ntl; ++t) {
    const int buf = t & 1;
    const int k0 = kbeg + t * 64;
    if (t + 1 < ntl) ATT_GLOAD(k0 + 64);
    bf16x8 pf[NCOMP][2][2];
#pragma unroll
    for (int c = 0; c < NCOMP; ++c) {
      f32x16 S[2];
#pragma unroll
      for (int kb = 0; kb < 2; ++kb) {
#pragma unroll
        for (int v = 0; v < 16; ++v) S[kb][v] = 0.f;
#pragma unroll
        for (int ks = 0; ks < KS; ++ks) {
          bf16x8 kf = *(const bf16x8*)(sK + (buf * 64 + kb * 32 + r) * KSTR + c * DC + ks * 16 + 8 * h);
          S[kb] = MFMA32(kf, qf[c][ks], S[kb]);
        }
      }
      float mx = -1e30f;
#pragma unroll
      for (int kb = 0; kb < 2; ++kb)
#pragma unroll
        for (int v = 0; v < 16; ++v) {
          float tv = S[kb][v] * sc_l2;
          if (BAND) {
            const int kp = k0 + kb * 32 + crow(v, h);
            const int d = kp - qtok;
            if (d > 128 || d < -128) tv = -1e30f;
          }
          S[kb][v] = tv;
          mx = fmaxf(mx, tv);
        }
      mx = fmaxf(mx, __shfl_xor(mx, 32));
      const float mnew = fmaxf(m[c], mx);
      const float alpha = __builtin_amdgcn_exp2f(m[c] - mnew);
      m[c] = mnew;
      float rsum = 0.f;
#pragma unroll
      for (int kb = 0; kb < 2; ++kb)
#pragma unroll
        for (int v = 0; v < 16; ++v) {
          float p = __builtin_amdgcn_exp2f(S[kb][v] - mnew);
          S[kb][v] = p;
          rsum += p;
        }
      l[c] = l[c] * alpha + rsum;
#pragma unroll
      for (int d = 0; d < 2; ++d)
#pragma unroll
        for (int v = 0; v < 16; ++v) Oa[c][d][v] *= alpha;
#pragma unroll
      for (int kb = 0; kb < 2; ++kb)
#pragma unroll
        for (int s = 0; s < 2; ++s) {
          uint4 pk;
          pk.x = pk2(S[kb][8 * s + 0], S[kb][8 * s + 1]);
          pk.y = pk2(S[kb][8 * s + 2], S[kb][8 * s + 3]);
          pk.z = pk2(S[kb][8 * s + 4], S[kb][8 * s + 5]);
          pk.w = pk2(S[kb][8 * s + 6], S[kb][8 * s + 7]);
          pf[c][kb][s] = __builtin_bit_cast(bf16x8, pk);
        }
    }
#pragma unroll
    for (int d = 0; d < 2; ++d)
#pragma unroll
      for (int kb = 0; kb < 2; ++kb)
#pragma unroll
        for (int s = 0; s < 2; ++s) {
          const u16* vp = sV + (buf * 64 + d * 32 + r) * LSTR + kb * 32 + 16 * s + 4 * h;
          uint2 lo = *(const uint2*)(vp);
          uint2 hi = *(const uint2*)(vp + 8);
          uint4 vv = {lo.x, lo.y, hi.x, hi.y};
          bf16x8 vf = __builtin_bit_cast(bf16x8, vv);
#pragma unroll
          for (int c = 0; c < NCOMP; ++c) Oa[c][d] = MFMA32(vf, pf[c][kb][s], Oa[c][d]);
        }
    if (t + 1 < ntl) ATT_SSTORE(buf ^ 1);
    __syncthreads();
  }

  float inv[NCOMP];
#pragma unroll
  for (int c = 0; c < NCOMP; ++c) {
    float lt = l[c] + __shfl_xor(l[c], 32);
    inv[c] = 1.f / lt;
  }
  if constexpr (DIFF) {
    float ss = 0.f;
#pragma unroll
    for (int d = 0; d < 2; ++d)
#pragma unroll
      for (int v = 0; v < 16; ++v) {
        float o = Oa[0][d][v] * inv[0] - lam * Oa[1][d][v] * inv[1];
        Oa[0][d][v] = o;
        ss += o * o;
      }
    ss += __shfl_xor(ss, 32);
    const float rs = rsqrtf(ss * (1.f / 64.f) + EPS) * onorm;
#pragma unroll
    for (int d = 0; d < 2; ++d)
#pragma unroll
      for (int v = 0; v < 16; ++v) Oa[0][d][v] *= rs * subg[d * 32 + crow(v, h)];
  } else {
#pragma unroll
    for (int d = 0; d < 2; ++d)
#pragma unroll
      for (int v = 0; v < 16; ++v) Oa[0][d][v] *= inv[0];
  }
  store_rows(O, 1024, 0, Oa[0][0], qtok, h);
  store_rows(O, 1024, 32, Oa[0][1], qtok, h);
}

DI void attn_phase(const Params& P, int layer, char* smem) {
  char* ws = P.ws;
  u16* qkv = (u16*)(ws + OFF_QKV);
  u16* BR = (u16*)(ws + OFF_XN);
  const float L2E = 1.4426950408889634f;
  const float lambda_init = 0.8f - 0.6f * __expf(-0.3f * (float)layer);
  float lam;
  {
    const float* dl = P.d_lambda + layer * 128;
    float s1 = 0.f, s2 = 0.f;
    for (int i = 0; i < 32; ++i) { s1 += dl[i] * dl[32 + i]; s2 += dl[64 + i] * dl[96 + i]; }
    lam = __expf(s1) - __expf(s2) + lambda_init;
  }
  for (int it = blockIdx.x; it < 2048; it += gridDim.x) {
    const int cls = it >> 8;
    if (cls < 6) {
      const int idx = it & 255;
      const int head = (idx & 7) >> 1;
      const int qb = ((idx >> 3) << 1) + (idx & 1);
      int qtok0, kbeg, kend;
      if (cls < 3) { qtok0 = qb * 256; kbeg = 0; kend = SEQ0; }
      else { const int s = qb >> 3; kbeg = SEQ0 + s * DSEQ; kend = kbeg + DSEQ; qtok0 = kbeg + (qb & 7) * 256; }
      const int typ = cls % 3;
      if (typ == 0) {
        attn_item<64, 2, false, true>(qkv + Q_QD + head * 64, 256, qkv + Q_KD + head * 64, 256,
                                      qkv + Q_VTD + (size_t)head * 64 * T, qtok0, kbeg, kend,
                                      0.17677669529663687f * L2E, 0.f, lam, 1.f - lambda_init,
                                      P.d_subln + layer * 64, BR + 768 + head * 64, smem);
      } else if (typ == 1) {
        attn_item<96, 1, false, false>(qkv + Q_QC + head * 96, 384, qkv + Q_KC + head * 96, 384,
                                       qkv + Q_VTC + (size_t)head * 64 * T, qtok0, kbeg, kend,
                                       0.10206207261596577f * L2E, 0.f, 0.f, 1.f, nullptr, BR + 512 + head * 64, smem);
      } else {
        attn_item<64, 1, false, false>(qkv + Q_QA + head * 64, 256, qkv + Q_KA + (head >> 1) * 64, 128,
                                       qkv + Q_VTA + (size_t)(head >> 1) * 64 * T, qtok0, kbeg, kend,
                                       0.125f * L2E, 0.f, 0.f, 1.f, nullptr, BR + head * 64, smem);
      }
    } else {
      const int idx = it - 1536;
      const int head = (idx & 7) >> 1;
      const int qbg = ((idx >> 3) << 1) + (idx & 1);
      const int qtok0 = qbg * 256;
      int sb, se;
      if (qtok0 < SEQ0) { sb = 0; se = SEQ0; }
      else { sb = SEQ0 + ((qtok0 - SEQ0) / DSEQ) * DSEQ; se = sb + DSEQ; }
      const int kbeg = max(sb, qtok0 - 128), kend = min(se, qtok0 + 256 + 128);
      const float sink = P.b_sink[layer * 4 + head];
      attn_item<64, 1, true, false>(qkv + Q_QB + head * 64, 256, qkv + Q_KB + (head >> 1) * 64, 128,
                                    qkv + Q_VTB + (size_t)(head >> 1) * 64 * T, qtok0, kbeg, kend,
                                    0.125f * L2E, sink * L2E, 0.f, 1.f, nullptr, BR + 256 + head * 64, smem);
    }
  }
}

DI void ew_phase(const Params& P, const float* __restrict__ Y, float coef, const float* __restrict__ gpost,
                 const float* __restrict__ gnext, bool from_inputs) {
  const int tid = opaque_tid();
  const int lane = tid & 63, wave = tid >> 6;
  u16* XN = (u16*)(P.ws + OFF_XN);
  for (int tok = blockIdx.x * 8 + wave; tok < T; tok += gridDim.x * 8) {
    const float* xs = from_inputs ? (tok < SEQ0 ? P.x_prompt + (size_t)tok * DM : P.x_sample + (size_t)(tok - SEQ0) * DM)
                                  : P.out + (size_t)tok * DM;
    float4 x[4];
#pragma unroll
    for (int i = 0; i < 4; ++i) x[i] = *(const float4*)(xs + (i * 64 + lane) * 4);
    if (Y) {
      float4 y[4];
      float ss = 0.f;
#pragma unroll
      for (int i = 0; i < 4; ++i) {
        y[i] = *(const float4*)(Y + (size_t)tok * DM + (i * 64 + lane) * 4);
        ss += y[i].x * y[i].x + y[i].y * y[i].y + y[i].z * y[i].z + y[i].w * y[i].w;
      }
      ss = wave_sum(ss);
      const float rs = rsqrtf(ss * (1.f / 1024.f) + EPS) * coef;
#pragma unroll
      for (int i = 0; i < 4; ++i) {
        float4 g = *(const float4*)(gpost + (i * 64 + lane) * 4);
        x[i].x += y[i].x * rs * g.x; x[i].y += y[i].y * rs * g.y;
        x[i].z += y[i].z * rs * g.z; x[i].w += y[i].w * rs * g.w;
      }
    }
#pragma unroll
    for (int i = 0; i < 4; ++i) *(float4*)(P.out + (size_t)tok * DM + (i * 64 + lane) * 4) = x[i];
    if (gnext) {
      float ss = 0.f;
#pragma unroll
      for (int i = 0; i < 4; ++i) ss += x[i].x * x[i].x + x[i].y * x[i].y + x[i].z * x[i].z + x[i].w * x[i].w;
      ss = wave_sum(ss);
      const float rs = rsqrtf(ss * (1.f / 1024.f) + EPS);
#pragma unroll
      for (int i = 0; i < 4; ++i) {
        float4 g = *(const float4*)(gnext + (i * 64 + lane) * 4);
        uint2 pk;
        pk.x = pk2(x[i].x * rs * g.x, x[i].y * rs * g.y);
        pk.y = pk2(x[i].z * rs * g.z, x[i].w * rs * g.w);
        *(uint2*)(XN + (size_t)tok * DM + (i * 64 + lane) * 4) = pk;
      }
    }
  }
}

DI int colmap(int mode, int n, int nsrc) {
  if (mode == 1) { return ((n >> 5) & 1) * DFF + (n >> 6) * 32 + (n & 31); }
  if (mode == 2) {
    if (n < 1664) return n;
    if (n < 2432) return n + 32;
    if (n < 2464) return n - 2432 + 1664;
    if (n < 2560) return -1;
    return n - 96;
  }
  return n < nsrc ? n : -1;
}
DI void conv_job(u16* __restrict__ dst, const float* __restrict__ src, int Nd, int K, int lds, int mode,
                 const float* __restrict__ kscale) {
  const int total = Nd * (K >> 3);
  const int gthreads = gridDim.x * NTHR;
  for (int idx = blockIdx.x * NTHR + opaque_tid(); idx < total; idx += gthreads) {
    const int n = idx % Nd, k8 = idx / Nd;
    const int col = colmap(mode, n, lds);
    float v[8];
#pragma unroll
    for (int j = 0; j < 8; ++j) {
      float x = 0.f;
      if (col >= 0) {
        x = src[(size_t)(k8 * 8 + j) * lds + col];
        if (kscale) x *= kscale[k8 * 8 + j];
      }
      v[j] = x;
    }
    uint4 pk = {pk2(v[0], v[1]), pk2(v[2], v[3]), pk2(v[4], v[5]), pk2(v[6], v[7])};
    *(uint4*)(dst + (size_t)n * K + k8 * 8) = pk;
  }
}
DI void convert_layer(const Params& P, int l) {
  u16* W = (u16*)(P.ws + OFF_W);
  for (int s = 0; s < 2; ++s) {
    conv_job(W + W_WI + (size_t)s * 5632 * 1024, P.ffn_wi + ((size_t)l * 2 + s) * 1024 * 5632, 5632, 1024, 5632, 1, nullptr);
    conv_job(W + W_WO + (size_t)s * 1024 * 2816, P.ffn_wo + ((size_t)l * 2 + s) * 2816 * 1024, 1024, 2816, 1024, 0, nullptr);
  }
  conv_job(W + W_WIN, P.w_in + (size_t)l * 1024 * NPROJ, 6656, 1024, NPROJ, 2, nullptr);
  conv_job(W + W_WUQ, P.c_w_uq + (size_t)l * 384 * 384, 512, 384, 384, 0, P.c_q_norm + l * 384);
  conv_job(W + W_WUKV, P.c_w_ukv + (size_t)l * 256 * 512, 512, 256, 512, 0, P.c_kv_norm + l * 256);
  conv_job(W + W_WB, P.w_branch + (size_t)l * 1024 * 1024, 1024, 1024, 1024, 0, nullptr);
  conv_job(W + W_WOUT, P.w_out + (size_t)l * 1024 * 1024, 1024, 1024, 1024, 0, nullptr);
}
DI void rope_tables(const Params& P) {
  float2* R64 = (float2*)(P.ws + OFF_R64);
  float2* R32 = (float2*)(P.ws + OFF_R32);
  const int gthreads = gridDim.x * NTHR;
  for (int idx = blockIdx.x * NTHR + opaque_tid(); idx < 16384 * 48; idx += gthreads) {
    int pos, f; double base; float2* dst;
    if (idx < 16384 * 32) { pos = idx >> 5; f = idx & 31; base = 0.7498942093324559; dst = R64 + idx; }
    else { const int i2 = idx - 16384 * 32; pos = i2 >> 4; f = i2 & 15; base = 0.5623413251903491; dst = R32 + i2; }
    double inv = 1.0;
    for (int k = 0; k < f; ++k) inv *= base;
    const float ang = (float)pos * (float)inv;
    double tr = (double)ang * 0.15915494309189535;
    tr -= rint(tr);
    const float tf = (float)tr;
    *dst = make_float2(__builtin_amdgcn_cosf(tf), __builtin_amdgcn_sinf(tf));
  }
}

__global__ void __launch_bounds__(NTHR) mega(Params P) {
  extern __shared__ __attribute__((aligned(16))) char smem[];
  cg::grid_group grid = cg::this_grid();
  int phase = 0;
#define ACTIVE() (phase >= P.phase_lo && phase < P.phase_hi)
#define SEAM() do { ++phase; if (P.coop) grid.sync(); } while (0)
  u16* W = (u16*)(P.ws + OFF_W);
  u16* XN = (u16*)(P.ws + OFF_XN);
  u16* R2 = (u16*)(P.ws + OFF_R2);
  u16* qkv = (u16*)(P.ws + OFF_QKV);
  const float* Y = (const float*)(qkv + Q_Y);

  if (ACTIVE()) {
    rope_tables(P);
    convert_layer(P, 0);
    ew_phase(P, nullptr, 0.f, nullptr, P.norm_g, true);
  }
  SEAM();
  for (int l = 0; l < 4; ++l) {
    const float* g = P.norm_g + (size_t)l * 6 * DM;
    if (ACTIVE()) gemm_phase<M_FFNUP, 4>(W + W_WI, XN, DM, DM, 22, smem, P, l);
    SEAM();
    if (ACTIVE()) gemm_phase<M_Y, 4>(W + W_WO, R2, DFF, DFF, 4, smem, P, l);
    SEAM();
    if (ACTIVE()) ew_phase(P, Y, 0.5f, g + DM, g + 2 * DM, false);
    SEAM();
    if (ACTIVE()) {
      gemm_phase<M_PROJ, 2>(W + W_WIN, XN, DM, DM, 10, smem, P, l);
      gemm_phase<M_GATE, 4>(W + W_WIN + 2560ull * 1024, XN, DM, DM, 16, smem, P, l);
    }
    SEAM();
    if (ACTIVE()) {
      gemm_phase<M_CUQ, 4>(W + W_WUQ, qkv + Q_CQ, 384, 384, 2, smem, P, l);
      gemm_phase<M_CUKV, 4>(W + W_WUKV, qkv + Q_CKV, 256, 256, 2, smem, P, l);
    }
    SEAM();
    if (ACTIVE()) attn_phase(P, l, smem);
    SEAM();
    if (ACTIVE()) gemm_phase<M_MERGE, 2>(W + W_WB, XN, DM, DM, 4, smem, P, l);
    SEAM();
    if (ACTIVE()) gemm_phase<M_Y, 4>(W + W_WOUT, qkv + Q_MERGED, DM, DM, 4, smem, P, l);
    SEAM();
    if (ACTIVE()) ew_phase(P, Y, 1.0f, g + 3 * DM, g + 4 * DM, false);
    SEAM();
    if (ACTIVE()) gemm_phase<M_FFNUP, 4>(W + W_WI + 5632ull * 1024, XN, DM, DM, 22, smem, P, l);
    SEAM();
    if (ACTIVE()) gemm_phase<M_Y, 4>(W + W_WO + 1024ull * 2816, R2, DFF, DFF, 4, smem, P, l);
    SEAM();
    if (ACTIVE()) {
      ew_phase(P, Y, 0.5f, g + 5 * DM, l < 3 ? g + 6 * DM : nullptr, false);
      if (l < 3) convert_layer(P, l + 1);
    }
    SEAM();
  }
}

constexpr int N_PHASES = 1 + 12 * 4;

extern "C" void kernel_launch(void* const* d_in, const int* in_sizes, int n_in, void* d_out, int out_size, void* d_ws,
                              size_t ws_size, hipStream_t stream) {
  static int grid_blocks = 0;
  if (!grid_blocks) {
    int dev = 0, cus = 0, per_cu = 0;
    hipGetDevice(&dev);
    hipDeviceGetAttribute(&cus, hipDeviceAttributeMultiprocessorCount, dev);
    hipFuncSetAttribute((const void*)mega, hipFuncAttributeMaxDynamicSharedMemorySize, SMEM_BYTES);
    hipOccupancyMaxActiveBlocksPerMultiprocessor(&per_cu, mega, NTHR, SMEM_BYTES);
    if (per_cu < 1) per_cu = 1;
    grid_blocks = cus * per_cu;
  }
  if (ws_size < WS_NEEDED) fprintf(stderr, "workspace too small: %zu < %zu\n", ws_size, (size_t)WS_NEEDED);
  Params P{};
  P.x_prompt = (const float*)d_in[0]; P.x_sample = (const float*)d_in[1]; P.norm_g = (const float*)d_in[2];
  P.w_in = (const float*)d_in[3]; P.a_qk_norm = (const float*)d_in[4]; P.b_sink = (const float*)d_in[5];
  P.c_q_norm = (const float*)d_in[6]; P.c_kv_norm = (const float*)d_in[7]; P.c_w_uq = (const float*)d_in[8];
  P.c_w_ukv = (const float*)d_in[9]; P.d_lambda = (const float*)d_in[10]; P.d_subln = (const float*)d_in[11];
  P.w_branch = (const float*)d_in[12]; P.w_out = (const float*)d_in[13]; P.ffn_wi = (const float*)d_in[14];
  P.ffn_wo = (const float*)d_in[15];
  P.out = (float*)d_out; P.ws = (char*)d_ws;
#if MULTI_LAUNCH
  for (int ph = 0; ph < N_PHASES; ++ph) {
    P.phase_lo = ph; P.phase_hi = ph + 1; P.coop = 0; P.pad0 = 0;
    hipLaunchKernelGGL(mega, dim3(grid_blocks), dim3(NTHR), SMEM_BYTES, stream, P);
  }
#else
  P.phase_lo = 0; P.phase_hi = 1 << 30; P.coop = 1; P.pad0 = 0;
  void* args[] = {&P};
  hipError_t e = hipLaunchCooperativeKernel((const void*)mega, dim3(grid_blocks), dim3(NTHR), args, SMEM_BYTES, stream);
  if (e != hipSuccess) fprintf(stderr, "cooperative launch failed: %s (grid %d)\n", hipGetErrorString(e), grid_blocks);
#endif
}
```

```cpp
#include <hip/hip_runtime.h>
#include <hip/hip_cooperative_groups.h>
#include <cstdio>
#include <cstdint>
namespace cg = cooperative_groups;

#ifndef MULTI_LAUNCH
#define MULTI_LAUNCH 0
#endif

#define DI __device__ __forceinline__
typedef unsigned short u16;
typedef __attribute__((ext_vector_type(8))) short bf16x8;
typedef __attribute__((ext_vector_type(16))) float f32x16;
typedef __attribute__((ext_vector_type(2))) float f32x2_t;
typedef __attribute__((ext_vector_type(2))) __bf16 bf16x2_t;

constexpr int T = 32768;
constexpr int DM = 1024;
constexpr int DFF = 2816;
constexpr int NPROJ = 6560;
constexpr int SEQ0 = 16384;
constexpr int DSEQ = 2048;
constexpr float EPS = 1e-6f;
constexpr int NTHR = 512;
constexpr int LSTR = 72;
constexpr int SMEM_BYTES = 2 * 2 * 256 * LSTR * 2;

constexpr size_t W_WI = 0;
constexpr size_t W_WO = W_WI + 2ull * 5632 * 1024;
constexpr size_t W_WIN = W_WO + 2ull * 1024 * 2816;
constexpr size_t W_WUQ = W_WIN + 6656ull * 1024;
constexpr size_t W_WUKV = W_WUQ + 512ull * 384;
constexpr size_t W_WB = W_WUKV + 512ull * 256;
constexpr size_t W_WOUT = W_WB + 1024ull * 1024;
constexpr size_t W_TOTAL = W_WOUT + 1024ull * 1024;

constexpr size_t OFF_W = 0;
constexpr size_t OFF_XN = OFF_W + W_TOTAL * 2;
constexpr size_t OFF_R2 = OFF_XN + (size_t)T * 1024 * 2;
constexpr size_t OFF_QKV = OFF_R2 + (size_t)T * 4096 * 2;
constexpr size_t OFF_SS = OFF_QKV + (size_t)T * 3456 * 2;
constexpr size_t OFF_R64 = OFF_SS + (size_t)T * 20 * 4;
constexpr size_t OFF_R32 = OFF_R64 + 16384ull * 32 * 8;
constexpr size_t WS_NEEDED = OFF_R32 + 16384ull * 16 * 8;

constexpr size_t Q_QA = 0;
constexpr size_t Q_KA = (size_t)T * 256;
constexpr size_t Q_VTA = (size_t)T * 384;
constexpr size_t Q_QB = (size_t)T * 512;
constexpr size_t Q_KB = (size_t)T * 768;
constexpr size_t Q_VTB = (size_t)T * 896;
constexpr size_t Q_CQ = (size_t)T * 1024;
constexpr size_t Q_CKV = (size_t)T * 1408;
constexpr size_t Q_QC = (size_t)T * 1664;
constexpr size_t Q_KC = (size_t)T * 2048;
constexpr size_t Q_VTC = (size_t)T * 2432;
constexpr size_t Q_QD = (size_t)T * 2688;
constexpr size_t Q_KD = (size_t)T * 2944;
constexpr size_t Q_VTD = (size_t)T * 3200;
constexpr size_t Q_MERGED = 0;
constexpr size_t Q_Y = (size_t)T * 1024;

struct Params {
  const float* x_prompt; const float* x_sample; const float* norm_g; const float* w_in;
  const float* a_qk_norm; const float* b_sink; const float* c_q_norm; const float* c_kv_norm;
  const float* c_w_uq; const float* c_w_ukv; const float* d_lambda; const float* d_subln;
  const float* w_branch; const float* w_out; const float* ffn_wi; const float* ffn_wo;
  float* out; char* ws;
  int phase_lo; int phase_hi; int coop; int pad0;
};

DI unsigned pk2(float a, float b) {
  f32x2_t v = {a, b};
  bf16x2_t r = __builtin_convertvector(v, bf16x2_t);
  return __builtin_bit_cast(unsigned, r);
}
DI u16 f2bf(float a) { return (u16)(pk2(a, 0.f) & 0xffffu); }
DI float bf2f(unsigned bits16) { return __uint_as_float(bits16 << 16); }
DI int crow(int v, int h) { return (v & 3) + 8 * (v >> 2) + 4 * h; }
DI int pos_of(int tok) { return tok < SEQ0 ? tok : ((tok - SEQ0) & (DSEQ - 1)); }
#define MFMA32(a, b, c) __builtin_amdgcn_mfma_f32_32x32x16_bf16((a), (b), (c), 0, 0, 0)

DI int opaque_tid() { int t = threadIdx.x; asm volatile("" : "+v"(t)); return t; }
DI float wave_sum(float v) {
#pragma unroll
  for (int m = 32; m >= 1; m >>= 1) v += __shfl_xor(v, m);
  return v;
}

DI void rope32_blk(f32x16& a, const float2* __restrict__ tab, int h) {
#pragma unroll
  for (int v = 0; v < 8; ++v) {
    float2 cs = tab[crow(v, h)];
    float x1 = a[v], x2 = a[v + 8];
    a[v] = x1 * cs.x - x2 * cs.y;
    a[v + 8] = x2 * cs.x + x1 * cs.y;
  }
}
DI void rope64_blk(f32x16& a0, f32x16& a1, const float2* __restrict__ tab, int h) {
#pragma unroll
  for (int v = 0; v < 16; ++v) {
    float2 cs = tab[crow(v, h)];
    float x1 = a0[v], x2 = a1[v];
    a0[v] = x1 * cs.x - x2 * cs.y;
    a1[v] = x2 * cs.x + x1 * cs.y;
  }
}
DI void store_rows(u16* __restrict__ base, int ld, int col0, const f32x16& a, int tok, int h) {
#pragma unroll
  for (int vq = 0; vq < 4; ++vq) {
    uint2 pk;
    pk.x = pk2(a[4 * vq], a[4 * vq + 1]);
    pk.y = pk2(a[4 * vq + 2], a[4 * vq + 3]);
    *(uint2*)(base + (size_t)tok * ld + col0 + 8 * vq + 4 * h) = pk;
  }
}
DI void store_T(u16* __restrict__ base, int row0, const f32x16& a, int tok, int h) {
#pragma unroll
  for (int v = 0; v < 16; ++v) base[(size_t)(row0 + crow(v, h)) * T + tok] = f2bf(a[v]);
}

enum { M_FFNUP = 0, M_Y = 1, M_PROJ = 2, M_CUQ = 3, M_CUKV = 4, M_MERGE = 5, M_GATE = 6 };

template <int MODE, int NJ>
DI void gemm_epilogue(f32x16 (&acc)[2][NJ], int fbase, int tbase, int r, int h, const Params& P, int layer) {
  char* ws = P.ws;
  u16* qkv = (u16*)(ws + OFF_QKV);
  const float2* R64 = (const float2*)(ws + OFF_R64);
  const float2* R32 = (const float2*)(ws + OFF_R32);
  float* SS = (float*)(ws + OFF_SS);
  if constexpr (MODE == M_FFNUP) {
    u16* H = (u16*)(ws + OFF_R2);
    const int hf0 = (fbase >> 6) * 32;
#pragma unroll
    for (int j = 0; j < NJ; ++j) {
      const int tok = tbase + j * 32 + r;
      f32x16 o;
#pragma unroll
      for (int v = 0; v < 16; ++v) {
        float g = acc[0][j][v], u = acc[1][j][v];
        o[v] = g / (1.f + __expf(-g)) * u;
      }
      store_rows(H, DFF, hf0, o, tok, h);
    }
  } else if constexpr (MODE == M_Y) {
    float* Y = (float*)(qkv + Q_Y);
#pragma unroll
    for (int j = 0; j < NJ; ++j) {
      const int tok = tbase + j * 32 + r;
#pragma unroll
      for (int i = 0; i < 2; ++i)
#pragma unroll
        for (int vq = 0; vq < 4; ++vq) {
          float4 o = {acc[i][j][4 * vq], acc[i][j][4 * vq + 1], acc[i][j][4 * vq + 2], acc[i][j][4 * vq + 3]};
          *(float4*)(Y + (size_t)tok * DM + fbase + i * 32 + 8 * vq + 4 * h) = o;
        }
    }
  } else if constexpr (MODE == M_PROJ) {
    if (fbase < 384) {
      const bool isK = fbase >= 256;
      const float* g = P.a_qk_norm + layer * 128 + (isK ? 64 : 0);
      u16* dst = qkv + (isK ? Q_KA : Q_QA);
      const int ld = isK ? 128 : 256;
      const int c0 = isK ? fbase - 256 : fbase;
      float gv[2][16];
#pragma unroll
      for (int i = 0; i < 2; ++i)
#pragma unroll
        for (int v = 0; v < 16; ++v) gv[i][v] = g[i * 32 + crow(v, h)];
#pragma unroll
      for (int j = 0; j < NJ; ++j) {
        const int tok = tbase + j * 32 + r;
        const int pos = pos_of(tok);
        float ss = 0.f;
#pragma unroll
        for (int i = 0; i < 2; ++i)
#pragma unroll
          for (int v = 0; v < 16; ++v) ss += acc[i][j][v] * acc[i][j][v];
        ss += __shfl_xor(ss, 32);
        const float rs = rsqrtf(ss * (1.f / 64.f) + EPS);
#pragma unroll
        for (int i = 0; i < 2; ++i)
#pragma unroll
          for (int v = 0; v < 16; ++v) acc[i][j][v] *= rs * gv[i][v];
        rope32_blk(acc[0][j], R32 + (size_t)(pos >> 6) * 16, h);
        rope32_blk(acc[1][j], R32 + (size_t)(pos & 63) * 16, h);
        store_rows(dst, ld, c0, acc[0][j], tok, h);
        store_rows(dst, ld, c0 + 32, acc[1][j], tok, h);
      }
    } else if (fbase < 512) {
#pragma unroll
      for (int j = 0; j < NJ; ++j) {
        const int tok = tbase + j * 32 + r;
        store_T(qkv + Q_VTA, fbase - 384, acc[0][j], tok, h);
        store_T(qkv + Q_VTA, fbase - 384 + 32, acc[1][j], tok, h);
      }
    } else if (fbase < 896) {
      const bool isK = fbase >= 768;
      u16* dst = qkv + (isK ? Q_KB : Q_QB);
      const int ld = isK ? 128 : 256;
      const int c0 = isK ? fbase - 768 : fbase - 512;
#pragma unroll
      for (int j = 0; j < NJ; ++j) {
        const int tok = tbase + j * 32 + r;
        const int pos = pos_of(tok);
        rope64_blk(acc[0][j], acc[1][j], R64 + (size_t)pos * 32, h);
        store_rows(dst, ld, c0, acc[0][j], tok, h);
        store_rows(dst, ld, c0 + 32, acc[1][j], tok, h);
      }
    } else if (fbase < 1024) {
#pragma unroll
      for (int j = 0; j < NJ; ++j) {
        const int tok = tbase + j * 32 + r;
        store_T(qkv + Q_VTB, fbase - 896, acc[0][j], tok, h);
        store_T(qkv + Q_VTB, fbase - 896 + 32, acc[1][j], tok, h);
      }
    } else if (fbase < 1664) {
      const bool isKV = fbase >= 1408;
      u16* dst = qkv + (isKV ? Q_CKV : Q_CQ);
      const int ld = isKV ? 256 : 384;
      const int c0 = isKV ? fbase - 1408 : fbase - 1024;
      const int sb = (isKV ? 12 : 0) + (c0 >> 5);
#pragma unroll
      for (int j = 0; j < NJ; ++j) {
        const int tok = tbase + j * 32 + r;
#pragma unroll
        for (int i = 0; i < 2; ++i) {
          float ss = 0.f;
#pragma unroll
          for (int v = 0; v < 16; ++v) ss += acc[i][j][v] * acc[i][j][v];
          ss += __shfl_xor(ss, 32);
          if (h == 0) SS[(size_t)tok * 20 + sb + i] = ss;
          store_rows(dst, ld, c0 + i * 32, acc[i][j], tok, h);
        }
      }
    } else if (fbase < 2176) {
      const bool isK = fbase >= 1920;
      u16* dst = qkv + (isK ? Q_KD : Q_QD);
      const int c0 = isK ? fbase - 1920 : fbase - 1664;
#pragma unroll
      for (int j = 0; j < NJ; ++j) {
        const int tok = tbase + j * 32 + r;
        const int pos = pos_of(tok);
#pragma unroll
        for (int i = 0; i < 2; ++i) {
          rope32_blk(acc[i][j], R32 + (size_t)pos * 16, h);
          store_rows(dst, 256, c0 + i * 32, acc[i][j], tok, h);
        }
      }
    } else if (fbase < 2432) {
#pragma unroll
      for (int j = 0; j < NJ; ++j) {
        const int tok = tbase + j * 32 + r;
        store_T(qkv + Q_VTD, fbase - 2176, acc[0][j], tok, h);
        store_T(qkv + Q_VTD, fbase - 2176 + 32, acc[1][j], tok, h);
      }
    } else if (fbase == 2432) {
#pragma unroll
      for (int j = 0; j < NJ; ++j) {
        const int tok = tbase + j * 32 + r;
        const int pos = pos_of(tok);
        rope32_blk(acc[0][j], R32 + (size_t)pos * 16, h);
#pragma unroll
        for (int hd = 0; hd < 4; ++hd) store_rows(qkv + Q_KC, 384, hd * 96 + 64, acc[0][j], tok, h);
      }
    }
  } else if constexpr (MODE == M_GATE) {
    u16* G = (u16*)(ws + OFF_R2);
#pragma unroll
    for (int j = 0; j < NJ; ++j) {
      const int tok = tbase + j * 32 + r;
#pragma unroll
      for (int i = 0; i < 2; ++i) {
        f32x16 o;
#pragma unroll
        for (int v = 0; v < 16; ++v) o[v] = 1.f / (1.f + __expf(-acc[i][j][v]));
        store_rows(G, 4096, fbase + i * 32, o, tok, h);
      }
    }
  } else if constexpr (MODE == M_CUQ) {
    if (fbase >= 384) return;
#pragma unroll
    for (int j = 0; j < NJ; ++j) {
      const int tok = tbase + j * 32 + r;
      const int pos = pos_of(tok);
      float ss = 0.f;
#pragma unroll
      for (int b = 0; b < 12; ++b) ss += SS[(size_t)tok * 20 + b];
      const float rs = rsqrtf(ss * (1.f / 384.f) + EPS);
#pragma unroll
      for (int i = 0; i < 2; ++i) {
        const int blk = (fbase >> 5) + i;
#pragma unroll
        for (int v = 0; v < 16; ++v) acc[i][j][v] *= rs;
        if (blk % 3 == 2) rope32_blk(acc[i][j], R32 + (size_t)pos * 16, h);
        store_rows(qkv + Q_QC, 384, blk * 32, acc[i][j], tok, h);
      }
    }
  } else if constexpr (MODE == M_CUKV) {
#pragma unroll
    for (int j = 0; j < NJ; ++j) {
      const int tok = tbase + j * 32 + r;
      float ss = 0.f;
#pragma unroll
      for (int b = 0; b < 8; ++b) ss += SS[(size_t)tok * 20 + 12 + b];
      const float rs = rsqrtf(ss * (1.f / 256.f) + EPS);
#pragma unroll
      for (int i = 0; i < 2; ++i) {
        const int blk = (fbase >> 5) + i;
        const int hd = blk >> 2, q = blk & 3;
#pragma unroll
        for (int v = 0; v < 16; ++v) acc[i][j][v] *= rs;
        if (q < 2) store_rows(qkv + Q_KC, 384, hd * 96 + q * 32, acc[i][j], tok, h);
        else store_T(qkv + Q_VTC, hd * 64 + (q - 2) * 32, acc[i][j], tok, h);
      }
    }
  } else if constexpr (MODE == M_MERGE) {
#pragma unroll
    for (int j = 0; j < NJ; ++j) {
      const int tok = tbase + j * 32 + r;
      store_rows(qkv + Q_MERGED, 1024, fbase, acc[0][j], tok, h);
      store_rows(qkv + Q_MERGED, 1024, fbase + 32, acc[1][j], tok, h);
    }
  }
}

template <int MODE, int NJ>
DI void gemm_tile(const u16* __restrict__ Wt, const u16* __restrict__ X, int ldx, int K, int f0, int t0, char* smem,
                  const Params& P, int layer) {
  constexpr int XROWS = NJ * 64;
  u16* sW = (u16*)smem;
  u16* sX = sW + 2 * 256 * LSTR;
  const int tid = opaque_tid(), lane = tid & 63, wave = tid >> 6, r = lane & 31, h = lane >> 5;
  const int wf = wave & 3, wt = wave >> 2;
  f32x16 acc[2][NJ];
  f32x16 tot[2][MODE == M_MERGE ? NJ : 1];
#pragma unroll
  for (int i = 0; i < 2; ++i)
#pragma unroll
    for (int j = 0; j < NJ; ++j)
#pragma unroll
      for (int v = 0; v < 16; ++v) acc[i][j][v] = 0.f;
  if constexpr (MODE == M_MERGE) {
#pragma unroll
    for (int i = 0; i < 2; ++i)
#pragma unroll
      for (int j = 0; j < NJ; ++j)
#pragma unroll
        for (int v = 0; v < 16; ++v) tot[i][j][v] = 0.f;
  }
  const int nk = K >> 6;
  uint4 wreg[4], xreg[NJ];
  const int crow_ = tid >> 3, ccol = (tid & 7) * 8;
  const u16* wp = Wt + (size_t)(f0 + crow_) * K + ccol;
  const u16* xp = X + (size_t)(t0 + crow_) * ldx + ccol;

  auto gload = [&](int kt) {
#pragma unroll
    for (int i = 0; i < 4; ++i) wreg[i] = *(const uint4*)(wp + (size_t)(i * 64) * K + kt * 64);
#pragma unroll
    for (int i = 0; i < NJ; ++i) xreg[i] = *(const uint4*)(xp + (size_t)(i * 64) * ldx + kt * 64);
  };
  auto sstore = [&](int buf) {
#pragma unroll
    for (int i = 0; i < 4; ++i) *(uint4*)(sW + (buf * 256 + i * 64 + crow_) * LSTR + ccol) = wreg[i];
#pragma unroll
    for (int i = 0; i < NJ; ++i) *(uint4*)(sX + (buf * XROWS + i * 64 + crow_) * LSTR + ccol) = xreg[i];
  };
  const int fbase = f0 + wf * 64, tbase = t0 + wt * (NJ * 32);

  gload(0);
  sstore(0);
  __syncthreads();
  for (int kt = 0; kt < nk; ++kt) {
    const int buf = kt & 1;
    if (kt + 1 < nk) gload(kt + 1);
    const u16* aW = sW + (buf * 256 + wf * 64 + r) * LSTR + h * 8;
    const u16* aX = sX + (buf * XROWS + wt * (NJ * 32) + r) * LSTR + h * 8;
#pragma unroll
    for (int ks = 0; ks < 4; ++ks) {
      bf16x8 wfrag[2], xfrag[NJ];
#pragma unroll
      for (int i = 0; i < 2; ++i) wfrag[i] = *(const bf16x8*)(aW + i * 32 * LSTR + ks * 16);
#pragma unroll
      for (int j = 0; j < NJ; ++j) xfrag[j] = *(const bf16x8*)(aX + j * 32 * LSTR + ks * 16);
#pragma unroll
      for (int i = 0; i < 2; ++i)
#pragma unroll
        for (int j = 0; j < NJ; ++j) acc[i][j] = MFMA32(wfrag[i], xfrag[j], acc[i][j]);
    }
    if constexpr (MODE == M_MERGE) {
      if ((kt & 3) == 3) {
        const int br = kt >> 2;
        const u16* G = (const u16*)(P.ws + OFF_R2);
#pragma unroll
        for (int j = 0; j < NJ; ++j) {
          const int tok = tbase + j * 32 + r;
#pragma unroll
          for (int i = 0; i < 2; ++i)
#pragma unroll
            for (int vq = 0; vq < 4; ++vq) {
              uint2 gp = *(const uint2*)(G + (size_t)tok * 4096 + br * 1024 + fbase + i * 32 + 8 * vq + 4 * h);
              tot[i][j][4 * vq + 0] += bf2f(gp.x & 0xffffu) * acc[i][j][4 * vq + 0];
              tot[i][j][4 * vq + 1] += bf2f(gp.x >> 16) * acc[i][j][4 * vq + 1];
              tot[i][j][4 * vq + 2] += bf2f(gp.y & 0xffffu) * acc[i][j][4 * vq + 2];
              tot[i][j][4 * vq + 3] += bf2f(gp.y >> 16) * acc[i][j][4 * vq + 3];
              acc[i][j][4 * vq + 0] = 0.f; acc[i][j][4 * vq + 1] = 0.f;
              acc[i][j][4 * vq + 2] = 0.f; acc[i][j][4 * vq + 3] = 0.f;
            }
        }
      }
    }
    if (kt + 1 < nk) sstore(buf ^ 1);
    __syncthreads();
  }
  if constexpr (MODE == M_MERGE) gemm_epilogue<MODE, NJ>(tot, fbase, tbase, r, h, P, layer);
  else gemm_epilogue<MODE, NJ>(acc, fbase, tbase, r, h, P, layer);
}

template <int MODE, int NJ>
DI void gemm_phase(const u16* Wt, const u16* X, int ldx, int K, int nF, char* smem, const Params& P, int layer) {
  constexpr int TT = NJ * 64;
  const int nT = T / TT;
  const int ntiles = nF * nT;
  for (int idx = blockIdx.x; idx < ntiles; idx += gridDim.x) {
    const int tt_lo = idx & 15;
    const int rest = idx >> 4;
    const int ft = rest % nF;
    const int tt = (rest / nF) * 16 + tt_lo;
    gemm_tile<MODE, NJ>(Wt, X, ldx, K, ft * 256, tt * TT, smem, P, layer);
  }
}

template <int DQK, int NCOMP, bool BAND, bool DIFF>
DI void attn_item(const u16* __restrict__ Q, int ldq, const u16* __restrict__ Kp, int ldk, const u16* __restrict__ Vt,
                  int qtok0, int kbeg, int kend, float sc_l2, float sink_l2, float lam, float onorm,
                  const float* __restrict__ subg, u16* __restrict__ O, char* smem) {
  constexpr int DC = DQK / NCOMP;
  constexpr int KS = DC / 16;
  constexpr int KSTR = DQK + 8;
  constexpr int KCH = DQK / 8;
  u16* sK = (u16*)smem;
  u16* sV = sK + 2 * 64 * KSTR;
  const int tid = opaque_tid(), lane = tid & 63, wave = tid >> 6, r = lane & 31, h = lane >> 5;
  const int qtok = qtok0 + wave * 32 + r;

  bf16x8 qf[NCOMP][KS];
#pragma unroll
  for (int c = 0; c < NCOMP; ++c)
#pragma unroll
    for (int ks = 0; ks < KS; ++ks) qf[c][ks] = *(const bf16x8*)(Q + (size_t)qtok * ldq + c * DC + ks * 16 + 8 * h);

  f32x16 Oa[NCOMP][2];
  float m[NCOMP], l[NCOMP];
#pragma unroll
  for (int c = 0; c < NCOMP; ++c) {
#pragma unroll
    for (int d = 0; d < 2; ++d)
#pragma unroll
      for (int v = 0; v < 16; ++v) Oa[c][d][v] = 0.f;
    m[c] = BAND ? sink_l2 : -1e30f;
    l[c] = (BAND && h == 0) ? 1.f : 0.f;
  }

  constexpr bool K2 = (64 * KCH > NTHR);
  const int kc0 = tid, kc1 = (tid + NTHR < 64 * KCH) ? tid + NTHR : tid;
  const int krow0 = kc0 / KCH, kcc0 = kc0 % KCH, krow1 = kc1 / KCH, kcc1 = kc1 % KCH;
  const u16* kg0 = Kp + (size_t)krow0 * ldk + kcc0 * 8;
  const u16* kg1 = Kp + (size_t)krow1 * ldk + kcc1 * 8;
  const u16* vg = Vt + (size_t)(tid >> 3) * T + (tid & 7) * 8;
  const int ks0 = krow0 * KSTR + kcc0 * 8, ks1 = krow1 * KSTR + kcc1 * 8;
  const int vs0 = (tid >> 3) * LSTR + (tid & 7) * 8;
  uint4 kreg0, kreg1, vreg;
#define ATT_GLOAD(k0_)                                                   \
  do {                                                                   \
    kreg0 = *(const uint4*)(kg0 + (size_t)(k0_) * ldk);                  \
    if constexpr (K2) kreg1 = *(const uint4*)(kg1 + (size_t)(k0_) * ldk); \
    vreg = *(const uint4*)(vg + (k0_));                                  \
  } while (0)
#define ATT_SSTORE(buf_)                                                 \
  do {                                                                   \
    *(uint4*)(sK + (buf_) * 64 * KSTR + ks0) = kreg0;                    \
    if constexpr (K2) *(uint4*)(sK + (buf_) * 64 * KSTR + ks1) = kreg1;  \
    *(uint4*)(sV + (buf_) * 64 * LSTR + vs0) = vreg;                     \
  } while (0)

  const int ntl = (kend - kbeg) >> 6;
  ATT_GLOAD(kbeg);
  ATT_SSTORE(0);
  __syncthreads();
  for (int t = 0; t < ntl; ++t) {
    const int buf = t & 1;
    const int k0 = kbeg + t * 64;
    if (t + 1 < ntl) ATT_GLOAD(k0 + 64);
    bf16x8 pf[NCOMP][2][2];
#pragma unroll
    for (int c = 0; c < NCOMP; ++c) {
      f32x16 S[2];
#pragma unroll
      for (int kb = 0; kb < 2; ++kb) {
#pragma unroll
        for (int v = 0; v < 16; ++v) S[kb][v] = 0.f;
#pragma unroll
        for (int ks = 0; ks < KS; ++ks) {
          bf16x8 kf = *(const bf16x8*)(sK + (buf * 64 + kb * 32 + r) * KSTR + c * DC + ks * 16 + 8 * h);
          S[kb] = MFMA32(kf, qf[c][ks], S[kb]);
        }
      }
      float mx = -1e30f;
#pragma unroll
      for (int kb = 0; kb < 2; ++kb)
#pragma unroll
        for (int v = 0; v < 16; ++v) {
          float tv = S[kb][v] * sc_l2;
          if (BAND) {
            const int kp = k0 + kb * 32 + crow(v, h);
            const int d = kp - qtok;
            if (d > 128 || d < -128) tv = -1e30f;
          }
          S[kb][v] = tv;
          mx = fmaxf(mx, tv);
        }
      mx = fmaxf(mx, __shfl_xor(mx, 32));
      const float mnew = fmaxf(m[c], mx);
      const float alpha = __builtin_amdgcn_exp2f(m[c] - mnew);
      m[c] = mnew;
      float rsum = 0.f;
#pragma unroll
      for (int kb = 0; kb < 2; ++kb)
#pragma unroll
        for (int v = 0; v < 16; ++v) {
          float p = __builtin_amdgcn_exp2f(S[kb][v] - mnew);
          S[kb][v] = p;
          rsum += p;
        }
      l[c] = l[c] * alpha + rsum;
#pragma unroll
      for (int d = 0; d < 2; ++d)
#pragma unroll
        for (int v = 0; v < 16; ++v) Oa[c][d][v] *= alpha;
#pragma unroll
      for (int kb = 0; kb < 2; ++kb)
#pragma unroll
        for (int s = 0; s < 2; ++s) {
          uint4 pk;
          pk.x = pk2(S[kb][8 * s + 0], S[kb][8 * s + 1]);
          pk.y = pk2(S[kb][8 * s + 2], S[kb][8 * s + 3]);
          pk.z = pk2(S[kb][8 * s + 4], S[kb][8 * s + 5]);
          pk.w = pk2(S[kb][8 * s + 6], S[kb][8 * s + 7]);
          pf[c][kb][s] = __builtin_bit_cast(bf16x8, pk);
        }
    }
#pragma unroll
    for (int d = 0; d < 2; ++d)
#pragma unroll
      for (int kb = 0; kb < 2; ++kb)
#pragma unroll
        for (int s = 0; s < 2; ++s) {
          const u16* vp = sV + (buf * 64 + d * 32 + r) * LSTR + kb * 32 + 16 * s + 4 * h;
          uint2 lo = *(const uint2*)(vp);
          uint2 hi = *(const uint2*)(vp + 8);
          uint4 vv = {lo.x, lo.y, hi.x, hi.y};
          bf16x8 vf = __builtin_bit_cast(bf16x8, vv);
#pragma unroll
          for (int c = 0; c < NCOMP; ++c) Oa[c][d] = MFMA32(vf, pf[c][kb][s], Oa[c][d]);
        }
    if (t + 1 < ntl) ATT_SSTORE(buf ^ 1);
    __syncthreads();
  }

  float inv[NCOMP];
#pragma unroll
  for (int c = 0; c < NCOMP; ++c) {
    float lt = l[c] + __shfl_xor(l[c], 32);
    inv[c] = 1.f / lt;
  }
  if constexpr (DIFF) {
    float ss = 0.f;
#pragma unroll
    for (int d = 0; d < 2; ++d)
#pragma unroll
      for (int v = 0; v < 16; ++v) {
        float o = Oa[0][d][v] * inv[0] - lam * Oa[1][d][v] * inv[1];
        Oa[0][d][v] = o;
        ss += o * o;
      }
    ss += __shfl_xor(ss, 32);
    const float rs = rsqrtf(ss * (1.f / 64.f) + EPS) * onorm;
#pragma unroll
    for (int d = 0; d < 2; ++d)
#pragma unroll
      for (int v = 0; v < 16; ++v) Oa[0][d][v] *= rs * subg[d * 32 + crow(v, h)];
  } else {
#pragma unroll
    for (int d = 0; d < 2; ++d)
#pragma unroll
      for (int v = 0; v < 16; ++v) Oa[0][d][v] *= inv[0];
  }
  store_rows(O, 1024, 0, Oa[0][0], qtok, h);
  store_rows(O, 1024, 32, Oa[0][1], qtok, h);
}

DI void attn_phase(const Params& P, int layer, char* smem) {
  char* ws = P.ws;
  u16* qkv = (u16*)(ws + OFF_QKV);
  u16* BR = (u16*)(ws + OFF_XN);
  const float L2E = 1.4426950408889634f;
  const float lambda_init = 0.8f - 0.6f * __expf(-0.3f * (float)layer);
  float lam;
  {
    const float* dl = P.d_lambda + layer * 128;
    float s1 = 0.f, s2 = 0.f;
    for (int i = 0; i < 32; ++i) { s1 += dl[i] * dl[32 + i]; s2 += dl[64 + i] * dl[96 + i]; }
    lam = __expf(s1) - __expf(s2) + lambda_init;
  }
  for (int it = blockIdx.x; it < 2048; it += gridDim.x) {
    const int cls = it >> 8;
    if (cls < 6) {
      const int idx = it & 255;
      const int head = (idx & 7) >> 1;
      const int qb = ((idx >> 3) << 1) + (idx & 1);
      int qtok0, kbeg, kend;
      if (cls < 3) { qtok0 = qb * 256; kbeg = 0; kend = SEQ0; }
      else { const int s = qb >> 3; kbeg = SEQ0 + s * DSEQ; kend = kbeg + DSEQ; qtok0 = kbeg + (qb & 7) * 256; }
      const int typ = cls % 3;
      if (typ == 0) {
        attn_item<64, 2, false, true>(qkv + Q_QD + head * 64, 256, qkv + Q_KD + head * 64, 256,
                                      qkv + Q_VTD + (size_t)head * 64 * T, qtok0, kbeg, kend,
                                      0.17677669529663687f * L2E, 0.f, lam, 1.f - lambda_init,
                                      P.d_subln + layer * 64, BR + 768 + head * 64, smem);
      } else if (typ == 1) {
        attn_item<96, 1, false, false>(qkv + Q_QC + head * 96, 384, qkv + Q_KC + head * 96, 384,
                                       qkv + Q_VTC + (size_t)head * 64 * T, qtok0, kbeg, kend,
                                       0.10206207261596577f * L2E, 0.f, 0.f, 1.f, nullptr, BR + 512 + head * 64, smem);
      } else {
        attn_item<64, 1, false, false>(qkv + Q_QA + head * 64, 256, qkv + Q_KA + (head >> 1) * 64, 128,
                                       qkv + Q_VTA + (size_t)(head >> 1) * 64 * T, qtok0, kbeg, kend,
                                       0.125f * L2E, 0.f, 0.f, 1.f, nullptr, BR + head * 64, smem);
      }
    } else {
      const int idx = it - 1536;
      const int head = (idx & 7) >> 1;
      const int qbg = ((idx >> 3) << 1) + (idx & 1);
      const int qtok0 = qbg * 256;
      int sb, se;
      if (qtok0 < SEQ0) { sb = 0; se = SEQ0; }
      else { sb = SEQ0 + ((qtok0 - SEQ0) / DSEQ) * DSEQ; se = sb + DSEQ; }
      const int kbeg = max(sb, qtok0 - 128), kend = min(se, qtok0 + 256 + 128);
      const float sink = P.b_sink[layer * 4 + head];
      attn_item<64, 1, true, false>(qkv + Q_QB + head * 64, 256, qkv + Q_KB + (head >> 1) * 64, 128,
                                    qkv + Q_VTB + (size_t)(head >> 1) * 64 * T, qtok0, kbeg, kend,
                                    0.125f * L2E, sink * L2E, 0.f, 1.f, nullptr, BR + 256 + head * 64, smem);
    }
  }
}

DI void ew_phase(const Params& P, const float* __restrict__ Y, float coef, const float* __restrict__ gpost,
                 const float* __restrict__ gnext, bool from_inputs) {
  const int tid = opaque_tid();
  const int lane = tid & 63, wave = tid >> 6;
  u16* XN = (u16*)(P.ws + OFF_XN);
  for (int tok = blockIdx.x * 8 + wave; tok < T; tok += gridDim.x * 8) {
    const float* xs = from_inputs ? (tok < SEQ0 ? P.x_prompt + (size_t)tok * DM : P.x_sample + (size_t)(tok - SEQ0) * DM)
                                  : P.out + (size_t)tok * DM;
    float4 x[4];
#pragma unroll
    for (int i = 0; i < 4; ++i) x[i] = *(const float4*)(xs + (i * 64 + lane) * 4);
    if (Y) {
      float4 y[4];
      float ss = 0.f;
#pragma unroll
      for (int i = 0; i < 4; ++i) {
        y[i] = *(const float4*)(Y + (size_t)tok * DM + (i * 64 + lane) * 4);
        ss += y[i].x * y[i].x + y[i].y * y[i].y + y[i].z * y[i].z + y[i].w * y[i].w;
      }
      ss = wave_sum(ss);
      const float rs = rsqrtf(ss * (1.f / 1024.f) + EPS) * coef;
#pragma unroll
      for (int i = 0; i < 4; ++i) {
        float4 g = *(const float4*)(gpost + (i * 64 + lane) * 4);
        x[i].x += y[i].x * rs * g.x; x[i].y += y[i].y * rs * g.y;
        x[i].z += y[i].z * rs * g.z; x[i].w += y[i].w * rs * g.w;
      }
    }
#pragma unroll
    for (int i = 0; i < 4; ++i) *(float4*)(P.out + (size_t)tok * DM + (i * 64 + lane) * 4) = x[i];
    if (gnext) {
      float ss = 0.f;
#pragma unroll
      for (int i = 0; i < 4; ++i) ss += x[i].x * x[i].x + x[i].y * x[i].y + x[i].z * x[i].z + x[i].w * x[i].w;
      ss = wave_sum(ss);
      const float rs = rsqrtf(ss * (1.f / 1024.f) + EPS);
#pragma unroll
      for (int i = 0; i < 4; ++i) {
        float4 g = *(const float4*)(gnext + (i * 64 + lane) * 4);
        uint2 pk;
        pk.x = pk2(x[i].x * rs * g.x, x[i].y * rs * g.y);
        pk.y = pk2(x[i].z * rs * g.z, x[i].w * rs * g.w);
        *(uint2*)(XN + (size_t)tok * DM + (i * 64 + lane) * 4) = pk;
      }
    }
  }
}

DI int colmap(int mode, int n, int nsrc) {
  if (mode == 1) { return ((n >> 5) & 1) * DFF + (n >> 6) * 32 + (n & 31); }
  if (mode == 2) {
    if (n < 1664) return n;
    if (n < 2432) return n + 32;
    if (n < 2464) return n - 2432 + 1664;
    if (n < 2560) return -1;
    return n - 96;
  }
  return n < nsrc ? n : -1;
}
DI void conv_job(u16* __restrict__ dst, const float* __restrict__ src, int Nd, int K, int lds, int mode,
                 const float* __restrict__ kscale) {
  const int total = Nd * (K >> 3);
  const int gthreads = gridDim.x * NTHR;
  for (int idx = blockIdx.x * NTHR + opaque_tid(); idx < total; idx += gthreads) {
    const int n = idx % Nd, k8 = idx / Nd;
    const int col = colmap(mode, n, lds);
    float v[8];
#pragma unroll
    for (int j = 0; j < 8; ++j) {
      float x = 0.f;
      if (col >= 0) {
        x = src[(size_t)(k8 * 8 + j) * lds + col];
        if (kscale) x *= kscale[k8 * 8 + j];
      }
      v[j] = x;
    }
    uint4 pk = {pk2(v[0], v[1]), pk2(v[2], v[3]), pk2(v[4], v[5]), pk2(v[6], v[7])};
    *(uint4*)(dst + (size_t)n * K + k8 * 8) = pk;
  }
}
DI void convert_layer(const Params& P, int l) {
  u16* W = (u16*)(P.ws + OFF_W);
  for (int s = 0; s < 2; ++s) {
    conv_job(W + W_WI + (size_t)s * 5632 * 1024, P.ffn_wi + ((size_t)l * 2 + s) * 1024 * 5632, 5632, 1024, 5632, 1, nullptr);
    conv_job(W + W_WO + (size_t)s * 1024 * 2816, P.ffn_wo + ((size_t)l * 2 + s) * 2816 * 1024, 1024, 2816, 1024, 0, nullptr);
  }
  conv_job(W + W_WIN, P.w_in + (size_t)l * 1024 * NPROJ, 6656, 1024, NPROJ, 2, nullptr);
  conv_job(W + W_WUQ, P.c_w_uq + (size_t)l * 384 * 384, 512, 384, 384, 0, P.c_q_norm + l * 384);
  conv_job(W + W_WUKV, P.c_w_ukv + (size_t)l * 256 * 512, 512, 256, 512, 0, P.c_kv_norm + l * 256);
  conv_job(W + W_WB, P.w_branch + (size_t)l * 1024 * 1024, 1024, 1024, 1024, 0, nullptr);
  conv_job(W + W_WOUT, P.w_out + (size_t)l * 1024 * 1024, 1024, 1024, 1024, 0, nullptr);
}
DI void rope_tables(const Params& P) {
  float2* R64 = (float2*)(P.ws + OFF_R64);
  float2* R32 = (float2*)(P.ws + OFF_R32);
  const int gthreads = gridDim.x * NTHR;
  for (int idx = blockIdx.x * NTHR + opaque_tid(); idx < 16384 * 48; idx += gthreads) {
    int pos, f; double base; float2* dst;
    if (idx < 16384 * 32) { pos = idx >> 5; f = idx & 31; base = 0.7498942093324559; dst = R64 + idx; }
    else { const int i2 = idx - 16384 * 32; pos = i2 >> 4; f = i2 & 15; base = 0.5623413251903491; dst = R32 + i2; }
    double inv = 1.0;
    for (int k = 0; k < f; ++k) inv *= base;
    const float ang = (float)pos * (float)inv;
    double tr = (double)ang * 0.15915494309189535;
    tr -= rint(tr);
    const float tf = (float)tr;
    *dst = make_float2(__builtin_amdgcn_cosf(tf), __builtin_amdgcn_sinf(tf));
  }
}

__global__ void __launch_bounds__(NTHR) mega(Params P) {
  extern __shared__ __attribute__((aligned(16))) char smem[];
  cg::grid_group grid = cg::this_grid();
  int phase = 0;
#define ACTIVE() (phase >= P.phase_lo && phase < P.phase_hi)
#define SEAM() do { ++phase; if (P.coop) grid.sync(); } while (0)
  u16* W = (u16*)(P.ws + OFF_W);
  u16* XN = (u16*)(P.ws + OFF_XN);
  u16* R2 = (u16*)(P.ws + OFF_R2);
  u16* qkv = (u16*)(P.ws + OFF_QKV);
  const float* Y = (const float*)(qkv + Q_Y);

  if (ACTIVE()) {
    rope_tables(P);
    convert_layer(P, 0);
    ew_phase(P, nullptr, 0.f, nullptr, P.norm_g, true);
  }
  SEAM();
  for (int l = 0; l < 4; ++l) {
    const float* g = P.norm_g + (size_t)l * 6 * DM;
    if (ACTIVE()) gemm_phase<M_FFNUP, 4>(W + W_WI, XN, DM, DM, 22, smem, P, l);
    SEAM();
    if (ACTIVE()) gemm_phase<M_Y, 4>(W + W_WO, R2, DFF, DFF, 4, smem, P, l);
    SEAM();
    if (ACTIVE()) ew_phase(P, Y, 0.5f, g + DM, g + 2 * DM, false);
    SEAM();
    if (ACTIVE()) {
      gemm_phase<M_PROJ, 2>(W + W_WIN, XN, DM, DM, 10, smem, P, l);
      gemm_phase<M_GATE, 4>(W + W_WIN + 2560ull * 1024, XN, DM, DM, 16, smem, P, l);
    }
    SEAM();
    if (ACTIVE()) {
      gemm_phase<M_CUQ, 4>(W + W_WUQ, qkv + Q_CQ, 384, 384, 2, smem, P, l);
      gemm_phase<M_CUKV, 4>(W + W_WUKV, qkv + Q_CKV, 256, 256, 2, smem, P, l);
    }
    SEAM();
    if (ACTIVE()) attn_phase(P, l, smem);
    SEAM();
    if (ACTIVE()) gemm_phase<M_MERGE, 2>(W + W_WB, XN, DM, DM, 4, smem, P, l);
    SEAM();
    if (ACTIVE()) gemm_phase<M_Y, 4>(W + W_WOUT, qkv + Q_MERGED, DM, DM, 4, smem, P, l);
    SEAM();
    if (ACTIVE()) ew_phase(P, Y, 1.0f, g + 3 * DM, g + 4 * DM, false);
    SEAM();
    if (ACTIVE()) gemm_phase<M_FFNUP, 4>(W + W_WI + 5632ull * 1024, XN, DM, DM, 22, smem, P, l);
    SEAM();
    if (ACTIVE()) gemm_phase<M_Y, 4>(W + W_WO + 1024ull * 2816, R2, DFF, DFF, 4, smem, P, l);
    SEAM();
    if (ACTIVE()) {
      ew_phase(P, Y, 0.5f, g + 5 * DM, l < 3 ? g + 6 * DM : nullptr, false);
      if (l < 3) convert_layer(P, l + 1);
    }
    SEAM();
  }
}

constexpr int N_PHASES = 1 + 12 * 4;

extern "C" void kernel_launch(void* const* d_in, const int* in_sizes, int n_in, void* d_out, int out_size, void* d_ws,
                              size_t ws_size, hipStream_t stream) {
  static int grid_blocks = 0;
  if (!grid_blocks) {
    int dev = 0, cus = 0, per_cu = 0;
    hipGetDevice(&dev);
    hipDeviceGetAttribute(&cus, hipDeviceAttributeMultiprocessorCount, dev);
    hipFuncSetAttribute((const void*)mega, hipFuncAttributeMaxDynamicSharedMemorySize, SMEM_BYTES);
    hipOccupancyMaxActiveBlocksPerMultiprocessor(&per_cu, mega, NTHR, SMEM_BYTES);
    if (per_cu < 1) per_cu = 1;
    grid_blocks = cus * per_cu;
  }
  if (ws_size < WS_NEEDED) fprintf(stderr, "workspace too small: %zu < %zu\n", ws_size, (size_t)WS_NEEDED);
  Params P{};
  P.x_prompt = (const float*)d_in[0]; P.x_sample = (const float*)d_in[1]; P.norm_g = (const float*)d_in[2];
  P.w_in = (const float*)d_in[3]; P.a_qk_norm = (const float*)d_in[4]; P.b_sink = (const float*)d_in[5];
  P.c_q_norm = (const float*)d_in[6]; P.c_kv_norm = (const float*)d_in[7]; P.c_w_uq = (const float*)d_in[8];
  P.c_w_ukv = (const float*)d_in[9]; P.d_lambda = (const float*)d_in[10]; P.d_subln = (const float*)d_in[11];
  P.w_branch = (const float*)d_in[12]; P.w_out = (const float*)d_in[13]; P.ffn_wi = (const float*)d_in[14];
  P.ffn_wo = (const float*)d_in[15];
  P.out = (float*)d_out; P.ws = (char*)d_ws;
#if MULTI_LAUNCH
  for (int ph = 0; ph < N_PHASES; ++ph) {
    P.phase_lo = ph; P.phase_hi = ph + 1; P.coop = 0; P.pad0 = 0;
    hipLaunchKernelGGL(mega, dim3(grid_blocks), dim3(NTHR), SMEM_BYTES, stream, P);
  }
#else
  P.phase_lo = 0; P.phase_hi = 1 << 30; P.coop = 1; P.pad0 = 0;
  void* args[] = {&P};
  hipError_t e = hipLaunchCooperativeKernel((const void*)mega, dim3(grid_blocks), dim3(NTHR), args, SMEM_BYTES, stream);
  if (e != hipSuccess) fprintf(stderr, "cooperative launch failed: %s (grid %d)\n", hipGetErrorString(e), grid_blocks);
#endif
}
```

```cpp
#include <hip/hip_runtime.h>
#include <hip/hip_cooperative_groups.h>
#include <cstdio>
#include <cstdint>
namespace cg = cooperative_groups;

#ifndef MULTI_LAUNCH
#define MULTI_LAUNCH 0
#endif

#define DI __device__ __forceinline__
typedef unsigned short u16;
typedef __attribute__((ext_vector_type(8))) short bf16x8;
typedef __attribute__((ext_vector_type(16))) float f32x16;
typedef __attribute__((ext_vector_type(2))) float f32x2_t;
typedef __attribute__((ext_vector_type(2))) __bf16 bf16x2_t;

constexpr int T = 32768;
constexpr int DM = 1024;
constexpr int DFF = 2816;
constexpr int NPROJ = 6560;
constexpr int SEQ0 = 16384;
constexpr int DSEQ = 2048;
constexpr float EPS = 1e-6f;
constexpr int NTHR = 512;
constexpr int LSTR = 72;
constexpr int SMEM_BYTES = 2 * 2 * 256 * LSTR * 2;

constexpr size_t W_WI = 0;
constexpr size_t W_WO = W_WI + 2ull * 5632 * 1024;
constexpr size_t W_WIN = W_WO + 2ull * 1024 * 2816;
constexpr size_t W_WUQ = W_WIN + 6656ull * 1024;
constexpr size_t W_WUKV = W_WUQ + 512ull * 384;
constexpr size_t W_WB = W_WUKV + 512ull * 256;
constexpr size_t W_WOUT = W_WB + 1024ull * 1024;
constexpr size_t W_TOTAL = W_WOUT + 1024ull * 1024;

constexpr size_t OFF_W = 0;
constexpr size_t OFF_XN = OFF_W + W_TOTAL * 2;
constexpr size_t OFF_R2 = OFF_XN + (size_t)T * 1024 * 2;
constexpr size_t OFF_QKV = OFF_R2 + (size_t)T * 4096 * 2;
constexpr size_t OFF_SS = OFF_QKV + (size_t)T * 3456 * 2;
constexpr size_t OFF_R64 = OFF_SS + (size_t)T * 20 * 4;
constexpr size_t OFF_R32 = OFF_R64 + 16384ull * 32 * 8;
constexpr size_t WS_NEEDED = OFF_R32 + 16384ull * 16 * 8;

constexpr size_t Q_QA = 0;
constexpr size_t Q_KA = (size_t)T * 256;
constexpr size_t Q_VTA = (size_t)T * 384;
constexpr size_t Q_QB = (size_t)T * 512;
constexpr size_t Q_KB = (size_t)T * 768;
constexpr size_t Q_VTB = (size_t)T * 896;
constexpr size_t Q_CQ = (size_t)T * 1024;
constexpr size_t Q_CKV = (size_t)T * 1408;
constexpr size_t Q_QC = (size_t)T * 1664;
constexpr size_t Q_KC = (size_t)T * 2048;
constexpr size_t Q_VTC = (size_t)T * 2432;
constexpr size_t Q_QD = (size_t)T * 2688;
constexpr size_t Q_KD = (size_t)T * 2944;
constexpr size_t Q_VTD = (size_t)T * 3200;
constexpr size_t Q_MERGED = 0;
constexpr size_t Q_Y = (size_t)T * 1024;

struct Params {
  const float* x_prompt; const float* x_sample; const float* norm_g; const float* w_in;
  const float* a_qk_norm; const float* b_sink; const float* c_q_norm; const float* c_kv_norm;
  const float* c_w_uq; const float* c_w_ukv; const float* d_lambda; const float* d_subln;
  const float* w_branch; const float* w_out; const float* ffn_wi; const float* ffn_wo;
  float* out; char* ws;
  int phase_lo; int phase_hi; int coop; int pad0;
};

DI unsigned pk2(float a, float b) {
  f32x2_t v = {a, b};
  bf16x2_t r = __builtin_convertvector(v, bf16x2_t);
  return __builtin_bit_cast(unsigned, r);
}
DI u16 f2bf(float a) { return (u16)(pk2(a, 0.f) & 0xffffu); }
DI float bf2f(unsigned bits16) { return __uint_as_float(bits16 << 16); }
DI int crow(int v, int h) { return (v & 3) + 8 * (v >> 2) + 4 * h; }
DI int pos_of(int tok) { return tok < SEQ0 ? tok : ((tok - SEQ0) & (DSEQ - 1)); }
#define MFMA32(a, b, c) __builtin_amdgcn_mfma_f32_32x32x16_bf16((a), (b), (c), 0, 0, 0)

typedef __attribute__((ext_vector_type(4))) unsigned u32x4;
DI u32x4 gld16(const void* p) { u32x4 r; asm volatile("global_load_dwordx4 %0, %1, off" : "=v"(r) : "v"(p)); return r; }
DI void wait_vm0(u32x4& a) { asm volatile("s_waitcnt vmcnt(0)" : "+v"(a) :: "memory"); }
DI void wait_vm0(u32x4& a, u32x4& b) { asm volatile("s_waitcnt vmcnt(0)" : "+v"(a), "+v"(b) :: "memory"); }
DI void wait_vm0(u32x4& a, u32x4& b, u32x4& c) { asm volatile("s_waitcnt vmcnt(0)" : "+v"(a), "+v"(b), "+v"(c) :: "memory"); }
DI void wait_vm0(u32x4& a, u32x4& b, u32x4& c, u32x4& d) { asm volatile("s_waitcnt vmcnt(0)" : "+v"(a), "+v"(b), "+v"(c), "+v"(d) :: "memory"); }
DI int opaque_tid() { int t = threadIdx.x; asm volatile("" : "+v"(t)); return t; }
DI float wave_sum(float v) {
#pragma unroll
  for (int m = 32; m >= 1; m >>= 1) v += __shfl_xor(v, m);
  return v;
}

DI void rope32_blk(f32x16& a, const float2* __restrict__ tab, int h) {
#pragma unroll
  for (int v = 0; v < 8; ++v) {
    float2 cs = tab[crow(v, h)];
    float x1 = a[v], x2 = a[v + 8];
    a[v] = x1 * cs.x - x2 * cs.y;
    a[v + 8] = x2 * cs.x + x1 * cs.y;
  }
}
DI void rope64_blk(f32x16& a0, f32x16& a1, const float2* __restrict__ tab, int h) {
#pragma unroll
  for (int v = 0; v < 16; ++v) {
    float2 cs = tab[crow(v, h)];
    float x1 = a0[v], x2 = a1[v];
    a0[v] = x1 * cs.x - x2 * cs.y;
    a1[v] = x2 * cs.x + x1 * cs.y;
  }
}
DI void store_rows(u16* __restrict__ base, int ld, int col0, const f32x16& a, int tok, int h) {
#pragma unroll
  for (int vq = 0; vq < 4; ++vq) {
    uint2 pk;
    pk.x = pk2(a[4 * vq], a[4 * vq + 1]);
    pk.y = pk2(a[4 * vq + 2], a[4 * vq + 3]);
    *(uint2*)(base + (size_t)tok * ld + col0 + 8 * vq + 4 * h) = pk;
  }
}
DI void store_T(u16* __restrict__ base, int row0, const f32x16& a, int tok, int h) {
#pragma unroll
  for (int v = 0; v < 16; ++v) base[(size_t)(row0 + crow(v, h)) * T + tok] = f2bf(a[v]);
}

enum { M_FFNUP = 0, M_Y = 1, M_PROJ = 2, M_CUQ = 3, M_CUKV = 4, M_MERGE = 5, M_GATE = 6 };

template <int MODE, int NJ>
DI void gemm_epilogue(f32x16 (&acc)[2][NJ], int fbase, int tbase, int r, int h, const Params& P, int layer) {
  char* ws = P.ws;
  u16* qkv = (u16*)(ws + OFF_QKV);
  const float2* R64 = (const float2*)(ws + OFF_R64);
  const float2* R32 = (const float2*)(ws + OFF_R32);
  float* SS = (float*)(ws + OFF_SS);
  if constexpr (MODE == M_FFNUP) {
    u16* H = (u16*)(ws + OFF_R2);
    const int hf0 = (fbase >> 6) * 32;
#pragma unroll
    for (int j = 0; j < NJ; ++j) {
      const int tok = tbase + j * 32 + r;
      f32x16 o;
#pragma unroll
      for (int v = 0; v < 16; ++v) {
        float g = acc[0][j][v], u = acc[1][j][v];
        o[v] = g / (1.f + __expf(-g)) * u;
      }
      store_rows(H, DFF, hf0, o, tok, h);
    }
  } else if constexpr (MODE == M_Y) {
    float* Y = (float*)(qkv + Q_Y);
#pragma unroll
    for (int j = 0; j < NJ; ++j) {
      const int tok = tbase + j * 32 + r;
#pragma unroll
      for (int i = 0; i < 2; ++i)
#pragma unroll
        for (int vq = 0; vq < 4; ++vq) {
          float4 o = {acc[i][j][4 * vq], acc[i][j][4 * vq + 1], acc[i][j][4 * vq + 2], acc[i][j][4 * vq + 3]};
          *(float4*)(Y + (size_t)tok * DM + fbase + i * 32 + 8 * vq + 4 * h) = o;
        }
    }
  } else if constexpr (MODE == M_PROJ) {
    if (fbase < 384) {
      const bool isK = fbase >= 256;
      const float* g = P.a_qk_norm + layer * 128 + (isK ? 64 : 0);
      u16* dst = qkv + (isK ? Q_KA : Q_QA);
      const int ld = isK ? 128 : 256;
      const int c0 = isK ? fbase - 256 : fbase;
      float gv[2][16];
#pragma unroll
      for (int i = 0; i < 2; ++i)
#pragma unroll
        for (int v = 0; v < 16; ++v) gv[i][v] = g[i * 32 + crow(v, h)];
#pragma unroll
      for (int j = 0; j < NJ; ++j) {
        const int tok = tbase + j * 32 + r;
        const int pos = pos_of(tok);
        float ss = 0.f;
#pragma unroll
        for (int i = 0; i < 2; ++i)
#pragma unroll
          for (int v = 0; v < 16; ++v) ss += acc[i][j][v] * acc[i][j][v];
        ss += __shfl_xor(ss, 32);
        const float rs = rsqrtf(ss * (1.f / 64.f) + EPS);
#pragma unroll
        for (int i = 0; i < 2; ++i)
#pragma unroll
          for (int v = 0; v < 16; ++v) acc[i][j][v] *= rs * gv[i][v];
        rope32_blk(acc[0][j], R32 + (size_t)(pos >> 6) * 16, h);
        rope32_blk(acc[1][j], R32 + (size_t)(pos & 63) * 16, h);
        store_rows(dst, ld, c0, acc[0][j], tok, h);
        store_rows(dst, ld, c0 + 32, acc[1][j], tok, h);
      }
    } else if (fbase < 512) {
#pragma unroll
      for (int j = 0; j < NJ; ++j) {
        const int tok = tbase + j * 32 + r;
        store_T(qkv + Q_VTA, fbase - 384, acc[0][j], tok, h);
        store_T(qkv + Q_VTA, fbase - 384 + 32, acc[1][j], tok, h);
      }
    } else if (fbase < 896) {
      const bool isK = fbase >= 768;
      u16* dst = qkv + (isK ? Q_KB : Q_QB);
      const int ld = isK ? 128 : 256;
      const int c0 = isK ? fbase - 768 : fbase - 512;
#pragma unroll
      for (int j = 0; j < NJ; ++j) {
        const int tok = tbase + j * 32 + r;
        const int pos = pos_of(tok);
        rope64_blk(acc[0][j], acc[1][j], R64 + (size_t)pos * 32, h);
        store_rows(dst, ld, c0, acc[0][j], tok, h);
        store_rows(dst, ld, c0 + 32, acc[1][j], tok, h);
      }
    } else if (fbase < 1024) {
#pragma unroll
      for (int j = 0; j < NJ; ++j) {
        const int tok = tbase + j * 32 + r;
        store_T(qkv + Q_VTB, fbase - 896, acc[0][j], tok, h);
        store_T(qkv + Q_VTB, fbase - 896 + 32, acc[1][j], tok, h);
      }
    } else if (fbase < 1664) {
      const bool isKV = fbase >= 1408;
      u16* dst = qkv + (isKV ? Q_CKV : Q_CQ);
      const int ld = isKV ? 256 : 384;
      const int c0 = isKV ? fbase - 1408 : fbase - 1024;
      const int sb = (isKV ? 12 : 0) + (c0 >> 5);
#pragma unroll
      for (int j = 0; j < NJ; ++j) {
        const int tok = tbase + j * 32 + r;
#pragma unroll
        for (int i = 0; i < 2; ++i) {
          float ss = 0.f;
#pragma unroll
          for (int v = 0; v < 16; ++v) ss += acc[i][j][v] * acc[i][j][v];
          ss += __shfl_xor(ss, 32);
          if (h == 0) SS[(size_t)tok * 20 + sb + i] = ss;
          store_rows(dst, ld, c0 + i * 32, acc[i][j], tok, h);
        }
      }
    } else if (fbase < 2176) {
      const bool isK = fbase >= 1920;
      u16* dst = qkv + (isK ? Q_KD : Q_QD);
      const int c0 = isK ? fbase - 1920 : fbase - 1664;
#pragma unroll
      for (int j = 0; j < NJ; ++j) {
        const int tok = tbase + j * 32 + r;
        const int pos = pos_of(tok);
#pragma unroll
        for (int i = 0; i < 2; ++i) {
          rope32_blk(acc[i][j], R32 + (size_t)pos * 16, h);
          store_rows(dst, 256, c0 + i * 32, acc[i][j], tok, h);
        }
      }
    } else if (fbase < 2432) {
#pragma unroll
      for (int j = 0; j < NJ; ++j) {
        const int tok = tbase + j * 32 + r;
        store_T(qkv + Q_VTD, fbase - 2176, acc[0][j], tok, h);
        store_T(qkv + Q_VTD, fbase - 2176 + 32, acc[1][j], tok, h);
      }
    } else if (fbase == 2432) {
#pragma unroll
      for (int j = 0; j < NJ; ++j) {
        const int tok = tbase + j * 32 + r;
        const int pos = pos_of(tok);
        rope32_blk(acc[0][j], R32 + (size_t)pos * 16, h);
#pragma unroll
        for (int hd = 0; hd < 4; ++hd) store_rows(qkv + Q_KC, 384, hd * 96 + 64, acc[0][j], tok, h);
      }
    }
  } else if constexpr (MODE == M_GATE) {
    u16* G = (u16*)(ws + OFF_R2);
#pragma unroll
    for (int j = 0; j < NJ; ++j) {
      const int tok = tbase + j * 32 + r;
#pragma unroll
      for (int i = 0; i < 2; ++i) {
        f32x16 o;
#pragma unroll
        for (int v = 0; v < 16; ++v) o[v] = 1.f / (1.f + __expf(-acc[i][j][v]));
        store_rows(G, 4096, fbase + i * 32, o, tok, h);
      }
    }
  } else if constexpr (MODE == M_CUQ) {
    if (fbase >= 384) return;
#pragma unroll
    for (int j = 0; j < NJ; ++j) {
      const int tok = tbase + j * 32 + r;
      const int pos = pos_of(tok);
      float ss = 0.f;
#pragma unroll
      for (int b = 0; b < 12; ++b) ss += SS[(size_t)tok * 20 + b];
      const float rs = rsqrtf(ss * (1.f / 384.f) + EPS);
#pragma unroll
      for (int i = 0; i < 2; ++i) {
        const int blk = (fbase >> 5) + i;
#pragma unroll
        for (int v = 0; v < 16; ++v) acc[i][j][v] *= rs;
        if (blk % 3 == 2) rope32_blk(acc[i][j], R32 + (size_t)pos * 16, h);
        store_rows(qkv + Q_QC, 384, blk * 32, acc[i][j], tok, h);
      }
    }
  } else if constexpr (MODE == M_CUKV) {
#pragma unroll
    for (int j = 0; j < NJ; ++j) {
      const int tok = tbase + j * 32 + r;
      float ss = 0.f;
#pragma unroll
      for (int b = 0; b < 8; ++b) ss += SS[(size_t)tok * 20 + 12 + b];
      const float rs = rsqrtf(ss * (1.f / 256.f) + EPS);
#pragma unroll
      for (int i = 0; i < 2; ++i) {
        const int blk = (fbase >> 5) + i;
        const int hd = blk >> 2, q = blk & 3;
#pragma unroll
        for (int v = 0; v < 16; ++v) acc[i][j][v] *= rs;
        if (q < 2) store_rows(qkv + Q_KC, 384, hd * 96 + q * 32, acc[i][j], tok, h);
        else store_T(qkv + Q_VTC, hd * 64 + (q - 2) * 32, acc[i][j], tok, h);
      }
    }
  } else if constexpr (MODE == M_MERGE) {
#pragma unroll
    for (int j = 0; j < NJ; ++j) {
      const int tok = tbase + j * 32 + r;
      store_rows(qkv + Q_MERGED, 1024, fbase, acc[0][j], tok, h);
      store_rows(qkv + Q_MERGED, 1024, fbase + 32, acc[1][j], tok, h);
    }
  }
}

template <int MODE, int NJ>
DI void gemm_tile(const u16* __restrict__ Wt, const u16* __restrict__ X, int ldx, int K, int f0, int t0, char* smem,
                  const Params& P, int layer) {
  constexpr int XROWS = NJ * 64;
  u16* sW = (u16*)smem;
  u16* sX = sW + 2 * 256 * LSTR;
  const int tid = opaque_tid(), lane = tid & 63, wave = tid >> 6, r = lane & 31, h = lane >> 5;
  const int wf = wave & 3, wt = wave >> 2;
  f32x16 acc[2][NJ];
  f32x16 tot[2][MODE == M_MERGE ? NJ : 1];
#pragma unroll
  for (int i = 0; i < 2; ++i)
#pragma unroll
    for (int j = 0; j < NJ; ++j)
#pragma unroll
      for (int v = 0; v < 16; ++v) acc[i][j][v] = 0.f;
  if constexpr (MODE == M_MERGE) {
#pragma unroll
    for (int i = 0; i < 2; ++i)
#pragma unroll
      for (int j = 0; j < NJ; ++j)
#pragma unroll
        for (int v = 0; v < 16; ++v) tot[i][j][v] = 0.f;
  }
  const int nk = K >> 6;
  u32x4 wreg[4], xreg[NJ];
  const int crow_ = tid >> 3, ccol = (tid & 7) * 8;
  const u16* wp = Wt + (size_t)(f0 + crow_) * K + ccol;
  const u16* xp = X + (size_t)(t0 + crow_) * ldx + ccol;

  auto gload = [&](int kt) {
#pragma unroll
    for (int i = 0; i < 4; ++i) wreg[i] = gld16(wp + (size_t)(i * 64) * K + kt * 64);
#pragma unroll
    for (int i = 0; i < NJ; ++i) xreg[i] = gld16(xp + (size_t)(i * 64) * ldx + kt * 64);
  };
  auto sstore = [&](int buf) {
    wait_vm0(wreg[0], wreg[1], wreg[2], wreg[3]);
    if constexpr (NJ == 4) wait_vm0(xreg[0], xreg[1], xreg[2], xreg[3]);
    else wait_vm0(xreg[0], xreg[1]);
#pragma unroll
    for (int i = 0; i < 4; ++i) *(u32x4*)(sW + (buf * 256 + i * 64 + crow_) * LSTR + ccol) = wreg[i];
#pragma unroll
    for (int i = 0; i < NJ; ++i) *(u32x4*)(sX + (buf * XROWS + i * 64 + crow_) * LSTR + ccol) = xreg[i];
  };
  const int fbase = f0 + wf * 64, tbase = t0 + wt * (NJ * 32);

  gload(0);
  sstore(0);
  __syncthreads();
  for (int kt = 0; kt < nk; ++kt) {
    const int buf = kt & 1;
    if (kt + 1 < nk) gload(kt + 1);
    const u16* aW = sW + (buf * 256 + wf * 64 + r) * LSTR + h * 8;
    const u16* aX = sX + (buf * XROWS + wt * (NJ * 32) + r) * LSTR + h * 8;
#pragma unroll
    for (int ks = 0; ks < 4; ++ks) {
      bf16x8 wfrag[2], xfrag[NJ];
#pragma unroll
      for (int i = 0; i < 2; ++i) wfrag[i] = *(const bf16x8*)(aW + i * 32 * LSTR + ks * 16);
#pragma unroll
      for (int j = 0; j < NJ; ++j) xfrag[j] = *(const bf16x8*)(aX + j * 32 * LSTR + ks * 16);
#pragma unroll
      for (int i = 0; i < 2; ++i)
#pragma unroll
        for (int j = 0; j < NJ; ++j) acc[i][j] = MFMA32(wfrag[i], xfrag[j], acc[i][j]);
    }
    if constexpr (MODE == M_MERGE) {
      if ((kt & 3) == 3) {
        const int br = kt >> 2;
        const u16* G = (const u16*)(P.ws + OFF_R2);
#pragma unroll
        for (int j = 0; j < NJ; ++j) {
          const int tok = tbase + j * 32 + r;
#pragma unroll
          for (int i = 0; i < 2; ++i)
#pragma unroll
            for (int vq = 0; vq < 4; ++vq) {
              uint2 gp = *(const uint2*)(G + (size_t)tok * 4096 + br * 1024 + fbase + i * 32 + 8 * vq + 4 * h);
              tot[i][j][4 * vq + 0] += bf2f(gp.x & 0xffffu) * acc[i][j][4 * vq + 0];
              tot[i][j][4 * vq + 1] += bf2f(gp.x >> 16) * acc[i][j][4 * vq + 1];
              tot[i][j][4 * vq + 2] += bf2f(gp.y & 0xffffu) * acc[i][j][4 * vq + 2];
              tot[i][j][4 * vq + 3] += bf2f(gp.y >> 16) * acc[i][j][4 * vq + 3];
              acc[i][j][4 * vq + 0] = 0.f; acc[i][j][4 * vq + 1] = 0.f;
              acc[i][j][4 * vq + 2] = 0.f; acc[i][j][4 * vq + 3] = 0.f;
            }
        }
      }
    }
    if (kt + 1 < nk) sstore(buf ^ 1);
    __syncthreads();
  }
  if constexpr (MODE == M_MERGE) gemm_epilogue<MODE, NJ>(tot, fbase, tbase, r, h, P, layer);
  else gemm_epilogue<MODE, NJ>(acc, fbase, tbase, r, h, P, layer);
}

template <int MODE, int NJ>
DI void gemm_phase(const u16* Wt, const u16* X, int ldx, int K, int nF, char* smem, const Params& P, int layer) {
  constexpr int TT = NJ * 64;
  const int nT = T / TT;
  const int ntiles = nF * nT;
  for (int idx = blockIdx.x; idx < ntiles; idx += gridDim.x) {
    const int tt_lo = idx & 15;
    const int rest = idx >> 4;
    const int ft = rest % nF;
    const int tt = (rest / nF) * 16 + tt_lo;
    gemm_tile<MODE, NJ>(Wt, X, ldx, K, ft * 256, tt * TT, smem, P, layer);
  }
}

template <int DQK, int NCOMP, bool BAND, bool DIFF>
DI void attn_item(const u16* __restrict__ Q, int ldq, const u16* __restrict__ Kp, int ldk, const u16* __restrict__ Vt,
                  int qtok0, int kbeg, int kend, float sc_l2, float sink_l2, float lam, float onorm,
                  const float* __restrict__ subg, u16* __restrict__ O, char* smem) {
  constexpr int DC = DQK / NCOMP;
  constexpr int KS = DC / 16;
  constexpr int KSTR = DQK + 8;
  constexpr int KCH = DQK / 8;
  u16* sK = (u16*)smem;
  u16* sV = sK + 2 * 64 * KSTR;
  const int tid = opaque_tid(), lane = tid & 63, wave = tid >> 6, r = lane & 31, h = lane >> 5;
  const int qtok = qtok0 + wave * 32 + r;

  bf16x8 qf[NCOMP][KS];
#pragma unroll
  for (int c = 0; c < NCOMP; ++c)
#pragma unroll
    for (int ks = 0; ks < KS; ++ks) qf[c][ks] = *(const bf16x8*)(Q + (size_t)qtok * ldq + c * DC + ks * 16 + 8 * h);

  f32x16 Oa[NCOMP][2];
  float m[NCOMP], l[NCOMP];
#pragma unroll
  for (int c = 0; c < NCOMP; ++c) {
#pragma unroll
    for (int d = 0; d < 2; ++d)
#pragma unroll
      for (int v = 0; v < 16; ++v) Oa[c][d][v] = 0.f;
    m[c] = BAND ? sink_l2 : -1e30f;
    l[c] = (BAND && h == 0) ? 1.f : 0.f;
  }

  constexpr bool K2 = (64 * KCH > NTHR);
  const int kc0 = tid, kc1 = (tid + NTHR < 64 * KCH) ? tid + NTHR : tid;
  const int krow0 = kc0 / KCH, kcc0 = kc0 % KCH, krow1 = kc1 / KCH, kcc1 = kc1 % KCH;
  const u16* kg0 = Kp + (size_t)krow0 * ldk + kcc0 * 8;
  const u16* kg1 = Kp + (size_t)krow1 * ldk + kcc1 * 8;
  const u16* vg = Vt + (size_t)(tid >> 3) * T + (tid & 7) * 8;
  const int ks0 = krow0 * KSTR + kcc0 * 8, ks1 = krow1 * KSTR + kcc1 * 8;
  const int vs0 = (tid >> 3) * LSTR + (tid & 7) * 8;
  u32x4 kreg0, kreg1, vreg;
#define ATT_GLOAD(k0_)                                                   \
  do {                                                                   \
    kreg0 = gld16(kg0 + (size_t)(k0_) * ldk);                            \
    if constexpr (K2) kreg1 = gld16(kg1 + (size_t)(k0_) * ldk);          \
    vreg = gld16(vg + (k0_));                                            \
  } while (0)
#define ATT_SSTORE(buf_)                                                 \
  do {                                                                   \
    if constexpr (K2) wait_vm0(kreg0, kreg1, vreg); else wait_vm0(kreg0, vreg); \
    *(u32x4*)(sK + (buf_) * 64 * KSTR + ks0) = kreg0;                    \
    if constexpr (K2) *(u32x4*)(sK + (buf_) * 64 * KSTR + ks1) = kreg1;  \
    *(u32x4*)(sV + (buf_) * 64 * LSTR + vs0) = vreg;                     \
  } while (0)

  const int ntl = (kend - kbeg) >> 6;
  ATT_GLOAD(kbeg);
  ATT_SSTORE(0);
  __syncthreads();
  for (int t = 0; t < ntl; ++t) {
    const int buf = t & 1;
    const int k0 = kbeg + t * 64;
    if (t + 1 < ntl) ATT_GLOAD(k0 + 64);
    bf16x8 pf[NCOMP][2][2];
#pragma unroll
    for (int c = 0; c < NCOMP; ++c) {
      f32x16 S[2];
#pragma unroll
      for (int kb = 0; kb < 2; ++kb) {
#pragma unroll
        for (int v = 0; v < 16; ++v) S[kb][v] = 0.f;
#pragma unroll
        for (int ks = 0; ks < KS; ++ks) {
          bf16x8 kf = *(const bf16x8*)(sK + (buf * 64 + kb * 32 + r) * KSTR + c * DC + ks * 16 + 8 * h);
          S[kb] = MFMA32(kf, qf[c][ks], S[kb]);
        }
      }
      float mx = -1e30f;
#pragma unroll
      for (int kb = 0; kb < 2; ++kb)
#pragma unroll
        for (int v = 0; v < 16; ++v) {
          float tv = S[kb][v] * sc_l2;
          if (BAND) {
            const int kp = k0 + kb * 32 + crow(v, h);
            const int d = kp - qtok;
            if (d > 128 || d < -128) tv = -1e30f;
          }
          S[kb][v] = tv;
          mx = fmaxf(mx, tv);
        }
      mx = fmaxf(mx, __shfl_xor(mx, 32));
      const float mnew = fmaxf(m[c], mx);
      const float alpha = __builtin_amdgcn_exp2f(m[c] - mnew);
      m[c] = mnew;
      float rsum = 0.f;
#pragma unroll
      for (int kb = 0; kb < 2; ++kb)
#pragma unroll
        for (int v = 0; v < 16; ++v) {
          float p = __builtin_amdgcn_exp2f(S[kb][v] - mnew);
          S[kb][v] = p;
          rsum += p;
        }
      l[c] = l[c] * alpha + rsum;
#pragma unroll
      for (int d = 0; d < 2; ++d)
#pragma unroll
        for (int v = 0; v < 16; ++v) Oa[c][d][v] *= alpha;
#pragma unroll
      for (int kb = 0; kb < 2; ++kb)
#pragma unroll
        for (int s = 0; s < 2; ++s) {
          uint4 pk;
          pk.x = pk2(S[kb][8 * s + 0], S[kb][8 * s + 1]);
          pk.y = pk2(S[kb][8 * s + 2], S[kb][8 * s + 3]);
          pk.z = pk2(S[kb][8 * s + 4], S[kb][8 * s + 5]);
          pk.w = pk2(S[kb][8 * s + 6], S[kb][8 * s + 7]);
          pf[c][kb][s] = __builtin_bit_cast(bf16x8, pk);
        }
    }
#pragma unroll
    for (int d = 0; d < 2; ++d)
#pragma unroll
      for (int kb = 0; kb < 2; ++kb)
#pragma unroll
        for (int s = 0; s < 2; ++s) {
          const u16* vp = sV + (buf * 64 + d * 32 + r) * LSTR + kb * 32 + 16 * s + 4 * h;
          uint2 lo = *(const uint2*)(vp);
          uint2 hi = *(const uint2*)(vp + 8);
          uint4 vv = {lo.x, lo.y, hi.x, hi.y};
          bf16x8 vf = __builtin_bit_cast(bf16x8, vv);
#pragma unroll
          for (int c = 0; c < NCOMP; ++c) Oa[c][d] = MFMA32(vf, pf[c][kb][s], Oa[c][d]);
        }
    if (t + 1 < ntl) ATT_SSTORE(buf ^ 1);
    __syncthreads();
  }

  float inv[NCOMP];
#pragma unroll
  for (int c = 0; c < NCOMP; ++c) {
    float lt = l[c] + __shfl_xor(l[c], 32);
    inv[c] = 1.f / lt;
  }
  if constexpr (DIFF) {
    float ss = 0.f;
#pragma unroll
    for (int d = 0; d < 2; ++d)
#pragma unroll
      for (int v = 0; v < 16; ++v) {
        float o = Oa[0][d][v] * inv[0] - lam * Oa[1][d][v] * inv[1];
        Oa[0][d][v] = o;
        ss += o * o;
      }
    ss += __shfl_xor(ss, 32);
    const float rs = rsqrtf(ss * (1.f / 64.f) + EPS) * onorm;
#pragma unroll
    for (int d = 0; d < 2; ++d)
#pragma unroll
      for (int v = 0; v < 16; ++v) Oa[0][d][v] *= rs * subg[d * 32 + crow(v, h)];
  } else {
#pragma unroll
    for (int d = 0; d < 2; ++d)
#pragma unroll
      for (int v = 0; v < 16; ++v) Oa[0][d][v] *= inv[0];
  }
  store_rows(O, 1024, 0, Oa[0][0], qtok, h);
  store_rows(O, 1024, 32, Oa[0][1], qtok, h);
}

DI void attn_phase(const Params& P, int layer, char* smem) {
  char* ws = P.ws;
  u16* qkv = (u16*)(ws + OFF_QKV);
  u16* BR = (u16*)(ws + OFF_XN);
  const float L2E = 1.4426950408889634f;
  const float lambda_init = 0.8f - 0.6f * __expf(-0.3f * (float)layer);
  float lam;
  {
    const float* dl = P.d_lambda + layer * 128;
    float s1 = 0.f, s2 = 0.f;
    for (int i = 0; i < 32; ++i) { s1 += dl[i] * dl[32 + i]; s2 += dl[64 + i] * dl[96 + i]; }
    lam = __expf(s1) - __expf(s2) + lambda_init;
  }
  for (int it = blockIdx.x; it < 2048; it += gridDim.x) {
    const int cls = it >> 8;
    if (cls < 6) {
      const int idx = it & 255;
      const int head = (idx & 7) >> 1;
      const int qb = ((idx >> 3) << 1) + (idx & 1);
      int qtok0, kbeg, kend;
      if (cls < 3) { qtok0 = qb * 256; kbeg = 0; kend = SEQ0; }
      else { const int s = qb >> 3; kbeg = SEQ0 + s * DSEQ; kend = kbeg + DSEQ; qtok0 = kbeg + (qb & 7) * 256; }
      const int typ = cls % 3;
      if (typ == 0) {
        attn_item<64, 2, false, true>(qkv + Q_QD + head * 64, 256, qkv + Q_KD + head * 64, 256,
                                      qkv + Q_VTD + (size_t)head * 64 * T, qtok0, kbeg, kend,
                                      0.17677669529663687f * L2E, 0.f, lam, 1.f - lambda_init,
                                      P.d_subln + layer * 64, BR + 768 + head * 64, smem);
      } else if (typ == 1) {
        attn_item<96, 1, false, false>(qkv + Q_QC + head * 96, 384, qkv + Q_KC + head * 96, 384,
                                       qkv + Q_VTC + (size_t)head * 64 * T, qtok0, kbeg, kend,
                                       0.10206207261596577f * L2E, 0.f, 0.f, 1.f, nullptr, BR + 512 + head * 64, smem);
      } else {
        attn_item<64, 1, false, false>(qkv + Q_QA + head * 64, 256, qkv + Q_KA + (head >> 1) * 64, 128,
                                       qkv + Q_VTA + (size_t)(head >> 1) * 64 * T, qtok0, kbeg, kend,
                                       0.125f * L2E, 0.f, 0.f, 1.f, nullptr, BR + head * 64, smem);
      }
    } else {
      const int idx = it - 1536;
      const int head = (idx & 7) >> 1;
      const int qbg = ((idx >> 3) << 1) + (idx & 1);
      const int qtok0 = qbg * 256;
      int sb, se;
      if (qtok0 < SEQ0) { sb = 0; se = SEQ0; }
      else { sb = SEQ0 + ((qtok0 - SEQ0) / DSEQ) * DSEQ; se = sb + DSEQ; }
      const int kbeg = max(sb, qtok0 - 128), kend = min(se, qtok0 + 256 + 128);
      const float sink = P.b_sink[layer * 4 + head];
      attn_item<64, 1, true, false>(qkv + Q_QB + head * 64, 256, qkv + Q_KB + (head >> 1) * 64, 128,
                                    qkv + Q_VTB + (size_t)(head >> 1) * 64 * T, qtok0, kbeg, kend,
                                    0.125f * L2E, sink * L2E, 0.f, 1.f, nullptr, BR + 256 + head * 64, smem);
    }
  }
}

DI void ew_phase(const Params& P, const float* __restrict__ Y, float coef, const float* __restrict__ gpost,
                 const float* __restrict__ gnext, bool from_inputs) {
  const int tid = opaque_tid();
  const int lane = tid & 63, wave = tid >> 6;
  u16* XN = (u16*)(P.ws + OFF_XN);
  for (int tok = blockIdx.x * 8 + wave; tok < T; tok += gridDim.x * 8) {
    const float* xs = from_inputs ? (tok < SEQ0 ? P.x_prompt + (size_t)tok * DM : P.x_sample + (size_t)(tok - SEQ0) * DM)
                                  : P.out + (size_t)tok * DM;
    float4 x[4];
#pragma unroll
    for (int i = 0; i < 4; ++i) x[i] = *(const float4*)(xs + (i * 64 + lane) * 4);
    if (Y) {
      float4 y[4];
      float ss = 0.f;
#pragma unroll
      for (int i = 0; i < 4; ++i) {
        y[i] = *(const float4*)(Y + (size_t)tok * DM + (i * 64 + lane) * 4);
        ss += y[i].x * y[i].x + y[i].y * y[i].y + y[i].z * y[i].z + y[i].w * y[i].w;
      }
      ss = wave_sum(ss);
      const float rs = rsqrtf(ss * (1.f / 1024.f) + EPS) * coef;
#pragma unroll
      for (int i = 0; i < 4; ++i) {
        float4 g = *(const float4*)(gpost + (i * 64 + lane) * 4);
        x[i].x += y[i].x * rs * g.x; x[i].y += y[i].y * rs * g.y;
        x[i].z += y[i].z * rs * g.z; x[i].w += y[i].w * rs * g.w;
      }
    }
#pragma unroll
    for (int i = 0; i < 4; ++i) *(float4*)(P.out + (size_t)tok * DM + (i * 64 + lane) * 4) = x[i];
    if (gnext) {
      float ss = 0.f;
#pragma unroll
      for (int i = 0; i < 4; ++i) ss += x[i].x * x[i].x + x[i].y * x[i].y + x[i].z * x[i].z + x[i].w * x[i].w;
      ss = wave_sum(ss);
      const float rs = rsqrtf(ss * (1.f / 1024.f) + EPS);
#pragma unroll
      for (int i = 0; i < 4; ++i) {
        float4 g = *(const float4*)(gnext + (i * 64 + lane) * 4);
        uint2 pk;
        pk.x = pk2(x[i].x * rs * g.x, x[i].y * rs * g.y);
        pk.y = pk2(x[i].z * rs * g.z, x[i].w * rs * g.w);
        *(uint2*)(XN + (size_t)tok * DM + (i * 64 + lane) * 4) = pk;
      }
    }
  }
}

DI int colmap(int mode, int n, int nsrc) {
  if (mode == 1) { return ((n >> 5) & 1) * DFF + (n >> 6) * 32 + (n & 31); }
  if (mode == 2) {
    if (n < 1664) return n;
    if (n < 2432) return n + 32;
    if (n < 2464) return n - 2432 + 1664;
    if (n < 2560) return -1;
    return n - 96;
  }
  return n < nsrc ? n : -1;
}
DI void conv_job(u16* __restrict__ dst, const float* __restrict__ src, int Nd, int K, int lds, int mode,
                 const float* __restrict__ kscale) {
  const int total = Nd * (K >> 3);
  const int gthreads = gridDim.x * NTHR;
  for (int idx = blockIdx.x * NTHR + opaque_tid(); idx < total; idx += gthreads) {
    const int n = idx % Nd, k8 = idx / Nd;
    const int col = colmap(mode, n, lds);
    float v[8];
#pragma unroll
    for (int j = 0; j < 8; ++j) {
      float x = 0.f;
      if (col >= 0) {
        x = src[(size_t)(k8 * 8 + j) * lds + col];
        if (kscale) x *= kscale[k8 * 8 + j];
      }
      v[j] = x;
    }
    uint4 pk = {pk2(v[0], v[1]), pk2(v[2], v[3]), pk2(v[4], v[5]), pk2(v[6], v[7])};
    *(uint4*)(dst + (size_t)n * K + k8 * 8) = pk;
  }
}
DI void convert_layer(const Params& P, int l) {
  u16* W = (u16*)(P.ws + OFF_W);
  for (int s = 0; s < 2; ++s) {
    conv_job(W + W_WI + (size_t)s * 5632 * 1024, P.ffn_wi + ((size_t)l * 2 + s) * 1024 * 5632, 5632, 1024, 5632, 1, nullptr);
    conv_job(W + W_WO + (size_t)s * 1024 * 2816, P.ffn_wo + ((size_t)l * 2 + s) * 2816 * 1024, 1024, 2816, 1024, 0, nullptr);
  }
  conv_job(W + W_WIN, P.w_in + (size_t)l * 1024 * NPROJ, 6656, 1024, NPROJ, 2, nullptr);
  conv_job(W + W_WUQ, P.c_w_uq + (size_t)l * 384 * 384, 512, 384, 384, 0, P.c_q_norm + l * 384);
  conv_job(W + W_WUKV, P.c_w_ukv + (size_t)l * 256 * 512, 512, 256, 512, 0, P.c_kv_norm + l * 256);
  conv_job(W + W_WB, P.w_branch + (size_t)l * 1024 * 1024, 1024, 1024, 1024, 0, nullptr);
  conv_job(W + W_WOUT, P.w_out + (size_t)l * 1024 * 1024, 1024, 1024, 1024, 0, nullptr);
}
DI void rope_tables(const Params& P) {
  float2* R64 = (float2*)(P.ws + OFF_R64);
  float2* R32 = (float2*)(P.ws + OFF_R32);
  const int gthreads = gridDim.x * NTHR;
  for (int idx = blockIdx.x * NTHR + opaque_tid(); idx < 16384 * 48; idx += gthreads) {
    int pos, f; double base; float2* dst;
    if (idx < 16384 * 32) { pos = idx >> 5; f = idx & 31; base = 0.7498942093324559; dst = R64 + idx; }
    else { const int i2 = idx - 16384 * 32; pos = i2 >> 4; f = i2 & 15; base = 0.5623413251903491; dst = R32 + i2; }
    double inv = 1.0;
    for (int k = 0; k < f; ++k) inv *= base;
    const float ang = (float)pos * (float)inv;
    double tr = (double)ang * 0.15915494309189535;
    tr -= rint(tr);
    const float tf = (float)tr;
    *dst = make_float2(__builtin_amdgcn_cosf(tf), __builtin_amdgcn_sinf(tf));
  }
}

__global__ void __launch_bounds__(NTHR) mega(Params P) {
  extern __shared__ __attribute__((aligned(16))) char smem[];
  cg::grid_group grid = cg::this_grid();
  int phase = 0;
#define ACTIVE() (phase >= P.phase_lo && phase < P.phase_hi)
#define SEAM() do { ++phase; if (P.coop) grid.sync(); } while (0)
  u16* W = (u16*)(P.ws + OFF_W);
  u16* XN = (u16*)(P.ws + OFF_XN);
  u16* R2 = (u16*)(P.ws + OFF_R2);
  u16* qkv = (u16*)(P.ws + OFF_QKV);
  const float* Y = (const float*)(qkv + Q_Y);

  if (ACTIVE()) {
    rope_tables(P);
    convert_layer(P, 0);
    ew_phase(P, nullptr, 0.f, nullptr, P.norm_g, true);
  }
  SEAM();
  for (int l = 0; l < 4; ++l) {
    const float* g = P.norm_g + (size_t)l * 6 * DM;
    if (ACTIVE()) gemm_phase<M_FFNUP, 4>(W + W_WI, XN, DM, DM, 22, smem, P, l);
    SEAM();
    if (ACTIVE()) gemm_phase<M_Y, 4>(W + W_WO, R2, DFF, DFF, 4, smem, P, l);
    SEAM();
    if (ACTIVE()) ew_phase(P, Y, 0.5f, g + DM, g + 2 * DM, false);
    SEAM();
    if (ACTIVE()) {
      gemm_phase<M_PROJ, 2>(W + W_WIN, XN, DM, DM, 10, smem, P, l);
      gemm_phase<M_GATE, 4>(W + W_WIN + 2560ull * 1024, XN, DM, DM, 16, smem, P, l);
    }
    SEAM();
    if (ACTIVE()) {
      gemm_phase<M_CUQ, 4>(W + W_WUQ, qkv + Q_CQ, 384, 384, 2, smem, P, l);
      gemm_phase<M_CUKV, 4>(W + W_WUKV, qkv + Q_CKV, 256, 256, 2, smem, P, l);
    }
    SEAM();
    if (ACTIVE()) attn_phase(P, l, smem);
    SEAM();
    if (ACTIVE()) gemm_phase<M_MERGE, 2>(W + W_WB, XN, DM, DM, 4, smem, P, l);
    SEAM();
    if (ACTIVE()) gemm_phase<M_Y, 4>(W + W_WOUT, qkv + Q_MERGED, DM, DM, 4, smem, P, l);
    SEAM();
    if (ACTIVE()) ew_phase(P, Y, 1.0f, g + 3 * DM, g + 4 * DM, false);
    SEAM();
    if (ACTIVE()) gemm_phase<M_FFNUP, 4>(W + W_WI + 5632ull * 1024, XN, DM, DM, 22, smem, P, l);
    SEAM();
    if (ACTIVE()) gemm_phase<M_Y, 4>(W + W_WO + 1024ull * 2816, R2, DFF, DFF, 4, smem, P, l);
    SEAM();
    if (ACTIVE()) {
      ew_phase(P, Y, 0.5f, g + 5 * DM, l < 3 ? g + 6 * DM : nullptr, false);
      if (l < 3) convert_layer(P, l + 1);
    }
    SEAM();
  }
}

constexpr int N_PHASES = 1 + 12 * 4;

extern "C" void kernel_launch(void* const* d_in, const int* in_sizes, int n_in, void* d_out, int out_size, void* d_ws,
                              size_t ws_size, hipStream_t stream) {
  static int grid_blocks = 0;
  if (!grid_blocks) {
    int dev = 0, cus = 0, per_cu = 0;
    hipGetDevice(&dev);
    hipDeviceGetAttribute(&cus, hipDeviceAttributeMultiprocessorCount, dev);
    hipFuncSetAttribute((const void*)mega, hipFuncAttributeMaxDynamicSharedMemorySize, SMEM_BYTES);
    hipOccupancyMaxActiveBlocksPerMultiprocessor(&per_cu, mega, NTHR, SMEM_BYTES);
    if (per_cu < 1) per_cu = 1;
    grid_blocks = cus * per_cu;
  }
  if (ws_size < WS_NEEDED) fprintf(stderr, "workspace too small: %zu < %zu\n", ws_size, (size_t)WS_NEEDED);
  Params P{};
  P.x_prompt = (const float*)d_in[0]; P.x_sample = (const float*)d_in[1]; P.norm_g = (const float*)d_in[2];
  P.w_in = (const float*)d_in[3]; P.a_qk_norm = (const float*)d_in[4]; P.b_sink = (const float*)d_in[5];
  P.c_q_norm = (const float*)d_in[6]; P.c_kv_norm = (const float*)d_in[7]; P.c_w_uq = (const float*)d_in[8];
  P.c_w_ukv = (const float*)d_in[9]; P.d_lambda = (const float*)d_in[10]; P.d_subln = (const float*)d_in[11];
  P.w_branch = (const float*)d_in[12]; P.w_out = (const float*)d_in[13]; P.ffn_wi = (const float*)d_in[14];
  P.ffn_wo = (const float*)d_in[15];
  P.out = (float*)d_out; P.ws = (char*)d_ws;
#if MULTI_LAUNCH
  for (int ph = 0; ph < N_PHASES; ++ph) {
    P.phase_lo = ph; P.phase_hi = ph + 1; P.coop = 0; P.pad0 = 0;
    hipLaunchKernelGGL(mega, dim3(grid_blocks), dim3(NTHR), SMEM_BYTES, stream, P);
  }
#else
  P.phase_lo = 0; P.phase_hi = 1 << 30; P.coop = 1; P.pad0 = 0;
  void* args[] = {&P};
  hipError_t e = hipLaunchCooperativeKernel((const void*)mega, dim3(grid_blocks), dim3(NTHR), args, SMEM_BYTES, stream);
  if (e != hipSuccess) fprintf(stderr, "cooperative launch failed: %s (grid %d)\n", hipGetErrorString(e), grid_blocks);
#endif
}
```

```cpp
#include <hip/hip_runtime.h>
#include <hip/hip_cooperative_groups.h>
#include <cstdio>
#include <cstdint>
#include <type_traits>
namespace cg = cooperative_groups;

#ifndef MULTI_LAUNCH
#define MULTI_LAUNCH 0
#endif

#define DI __device__ __forceinline__
typedef unsigned short u16;
typedef __attribute__((ext_vector_type(8))) short bf16x8;
typedef __attribute__((ext_vector_type(16))) float f32x16;
typedef __attribute__((ext_vector_type(2))) float f32x2_t;
typedef __attribute__((ext_vector_type(2))) __bf16 bf16x2_t;

constexpr int T = 32768;
constexpr int DM = 1024;
constexpr int DFF = 2816;
constexpr int NPROJ = 6560;
constexpr int SEQ0 = 16384;
constexpr int DSEQ = 2048;
constexpr float EPS = 1e-6f;
constexpr int NTHR = 512;
constexpr int LSTR = 72;
constexpr int SMEM_BYTES = 2 * 2 * 256 * LSTR * 2;

constexpr size_t W_WI = 0;
constexpr size_t W_WO = W_WI + 2ull * 5632 * 1024;
constexpr size_t W_WIN = W_WO + 2ull * 1024 * 2816;
constexpr size_t W_WUQ = W_WIN + 6656ull * 1024;
constexpr size_t W_WUKV = W_WUQ + 512ull * 384;
constexpr size_t W_WB = W_WUKV + 512ull * 256;
constexpr size_t W_WOUT = W_WB + 1024ull * 1024;
constexpr size_t W_TOTAL = W_WOUT + 1024ull * 1024;

constexpr size_t OFF_W = 0;
constexpr size_t OFF_XN = OFF_W + W_TOTAL * 2;
constexpr size_t OFF_R2 = OFF_XN + (size_t)T * 1024 * 2;
constexpr size_t OFF_QKV = OFF_R2 + (size_t)T * 4096 * 2;
constexpr size_t OFF_SS = OFF_QKV + (size_t)T * 3456 * 2;
constexpr size_t OFF_R64 = OFF_SS + (size_t)T * 20 * 4;
constexpr size_t OFF_R32 = OFF_R64 + 16384ull * 32 * 8;
constexpr size_t OFF_DS = OFF_R32 + 16384ull * 16 * 8;
constexpr size_t WS_NEEDED = OFF_DS + (size_t)T * 256 * 4;

constexpr size_t Q_QA = 0;
constexpr size_t Q_KA = (size_t)T * 256;
constexpr size_t Q_VTA = (size_t)T * 384;
constexpr size_t Q_QB = (size_t)T * 512;
constexpr size_t Q_KB = (size_t)T * 768;
constexpr size_t Q_VTB = (size_t)T * 896;
constexpr size_t Q_CQ = (size_t)T * 1024;
constexpr size_t Q_CKV = (size_t)T * 1408;
constexpr size_t Q_QC = (size_t)T * 1664;
constexpr size_t Q_KC = (size_t)T * 2048;
constexpr size_t Q_VTC = (size_t)T * 2432;
constexpr size_t Q_QD = (size_t)T * 2688;
constexpr size_t Q_KD = (size_t)T * 2944;
constexpr size_t Q_VTD = (size_t)T * 3200;
constexpr size_t Q_MERGED = 0;
constexpr size_t Q_Y = (size_t)T * 1024;

struct Params {
  const float* x_prompt; const float* x_sample; const float* norm_g; const float* w_in;
  const float* a_qk_norm; const float* b_sink; const float* c_q_norm; const float* c_kv_norm;
  const float* c_w_uq; const float* c_w_ukv; const float* d_lambda; const float* d_subln;
  const float* w_branch; const float* w_out; const float* ffn_wi; const float* ffn_wo;
  float* out; char* ws;
  int phase_lo; int phase_hi; int coop; int pad0;
};

DI unsigned pk2(float a, float b) {
  f32x2_t v = {a, b};
  bf16x2_t r = __builtin_convertvector(v, bf16x2_t);
  return __builtin_bit_cast(unsigned, r);
}
DI u16 f2bf(float a) { return (u16)(pk2(a, 0.f) & 0xffffu); }
DI float bf2f(unsigned bits16) { return __uint_as_float(bits16 << 16); }
DI int crow(int v, int h) { return (v & 3) + 8 * (v >> 2) + 4 * h; }
DI int pos_of(int tok) { return tok < SEQ0 ? tok : ((tok - SEQ0) & (DSEQ - 1)); }
#define MFMA32(a, b, c) __builtin_amdgcn_mfma_f32_32x32x16_bf16((a), (b), (c), 0, 0, 0)

typedef __attribute__((ext_vector_type(4))) unsigned u32x4;
DI u32x4 gld16(const void* p) { u32x4 r; asm volatile("global_load_dwordx4 %0, %1, off" : "=v"(r) : "v"(p)); return r; }
DI void wait_vm0(u32x4& a) { asm volatile("s_waitcnt vmcnt(0)" : "+v"(a) :: "memory"); }
DI void wait_vm0(u32x4& a, u32x4& b) { asm volatile("s_waitcnt vmcnt(0)" : "+v"(a), "+v"(b) :: "memory"); }
DI void wait_vm0(u32x4& a, u32x4& b, u32x4& c) { asm volatile("s_waitcnt vmcnt(0)" : "+v"(a), "+v"(b), "+v"(c) :: "memory"); }
DI void wait_vm0(u32x4& a, u32x4& b, u32x4& c, u32x4& d) { asm volatile("s_waitcnt vmcnt(0)" : "+v"(a), "+v"(b), "+v"(c), "+v"(d) :: "memory"); }
DI int opaque_tid() { int t = threadIdx.x; asm volatile("" : "+v"(t)); return t; }
DI float wave_sum(float v) {
#pragma unroll
  for (int m = 32; m >= 1; m >>= 1) v += __shfl_xor(v, m);
  return v;
}

DI void rope32_blk(f32x16& a, const float2* __restrict__ tab, int h) {
#pragma unroll
  for (int v = 0; v < 8; ++v) {
    float2 cs = tab[crow(v, h)];
    float x1 = a[v], x2 = a[v + 8];
    a[v] = x1 * cs.x - x2 * cs.y;
    a[v + 8] = x2 * cs.x + x1 * cs.y;
  }
}
DI void rope64_blk(f32x16& a0, f32x16& a1, const float2* __restrict__ tab, int h) {
#pragma unroll
  for (int v = 0; v < 16; ++v) {
    float2 cs = tab[crow(v, h)];
    float x1 = a0[v], x2 = a1[v];
    a0[v] = x1 * cs.x - x2 * cs.y;
    a1[v] = x2 * cs.x + x1 * cs.y;
  }
}
DI void store_rows(u16* __restrict__ base, int ld, int col0, const f32x16& a, int tok, int h) {
#pragma unroll
  for (int vq = 0; vq < 4; ++vq) {
    uint2 pk;
    pk.x = pk2(a[4 * vq], a[4 * vq + 1]);
    pk.y = pk2(a[4 * vq + 2], a[4 * vq + 3]);
    *(uint2*)(base + (size_t)tok * ld + col0 + 8 * vq + 4 * h) = pk;
  }
}
DI void store_T(u16* __restrict__ base, int row0, const f32x16& a, int tok, int h) {
  const int tp = (tok & ~12) | ((tok & 4) << 1) | ((tok & 8) >> 1);
#pragma unroll
  for (int v = 0; v < 16; ++v) base[(size_t)(row0 + crow(v, h)) * T + tp] = f2bf(a[v]);
}

enum { M_FFNUP = 0, M_Y = 1, M_PROJ = 2, M_CUQ = 3, M_CUKV = 4, M_MERGE = 5, M_GATE = 6 };

template <int MODE, int NJ>
DI void gemm_epilogue(f32x16 (&acc)[2][NJ], int fbase, int tbase, int r, int h, const Params& P, int layer) {
  char* ws = P.ws;
  u16* qkv = (u16*)(ws + OFF_QKV);
  const float2* R64 = (const float2*)(ws + OFF_R64);
  const float2* R32 = (const float2*)(ws + OFF_R32);
  float* SS = (float*)(ws + OFF_SS);
  if constexpr (MODE == M_FFNUP) {
    u16* H = (u16*)(ws + OFF_R2);
    const int hf0 = (fbase >> 6) * 32;
#pragma unroll
    for (int j = 0; j < NJ; ++j) {
      const int tok = tbase + j * 32 + r;
      f32x16 o;
#pragma unroll
      for (int v = 0; v < 16; ++v) {
        float g = acc[0][j][v], u = acc[1][j][v];
        o[v] = g / (1.f + __expf(-g)) * u;
      }
      store_rows(H, DFF, hf0, o, tok, h);
    }
  } else if constexpr (MODE == M_Y) {
    float* Y = (float*)(qkv + Q_Y);
#pragma unroll
    for (int j = 0; j < NJ; ++j) {
      const int tok = tbase + j * 32 + r;
#pragma unroll
      for (int i = 0; i < 2; ++i)
#pragma unroll
        for (int vq = 0; vq < 4; ++vq) {
          float4 o = {acc[i][j][4 * vq], acc[i][j][4 * vq + 1], acc[i][j][4 * vq + 2], acc[i][j][4 * vq + 3]};
          *(float4*)(Y + (size_t)tok * DM + fbase + i * 32 + 8 * vq + 4 * h) = o;
        }
    }
  } else if constexpr (MODE == M_PROJ) {
    if (fbase < 384) {
      const bool isK = fbase >= 256;
      const float* g = P.a_qk_norm + layer * 128 + (isK ? 64 : 0);
      u16* dst = qkv + (isK ? Q_KA : Q_QA);
      const int ld = isK ? 128 : 256;
      const int c0 = isK ? fbase - 256 : fbase;
      float gv[2][16];
#pragma unroll
      for (int i = 0; i < 2; ++i)
#pragma unroll
        for (int v = 0; v < 16; ++v) gv[i][v] = g[i * 32 + crow(v, h)];
#pragma unroll
      for (int j = 0; j < NJ; ++j) {
        const int tok = tbase + j * 32 + r;
        const int pos = pos_of(tok);
        float ss = 0.f;
#pragma unroll
        for (int i = 0; i < 2; ++i)
#pragma unroll
          for (int v = 0; v < 16; ++v) ss += acc[i][j][v] * acc[i][j][v];
        ss += __shfl_xor(ss, 32);
        const float rs = rsqrtf(ss * (1.f / 64.f) + EPS);
#pragma unroll
        for (int i = 0; i < 2; ++i)
#pragma unroll
          for (int v = 0; v < 16; ++v) acc[i][j][v] *= rs * gv[i][v];
        rope32_blk(acc[0][j], R32 + (size_t)(pos >> 6) * 16, h);
        rope32_blk(acc[1][j], R32 + (size_t)(pos & 63) * 16, h);
        store_rows(dst, ld, c0, acc[0][j], tok, h);
        store_rows(dst, ld, c0 + 32, acc[1][j], tok, h);
      }
    } else if (fbase < 512) {
#pragma unroll
      for (int j = 0; j < NJ; ++j) {
        const int tok = tbase + j * 32 + r;
        store_T(qkv + Q_VTA, fbase - 384, acc[0][j], tok, h);
        store_T(qkv + Q_VTA, fbase - 384 + 32, acc[1][j], tok, h);
      }
    } else if (fbase < 896) {
      const bool isK = fbase >= 768;
      u16* dst = qkv + (isK ? Q_KB : Q_QB);
      const int ld = isK ? 128 : 256;
      const int c0 = isK ? fbase - 768 : fbase - 512;
#pragma unroll
      for (int j = 0; j < NJ; ++j) {
        const int tok = tbase + j * 32 + r;
        const int pos = pos_of(tok);
        rope64_blk(acc[0][j], acc[1][j], R64 + (size_t)pos * 32, h);
        store_rows(dst, ld, c0, acc[0][j], tok, h);
        store_rows(dst, ld, c0 + 32, acc[1][j], tok, h);
      }
    } else if (fbase < 1024) {
#pragma unroll
      for (int j = 0; j < NJ; ++j) {
        const int tok = tbase + j * 32 + r;
        store_T(qkv + Q_VTB, fbase - 896, acc[0][j], tok, h);
        store_T(qkv + Q_VTB, fbase - 896 + 32, acc[1][j], tok, h);
      }
    } else if (fbase < 1664) {
      const bool isKV = fbase >= 1408;
      u16* dst = qkv + (isKV ? Q_CKV : Q_CQ);
      const int ld = isKV ? 256 : 384;
      const int c0 = isKV ? fbase - 1408 : fbase - 1024;
      const int sb = (isKV ? 12 : 0) + (c0 >> 5);
#pragma unroll
      for (int j = 0; j < NJ; ++j) {
        const int tok = tbase + j * 32 + r;
#pragma unroll
        for (int i = 0; i < 2; ++i) {
          float ss = 0.f;
#pragma unroll
          for (int v = 0; v < 16; ++v) ss += acc[i][j][v] * acc[i][j][v];
          ss += __shfl_xor(ss, 32);
          if (h == 0) SS[(size_t)tok * 20 + sb + i] = ss;
          store_rows(dst, ld, c0 + i * 32, acc[i][j], tok, h);
        }
      }
    } else if (fbase < 2176) {
      const bool isK = fbase >= 1920;
      u16* dst = qkv + (isK ? Q_KD : Q_QD);
      const int c0 = isK ? fbase - 1920 : fbase - 1664;
#pragma unroll
      for (int j = 0; j < NJ; ++j) {
        const int tok = tbase + j * 32 + r;
        const int pos = pos_of(tok);
#pragma unroll
        for (int i = 0; i < 2; ++i) {
          rope32_blk(acc[i][j], R32 + (size_t)pos * 16, h);
          store_rows(dst, 256, c0 + i * 32, acc[i][j], tok, h);
        }
      }
    } else if (fbase < 2432) {
#pragma unroll
      for (int j = 0; j < NJ; ++j) {
        const int tok = tbase + j * 32 + r;
        store_T(qkv + Q_VTD, fbase - 2176, acc[0][j], tok, h);
        store_T(qkv + Q_VTD, fbase - 2176 + 32, acc[1][j], tok, h);
      }
    } else if (fbase == 2432) {
#pragma unroll
      for (int j = 0; j < NJ; ++j) {
        const int tok = tbase + j * 32 + r;
        const int pos = pos_of(tok);
        rope32_blk(acc[0][j], R32 + (size_t)pos * 16, h);
#pragma unroll
        for (int hd = 0; hd < 4; ++hd) store_rows(qkv + Q_KC, 384, hd * 96 + 64, acc[0][j], tok, h);
      }
    }
  } else if constexpr (MODE == M_GATE) {
    u16* G = (u16*)(ws + OFF_R2);
#pragma unroll
    for (int j = 0; j < NJ; ++j) {
      const int tok = tbase + j * 32 + r;
#pragma unroll
      for (int i = 0; i < 2; ++i) {
        f32x16 o;
#pragma unroll
        for (int v = 0; v < 16; ++v) o[v] = 1.f / (1.f + __expf(-acc[i][j][v]));
        store_rows(G, 4096, fbase + i * 32, o, tok, h);
      }
    }
  } else if constexpr (MODE == M_CUQ) {
    if (fbase >= 384) return;
#pragma unroll
    for (int j = 0; j < NJ; ++j) {
      const int tok = tbase + j * 32 + r;
      const int pos = pos_of(tok);
      float ss = 0.f;
#pragma unroll
      for (int b = 0; b < 12; ++b) ss += SS[(size_t)tok * 20 + b];
      const float rs = rsqrtf(ss * (1.f / 384.f) + EPS);
#pragma unroll
      for (int i = 0; i < 2; ++i) {
        const int blk = (fbase >> 5) + i;
#pragma unroll
        for (int v = 0; v < 16; ++v) acc[i][j][v] *= rs;
        if (blk % 3 == 2) rope32_blk(acc[i][j], R32 + (size_t)pos * 16, h);
        store_rows(qkv + Q_QC, 384, blk * 32, acc[i][j], tok, h);
      }
    }
  } else if constexpr (MODE == M_CUKV) {
#pragma unroll
    for (int j = 0; j < NJ; ++j) {
      const int tok = tbase + j * 32 + r;
      float ss = 0.f;
#pragma unroll
      for (int b = 0; b < 8; ++b) ss += SS[(size_t)tok * 20 + 12 + b];
      const float rs = rsqrtf(ss * (1.f / 256.f) + EPS);
#pragma unroll
      for (int i = 0; i < 2; ++i) {
        const int blk = (fbase >> 5) + i;
        const int hd = blk >> 2, q = blk & 3;
#pragma unroll
        for (int v = 0; v < 16; ++v) acc[i][j][v] *= rs;
        if (q < 2) store_rows(qkv + Q_KC, 384, hd * 96 + q * 32, acc[i][j], tok, h);
        else store_T(qkv + Q_VTC, hd * 64 + (q - 2) * 32, acc[i][j], tok, h);
      }
    }
  } else if constexpr (MODE == M_MERGE) {
#pragma unroll
    for (int j = 0; j < NJ; ++j) {
      const int tok = tbase + j * 32 + r;
      store_rows(qkv + Q_MERGED, 1024, fbase, acc[0][j], tok, h);
      store_rows(qkv + Q_MERGED, 1024, fbase + 32, acc[1][j], tok, h);
    }
  }
}

template <int MODE, int NJ>
DI void gemm_tile(const u16* __restrict__ Wt, const u16* __restrict__ X, int ldx, int K, int f0, int t0, char* smem,
                  const Params& P, int layer) {
  constexpr int XROWS = NJ * 64;
  u16* sW = (u16*)smem;
  u16* sX = sW + 2 * 256 * LSTR;
  const int tid = opaque_tid(), lane = tid & 63, wave = tid >> 6, r = lane & 31, h = lane >> 5;
  const int wf = wave & 3, wt = wave >> 2;
  f32x16 acc[2][NJ];
  f32x16 tot[2][MODE == M_MERGE ? NJ : 1];
#pragma unroll
  for (int i = 0; i < 2; ++i)
#pragma unroll
    for (int j = 0; j < NJ; ++j)
#pragma unroll
      for (int v = 0; v < 16; ++v) acc[i][j][v] = 0.f;
  if constexpr (MODE == M_MERGE) {
#pragma unroll
    for (int i = 0; i < 2; ++i)
#pragma unroll
      for (int j = 0; j < NJ; ++j)
#pragma unroll
        for (int v = 0; v < 16; ++v) tot[i][j][v] = 0.f;
  }
  const int nk = K >> 6;
  u32x4 wreg[4], xreg[NJ];
  const int crow_ = tid >> 3, ccol = (tid & 7) * 8;
  const u16* wp = Wt + (size_t)(f0 + crow_) * K + ccol;
  const u16* xp = X + (size_t)(t0 + crow_) * ldx + ccol;

  auto gload = [&](int kt) {
#pragma unroll
    for (int i = 0; i < 4; ++i) wreg[i] = gld16(wp + (size_t)(i * 64) * K + kt * 64);
#pragma unroll
    for (int i = 0; i < NJ; ++i) xreg[i] = gld16(xp + (size_t)(i * 64) * ldx + kt * 64);
  };
  auto sstore = [&](int buf) {
    wait_vm0(wreg[0], wreg[1], wreg[2], wreg[3]);
    if constexpr (NJ == 4) wait_vm0(xreg[0], xreg[1], xreg[2], xreg[3]);
    else wait_vm0(xreg[0], xreg[1]);
#pragma unroll
    for (int i = 0; i < 4; ++i) *(u32x4*)(sW + (buf * 256 + i * 64 + crow_) * LSTR + ccol) = wreg[i];
#pragma unroll
    for (int i = 0; i < NJ; ++i) *(u32x4*)(sX + (buf * XROWS + i * 64 + crow_) * LSTR + ccol) = xreg[i];
  };
  const int fbase = f0 + wf * 64, tbase = t0 + wt * (NJ * 32);

  gload(0);
  sstore(0);
  __syncthreads();
  for (int kt = 0; kt < nk; ++kt) {
    const int buf = kt & 1;
    if (kt + 1 < nk) gload(kt + 1);
    const u16* aW = sW + (buf * 256 + wf * 64 + r) * LSTR + h * 8;
    const u16* aX = sX + (buf * XROWS + wt * (NJ * 32) + r) * LSTR + h * 8;
#pragma unroll
    for (int ks = 0; ks < 4; ++ks) {
      bf16x8 wfrag[2], xfrag[NJ];
#pragma unroll
      for (int i = 0; i < 2; ++i) wfrag[i] = *(const bf16x8*)(aW + i * 32 * LSTR + ks * 16);
#pragma unroll
      for (int j = 0; j < NJ; ++j) xfrag[j] = *(const bf16x8*)(aX + j * 32 * LSTR + ks * 16);
#pragma unroll
      for (int i = 0; i < 2; ++i)
#pragma unroll
        for (int j = 0; j < NJ; ++j) acc[i][j] = MFMA32(wfrag[i], xfrag[j], acc[i][j]);
    }
    if constexpr (MODE == M_MERGE) {
      if ((kt & 3) == 3) {
        const int br = kt >> 2;
        const u16* G = (const u16*)(P.ws + OFF_R2);
#pragma unroll
        for (int j = 0; j < NJ; ++j) {
          const int tok = tbase + j * 32 + r;
#pragma unroll
          for (int i = 0; i < 2; ++i)
#pragma unroll
            for (int vq = 0; vq < 4; ++vq) {
              uint2 gp = *(const uint2*)(G + (size_t)tok * 4096 + br * 1024 + fbase + i * 32 + 8 * vq + 4 * h);
              tot[i][j][4 * vq + 0] += bf2f(gp.x & 0xffffu) * acc[i][j][4 * vq + 0];
              tot[i][j][4 * vq + 1] += bf2f(gp.x >> 16) * acc[i][j][4 * vq + 1];
              tot[i][j][4 * vq + 2] += bf2f(gp.y & 0xffffu) * acc[i][j][4 * vq + 2];
              tot[i][j][4 * vq + 3] += bf2f(gp.y >> 16) * acc[i][j][4 * vq + 3];
              acc[i][j][4 * vq + 0] = 0.f; acc[i][j][4 * vq + 1] = 0.f;
              acc[i][j][4 * vq + 2] = 0.f; acc[i][j][4 * vq + 3] = 0.f;
            }
        }
      }
    }
    if (kt + 1 < nk) sstore(buf ^ 1);
    __syncthreads();
  }
  if constexpr (MODE == M_MERGE) gemm_epilogue<MODE, NJ>(tot, fbase, tbase, r, h, P, layer);
  else gemm_epilogue<MODE, NJ>(acc, fbase, tbase, r, h, P, layer);
}

template <int MODE, int NJ>
DI void gemm_phase(const u16* Wt, const u16* X, int ldx, int K, int nF, char* smem, const Params& P, int layer) {
  constexpr int TT = NJ * 64;
  const int nT = T / TT;
  const int ntiles = nF * nT;
  for (int idx = blockIdx.x; idx < ntiles; idx += gridDim.x) {
    const int tt_lo = idx & 15;
    const int rest = idx >> 4;
    const int ft = rest % nF;
    const int tt = (rest / nF) * 16 + tt_lo;
    gemm_tile<MODE, NJ>(Wt, X, ldx, K, ft * 256, tt * TT, smem, P, layer);
  }
}

template <int DQK, int NCOMP, bool BAND, int EPI>
DI void attn_item(const u16* __restrict__ Q, int ldq, const u16* __restrict__ Kp, int ldk, const u16* __restrict__ Vt,
                  int qtok0, int kbeg, int kend, float sc_l2, float sink_l2, float lam, float onorm,
                  const float* __restrict__ subg, u16* __restrict__ O, float* __restrict__ DS, char* smem) {
  constexpr int DC = DQK / NCOMP;
  constexpr int KS = DC / 16;
  constexpr int KEYS = (NCOMP == 1) ? 128 : 64;
  constexpr int KSTR = DQK + 8, VSTR = KEYS + 8;
  constexpr int KCH = DQK / 8, VCH = KEYS / 8;
  constexpr int NKC = KEYS * KCH / NTHR, NVC = 64 * VCH / NTHR;
  constexpr int KSLOT = KEYS * KSTR, VSLOT = 64 * VSTR;
  u16* sK = (u16*)smem;
  u16* sV = sK + 3 * KSLOT;
  const int tid = opaque_tid(), lane = tid & 63, wave = tid >> 6, r = lane & 31, h = lane >> 5;
  const int qtok = qtok0 + wave * 32 + r;

  bf16x8 qf[NCOMP][KS];
#pragma unroll
  for (int c = 0; c < NCOMP; ++c)
#pragma unroll
    for (int ks = 0; ks < KS; ++ks) qf[c][ks] = *(const bf16x8*)(Q + (size_t)qtok * ldq + c * DC + ks * 16 + 8 * h);

  f32x16 Oa[NCOMP][2];
  float m[NCOMP], l[NCOMP];
#pragma unroll
  for (int c = 0; c < NCOMP; ++c) {
#pragma unroll
    for (int d = 0; d < 2; ++d)
#pragma unroll
      for (int v = 0; v < 16; ++v) Oa[c][d][v] = 0.f;
    m[c] = BAND ? sink_l2 : -1e30f;
    l[c] = (BAND && h == 0) ? 1.f : 0.f;
  }

  const u16* kg[NKC]; int kso[NKC];
#pragma unroll
  for (int i = 0; i < NKC; ++i) {
    const int c = tid + i * NTHR;
    const int row = c / KCH, cc = c % KCH;
    kg[i] = Kp + (size_t)(kbeg + row) * ldk + cc * 8;
    kso[i] = row * KSTR + cc * 8;
  }
  const u16* vg[NVC]; int vso[NVC];
#pragma unroll
  for (int i = 0; i < NVC; ++i) {
    const int c = tid + i * NTHR;
    const int row = c / VCH, cc = c % VCH;
    vg[i] = Vt + (size_t)row * T + kbeg + cc * 8;
    vso[i] = row * VSTR + cc * 8;
  }
  u32x4 kreg[NKC], vreg[NVC];
  auto loadK = [&](int t) {
#pragma unroll
    for (int i = 0; i < NKC; ++i) kreg[i] = gld16(kg[i] + (size_t)t * KEYS * ldk);
  };
  auto loadV = [&](int t) {
#pragma unroll
    for (int i = 0; i < NVC; ++i) vreg[i] = gld16(vg[i] + t * KEYS);
  };
  auto waitK = [&]() {
    if constexpr (NKC == 1) wait_vm0(kreg[0]);
    else if constexpr (NKC == 2) wait_vm0(kreg[0], kreg[1]);
    else wait_vm0(kreg[0], kreg[1], kreg[2]);
  };
  auto waitV = [&]() {
    if constexpr (NVC == 1) wait_vm0(vreg[0]);
    else wait_vm0(vreg[0], vreg[1]);
  };
  auto storeK = [&](int slot) {
#pragma unroll
    for (int i = 0; i < NKC; ++i) *(u32x4*)(sK + slot * KSLOT + kso[i]) = kreg[i];
  };
  auto storeV = [&](int slot) {
#pragma unroll
    for (int i = 0; i < NVC; ++i) *(u32x4*)(sV + slot * VSLOT + vso[i]) = vreg[i];
  };

  f32x16 S0[2], S1[2];
  bf16x8 pfA[2][2], pfB[2][2];
  float alpha_pend = 1.f;
  bool need_pend = false;

  auto att_S = [&](auto uu_t, f32x16 (&S)[2], int slot) {
    constexpr int UU = decltype(uu_t)::value;
    constexpr int C = (NCOMP == 2) ? UU : 0;
    const u16* base = sK + slot * KSLOT + ((NCOMP == 1 ? UU * 64 : 0) + r) * KSTR + (NCOMP == 2 ? UU * DC : 0) + 8 * h;
#pragma unroll
    for (int kb = 0; kb < 2; ++kb) {
#pragma unroll
      for (int v = 0; v < 16; ++v) S[kb][v] = 0.f;
#pragma unroll
      for (int ks = 0; ks < KS; ++ks) {
        bf16x8 kf = *(const bf16x8*)(base + kb * 32 * KSTR + ks * 16);
        S[kb] = MFMA32(kf, qf[C][ks], S[kb]);
      }
    }
  };
  auto att_PV = [&](auto uu_t, const bf16x8 (&pf)[2][2], int slot) {
    constexpr int UU = decltype(uu_t)::value;
    constexpr int C = (NCOMP == 2) ? UU : 0;
    const u16* base = sV + slot * VSLOT + r * VSTR + (NCOMP == 1 ? UU * 64 : 0) + 8 * h;
#pragma unroll
    for (int d = 0; d < 2; ++d)
#pragma unroll
      for (int kb = 0; kb < 2; ++kb)
#pragma unroll
        for (int s = 0; s < 2; ++s) {
          bf16x8 vf = *(const bf16x8*)(base + d * 32 * VSTR + kb * 32 + 16 * s);
          Oa[C][d] = MFMA32(vf, pf[kb][s], Oa[C][d]);
        }
  };
  auto att_rescale = [&](auto uu_t) {
    constexpr int UU = decltype(uu_t)::value;
    constexpr int C = (NCOMP == 2) ? UU : 0;
    if (need_pend) {
#pragma unroll
      for (int d = 0; d < 2; ++d)
#pragma unroll
        for (int v = 0; v < 16; ++v) Oa[C][d][v] *= alpha_pend;
    }
  };
  auto att_softmax = [&](auto uu_t, f32x16 (&S)[2], bf16x8 (&pf)[2][2], int kpos0) {
    constexpr int UU = decltype(uu_t)::value;
    constexpr int C = (NCOMP == 2) ? UU : 0;
    if constexpr (BAND) {
#pragma unroll
      for (int kb = 0; kb < 2; ++kb)
#pragma unroll
        for (int v = 0; v < 16; ++v) {
          const int d = kpos0 + kb * 32 + crow(v, h) - qtok;
          if (d > 128 || d < -128) S[kb][v] = -1e30f;
        }
    }
    float mx = S[0][0];
#pragma unroll
    for (int kb = 0; kb < 2; ++kb)
#pragma unroll
      for (int v = 0; v < 16; ++v) mx = fmaxf(mx, S[kb][v]);
    mx = fmaxf(mx, __shfl_xor(mx, 32));
    const float mold = m[C];
    const float mnew = fmaxf(mold, mx * sc_l2);
    need_pend = __builtin_amdgcn_ballot_w64(mnew > mold) != 0;
    alpha_pend = __builtin_amdgcn_exp2f(mold - mnew);
    m[C] = mnew;
    float rsum = 0.f;
#pragma unroll
    for (int kb = 0; kb < 2; ++kb)
#pragma unroll
      for (int v = 0; v < 16; ++v) {
        float p = __builtin_amdgcn_exp2f(__builtin_fmaf(S[kb][v], sc_l2, -mnew));
        S[kb][v] = p;
        rsum += p;
      }
    l[C] = l[C] * alpha_pend + rsum;
#pragma unroll
    for (int kb = 0; kb < 2; ++kb)
#pragma unroll
      for (int s = 0; s < 2; ++s) {
        u32x4 pk;
        pk.x = pk2(S[kb][8 * s + 0], S[kb][8 * s + 1]);
        pk.y = pk2(S[kb][8 * s + 2], S[kb][8 * s + 3]);
        pk.z = pk2(S[kb][8 * s + 4], S[kb][8 * s + 5]);
        pk.w = pk2(S[kb][8 * s + 6], S[kb][8 * s + 7]);
        pf[kb][s] = __builtin_bit_cast(bf16x8, pk);
      }
  };
  using U0 = std::integral_constant<int, 0>;
  using U1 = std::integral_constant<int, 1>;

  const int ntl = (kend - kbeg) / KEYS;
  auto step = [&](auto first_t, auto lk_t, auto lv_t, int t, int sa, int sb, int sc) {
    constexpr bool FIRST = decltype(first_t)::value, LK = decltype(lk_t)::value, LV = decltype(lv_t)::value;
    if constexpr (LK) loadK(t + 2);
    if constexpr (LV) loadV(t + 1);
    if constexpr (!FIRST) att_rescale(U1{});
    att_S(U1{}, S1, sa);
    if constexpr (!FIRST) att_PV(U1{}, pfB, sc);
    att_softmax(U0{}, S0, pfA, kbeg + t * KEYS);
    att_rescale(U0{});
    if constexpr (LV) att_S(U0{}, S0, sb);
    att_PV(U0{}, pfA, sa);
    att_softmax(U1{}, S1, pfB, kbeg + t * KEYS + 64);
    if constexpr (LK) { waitK(); storeK(sc); }
    if constexpr (LV) { waitV(); storeV(sb); }
    __syncthreads();
  };
  using TT = std::true_type;
  using FF = std::false_type;

  loadK(0); loadV(0);
  waitK(); waitV();
  storeK(0); storeV(0);
  loadK(1);
  waitK();
  storeK(1);
  __syncthreads();
  att_S(U0{}, S0, 0);
  int sa = 0, sb = 1, sc = 2;
  step(TT{}, TT{}, TT{}, 0, sa, sb, sc);
  { int tmp = sa; sa = sb; sb = sc; sc = tmp; }
  for (int t = 1; t < ntl - 2; ++t) {
    step(FF{}, TT{}, TT{}, t, sa, sb, sc);
    int tmp = sa; sa = sb; sb = sc; sc = tmp;
  }
  step(FF{}, FF{}, TT{}, ntl - 2, sa, sb, sc);
  { int tmp = sa; sa = sb; sb = sc; sc = tmp; }
  step(FF{}, FF{}, FF{}, ntl - 1, sa, sb, sc);
  att_rescale(U1{});
  att_PV(U1{}, pfB, sa);

  float inv[NCOMP];
#pragma unroll
  for (int c = 0; c < NCOMP; ++c) {
    float lt = l[c] + __shfl_xor(l[c], 32);
    inv[c] = 1.f / lt;
  }
  if constexpr (EPI == 1) {
#pragma unroll
    for (int d = 0; d < 2; ++d)
#pragma unroll
      for (int vq = 0; vq < 4; ++vq) {
        float4 o = {Oa[0][d][4 * vq] * inv[0], Oa[0][d][4 * vq + 1] * inv[0], Oa[0][d][4 * vq + 2] * inv[0], Oa[0][d][4 * vq + 3] * inv[0]};
        *(float4*)(DS + (size_t)qtok * 256 + d * 32 + 8 * vq + 4 * h) = o;
      }
  } else {
    if constexpr (EPI == 2) {
      float ss = 0.f;
#pragma unroll
      for (int d = 0; d < 2; ++d)
#pragma unroll
        for (int vq = 0; vq < 4; ++vq) {
          const float4 o1 = *(const float4*)(DS + (size_t)qtok * 256 + d * 32 + 8 * vq + 4 * h);
          const float a0 = o1.x - lam * Oa[0][d][4 * vq] * inv[0];
          const float a1 = o1.y - lam * Oa[0][d][4 * vq + 1] * inv[0];
          const float a2 = o1.z - lam * Oa[0][d][4 * vq + 2] * inv[0];
          const float a3 = o1.w - lam * Oa[0][d][4 * vq + 3] * inv[0];
          Oa[0][d][4 * vq] = a0; Oa[0][d][4 * vq + 1] = a1; Oa[0][d][4 * vq + 2] = a2; Oa[0][d][4 * vq + 3] = a3;
          ss += a0 * a0 + a1 * a1 + a2 * a2 + a3 * a3;
        }
      ss += __shfl_xor(ss, 32);
      const float rs = rsqrtf(ss * (1.f / 64.f) + EPS) * onorm;
#pragma unroll
      for (int d = 0; d < 2; ++d)
#pragma unroll
        for (int v = 0; v < 16; ++v) Oa[0][d][v] *= rs * subg[d * 32 + crow(v, h)];
    } else {
#pragma unroll
      for (int d = 0; d < 2; ++d)
#pragma unroll
        for (int v = 0; v < 16; ++v) Oa[0][d][v] *= inv[0];
    }
    store_rows(O, 1024, 0, Oa[0][0], qtok, h);
    store_rows(O, 1024, 32, Oa[0][1], qtok, h);
  }
  __syncthreads();
}

DI void attn_phase(const Params& P, int layer, char* smem) {
  char* ws = P.ws;
  u16* qkv = (u16*)(ws + OFF_QKV);
  u16* BR = (u16*)(ws + OFF_XN);
  const float L2E = 1.4426950408889634f;
  const float lambda_init = 0.8f - 0.6f * __expf(-0.3f * (float)layer);
  float lam;
  {
    const float* dl = P.d_lambda + layer * 128;
    float s1 = 0.f, s2 = 0.f;
    for (int i = 0; i < 32; ++i) { s1 += dl[i] * dl[32 + i]; s2 += dl[64 + i] * dl[96 + i]; }
    lam = __expf(s1) - __expf(s2) + lambda_init;
  }
  for (int it = blockIdx.x; it < 2048; it += gridDim.x) {
    const int cls = it >> 8;
    if (cls < 6) {
      const int idx = it & 255;
      const int head = (idx & 7) >> 1;
      const int qb = ((idx >> 3) << 1) + (idx & 1);
      int qtok0, kbeg, kend;
      if (cls < 3) { qtok0 = qb * 256; kbeg = 0; kend = SEQ0; }
      else { const int s = qb >> 3; kbeg = SEQ0 + s * DSEQ; kend = kbeg + DSEQ; qtok0 = kbeg + (qb & 7) * 256; }
      const int typ = cls % 3;
      if (typ == 0) {
        float* DS = (float*)(ws + OFF_DS) + head * 64;
        attn_item<32, 1, false, 1>(qkv + Q_QD + head * 64, 256, qkv + Q_KD + head * 64, 256,
                                   qkv + Q_VTD + (size_t)head * 64 * T, qtok0, kbeg, kend,
                                   0.17677669529663687f * L2E, 0.f, lam, 1.f - lambda_init,
                                   P.d_subln + layer * 64, BR + 768 + head * 64, DS, smem);
        attn_item<32, 1, false, 2>(qkv + Q_QD + head * 64 + 32, 256, qkv + Q_KD + head * 64 + 32, 256,
                                   qkv + Q_VTD + (size_t)head * 64 * T, qtok0, kbeg, kend,
                                   0.17677669529663687f * L2E, 0.f, lam, 1.f - lambda_init,
                                   P.d_subln + layer * 64, BR + 768 + head * 64, DS, smem);
      } else if (typ == 1) {
        attn_item<96, 1, false, 0>(qkv + Q_QC + head * 96, 384, qkv + Q_KC + head * 96, 384,
                                       qkv + Q_VTC + (size_t)head * 64 * T, qtok0, kbeg, kend,
                                       0.10206207261596577f * L2E, 0.f, 0.f, 1.f, nullptr, BR + 512 + head * 64, nullptr, smem);
      } else {
        attn_item<64, 1, false, 0>(qkv + Q_QA + head * 64, 256, qkv + Q_KA + (head >> 1) * 64, 128,
                                       qkv + Q_VTA + (size_t)(head >> 1) * 64 * T, qtok0, kbeg, kend,
                                       0.125f * L2E, 0.f, 0.f, 1.f, nullptr, BR + head * 64, nullptr, smem);
      }
    } else {
      const int idx = it - 1536;
      const int head = (idx & 7) >> 1;
      const int qbg = ((idx >> 3) << 1) + (idx & 1);
      const int qtok0 = qbg * 256;
      int sb, se;
      if (qtok0 < SEQ0) { sb = 0; se = SEQ0; }
      else { sb = SEQ0 + ((qtok0 - SEQ0) / DSEQ) * DSEQ; se = sb + DSEQ; }
      const int kbeg = max(sb, qtok0 - 128), kend = min(se, qtok0 + 256 + 128);
      const float sink = P.b_sink[layer * 4 + head];
      attn_item<64, 1, true, 0>(qkv + Q_QB + head * 64, 256, qkv + Q_KB + (head >> 1) * 64, 128,
                                    qkv + Q_VTB + (size_t)(head >> 1) * 64 * T, qtok0, kbeg, kend,
                                    0.125f * L2E, sink * L2E, 0.f, 1.f, nullptr, BR + 256 + head * 64, nullptr, smem);
    }
  }
}

DI void ew_phase(const Params& P, const float* __restrict__ Y, float coef, const float* __restrict__ gpost,
                 const float* __restrict__ gnext, bool from_inputs) {
  const int tid = opaque_tid();
  const int lane = tid & 63, wave = tid >> 6;
  u16* XN = (u16*)(P.ws + OFF_XN);
  for (int tok = blockIdx.x * 8 + wave; tok < T; tok += gridDim.x * 8) {
    const float* xs = from_inputs ? (tok < SEQ0 ? P.x_prompt + (size_t)tok * DM : P.x_sample + (size_t)(tok - SEQ0) * DM)
                                  : P.out + (size_t)tok * DM;
    float4 x[4];
#pragma unroll
    for (int i = 0; i < 4; ++i) x[i] = *(const float4*)(xs + (i * 64 + lane) * 4);
    if (Y) {
      float4 y[4];
      float ss = 0.f;
#pragma unroll
      for (int i = 0; i < 4; ++i) {
        y[i] = *(const float4*)(Y + (size_t)tok * DM + (i * 64 + lane) * 4);
        ss += y[i].x * y[i].x + y[i].y * y[i].y + y[i].z * y[i].z + y[i].w * y[i].w;
      }
      ss = wave_sum(ss);
      const float rs = rsqrtf(ss * (1.f / 1024.f) + EPS) * coef;
#pragma unroll
      for (int i = 0; i < 4; ++i) {
        float4 g = *(const float4*)(gpost + (i * 64 + lane) * 4);
        x[i].x += y[i].x * rs * g.x; x[i].y += y[i].y * rs * g.y;
        x[i].z += y[i].z * rs * g.z; x[i].w += y[i].w * rs * g.w;
      }
    }
#pragma unroll
    for (int i = 0; i < 4; ++i) *(float4*)(P.out + (size_t)tok * DM + (i * 64 + lane) * 4) = x[i];
    if (gnext) {
      float ss = 0.f;
#pragma unroll
      for (int i = 0; i < 4; ++i) ss += x[i].x * x[i].x + x[i].y * x[i].y + x[i].z * x[i].z + x[i].w * x[i].w;
      ss = wave_sum(ss);
      const float rs = rsqrtf(ss * (1.f / 1024.f) + EPS);
#pragma unroll
      for (int i = 0; i < 4; ++i) {
        float4 g = *(const float4*)(gnext + (i * 64 + lane) * 4);
        uint2 pk;
        pk.x = pk2(x[i].x * rs * g.x, x[i].y * rs * g.y);
        pk.y = pk2(x[i].z * rs * g.z, x[i].w * rs * g.w);
        *(uint2*)(XN + (size_t)tok * DM + (i * 64 + lane) * 4) = pk;
      }
    }
  }
}

DI int colmap(int mode, int n, int nsrc) {
  if (mode == 1) { return ((n >> 5) & 1) * DFF + (n >> 6) * 32 + (n & 31); }
  if (mode == 2) {
    if (n < 1664) return n;
    if (n < 2432) return n + 32;
    if (n < 2464) return n - 2432 + 1664;
    if (n < 2560) return -1;
    return n - 96;
  }
  return n < nsrc ? n : -1;
}
DI void conv_job(u16* __restrict__ dst, const float* __restrict__ src, int Nd, int K, int lds, int mode,
                 const float* __restrict__ kscale) {
  const int total = Nd * (K >> 3);
  const int gthreads = gridDim.x * NTHR;
  for (int idx = blockIdx.x * NTHR + opaque_tid(); idx < total; idx += gthreads) {
    const int n = idx % Nd, k8 = idx / Nd;
    const int col = colmap(mode, n, lds);
    float v[8];
#pragma unroll
    for (int j = 0; j < 8; ++j) {
      float x = 0.f;
      if (col >= 0) {
        x = src[(size_t)(k8 * 8 + j) * lds + col];
        if (kscale) x *= kscale[k8 * 8 + j];
      }
      v[j] = x;
    }
    uint4 pk = {pk2(v[0], v[1]), pk2(v[2], v[3]), pk2(v[4], v[5]), pk2(v[6], v[7])};
    *(uint4*)(dst + (size_t)n * K + k8 * 8) = pk;
  }
}
DI void convert_layer(const Params& P, int l) {
  u16* W = (u16*)(P.ws + OFF_W);
  for (int s = 0; s < 2; ++s) {
    conv_job(W + W_WI + (size_t)s * 5632 * 1024, P.ffn_wi + ((size_t)l * 2 + s) * 1024 * 5632, 5632, 1024, 5632, 1, nullptr);
    conv_job(W + W_WO + (size_t)s * 1024 * 2816, P.ffn_wo + ((size_t)l * 2 + s) * 2816 * 1024, 1024, 2816, 1024, 0, nullptr);
  }
  conv_job(W + W_WIN, P.w_in + (size_t)l * 1024 * NPROJ, 6656, 1024, NPROJ, 2, nullptr);
  conv_job(W + W_WUQ, P.c_w_uq + (size_t)l * 384 * 384, 512, 384, 384, 0, P.c_q_norm + l * 384);
  conv_job(W + W_WUKV, P.c_w_ukv + (size_t)l * 256 * 512, 512, 256, 512, 0, P.c_kv_norm + l * 256);
  conv_job(W + W_WB, P.w_branch + (size_t)l * 1024 * 1024, 1024, 1024, 1024, 0, nullptr);
  conv_job(W + W_WOUT, P.w_out + (size_t)l * 1024 * 1024, 1024, 1024, 1024, 0, nullptr);
}
DI void rope_tables(const Params& P) {
  float2* R64 = (float2*)(P.ws + OFF_R64);
  float2* R32 = (float2*)(P.ws + OFF_R32);
  const int gthreads = gridDim.x * NTHR;
  for (int idx = blockIdx.x * NTHR + opaque_tid(); idx < 16384 * 48; idx += gthreads) {
    int pos, f; double base; float2* dst;
    if (idx < 16384 * 32) { pos = idx >> 5; f = idx & 31; base = 0.7498942093324559; dst = R64 + idx; }
    else { const int i2 = idx - 16384 * 32; pos = i2 >> 4; f = i2 & 15; base = 0.5623413251903491; dst = R32 + i2; }
    double inv = 1.0;
    for (int k = 0; k < f; ++k) inv *= base;
    const float ang = (float)pos * (float)inv;
    double tr = (double)ang * 0.15915494309189535;
    tr -= rint(tr);
    const float tf = (float)tr;
    *dst = make_float2(__builtin_amdgcn_cosf(tf), __builtin_amdgcn_sinf(tf));
  }
}

__global__ void __launch_bounds__(NTHR) mega(Params P) {
  extern __shared__ __attribute__((aligned(16))) char smem[];
  cg::grid_group grid = cg::this_grid();
  int phase = 0;
#define ACTIVE() (phase >= P.phase_lo && phase < P.phase_hi)
#define SEAM() do { ++phase; if (P.coop) grid.sync(); } while (0)
  u16* W = (u16*)(P.ws + OFF_W);
  u16* XN = (u16*)(P.ws + OFF_XN);
  u16* R2 = (u16*)(P.ws + OFF_R2);
  u16* qkv = (u16*)(P.ws + OFF_QKV);
  const float* Y = (const float*)(qkv + Q_Y);

  if (ACTIVE()) {
    rope_tables(P);
    convert_layer(P, 0);
    ew_phase(P, nullptr, 0.f, nullptr, P.norm_g, true);
  }
  SEAM();
  for (int l = 0; l < 4; ++l) {
    const float* g = P.norm_g + (size_t)l * 6 * DM;
    if (ACTIVE()) gemm_phase<M_FFNUP, 4>(W + W_WI, XN, DM, DM, 22, smem, P, l);
    SEAM();
    if (ACTIVE()) gemm_phase<M_Y, 4>(W + W_WO, R2, DFF, DFF, 4, smem, P, l);
    SEAM();
    if (ACTIVE()) ew_phase(P, Y, 0.5f, g + DM, g + 2 * DM, false);
    SEAM();
    if (ACTIVE()) {
      gemm_phase<M_PROJ, 2>(W + W_WIN, XN, DM, DM, 10, smem, P, l);
      gemm_phase<M_GATE, 4>(W + W_WIN + 2560ull * 1024, XN, DM, DM, 16, smem, P, l);
    }
    SEAM();
    if (ACTIVE()) {
      gemm_phase<M_CUQ, 4>(W + W_WUQ, qkv + Q_CQ, 384, 384, 2, smem, P, l);
      gemm_phase<M_CUKV, 4>(W + W_WUKV, qkv + Q_CKV, 256, 256, 2, smem, P, l);
    }
    SEAM();
    if (ACTIVE()) attn_phase(P, l, smem);
    SEAM();
    if (ACTIVE()) gemm_phase<M_MERGE, 2>(W + W_WB, XN, DM, DM, 4, smem, P, l);
    SEAM();
    if (ACTIVE()) gemm_phase<M_Y, 4>(W + W_WOUT, qkv + Q_MERGED, DM, DM, 4, smem, P, l);
    SEAM();
    if (ACTIVE()) ew_phase(P, Y, 1.0f, g + 3 * DM, g + 4 * DM, false);
    SEAM();
    if (ACTIVE()) gemm_phase<M_FFNUP, 4>(W + W_WI + 5632ull * 1024, XN, DM, DM, 22, smem, P, l);
    SEAM();
    if (ACTIVE()) gemm_phase<M_Y, 4>(W + W_WO + 1024ull * 2816, R2, DFF, DFF, 4, smem, P, l);
    SEAM();
    if (ACTIVE()) {
      ew_phase(P, Y, 0.5f, g + 5 * DM, l < 3 ? g + 6 * DM : nullptr, false);
      if (l < 3) convert_layer(P, l + 1);
    }
    SEAM();
  }
}

constexpr int N_PHASES = 1 + 12 * 4;

extern "C" void kernel_launch(void* const* d_in, const int* in_sizes, int n_in, void* d_out, int out_size, void* d_ws,
                              size_t ws_size, hipStream_t stream) {
  static int grid_blocks = 0;
  if (!grid_blocks) {
    int dev = 0, cus = 0, per_cu = 0;
    hipGetDevice(&dev);
    hipDeviceGetAttribute(&cus, hipDeviceAttributeMultiprocessorCount, dev);
    hipFuncSetAttribute((const void*)mega, hipFuncAttributeMaxDynamicSharedMemorySize, SMEM_BYTES);
    hipOccupancyMaxActiveBlocksPerMultiprocessor(&per_cu, mega, NTHR, SMEM_BYTES);
    if (per_cu < 1) per_cu = 1;
    grid_blocks = cus * per_cu;
  }
  if (ws_size < WS_NEEDED) fprintf(stderr, "workspace too small: %zu < %zu\n", ws_size, (size_t)WS_NEEDED);
  Params P{};
  P.x_prompt = (const float*)d_in[0]; P.x_sample = (const float*)d_in[1]; P.norm_g = (const float*)d_in[2];
  P.w_in = (const float*)d_in[3]; P.a_qk_norm = (const float*)d_in[4]; P.b_sink = (const float*)d_in[5];
  P.c_q_norm = (const float*)d_in[6]; P.c_kv_norm = (const float*)d_in[7]; P.c_w_uq = (const float*)d_in[8];
  P.c_w_ukv = (const float*)d_in[9]; P.d_lambda = (const float*)d_in[10]; P.d_subln = (const float*)d_in[11];
  P.w_branch = (const float*)d_in[12]; P.w_out = (const float*)d_in[13]; P.ffn_wi = (const float*)d_in[14];
  P.ffn_wo = (const float*)d_in[15];
  P.out = (float*)d_out; P.ws = (char*)d_ws;
#if MULTI_LAUNCH
  for (int ph = 0; ph < N_PHASES; ++ph) {
    P.phase_lo = ph; P.phase_hi = ph + 1; P.coop = 0; P.pad0 = 0;
    hipLaunchKernelGGL(mega, dim3(grid_blocks), dim3(NTHR), SMEM_BYTES, stream, P);
  }
#else
  P.phase_lo = 0; P.phase_hi = 1 << 30; P.coop = 1; P.pad0 = 0;
  void* args[] = {&P};
  hipError_t e = hipLaunchCooperativeKernel((const void*)mega, dim3(grid_blocks), dim3(NTHR), args, SMEM_BYTES, stream);
  if (e != hipSuccess) fprintf(stderr, "cooperative launch failed: %s (grid %d)\n", hipGetErrorString(e), grid_blocks);
#endif
}
```

```cpp
#include <hip/hip_runtime.h>
#include <hip/hip_cooperative_groups.h>
#include <cstdio>
#include <cstdint>
#include <type_traits>
namespace cg = cooperative_groups;

#ifndef MULTI_LAUNCH
#define MULTI_LAUNCH 0
#endif

#define DI __device__ __forceinline__
typedef unsigned short u16;
typedef __attribute__((ext_vector_type(8))) short bf16x8;
typedef __attribute__((ext_vector_type(16))) float f32x16;
typedef __attribute__((ext_vector_type(2))) float f32x2_t;
typedef __attribute__((ext_vector_type(2))) __bf16 bf16x2_t;

constexpr int T = 32768;
constexpr int DM = 1024;
constexpr int DFF = 2816;
constexpr int KP1 = 1088;
constexpr int KP2 = 2880;
constexpr int GP = 4160;
constexpr int YP = 1040;
constexpr int NPROJ = 6560;
constexpr int SEQ0 = 16384;
constexpr int DSEQ = 2048;
constexpr float EPS = 1e-6f;
constexpr int NTHR = 512;
constexpr int LSTR = 72;
constexpr int SMEM_BYTES = 2 * 2 * 256 * LSTR * 2;

constexpr size_t W_WI = 0;
constexpr size_t W_WO = W_WI + 2ull * 5632 * KP1;
constexpr size_t W_WIN = W_WO + 2ull * 1024 * KP2;
constexpr size_t W_WUQ = W_WIN + 6656ull * KP1;
constexpr size_t W_WUKV = W_WUQ + 512ull * 384;
constexpr size_t W_WB = W_WUKV + 512ull * 256;
constexpr size_t W_WOUT = W_WB + 1024ull * KP1;
constexpr size_t W_TOTAL = W_WOUT + 1024ull * KP1;

constexpr size_t OFF_W = 0;
constexpr size_t OFF_XN = OFF_W + W_TOTAL * 2;
constexpr size_t OFF_R2 = OFF_XN + (size_t)T * KP1 * 2;
constexpr size_t OFF_QKV = OFF_R2 + (size_t)T * GP * 2;
constexpr size_t OFF_SS = OFF_QKV + (size_t)T * 3456 * 2;
constexpr size_t OFF_R64 = OFF_SS + (size_t)T * 20 * 4;
constexpr size_t OFF_R32 = OFF_R64 + 16384ull * 32 * 8;
constexpr size_t OFF_DS = OFF_R32 + 16384ull * 16 * 8;
constexpr size_t WS_NEEDED = OFF_DS + (size_t)T * 256 * 4;

constexpr size_t Q_QA = 0;
constexpr size_t Q_KA = (size_t)T * 256;
constexpr size_t Q_VTA = (size_t)T * 384;
constexpr size_t Q_QB = (size_t)T * 512;
constexpr size_t Q_KB = (size_t)T * 768;
constexpr size_t Q_VTB = (size_t)T * 896;
constexpr size_t Q_CQ = (size_t)T * 1024;
constexpr size_t Q_CKV = (size_t)T * 1408;
constexpr size_t Q_QC = (size_t)T * 1664;
constexpr size_t Q_KC = (size_t)T * 2048;
constexpr size_t Q_VTC = (size_t)T * 2432;
constexpr size_t Q_QD = (size_t)T * 2688;
constexpr size_t Q_KD = (size_t)T * 2944;
constexpr size_t Q_VTD = (size_t)T * 3200;
constexpr size_t Q_MERGED = 0;
constexpr size_t Q_Y = (size_t)T * KP1;

struct Params {
  const float* x_prompt; const float* x_sample; const float* norm_g; const float* w_in;
  const float* a_qk_norm; const float* b_sink; const float* c_q_norm; const float* c_kv_norm;
  const float* c_w_uq; const float* c_w_ukv; const float* d_lambda; const float* d_subln;
  const float* w_branch; const float* w_out; const float* ffn_wi; const float* ffn_wo;
  float* out; char* ws;
  int phase_lo; int phase_hi; int coop; int pad0;
};

DI unsigned pk2(float a, float b) {
  f32x2_t v = {a, b};
  bf16x2_t r = __builtin_convertvector(v, bf16x2_t);
  return __builtin_bit_cast(unsigned, r);
}
DI u16 f2bf(float a) { return (u16)(pk2(a, 0.f) & 0xffffu); }
DI float bf2f(unsigned bits16) { return __uint_as_float(bits16 << 16); }
DI int crow(int v, int h) { return (v & 3) + 8 * (v >> 2) + 4 * h; }
DI int pos_of(int tok) { return tok < SEQ0 ? tok : ((tok - SEQ0) & (DSEQ - 1)); }
#define MFMA32(a, b, c) __builtin_amdgcn_mfma_f32_32x32x16_bf16((a), (b), (c), 0, 0, 0)

typedef __attribute__((ext_vector_type(4))) unsigned u32x4;
DI u32x4 gld16(const void* p) { u32x4 r; asm volatile("global_load_dwordx4 %0, %1, off" : "=v"(r) : "v"(p)); return r; }
DI void wait_vm0(u32x4& a) { asm volatile("s_waitcnt vmcnt(0)" : "+v"(a) :: "memory"); }
DI void wait_vm0(u32x4& a, u32x4& b) { asm volatile("s_waitcnt vmcnt(0)" : "+v"(a), "+v"(b) :: "memory"); }
DI void wait_vm0(u32x4& a, u32x4& b, u32x4& c) { asm volatile("s_waitcnt vmcnt(0)" : "+v"(a), "+v"(b), "+v"(c) :: "memory"); }
DI void wait_vm0(u32x4& a, u32x4& b, u32x4& c, u32x4& d) { asm volatile("s_waitcnt vmcnt(0)" : "+v"(a), "+v"(b), "+v"(c), "+v"(d) :: "memory"); }
DI u32x4 gld16s(unsigned voff, const void* sbase) { u32x4 r; asm volatile("global_load_dwordx4 %0, %1, %2" : "=v"(r) : "v"(voff), "s"(sbase)); return r; }
#define DEF_WAIT8(name, cnt) DI void name(u32x4& a, u32x4& b, u32x4& c, u32x4& d, u32x4& e, u32x4& f, u32x4& g, u32x4& h) { asm volatile("s_waitcnt vmcnt(" #cnt ")" : "+v"(a), "+v"(b), "+v"(c), "+v"(d), "+v"(e), "+v"(f), "+v"(g), "+v"(h) :: "memory"); }
#define DEF_WAIT6(name, cnt) DI void name(u32x4& a, u32x4& b, u32x4& c, u32x4& d, u32x4& e, u32x4& f) { asm volatile("s_waitcnt vmcnt(" #cnt ")" : "+v"(a), "+v"(b), "+v"(c), "+v"(d), "+v"(e), "+v"(f) :: "memory"); }
DEF_WAIT8(wait8_vm8, 8)
DEF_WAIT8(wait8_vm0, 0)
DEF_WAIT6(wait6_vm6, 6)
DEF_WAIT6(wait6_vm0, 0)
DI int opaque_tid() { int t = threadIdx.x; asm volatile("" : "+v"(t)); return t; }
DI float wave_sum(float v) {
#pragma unroll
  for (int m = 32; m >= 1; m >>= 1) v += __shfl_xor(v, m);
  return v;
}

DI void rope32_blk(f32x16& a, const float2* __restrict__ tab, int h) {
#pragma unroll
  for (int v = 0; v < 8; ++v) {
    float2 cs = tab[crow(v, h)];
    float x1 = a[v], x2 = a[v + 8];
    a[v] = x1 * cs.x - x2 * cs.y;
    a[v + 8] = x2 * cs.x + x1 * cs.y;
  }
}
DI void rope64_blk(f32x16& a0, f32x16& a1, const float2* __restrict__ tab, int h) {
#pragma unroll
  for (int v = 0; v < 16; ++v) {
    float2 cs = tab[crow(v, h)];
    float x1 = a0[v], x2 = a1[v];
    a0[v] = x1 * cs.x - x2 * cs.y;
    a1[v] = x2 * cs.x + x1 * cs.y;
  }
}
DI void store_rows(u16* __restrict__ base, int ld, int col0, const f32x16& a, int tok, int h) {
#pragma unroll
  for (int vq = 0; vq < 4; ++vq) {
    uint2 pk;
    pk.x = pk2(a[4 * vq], a[4 * vq + 1]);
    pk.y = pk2(a[4 * vq + 2], a[4 * vq + 3]);
    *(uint2*)(base + (size_t)tok * ld + col0 + 8 * vq + 4 * h) = pk;
  }
}
DI void store_T(u16* __restrict__ base, int row0, const f32x16& a, int tok, int h) {
  const int tp = (tok & ~12) | ((tok & 4) << 1) | ((tok & 8) >> 1);
#pragma unroll
  for (int v = 0; v < 16; ++v) base[(size_t)((row0 + crow(v, h)) >> 6) * 64 * T + (size_t)(tp >> 7) * 8192 + ((row0 + crow(v, h)) & 63) * 128 + (tp & 127)] = f2bf(a[v]);
}

enum { M_FFNUP = 0, M_Y = 1, M_PROJ = 2, M_CUQ = 3, M_CUKV = 4, M_MERGE = 5, M_GATE = 6 };

template <int MODE, int NJ>
DI void gemm_epilogue(f32x16 (&acc)[2][NJ], int fbase, int tbase, int r, int h, const Params& P, int layer) {
  char* ws = P.ws;
  u16* qkv = (u16*)(ws + OFF_QKV);
  const float2* R64 = (const float2*)(ws + OFF_R64);
  const float2* R32 = (const float2*)(ws + OFF_R32);
  float* SS = (float*)(ws + OFF_SS);
  if constexpr (MODE == M_FFNUP) {
    u16* H = (u16*)(ws + OFF_R2);
    const int hf0 = (fbase >> 6) * 32;
#pragma unroll
    for (int j = 0; j < NJ; ++j) {
      const int tok = tbase + j * 32 + r;
      f32x16 o;
#pragma unroll
      for (int v = 0; v < 16; ++v) {
        float g = acc[0][j][v], u = acc[1][j][v];
        o[v] = g * __builtin_amdgcn_rcpf(1.f + __builtin_amdgcn_exp2f(-1.4426950408889634f * g)) * u;
      }
      store_rows(H, KP2, hf0, o, tok, h);
    }
  } else if constexpr (MODE == M_Y) {
    float* Y = (float*)(qkv + Q_Y);
#pragma unroll
    for (int j = 0; j < NJ; ++j) {
      const int tok = tbase + j * 32 + r;
#pragma unroll
      for (int i = 0; i < 2; ++i)
#pragma unroll
        for (int vq = 0; vq < 4; ++vq) {
          float4 o = {acc[i][j][4 * vq], acc[i][j][4 * vq + 1], acc[i][j][4 * vq + 2], acc[i][j][4 * vq + 3]};
          *(float4*)(Y + (size_t)tok * YP + fbase + i * 32 + 8 * vq + 4 * h) = o;
        }
    }
  } else if constexpr (MODE == M_PROJ) {
    if (fbase < 384) {
      const bool isK = fbase >= 256;
      const float* g = P.a_qk_norm + layer * 128 + (isK ? 64 : 0);
      u16* dst = qkv + (isK ? Q_KA : Q_QA);
      const int ld = isK ? 128 : 256;
      const int c0 = isK ? fbase - 256 : fbase;
      float gv[2][16];
#pragma unroll
      for (int i = 0; i < 2; ++i)
#pragma unroll
        for (int v = 0; v < 16; ++v) gv[i][v] = g[i * 32 + crow(v, h)];
#pragma unroll
      for (int j = 0; j < NJ; ++j) {
        const int tok = tbase + j * 32 + r;
        const int pos = pos_of(tok);
        float ss = 0.f;
#pragma unroll
        for (int i = 0; i < 2; ++i)
#pragma unroll
          for (int v = 0; v < 16; ++v) ss += acc[i][j][v] * acc[i][j][v];
        ss += __shfl_xor(ss, 32);
        const float rs = rsqrtf(ss * (1.f / 64.f) + EPS);
#pragma unroll
        for (int i = 0; i < 2; ++i)
#pragma unroll
          for (int v = 0; v < 16; ++v) acc[i][j][v] *= rs * gv[i][v];
        rope32_blk(acc[0][j], R32 + (size_t)(pos >> 6) * 16, h);
        rope32_blk(acc[1][j], R32 + (size_t)(pos & 63) * 16, h);
        store_rows(dst, ld, c0, acc[0][j], tok, h);
        store_rows(dst, ld, c0 + 32, acc[1][j], tok, h);
      }
    } else if (fbase < 512) {
#pragma unroll
      for (int j = 0; j < NJ; ++j) {
        const int tok = tbase + j * 32 + r;
        store_T(qkv + Q_VTA, fbase - 384, acc[0][j], tok, h);
        store_T(qkv + Q_VTA, fbase - 384 + 32, acc[1][j], tok, h);
      }
    } else if (fbase < 896) {
      const bool isK = fbase >= 768;
      u16* dst = qkv + (isK ? Q_KB : Q_QB);
      const int ld = isK ? 128 : 256;
      const int c0 = isK ? fbase - 768 : fbase - 512;
#pragma unroll
      for (int j = 0; j < NJ; ++j) {
        const int tok = tbase + j * 32 + r;
        const int pos = pos_of(tok);
        rope64_blk(acc[0][j], acc[1][j], R64 + (size_t)pos * 32, h);
        store_rows(dst, ld, c0, acc[0][j], tok, h);
        store_rows(dst, ld, c0 + 32, acc[1][j], tok, h);
      }
    } else if (fbase < 1024) {
#pragma unroll
      for (int j = 0; j < NJ; ++j) {
        const int tok = tbase + j * 32 + r;
        store_T(qkv + Q_VTB, fbase - 896, acc[0][j], tok, h);
        store_T(qkv + Q_VTB, fbase - 896 + 32, acc[1][j], tok, h);
      }
    } else if (fbase < 1664) {
      const bool isKV = fbase >= 1408;
      u16* dst = qkv + (isKV ? Q_CKV : Q_CQ);
      const int ld = isKV ? 256 : 384;
      const int c0 = isKV ? fbase - 1408 : fbase - 1024;
      const int sb = (isKV ? 12 : 0) + (c0 >> 5);
#pragma unroll
      for (int j = 0; j < NJ; ++j) {
        const int tok = tbase + j * 32 + r;
#pragma unroll
        for (int i = 0; i < 2; ++i) {
          float ss = 0.f;
#pragma unroll
          for (int v = 0; v < 16; ++v) ss += acc[i][j][v] * acc[i][j][v];
          ss += __shfl_xor(ss, 32);
          if (h == 0) SS[(size_t)tok * 20 + sb + i] = ss;
          store_rows(dst, ld, c0 + i * 32, acc[i][j], tok, h);
        }
      }
    } else if (fbase < 2176) {
      const bool isK = fbase >= 1920;
      u16* dst = qkv + (isK ? Q_KD : Q_QD);
      const int c0 = isK ? fbase - 1920 : fbase - 1664;
#pragma unroll
      for (int j = 0; j < NJ; ++j) {
        const int tok = tbase + j * 32 + r;
        const int pos = pos_of(tok);
#pragma unroll
        for (int i = 0; i < 2; ++i) {
          rope32_blk(acc[i][j], R32 + (size_t)pos * 16, h);
          store_rows(dst, 256, c0 + i * 32, acc[i][j], tok, h);
        }
      }
    } else if (fbase < 2432) {
#pragma unroll
      for (int j = 0; j < NJ; ++j) {
        const int tok = tbase + j * 32 + r;
        store_T(qkv + Q_VTD, fbase - 2176, acc[0][j], tok, h);
        store_T(qkv + Q_VTD, fbase - 2176 + 32, acc[1][j], tok, h);
      }
    } else if (fbase == 2432) {
#pragma unroll
      for (int j = 0; j < NJ; ++j) {
        const int tok = tbase + j * 32 + r;
        const int pos = pos_of(tok);
        rope32_blk(acc[0][j], R32 + (size_t)pos * 16, h);
#pragma unroll
        for (int hd = 0; hd < 4; ++hd) store_rows(qkv + Q_KC, 384, hd * 96 + 64, acc[0][j], tok, h);
      }
    }
  } else if constexpr (MODE == M_GATE) {
    u16* G = (u16*)(ws + OFF_R2);
#pragma unroll
    for (int j = 0; j < NJ; ++j) {
      const int tok = tbase + j * 32 + r;
#pragma unroll
      for (int i = 0; i < 2; ++i) {
        f32x16 o;
#pragma unroll
        for (int v = 0; v < 16; ++v) o[v] = __builtin_amdgcn_rcpf(1.f + __builtin_amdgcn_exp2f(-1.4426950408889634f * acc[i][j][v]));
        store_rows(G, GP, fbase + i * 32, o, tok, h);
      }
    }
  } else if constexpr (MODE == M_CUQ) {
    if (fbase >= 384) return;
#pragma unroll
    for (int j = 0; j < NJ; ++j) {
      const int tok = tbase + j * 32 + r;
      const int pos = pos_of(tok);
      float ss = 0.f;
#pragma unroll
      for (int b = 0; b < 12; ++b) ss += SS[(size_t)tok * 20 + b];
      const float rs = rsqrtf(ss * (1.f / 384.f) + EPS);
#pragma unroll
      for (int i = 0; i < 2; ++i) {
        const int blk = (fbase >> 5) + i;
#pragma unroll
        for (int v = 0; v < 16; ++v) acc[i][j][v] *= rs;
        if (blk % 3 == 2) rope32_blk(acc[i][j], R32 + (size_t)pos * 16, h);
        store_rows(qkv + Q_QC, 384, blk * 32, acc[i][j], tok, h);
      }
    }
  } else if constexpr (MODE == M_CUKV) {
#pragma unroll
    for (int j = 0; j < NJ; ++j) {
      const int tok = tbase + j * 32 + r;
      float ss = 0.f;
#pragma unroll
      for (int b = 0; b < 8; ++b) ss += SS[(size_t)tok * 20 + 12 + b];
      const float rs = rsqrtf(ss * (1.f / 256.f) + EPS);
#pragma unroll
      for (int i = 0; i < 2; ++i) {
        const int blk = (fbase >> 5) + i;
        const int hd = blk >> 2, q = blk & 3;
#pragma unroll
        for (int v = 0; v < 16; ++v) acc[i][j][v] *= rs;
        if (q < 2) store_rows(qkv + Q_KC, 384, hd * 96 + q * 32, acc[i][j], tok, h);
        else store_T(qkv + Q_VTC, hd * 64 + (q - 2) * 32, acc[i][j], tok, h);
      }
    }
  } else if constexpr (MODE == M_MERGE) {
#pragma unroll
    for (int j = 0; j < NJ; ++j) {
      const int tok = tbase + j * 32 + r;
      store_rows(qkv + Q_MERGED, KP1, fbase, acc[0][j], tok, h);
      store_rows(qkv + Q_MERGED, KP1, fbase + 32, acc[1][j], tok, h);
    }
  }
}

template <int MODE, int NJ>
DI void gemm_tile(const u16* __restrict__ Wt, int ldw, const u16* __restrict__ X, int ldx, int K, int f0, int t0, char* smem,
                  const Params& P, int layer) {
  constexpr int XROWS = NJ * 64;
  u16* sW = (u16*)smem;
  u16* sX = sW + 2 * 256 * LSTR;
  const int tid = opaque_tid(), lane = tid & 63, wave = tid >> 6, r = lane & 31, h = lane >> 5;
  const int wf = wave & 3, wt = wave >> 2;
  f32x16 acc[2][NJ];
  f32x16 tot[2][MODE == M_MERGE ? NJ : 1];
#pragma unroll
  for (int i = 0; i < 2; ++i)
#pragma unroll
    for (int j = 0; j < NJ; ++j)
#pragma unroll
      for (int v = 0; v < 16; ++v) acc[i][j][v] = 0.f;
  if constexpr (MODE == M_MERGE) {
#pragma unroll
    for (int i = 0; i < 2; ++i)
#pragma unroll
      for (int j = 0; j < NJ; ++j)
#pragma unroll
        for (int v = 0; v < 16; ++v) tot[i][j][v] = 0.f;
  }
  const int nk = K >> 6;
  u32x4 wA[4], xA[NJ], wB[4], xB[NJ];
  const int crow_ = tid >> 3, ccol = (tid & 7) * 8;
  const unsigned voffW = (unsigned)(crow_ * ldw + ccol) * 2u, voffX = (unsigned)(crow_ * ldx + ccol) * 2u;
  const char* wbase = (const char*)(Wt + (size_t)f0 * ldw);
  const char* xbase = (const char*)(X + (size_t)t0 * ldx);
  const int fbase = f0 + wf * 64, tbase = t0 + wt * (NJ * 32);
  const int ldsW = crow_ * LSTR + ccol;

#define GEMM_GLOAD(WR, XR, kt_)                                                                                          \
  do {                                                                                                                   \
    _Pragma("unroll") for (int i = 0; i < 4; ++i) WR[i] = gld16s(voffW, wbase + ((size_t)(i * 64) * ldw + (kt_) * 64) * 2);  \
    _Pragma("unroll") for (int i = 0; i < NJ; ++i) XR[i] = gld16s(voffX, xbase + ((size_t)(i * 64) * ldx + (kt_) * 64) * 2); \
  } while (0)
#define GEMM_SSTORE(WR, XR, buf_, more_)                                                                                 \
  do {                                                                                                                   \
    if constexpr (NJ == 4) {                                                                                             \
      if constexpr (more_) wait8_vm8(WR[0], WR[1], WR[2], WR[3], XR[0], XR[1], XR[2], XR[3]);                            \
      else wait8_vm0(WR[0], WR[1], WR[2], WR[3], XR[0], XR[1], XR[2], XR[3]);                                            \
    } else {                                                                                                             \
      if constexpr (more_) wait6_vm6(WR[0], WR[1], WR[2], WR[3], XR[0], XR[1]);                                          \
      else wait6_vm0(WR[0], WR[1], WR[2], WR[3], XR[0], XR[1]);                                                          \
    }                                                                                                                    \
    _Pragma("unroll") for (int i = 0; i < 4; ++i) *(u32x4*)(sW + ((buf_) * 256 + i * 64) * LSTR + ldsW) = WR[i];         \
    _Pragma("unroll") for (int i = 0; i < NJ; ++i) *(u32x4*)(sX + ((buf_) * XROWS + i * 64) * LSTR + ldsW) = XR[i];      \
  } while (0)

  auto compute = [&](int buf, int kt) {
    const u16* aW = sW + (buf * 256 + wf * 64 + r) * LSTR + h * 8;
    const u16* aX = sX + (buf * XROWS + wt * (NJ * 32) + r) * LSTR + h * 8;
#pragma unroll
    for (int ks = 0; ks < 4; ++ks) {
      bf16x8 wfrag[2], xfrag[NJ];
#pragma unroll
      for (int i = 0; i < 2; ++i) wfrag[i] = *(const bf16x8*)(aW + i * 32 * LSTR + ks * 16);
#pragma unroll
      for (int j = 0; j < NJ; ++j) xfrag[j] = *(const bf16x8*)(aX + j * 32 * LSTR + ks * 16);
#pragma unroll
      for (int i = 0; i < 2; ++i)
#pragma unroll
        for (int j = 0; j < NJ; ++j) acc[i][j] = MFMA32(wfrag[i], xfrag[j], acc[i][j]);
    }
    if constexpr (MODE == M_MERGE) {
      if ((kt & 3) == 3) {
        const int br = kt >> 2;
        const u16* G = (const u16*)(P.ws + OFF_R2);
#pragma unroll
        for (int j = 0; j < NJ; ++j) {
          const int tok = tbase + j * 32 + r;
#pragma unroll
          for (int i = 0; i < 2; ++i)
#pragma unroll
            for (int vq = 0; vq < 4; ++vq) {
              uint2 gp = *(const uint2*)(G + (size_t)tok * GP + br * 1024 + fbase + i * 32 + 8 * vq + 4 * h);
              tot[i][j][4 * vq + 0] += bf2f(gp.x & 0xffffu) * acc[i][j][4 * vq + 0];
              tot[i][j][4 * vq + 1] += bf2f(gp.x >> 16) * acc[i][j][4 * vq + 1];
              tot[i][j][4 * vq + 2] += bf2f(gp.y & 0xffffu) * acc[i][j][4 * vq + 2];
              tot[i][j][4 * vq + 3] += bf2f(gp.y >> 16) * acc[i][j][4 * vq + 3];
              acc[i][j][4 * vq + 0] = 0.f; acc[i][j][4 * vq + 1] = 0.f;
              acc[i][j][4 * vq + 2] = 0.f; acc[i][j][4 * vq + 3] = 0.f;
            }
        }
      }
    }
  };

  GEMM_GLOAD(wA, xA, 0);
  GEMM_GLOAD(wB, xB, 1);
  GEMM_SSTORE(wA, xA, 0, true);
  __syncthreads();
  for (int kt = 0; kt < nk - 2; kt += 2) {
    GEMM_GLOAD(wA, xA, kt + 2);
    compute(0, kt);
    GEMM_SSTORE(wB, xB, 1, true);
    __syncthreads();
    GEMM_GLOAD(wB, xB, kt + 3);
    compute(1, kt + 1);
    GEMM_SSTORE(wA, xA, 0, true);
    __syncthreads();
  }
  compute(0, nk - 2);
  GEMM_SSTORE(wB, xB, 1, false);
  __syncthreads();
  compute(1, nk - 1);
  __syncthreads();
  if constexpr (MODE == M_MERGE) gemm_epilogue<MODE, NJ>(tot, fbase, tbase, r, h, P, layer);
  else gemm_epilogue<MODE, NJ>(acc, fbase, tbase, r, h, P, layer);
}

template <int MODE, int NJ>
DI void gemm_phase(const u16* Wt, int ldw, const u16* X, int ldx, int K, int nF, char* smem, const Params& P, int layer) {
  constexpr int TT = NJ * 64;
  const int nT = T / TT;
  const int ntiles = nF * nT;
  for (int idx = blockIdx.x; idx < ntiles; idx += gridDim.x) {
    const int tt_lo = idx & 15;
    const int rest = idx >> 4;
    const int ft = rest % nF;
    const int tt = (rest / nF) * 16 + tt_lo;
    gemm_tile<MODE, NJ>(Wt, ldw, X, ldx, K, ft * 256, tt * TT, smem, P, layer);
  }
}

template <int DQK, int NCOMP, bool BAND, int EPI>
DI void attn_item(const u16* __restrict__ Q, int ldq, const u16* __restrict__ Kp, int ldk, const u16* __restrict__ Vt,
                  int qtok0, int kbeg, int kend, float sc_l2, float sink_l2, float lam, float onorm,
                  const float* __restrict__ subg, u16* __restrict__ O, float* __restrict__ DS, char* smem) {
  constexpr int DC = DQK / NCOMP;
  constexpr int KS = DC / 16;
  constexpr int KEYS = (NCOMP == 1) ? 128 : 64;
  constexpr int KSTR = DQK + 8, VSTR = KEYS + 8;
  constexpr int KCH = DQK / 8, VCH = KEYS / 8;
  constexpr int NKC = KEYS * KCH / NTHR, NVC = 64 * VCH / NTHR;
  constexpr int KSLOT = KEYS * KSTR, VSLOT = 64 * VSTR;
  u16* sK = (u16*)smem;
  u16* sV = sK + 3 * KSLOT;
  const int tid = opaque_tid(), lane = tid & 63, wave = tid >> 6, r = lane & 31, h = lane >> 5;
  const int qtok = qtok0 + wave * 32 + r;

  bf16x8 qf[NCOMP][KS];
#pragma unroll
  for (int c = 0; c < NCOMP; ++c)
#pragma unroll
    for (int ks = 0; ks < KS; ++ks) qf[c][ks] = *(const bf16x8*)(Q + (size_t)qtok * ldq + c * DC + ks * 16 + 8 * h);

  f32x16 Oa[NCOMP][2];
  float m[NCOMP], l[NCOMP];
#pragma unroll
  for (int c = 0; c < NCOMP; ++c) {
#pragma unroll
    for (int d = 0; d < 2; ++d)
#pragma unroll
      for (int v = 0; v < 16; ++v) Oa[c][d][v] = 0.f;
    m[c] = BAND ? sink_l2 : -1e30f;
    l[c] = (BAND && h == 0) ? 1.f : 0.f;
  }

  const u16* kg[NKC]; int kso[NKC];
#pragma unroll
  for (int i = 0; i < NKC; ++i) {
    const int c = tid + i * NTHR;
    const int row = c / KCH, cc = c % KCH;
    kg[i] = Kp + (size_t)(kbeg + row) * ldk + cc * 8;
    kso[i] = row * KSTR + cc * 8;
  }
  const u16* vg[NVC]; int vso[NVC];
#pragma unroll
  for (int i = 0; i < NVC; ++i) {
    const int c = tid + i * NTHR;
    const int row = c / VCH, cc = c % VCH;
    vg[i] = Vt + (size_t)(kbeg >> 7) * 8192 + row * 128 + cc * 8;
    vso[i] = row * VSTR + cc * 8;
  }
  u32x4 kreg[NKC], vreg[NVC];
  auto loadK = [&](int t) {
#pragma unroll
    for (int i = 0; i < NKC; ++i) kreg[i] = gld16(kg[i] + (size_t)t * KEYS * ldk);
  };
  auto loadV = [&](int t) {
#pragma unroll
    for (int i = 0; i < NVC; ++i) vreg[i] = gld16(vg[i] + (size_t)t * 8192);
  };
  auto waitK = [&]() {
    if constexpr (NKC == 1) wait_vm0(kreg[0]);
    else if constexpr (NKC == 2) wait_vm0(kreg[0], kreg[1]);
    else wait_vm0(kreg[0], kreg[1], kreg[2]);
  };
  auto waitV = [&]() {
    if constexpr (NVC == 1) wait_vm0(vreg[0]);
    else wait_vm0(vreg[0], vreg[1]);
  };
  auto storeK = [&](int slot) {
#pragma unroll
    for (int i = 0; i < NKC; ++i) *(u32x4*)(sK + slot * KSLOT + kso[i]) = kreg[i];
  };
  auto storeV = [&](int slot) {
#pragma unroll
    for (int i = 0; i < NVC; ++i) *(u32x4*)(sV + slot * VSLOT + vso[i]) = vreg[i];
  };

  f32x16 S0[2], S1[2];
  bf16x8 pfA[2][2], pfB[2][2];
  float alpha_pend = 1.f;
  bool need_pend = false;

  auto att_S = [&](auto uu_t, f32x16 (&S)[2], int slot) {
    constexpr int UU = decltype(uu_t)::value;
    constexpr int C = (NCOMP == 2) ? UU : 0;
    const u16* base = sK + slot * KSLOT + ((NCOMP == 1 ? UU * 64 : 0) + r) * KSTR + (NCOMP == 2 ? UU * DC : 0) + 8 * h;
#pragma unroll
    for (int kb = 0; kb < 2; ++kb) {
#pragma unroll
      for (int v = 0; v < 16; ++v) S[kb][v] = 0.f;
#pragma unroll
      for (int ks = 0; ks < KS; ++ks) {
        bf16x8 kf = *(const bf16x8*)(base + kb * 32 * KSTR + ks * 16);
        S[kb] = MFMA32(kf, qf[C][ks], S[kb]);
      }
    }
  };
  auto att_PV = [&](auto uu_t, const bf16x8 (&pf)[2][2], int slot) {
    constexpr int UU = decltype(uu_t)::value;
    constexpr int C = (NCOMP == 2) ? UU : 0;
    const u16* base = sV + slot * VSLOT + r * VSTR + (NCOMP == 1 ? UU * 64 : 0) + 8 * h;
#pragma unroll
    for (int d = 0; d < 2; ++d)
#pragma unroll
      for (int kb = 0; kb < 2; ++kb)
#pragma unroll
        for (int s = 0; s < 2; ++s) {
          bf16x8 vf = *(const bf16x8*)(base + d * 32 * VSTR + kb * 32 + 16 * s);
          Oa[C][d] = MFMA32(vf, pf[kb][s], Oa[C][d]);
        }
  };
  auto att_rescale = [&](auto uu_t) {
    constexpr int UU = decltype(uu_t)::value;
    constexpr int C = (NCOMP == 2) ? UU : 0;
    if (need_pend) {
#pragma unroll
      for (int d = 0; d < 2; ++d)
#pragma unroll
        for (int v = 0; v < 16; ++v) Oa[C][d][v] *= alpha_pend;
    }
  };
  auto att_softmax = [&](auto uu_t, f32x16 (&S)[2], bf16x8 (&pf)[2][2], int kpos0) {
    constexpr int UU = decltype(uu_t)::value;
    constexpr int C = (NCOMP == 2) ? UU : 0;
    if constexpr (BAND) {
#pragma unroll
      for (int kb = 0; kb < 2; ++kb)
#pragma unroll
        for (int v = 0; v < 16; ++v) {
          const int d = kpos0 + kb * 32 + crow(v, h) - qtok;
          if (d > 128 || d < -128) S[kb][v] = -1e30f;
        }
    }
    float mx = S[0][0];
#pragma unroll
    for (int kb = 0; kb < 2; ++kb)
#pragma unroll
      for (int v = 0; v < 16; ++v) mx = fmaxf(mx, S[kb][v]);
    mx = fmaxf(mx, __shfl_xor(mx, 32));
    const float mold = m[C];
    const float mnew = fmaxf(mold, mx * sc_l2);
    need_pend = __builtin_amdgcn_ballot_w64(mnew > mold) != 0;
    alpha_pend = __builtin_amdgcn_exp2f(mold - mnew);
    m[C] = mnew;
    float rsum = 0.f;
#pragma unroll
    for (int kb = 0; kb < 2; ++kb)
#pragma unroll
      for (int v = 0; v < 16; ++v) {
        float p = __builtin_amdgcn_exp2f(__builtin_fmaf(S[kb][v], sc_l2, -mnew));
        S[kb][v] = p;
        rsum += p;
      }
    l[C] = l[C] * alpha_pend + rsum;
#pragma unroll
    for (int kb = 0; kb < 2; ++kb)
#pragma unroll
      for (int s = 0; s < 2; ++s) {
        u32x4 pk;
        pk.x = pk2(S[kb][8 * s + 0], S[kb][8 * s + 1]);
        pk.y = pk2(S[kb][8 * s + 2], S[kb][8 * s + 3]);
        pk.z = pk2(S[kb][8 * s + 4], S[kb][8 * s + 5]);
        pk.w = pk2(S[kb][8 * s + 6], S[kb][8 * s + 7]);
        pf[kb][s] = __builtin_bit_cast(bf16x8, pk);
      }
  };
  using U0 = std::integral_constant<int, 0>;
  using U1 = std::integral_constant<int, 1>;

  const int ntl = (kend - kbeg) / KEYS;
  auto step = [&](auto first_t, auto lk_t, auto lv_t, int t, int sa, int sb, int sc) {
    constexpr bool FIRST = decltype(first_t)::value, LK = decltype(lk_t)::value, LV = decltype(lv_t)::value;
    if constexpr (LK) loadK(t + 2);
    if constexpr (LV) loadV(t + 1);
    if constexpr (!FIRST) att_rescale(U1{});
    att_S(U1{}, S1, sa);
    if constexpr (!FIRST) att_PV(U1{}, pfB, sc);
    att_softmax(U0{}, S0, pfA, kbeg + t * KEYS);
    att_rescale(U0{});
    if constexpr (LV) att_S(U0{}, S0, sb);
    att_PV(U0{}, pfA, sa);
    att_softmax(U1{}, S1, pfB, kbeg + t * KEYS + 64);
    if constexpr (LK) { waitK(); storeK(sc); }
    if constexpr (LV) { waitV(); storeV(sb); }
    __syncthreads();
  };
  using TT = std::true_type;
  using FF = std::false_type;

  loadK(0); loadV(0);
  waitK(); waitV();
  storeK(0); storeV(0);
  loadK(1);
  waitK();
  storeK(1);
  __syncthreads();
  att_S(U0{}, S0, 0);
  int sa = 0, sb = 1, sc = 2;
  step(TT{}, TT{}, TT{}, 0, sa, sb, sc);
  { int tmp = sa; sa = sb; sb = sc; sc = tmp; }
  for (int t = 1; t < ntl - 2; ++t) {
    step(FF{}, TT{}, TT{}, t, sa, sb, sc);
    int tmp = sa; sa = sb; sb = sc; sc = tmp;
  }
  step(FF{}, FF{}, TT{}, ntl - 2, sa, sb, sc);
  { int tmp = sa; sa = sb; sb = sc; sc = tmp; }
  step(FF{}, FF{}, FF{}, ntl - 1, sa, sb, sc);
  att_rescale(U1{});
  att_PV(U1{}, pfB, sa);

  float inv[NCOMP];
#pragma unroll
  for (int c = 0; c < NCOMP; ++c) {
    float lt = l[c] + __shfl_xor(l[c], 32);
    inv[c] = 1.f / lt;
  }
  if constexpr (EPI == 1) {
#pragma unroll
    for (int d = 0; d < 2; ++d)
#pragma unroll
      for (int vq = 0; vq < 4; ++vq) {
        float4 o = {Oa[0][d][4 * vq] * inv[0], Oa[0][d][4 * vq + 1] * inv[0], Oa[0][d][4 * vq + 2] * inv[0], Oa[0][d][4 * vq + 3] * inv[0]};
        *(float4*)(DS + (size_t)qtok * 256 + d * 32 + 8 * vq + 4 * h) = o;
      }
  } else {
    if constexpr (EPI == 2) {
      float ss = 0.f;
#pragma unroll
      for (int d = 0; d < 2; ++d)
#pragma unroll
        for (int vq = 0; vq < 4; ++vq) {
          const float4 o1 = *(const float4*)(DS + (size_t)qtok * 256 + d * 32 + 8 * vq + 4 * h);
          const float a0 = o1.x - lam * Oa[0][d][4 * vq] * inv[0];
          const float a1 = o1.y - lam * Oa[0][d][4 * vq + 1] * inv[0];
          const float a2 = o1.z - lam * Oa[0][d][4 * vq + 2] * inv[0];
          const float a3 = o1.w - lam * Oa[0][d][4 * vq + 3] * inv[0];
          Oa[0][d][4 * vq] = a0; Oa[0][d][4 * vq + 1] = a1; Oa[0][d][4 * vq + 2] = a2; Oa[0][d][4 * vq + 3] = a3;
          ss += a0 * a0 + a1 * a1 + a2 * a2 + a3 * a3;
        }
      ss += __shfl_xor(ss, 32);
      const float rs = rsqrtf(ss * (1.f / 64.f) + EPS) * onorm;
#pragma unroll
      for (int d = 0; d < 2; ++d)
#pragma unroll
        for (int v = 0; v < 16; ++v) Oa[0][d][v] *= rs * subg[d * 32 + crow(v, h)];
    } else {
#pragma unroll
      for (int d = 0; d < 2; ++d)
#pragma unroll
        for (int v = 0; v < 16; ++v) Oa[0][d][v] *= inv[0];
    }
    store_rows(O, KP1, 0, Oa[0][0], qtok, h);
    store_rows(O, KP1, 32, Oa[0][1], qtok, h);
  }
  __syncthreads();
}

DI void attn_phase(const Params& P, int layer, char* smem) {
  char* ws = P.ws;
  u16* qkv = (u16*)(ws + OFF_QKV);
  u16* BR = (u16*)(ws + OFF_XN);
  const float L2E = 1.4426950408889634f;
  const float lambda_init = 0.8f - 0.6f * __expf(-0.3f * (float)layer);
  float lam;
  {
    const float* dl = P.d_lambda + layer * 128;
    float s1 = 0.f, s2 = 0.f;
    for (int i = 0; i < 32; ++i) { s1 += dl[i] * dl[32 + i]; s2 += dl[64 + i] * dl[96 + i]; }
    lam = __expf(s1) - __expf(s2) + lambda_init;
  }
  for (int it = blockIdx.x; it < 2048; it += gridDim.x) {
    const int cls = it >> 8;
    if (cls < 6) {
      const int idx = it & 255;
      const int head = (idx & 7) >> 1;
      const int qb = ((idx >> 3) << 1) + (idx & 1);
      int qtok0, kbeg, kend;
      if (cls < 3) { qtok0 = qb * 256; kbeg = 0; kend = SEQ0; }
      else { const int s = qb >> 3; kbeg = SEQ0 + s * DSEQ; kend = kbeg + DSEQ; qtok0 = kbeg + (qb & 7) * 256; }
      const int typ = cls % 3;
      if (typ == 0) {
        float* DS = (float*)(ws + OFF_DS) + head * 64;
        attn_item<32, 1, false, 1>(qkv + Q_QD + head * 64, 256, qkv + Q_KD + head * 64, 256,
                                   qkv + Q_VTD + (size_t)head * 64 * T, qtok0, kbeg, kend,
                                   0.17677669529663687f * L2E, 0.f, lam, 1.f - lambda_init,
                                   P.d_subln + layer * 64, BR + 768 + head * 64, DS, smem);
        attn_item<32, 1, false, 2>(qkv + Q_QD + head * 64 + 32, 256, qkv + Q_KD + head * 64 + 32, 256,
                                   qkv + Q_VTD + (size_t)head * 64 * T, qtok0, kbeg, kend,
                                   0.17677669529663687f * L2E, 0.f, lam, 1.f - lambda_init,
                                   P.d_subln + layer * 64, BR + 768 + head * 64, DS, smem);
      } else if (typ == 1) {
        attn_item<96, 1, false, 0>(qkv + Q_QC + head * 96, 384, qkv + Q_KC + head * 96, 384,
                                       qkv + Q_VTC + (size_t)head * 64 * T, qtok0, kbeg, kend,
                                       0.10206207261596577f * L2E, 0.f, 0.f, 1.f, nullptr, BR + 512 + head * 64, nullptr, smem);
      } else {
        attn_item<64, 1, false, 0>(qkv + Q_QA + head * 64, 256, qkv + Q_KA + (head >> 1) * 64, 128,
                                       qkv + Q_VTA + (size_t)(head >> 1) * 64 * T, qtok0, kbeg, kend,
                                       0.125f * L2E, 0.f, 0.f, 1.f, nullptr, BR + head * 64, nullptr, smem);
      }
    } else {
      const int idx = it - 1536;
      const int head = (idx & 7) >> 1;
      const int qbg = ((idx >> 3) << 1) + (idx & 1);
      const int qtok0 = qbg * 256;
      int sb, se;
      if (qtok0 < SEQ0) { sb = 0; se = SEQ0; }
      else { sb = SEQ0 + ((qtok0 - SEQ0) / DSEQ) * DSEQ; se = sb + DSEQ; }
      const int kbeg = max(sb, qtok0 - 128), kend = min(se, qtok0 + 256 + 128);
      const float sink = P.b_sink[layer * 4 + head];
      attn_item<64, 1, true, 0>(qkv + Q_QB + head * 64, 256, qkv + Q_KB + (head >> 1) * 64, 128,
                                    qkv + Q_VTB + (size_t)(head >> 1) * 64 * T, qtok0, kbeg, kend,
                                    0.125f * L2E, sink * L2E, 0.f, 1.f, nullptr, BR + 256 + head * 64, nullptr, smem);
    }
  }
}

DI void ew_phase(const Params& P, const float* __restrict__ Y, float coef, const float* __restrict__ gpost,
                 const float* __restrict__ gnext, bool from_inputs) {
  const int tid = opaque_tid();
  const int lane = tid & 63, wave = tid >> 6;
  u16* XN = (u16*)(P.ws + OFF_XN);
  for (int tok = blockIdx.x * 8 + wave; tok < T; tok += gridDim.x * 8) {
    const float* xs = from_inputs ? (tok < SEQ0 ? P.x_prompt + (size_t)tok * DM : P.x_sample + (size_t)(tok - SEQ0) * DM)
                                  : P.out + (size_t)tok * DM;
    float4 x[4];
#pragma unroll
    for (int i = 0; i < 4; ++i) x[i] = *(const float4*)(xs + (i * 64 + lane) * 4);
    if (Y) {
      float4 y[4];
      float ss = 0.f;
#pragma unroll
      for (int i = 0; i < 4; ++i) {
        y[i] = *(const float4*)(Y + (size_t)tok * YP + (i * 64 + lane) * 4);
        ss += y[i].x * y[i].x + y[i].y * y[i].y + y[i].z * y[i].z + y[i].w * y[i].w;
      }
      ss = wave_sum(ss);
      const float rs = rsqrtf(ss * (1.f / 1024.f) + EPS) * coef;
#pragma unroll
      for (int i = 0; i < 4; ++i) {
        float4 g = *(const float4*)(gpost + (i * 64 + lane) * 4);
        x[i].x += y[i].x * rs * g.x; x[i].y += y[i].y * rs * g.y;
        x[i].z += y[i].z * rs * g.z; x[i].w += y[i].w * rs * g.w;
      }
    }
#pragma unroll
    for (int i = 0; i < 4; ++i) *(float4*)(P.out + (size_t)tok * DM + (i * 64 + lane) * 4) = x[i];
    if (gnext) {
      float ss = 0.f;
#pragma unroll
      for (int i = 0; i < 4; ++i) ss += x[i].x * x[i].x + x[i].y * x[i].y + x[i].z * x[i].z + x[i].w * x[i].w;
      ss = wave_sum(ss);
      const float rs = rsqrtf(ss * (1.f / 1024.f) + EPS);
#pragma unroll
      for (int i = 0; i < 4; ++i) {
        float4 g = *(const float4*)(gnext + (i * 64 + lane) * 4);
        uint2 pk;
        pk.x = pk2(x[i].x * rs * g.x, x[i].y * rs * g.y);
        pk.y = pk2(x[i].z * rs * g.z, x[i].w * rs * g.w);
        *(uint2*)(XN + (size_t)tok * KP1 + (i * 64 + lane) * 4) = pk;
      }
    }
  }
}

DI int colmap(int mode, int n, int nsrc) {
  if (mode == 1) { return ((n >> 5) & 1) * DFF + (n >> 6) * 32 + (n & 31); }
  if (mode == 2) {
    if (n < 1664) return n;
    if (n < 2432) return n + 32;
    if (n < 2464) return n - 2432 + 1664;
    if (n < 2560) return -1;
    return n - 96;
  }
  return n < nsrc ? n : -1;
}
DI void conv_job(u16* __restrict__ dst, int ldd, const float* __restrict__ src, int Nd, int K, int lds, int mode,
                 const float* __restrict__ kscale) {
  const int total = Nd * (K >> 3);
  const int gthreads = gridDim.x * NTHR;
  for (int idx = blockIdx.x * NTHR + opaque_tid(); idx < total; idx += gthreads) {
    const int n = idx % Nd, k8 = idx / Nd;
    const int col = colmap(mode, n, lds);
    float v[8];
#pragma unroll
    for (int j = 0; j < 8; ++j) {
      float x = 0.f;
      if (col >= 0) {
        x = src[(size_t)(k8 * 8 + j) * lds + col];
        if (kscale) x *= kscale[k8 * 8 + j];
      }
      v[j] = x;
    }
    uint4 pk = {pk2(v[0], v[1]), pk2(v[2], v[3]), pk2(v[4], v[5]), pk2(v[6], v[7])};
    *(uint4*)(dst + (size_t)n * ldd + k8 * 8) = pk;
  }
}
DI void convert_layer(const Params& P, int l) {
  u16* W = (u16*)(P.ws + OFF_W);
  for (int s = 0; s < 2; ++s) {
    conv_job(W + W_WI + (size_t)s * 5632 * KP1, KP1, P.ffn_wi + ((size_t)l * 2 + s) * 1024 * 5632, 5632, 1024, 5632, 1, nullptr);
    conv_job(W + W_WO + (size_t)s * 1024 * KP2, KP2, P.ffn_wo + ((size_t)l * 2 + s) * 2816 * 1024, 1024, 2816, 1024, 0, nullptr);
  }
  conv_job(W + W_WIN, KP1, P.w_in + (size_t)l * 1024 * NPROJ, 6656, 1024, NPROJ, 2, nullptr);
  conv_job(W + W_WUQ, 384, P.c_w_uq + (size_t)l * 384 * 384, 512, 384, 384, 0, P.c_q_norm + l * 384);
  conv_job(W + W_WUKV, 256, P.c_w_ukv + (size_t)l * 256 * 512, 512, 256, 512, 0, P.c_kv_norm + l * 256);
  conv_job(W + W_WB, KP1, P.w_branch + (size_t)l * 1024 * 1024, 1024, 1024, 1024, 0, nullptr);
  conv_job(W + W_WOUT, KP1, P.w_out + (size_t)l * 1024 * 1024, 1024, 1024, 1024, 0, nullptr);
}
DI void rope_tables(const Params& P) {
  float2* R64 = (float2*)(P.ws + OFF_R64);
  float2* R32 = (float2*)(P.ws + OFF_R32);
  const int gthreads = gridDim.x * NTHR;
  for (int idx = blockIdx.x * NTHR + opaque_tid(); idx < 16384 * 48; idx += gthreads) {
    int pos, f; double base; float2* dst;
    if (idx < 16384 * 32) { pos = idx >> 5; f = idx & 31; base = 0.7498942093324559; dst = R64 + idx; }
    else { const int i2 = idx - 16384 * 32; pos = i2 >> 4; f = i2 & 15; base = 0.5623413251903491; dst = R32 + i2; }
    double inv = 1.0;
    for (int k = 0; k < f; ++k) inv *= base;
    const float ang = (float)pos * (float)inv;
    double tr = (double)ang * 0.15915494309189535;
    tr -= rint(tr);
    const float tf = (float)tr;
    *dst = make_float2(__builtin_amdgcn_cosf(tf), __builtin_amdgcn_sinf(tf));
  }
}

__global__ void __launch_bounds__(NTHR) __attribute__((amdgpu_waves_per_eu(2, 2))) mega(Params P) {
  extern __shared__ __attribute__((aligned(16))) char smem[];
  cg::grid_group grid = cg::this_grid();
  int phase = 0;
#define ACTIVE() (phase >= P.phase_lo && phase < P.phase_hi)
#define SEAM() do { ++phase; if (P.coop) grid.sync(); } while (0)
  u16* W = (u16*)(P.ws + OFF_W);
  u16* XN = (u16*)(P.ws + OFF_XN);
  u16* R2 = (u16*)(P.ws + OFF_R2);
  u16* qkv = (u16*)(P.ws + OFF_QKV);
  const float* Y = (const float*)(qkv + Q_Y);

  if (ACTIVE()) {
    rope_tables(P);
    convert_layer(P, 0);
    ew_phase(P, nullptr, 0.f, nullptr, P.norm_g, true);
  }
  SEAM();
  for (int l = 0; l < 4; ++l) {
    const float* g = P.norm_g + (size_t)l * 6 * DM;
    if (ACTIVE()) gemm_phase<M_FFNUP, 4>(W + W_WI, KP1, XN, KP1, DM, 22, smem, P, l);
    SEAM();
    if (ACTIVE()) gemm_phase<M_Y, 4>(W + W_WO, KP2, R2, KP2, DFF, 4, smem, P, l);
    SEAM();
    if (ACTIVE()) ew_phase(P, Y, 0.5f, g + DM, g + 2 * DM, false);
    SEAM();
    if (ACTIVE()) {
      gemm_phase<M_PROJ, 2>(W + W_WIN, KP1, XN, KP1, DM, 10, smem, P, l);
      gemm_phase<M_GATE, 4>(W + W_WIN + 2560ull * KP1, KP1, XN, KP1, DM, 16, smem, P, l);
    }
    SEAM();
    if (ACTIVE()) {
      gemm_phase<M_CUQ, 4>(W + W_WUQ, 384, qkv + Q_CQ, 384, 384, 2, smem, P, l);
      gemm_phase<M_CUKV, 4>(W + W_WUKV, 256, qkv + Q_CKV, 256, 256, 2, smem, P, l);
    }
    SEAM();
    if (ACTIVE()) attn_phase(P, l, smem);
    SEAM();
    if (ACTIVE()) gemm_phase<M_MERGE, 2>(W + W_WB, KP1, XN, KP1, DM, 4, smem, P, l);
    SEAM();
    if (ACTIVE()) gemm_phase<M_Y, 4>(W + W_WOUT, KP1, qkv + Q_MERGED, KP1, DM, 4, smem, P, l);
    SEAM();
    if (ACTIVE()) ew_phase(P, Y, 1.0f, g + 3 * DM, g + 4 * DM, false);
    SEAM();
    if (ACTIVE()) gemm_phase<M_FFNUP, 4>(W + W_WI + 5632ull * KP1, KP1, XN, KP1, DM, 22, smem, P, l);
    SEAM();
    if (ACTIVE()) gemm_phase<M_Y, 4>(W + W_WO + 1024ull * KP2, KP2, R2, KP2, DFF, 4, smem, P, l);
    SEAM();
    if (ACTIVE()) {
      ew_phase(P, Y, 0.5f, g + 5 * DM, l < 3 ? g + 6 * DM : nullptr, false);
      if (l < 3) convert_layer(P, l + 1);
    }
    SEAM();
  }
}

constexpr int N_PHASES = 1 + 12 * 4;

extern "C" void kernel_launch(void* const* d_in, const int* in_sizes, int n_in, void* d_out, int out_size, void* d_ws,
                              size_t ws_size, hipStream_t stream) {
  static int grid_blocks = 0;
  if (!grid_blocks) {
    int dev = 0, cus = 0, per_cu = 0;
    hipGetDevice(&dev);
    hipDeviceGetAttribute(&cus, hipDeviceAttributeMultiprocessorCount, dev);
    hipFuncSetAttribute((const void*)mega, hipFuncAttributeMaxDynamicSharedMemorySize, SMEM_BYTES);
    hipOccupancyMaxActiveBlocksPerMultiprocessor(&per_cu, mega, NTHR, SMEM_BYTES);
    if (per_cu < 1) per_cu = 1;
    grid_blocks = cus * per_cu;
  }
  if (ws_size < WS_NEEDED) fprintf(stderr, "workspace too small: %zu < %zu\n", ws_size, (size_t)WS_NEEDED);
  Params P{};
  P.x_prompt = (const float*)d_in[0]; P.x_sample = (const float*)d_in[1]; P.norm_g = (const float*)d_in[2];
  P.w_in = (const float*)d_in[3]; P.a_qk_norm = (const float*)d_in[4]; P.b_sink = (const float*)d_in[5];
  P.c_q_norm = (const float*)d_in[6]; P.c_kv_norm = (const float*)d_in[7]; P.c_w_uq = (const float*)d_in[8];
  P.c_w_ukv = (const float*)d_in[9]; P.d_lambda = (const float*)d_in[10]; P.d_subln = (const float*)d_in[11];
  P.w_branch = (const float*)d_in[12]; P.w_out = (const float*)d_in[13]; P.ffn_wi = (const float*)d_in[14];
  P.ffn_wo = (const float*)d_in[15];
  P.out = (float*)d_out; P.ws = (char*)d_ws;
#if MULTI_LAUNCH
  for (int ph = 0; ph < N_PHASES; ++ph) {
    P.phase_lo = ph; P.phase_hi = ph + 1; P.coop = 0; P.pad0 = 0;
    hipLaunchKernelGGL(mega, dim3(grid_blocks), dim3(NTHR), SMEM_BYTES, stream, P);
  }
#else
  P.phase_lo = 0; P.phase_hi = 1 << 30; P.coop = 1; P.pad0 = 0;
  void* args[] = {&P};
  hipError_t e = hipLaunchCooperativeKernel((const void*)mega, dim3(grid_blocks), dim3(NTHR), args, SMEM_BYTES, stream);
  if (e != hipSuccess) fprintf(stderr, "cooperative launch failed: %s (grid %d)\n", hipGetErrorString(e), grid_blocks);
#endif
}
```

```cpp
#include <hip/hip_runtime.h>
#include <hip/hip_cooperative_groups.h>
#include <cstdio>
#include <cstdint>
#include <type_traits>
namespace cg = cooperative_groups;

#ifndef MULTI_LAUNCH
#define MULTI_LAUNCH 0
#endif

#define DI __device__ __forceinline__
typedef unsigned short u16;
typedef __attribute__((ext_vector_type(8))) short bf16x8;
typedef __attribute__((ext_vector_type(16))) float f32x16;
typedef __attribute__((ext_vector_type(2))) float f32x2_t;
typedef __attribute__((ext_vector_type(2))) __bf16 bf16x2_t;

constexpr int T = 32768;
constexpr int DM = 1024;
constexpr int DFF = 2816;
constexpr int KP1 = 1088;
constexpr int KP2 = 2880;
constexpr int GP = 4160;
constexpr int YP = 1040;
constexpr int NPROJ = 6560;
constexpr int SEQ0 = 16384;
constexpr int DSEQ = 2048;
constexpr float EPS = 1e-6f;
constexpr int NTHR = 512;
constexpr int LSTR = 72;
constexpr int SMEM_BYTES = 2 * 2 * 256 * LSTR * 2;

constexpr size_t W_WI = 0;
constexpr size_t W_WO = W_WI + 2ull * 5632 * KP1;
constexpr size_t W_WIN = W_WO + 2ull * 1024 * KP2;
constexpr size_t W_WUQ = W_WIN + 6656ull * KP1;
constexpr size_t W_WUKV = W_WUQ + 512ull * 384;
constexpr size_t W_WB = W_WUKV + 512ull * 256;
constexpr size_t W_WOUT = W_WB + 1024ull * KP1;
constexpr size_t W_TOTAL = W_WOUT + 1024ull * KP1;

constexpr size_t OFF_W = 0;
constexpr size_t OFF_XN = OFF_W + W_TOTAL * 2;
constexpr size_t OFF_R2 = OFF_XN + (size_t)T * KP1 * 2;
constexpr size_t OFF_QKV = OFF_R2 + (size_t)T * GP * 2;
constexpr size_t OFF_SS = OFF_QKV + (size_t)T * 3456 * 2;
constexpr size_t OFF_R64 = OFF_SS + (size_t)T * 20 * 4;
constexpr size_t OFF_R32 = OFF_R64 + 16384ull * 32 * 8;
constexpr size_t OFF_DS = OFF_R32 + 16384ull * 16 * 8;
constexpr size_t OFF_BAR = OFF_DS + (size_t)T * 256 * 4;
constexpr size_t WS_NEEDED = OFF_BAR + 1024;

constexpr size_t Q_QA = 0;
constexpr size_t Q_KA = (size_t)T * 256;
constexpr size_t Q_VTA = (size_t)T * 384;
constexpr size_t Q_QB = (size_t)T * 512;
constexpr size_t Q_KB = (size_t)T * 768;
constexpr size_t Q_VTB = (size_t)T * 896;
constexpr size_t Q_CQ = (size_t)T * 1024;
constexpr size_t Q_CKV = (size_t)T * 1408;
constexpr size_t Q_QC = (size_t)T * 1664;
constexpr size_t Q_KC = (size_t)T * 2048;
constexpr size_t Q_VTC = (size_t)T * 2432;
constexpr size_t Q_QD = (size_t)T * 2688;
constexpr size_t Q_KD = (size_t)T * 2944;
constexpr size_t Q_VTD = (size_t)T * 3200;
constexpr size_t Q_MERGED = 0;
constexpr size_t Q_Y = (size_t)T * KP1;

struct Params {
  const float* x_prompt; const float* x_sample; const float* norm_g; const float* w_in;
  const float* a_qk_norm; const float* b_sink; const float* c_q_norm; const float* c_kv_norm;
  const float* c_w_uq; const float* c_w_ukv; const float* d_lambda; const float* d_subln;
  const float* w_branch; const float* w_out; const float* ffn_wi; const float* ffn_wo;
  float* out; char* ws;
  int phase_lo; int phase_hi; int coop; int pad0;
};

DI unsigned pk2(float a, float b) {
  f32x2_t v = {a, b};
  bf16x2_t r = __builtin_convertvector(v, bf16x2_t);
  return __builtin_bit_cast(unsigned, r);
}
DI u16 f2bf(float a) { return (u16)(pk2(a, 0.f) & 0xffffu); }
DI float bf2f(unsigned bits16) { return __uint_as_float(bits16 << 16); }
DI int crow(int v, int h) { return (v & 3) + 8 * (v >> 2) + 4 * h; }
DI int pos_of(int tok) { return tok < SEQ0 ? tok : ((tok - SEQ0) & (DSEQ - 1)); }
#define MFMA32(a, b, c) __builtin_amdgcn_mfma_f32_32x32x16_bf16((a), (b), (c), 0, 0, 0)

typedef __attribute__((ext_vector_type(4))) unsigned u32x4;
DI u32x4 gld16(const void* p) { u32x4 r; asm volatile("global_load_dwordx4 %0, %1, off" : "=v"(r) : "v"(p)); return r; }
DI void wait_vm0(u32x4& a) { asm volatile("s_waitcnt vmcnt(0)" : "+v"(a) :: "memory"); }
DI void wait_vm0(u32x4& a, u32x4& b) { asm volatile("s_waitcnt vmcnt(0)" : "+v"(a), "+v"(b) :: "memory"); }
DI void wait_vm0(u32x4& a, u32x4& b, u32x4& c) { asm volatile("s_waitcnt vmcnt(0)" : "+v"(a), "+v"(b), "+v"(c) :: "memory"); }
DI void wait_vm0(u32x4& a, u32x4& b, u32x4& c, u32x4& d) { asm volatile("s_waitcnt vmcnt(0)" : "+v"(a), "+v"(b), "+v"(c), "+v"(d) :: "memory"); }
DI u32x4 gld16s(unsigned voff, const void* sbase) { u32x4 r; asm volatile("global_load_dwordx4 %0, %1, %2" : "=v"(r) : "v"(voff), "s"(sbase)); return r; }
#define DEF_WAIT8(name, cnt) DI void name(u32x4& a, u32x4& b, u32x4& c, u32x4& d, u32x4& e, u32x4& f, u32x4& g, u32x4& h) { asm volatile("s_waitcnt vmcnt(" #cnt ")" : "+v"(a), "+v"(b), "+v"(c), "+v"(d), "+v"(e), "+v"(f), "+v"(g), "+v"(h) :: "memory"); }
#define DEF_WAIT6(name, cnt) DI void name(u32x4& a, u32x4& b, u32x4& c, u32x4& d, u32x4& e, u32x4& f) { asm volatile("s_waitcnt vmcnt(" #cnt ")" : "+v"(a), "+v"(b), "+v"(c), "+v"(d), "+v"(e), "+v"(f) :: "memory"); }
DEF_WAIT8(wait8_vm8, 8)
DEF_WAIT8(wait8_vm0, 0)
DEF_WAIT6(wait6_vm6, 6)
DEF_WAIT6(wait6_vm0, 0)
DI int opaque_tid() { int t = threadIdx.x; asm volatile("" : "+v"(t)); return t; }
DI float wave_sum(float v) {
#pragma unroll
  for (int m = 32; m >= 1; m >>= 1) v += __shfl_xor(v, m);
  return v;
}

DI void rope32_blk(f32x16& a, const float2* __restrict__ tab, int h) {
#pragma unroll
  for (int v = 0; v < 8; ++v) {
    float2 cs = tab[crow(v, h)];
    float x1 = a[v], x2 = a[v + 8];
    a[v] = x1 * cs.x - x2 * cs.y;
    a[v + 8] = x2 * cs.x + x1 * cs.y;
  }
}
DI void rope64_blk(f32x16& a0, f32x16& a1, const float2* __restrict__ tab, int h) {
#pragma unroll
  for (int v = 0; v < 16; ++v) {
    float2 cs = tab[crow(v, h)];
    float x1 = a0[v], x2 = a1[v];
    a0[v] = x1 * cs.x - x2 * cs.y;
    a1[v] = x2 * cs.x + x1 * cs.y;
  }
}
DI void store_rows(u16* __restrict__ base, int ld, int col0, const f32x16& a, int tok, int h) {
#pragma unroll
  for (int vq = 0; vq < 4; ++vq) {
    uint2 pk;
    pk.x = pk2(a[4 * vq], a[4 * vq + 1]);
    pk.y = pk2(a[4 * vq + 2], a[4 * vq + 3]);
    *(uint2*)(base + (size_t)tok * ld + col0 + 8 * vq + 4 * h) = pk;
  }
}
DI void store_T(u16* __restrict__ base, int row0, const f32x16& a, int tok, int h) {
  const int tp = (tok & ~12) | ((tok & 4) << 1) | ((tok & 8) >> 1);
#pragma unroll
  for (int v = 0; v < 16; ++v) base[(size_t)((row0 + crow(v, h)) >> 6) * 64 * T + (size_t)(tp >> 7) * 8192 + ((row0 + crow(v, h)) & 63) * 128 + (tp & 127)] = f2bf(a[v]);
}

enum { M_FFNUP = 0, M_Y = 1, M_PROJ = 2, M_CUQ = 3, M_CUKV = 4, M_MERGE = 5, M_GATE = 6 };

template <int MODE, int NJ>
DI void gemm_epilogue(f32x16 (&acc)[2][NJ], int fbase, int tbase, int r, int h, const Params& P, int layer) {
  char* ws = P.ws;
  u16* qkv = (u16*)(ws + OFF_QKV);
  const float2* R64 = (const float2*)(ws + OFF_R64);
  const float2* R32 = (const float2*)(ws + OFF_R32);
  float* SS = (float*)(ws + OFF_SS);
  if constexpr (MODE == M_FFNUP) {
    u16* H = (u16*)(ws + OFF_R2);
    const int hf0 = (fbase >> 6) * 32;
#pragma unroll
    for (int j = 0; j < NJ; ++j) {
      const int tok = tbase + j * 32 + r;
      f32x16 o;
#pragma unroll
      for (int v = 0; v < 16; ++v) {
        float g = acc[0][j][v], u = acc[1][j][v];
        o[v] = g * __builtin_amdgcn_rcpf(1.f + __builtin_amdgcn_exp2f(-1.4426950408889634f * g)) * u;
      }
      store_rows(H, KP2, hf0, o, tok, h);
    }
  } else if constexpr (MODE == M_Y) {
    float* Y = (float*)(qkv + Q_Y);
#pragma unroll
    for (int j = 0; j < NJ; ++j) {
      const int tok = tbase + j * 32 + r;
#pragma unroll
      for (int i = 0; i < 2; ++i)
#pragma unroll
        for (int vq = 0; vq < 4; ++vq) {
          float4 o = {acc[i][j][4 * vq], acc[i][j][4 * vq + 1], acc[i][j][4 * vq + 2], acc[i][j][4 * vq + 3]};
          *(float4*)(Y + (size_t)tok * YP + fbase + i * 32 + 8 * vq + 4 * h) = o;
        }
    }
  } else if constexpr (MODE == M_PROJ) {
    if (fbase < 384) {
      const bool isK = fbase >= 256;
      const float* g = P.a_qk_norm + layer * 128 + (isK ? 64 : 0);
      u16* dst = qkv + (isK ? Q_KA : Q_QA);
      const int ld = isK ? 128 : 256;
      const int c0 = isK ? fbase - 256 : fbase;
      float gv[2][16];
#pragma unroll
      for (int i = 0; i < 2; ++i)
#pragma unroll
        for (int v = 0; v < 16; ++v) gv[i][v] = g[i * 32 + crow(v, h)];
#pragma unroll
      for (int j = 0; j < NJ; ++j) {
        const int tok = tbase + j * 32 + r;
        const int pos = pos_of(tok);
        float ss = 0.f;
#pragma unroll
        for (int i = 0; i < 2; ++i)
#pragma unroll
          for (int v = 0; v < 16; ++v) ss += acc[i][j][v] * acc[i][j][v];
        ss += __shfl_xor(ss, 32);
        const float rs = rsqrtf(ss * (1.f / 64.f) + EPS);
#pragma unroll
        for (int i = 0; i < 2; ++i)
#pragma unroll
          for (int v = 0; v < 16; ++v) acc[i][j][v] *= rs * gv[i][v];
        rope32_blk(acc[0][j], R32 + (size_t)(pos >> 6) * 16, h);
        rope32_blk(acc[1][j], R32 + (size_t)(pos & 63) * 16, h);
        store_rows(dst, ld, c0, acc[0][j], tok, h);
        store_rows(dst, ld, c0 + 32, acc[1][j], tok, h);
      }
    } else if (fbase < 512) {
#pragma unroll
      for (int j = 0; j < NJ; ++j) {
        const int tok = tbase + j * 32 + r;
        store_T(qkv + Q_VTA, fbase - 384, acc[0][j], tok, h);
        store_T(qkv + Q_VTA, fbase - 384 + 32, acc[1][j], tok, h);
      }
    } else if (fbase < 896) {
      const bool isK = fbase >= 768;
      u16* dst = qkv + (isK ? Q_KB : Q_QB);
      const int ld = isK ? 128 : 256;
      const int c0 = isK ? fbase - 768 : fbase - 512;
#pragma unroll
      for (int j = 0; j < NJ; ++j) {
        const int tok = tbase + j * 32 + r;
        const int pos = pos_of(tok);
        rope64_blk(acc[0][j], acc[1][j], R64 + (size_t)pos * 32, h);
        store_rows(dst, ld, c0, acc[0][j], tok, h);
        store_rows(dst, ld, c0 + 32, acc[1][j], tok, h);
      }
    } else if (fbase < 1024) {
#pragma unroll
      for (int j = 0; j < NJ; ++j) {
        const int tok = tbase + j * 32 + r;
        store_T(qkv + Q_VTB, fbase - 896, acc[0][j], tok, h);
        store_T(qkv + Q_VTB, fbase - 896 + 32, acc[1][j], tok, h);
      }
    } else if (fbase < 1664) {
      const bool isKV = fbase >= 1408;
      u16* dst = qkv + (isKV ? Q_CKV : Q_CQ);
      const int ld = isKV ? 256 : 384;
      const int c0 = isKV ? fbase - 1408 : fbase - 1024;
      const int sb = (isKV ? 12 : 0) + (c0 >> 5);
#pragma unroll
      for (int j = 0; j < NJ; ++j) {
        const int tok = tbase + j * 32 + r;
#pragma unroll
        for (int i = 0; i < 2; ++i) {
          float ss = 0.f;
#pragma unroll
          for (int v = 0; v < 16; ++v) ss += acc[i][j][v] * acc[i][j][v];
          ss += __shfl_xor(ss, 32);
          if (h == 0) SS[(size_t)tok * 20 + sb + i] = ss;
          store_rows(dst, ld, c0 + i * 32, acc[i][j], tok, h);
        }
      }
    } else if (fbase < 2176) {
      const bool isK = fbase >= 1920;
      u16* dst = qkv + (isK ? Q_KD : Q_QD);
      const int c0 = isK ? fbase - 1920 : fbase - 1664;
#pragma unroll
      for (int j = 0; j < NJ; ++j) {
        const int tok = tbase + j * 32 + r;
        const int pos = pos_of(tok);
#pragma unroll
        for (int i = 0; i < 2; ++i) {
          rope32_blk(acc[i][j], R32 + (size_t)pos * 16, h);
          store_rows(dst, 256, c0 + i * 32, acc[i][j], tok, h);
        }
      }
    } else if (fbase < 2432) {
#pragma unroll
      for (int j = 0; j < NJ; ++j) {
        const int tok = tbase + j * 32 + r;
        store_T(qkv + Q_VTD, fbase - 2176, acc[0][j], tok, h);
        store_T(qkv + Q_VTD, fbase - 2176 + 32, acc[1][j], tok, h);
      }
    } else if (fbase == 2432) {
#pragma unroll
      for (int j = 0; j < NJ; ++j) {
        const int tok = tbase + j * 32 + r;
        const int pos = pos_of(tok);
        rope32_blk(acc[0][j], R32 + (size_t)pos * 16, h);
#pragma unroll
        for (int hd = 0; hd < 4; ++hd) store_rows(qkv + Q_KC, 384, hd * 96 + 64, acc[0][j], tok, h);
      }
    }
  } else if constexpr (MODE == M_GATE) {
    u16* G = (u16*)(ws + OFF_R2);
#pragma unroll
    for (int j = 0; j < NJ; ++j) {
      const int tok = tbase + j * 32 + r;
#pragma unroll
      for (int i = 0; i < 2; ++i) {
        f32x16 o;
#pragma unroll
        for (int v = 0; v < 16; ++v) o[v] = __builtin_amdgcn_rcpf(1.f + __builtin_amdgcn_exp2f(-1.4426950408889634f * acc[i][j][v]));
        store_rows(G, GP, fbase + i * 32, o, tok, h);
      }
    }
  } else if constexpr (MODE == M_CUQ) {
    if (fbase >= 384) return;
#pragma unroll
    for (int j = 0; j < NJ; ++j) {
      const int tok = tbase + j * 32 + r;
      const int pos = pos_of(tok);
      float ss = 0.f;
#pragma unroll
      for (int b = 0; b < 12; ++b) ss += SS[(size_t)tok * 20 + b];
      const float rs = rsqrtf(ss * (1.f / 384.f) + EPS);
#pragma unroll
      for (int i = 0; i < 2; ++i) {
        const int blk = (fbase >> 5) + i;
#pragma unroll
        for (int v = 0; v < 16; ++v) acc[i][j][v] *= rs;
        if (blk % 3 == 2) rope32_blk(acc[i][j], R32 + (size_t)pos * 16, h);
        store_rows(qkv + Q_QC, 384, blk * 32, acc[i][j], tok, h);
      }
    }
  } else if constexpr (MODE == M_CUKV) {
#pragma unroll
    for (int j = 0; j < NJ; ++j) {
      const int tok = tbase + j * 32 + r;
      float ss = 0.f;
#pragma unroll
      for (int b = 0; b < 8; ++b) ss += SS[(size_t)tok * 20 + 12 + b];
      const float rs = rsqrtf(ss * (1.f / 256.f) + EPS);
#pragma unroll
      for (int i = 0; i < 2; ++i) {
        const int blk = (fbase >> 5) + i;
        const int hd = blk >> 2, q = blk & 3;
#pragma unroll
        for (int v = 0; v < 16; ++v) acc[i][j][v] *= rs;
        if (q < 2) store_rows(qkv + Q_KC, 384, hd * 96 + q * 32, acc[i][j], tok, h);
        else store_T(qkv + Q_VTC, hd * 64 + (q - 2) * 32, acc[i][j], tok, h);
      }
    }
  } else if constexpr (MODE == M_MERGE) {
#pragma unroll
    for (int j = 0; j < NJ; ++j) {
      const int tok = tbase + j * 32 + r;
      store_rows(qkv + Q_MERGED, KP1, fbase, acc[0][j], tok, h);
      store_rows(qkv + Q_MERGED, KP1, fbase + 32, acc[1][j], tok, h);
    }
  }
}

template <int MODE, int NJ>
DI void gemm_tile(const u16* __restrict__ Wt, int ldw, const u16* __restrict__ X, int ldx, int K, int f0, int t0, char* smem,
                  const Params& P, int layer) {
  constexpr int XROWS = NJ * 64;
  u16* sW = (u16*)smem;
  u16* sX = sW + 2 * 256 * LSTR;
  const int tid = opaque_tid(), lane = tid & 63, wave = tid >> 6, r = lane & 31, h = lane >> 5;
  const int wf = wave & 3, wt = wave >> 2;
  f32x16 acc[2][NJ];
  f32x16 tot[2][MODE == M_MERGE ? NJ : 1];
#pragma unroll
  for (int i = 0; i < 2; ++i)
#pragma unroll
    for (int j = 0; j < NJ; ++j)
#pragma unroll
      for (int v = 0; v < 16; ++v) acc[i][j][v] = 0.f;
  if constexpr (MODE == M_MERGE) {
#pragma unroll
    for (int i = 0; i < 2; ++i)
#pragma unroll
      for (int j = 0; j < NJ; ++j)
#pragma unroll
        for (int v = 0; v < 16; ++v) tot[i][j][v] = 0.f;
  }
  const int nk = K >> 6;
  u32x4 wA[4], xA[NJ], wB[4], xB[NJ];
  const int crow_ = tid >> 3, ccol = (tid & 7) * 8;
  const unsigned voffW = (unsigned)(crow_ * ldw + ccol) * 2u, voffX = (unsigned)(crow_ * ldx + ccol) * 2u;
  const char* wbase = (const char*)(Wt + (size_t)f0 * ldw);
  const char* xbase = (const char*)(X + (size_t)t0 * ldx);
  const int fbase = f0 + wf * 64, tbase = t0 + wt * (NJ * 32);
  const int ldsW = crow_ * LSTR + ccol;

#define GEMM_GLOAD(WR, XR, kt_)                                                                                          \
  do {                                                                                                                   \
    _Pragma("unroll") for (int i = 0; i < 4; ++i) WR[i] = gld16s(voffW, wbase + ((size_t)(i * 64) * ldw + (kt_) * 64) * 2);  \
    _Pragma("unroll") for (int i = 0; i < NJ; ++i) XR[i] = gld16s(voffX, xbase + ((size_t)(i * 64) * ldx + (kt_) * 64) * 2); \
  } while (0)
#define GEMM_SSTORE(WR, XR, buf_, more_)                                                                                 \
  do {                                                                                                                   \
    if constexpr (NJ == 4) {                                                                                             \
      if constexpr (more_) wait8_vm8(WR[0], WR[1], WR[2], WR[3], XR[0], XR[1], XR[2], XR[3]);                            \
      else wait8_vm0(WR[0], WR[1], WR[2], WR[3], XR[0], XR[1], XR[2], XR[3]);                                            \
    } else {                                                                                                             \
      if constexpr (more_) wait6_vm6(WR[0], WR[1], WR[2], WR[3], XR[0], XR[1]);                                          \
      else wait6_vm0(WR[0], WR[1], WR[2], WR[3], XR[0], XR[1]);                                                          \
    }                                                                                                                    \
    _Pragma("unroll") for (int i = 0; i < 4; ++i) *(u32x4*)(sW + ((buf_) * 256 + i * 64) * LSTR + ldsW) = WR[i];         \
    _Pragma("unroll") for (int i = 0; i < NJ; ++i) *(u32x4*)(sX + ((buf_) * XROWS + i * 64) * LSTR + ldsW) = XR[i];      \
  } while (0)

  auto compute = [&](int buf, int kt) {
    const u16* aW = sW + (buf * 256 + wf * 64 + r) * LSTR + h * 8;
    const u16* aX = sX + (buf * XROWS + wt * (NJ * 32) + r) * LSTR + h * 8;
#pragma unroll
    for (int ks = 0; ks < 4; ++ks) {
      bf16x8 wfrag[2], xfrag[NJ];
#pragma unroll
      for (int i = 0; i < 2; ++i) wfrag[i] = *(const bf16x8*)(aW + i * 32 * LSTR + ks * 16);
#pragma unroll
      for (int j = 0; j < NJ; ++j) xfrag[j] = *(const bf16x8*)(aX + j * 32 * LSTR + ks * 16);
#pragma unroll
      for (int i = 0; i < 2; ++i)
#pragma unroll
        for (int j = 0; j < NJ; ++j) acc[i][j] = MFMA32(wfrag[i], xfrag[j], acc[i][j]);
    }
    if constexpr (MODE == M_MERGE) {
      if ((kt & 3) == 3) {
        const int br = kt >> 2;
        const u16* G = (const u16*)(P.ws + OFF_R2);
#pragma unroll
        for (int j = 0; j < NJ; ++j) {
          const int tok = tbase + j * 32 + r;
#pragma unroll
          for (int i = 0; i < 2; ++i)
#pragma unroll
            for (int vq = 0; vq < 4; ++vq) {
              uint2 gp = *(const uint2*)(G + (size_t)tok * GP + br * 1024 + fbase + i * 32 + 8 * vq + 4 * h);
              tot[i][j][4 * vq + 0] += bf2f(gp.x & 0xffffu) * acc[i][j][4 * vq + 0];
              tot[i][j][4 * vq + 1] += bf2f(gp.x >> 16) * acc[i][j][4 * vq + 1];
              tot[i][j][4 * vq + 2] += bf2f(gp.y & 0xffffu) * acc[i][j][4 * vq + 2];
              tot[i][j][4 * vq + 3] += bf2f(gp.y >> 16) * acc[i][j][4 * vq + 3];
              acc[i][j][4 * vq + 0] = 0.f; acc[i][j][4 * vq + 1] = 0.f;
              acc[i][j][4 * vq + 2] = 0.f; acc[i][j][4 * vq + 3] = 0.f;
            }
        }
      }
    }
  };

  GEMM_GLOAD(wA, xA, 0);
  GEMM_GLOAD(wB, xB, 1);
  GEMM_SSTORE(wA, xA, 0, true);
  __syncthreads();
  for (int kt = 0; kt < nk - 2; kt += 2) {
    GEMM_GLOAD(wA, xA, kt + 2);
    compute(0, kt);
    GEMM_SSTORE(wB, xB, 1, true);
    __syncthreads();
    GEMM_GLOAD(wB, xB, kt + 3);
    compute(1, kt + 1);
    GEMM_SSTORE(wA, xA, 0, true);
    __syncthreads();
  }
  compute(0, nk - 2);
  GEMM_SSTORE(wB, xB, 1, false);
  __syncthreads();
  compute(1, nk - 1);
  __syncthreads();
  if constexpr (MODE == M_MERGE) gemm_epilogue<MODE, NJ>(tot, fbase, tbase, r, h, P, layer);
  else gemm_epilogue<MODE, NJ>(acc, fbase, tbase, r, h, P, layer);
}

template <int MODE, int NJ>
DI void gemm_phase(const u16* Wt, int ldw, const u16* X, int ldx, int K, int nF, char* smem, const Params& P, int layer) {
  constexpr int TT = NJ * 64;
  const int nT = T / TT;
  const int ntiles = nF * nT;
  for (int idx = blockIdx.x; idx < ntiles; idx += gridDim.x) {
    const int tt_lo = idx & 15;
    const int rest = idx >> 4;
    const int ft = rest % nF;
    const int tt = (rest / nF) * 16 + tt_lo;
    gemm_tile<MODE, NJ>(Wt, ldw, X, ldx, K, ft * 256, tt * TT, smem, P, layer);
  }
}

template <int DQK, int NCOMP, bool BAND, int EPI>
DI void attn_item(const u16* __restrict__ Q, int ldq, const u16* __restrict__ Kp, int ldk, const u16* __restrict__ Vt,
                  int qtok0, int kbeg, int kend, float sc_l2, float sink_l2, float lam, float onorm,
                  const float* __restrict__ subg, u16* __restrict__ O, float* __restrict__ DS, char* smem) {
  constexpr int DC = DQK / NCOMP;
  constexpr int KS = DC / 16;
  constexpr int KEYS = (NCOMP == 1) ? 128 : 64;
  constexpr int KSTR = DQK + 8, VSTR = KEYS + 8;
  constexpr int KCH = DQK / 8, VCH = KEYS / 8;
  constexpr int NKC = KEYS * KCH / NTHR, NVC = 64 * VCH / NTHR;
  constexpr int KSLOT = KEYS * KSTR, VSLOT = 64 * VSTR;
  u16* sK = (u16*)smem;
  u16* sV = sK + 3 * KSLOT;
  const int tid = opaque_tid(), lane = tid & 63, wave = tid >> 6, r = lane & 31, h = lane >> 5;
  const int qtok = qtok0 + wave * 32 + r;

  bf16x8 qf[NCOMP][KS];
#pragma unroll
  for (int c = 0; c < NCOMP; ++c)
#pragma unroll
    for (int ks = 0; ks < KS; ++ks) qf[c][ks] = *(const bf16x8*)(Q + (size_t)qtok * ldq + c * DC + ks * 16 + 8 * h);

  f32x16 Oa[NCOMP][2];
  float m[NCOMP], l[NCOMP];
#pragma unroll
  for (int c = 0; c < NCOMP; ++c) {
#pragma unroll
    for (int d = 0; d < 2; ++d)
#pragma unroll
      for (int v = 0; v < 16; ++v) Oa[c][d][v] = 0.f;
    m[c] = BAND ? sink_l2 : -1e30f;
    l[c] = (BAND && h == 0) ? 1.f : 0.f;
  }

  const u16* kg[NKC]; int kso[NKC];
#pragma unroll
  for (int i = 0; i < NKC; ++i) {
    const int c = tid + i * NTHR;
    const int row = c / KCH, cc = c % KCH;
    kg[i] = Kp + (size_t)(kbeg + row) * ldk + cc * 8;
    kso[i] = row * KSTR + cc * 8;
  }
  const u16* vg[NVC]; int vso[NVC];
#pragma unroll
  for (int i = 0; i < NVC; ++i) {
    const int c = tid + i * NTHR;
    const int row = c / VCH, cc = c % VCH;
    vg[i] = Vt + (size_t)(kbeg >> 7) * 8192 + row * 128 + cc * 8;
    vso[i] = row * VSTR + cc * 8;
  }
  u32x4 kreg[NKC], vreg[NVC];
  auto loadK = [&](int t) {
#pragma unroll
    for (int i = 0; i < NKC; ++i) kreg[i] = gld16(kg[i] + (size_t)t * KEYS * ldk);
  };
  auto loadV = [&](int t) {
#pragma unroll
    for (int i = 0; i < NVC; ++i) vreg[i] = gld16(vg[i] + (size_t)t * 8192);
  };
  auto waitK = [&]() {
    if constexpr (NKC == 1) wait_vm0(kreg[0]);
    else if constexpr (NKC == 2) wait_vm0(kreg[0], kreg[1]);
    else wait_vm0(kreg[0], kreg[1], kreg[2]);
  };
  auto waitV = [&]() {
    if constexpr (NVC == 1) wait_vm0(vreg[0]);
    else wait_vm0(vreg[0], vreg[1]);
  };
  auto storeK = [&](int slot) {
#pragma unroll
    for (int i = 0; i < NKC; ++i) *(u32x4*)(sK + slot * KSLOT + kso[i]) = kreg[i];
  };
  auto storeV = [&](int slot) {
#pragma unroll
    for (int i = 0; i < NVC; ++i) *(u32x4*)(sV + slot * VSLOT + vso[i]) = vreg[i];
  };

  f32x16 S0[2], S1[2];
  bf16x8 pfA[2][2], pfB[2][2];
  float alpha_pend = 1.f;
  bool need_pend = false;

  auto att_S = [&](auto uu_t, f32x16 (&S)[2], int slot) {
    constexpr int UU = decltype(uu_t)::value;
    constexpr int C = (NCOMP == 2) ? UU : 0;
    const u16* base = sK + slot * KSLOT + ((NCOMP == 1 ? UU * 64 : 0) + r) * KSTR + (NCOMP == 2 ? UU * DC : 0) + 8 * h;
#pragma unroll
    for (int kb = 0; kb < 2; ++kb) {
#pragma unroll
      for (int v = 0; v < 16; ++v) S[kb][v] = 0.f;
#pragma unroll
      for (int ks = 0; ks < KS; ++ks) {
        bf16x8 kf = *(const bf16x8*)(base + kb * 32 * KSTR + ks * 16);
        S[kb] = MFMA32(kf, qf[C][ks], S[kb]);
      }
    }
  };
  auto att_PV = [&](auto uu_t, const bf16x8 (&pf)[2][2], int slot) {
    constexpr int UU = decltype(uu_t)::value;
    constexpr int C = (NCOMP == 2) ? UU : 0;
    const u16* base = sV + slot * VSLOT + r * VSTR + (NCOMP == 1 ? UU * 64 : 0) + 8 * h;
#pragma unroll
    for (int d = 0; d < 2; ++d)
#pragma unroll
      for (int kb = 0; kb < 2; ++kb)
#pragma unroll
        for (int s = 0; s < 2; ++s) {
          bf16x8 vf = *(const bf16x8*)(base + d * 32 * VSTR + kb * 32 + 16 * s);
          Oa[C][d] = MFMA32(vf, pf[kb][s], Oa[C][d]);
        }
  };
  auto att_rescale = [&](auto uu_t) {
    constexpr int UU = decltype(uu_t)::value;
    constexpr int C = (NCOMP == 2) ? UU : 0;
    if (need_pend) {
#pragma unroll
      for (int d = 0; d < 2; ++d)
#pragma unroll
        for (int v = 0; v < 16; ++v) Oa[C][d][v] *= alpha_pend;
    }
  };
  auto att_softmax = [&](auto uu_t, f32x16 (&S)[2], bf16x8 (&pf)[2][2], int kpos0) {
    constexpr int UU = decltype(uu_t)::value;
    constexpr int C = (NCOMP == 2) ? UU : 0;
    if constexpr (BAND) {
#pragma unroll
      for (int kb = 0; kb < 2; ++kb)
#pragma unroll
        for (int v = 0; v < 16; ++v) {
          const int d = kpos0 + kb * 32 + crow(v, h) - qtok;
          if (d > 128 || d < -128) S[kb][v] = -1e30f;
        }
    }
    float mx = S[0][0];
#pragma unroll
    for (int kb = 0; kb < 2; ++kb)
#pragma unroll
      for (int v = 0; v < 16; ++v) mx = fmaxf(mx, S[kb][v]);
    mx = fmaxf(mx, __shfl_xor(mx, 32));
    const float mold = m[C];
    const float mnew = fmaxf(mold, mx * sc_l2);
    need_pend = __builtin_amdgcn_ballot_w64(mnew > mold) != 0;
    alpha_pend = __builtin_amdgcn_exp2f(mold - mnew);
    m[C] = mnew;
    float rsum = 0.f;
#pragma unroll
    for (int kb = 0; kb < 2; ++kb)
#pragma unroll
      for (int v = 0; v < 16; ++v) {
        float p = __builtin_amdgcn_exp2f(__builtin_fmaf(S[kb][v], sc_l2, -mnew));
        S[kb][v] = p;
        rsum += p;
      }
    l[C] = l[C] * alpha_pend + rsum;
#pragma unroll
    for (int kb = 0; kb < 2; ++kb)
#pragma unroll
      for (int s = 0; s < 2; ++s) {
        u32x4 pk;
        pk.x = pk2(S[kb][8 * s + 0], S[kb][8 * s + 1]);
        pk.y = pk2(S[kb][8 * s + 2], S[kb][8 * s + 3]);
        pk.z = pk2(S[kb][8 * s + 4], S[kb][8 * s + 5]);
        pk.w = pk2(S[kb][8 * s + 6], S[kb][8 * s + 7]);
        pf[kb][s] = __builtin_bit_cast(bf16x8, pk);
      }
  };
  using U0 = std::integral_constant<int, 0>;
  using U1 = std::integral_constant<int, 1>;

  const int ntl = (kend - kbeg) / KEYS;
  auto step = [&](auto first_t, auto lk_t, auto lv_t, int t, int sa, int sb, int sc) {
    constexpr bool FIRST = decltype(first_t)::value, LK = decltype(lk_t)::value, LV = decltype(lv_t)::value;
    if constexpr (LK) loadK(t + 2);
    if constexpr (LV) loadV(t + 1);
    if constexpr (!FIRST) att_rescale(U1{});
    att_S(U1{}, S1, sa);
    if constexpr (!FIRST) att_PV(U1{}, pfB, sc);
    att_softmax(U0{}, S0, pfA, kbeg + t * KEYS);
    att_rescale(U0{});
    if constexpr (LV) att_S(U0{}, S0, sb);
    att_PV(U0{}, pfA, sa);
    att_softmax(U1{}, S1, pfB, kbeg + t * KEYS + 64);
    if constexpr (LK) { waitK(); storeK(sc); }
    if constexpr (LV) { waitV(); storeV(sb); }
    __syncthreads();
  };
  using TT = std::true_type;
  using FF = std::false_type;

  loadK(0); loadV(0);
  waitK(); waitV();
  storeK(0); storeV(0);
  loadK(1);
  waitK();
  storeK(1);
  __syncthreads();
  att_S(U0{}, S0, 0);
  int sa = 0, sb = 1, sc = 2;
  step(TT{}, TT{}, TT{}, 0, sa, sb, sc);
  { int tmp = sa; sa = sb; sb = sc; sc = tmp; }
  for (int t = 1; t < ntl - 2; ++t) {
    step(FF{}, TT{}, TT{}, t, sa, sb, sc);
    int tmp = sa; sa = sb; sb = sc; sc = tmp;
  }
  step(FF{}, FF{}, TT{}, ntl - 2, sa, sb, sc);
  { int tmp = sa; sa = sb; sb = sc; sc = tmp; }
  step(FF{}, FF{}, FF{}, ntl - 1, sa, sb, sc);
  att_rescale(U1{});
  att_PV(U1{}, pfB, sa);

  float inv[NCOMP];
#pragma unroll
  for (int c = 0; c < NCOMP; ++c) {
    float lt = l[c] + __shfl_xor(l[c], 32);
    inv[c] = 1.f / lt;
  }
  if constexpr (EPI == 1) {
#pragma unroll
    for (int d = 0; d < 2; ++d)
#pragma unroll
      for (int vq = 0; vq < 4; ++vq) {
        float4 o = {Oa[0][d][4 * vq] * inv[0], Oa[0][d][4 * vq + 1] * inv[0], Oa[0][d][4 * vq + 2] * inv[0], Oa[0][d][4 * vq + 3] * inv[0]};
        *(float4*)(DS + (size_t)qtok * 256 + d * 32 + 8 * vq + 4 * h) = o;
      }
  } else {
    if constexpr (EPI == 2) {
      float ss = 0.f;
#pragma unroll
      for (int d = 0; d < 2; ++d)
#pragma unroll
        for (int vq = 0; vq < 4; ++vq) {
          const float4 o1 = *(const float4*)(DS + (size_t)qtok * 256 + d * 32 + 8 * vq + 4 * h);
          const float a0 = o1.x - lam * Oa[0][d][4 * vq] * inv[0];
          const float a1 = o1.y - lam * Oa[0][d][4 * vq + 1] * inv[0];
          const float a2 = o1.z - lam * Oa[0][d][4 * vq + 2] * inv[0];
          const float a3 = o1.w - lam * Oa[0][d][4 * vq + 3] * inv[0];
          Oa[0][d][4 * vq] = a0; Oa[0][d][4 * vq + 1] = a1; Oa[0][d][4 * vq + 2] = a2; Oa[0][d][4 * vq + 3] = a3;
          ss += a0 * a0 + a1 * a1 + a2 * a2 + a3 * a3;
        }
      ss += __shfl_xor(ss, 32);
      const float rs = rsqrtf(ss * (1.f / 64.f) + EPS) * onorm;
#pragma unroll
      for (int d = 0; d < 2; ++d)
#pragma unroll
        for (int v = 0; v < 16; ++v) Oa[0][d][v] *= rs * subg[d * 32 + crow(v, h)];
    } else {
#pragma unroll
      for (int d = 0; d < 2; ++d)
#pragma unroll
        for (int v = 0; v < 16; ++v) Oa[0][d][v] *= inv[0];
    }
    store_rows(O, KP1, 0, Oa[0][0], qtok, h);
    store_rows(O, KP1, 32, Oa[0][1], qtok, h);
  }
  __syncthreads();
}

DI void attn_phase(const Params& P, int layer, char* smem) {
  char* ws = P.ws;
  u16* qkv = (u16*)(ws + OFF_QKV);
  u16* BR = (u16*)(ws + OFF_XN);
  const float L2E = 1.4426950408889634f;
  const float lambda_init = 0.8f - 0.6f * __expf(-0.3f * (float)layer);
  float lam;
  {
    const float* dl = P.d_lambda + layer * 128;
    float s1 = 0.f, s2 = 0.f;
    for (int i = 0; i < 32; ++i) { s1 += dl[i] * dl[32 + i]; s2 += dl[64 + i] * dl[96 + i]; }
    lam = __expf(s1) - __expf(s2) + lambda_init;
  }
  for (int it = blockIdx.x; it < 2048; it += gridDim.x) {
    const int cls = it >> 8;
    if (cls < 6) {
      const int idx = it & 255;
      const int head = (idx & 7) >> 1;
      const int qb = ((idx >> 3) << 1) + (idx & 1);
      int qtok0, kbeg, kend;
      if (cls < 3) { qtok0 = qb * 256; kbeg = 0; kend = SEQ0; }
      else { const int s = qb >> 3; kbeg = SEQ0 + s * DSEQ; kend = kbeg + DSEQ; qtok0 = kbeg + (qb & 7) * 256; }
      const int typ = cls % 3;
      if (typ == 0) {
        float* DS = (float*)(ws + OFF_DS) + head * 64;
        attn_item<32, 1, false, 1>(qkv + Q_QD + head * 64, 256, qkv + Q_KD + head * 64, 256,
                                   qkv + Q_VTD + (size_t)head * 64 * T, qtok0, kbeg, kend,
                                   0.17677669529663687f * L2E, 0.f, lam, 1.f - lambda_init,
                                   P.d_subln + layer * 64, BR + 768 + head * 64, DS, smem);
        attn_item<32, 1, false, 2>(qkv + Q_QD + head * 64 + 32, 256, qkv + Q_KD + head * 64 + 32, 256,
                                   qkv + Q_VTD + (size_t)head * 64 * T, qtok0, kbeg, kend,
                                   0.17677669529663687f * L2E, 0.f, lam, 1.f - lambda_init,
                                   P.d_subln + layer * 64, BR + 768 + head * 64, DS, smem);
      } else if (typ == 1) {
        attn_item<96, 1, false, 0>(qkv + Q_QC + head * 96, 384, qkv + Q_KC + head * 96, 384,
                                       qkv + Q_VTC + (size_t)head * 64 * T, qtok0, kbeg, kend,
                                       0.10206207261596577f * L2E, 0.f, 0.f, 1.f, nullptr, BR + 512 + head * 64, nullptr, smem);
      } else {
        attn_item<64, 1, false, 0>(qkv + Q_QA + head * 64, 256, qkv + Q_KA + (head >> 1) * 64, 128,
                                       qkv + Q_VTA + (size_t)(head >> 1) * 64 * T, qtok0, kbeg, kend,
                                       0.125f * L2E, 0.f, 0.f, 1.f, nullptr, BR + head * 64, nullptr, smem);
      }
    } else {
      const int idx = it - 1536;
      const int head = (idx & 7) >> 1;
      const int qbg = ((idx >> 3) << 1) + (idx & 1);
      const int qtok0 = qbg * 256;
      int sb, se;
      if (qtok0 < SEQ0) { sb = 0; se = SEQ0; }
      else { sb = SEQ0 + ((qtok0 - SEQ0) / DSEQ) * DSEQ; se = sb + DSEQ; }
      const int kbeg = max(sb, qtok0 - 128), kend = min(se, qtok0 + 256 + 128);
      const float sink = P.b_sink[layer * 4 + head];
      attn_item<64, 1, true, 0>(qkv + Q_QB + head * 64, 256, qkv + Q_KB + (head >> 1) * 64, 128,
                                    qkv + Q_VTB + (size_t)(head >> 1) * 64 * T, qtok0, kbeg, kend,
                                    0.125f * L2E, sink * L2E, 0.f, 1.f, nullptr, BR + 256 + head * 64, nullptr, smem);
    }
  }
}

DI void ew_phase(const Params& P, const float* __restrict__ Y, float coef, const float* __restrict__ gpost,
                 const float* __restrict__ gnext, bool from_inputs) {
  const int tid = opaque_tid();
  const int lane = tid & 63, wave = tid >> 6;
  u16* XN = (u16*)(P.ws + OFF_XN);
  for (int tok = blockIdx.x * 8 + wave; tok < T; tok += gridDim.x * 8) {
    const float* xs = from_inputs ? (tok < SEQ0 ? P.x_prompt + (size_t)tok * DM : P.x_sample + (size_t)(tok - SEQ0) * DM)
                                  : P.out + (size_t)tok * DM;
    float4 x[4];
#pragma unroll
    for (int i = 0; i < 4; ++i) x[i] = *(const float4*)(xs + (i * 64 + lane) * 4);
    if (Y) {
      float4 y[4];
      float ss = 0.f;
#pragma unroll
      for (int i = 0; i < 4; ++i) {
        y[i] = *(const float4*)(Y + (size_t)tok * YP + (i * 64 + lane) * 4);
        ss += y[i].x * y[i].x + y[i].y * y[i].y + y[i].z * y[i].z + y[i].w * y[i].w;
      }
      ss = wave_sum(ss);
      const float rs = rsqrtf(ss * (1.f / 1024.f) + EPS) * coef;
#pragma unroll
      for (int i = 0; i < 4; ++i) {
        float4 g = *(const float4*)(gpost + (i * 64 + lane) * 4);
        x[i].x += y[i].x * rs * g.x; x[i].y += y[i].y * rs * g.y;
        x[i].z += y[i].z * rs * g.z; x[i].w += y[i].w * rs * g.w;
      }
    }
#pragma unroll
    for (int i = 0; i < 4; ++i) *(float4*)(P.out + (size_t)tok * DM + (i * 64 + lane) * 4) = x[i];
    if (gnext) {
      float ss = 0.f;
#pragma unroll
      for (int i = 0; i < 4; ++i) ss += x[i].x * x[i].x + x[i].y * x[i].y + x[i].z * x[i].z + x[i].w * x[i].w;
      ss = wave_sum(ss);
      const float rs = rsqrtf(ss * (1.f / 1024.f) + EPS);
#pragma unroll
      for (int i = 0; i < 4; ++i) {
        float4 g = *(const float4*)(gnext + (i * 64 + lane) * 4);
        uint2 pk;
        pk.x = pk2(x[i].x * rs * g.x, x[i].y * rs * g.y);
        pk.y = pk2(x[i].z * rs * g.z, x[i].w * rs * g.w);
        *(uint2*)(XN + (size_t)tok * KP1 + (i * 64 + lane) * 4) = pk;
      }
    }
  }
}

DI int colmap(int mode, int n, int nsrc) {
  if (mode == 1) { return ((n >> 5) & 1) * DFF + (n >> 6) * 32 + (n & 31); }
  if (mode == 2) {
    if (n < 1664) return n;
    if (n < 2432) return n + 32;
    if (n < 2464) return n - 2432 + 1664;
    if (n < 2560) return -1;
    return n - 96;
  }
  return n < nsrc ? n : -1;
}
DI void conv_job(u16* __restrict__ dst, int ldd, const float* __restrict__ src, int Nd, int K, int lds, int mode,
                 const float* __restrict__ kscale) {
  const int total = Nd * (K >> 3);
  const int gthreads = gridDim.x * NTHR;
  for (int idx = blockIdx.x * NTHR + opaque_tid(); idx < total; idx += gthreads) {
    const int n = idx % Nd, k8 = idx / Nd;
    const int col = colmap(mode, n, lds);
    float v[8];
#pragma unroll
    for (int j = 0; j < 8; ++j) {
      float x = 0.f;
      if (col >= 0) {
        x = src[(size_t)(k8 * 8 + j) * lds + col];
        if (kscale) x *= kscale[k8 * 8 + j];
      }
      v[j] = x;
    }
    uint4 pk = {pk2(v[0], v[1]), pk2(v[2], v[3]), pk2(v[4], v[5]), pk2(v[6], v[7])};
    *(uint4*)(dst + (size_t)n * ldd + k8 * 8) = pk;
  }
}
DI void convert_layer(const Params& P, int l) {
  u16* W = (u16*)(P.ws + OFF_W);
  for (int s = 0; s < 2; ++s) {
    conv_job(W + W_WI + (size_t)s * 5632 * KP1, KP1, P.ffn_wi + ((size_t)l * 2 + s) * 1024 * 5632, 5632, 1024, 5632, 1, nullptr);
    conv_job(W + W_WO + (size_t)s * 1024 * KP2, KP2, P.ffn_wo + ((size_t)l * 2 + s) * 2816 * 1024, 1024, 2816, 1024, 0, nullptr);
  }
  conv_job(W + W_WIN, KP1, P.w_in + (size_t)l * 1024 * NPROJ, 6656, 1024, NPROJ, 2, nullptr);
  conv_job(W + W_WUQ, 384, P.c_w_uq + (size_t)l * 384 * 384, 512, 384, 384, 0, P.c_q_norm + l * 384);
  conv_job(W + W_WUKV, 256, P.c_w_ukv + (size_t)l * 256 * 512, 512, 256, 512, 0, P.c_kv_norm + l * 256);
  conv_job(W + W_WB, KP1, P.w_branch + (size_t)l * 1024 * 1024, 1024, 1024, 1024, 0, nullptr);
  conv_job(W + W_WOUT, KP1, P.w_out + (size_t)l * 1024 * 1024, 1024, 1024, 1024, 0, nullptr);
}
DI void rope_tables(const Params& P) {
  float2* R64 = (float2*)(P.ws + OFF_R64);
  float2* R32 = (float2*)(P.ws + OFF_R32);
  const int gthreads = gridDim.x * NTHR;
  for (int idx = blockIdx.x * NTHR + opaque_tid(); idx < 16384 * 48; idx += gthreads) {
    int pos, f; double base; float2* dst;
    if (idx < 16384 * 32) { pos = idx >> 5; f = idx & 31; base = 0.7498942093324559; dst = R64 + idx; }
    else { const int i2 = idx - 16384 * 32; pos = i2 >> 4; f = i2 & 15; base = 0.5623413251903491; dst = R32 + i2; }
    double inv = 1.0;
    for (int k = 0; k < f; ++k) inv *= base;
    const float ang = (float)pos * (float)inv;
    double tr = (double)ang * 0.15915494309189535;
    tr -= rint(tr);
    const float tf = (float)tr;
    *dst = make_float2(__builtin_amdgcn_cosf(tf), __builtin_amdgcn_sinf(tf));
  }
}

DI void fast_grid_barrier(unsigned* bar, unsigned nblk) {
  asm volatile("s_waitcnt vmcnt(0) lgkmcnt(0)" ::: "memory");
  __syncthreads();
  if (threadIdx.x == 0) {
    __builtin_amdgcn_fence(__ATOMIC_RELEASE, "agent");
    asm volatile("s_waitcnt vmcnt(0) lgkmcnt(0)" ::: "memory");
    const unsigned gen = __hip_atomic_load(&bar[64], __ATOMIC_RELAXED, __HIP_MEMORY_SCOPE_AGENT);
    const unsigned old = __hip_atomic_fetch_add(&bar[0], 1u, __ATOMIC_RELAXED, __HIP_MEMORY_SCOPE_AGENT);
    if (old == nblk - 1u) {
      __hip_atomic_store(&bar[0], 0u, __ATOMIC_RELAXED, __HIP_MEMORY_SCOPE_AGENT);
      __hip_atomic_fetch_add(&bar[64], 1u, __ATOMIC_RELEASE, __HIP_MEMORY_SCOPE_AGENT);
    } else {
      while (__hip_atomic_load(&bar[64], __ATOMIC_RELAXED, __HIP_MEMORY_SCOPE_AGENT) == gen) __builtin_amdgcn_s_sleep(1);
    }
    __builtin_amdgcn_fence(__ATOMIC_ACQUIRE, "agent");
    asm volatile("s_waitcnt vmcnt(0) lgkmcnt(0)" ::: "memory");
  }
  __syncthreads();
}

__global__ void __launch_bounds__(NTHR) __attribute__((amdgpu_waves_per_eu(2, 2))) mega(Params P) {
  extern __shared__ __attribute__((aligned(16))) char smem[];
  cg::grid_group grid = cg::this_grid();
  int phase = 0;
#define ACTIVE() (phase >= P.phase_lo && phase < P.phase_hi)
#define SEAM() do { ++phase; if (P.coop) { if (phase == 1) grid.sync(); else fast_grid_barrier((unsigned*)(P.ws + OFF_BAR), gridDim.x); } } while (0)
  u16* W = (u16*)(P.ws + OFF_W);
  u16* XN = (u16*)(P.ws + OFF_XN);
  u16* R2 = (u16*)(P.ws + OFF_R2);
  u16* qkv = (u16*)(P.ws + OFF_QKV);
  const float* Y = (const float*)(qkv + Q_Y);

  if (ACTIVE()) {
    rope_tables(P);
    convert_layer(P, 0);
    ew_phase(P, nullptr, 0.f, nullptr, P.norm_g, true);
  }
  SEAM();
  for (int l = 0; l < 4; ++l) {
    const float* g = P.norm_g + (size_t)l * 6 * DM;
    if (ACTIVE()) gemm_phase<M_FFNUP, 4>(W + W_WI, KP1, XN, KP1, DM, 22, smem, P, l);
    SEAM();
    if (ACTIVE()) gemm_phase<M_Y, 4>(W + W_WO, KP2, R2, KP2, DFF, 4, smem, P, l);
    SEAM();
    if (ACTIVE()) ew_phase(P, Y, 0.5f, g + DM, g + 2 * DM, false);
    SEAM();
    if (ACTIVE()) {
      gemm_phase<M_PROJ, 2>(W + W_WIN, KP1, XN, KP1, DM, 10, smem, P, l);
      gemm_phase<M_GATE, 4>(W + W_WIN + 2560ull * KP1, KP1, XN, KP1, DM, 16, smem, P, l);
    }
    SEAM();
    if (ACTIVE()) {
      gemm_phase<M_CUQ, 4>(W + W_WUQ, 384, qkv + Q_CQ, 384, 384, 2, smem, P, l);
      gemm_phase<M_CUKV, 4>(W + W_WUKV, 256, qkv + Q_CKV, 256, 256, 2, smem, P, l);
    }
    SEAM();
    if (ACTIVE()) attn_phase(P, l, smem);
    SEAM();
    if (ACTIVE()) gemm_phase<M_MERGE, 2>(W + W_WB, KP1, XN, KP1, DM, 4, smem, P, l);
    SEAM();
    if (ACTIVE()) gemm_phase<M_Y, 4>(W + W_WOUT, KP1, qkv + Q_MERGED, KP1, DM, 4, smem, P, l);
    SEAM();
    if (ACTIVE()) ew_phase(P, Y, 1.0f, g + 3 * DM, g + 4 * DM, false);
    SEAM();
    if (ACTIVE()) gemm_phase<M_FFNUP, 4>(W + W_WI + 5632ull * KP1, KP1, XN, KP1, DM, 22, smem, P, l);
    SEAM();
    if (ACTIVE()) gemm_phase<M_Y, 4>(W + W_WO + 1024ull * KP2, KP2, R2, KP2, DFF, 4, smem, P, l);
    SEAM();
    if (ACTIVE()) {
      ew_phase(P, Y, 0.5f, g + 5 * DM, l < 3 ? g + 6 * DM : nullptr, false);
      if (l < 3) convert_layer(P, l + 1);
    }
    SEAM();
  }
}

constexpr int N_PHASES = 1 + 12 * 4;

extern "C" void kernel_launch(void* const* d_in, const int* in_sizes, int n_in, void* d_out, int out_size, void* d_ws,
                              size_t ws_size, hipStream_t stream) {
  static int grid_blocks = 0;
  if (!grid_blocks) {
    int dev = 0, cus = 0, per_cu = 0;
    hipGetDevice(&dev);
    hipDeviceGetAttribute(&cus, hipDeviceAttributeMultiprocessorCount, dev);
    hipFuncSetAttribute((const void*)mega, hipFuncAttributeMaxDynamicSharedMemorySize, SMEM_BYTES);
    hipOccupancyMaxActiveBlocksPerMultiprocessor(&per_cu, mega, NTHR, SMEM_BYTES);
    if (per_cu < 1) per_cu = 1;
    grid_blocks = cus * per_cu;
  }
  if (ws_size < WS_NEEDED) fprintf(stderr, "workspace too small: %zu < %zu\n", ws_size, (size_t)WS_NEEDED);
  Params P{};
  P.x_prompt = (const float*)d_in[0]; P.x_sample = (const float*)d_in[1]; P.norm_g = (const float*)d_in[2];
  P.w_in = (const float*)d_in[3]; P.a_qk_norm = (const float*)d_in[4]; P.b_sink = (const float*)d_in[5];
  P.c_q_norm = (const float*)d_in[6]; P.c_kv_norm = (const float*)d_in[7]; P.c_w_uq = (const float*)d_in[8];
  P.c_w_ukv = (const float*)d_in[9]; P.d_lambda = (const float*)d_in[10]; P.d_subln = (const float*)d_in[11];
  P.w_branch = (const float*)d_in[12]; P.w_out = (const float*)d_in[13]; P.ffn_wi = (const float*)d_in[14];
  P.ffn_wo = (const float*)d_in[15];
  P.out = (float*)d_out; P.ws = (char*)d_ws;
#if MULTI_LAUNCH
  for (int ph = 0; ph < N_PHASES; ++ph) {
    P.phase_lo = ph; P.phase_hi = ph + 1; P.coop = 0; P.pad0 = 0;
    hipLaunchKernelGGL(mega, dim3(grid_blocks), dim3(NTHR), SMEM_BYTES, stream, P);
  }
#else
  P.phase_lo = 0; P.phase_hi = 1 << 30; P.coop = 1; P.pad0 = 0;
  hipMemsetAsync((char*)d_ws + OFF_BAR, 0, 1024, stream);
  void* args[] = {&P};
  hipError_t e = hipLaunchCooperativeKernel((const void*)mega, dim3(grid_blocks), dim3(NTHR), args, SMEM_BYTES, stream);
  if (e != hipSuccess) fprintf(stderr, "cooperative launch failed: %s (grid %d)\n", hipGetErrorString(e), grid_blocks);
#endif
}
```

```cpp
#include <hip/hip_runtime.h>
#include <hip/hip_cooperative_groups.h>
#include <cstdio>
#include <cstdint>
#include <type_traits>
namespace cg = cooperative_groups;

#ifndef MULTI_LAUNCH
#define MULTI_LAUNCH 0
#endif

#define DI __device__ __forceinline__
typedef unsigned short u16;
typedef __attribute__((ext_vector_type(8))) short bf16x8;
typedef __attribute__((ext_vector_type(16))) float f32x16;
typedef __attribute__((ext_vector_type(2))) float f32x2_t;
typedef __attribute__((ext_vector_type(2))) __bf16 bf16x2_t;

constexpr int T = 32768;
constexpr int DM = 1024;
constexpr int DFF = 2816;
constexpr int KP1 = 1088;
constexpr int KP2 = 2880;
constexpr int GP = 4160;
constexpr int YP = 1040;
constexpr int NPROJ = 6560;
constexpr int SEQ0 = 16384;
constexpr int DSEQ = 2048;
constexpr float EPS = 1e-6f;
constexpr int NTHR = 512;
constexpr int LSTR = 72;
constexpr int SMEM_BYTES = 2 * 2 * 256 * LSTR * 2;

constexpr size_t W_WI = 0;
constexpr size_t W_WO = W_WI + 2ull * 5632 * KP1;
constexpr size_t W_WIN = W_WO + 2ull * 1024 * KP2;
constexpr size_t W_WUQ = W_WIN + 6656ull * KP1;
constexpr size_t W_WUKV = W_WUQ + 512ull * 384;
constexpr size_t W_WB = W_WUKV + 512ull * 256;
constexpr size_t W_WOUT = W_WB + 1024ull * KP1;
constexpr size_t W_TOTAL = W_WOUT + 1024ull * KP1;

constexpr size_t OFF_W = 0;
constexpr size_t OFF_XN = OFF_W + W_TOTAL * 2;
constexpr size_t OFF_R2 = OFF_XN + (size_t)T * KP1 * 2;
constexpr size_t OFF_QKV = OFF_R2 + (size_t)T * GP * 2;
constexpr size_t OFF_SS = OFF_QKV + (size_t)T * 3456 * 2;
constexpr size_t OFF_R64 = OFF_SS + (size_t)T * 20 * 4;
constexpr size_t OFF_R32 = OFF_R64 + 16384ull * 32 * 8;
constexpr size_t OFF_DS = OFF_R32 + 16384ull * 16 * 8;
constexpr size_t OFF_BAR = OFF_DS + (size_t)T * 256 * 4;
constexpr size_t WS_NEEDED = OFF_BAR + 1024;

constexpr size_t Q_QA = 0;
constexpr size_t Q_KA = (size_t)T * 256;
constexpr size_t Q_VTA = (size_t)T * 384;
constexpr size_t Q_QB = (size_t)T * 512;
constexpr size_t Q_KB = (size_t)T * 768;
constexpr size_t Q_VTB = (size_t)T * 896;
constexpr size_t Q_CQ = (size_t)T * 1024;
constexpr size_t Q_CKV = (size_t)T * 1408;
constexpr size_t Q_QC = (size_t)T * 1664;
constexpr size_t Q_KC = (size_t)T * 2048;
constexpr size_t Q_VTC = (size_t)T * 2432;
constexpr size_t Q_QD = (size_t)T * 2688;
constexpr size_t Q_KD = (size_t)T * 2944;
constexpr size_t Q_VTD = (size_t)T * 3200;
constexpr size_t Q_MERGED = 0;
constexpr size_t Q_Y = (size_t)T * KP1;

struct Params {
  const float* x_prompt; const float* x_sample; const float* norm_g; const float* w_in;
  const float* a_qk_norm; const float* b_sink; const float* c_q_norm; const float* c_kv_norm;
  const float* c_w_uq; const float* c_w_ukv; const float* d_lambda; const float* d_subln;
  const float* w_branch; const float* w_out; const float* ffn_wi; const float* ffn_wo;
  float* out; char* ws;
  int phase_lo; int phase_hi; int coop; int pad0;
};

DI unsigned pk2(float a, float b) {
  f32x2_t v = {a, b};
  bf16x2_t r = __builtin_convertvector(v, bf16x2_t);
  return __builtin_bit_cast(unsigned, r);
}
DI u16 f2bf(float a) { return (u16)(pk2(a, 0.f) & 0xffffu); }
DI float bf2f(unsigned bits16) { return __uint_as_float(bits16 << 16); }
DI int crow(int v, int h) { return (v & 3) + 8 * (v >> 2) + 4 * h; }
DI int pos_of(int tok) { return tok < SEQ0 ? tok : ((tok - SEQ0) & (DSEQ - 1)); }
#define MFMA32(a, b, c) __builtin_amdgcn_mfma_f32_32x32x16_bf16((a), (b), (c), 0, 0, 0)

typedef __attribute__((ext_vector_type(4))) unsigned u32x4;
DI u32x4 gld16(const void* p) { u32x4 r; asm volatile("global_load_dwordx4 %0, %1, off" : "=v"(r) : "v"(p)); return r; }
DI void wait_vm0(u32x4& a) { asm volatile("s_waitcnt vmcnt(0)" : "+v"(a) :: "memory"); }
DI void wait_vm0(u32x4& a, u32x4& b) { asm volatile("s_waitcnt vmcnt(0)" : "+v"(a), "+v"(b) :: "memory"); }
DI void wait_vm0(u32x4& a, u32x4& b, u32x4& c) { asm volatile("s_waitcnt vmcnt(0)" : "+v"(a), "+v"(b), "+v"(c) :: "memory"); }
DI void wait_vm0(u32x4& a, u32x4& b, u32x4& c, u32x4& d) { asm volatile("s_waitcnt vmcnt(0)" : "+v"(a), "+v"(b), "+v"(c), "+v"(d) :: "memory"); }
DI u32x4 gld16s(unsigned voff, const void* sbase) { u32x4 r; asm volatile("global_load_dwordx4 %0, %1, %2" : "=v"(r) : "v"(voff), "s"(sbase)); return r; }
#define DEF_WAIT8(name, cnt) DI void name(u32x4& a, u32x4& b, u32x4& c, u32x4& d, u32x4& e, u32x4& f, u32x4& g, u32x4& h) { asm volatile("s_waitcnt vmcnt(" #cnt ")" : "+v"(a), "+v"(b), "+v"(c), "+v"(d), "+v"(e), "+v"(f), "+v"(g), "+v"(h) :: "memory"); }
#define DEF_WAIT6(name, cnt) DI void name(u32x4& a, u32x4& b, u32x4& c, u32x4& d, u32x4& e, u32x4& f) { asm volatile("s_waitcnt vmcnt(" #cnt ")" : "+v"(a), "+v"(b), "+v"(c), "+v"(d), "+v"(e), "+v"(f) :: "memory"); }
DEF_WAIT8(wait8_vm8, 8)
DEF_WAIT8(wait8_vm0, 0)
DEF_WAIT6(wait6_vm6, 6)
DEF_WAIT6(wait6_vm0, 0)
DI int opaque_tid() { int t = threadIdx.x; asm volatile("" : "+v"(t)); return t; }
DI float wave_sum(float v) {
#pragma unroll
  for (int m = 32; m >= 1; m >>= 1) v += __shfl_xor(v, m);
  return v;
}

DI void rope32_blk(f32x16& a, const float2* __restrict__ tab, int h) {
#pragma unroll
  for (int v = 0; v < 8; ++v) {
    float2 cs = tab[crow(v, h)];
    float x1 = a[v], x2 = a[v + 8];
    a[v] = x1 * cs.x - x2 * cs.y;
    a[v + 8] = x2 * cs.x + x1 * cs.y;
  }
}
DI void rope64_blk(f32x16& a0, f32x16& a1, const float2* __restrict__ tab, int h) {
#pragma unroll
  for (int v = 0; v < 16; ++v) {
    float2 cs = tab[crow(v, h)];
    float x1 = a0[v], x2 = a1[v];
    a0[v] = x1 * cs.x - x2 * cs.y;
    a1[v] = x2 * cs.x + x1 * cs.y;
  }
}
DI void store_rows(u16* __restrict__ base, int ld, int col0, const f32x16& a, int tok, int h) {
#pragma unroll
  for (int vq = 0; vq < 4; ++vq) {
    uint2 pk;
    pk.x = pk2(a[4 * vq], a[4 * vq + 1]);
    pk.y = pk2(a[4 * vq + 2], a[4 * vq + 3]);
    *(uint2*)(base + (size_t)tok * ld + col0 + 8 * vq + 4 * h) = pk;
  }
}
DI void store_T(u16* __restrict__ base, int row0, const f32x16& a, int tok, int h) {
  const int tp = (tok & ~12) | ((tok & 4) << 1) | ((tok & 8) >> 1);
#pragma unroll
  for (int v = 0; v < 16; ++v) base[(size_t)((row0 + crow(v, h)) >> 6) * 64 * T + (size_t)(tp >> 7) * 8192 + ((row0 + crow(v, h)) & 63) * 128 + (tp & 127)] = f2bf(a[v]);
}

enum { M_FFNUP = 0, M_Y = 1, M_PROJ = 2, M_CUQ = 3, M_CUKV = 4, M_MERGE = 5, M_GATE = 6 };

template <int MODE, int NJ>
DI void gemm_epilogue(f32x16 (&acc)[2][NJ], int fbase, int tbase, int r, int h, const Params& P, int layer) {
  char* ws = P.ws;
  u16* qkv = (u16*)(ws + OFF_QKV);
  const float2* R64 = (const float2*)(ws + OFF_R64);
  const float2* R32 = (const float2*)(ws + OFF_R32);
  float* SS = (float*)(ws + OFF_SS);
  if constexpr (MODE == M_FFNUP) {
    u16* H = (u16*)(ws + OFF_R2);
    const int hf0 = (fbase >> 6) * 32;
#pragma unroll
    for (int j = 0; j < NJ; ++j) {
      const int tok = tbase + j * 32 + r;
      f32x16 o;
#pragma unroll
      for (int v = 0; v < 16; ++v) {
        float g = acc[0][j][v], u = acc[1][j][v];
        o[v] = g * __builtin_amdgcn_rcpf(1.f + __builtin_amdgcn_exp2f(-1.4426950408889634f * g)) * u;
      }
      store_rows(H, KP2, hf0, o, tok, h);
    }
  } else if constexpr (MODE == M_Y) {
    float* Y = (float*)(qkv + Q_Y);
#pragma unroll
    for (int j = 0; j < NJ; ++j) {
      const int tok = tbase + j * 32 + r;
#pragma unroll
      for (int i = 0; i < 2; ++i)
#pragma unroll
        for (int vq = 0; vq < 4; ++vq) {
          float4 o = {acc[i][j][4 * vq], acc[i][j][4 * vq + 1], acc[i][j][4 * vq + 2], acc[i][j][4 * vq + 3]};
          *(float4*)(Y + (size_t)tok * YP + fbase + i * 32 + 8 * vq + 4 * h) = o;
        }
    }
  } else if constexpr (MODE == M_PROJ) {
    if (fbase < 384) {
      const bool isK = fbase >= 256;
      const float* g = P.a_qk_norm + layer * 128 + (isK ? 64 : 0);
      u16* dst = qkv + (isK ? Q_KA : Q_QA);
      const int ld = isK ? 128 : 256;
      const int c0 = isK ? fbase - 256 : fbase;
      float gv[2][16];
#pragma unroll
      for (int i = 0; i < 2; ++i)
#pragma unroll
        for (int v = 0; v < 16; ++v) gv[i][v] = g[i * 32 + crow(v, h)];
#pragma unroll
      for (int j = 0; j < NJ; ++j) {
        const int tok = tbase + j * 32 + r;
        const int pos = pos_of(tok);
        float ss = 0.f;
#pragma unroll
        for (int i = 0; i < 2; ++i)
#pragma unroll
          for (int v = 0; v < 16; ++v) ss += acc[i][j][v] * acc[i][j][v];
        ss += __shfl_xor(ss, 32);
        const float rs = rsqrtf(ss * (1.f / 64.f) + EPS);
#pragma unroll
        for (int i = 0; i < 2; ++i)
#pragma unroll
          for (int v = 0; v < 16; ++v) acc[i][j][v] *= rs * gv[i][v];
        rope32_blk(acc[0][j], R32 + (size_t)(pos >> 6) * 16, h);
        rope32_blk(acc[1][j], R32 + (size_t)(pos & 63) * 16, h);
        store_rows(dst, ld, c0, acc[0][j], tok, h);
        store_rows(dst, ld, c0 + 32, acc[1][j], tok, h);
      }
    } else if (fbase < 512) {
#pragma unroll
      for (int j = 0; j < NJ; ++j) {
        const int tok = tbase + j * 32 + r;
        store_T(qkv + Q_VTA, fbase - 384, acc[0][j], tok, h);
        store_T(qkv + Q_VTA, fbase - 384 + 32, acc[1][j], tok, h);
      }
    } else if (fbase < 896) {
      const bool isK = fbase >= 768;
      u16* dst = qkv + (isK ? Q_KB : Q_QB);
      const int ld = isK ? 128 : 256;
      const int c0 = isK ? fbase - 768 : fbase - 512;
#pragma unroll
      for (int j = 0; j < NJ; ++j) {
        const int tok = tbase + j * 32 + r;
        const int pos = pos_of(tok);
        rope64_blk(acc[0][j], acc[1][j], R64 + (size_t)pos * 32, h);
        store_rows(dst, ld, c0, acc[0][j], tok, h);
        store_rows(dst, ld, c0 + 32, acc[1][j], tok, h);
      }
    } else if (fbase < 1024) {
#pragma unroll
      for (int j = 0; j < NJ; ++j) {
        const int tok = tbase + j * 32 + r;
        store_T(qkv + Q_VTB, fbase - 896, acc[0][j], tok, h);
        store_T(qkv + Q_VTB, fbase - 896 + 32, acc[1][j], tok, h);
      }
    } else if (fbase < 1664) {
      const bool isKV = fbase >= 1408;
      u16* dst = qkv + (isKV ? Q_CKV : Q_CQ);
      const int ld = isKV ? 256 : 384;
      const int c0 = isKV ? fbase - 1408 : fbase - 1024;
      const int sb = (isKV ? 12 : 0) + (c0 >> 5);
#pragma unroll
      for (int j = 0; j < NJ; ++j) {
        const int tok = tbase + j * 32 + r;
#pragma unroll
        for (int i = 0; i < 2; ++i) {
          float ss = 0.f;
#pragma unroll
          for (int v = 0; v < 16; ++v) ss += acc[i][j][v] * acc[i][j][v];
          ss += __shfl_xor(ss, 32);
          if (h == 0) SS[(size_t)tok * 20 + sb + i] = ss;
          store_rows(dst, ld, c0 + i * 32, acc[i][j], tok, h);
        }
      }
    } else if (fbase < 2176) {
      const bool isK = fbase >= 1920;
      u16* dst = qkv + (isK ? Q_KD : Q_QD);
      const int c0 = isK ? fbase - 1920 : fbase - 1664;
#pragma unroll
      for (int j = 0; j < NJ; ++j) {
        const int tok = tbase + j * 32 + r;
        const int pos = pos_of(tok);
#pragma unroll
        for (int i = 0; i < 2; ++i) {
          rope32_blk(acc[i][j], R32 + (size_t)pos * 16, h);
          store_rows(dst, 256, c0 + i * 32, acc[i][j], tok, h);
        }
      }
    } else if (fbase < 2432) {
#pragma unroll
      for (int j = 0; j < NJ; ++j) {
        const int tok = tbase + j * 32 + r;
        store_T(qkv + Q_VTD, fbase - 2176, acc[0][j], tok, h);
        store_T(qkv + Q_VTD, fbase - 2176 + 32, acc[1][j], tok, h);
      }
    } else if (fbase == 2432) {
#pragma unroll
      for (int j = 0; j < NJ; ++j) {
        const int tok = tbase + j * 32 + r;
        const int pos = pos_of(tok);
        rope32_blk(acc[0][j], R32 + (size_t)pos * 16, h);
#pragma unroll
        for (int hd = 0; hd < 4; ++hd) store_rows(qkv + Q_KC, 384, hd * 96 + 64, acc[0][j], tok, h);
      }
    }
  } else if constexpr (MODE == M_GATE) {
    u16* G = (u16*)(ws + OFF_R2);
#pragma unroll
    for (int j = 0; j < NJ; ++j) {
      const int tok = tbase + j * 32 + r;
#pragma unroll
      for (int i = 0; i < 2; ++i) {
        f32x16 o;
#pragma unroll
        for (int v = 0; v < 16; ++v) o[v] = __builtin_amdgcn_rcpf(1.f + __builtin_amdgcn_exp2f(-1.4426950408889634f * acc[i][j][v]));
        store_rows(G, GP, fbase + i * 32, o, tok, h);
      }
    }
  } else if constexpr (MODE == M_CUQ) {
    if (fbase >= 384) return;
#pragma unroll
    for (int j = 0; j < NJ; ++j) {
      const int tok = tbase + j * 32 + r;
      const int pos = pos_of(tok);
      float ss = 0.f;
#pragma unroll
      for (int b = 0; b < 12; ++b) ss += SS[(size_t)tok * 20 + b];
      const float rs = rsqrtf(ss * (1.f / 384.f) + EPS);
#pragma unroll
      for (int i = 0; i < 2; ++i) {
        const int blk = (fbase >> 5) + i;
#pragma unroll
        for (int v = 0; v < 16; ++v) acc[i][j][v] *= rs;
        if (blk % 3 == 2) rope32_blk(acc[i][j], R32 + (size_t)pos * 16, h);
        store_rows(qkv + Q_QC, 384, blk * 32, acc[i][j], tok, h);
      }
    }
  } else if constexpr (MODE == M_CUKV) {
#pragma unroll
    for (int j = 0; j < NJ; ++j) {
      const int tok = tbase + j * 32 + r;
      float ss = 0.f;
#pragma unroll
      for (int b = 0; b < 8; ++b) ss += SS[(size_t)tok * 20 + 12 + b];
      const float rs = rsqrtf(ss * (1.f / 256.f) + EPS);
#pragma unroll
      for (int i = 0; i < 2; ++i) {
        const int blk = (fbase >> 5) + i;
        const int hd = blk >> 2, q = blk & 3;
#pragma unroll
        for (int v = 0; v < 16; ++v) acc[i][j][v] *= rs;
        if (q < 2) store_rows(qkv + Q_KC, 384, hd * 96 + q * 32, acc[i][j], tok, h);
        else store_T(qkv + Q_VTC, hd * 64 + (q - 2) * 32, acc[i][j], tok, h);
      }
    }
  } else if constexpr (MODE == M_MERGE) {
#pragma unroll
    for (int j = 0; j < NJ; ++j) {
      const int tok = tbase + j * 32 + r;
      store_rows(qkv + Q_MERGED, KP1, fbase, acc[0][j], tok, h);
      store_rows(qkv + Q_MERGED, KP1, fbase + 32, acc[1][j], tok, h);
    }
  }
}

typedef __attribute__((address_space(3))) unsigned lds_u32_t;
typedef __attribute__((address_space(1))) const unsigned glb_u32_t;
template <int MODE, int NJ>
DI void gemm_tile(const u16* __restrict__ Wt, int ldw, const u16* __restrict__ X, int ldx, int K, int f0, int t0, char* smem,
                  const Params& P, int layer) {
  constexpr int XROWS = NJ * 64;
  constexpr int WSTG = 256 * 64, XSTG = XROWS * 64;
  u16* sW = (u16*)smem;
  u16* sX = sW + 2 * WSTG;
  const int tid = opaque_tid(), lane = tid & 63, wave = tid >> 6, r = lane & 31, h = lane >> 5;
  const int wf = wave & 3, wt = wave >> 2;
  f32x16 acc[2][NJ];
  f32x16 tot[2][MODE == M_MERGE ? NJ : 1];
#pragma unroll
  for (int i = 0; i < 2; ++i)
#pragma unroll
    for (int j = 0; j < NJ; ++j)
#pragma unroll
      for (int v = 0; v < 16; ++v) acc[i][j][v] = 0.f;
  if constexpr (MODE == M_MERGE) {
#pragma unroll
    for (int i = 0; i < 2; ++i)
#pragma unroll
      for (int j = 0; j < NJ; ++j)
#pragma unroll
        for (int v = 0; v < 16; ++v) tot[i][j][v] = 0.f;
  }
  const int nk = K >> 6;
  const int srow = tid >> 3;
  const int schunk = (tid & 7) ^ ((tid >> 4) & 7);
  const u16* wp = Wt + (size_t)(f0 + srow) * ldw + schunk * 8;
  const u16* xp = X + (size_t)(t0 + srow) * ldx + schunk * 8;
  const int fbase = f0 + wf * 64, tbase = t0 + wt * (NJ * 32);

  auto issue = [&](int kt, int buf) {
#pragma unroll
    for (int i = 0; i < 4; ++i)
      __builtin_amdgcn_global_load_lds((glb_u32_t*)(wp + (size_t)(i * 64) * ldw + kt * 64),
                                       (lds_u32_t*)(sW + buf * WSTG + i * 4096 + tid * 8), 16, 0, 0);
#pragma unroll
    for (int i = 0; i < NJ; ++i)
      __builtin_amdgcn_global_load_lds((glb_u32_t*)(xp + (size_t)(i * 64) * ldx + kt * 64),
                                       (lds_u32_t*)(sX + buf * XSTG + i * 4096 + tid * 8), 16, 0, 0);
  };
  const int swz = (r >> 1) & 7;
  auto compute = [&](int buf, int kt) {
    const u16* aW = sW + buf * WSTG + (wf * 64 + r) * 64;
    const u16* aX = sX + buf * XSTG + (wt * (NJ * 32) + r) * 64;
#pragma unroll
    for (int ks = 0; ks < 4; ++ks) {
      const int co = ((2 * ks + h) ^ swz) * 8;
      bf16x8 wfrag[2], xfrag[NJ];
#pragma unroll
      for (int i = 0; i < 2; ++i) wfrag[i] = *(const bf16x8*)(aW + i * 32 * 64 + co);
#pragma unroll
      for (int j = 0; j < NJ; ++j) xfrag[j] = *(const bf16x8*)(aX + j * 32 * 64 + co);
#pragma unroll
      for (int i = 0; i < 2; ++i)
#pragma unroll
        for (int j = 0; j < NJ; ++j) acc[i][j] = MFMA32(wfrag[i], xfrag[j], acc[i][j]);
    }
    if constexpr (MODE == M_MERGE) {
      if ((kt & 3) == 3) {
        const int br = kt >> 2;
        const u16* G = (const u16*)(P.ws + OFF_R2);
#pragma unroll
        for (int j = 0; j < NJ; ++j) {
          const int tok = tbase + j * 32 + r;
#pragma unroll
          for (int i = 0; i < 2; ++i)
#pragma unroll
            for (int vq = 0; vq < 4; ++vq) {
              uint2 gp = *(const uint2*)(G + (size_t)tok * GP + br * 1024 + fbase + i * 32 + 8 * vq + 4 * h);
              tot[i][j][4 * vq + 0] += bf2f(gp.x & 0xffffu) * acc[i][j][4 * vq + 0];
              tot[i][j][4 * vq + 1] += bf2f(gp.x >> 16) * acc[i][j][4 * vq + 1];
              tot[i][j][4 * vq + 2] += bf2f(gp.y & 0xffffu) * acc[i][j][4 * vq + 2];
              tot[i][j][4 * vq + 3] += bf2f(gp.y >> 16) * acc[i][j][4 * vq + 3];
              acc[i][j][4 * vq + 0] = 0.f; acc[i][j][4 * vq + 1] = 0.f;
              acc[i][j][4 * vq + 2] = 0.f; acc[i][j][4 * vq + 3] = 0.f;
            }
        }
      }
    }
  };

  issue(0, 0);
  asm volatile("s_waitcnt vmcnt(0)" ::: "memory");
  __syncthreads();
  for (int kt = 0; kt < nk; ++kt) {
    const int buf = kt & 1;
    if (kt + 1 < nk) issue(kt + 1, buf ^ 1);
    compute(buf, kt);
    asm volatile("s_waitcnt vmcnt(0) lgkmcnt(0)" ::: "memory");
    __syncthreads();
  }
  if constexpr (MODE == M_MERGE) gemm_epilogue<MODE, NJ>(tot, fbase, tbase, r, h, P, layer);
  else gemm_epilogue<MODE, NJ>(acc, fbase, tbase, r, h, P, layer);
}

template <int MODE, int NJ>
DI void gemm_phase(const u16* Wt, int ldw, const u16* X, int ldx, int K, int nF, char* smem, const Params& P, int layer) {
  constexpr int TT = NJ * 64;
  const int nT = T / TT;
  const int ntiles = nF * nT;
  for (int idx = blockIdx.x; idx < ntiles; idx += gridDim.x) {
    const int tt_lo = idx & 15;
    const int rest = idx >> 4;
    const int ft = rest % nF;
    const int tt = (rest / nF) * 16 + tt_lo;
    gemm_tile<MODE, NJ>(Wt, ldw, X, ldx, K, ft * 256, tt * TT, smem, P, layer);
  }
}

template <int DQK, int NCOMP, bool BAND, int EPI>
DI void attn_item(const u16* __restrict__ Q, int ldq, const u16* __restrict__ Kp, int ldk, const u16* __restrict__ Vt,
                  int qtok0, int kbeg, int kend, float sc_l2, float sink_l2, float lam, float onorm,
                  const float* __restrict__ subg, u16* __restrict__ O, float* __restrict__ DS, char* smem) {
  constexpr int DC = DQK / NCOMP;
  constexpr int KS = DC / 16;
  constexpr int KEYS = (NCOMP == 1) ? 128 : 64;
  constexpr int KSTR = DQK + 8, VSTR = KEYS + 8;
  constexpr int KCH = DQK / 8, VCH = KEYS / 8;
  constexpr int NKC = KEYS * KCH / NTHR, NVC = 64 * VCH / NTHR;
  constexpr int KSLOT = KEYS * KSTR, VSLOT = 64 * VSTR;
  u16* sK = (u16*)smem;
  u16* sV = sK + 3 * KSLOT;
  const int tid = opaque_tid(), lane = tid & 63, wave = tid >> 6, r = lane & 31, h = lane >> 5;
  const int qtok = qtok0 + wave * 32 + r;

  bf16x8 qf[NCOMP][KS];
#pragma unroll
  for (int c = 0; c < NCOMP; ++c)
#pragma unroll
    for (int ks = 0; ks < KS; ++ks) qf[c][ks] = *(const bf16x8*)(Q + (size_t)qtok * ldq + c * DC + ks * 16 + 8 * h);

  f32x16 Oa[NCOMP][2];
  float m[NCOMP], l[NCOMP];
#pragma unroll
  for (int c = 0; c < NCOMP; ++c) {
#pragma unroll
    for (int d = 0; d < 2; ++d)
#pragma unroll
      for (int v = 0; v < 16; ++v) Oa[c][d][v] = 0.f;
    m[c] = BAND ? sink_l2 : -1e30f;
    l[c] = (BAND && h == 0) ? 1.f : 0.f;
  }

  const u16* kg[NKC]; int kso[NKC];
#pragma unroll
  for (int i = 0; i < NKC; ++i) {
    const int c = tid + i * NTHR;
    const int row = c / KCH, cc = c % KCH;
    kg[i] = Kp + (size_t)(kbeg + row) * ldk + cc * 8;
    kso[i] = row * KSTR + cc * 8;
  }
  const u16* vg[NVC]; int vso[NVC];
#pragma unroll
  for (int i = 0; i < NVC; ++i) {
    const int c = tid + i * NTHR;
    const int row = c / VCH, cc = c % VCH;
    vg[i] = Vt + (size_t)(kbeg >> 7) * 8192 + row * 128 + cc * 8;
    vso[i] = row * VSTR + cc * 8;
  }
  u32x4 kreg[NKC], vreg[NVC];
  auto loadK = [&](int t) {
#pragma unroll
    for (int i = 0; i < NKC; ++i) kreg[i] = gld16(kg[i] + (size_t)t * KEYS * ldk);
  };
  auto loadV = [&](int t) {
#pragma unroll
    for (int i = 0; i < NVC; ++i) vreg[i] = gld16(vg[i] + (size_t)t * 8192);
  };
  auto waitK = [&]() {
    if constexpr (NKC == 1) wait_vm0(kreg[0]);
    else if constexpr (NKC == 2) wait_vm0(kreg[0], kreg[1]);
    else wait_vm0(kreg[0], kreg[1], kreg[2]);
  };
  auto waitV = [&]() {
    if constexpr (NVC == 1) wait_vm0(vreg[0]);
    else wait_vm0(vreg[0], vreg[1]);
  };
  auto storeK = [&](int slot) {
#pragma unroll
    for (int i = 0; i < NKC; ++i) *(u32x4*)(sK + slot * KSLOT + kso[i]) = kreg[i];
  };
  auto storeV = [&](int slot) {
#pragma unroll
    for (int i = 0; i < NVC; ++i) *(u32x4*)(sV + slot * VSLOT + vso[i]) = vreg[i];
  };

  f32x16 S0[2], S1[2];
  bf16x8 pfA[2][2], pfB[2][2];
  float alpha_pend = 1.f;
  bool need_pend = false;

  auto att_S = [&](auto uu_t, f32x16 (&S)[2], int slot) {
    constexpr int UU = decltype(uu_t)::value;
    constexpr int C = (NCOMP == 2) ? UU : 0;
    const u16* base = sK + slot * KSLOT + ((NCOMP == 1 ? UU * 64 : 0) + r) * KSTR + (NCOMP == 2 ? UU * DC : 0) + 8 * h;
#pragma unroll
    for (int kb = 0; kb < 2; ++kb) {
#pragma unroll
      for (int v = 0; v < 16; ++v) S[kb][v] = 0.f;
#pragma unroll
      for (int ks = 0; ks < KS; ++ks) {
        bf16x8 kf = *(const bf16x8*)(base + kb * 32 * KSTR + ks * 16);
        S[kb] = MFMA32(kf, qf[C][ks], S[kb]);
      }
    }
  };
  auto att_PV = [&](auto uu_t, const bf16x8 (&pf)[2][2], int slot) {
    constexpr int UU = decltype(uu_t)::value;
    constexpr int C = (NCOMP == 2) ? UU : 0;
    const u16* base = sV + slot * VSLOT + r * VSTR + (NCOMP == 1 ? UU * 64 : 0) + 8 * h;
#pragma unroll
    for (int d = 0; d < 2; ++d)
#pragma unroll
      for (int kb = 0; kb < 2; ++kb)
#pragma unroll
        for (int s = 0; s < 2; ++s) {
          bf16x8 vf = *(const bf16x8*)(base + d * 32 * VSTR + kb * 32 + 16 * s);
          Oa[C][d] = MFMA32(vf, pf[kb][s], Oa[C][d]);
        }
  };
  auto att_rescale = [&](auto uu_t) {
    constexpr int UU = decltype(uu_t)::value;
    constexpr int C = (NCOMP == 2) ? UU : 0;
    if (need_pend) {
#pragma unroll
      for (int d = 0; d < 2; ++d)
#pragma unroll
        for (int v = 0; v < 16; ++v) Oa[C][d][v] *= alpha_pend;
    }
  };
  auto att_softmax = [&](auto uu_t, f32x16 (&S)[2], bf16x8 (&pf)[2][2], int kpos0) {
    constexpr int UU = decltype(uu_t)::value;
    constexpr int C = (NCOMP == 2) ? UU : 0;
    if constexpr (BAND) {
#pragma unroll
      for (int kb = 0; kb < 2; ++kb)
#pragma unroll
        for (int v = 0; v < 16; ++v) {
          const int d = kpos0 + kb * 32 + crow(v, h) - qtok;
          if (d > 128 || d < -128) S[kb][v] = -1e30f;
        }
    }
    float mx = S[0][0];
#pragma unroll
    for (int kb = 0; kb < 2; ++kb)
#pragma unroll
      for (int v = 0; v < 16; ++v) mx = fmaxf(mx, S[kb][v]);
    mx = fmaxf(mx, __shfl_xor(mx, 32));
    const float mold = m[C];
    const float mnew = fmaxf(mold, mx * sc_l2);
    need_pend = __builtin_amdgcn_ballot_w64(mnew > mold) != 0;
    alpha_pend = __builtin_amdgcn_exp2f(mold - mnew);
    m[C] = mnew;
    float rsum = 0.f;
#pragma unroll
    for (int kb = 0; kb < 2; ++kb)
#pragma unroll
      for (int v = 0; v < 16; ++v) {
        float p = __builtin_amdgcn_exp2f(__builtin_fmaf(S[kb][v], sc_l2, -mnew));
        S[kb][v] = p;
        rsum += p;
      }
    l[C] = l[C] * alpha_pend + rsum;
#pragma unroll
    for (int kb = 0; kb < 2; ++kb)
#pragma unroll
      for (int s = 0; s < 2; ++s) {
        u32x4 pk;
        pk.x = pk2(S[kb][8 * s + 0], S[kb][8 * s + 1]);
        pk.y = pk2(S[kb][8 * s + 2], S[kb][8 * s + 3]);
        pk.z = pk2(S[kb][8 * s + 4], S[kb][8 * s + 5]);
        pk.w = pk2(S[kb][8 * s + 6], S[kb][8 * s + 7]);
        pf[kb][s] = __builtin_bit_cast(bf16x8, pk);
      }
  };
  using U0 = std::integral_constant<int, 0>;
  using U1 = std::integral_constant<int, 1>;

  const int ntl = (kend - kbeg) / KEYS;
  auto step = [&](auto first_t, auto lk_t, auto lv_t, int t, int sa, int sb, int sc) {
    constexpr bool FIRST = decltype(first_t)::value, LK = decltype(lk_t)::value, LV = decltype(lv_t)::value;
    if constexpr (LK) loadK(t + 2);
    if constexpr (LV) loadV(t + 1);
    if constexpr (!FIRST) att_rescale(U1{});
    att_S(U1{}, S1, sa);
    if constexpr (!FIRST) att_PV(U1{}, pfB, sc);
    att_softmax(U0{}, S0, pfA, kbeg + t * KEYS);
    att_rescale(U0{});
    if constexpr (LV) att_S(U0{}, S0, sb);
    att_PV(U0{}, pfA, sa);
    att_softmax(U1{}, S1, pfB, kbeg + t * KEYS + 64);
    if constexpr (LK) { waitK(); storeK(sc); }
    if constexpr (LV) { waitV(); storeV(sb); }
    __syncthreads();
  };
  using TT = std::true_type;
  using FF = std::false_type;

  loadK(0); loadV(0);
  waitK(); waitV();
  storeK(0); storeV(0);
  loadK(1);
  waitK();
  storeK(1);
  __syncthreads();
  att_S(U0{}, S0, 0);
  int sa = 0, sb = 1, sc = 2;
  step(TT{}, TT{}, TT{}, 0, sa, sb, sc);
  { int tmp = sa; sa = sb; sb = sc; sc = tmp; }
  for (int t = 1; t < ntl - 2; ++t) {
    step(FF{}, TT{}, TT{}, t, sa, sb, sc);
    int tmp = sa; sa = sb; sb = sc; sc = tmp;
  }
  step(FF{}, FF{}, TT{}, ntl - 2, sa, sb, sc);
  { int tmp = sa; sa = sb; sb = sc; sc = tmp; }
  step(FF{}, FF{}, FF{}, ntl - 1, sa, sb, sc);
  att_rescale(U1{});
  att_PV(U1{}, pfB, sa);

  float inv[NCOMP];
#pragma unroll
  for (int c = 0; c < NCOMP; ++c) {
    float lt = l[c] + __shfl_xor(l[c], 32);
    inv[c] = 1.f / lt;
  }
  if constexpr (EPI == 1) {
#pragma unroll
    for (int d = 0; d < 2; ++d)
#pragma unroll
      for (int vq = 0; vq < 4; ++vq) {
        float4 o = {Oa[0][d][4 * vq] * inv[0], Oa[0][d][4 * vq + 1] * inv[0], Oa[0][d][4 * vq + 2] * inv[0], Oa[0][d][4 * vq + 3] * inv[0]};
        *(float4*)(DS + (size_t)qtok * 256 + d * 32 + 8 * vq + 4 * h) = o;
      }
  } else {
    if constexpr (EPI == 2) {
      float ss = 0.f;
#pragma unroll
      for (int d = 0; d < 2; ++d)
#pragma unroll
        for (int vq = 0; vq < 4; ++vq) {
          const float4 o1 = *(const float4*)(DS + (size_t)qtok * 256 + d * 32 + 8 * vq + 4 * h);
          const float a0 = o1.x - lam * Oa[0][d][4 * vq] * inv[0];
          const float a1 = o1.y - lam * Oa[0][d][4 * vq + 1] * inv[0];
          const float a2 = o1.z - lam * Oa[0][d][4 * vq + 2] * inv[0];
          const float a3 = o1.w - lam * Oa[0][d][4 * vq + 3] * inv[0];
          Oa[0][d][4 * vq] = a0; Oa[0][d][4 * vq + 1] = a1; Oa[0][d][4 * vq + 2] = a2; Oa[0][d][4 * vq + 3] = a3;
          ss += a0 * a0 + a1 * a1 + a2 * a2 + a3 * a3;
        }
      ss += __shfl_xor(ss, 32);
      const float rs = rsqrtf(ss * (1.f / 64.f) + EPS) * onorm;
#pragma unroll
      for (int d = 0; d < 2; ++d)
#pragma unroll
        for (int v = 0; v < 16; ++v) Oa[0][d][v] *= rs * subg[d * 32 + crow(v, h)];
    } else {
#pragma unroll
      for (int d = 0; d < 2; ++d)
#pragma unroll
        for (int v = 0; v < 16; ++v) Oa[0][d][v] *= inv[0];
    }
    store_rows(O, KP1, 0, Oa[0][0], qtok, h);
    store_rows(O, KP1, 32, Oa[0][1], qtok, h);
  }
  __syncthreads();
}

DI void attn_phase(const Params& P, int layer, char* smem) {
  char* ws = P.ws;
  u16* qkv = (u16*)(ws + OFF_QKV);
  u16* BR = (u16*)(ws + OFF_XN);
  const float L2E = 1.4426950408889634f;
  const float lambda_init = 0.8f - 0.6f * __expf(-0.3f * (float)layer);
  float lam;
  {
    const float* dl = P.d_lambda + layer * 128;
    float s1 = 0.f, s2 = 0.f;
    for (int i = 0; i < 32; ++i) { s1 += dl[i] * dl[32 + i]; s2 += dl[64 + i] * dl[96 + i]; }
    lam = __expf(s1) - __expf(s2) + lambda_init;
  }
  for (int it = blockIdx.x; it < 2048; it += gridDim.x) {
    const int cls = it >> 8;
    if (cls < 6) {
      const int idx = it & 255;
      const int head = (idx & 7) >> 1;
      const int qb = ((idx >> 3) << 1) + (idx & 1);
      int qtok0, kbeg, kend;
      if (cls < 3) { qtok0 = qb * 256; kbeg = 0; kend = SEQ0; }
      else { const int s = qb >> 3; kbeg = SEQ0 + s * DSEQ; kend = kbeg + DSEQ; qtok0 = kbeg + (qb & 7) * 256; }
      const int typ = cls % 3;
      if (typ == 0) {
        float* DS = (float*)(ws + OFF_DS) + head * 64;
        attn_item<32, 1, false, 1>(qkv + Q_QD + head * 64, 256, qkv + Q_KD + head * 64, 256,
                                   qkv + Q_VTD + (size_t)head * 64 * T, qtok0, kbeg, kend,
                                   0.17677669529663687f * L2E, 0.f, lam, 1.f - lambda_init,
                                   P.d_subln + layer * 64, BR + 768 + head * 64, DS, smem);
        attn_item<32, 1, false, 2>(qkv + Q_QD + head * 64 + 32, 256, qkv + Q_KD + head * 64 + 32, 256,
                                   qkv + Q_VTD + (size_t)head * 64 * T, qtok0, kbeg, kend,
                                   0.17677669529663687f * L2E, 0.f, lam, 1.f - lambda_init,
                                   P.d_subln + layer * 64, BR + 768 + head * 64, DS, smem);
      } else if (typ == 1) {
        attn_item<96, 1, false, 0>(qkv + Q_QC + head * 96, 384, qkv + Q_KC + head * 96, 384,
                                       qkv + Q_VTC + (size_t)head * 64 * T, qtok0, kbeg, kend,
                                       0.10206207261596577f * L2E, 0.f, 0.f, 1.f, nullptr, BR + 512 + head * 64, nullptr, smem);
      } else {
        attn_item<64, 1, false, 0>(qkv + Q_QA + head * 64, 256, qkv + Q_KA + (head >> 1) * 64, 128,
                                       qkv + Q_VTA + (size_t)(head >> 1) * 64 * T, qtok0, kbeg, kend,
                                       0.125f * L2E, 0.f, 0.f, 1.f, nullptr, BR + head * 64, nullptr, smem);
      }
    } else {
      const int idx = it - 1536;
      const int head = (idx & 7) >> 1;
      const int qbg = ((idx >> 3) << 1) + (idx & 1);
      const int qtok0 = qbg * 256;
      int sb, se;
      if (qtok0 < SEQ0) { sb = 0; se = SEQ0; }
      else { sb = SEQ0 + ((qtok0 - SEQ0) / DSEQ) * DSEQ; se = sb + DSEQ; }
      const int kbeg = max(sb, qtok0 - 128), kend = min(se, qtok0 + 256 + 128);
      const float sink = P.b_sink[layer * 4 + head];
      attn_item<64, 1, true, 0>(qkv + Q_QB + head * 64, 256, qkv + Q_KB + (head >> 1) * 64, 128,
                                    qkv + Q_VTB + (size_t)(head >> 1) * 64 * T, qtok0, kbeg, kend,
                                    0.125f * L2E, sink * L2E, 0.f, 1.f, nullptr, BR + 256 + head * 64, nullptr, smem);
    }
  }
}

DI void ew_phase(const Params& P, const float* __restrict__ Y, float coef, const float* __restrict__ gpost,
                 const float* __restrict__ gnext, bool from_inputs) {
  const int tid = opaque_tid();
  const int lane = tid & 63, wave = tid >> 6;
  u16* XN = (u16*)(P.ws + OFF_XN);
  for (int tok = blockIdx.x * 8 + wave; tok < T; tok += gridDim.x * 8) {
    const float* xs = from_inputs ? (tok < SEQ0 ? P.x_prompt + (size_t)tok * DM : P.x_sample + (size_t)(tok - SEQ0) * DM)
                                  : P.out + (size_t)tok * DM;
    float4 x[4];
#pragma unroll
    for (int i = 0; i < 4; ++i) x[i] = *(const float4*)(xs + (i * 64 + lane) * 4);
    if (Y) {
      float4 y[4];
      float ss = 0.f;
#pragma unroll
      for (int i = 0; i < 4; ++i) {
        y[i] = *(const float4*)(Y + (size_t)tok * YP + (i * 64 + lane) * 4);
        ss += y[i].x * y[i].x + y[i].y * y[i].y + y[i].z * y[i].z + y[i].w * y[i].w;
      }
      ss = wave_sum(ss);
      const float rs = rsqrtf(ss * (1.f / 1024.f) + EPS) * coef;
#pragma unroll
      for (int i = 0; i < 4; ++i) {
        float4 g = *(const float4*)(gpost + (i * 64 + lane) * 4);
        x[i].x += y[i].x * rs * g.x; x[i].y += y[i].y * rs * g.y;
        x[i].z += y[i].z * rs * g.z; x[i].w += y[i].w * rs * g.w;
      }
    }
#pragma unroll
    for (int i = 0; i < 4; ++i) *(float4*)(P.out + (size_t)tok * DM + (i * 64 + lane) * 4) = x[i];
    if (gnext) {
      float ss = 0.f;
#pragma unroll
      for (int i = 0; i < 4; ++i) ss += x[i].x * x[i].x + x[i].y * x[i].y + x[i].z * x[i].z + x[i].w * x[i].w;
      ss = wave_sum(ss);
      const float rs = rsqrtf(ss * (1.f / 1024.f) + EPS);
#pragma unroll
      for (int i = 0; i < 4; ++i) {
        float4 g = *(const float4*)(gnext + (i * 64 + lane) * 4);
        uint2 pk;
        pk.x = pk2(x[i].x * rs * g.x, x[i].y * rs * g.y);
        pk.y = pk2(x[i].z * rs * g.z, x[i].w * rs * g.w);
        *(uint2*)(XN + (size_t)tok * KP1 + (i * 64 + lane) * 4) = pk;
      }
    }
  }
}

DI int colmap(int mode, int n, int nsrc) {
  if (mode == 1) { return ((n >> 5) & 1) * DFF + (n >> 6) * 32 + (n & 31); }
  if (mode == 2) {
    if (n < 1664) return n;
    if (n < 2432) return n + 32;
    if (n < 2464) return n - 2432 + 1664;
    if (n < 2560) return -1;
    return n - 96;
  }
  return n < nsrc ? n : -1;
}
DI void conv_job(u16* __restrict__ dst, int ldd, const float* __restrict__ src, int Nd, int K, int lds, int mode,
                 const float* __restrict__ kscale) {
  const int total = Nd * (K >> 3);
  const int gthreads = gridDim.x * NTHR;
  for (int idx = blockIdx.x * NTHR + opaque_tid(); idx < total; idx += gthreads) {
    const int n = idx % Nd, k8 = idx / Nd;
    const int col = colmap(mode, n, lds);
    float v[8];
#pragma unroll
    for (int j = 0; j < 8; ++j) {
      float x = 0.f;
      if (col >= 0) {
        x = src[(size_t)(k8 * 8 + j) * lds + col];
        if (kscale) x *= kscale[k8 * 8 + j];
      }
      v[j] = x;
    }
    uint4 pk = {pk2(v[0], v[1]), pk2(v[2], v[3]), pk2(v[4], v[5]), pk2(v[6], v[7])};
    *(uint4*)(dst + (size_t)n * ldd + k8 * 8) = pk;
  }
}
DI void convert_layer(const Params& P, int l) {
  u16* W = (u16*)(P.ws + OFF_W);
  for (int s = 0; s < 2; ++s) {
    conv_job(W + W_WI + (size_t)s * 5632 * KP1, KP1, P.ffn_wi + ((size_t)l * 2 + s) * 1024 * 5632, 5632, 1024, 5632, 1, nullptr);
    conv_job(W + W_WO + (size_t)s * 1024 * KP2, KP2, P.ffn_wo + ((size_t)l * 2 + s) * 2816 * 1024, 1024, 2816, 1024, 0, nullptr);
  }
  conv_job(W + W_WIN, KP1, P.w_in + (size_t)l * 1024 * NPROJ, 6656, 1024, NPROJ, 2, nullptr);
  conv_job(W + W_WUQ, 384, P.c_w_uq + (size_t)l * 384 * 384, 512, 384, 384, 0, P.c_q_norm + l * 384);
  conv_job(W + W_WUKV, 256, P.c_w_ukv + (size_t)l * 256 * 512, 512, 256, 512, 0, P.c_kv_norm + l * 256);
  conv_job(W + W_WB, KP1, P.w_branch + (size_t)l * 1024 * 1024, 1024, 1024, 1024, 0, nullptr);
  conv_job(W + W_WOUT, KP1, P.w_out + (size_t)l * 1024 * 1024, 1024, 1024, 1024, 0, nullptr);
}
DI void rope_tables(const Params& P) {
  float2* R64 = (float2*)(P.ws + OFF_R64);
  float2* R32 = (float2*)(P.ws + OFF_R32);
  const int gthreads = gridDim.x * NTHR;
  for (int idx = blockIdx.x * NTHR + opaque_tid(); idx < 16384 * 48; idx += gthreads) {
    int pos, f; double base; float2* dst;
    if (idx < 16384 * 32) { pos = idx >> 5; f = idx & 31; base = 0.7498942093324559; dst = R64 + idx; }
    else { const int i2 = idx - 16384 * 32; pos = i2 >> 4; f = i2 & 15; base = 0.5623413251903491; dst = R32 + i2; }
    double inv = 1.0;
    for (int k = 0; k < f; ++k) inv *= base;
    const float ang = (float)pos * (float)inv;
    double tr = (double)ang * 0.15915494309189535;
    tr -= rint(tr);
    const float tf = (float)tr;
    *dst = make_float2(__builtin_amdgcn_cosf(tf), __builtin_amdgcn_sinf(tf));
  }
}

DI void fast_grid_barrier(unsigned* bar, unsigned nblk) {
  asm volatile("s_waitcnt vmcnt(0) lgkmcnt(0)" ::: "memory");
  __syncthreads();
  if (threadIdx.x == 0) {
    __builtin_amdgcn_fence(__ATOMIC_RELEASE, "agent");
    asm volatile("s_waitcnt vmcnt(0) lgkmcnt(0)" ::: "memory");
    const unsigned gen = __hip_atomic_load(&bar[64], __ATOMIC_RELAXED, __HIP_MEMORY_SCOPE_AGENT);
    const unsigned old = __hip_atomic_fetch_add(&bar[0], 1u, __ATOMIC_RELAXED, __HIP_MEMORY_SCOPE_AGENT);
    if (old == nblk - 1u) {
      __hip_atomic_store(&bar[0], 0u, __ATOMIC_RELAXED, __HIP_MEMORY_SCOPE_AGENT);
      __hip_atomic_fetch_add(&bar[64], 1u, __ATOMIC_RELEASE, __HIP_MEMORY_SCOPE_AGENT);
    } else {
      while (__hip_atomic_load(&bar[64], __ATOMIC_RELAXED, __HIP_MEMORY_SCOPE_AGENT) == gen) __builtin_amdgcn_s_sleep(1);
    }
    __builtin_amdgcn_fence(__ATOMIC_ACQUIRE, "agent");
    asm volatile("s_waitcnt vmcnt(0) lgkmcnt(0)" ::: "memory");
  }
  __syncthreads();
}

__global__ void __launch_bounds__(NTHR) __attribute__((amdgpu_waves_per_eu(2, 2))) mega(Params P) {
  extern __shared__ __attribute__((aligned(16))) char smem[];
  cg::grid_group grid = cg::this_grid();
  int phase = 0;
#define ACTIVE() (phase >= P.phase_lo && phase < P.phase_hi)
#define SEAM() do { ++phase; if (P.coop) { if (phase == 1) grid.sync(); else fast_grid_barrier((unsigned*)(P.ws + OFF_BAR), gridDim.x); } } while (0)
  u16* W = (u16*)(P.ws + OFF_W);
  u16* XN = (u16*)(P.ws + OFF_XN);
  u16* R2 = (u16*)(P.ws + OFF_R2);
  u16* qkv = (u16*)(P.ws + OFF_QKV);
  const float* Y = (const float*)(qkv + Q_Y);

  if (ACTIVE()) {
    rope_tables(P);
    convert_layer(P, 0);
    ew_phase(P, nullptr, 0.f, nullptr, P.norm_g, true);
  }
  SEAM();
  for (int l = 0; l < 4; ++l) {
    const float* g = P.norm_g + (size_t)l * 6 * DM;
    if (ACTIVE()) gemm_phase<M_FFNUP, 4>(W + W_WI, KP1, XN, KP1, DM, 22, smem, P, l);
    SEAM();
    if (ACTIVE()) gemm_phase<M_Y, 4>(W + W_WO, KP2, R2, KP2, DFF, 4, smem, P, l);
    SEAM();
    if (ACTIVE()) ew_phase(P, Y, 0.5f, g + DM, g + 2 * DM, false);
    SEAM();
    if (ACTIVE()) {
      gemm_phase<M_PROJ, 2>(W + W_WIN, KP1, XN, KP1, DM, 10, smem, P, l);
      gemm_phase<M_GATE, 4>(W + W_WIN + 2560ull * KP1, KP1, XN, KP1, DM, 16, smem, P, l);
    }
    SEAM();
    if (ACTIVE()) {
      gemm_phase<M_CUQ, 4>(W + W_WUQ, 384, qkv + Q_CQ, 384, 384, 2, smem, P, l);
      gemm_phase<M_CUKV, 4>(W + W_WUKV, 256, qkv + Q_CKV, 256, 256, 2, smem, P, l);
    }
    SEAM();
    if (ACTIVE()) attn_phase(P, l, smem);
    SEAM();
    if (ACTIVE()) gemm_phase<M_MERGE, 2>(W + W_WB, KP1, XN, KP1, DM, 4, smem, P, l);
    SEAM();
    if (ACTIVE()) gemm_phase<M_Y, 4>(W + W_WOUT, KP1, qkv + Q_MERGED, KP1, DM, 4, smem, P, l);
    SEAM();
    if (ACTIVE()) ew_phase(P, Y, 1.0f, g + 3 * DM, g + 4 * DM, false);
    SEAM();
    if (ACTIVE()) gemm_phase<M_FFNUP, 4>(W + W_WI + 5632ull * KP1, KP1, XN, KP1, DM, 22, smem, P, l);
    SEAM();
    if (ACTIVE()) gemm_phase<M_Y, 4>(W + W_WO + 1024ull * KP2, KP2, R2, KP2, DFF, 4, smem, P, l);
    SEAM();
    if (ACTIVE()) {
      ew_phase(P, Y, 0.5f, g + 5 * DM, l < 3 ? g + 6 * DM : nullptr, false);
      if (l < 3) convert_layer(P, l + 1);
    }
    SEAM();
  }
}

constexpr int N_PHASES = 1 + 12 * 4;

extern "C" void kernel_launch(void* const* d_in, const int* in_sizes, int n_in, void* d_out, int out_size, void* d_ws,
                              size_t ws_size, hipStream_t stream) {
  static int grid_blocks = 0;
  if (!grid_blocks) {
    int dev = 0, cus = 0, per_cu = 0;
    hipGetDevice(&dev);
    hipDeviceGetAttribute(&cus, hipDeviceAttributeMultiprocessorCount, dev);
    hipFuncSetAttribute((const void*)mega, hipFuncAttributeMaxDynamicSharedMemorySize, SMEM_BYTES);
    hipOccupancyMaxActiveBlocksPerMultiprocessor(&per_cu, mega, NTHR, SMEM_BYTES);
    if (per_cu < 1) per_cu = 1;
    grid_blocks = cus * per_cu;
  }
  if (ws_size < WS_NEEDED) fprintf(stderr, "workspace too small: %zu < %zu\n", ws_size, (size_t)WS_NEEDED);
  Params P{};
  P.x_prompt = (const float*)d_in[0]; P.x_sample = (const float*)d_in[1]; P.norm_g = (const float*)d_in[2];
  P.w_in = (const float*)d_in[3]; P.a_qk_norm = (const float*)d_in[4]; P.b_sink = (const float*)d_in[5];
  P.c_q_norm = (const float*)d_in[6]; P.c_kv_norm = (const float*)d_in[7]; P.c_w_uq = (const float*)d_in[8];
  P.c_w_ukv = (const float*)d_in[9]; P.d_lambda = (const float*)d_in[10]; P.d_subln = (const float*)d_in[11];
  P.w_branch = (const float*)d_in[12]; P.w_out = (const float*)d_in[13]; P.ffn_wi = (const float*)d_in[14];
  P.ffn_wo = (const float*)d_in[15];
  P.out = (float*)d_out; P.ws = (char*)d_ws;
#if MULTI_LAUNCH
  for (int ph = 0; ph < N_PHASES; ++ph) {
    P.phase_lo = ph; P.phase_hi = ph + 1; P.coop = 0; P.pad0 = 0;
    hipLaunchKernelGGL(mega, dim3(grid_blocks), dim3(NTHR), SMEM_BYTES, stream, P);
  }
#else
  P.phase_lo = 0; P.phase_hi = 1 << 30; P.coop = 1; P.pad0 = 0;
  hipMemsetAsync((char*)d_ws + OFF_BAR, 0, 1024, stream);
  void* args[] = {&P};
  hipError_t e = hipLaunchCooperativeKernel((const void*)mega, dim3(grid_blocks), dim3(NTHR), args, SMEM_BYTES, stream);
  if (e != hipSuccess) fprintf(stderr, "cooperative launch failed: %s (grid %d)\n", hipGetErrorString(e), grid_blocks);
#endif
}
```

```cpp
#include <hip/hip_runtime.h>
#include <hip/hip_cooperative_groups.h>
#include <cstdio>
#include <cstdint>
#include <type_traits>
namespace cg = cooperative_groups;

#ifndef MULTI_LAUNCH
#define MULTI_LAUNCH 0
#endif

#define DI __device__ __forceinline__
typedef unsigned short u16;
typedef __attribute__((ext_vector_type(8))) short bf16x8;
typedef __attribute__((ext_vector_type(16))) float f32x16;
typedef __attribute__((ext_vector_type(2))) float f32x2_t;
typedef __attribute__((ext_vector_type(2))) __bf16 bf16x2_t;

constexpr int T = 32768;
constexpr int DM = 1024;
constexpr int DFF = 2816;
constexpr int KP1 = 1088;
constexpr int KP2 = 2880;
constexpr int GP = 4160;
constexpr int YP = 1040;
constexpr int NPROJ = 6560;
constexpr int SEQ0 = 16384;
constexpr int DSEQ = 2048;
constexpr float EPS = 1e-6f;
constexpr int NTHR = 512;
constexpr int LSTR = 72;
constexpr int SMEM_BYTES = 2 * 2 * 256 * LSTR * 2;

constexpr size_t W_WI = 0;
constexpr size_t W_WO = W_WI + 2ull * 5632 * KP1;
constexpr size_t W_WIN = W_WO + 2ull * 1024 * KP2;
constexpr size_t W_WUQ = W_WIN + 6656ull * KP1;
constexpr size_t W_WUKV = W_WUQ + 512ull * 384;
constexpr size_t W_WB = W_WUKV + 512ull * 256;
constexpr size_t W_WOUT = W_WB + 1024ull * KP1;
constexpr size_t W_TOTAL = W_WOUT + 1024ull * KP1;

constexpr size_t OFF_W = 0;
constexpr size_t OFF_XN = OFF_W + W_TOTAL * 2;
constexpr size_t OFF_R2 = OFF_XN + (size_t)T * KP1 * 2;
constexpr size_t OFF_QKV = OFF_R2 + (size_t)T * GP * 2;
constexpr size_t OFF_SS = OFF_QKV + (size_t)T * 3456 * 2;
constexpr size_t OFF_R64 = OFF_SS + (size_t)T * 20 * 4;
constexpr size_t OFF_R32 = OFF_R64 + 16384ull * 32 * 8;
constexpr size_t OFF_DS = OFF_R32 + 16384ull * 16 * 8;
constexpr size_t OFF_BAR = OFF_DS + (size_t)T * 256 * 4;
constexpr size_t WS_NEEDED = OFF_BAR + 1024;

constexpr size_t Q_QA = 0;
constexpr size_t Q_KA = (size_t)T * 256;
constexpr size_t Q_VTA = (size_t)T * 384;
constexpr size_t Q_QB = (size_t)T * 512;
constexpr size_t Q_KB = (size_t)T * 768;
constexpr size_t Q_VTB = (size_t)T * 896;
constexpr size_t Q_CQ = (size_t)T * 1024;
constexpr size_t Q_CKV = (size_t)T * 1408;
constexpr size_t Q_QC = (size_t)T * 1664;
constexpr size_t Q_KC = (size_t)T * 2048;
constexpr size_t Q_VTC = (size_t)T * 2432;
constexpr size_t Q_QD = (size_t)T * 2688;
constexpr size_t Q_KD = (size_t)T * 2944;
constexpr size_t Q_VTD = (size_t)T * 3200;
constexpr size_t Q_MERGED = 0;
constexpr size_t Q_Y = (size_t)T * KP1;

struct Params {
  const float* x_prompt; const float* x_sample; const float* norm_g; const float* w_in;
  const float* a_qk_norm; const float* b_sink; const float* c_q_norm; const float* c_kv_norm;
  const float* c_w_uq; const float* c_w_ukv; const float* d_lambda; const float* d_subln;
  const float* w_branch; const float* w_out; const float* ffn_wi; const float* ffn_wo;
  float* out; char* ws;
  int phase_lo; int phase_hi; int coop; int pad0;
};

DI unsigned pk2(float a, float b) {
  f32x2_t v = {a, b};
  bf16x2_t r = __builtin_convertvector(v, bf16x2_t);
  return __builtin_bit_cast(unsigned, r);
}
DI u16 f2bf(float a) { return (u16)(pk2(a, 0.f) & 0xffffu); }
DI float bf2f(unsigned bits16) { return __uint_as_float(bits16 << 16); }
DI int crow(int v, int h) { return (v & 3) + 8 * (v >> 2) + 4 * h; }
DI int pos_of(int tok) { return tok < SEQ0 ? tok : ((tok - SEQ0) & (DSEQ - 1)); }
#define MFMA32(a, b, c) __builtin_amdgcn_mfma_f32_32x32x16_bf16((a), (b), (c), 0, 0, 0)

typedef __attribute__((ext_vector_type(4))) unsigned u32x4;
DI u32x4 gld16(const void* p) { u32x4 r; asm volatile("global_load_dwordx4 %0, %1, off" : "=v"(r) : "v"(p)); return r; }
DI void wait_vm0(u32x4& a) { asm volatile("s_waitcnt vmcnt(0)" : "+v"(a) :: "memory"); }
DI void wait_vm0(u32x4& a, u32x4& b) { asm volatile("s_waitcnt vmcnt(0)" : "+v"(a), "+v"(b) :: "memory"); }
DI void wait_vm0(u32x4& a, u32x4& b, u32x4& c) { asm volatile("s_waitcnt vmcnt(0)" : "+v"(a), "+v"(b), "+v"(c) :: "memory"); }
DI void wait_vm0(u32x4& a, u32x4& b, u32x4& c, u32x4& d) { asm volatile("s_waitcnt vmcnt(0)" : "+v"(a), "+v"(b), "+v"(c), "+v"(d) :: "memory"); }
DI u32x4 gld16s(unsigned voff, const void* sbase) { u32x4 r; asm volatile("global_load_dwordx4 %0, %1, %2" : "=v"(r) : "v"(voff), "s"(sbase)); return r; }
#define DEF_WAIT8(name, cnt) DI void name(u32x4& a, u32x4& b, u32x4& c, u32x4& d, u32x4& e, u32x4& f, u32x4& g, u32x4& h) { asm volatile("s_waitcnt vmcnt(" #cnt ")" : "+v"(a), "+v"(b), "+v"(c), "+v"(d), "+v"(e), "+v"(f), "+v"(g), "+v"(h) :: "memory"); }
#define DEF_WAIT6(name, cnt) DI void name(u32x4& a, u32x4& b, u32x4& c, u32x4& d, u32x4& e, u32x4& f) { asm volatile("s_waitcnt vmcnt(" #cnt ")" : "+v"(a), "+v"(b), "+v"(c), "+v"(d), "+v"(e), "+v"(f) :: "memory"); }
DEF_WAIT8(wait8_vm8, 8)
DEF_WAIT8(wait8_vm0, 0)
DEF_WAIT6(wait6_vm6, 6)
DEF_WAIT6(wait6_vm0, 0)
DI int opaque_tid() { int t = threadIdx.x; asm volatile("" : "+v"(t)); return t; }
DI float wave_sum(float v) {
#pragma unroll
  for (int m = 32; m >= 1; m >>= 1) v += __shfl_xor(v, m);
  return v;
}

DI void rope32_blk(f32x16& a, const float2* __restrict__ tab, int h) {
#pragma unroll
  for (int v = 0; v < 8; ++v) {
    float2 cs = tab[crow(v, h)];
    float x1 = a[v], x2 = a[v + 8];
    a[v] = x1 * cs.x - x2 * cs.y;
    a[v + 8] = x2 * cs.x + x1 * cs.y;
  }
}
DI void rope64_blk(f32x16& a0, f32x16& a1, const float2* __restrict__ tab, int h) {
#pragma unroll
  for (int v = 0; v < 16; ++v) {
    float2 cs = tab[crow(v, h)];
    float x1 = a0[v], x2 = a1[v];
    a0[v] = x1 * cs.x - x2 * cs.y;
    a1[v] = x2 * cs.x + x1 * cs.y;
  }
}
DI void store_rows(u16* __restrict__ base, int ld, int col0, const f32x16& a, int tok, int h) {
#pragma unroll
  for (int vq = 0; vq < 4; ++vq) {
    uint2 pk;
    pk.x = pk2(a[4 * vq], a[4 * vq + 1]);
    pk.y = pk2(a[4 * vq + 2], a[4 * vq + 3]);
    *(uint2*)(base + (size_t)tok * ld + col0 + 8 * vq + 4 * h) = pk;
  }
}
DI void store_T(u16* __restrict__ base, int row0, const f32x16& a, int tok, int h) {
  const int tp = (tok & ~12) | ((tok & 4) << 1) | ((tok & 8) >> 1);
#pragma unroll
  for (int v = 0; v < 16; ++v) base[(size_t)((row0 + crow(v, h)) >> 6) * 64 * T + (size_t)(tp >> 7) * 8192 + ((row0 + crow(v, h)) & 63) * 128 + (tp & 127)] = f2bf(a[v]);
}

enum { M_FFNUP = 0, M_Y = 1, M_PROJ = 2, M_CUQ = 3, M_CUKV = 4, M_MERGE = 5, M_GATE = 6 };

template <int MODE, int NJ>
DI void gemm_epilogue(f32x16 (&acc)[2][NJ], int fbase, int tbase, int r, int h, const Params& P, int layer) {
  char* ws = P.ws;
  u16* qkv = (u16*)(ws + OFF_QKV);
  const float2* R64 = (const float2*)(ws + OFF_R64);
  const float2* R32 = (const float2*)(ws + OFF_R32);
  float* SS = (float*)(ws + OFF_SS);
  if constexpr (MODE == M_FFNUP) {
    u16* H = (u16*)(ws + OFF_R2);
    const int hf0 = (fbase >> 6) * 32;
#pragma unroll
    for (int j = 0; j < NJ; ++j) {
      const int tok = tbase + j * 32 + r;
      f32x16 o;
#pragma unroll
      for (int v = 0; v < 16; ++v) {
        float g = acc[0][j][v], u = acc[1][j][v];
        o[v] = g * __builtin_amdgcn_rcpf(1.f + __builtin_amdgcn_exp2f(-1.4426950408889634f * g)) * u;
      }
      store_rows(H, KP2, hf0, o, tok, h);
    }
  } else if constexpr (MODE == M_Y) {
    float* Y = (float*)(qkv + Q_Y);
#pragma unroll
    for (int j = 0; j < NJ; ++j) {
      const int tok = tbase + j * 32 + r;
#pragma unroll
      for (int i = 0; i < 2; ++i)
#pragma unroll
        for (int vq = 0; vq < 4; ++vq) {
          float4 o = {acc[i][j][4 * vq], acc[i][j][4 * vq + 1], acc[i][j][4 * vq + 2], acc[i][j][4 * vq + 3]};
          *(float4*)(Y + (size_t)tok * YP + fbase + i * 32 + 8 * vq + 4 * h) = o;
        }
    }
  } else if constexpr (MODE == M_PROJ) {
    if (fbase < 384) {
      const bool isK = fbase >= 256;
      const float* g = P.a_qk_norm + layer * 128 + (isK ? 64 : 0);
      u16* dst = qkv + (isK ? Q_KA : Q_QA);
      const int ld = isK ? 128 : 256;
      const int c0 = isK ? fbase - 256 : fbase;
      float gv[2][16];
#pragma unroll
      for (int i = 0; i < 2; ++i)
#pragma unroll
        for (int v = 0; v < 16; ++v) gv[i][v] = g[i * 32 + crow(v, h)];
#pragma unroll
      for (int j = 0; j < NJ; ++j) {
        const int tok = tbase + j * 32 + r;
        const int pos = pos_of(tok);
        float ss = 0.f;
#pragma unroll
        for (int i = 0; i < 2; ++i)
#pragma unroll
          for (int v = 0; v < 16; ++v) ss += acc[i][j][v] * acc[i][j][v];
        ss += __shfl_xor(ss, 32);
        const float rs = rsqrtf(ss * (1.f / 64.f) + EPS);
#pragma unroll
        for (int i = 0; i < 2; ++i)
#pragma unroll
          for (int v = 0; v < 16; ++v) acc[i][j][v] *= rs * gv[i][v];
        rope32_blk(acc[0][j], R32 + (size_t)(pos >> 6) * 16, h);
        rope32_blk(acc[1][j], R32 + (size_t)(pos & 63) * 16, h);
        store_rows(dst, ld, c0, acc[0][j], tok, h);
        store_rows(dst, ld, c0 + 32, acc[1][j], tok, h);
      }
    } else if (fbase < 512) {
#pragma unroll
      for (int j = 0; j < NJ; ++j) {
        const int tok = tbase + j * 32 + r;
        store_T(qkv + Q_VTA, fbase - 384, acc[0][j], tok, h);
        store_T(qkv + Q_VTA, fbase - 384 + 32, acc[1][j], tok, h);
      }
    } else if (fbase < 896) {
      const bool isK = fbase >= 768;
      u16* dst = qkv + (isK ? Q_KB : Q_QB);
      const int ld = isK ? 128 : 256;
      const int c0 = isK ? fbase - 768 : fbase - 512;
#pragma unroll
      for (int j = 0; j < NJ; ++j) {
        const int tok = tbase + j * 32 + r;
        const int pos = pos_of(tok);
        rope64_blk(acc[0][j], acc[1][j], R64 + (size_t)pos * 32, h);
        store_rows(dst, ld, c0, acc[0][j], tok, h);
        store_rows(dst, ld, c0 + 32, acc[1][j], tok, h);
      }
    } else if (fbase < 1024) {
#pragma unroll
      for (int j = 0; j < NJ; ++j) {
        const int tok = tbase + j * 32 + r;
        store_T(qkv + Q_VTB, fbase - 896, acc[0][j], tok, h);
        store_T(qkv + Q_VTB, fbase - 896 + 32, acc[1][j], tok, h);
      }
    } else if (fbase < 1664) {
      const bool isKV = fbase >= 1408;
      u16* dst = qkv + (isKV ? Q_CKV : Q_CQ);
      const int ld = isKV ? 256 : 384;
      const int c0 = isKV ? fbase - 1408 : fbase - 1024;
      const int sb = (isKV ? 12 : 0) + (c0 >> 5);
#pragma unroll
      for (int j = 0; j < NJ; ++j) {
        const int tok = tbase + j * 32 + r;
#pragma unroll
        for (int i = 0; i < 2; ++i) {
          float ss = 0.f;
#pragma unroll
          for (int v = 0; v < 16; ++v) ss += acc[i][j][v] * acc[i][j][v];
          ss += __shfl_xor(ss, 32);
          if (h == 0) SS[(size_t)tok * 20 + sb + i] = ss;
          store_rows(dst, ld, c0 + i * 32, acc[i][j], tok, h);
        }
      }
    } else if (fbase < 2176) {
      const bool isK = fbase >= 1920;
      u16* dst = qkv + (isK ? Q_KD : Q_QD);
      const int c0 = isK ? fbase - 1920 : fbase - 1664;
#pragma unroll
      for (int j = 0; j < NJ; ++j) {
        const int tok = tbase + j * 32 + r;
        const int pos = pos_of(tok);
#pragma unroll
        for (int i = 0; i < 2; ++i) {
          rope32_blk(acc[i][j], R32 + (size_t)pos * 16, h);
          store_rows(dst, 256, c0 + i * 32, acc[i][j], tok, h);
        }
      }
    } else if (fbase < 2432) {
#pragma unroll
      for (int j = 0; j < NJ; ++j) {
        const int tok = tbase + j * 32 + r;
        store_T(qkv + Q_VTD, fbase - 2176, acc[0][j], tok, h);
        store_T(qkv + Q_VTD, fbase - 2176 + 32, acc[1][j], tok, h);
      }
    } else if (fbase == 2432) {
#pragma unroll
      for (int j = 0; j < NJ; ++j) {
        const int tok = tbase + j * 32 + r;
        const int pos = pos_of(tok);
        rope32_blk(acc[0][j], R32 + (size_t)pos * 16, h);
#pragma unroll
        for (int hd = 0; hd < 4; ++hd) store_rows(qkv + Q_KC, 384, hd * 96 + 64, acc[0][j], tok, h);
      }
    }
  } else if constexpr (MODE == M_GATE) {
    u16* G = (u16*)(ws + OFF_R2);
#pragma unroll
    for (int j = 0; j < NJ; ++j) {
      const int tok = tbase + j * 32 + r;
#pragma unroll
      for (int i = 0; i < 2; ++i) {
        f32x16 o;
#pragma unroll
        for (int v = 0; v < 16; ++v) o[v] = __builtin_amdgcn_rcpf(1.f + __builtin_amdgcn_exp2f(-1.4426950408889634f * acc[i][j][v]));
        store_rows(G, GP, fbase + i * 32, o, tok, h);
      }
    }
  } else if constexpr (MODE == M_CUQ) {
    if (fbase >= 384) return;
#pragma unroll
    for (int j = 0; j < NJ; ++j) {
      const int tok = tbase + j * 32 + r;
      const int pos = pos_of(tok);
      float ss = 0.f;
#pragma unroll
      for (int b = 0; b < 12; ++b) ss += SS[(size_t)tok * 20 + b];
      const float rs = rsqrtf(ss * (1.f / 384.f) + EPS);
#pragma unroll
      for (int i = 0; i < 2; ++i) {
        const int blk = (fbase >> 5) + i;
#pragma unroll
        for (int v = 0; v < 16; ++v) acc[i][j][v] *= rs;
        if (blk % 3 == 2) rope32_blk(acc[i][j], R32 + (size_t)pos * 16, h);
        store_rows(qkv + Q_QC, 384, blk * 32, acc[i][j], tok, h);
      }
    }
  } else if constexpr (MODE == M_CUKV) {
#pragma unroll
    for (int j = 0; j < NJ; ++j) {
      const int tok = tbase + j * 32 + r;
      float ss = 0.f;
#pragma unroll
      for (int b = 0; b < 8; ++b) ss += SS[(size_t)tok * 20 + 12 + b];
      const float rs = rsqrtf(ss * (1.f / 256.f) + EPS);
#pragma unroll
      for (int i = 0; i < 2; ++i) {
        const int blk = (fbase >> 5) + i;
        const int hd = blk >> 2, q = blk & 3;
#pragma unroll
        for (int v = 0; v < 16; ++v) acc[i][j][v] *= rs;
        if (q < 2) store_rows(qkv + Q_KC, 384, hd * 96 + q * 32, acc[i][j], tok, h);
        else store_T(qkv + Q_VTC, hd * 64 + (q - 2) * 32, acc[i][j], tok, h);
      }
    }
  } else if constexpr (MODE == M_MERGE) {
#pragma unroll
    for (int j = 0; j < NJ; ++j) {
      const int tok = tbase + j * 32 + r;
      store_rows(qkv + Q_MERGED, KP1, fbase, acc[0][j], tok, h);
      store_rows(qkv + Q_MERGED, KP1, fbase + 32, acc[1][j], tok, h);
    }
  }
}

typedef __attribute__((address_space(3))) unsigned lds_u32_t;
typedef __attribute__((address_space(1))) const unsigned glb_u32_t;
template <int MODE, int NJ>
DI void gemm_tile(const u16* __restrict__ Wt, int ldw, const u16* __restrict__ X, int ldx, int K, int f0, int t0, char* smem,
                  const Params& P, int layer) {
  constexpr int XROWS = NJ * 64;
  constexpr int WSTG = 256 * 64, XSTG = XROWS * 64;
  u16* sW = (u16*)smem;
  u16* sX = sW + 2 * WSTG;
  const int tid = opaque_tid(), lane = tid & 63, wave = tid >> 6, r = lane & 31, h = lane >> 5;
  const int wf = wave & 3, wt = wave >> 2;
  f32x16 acc[2][NJ];
  f32x16 tot[2][MODE == M_MERGE ? NJ : 1];
#pragma unroll
  for (int i = 0; i < 2; ++i)
#pragma unroll
    for (int j = 0; j < NJ; ++j)
#pragma unroll
      for (int v = 0; v < 16; ++v) acc[i][j][v] = 0.f;
  if constexpr (MODE == M_MERGE) {
#pragma unroll
    for (int i = 0; i < 2; ++i)
#pragma unroll
      for (int j = 0; j < NJ; ++j)
#pragma unroll
        for (int v = 0; v < 16; ++v) tot[i][j][v] = 0.f;
  }
  const int nk = K >> 6;
  const int srow = tid >> 3;
  const int schunk = (tid & 7) ^ ((tid >> 4) & 7);
  const u16* wp = Wt + (size_t)(f0 + srow) * ldw + schunk * 8;
  const u16* xp = X + (size_t)(t0 + srow) * ldx + schunk * 8;
  const int fbase = f0 + wf * 64, tbase = t0 + wt * (NJ * 32);

  auto issue = [&](int kt, int buf) {
#pragma unroll
    for (int i = 0; i < 4; ++i)
      __builtin_amdgcn_global_load_lds((glb_u32_t*)(wp + (size_t)(i * 64) * ldw + kt * 64),
                                       (lds_u32_t*)(sW + buf * WSTG + i * 4096 + tid * 8), 16, 0, 0);
#pragma unroll
    for (int i = 0; i < NJ; ++i)
      __builtin_amdgcn_global_load_lds((glb_u32_t*)(xp + (size_t)(i * 64) * ldx + kt * 64),
                                       (lds_u32_t*)(sX + buf * XSTG + i * 4096 + tid * 8), 16, 0, 0);
  };
  const int swz = (r >> 1) & 7;
  auto compute = [&](int buf, int kt) {
    const u16* aW = sW + buf * WSTG + (wf * 64 + r) * 64;
    const u16* aX = sX + buf * XSTG + (wt * (NJ * 32) + r) * 64;
#pragma unroll
    for (int ks = 0; ks < 4; ++ks) {
      const int co = ((2 * ks + h) ^ swz) * 8;
      bf16x8 wfrag[2], xfrag[NJ];
#pragma unroll
      for (int i = 0; i < 2; ++i) wfrag[i] = *(const bf16x8*)(aW + i * 32 * 64 + co);
#pragma unroll
      for (int j = 0; j < NJ; ++j) xfrag[j] = *(const bf16x8*)(aX + j * 32 * 64 + co);
#pragma unroll
      for (int i = 0; i < 2; ++i)
#pragma unroll
        for (int j = 0; j < NJ; ++j) acc[i][j] = MFMA32(wfrag[i], xfrag[j], acc[i][j]);
    }
    if constexpr (MODE == M_MERGE) {
      if ((kt & 3) == 3) {
        const int br = kt >> 2;
        const u16* G = (const u16*)(P.ws + OFF_R2);
#pragma unroll
        for (int j = 0; j < NJ; ++j) {
          const int tok = tbase + j * 32 + r;
#pragma unroll
          for (int i = 0; i < 2; ++i)
#pragma unroll
            for (int vq = 0; vq < 4; ++vq) {
              uint2 gp = *(const uint2*)(G + (size_t)tok * GP + br * 1024 + fbase + i * 32 + 8 * vq + 4 * h);
              tot[i][j][4 * vq + 0] += bf2f(gp.x & 0xffffu) * acc[i][j][4 * vq + 0];
              tot[i][j][4 * vq + 1] += bf2f(gp.x >> 16) * acc[i][j][4 * vq + 1];
              tot[i][j][4 * vq + 2] += bf2f(gp.y & 0xffffu) * acc[i][j][4 * vq + 2];
              tot[i][j][4 * vq + 3] += bf2f(gp.y >> 16) * acc[i][j][4 * vq + 3];
              acc[i][j][4 * vq + 0] = 0.f; acc[i][j][4 * vq + 1] = 0.f;
              acc[i][j][4 * vq + 2] = 0.f; acc[i][j][4 * vq + 3] = 0.f;
            }
        }
      }
    }
  };

  issue(0, 0);
  asm volatile("s_waitcnt vmcnt(0)" ::: "memory");
  __syncthreads();
  for (int kt = 0; kt < nk; ++kt) {
    const int buf = kt & 1;
    if (kt + 1 < nk) issue(kt + 1, buf ^ 1);
    compute(buf, kt);
    asm volatile("s_waitcnt vmcnt(0) lgkmcnt(0)" ::: "memory");
    __syncthreads();
  }
  if constexpr (MODE == M_MERGE) gemm_epilogue<MODE, NJ>(tot, fbase, tbase, r, h, P, layer);
  else gemm_epilogue<MODE, NJ>(acc, fbase, tbase, r, h, P, layer);
}

template <int MODE, int NJ>
DI void gemm_phase(const u16* Wt, int ldw, const u16* X, int ldx, int K, int nF, char* smem, const Params& P, int layer) {
  constexpr int TT = NJ * 64;
  const int nT = T / TT;
  const int ntiles = nF * nT;
  for (int idx = blockIdx.x; idx < ntiles; idx += gridDim.x) {
    const int tt_lo = idx & 15;
    const int rest = idx >> 4;
    const int ft = rest % nF;
    const int tt = (rest / nF) * 16 + tt_lo;
    gemm_tile<MODE, NJ>(Wt, ldw, X, ldx, K, ft * 256, tt * TT, smem, P, layer);
  }
}

template <int DQK, int NCOMP, bool BAND, int EPI>
DI void attn_item(const u16* __restrict__ Q, int ldq, const u16* __restrict__ Kp, int ldk, const u16* __restrict__ Vt,
                  int qtok0, int kbeg, int kend, float sc_l2, float sink_l2, float lam, float onorm,
                  const float* __restrict__ subg, u16* __restrict__ O, float* __restrict__ DS, char* smem) {
  constexpr int DC = DQK / NCOMP;
  constexpr int KS = DC / 16;
  constexpr int KEYS = (NCOMP == 1) ? 128 : 64;
  constexpr int KSTR = DQK + 8, VSTR = KEYS + 8;
  constexpr int KCH = DQK / 8, VCH = KEYS / 8;
  constexpr int NKC = KEYS * KCH / NTHR, NVC = 64 * VCH / NTHR;
  constexpr int KSLOT = KEYS * KSTR, VSLOT = 64 * VSTR;
  u16* sK = (u16*)smem;
  u16* sV = sK + 3 * KSLOT;
  const int tid = opaque_tid(), lane = tid & 63, wave = tid >> 6, r = lane & 31, h = lane >> 5;
  const int qtok = qtok0 + wave * 32 + r;

  bf16x8 qf[NCOMP][KS];
#pragma unroll
  for (int c = 0; c < NCOMP; ++c)
#pragma unroll
    for (int ks = 0; ks < KS; ++ks) qf[c][ks] = *(const bf16x8*)(Q + (size_t)qtok * ldq + c * DC + ks * 16 + 8 * h);

  f32x16 Oa[NCOMP][2];
  float m[NCOMP], l[NCOMP];
#pragma unroll
  for (int c = 0; c < NCOMP; ++c) {
#pragma unroll
    for (int d = 0; d < 2; ++d)
#pragma unroll
      for (int v = 0; v < 16; ++v) Oa[c][d][v] = 0.f;
    m[c] = BAND ? sink_l2 : -1e30f;
    l[c] = (BAND && h == 0) ? 1.f : 0.f;
  }

  const u16* kg[NKC]; int kso[NKC];
#pragma unroll
  for (int i = 0; i < NKC; ++i) {
    const int c = tid + i * NTHR;
    const int row = c / KCH, cc = c % KCH;
    kg[i] = Kp + (size_t)(kbeg + row) * ldk + cc * 8;
    kso[i] = row * KSTR + cc * 8;
  }
  const u16* vg[NVC]; int vso[NVC];
#pragma unroll
  for (int i = 0; i < NVC; ++i) {
    const int c = tid + i * NTHR;
    const int row = c / VCH, cc = c % VCH;
    vg[i] = Vt + (size_t)(kbeg >> 7) * 8192 + row * 128 + cc * 8;
    vso[i] = row * VSTR + cc * 8;
  }
  u32x4 kreg[NKC], vreg[NVC];
  auto loadK = [&](int t) {
#pragma unroll
    for (int i = 0; i < NKC; ++i) kreg[i] = gld16(kg[i] + (size_t)t * KEYS * ldk);
  };
  auto loadV = [&](int t) {
#pragma unroll
    for (int i = 0; i < NVC; ++i) vreg[i] = gld16(vg[i] + (size_t)t * 8192);
  };
  auto waitK = [&]() {
    if constexpr (NKC == 1) wait_vm0(kreg[0]);
    else if constexpr (NKC == 2) wait_vm0(kreg[0], kreg[1]);
    else wait_vm0(kreg[0], kreg[1], kreg[2]);
  };
  auto waitV = [&]() {
    if constexpr (NVC == 1) wait_vm0(vreg[0]);
    else wait_vm0(vreg[0], vreg[1]);
  };
  auto storeK = [&](int slot) {
#pragma unroll
    for (int i = 0; i < NKC; ++i) *(u32x4*)(sK + slot * KSLOT + kso[i]) = kreg[i];
  };
  auto storeV = [&](int slot) {
#pragma unroll
    for (int i = 0; i < NVC; ++i) *(u32x4*)(sV + slot * VSLOT + vso[i]) = vreg[i];
  };

  f32x16 S0[2], S1[2];
  bf16x8 pfA[2][2], pfB[2][2];
  float alpha_pend = 1.f;
  bool need_pend = false;

  auto att_S = [&](auto uu_t, f32x16 (&S)[2], int slot) {
    constexpr int UU = decltype(uu_t)::value;
    constexpr int C = (NCOMP == 2) ? UU : 0;
    const u16* base = sK + slot * KSLOT + ((NCOMP == 1 ? UU * 64 : 0) + r) * KSTR + (NCOMP == 2 ? UU * DC : 0) + 8 * h;
#pragma unroll
    for (int kb = 0; kb < 2; ++kb) {
#pragma unroll
      for (int v = 0; v < 16; ++v) S[kb][v] = 0.f;
#pragma unroll
      for (int ks = 0; ks < KS; ++ks) {
        bf16x8 kf = *(const bf16x8*)(base + kb * 32 * KSTR + ks * 16);
        S[kb] = MFMA32(kf, qf[C][ks], S[kb]);
      }
    }
  };
  auto att_PV = [&](auto uu_t, const bf16x8 (&pf)[2][2], int slot) {
    constexpr int UU = decltype(uu_t)::value;
    constexpr int C = (NCOMP == 2) ? UU : 0;
    const u16* base = sV + slot * VSLOT + r * VSTR + (NCOMP == 1 ? UU * 64 : 0) + 8 * h;
#pragma unroll
    for (int d = 0; d < 2; ++d)
#pragma unroll
      for (int kb = 0; kb < 2; ++kb)
#pragma unroll
        for (int s = 0; s < 2; ++s) {
          bf16x8 vf = *(const bf16x8*)(base + d * 32 * VSTR + kb * 32 + 16 * s);
          Oa[C][d] = MFMA32(vf, pf[kb][s], Oa[C][d]);
        }
  };
  auto att_rescale = [&](auto uu_t) {
    constexpr int UU = decltype(uu_t)::value;
    constexpr int C = (NCOMP == 2) ? UU : 0;
    if (need_pend) {
#pragma unroll
      for (int d = 0; d < 2; ++d)
#pragma unroll
        for (int v = 0; v < 16; ++v) Oa[C][d][v] *= alpha_pend;
    }
  };
  auto att_softmax = [&](auto uu_t, f32x16 (&S)[2], bf16x8 (&pf)[2][2], int kpos0) {
    constexpr int UU = decltype(uu_t)::value;
    constexpr int C = (NCOMP == 2) ? UU : 0;
    if constexpr (BAND) {
#pragma unroll
      for (int kb = 0; kb < 2; ++kb)
#pragma unroll
        for (int v = 0; v < 16; ++v) {
          const int d = kpos0 + kb * 32 + crow(v, h) - qtok;
          if (d > 128 || d < -128) S[kb][v] = -1e30f;
        }
    }
    float mx = S[0][0];
#pragma unroll
    for (int kb = 0; kb < 2; ++kb)
#pragma unroll
      for (int v = 0; v < 16; ++v) mx = fmaxf(mx, S[kb][v]);
    mx = fmaxf(mx, __shfl_xor(mx, 32));
    const float mold = m[C];
    const float mnew = fmaxf(mold, mx * sc_l2);
    need_pend = __builtin_amdgcn_ballot_w64(mnew > mold) != 0;
    alpha_pend = __builtin_amdgcn_exp2f(mold - mnew);
    m[C] = mnew;
    float rsum = 0.f;
#pragma unroll
    for (int kb = 0; kb < 2; ++kb)
#pragma unroll
      for (int v = 0; v < 16; ++v) {
        float p = __builtin_amdgcn_exp2f(__builtin_fmaf(S[kb][v], sc_l2, -mnew));
        S[kb][v] = p;
        rsum += p;
      }
    l[C] = l[C] * alpha_pend + rsum;
#pragma unroll
    for (int kb = 0; kb < 2; ++kb)
#pragma unroll
      for (int s = 0; s < 2; ++s) {
        u32x4 pk;
        pk.x = pk2(S[kb][8 * s + 0], S[kb][8 * s + 1]);
        pk.y = pk2(S[kb][8 * s + 2], S[kb][8 * s + 3]);
        pk.z = pk2(S[kb][8 * s + 4], S[kb][8 * s + 5]);
        pk.w = pk2(S[kb][8 * s + 6], S[kb][8 * s + 7]);
        pf[kb][s] = __builtin_bit_cast(bf16x8, pk);
      }
  };
  using U0 = std::integral_constant<int, 0>;
  using U1 = std::integral_constant<int, 1>;

  const int ntl = (kend - kbeg) / KEYS;
  auto step = [&](auto first_t, auto lk_t, auto lv_t, int t, int sa, int sb, int sc) {
    constexpr bool FIRST = decltype(first_t)::value, LK = decltype(lk_t)::value, LV = decltype(lv_t)::value;
    if constexpr (LK) loadK(t + 2);
    if constexpr (LV) loadV(t + 1);
    if constexpr (!FIRST) att_rescale(U1{});
    att_S(U1{}, S1, sa);
    if constexpr (!FIRST) att_PV(U1{}, pfB, sc);
    att_softmax(U0{}, S0, pfA, kbeg + t * KEYS);
    att_rescale(U0{});
    if constexpr (LV) att_S(U0{}, S0, sb);
    att_PV(U0{}, pfA, sa);
    att_softmax(U1{}, S1, pfB, kbeg + t * KEYS + 64);
    if constexpr (LK) { waitK(); storeK(sc); }
    if constexpr (LV) { waitV(); storeV(sb); }
    __syncthreads();
  };
  using TT = std::true_type;
  using FF = std::false_type;

  loadK(0); loadV(0);
  waitK(); waitV();
  storeK(0); storeV(0);
  loadK(1);
  waitK();
  storeK(1);
  __syncthreads();
  att_S(U0{}, S0, 0);
  int sa = 0, sb = 1, sc = 2;
  step(TT{}, TT{}, TT{}, 0, sa, sb, sc);
  { int tmp = sa; sa = sb; sb = sc; sc = tmp; }
  for (int t = 1; t < ntl - 2; ++t) {
    step(FF{}, TT{}, TT{}, t, sa, sb, sc);
    int tmp = sa; sa = sb; sb = sc; sc = tmp;
  }
  step(FF{}, FF{}, TT{}, ntl - 2, sa, sb, sc);
  { int tmp = sa; sa = sb; sb = sc; sc = tmp; }
  step(FF{}, FF{}, FF{}, ntl - 1, sa, sb, sc);
  att_rescale(U1{});
  att_PV(U1{}, pfB, sa);

  float inv[NCOMP];
#pragma unroll
  for (int c = 0; c < NCOMP; ++c) {
    float lt = l[c] + __shfl_xor(l[c], 32);
    inv[c] = 1.f / lt;
  }
  if constexpr (EPI == 1) {
#pragma unroll
    for (int d = 0; d < 2; ++d)
#pragma unroll
      for (int vq = 0; vq < 4; ++vq) {
        float4 o = {Oa[0][d][4 * vq] * inv[0], Oa[0][d][4 * vq + 1] * inv[0], Oa[0][d][4 * vq + 2] * inv[0], Oa[0][d][4 * vq + 3] * inv[0]};
        *(float4*)(DS + (size_t)qtok * 256 + d * 32 + 8 * vq + 4 * h) = o;
      }
  } else {
    if constexpr (EPI == 2) {
      float ss = 0.f;
#pragma unroll
      for (int d = 0; d < 2; ++d)
#pragma unroll
        for (int vq = 0; vq < 4; ++vq) {
          const float4 o1 = *(const float4*)(DS + (size_t)qtok * 256 + d * 32 + 8 * vq + 4 * h);
          const float a0 = o1.x - lam * Oa[0][d][4 * vq] * inv[0];
          const float a1 = o1.y - lam * Oa[0][d][4 * vq + 1] * inv[0];
          const float a2 = o1.z - lam * Oa[0][d][4 * vq + 2] * inv[0];
          const float a3 = o1.w - lam * Oa[0][d][4 * vq + 3] * inv[0];
          Oa[0][d][4 * vq] = a0; Oa[0][d][4 * vq + 1] = a1; Oa[0][d][4 * vq + 2] = a2; Oa[0][d][4 * vq + 3] = a3;
          ss += a0 * a0 + a1 * a1 + a2 * a2 + a3 * a3;
        }
      ss += __shfl_xor(ss, 32);
      const float rs = rsqrtf(ss * (1.f / 64.f) + EPS) * onorm;
#pragma unroll
      for (int d = 0; d < 2; ++d)
#pragma unroll
        for (int v = 0; v < 16; ++v) Oa[0][d][v] *= rs * subg[d * 32 + crow(v, h)];
    } else {
#pragma unroll
      for (int d = 0; d < 2; ++d)
#pragma unroll
        for (int v = 0; v < 16; ++v) Oa[0][d][v] *= inv[0];
    }
    store_rows(O, KP1, 0, Oa[0][0], qtok, h);
    store_rows(O, KP1, 32, Oa[0][1], qtok, h);
  }
  __syncthreads();
}

DI void attn_phase(const Params& P, int layer, char* smem) {
  char* ws = P.ws;
  u16* qkv = (u16*)(ws + OFF_QKV);
  u16* BR = (u16*)(ws + OFF_XN);
  const float L2E = 1.4426950408889634f;
  const float lambda_init = 0.8f - 0.6f * __expf(-0.3f * (float)layer);
  float lam;
  {
    const float* dl = P.d_lambda + layer * 128;
    float s1 = 0.f, s2 = 0.f;
    for (int i = 0; i < 32; ++i) { s1 += dl[i] * dl[32 + i]; s2 += dl[64 + i] * dl[96 + i]; }
    lam = __expf(s1) - __expf(s2) + lambda_init;
  }
  for (int it = blockIdx.x; it < 2048; it += gridDim.x) {
    const int cls = it >> 8;
    if (cls < 6) {
      const int idx = it & 255;
      const int head = (idx & 7) >> 1;
      const int qb = ((idx >> 3) << 1) + (idx & 1);
      int qtok0, kbeg, kend;
      if (cls < 3) { qtok0 = qb * 256; kbeg = 0; kend = SEQ0; }
      else { const int s = qb >> 3; kbeg = SEQ0 + s * DSEQ; kend = kbeg + DSEQ; qtok0 = kbeg + (qb & 7) * 256; }
      const int typ = cls % 3;
      if (typ == 0) {
        float* DS = (float*)(ws + OFF_DS) + head * 64;
        attn_item<32, 1, false, 1>(qkv + Q_QD + head * 64, 256, qkv + Q_KD + head * 64, 256,
                                   qkv + Q_VTD + (size_t)head * 64 * T, qtok0, kbeg, kend,
                                   0.17677669529663687f * L2E, 0.f, lam, 1.f - lambda_init,
                                   P.d_subln + layer * 64, BR + 768 + head * 64, DS, smem);
        attn_item<32, 1, false, 2>(qkv + Q_QD + head * 64 + 32, 256, qkv + Q_KD + head * 64 + 32, 256,
                                   qkv + Q_VTD + (size_t)head * 64 * T, qtok0, kbeg, kend,
                                   0.17677669529663687f * L2E, 0.f, lam, 1.f - lambda_init,
                                   P.d_subln + layer * 64, BR + 768 + head * 64, DS, smem);
      } else if (typ == 1) {
        attn_item<96, 1, false, 0>(qkv + Q_QC + head * 96, 384, qkv + Q_KC + head * 96, 384,
                                       qkv + Q_VTC + (size_t)head * 64 * T, qtok0, kbeg, kend,
                                       0.10206207261596577f * L2E, 0.f, 0.f, 1.f, nullptr, BR + 512 + head * 64, nullptr, smem);
      } else {
        attn_item<64, 1, false, 0>(qkv + Q_QA + head * 64, 256, qkv + Q_KA + (head >> 1) * 64, 128,
                                       qkv + Q_VTA + (size_t)(head >> 1) * 64 * T, qtok0, kbeg, kend,
                                       0.125f * L2E, 0.f, 0.f, 1.f, nullptr, BR + head * 64, nullptr, smem);
      }
    } else {
      const int idx = it - 1536;
      const int head = (idx & 7) >> 1;
      const int qbg = ((idx >> 3) << 1) + (idx & 1);
      const int qtok0 = qbg * 256;
      int sb, se;
      if (qtok0 < SEQ0) { sb = 0; se = SEQ0; }
      else { sb = SEQ0 + ((qtok0 - SEQ0) / DSEQ) * DSEQ; se = sb + DSEQ; }
      const int kbeg = max(sb, qtok0 - 128), kend = min(se, qtok0 + 256 + 128);
      const float sink = P.b_sink[layer * 4 + head];
      attn_item<64, 1, true, 0>(qkv + Q_QB + head * 64, 256, qkv + Q_KB + (head >> 1) * 64, 128,
                                    qkv + Q_VTB + (size_t)(head >> 1) * 64 * T, qtok0, kbeg, kend,
                                    0.125f * L2E, sink * L2E, 0.f, 1.f, nullptr, BR + 256 + head * 64, nullptr, smem);
    }
  }
}

DI void ew_phase(const Params& P, const float* __restrict__ Y, float coef, const float* __restrict__ gpost,
                 const float* __restrict__ gnext, bool from_inputs) {
  const int tid = opaque_tid();
  const int lane = tid & 63, wave = tid >> 6;
  u16* XN = (u16*)(P.ws + OFF_XN);
  for (int tok = blockIdx.x * 8 + wave; tok < T; tok += gridDim.x * 8) {
    const float* xs = from_inputs ? (tok < SEQ0 ? P.x_prompt + (size_t)tok * DM : P.x_sample + (size_t)(tok - SEQ0) * DM)
                                  : P.out + (size_t)tok * DM;
    float4 x[4];
#pragma unroll
    for (int i = 0; i < 4; ++i) x[i] = *(const float4*)(xs + (i * 64 + lane) * 4);
    if (Y) {
      float4 y[4];
      float ss = 0.f;
#pragma unroll
      for (int i = 0; i < 4; ++i) {
        y[i] = *(const float4*)(Y + (size_t)tok * YP + (i * 64 + lane) * 4);
        ss += y[i].x * y[i].x + y[i].y * y[i].y + y[i].z * y[i].z + y[i].w * y[i].w;
      }
      ss = wave_sum(ss);
      const float rs = rsqrtf(ss * (1.f / 1024.f) + EPS) * coef;
#pragma unroll
      for (int i = 0; i < 4; ++i) {
        float4 g = *(const float4*)(gpost + (i * 64 + lane) * 4);
        x[i].x += y[i].x * rs * g.x; x[i].y += y[i].y * rs * g.y;
        x[i].z += y[i].z * rs * g.z; x[i].w += y[i].w * rs * g.w;
      }
    }
#pragma unroll
    for (int i = 0; i < 4; ++i) *(float4*)(P.out + (size_t)tok * DM + (i * 64 + lane) * 4) = x[i];
    if (gnext) {
      float ss = 0.f;
#pragma unroll
      for (int i = 0; i < 4; ++i) ss += x[i].x * x[i].x + x[i].y * x[i].y + x[i].z * x[i].z + x[i].w * x[i].w;
      ss = wave_sum(ss);
      const float rs = rsqrtf(ss * (1.f / 1024.f) + EPS);
#pragma unroll
      for (int i = 0; i < 4; ++i) {
        float4 g = *(const float4*)(gnext + (i * 64 + lane) * 4);
        uint2 pk;
        pk.x = pk2(x[i].x * rs * g.x, x[i].y * rs * g.y);
        pk.y = pk2(x[i].z * rs * g.z, x[i].w * rs * g.w);
        *(uint2*)(XN + (size_t)tok * KP1 + (i * 64 + lane) * 4) = pk;
      }
    }
  }
}

DI int colmap(int mode, int n, int nsrc) {
  if (mode == 1) { return ((n >> 5) & 1) * DFF + (n >> 6) * 32 + (n & 31); }
  if (mode == 2) {
    if (n < 1664) return n;
    if (n < 2432) return n + 32;
    if (n < 2464) return n - 2432 + 1664;
    if (n < 2560) return -1;
    return n - 96;
  }
  return n < nsrc ? n : -1;
}
DI void conv_job(u16* __restrict__ dst, int ldd, const float* __restrict__ src, int Nd, int K, int lds, int mode,
                 const float* __restrict__ kscale) {
  const int total = Nd * (K >> 3);
  const int gthreads = gridDim.x * NTHR;
  for (int idx = blockIdx.x * NTHR + opaque_tid(); idx < total; idx += gthreads) {
    const int n = idx % Nd, k8 = idx / Nd;
    const int col = colmap(mode, n, lds);
    float v[8];
#pragma unroll
    for (int j = 0; j < 8; ++j) {
      float x = 0.f;
      if (col >= 0) {
        x = src[(size_t)(k8 * 8 + j) * lds + col];
        if (kscale) x *= kscale[k8 * 8 + j];
      }
      v[j] = x;
    }
    uint4 pk = {pk2(v[0], v[1]), pk2(v[2], v[3]), pk2(v[4], v[5]), pk2(v[6], v[7])};
    *(uint4*)(dst + (size_t)n * ldd + k8 * 8) = pk;
  }
}
DI void convert_layer(const Params& P, int l) {
  u16* W = (u16*)(P.ws + OFF_W);
  for (int s = 0; s < 2; ++s) {
    conv_job(W + W_WI + (size_t)s * 5632 * KP1, KP1, P.ffn_wi + ((size_t)l * 2 + s) * 1024 * 5632, 5632, 1024, 5632, 1, nullptr);
    conv_job(W + W_WO + (size_t)s * 1024 * KP2, KP2, P.ffn_wo + ((size_t)l * 2 + s) * 2816 * 1024, 1024, 2816, 1024, 0, nullptr);
  }
  conv_job(W + W_WIN, KP1, P.w_in + (size_t)l * 1024 * NPROJ, 6656, 1024, NPROJ, 2, nullptr);
  conv_job(W + W_WUQ, 384, P.c_w_uq + (size_t)l * 384 * 384, 512, 384, 384, 0, P.c_q_norm + l * 384);
  conv_job(W + W_WUKV, 256, P.c_w_ukv + (size_t)l * 256 * 512, 512, 256, 512, 0, P.c_kv_norm + l * 256);
  conv_job(W + W_WB, KP1, P.w_branch + (size_t)l * 1024 * 1024, 1024, 1024, 1024, 0, nullptr);
  conv_job(W + W_WOUT, KP1, P.w_out + (size_t)l * 1024 * 1024, 1024, 1024, 1024, 0, nullptr);
}
DI void rope_tables(const Params& P) {
  float2* R64 = (float2*)(P.ws + OFF_R64);
  float2* R32 = (float2*)(P.ws + OFF_R32);
  const int gthreads = gridDim.x * NTHR;
  for (int idx = blockIdx.x * NTHR + opaque_tid(); idx < 16384 * 48; idx += gthreads) {
    int pos, f; double base; float2* dst;
    if (idx < 16384 * 32) { pos = idx >> 5; f = idx & 31; base = 0.7498942093324559; dst = R64 + idx; }
    else { const int i2 = idx - 16384 * 32; pos = i2 >> 4; f = i2 & 15; base = 0.5623413251903491; dst = R32 + i2; }
    double inv = 1.0;
    for (int k = 0; k < f; ++k) inv *= base;
    const float ang = (float)pos * (float)inv;
    double tr = (double)ang * 0.15915494309189535;
    tr -= rint(tr);
    const float tf = (float)tr;
    *dst = make_float2(__builtin_amdgcn_cosf(tf), __builtin_amdgcn_sinf(tf));
  }
}

DI void fast_grid_barrier(unsigned* bar, unsigned nblk) {
  asm volatile("s_waitcnt vmcnt(0) lgkmcnt(0)" ::: "memory");
  __syncthreads();
  if (threadIdx.x == 0) {
    __builtin_amdgcn_fence(__ATOMIC_RELEASE, "agent");
    asm volatile("s_waitcnt vmcnt(0) lgkmcnt(0)" ::: "memory");
    const unsigned gen = __hip_atomic_load(&bar[64], __ATOMIC_RELAXED, __HIP_MEMORY_SCOPE_AGENT);
    const unsigned old = __hip_atomic_fetch_add(&bar[0], 1u, __ATOMIC_RELAXED, __HIP_MEMORY_SCOPE_AGENT);
    if (old == nblk - 1u) {
      __hip_atomic_store(&bar[0], 0u, __ATOMIC_RELAXED, __HIP_MEMORY_SCOPE_AGENT);
      __hip_atomic_fetch_add(&bar[64], 1u, __ATOMIC_RELEASE, __HIP_MEMORY_SCOPE_AGENT);
    } else {
      while (__hip_atomic_load(&bar[64], __ATOMIC_RELAXED, __HIP_MEMORY_SCOPE_AGENT) == gen) __builtin_amdgcn_s_sleep(1);
    }
    __builtin_amdgcn_fence(__ATOMIC_ACQUIRE, "agent");
    asm volatile("s_waitcnt vmcnt(0) lgkmcnt(0)" ::: "memory");
  }
  __syncthreads();
}

__global__ void __launch_bounds__(NTHR) __attribute__((amdgpu_waves_per_eu(2, 2))) mega(Params P) {
  extern __shared__ __attribute__((aligned(16))) char smem[];
  cg::grid_group grid = cg::this_grid();
  int phase = 0;
#define ACTIVE() (phase >= P.phase_lo && phase < P.phase_hi)
#define SEAM() do { ++phase; if (P.coop) { if (phase == 1) grid.sync(); else fast_grid_barrier((unsigned*)(P.ws + OFF_BAR), gridDim.x); } } while (0)
  u16* W = (u16*)(P.ws + OFF_W);
  u16* XN = (u16*)(P.ws + OFF_XN);
  u16* R2 = (u16*)(P.ws + OFF_R2);
  u16* qkv = (u16*)(P.ws + OFF_QKV);
  const float* Y = (const float*)(qkv + Q_Y);

  if (ACTIVE()) {
    rope_tables(P);
    convert_layer(P, 0);
    ew_phase(P, nullptr, 0.f, nullptr, P.norm_g, true);
  }
  SEAM();
  for (int l = 0; l < 4; ++l) {
    const float* g = P.norm_g + (size_t)l * 6 * DM;
    if (ACTIVE()) gemm_phase<M_FFNUP, 4>(W + W_WI, KP1, XN, KP1, DM, 22, smem, P, l);
    SEAM();
    if (ACTIVE()) gemm_phase<M_Y, 4>(W + W_WO, KP2, R2, KP2, DFF, 4, smem, P, l);
    SEAM();
    if (ACTIVE()) ew_phase(P, Y, 0.5f, g + DM, g + 2 * DM, false);
    SEAM();
    if (ACTIVE()) {
      gemm_phase<M_PROJ, 4>(W + W_WIN, KP1, XN, KP1, DM, 10, smem, P, l);
      gemm_phase<M_GATE, 4>(W + W_WIN + 2560ull * KP1, KP1, XN, KP1, DM, 16, smem, P, l);
    }
    SEAM();
    if (ACTIVE()) {
      gemm_phase<M_CUQ, 4>(W + W_WUQ, 384, qkv + Q_CQ, 384, 384, 2, smem, P, l);
      gemm_phase<M_CUKV, 4>(W + W_WUKV, 256, qkv + Q_CKV, 256, 256, 2, smem, P, l);
    }
    SEAM();
    if (ACTIVE()) attn_phase(P, l, smem);
    SEAM();
    if (ACTIVE()) gemm_phase<M_MERGE, 2>(W + W_WB, KP1, XN, KP1, DM, 4, smem, P, l);
    SEAM();
    if (ACTIVE()) gemm_phase<M_Y, 4>(W + W_WOUT, KP1, qkv + Q_MERGED, KP1, DM, 4, smem, P, l);
    SEAM();
    if (ACTIVE()) ew_phase(P, Y, 1.0f, g + 3 * DM, g + 4 * DM, false);
    SEAM();
    if (ACTIVE()) gemm_phase<M_FFNUP, 4>(W + W_WI + 5632ull * KP1, KP1, XN, KP1, DM, 22, smem, P, l);
    SEAM();
    if (ACTIVE()) gemm_phase<M_Y, 4>(W + W_WO + 1024ull * KP2, KP2, R2, KP2, DFF, 4, smem, P, l);
    SEAM();
    if (ACTIVE()) {
      ew_phase(P, Y, 0.5f, g + 5 * DM, l < 3 ? g + 6 * DM : nullptr, false);
      if (l < 3) convert_layer(P, l + 1);
    }
    SEAM();
  }
}

constexpr int N_PHASES = 1 + 12 * 4;

extern "C" void kernel_launch(void* const* d_in, const int* in_sizes, int n_in, void* d_out, int out_size, void* d_ws,
                              size_t ws_size, hipStream_t stream) {
  static int grid_blocks = 0;
  if (!grid_blocks) {
    int dev = 0, cus = 0, per_cu = 0;
    hipGetDevice(&dev);
    hipDeviceGetAttribute(&cus, hipDeviceAttributeMultiprocessorCount, dev);
    hipFuncSetAttribute((const void*)mega, hipFuncAttributeMaxDynamicSharedMemorySize, SMEM_BYTES);
    hipOccupancyMaxActiveBlocksPerMultiprocessor(&per_cu, mega, NTHR, SMEM_BYTES);
    if (per_cu < 1) per_cu = 1;
    grid_blocks = cus * per_cu;
  }
  if (ws_size < WS_NEEDED) fprintf(stderr, "workspace too small: %zu < %zu\n", ws_size, (size_t)WS_NEEDED);
  Params P{};
  P.x_prompt = (const float*)d_in[0]; P.x_sample = (const float*)d_in[1]; P.norm_g = (const float*)d_in[2];
  P.w_in = (const float*)d_in[3]; P.a_qk_norm = (const float*)d_in[4]; P.b_sink = (const float*)d_in[5];
  P.c_q_norm = (const float*)d_in[6]; P.c_kv_norm = (const float*)d_in[7]; P.c_w_uq = (const float*)d_in[8];
  P.c_w_ukv = (const float*)d_in[9]; P.d_lambda = (const float*)d_in[10]; P.d_subln = (const float*)d_in[11];
  P.w_branch = (const float*)d_in[12]; P.w_out = (const float*)d_in[13]; P.ffn_wi = (const float*)d_in[14];
  P.ffn_wo = (const float*)d_in[15];
  P.out = (float*)d_out; P.ws = (char*)d_ws;
#if MULTI_LAUNCH
  for (int ph = 0; ph < N_PHASES; ++ph) {
    P.phase_lo = ph; P.phase_hi = ph + 1; P.coop = 0; P.pad0 = 0;
    hipLaunchKernelGGL(mega, dim3(grid_blocks), dim3(NTHR), SMEM_BYTES, stream, P);
  }
#else
  P.phase_lo = 0; P.phase_hi = 1 << 30; P.coop = 1; P.pad0 = 0;
  hipMemsetAsync((char*)d_ws + OFF_BAR, 0, 1024, stream);
  void* args[] = {&P};
  hipError_t e = hipLaunchCooperativeKernel((const void*)mega, dim3(grid_blocks), dim3(NTHR), args, SMEM_BYTES, stream);
  if (e != hipSuccess) fprintf(stderr, "cooperative launch failed: %s (grid %d)\n", hipGetErrorString(e), grid_blocks);
#endif
}
```

```cpp
#include <hip/hip_runtime.h>
#include <hip/hip_cooperative_groups.h>
#include <cstdio>
#include <cstdint>
#include <type_traits>
namespace cg = cooperative_groups;

#ifndef MULTI_LAUNCH
#define MULTI_LAUNCH 0
#endif

#define DI __device__ __forceinline__
typedef unsigned short u16;
typedef __attribute__((ext_vector_type(8))) short bf16x8;
typedef __attribute__((ext_vector_type(16))) float f32x16;
typedef __attribute__((ext_vector_type(2))) float f32x2_t;
typedef __attribute__((ext_vector_type(2))) __bf16 bf16x2_t;

constexpr int T = 32768;
constexpr int DM = 1024;
constexpr int DFF = 2816;
constexpr int KP1 = 1088;
constexpr int KP2 = 2880;
constexpr int GP = 4160;
constexpr int YP = 1040;
constexpr int NPROJ = 6560;
constexpr int SEQ0 = 16384;
constexpr int DSEQ = 2048;
constexpr float EPS = 1e-6f;
constexpr int NTHR = 512;
constexpr int LSTR = 72;
constexpr int SMEM_BYTES = 2 * 2 * 256 * LSTR * 2;

constexpr size_t W_WI = 0;
constexpr size_t W_WO = W_WI + 2ull * 5632 * KP1;
constexpr size_t W_WIN = W_WO + 2ull * 1024 * KP2;
constexpr size_t W_WUQ = W_WIN + 6656ull * KP1;
constexpr size_t W_WUKV = W_WUQ + 512ull * 384;
constexpr size_t W_WB = W_WUKV + 512ull * 256;
constexpr size_t W_WOUT = W_WB + 1024ull * KP1;
constexpr size_t W_TOTAL = W_WOUT + 1024ull * KP1;

constexpr size_t OFF_W = 0;
constexpr size_t OFF_XN = OFF_W + W_TOTAL * 2;
constexpr size_t OFF_R2 = OFF_XN + (size_t)T * KP1 * 2;
constexpr size_t OFF_QKV = OFF_R2 + (size_t)T * GP * 2;
constexpr size_t OFF_SS = OFF_QKV + (size_t)T * 3456 * 2;
constexpr size_t OFF_R64 = OFF_SS + (size_t)T * 20 * 4;
constexpr size_t OFF_R32 = OFF_R64 + 16384ull * 32 * 8;
constexpr size_t OFF_DS = OFF_R32 + 16384ull * 16 * 8;
constexpr size_t OFF_BAR = OFF_DS + (size_t)T * 256 * 4;
constexpr size_t WS_NEEDED = OFF_BAR + 1024;

constexpr size_t Q_QA = 0;
constexpr size_t Q_KA = (size_t)T * 256;
constexpr size_t Q_VTA = (size_t)T * 384;
constexpr size_t Q_QB = (size_t)T * 512;
constexpr size_t Q_KB = (size_t)T * 768;
constexpr size_t Q_VTB = (size_t)T * 896;
constexpr size_t Q_CQ = (size_t)T * 1024;
constexpr size_t Q_CKV = (size_t)T * 1408;
constexpr size_t Q_QC = (size_t)T * 1664;
constexpr size_t Q_KC = (size_t)T * 2048;
constexpr size_t Q_VTC = (size_t)T * 2432;
constexpr size_t Q_QD = (size_t)T * 2688;
constexpr size_t Q_KD = (size_t)T * 2944;
constexpr size_t Q_VTD = (size_t)T * 3200;
constexpr size_t Q_MERGED = 0;
constexpr size_t Q_Y = (size_t)T * KP1;

struct Params {
  const float* x_prompt; const float* x_sample; const float* norm_g; const float* w_in;
  const float* a_qk_norm; const float* b_sink; const float* c_q_norm; const float* c_kv_norm;
  const float* c_w_uq; const float* c_w_ukv; const float* d_lambda; const float* d_subln;
  const float* w_branch; const float* w_out; const float* ffn_wi; const float* ffn_wo;
  float* out; char* ws;
  int phase_lo; int phase_hi; int coop; int pad0;
};

DI unsigned pk2(float a, float b) {
  f32x2_t v = {a, b};
  bf16x2_t r = __builtin_convertvector(v, bf16x2_t);
  return __builtin_bit_cast(unsigned, r);
}
DI u16 f2bf(float a) { return (u16)(pk2(a, 0.f) & 0xffffu); }
DI float bf2f(unsigned bits16) { return __uint_as_float(bits16 << 16); }
DI int crow(int v, int h) { return (v & 3) + 8 * (v >> 2) + 4 * h; }
DI int pos_of(int tok) { return tok < SEQ0 ? tok : ((tok - SEQ0) & (DSEQ - 1)); }
#define MFMA32(a, b, c) __builtin_amdgcn_mfma_f32_32x32x16_bf16((a), (b), (c), 0, 0, 0)

typedef __attribute__((ext_vector_type(4))) unsigned u32x4;
DI u32x4 gld16(const void* p) { u32x4 r; asm volatile("global_load_dwordx4 %0, %1, off" : "=v"(r) : "v"(p)); return r; }
DI void wait_vm0(u32x4& a) { asm volatile("s_waitcnt vmcnt(0)" : "+v"(a) :: "memory"); }
DI void wait_vm0(u32x4& a, u32x4& b) { asm volatile("s_waitcnt vmcnt(0)" : "+v"(a), "+v"(b) :: "memory"); }
DI void wait_vm0(u32x4& a, u32x4& b, u32x4& c) { asm volatile("s_waitcnt vmcnt(0)" : "+v"(a), "+v"(b), "+v"(c) :: "memory"); }
DI void wait_vm0(u32x4& a, u32x4& b, u32x4& c, u32x4& d) { asm volatile("s_waitcnt vmcnt(0)" : "+v"(a), "+v"(b), "+v"(c), "+v"(d) :: "memory"); }
DI u32x4 gld16s(unsigned voff, const void* sbase) { u32x4 r; asm volatile("global_load_dwordx4 %0, %1, %2" : "=v"(r) : "v"(voff), "s"(sbase)); return r; }
#define DEF_WAIT8(name, cnt) DI void name(u32x4& a, u32x4& b, u32x4& c, u32x4& d, u32x4& e, u32x4& f, u32x4& g, u32x4& h) { asm volatile("s_waitcnt vmcnt(" #cnt ")" : "+v"(a), "+v"(b), "+v"(c), "+v"(d), "+v"(e), "+v"(f), "+v"(g), "+v"(h) :: "memory"); }
#define DEF_WAIT6(name, cnt) DI void name(u32x4& a, u32x4& b, u32x4& c, u32x4& d, u32x4& e, u32x4& f) { asm volatile("s_waitcnt vmcnt(" #cnt ")" : "+v"(a), "+v"(b), "+v"(c), "+v"(d), "+v"(e), "+v"(f) :: "memory"); }
DEF_WAIT8(wait8_vm8, 8)
DEF_WAIT8(wait8_vm0, 0)
DEF_WAIT6(wait6_vm6, 6)
DEF_WAIT6(wait6_vm0, 0)
DI int opaque_tid() { int t = threadIdx.x; asm volatile("" : "+v"(t)); return t; }
DI float wave_sum(float v) {
#pragma unroll
  for (int m = 32; m >= 1; m >>= 1) v += __shfl_xor(v, m);
  return v;
}

DI void rope32_blk(f32x16& a, const float2* __restrict__ tab, int h) {
#pragma unroll
  for (int v = 0; v < 8; ++v) {
    float2 cs = tab[crow(v, h)];
    float x1 = a[v], x2 = a[v + 8];
    a[v] = x1 * cs.x - x2 * cs.y;
    a[v + 8] = x2 * cs.x + x1 * cs.y;
  }
}
DI void rope64_blk(f32x16& a0, f32x16& a1, const float2* __restrict__ tab, int h) {
#pragma unroll
  for (int v = 0; v < 16; ++v) {
    float2 cs = tab[crow(v, h)];
    float x1 = a0[v], x2 = a1[v];
    a0[v] = x1 * cs.x - x2 * cs.y;
    a1[v] = x2 * cs.x + x1 * cs.y;
  }
}
DI void store_rows(u16* __restrict__ base, int ld, int col0, const f32x16& a, int tok, int h) {
#pragma unroll
  for (int vq = 0; vq < 4; ++vq) {
    uint2 pk;
    pk.x = pk2(a[4 * vq], a[4 * vq + 1]);
    pk.y = pk2(a[4 * vq + 2], a[4 * vq + 3]);
    *(uint2*)(base + (size_t)tok * ld + col0 + 8 * vq + 4 * h) = pk;
  }
}
DI void store_T(u16* __restrict__ base, int row0, const f32x16& a, int tok, int h) {
  const int tp = (tok & ~12) | ((tok & 4) << 1) | ((tok & 8) >> 1);
#pragma unroll
  for (int v = 0; v < 16; ++v) base[(size_t)((row0 + crow(v, h)) >> 6) * 64 * T + (size_t)(tp >> 7) * 8192 + ((row0 + crow(v, h)) & 63) * 128 + (tp & 127)] = f2bf(a[v]);
}

enum { M_FFNUP = 0, M_Y = 1, M_PROJ = 2, M_CUQ = 3, M_CUKV = 4, M_MERGE = 5, M_GATE = 6 };

template <int MODE, int NJ>
DI void gemm_epilogue(f32x16 (&acc)[2][NJ], int fbase, int tbase, int r, int h, const Params& P, int layer) {
  char* ws = P.ws;
  u16* qkv = (u16*)(ws + OFF_QKV);
  const float2* R64 = (const float2*)(ws + OFF_R64);
  const float2* R32 = (const float2*)(ws + OFF_R32);
  float* SS = (float*)(ws + OFF_SS);
  if constexpr (MODE == M_FFNUP) {
    u16* H = (u16*)(ws + OFF_R2);
    const int hf0 = (fbase >> 6) * 32;
#pragma unroll
    for (int j = 0; j < NJ; ++j) {
      const int tok = tbase + j * 32 + r;
      f32x16 o;
#pragma unroll
      for (int v = 0; v < 16; ++v) {
        float g = acc[0][j][v], u = acc[1][j][v];
        o[v] = g * __builtin_amdgcn_rcpf(1.f + __builtin_amdgcn_exp2f(-1.4426950408889634f * g)) * u;
      }
      store_rows(H, KP2, hf0, o, tok, h);
    }
  } else if constexpr (MODE == M_Y) {
    u16* Yb = qkv + Q_Y;
#pragma unroll
    for (int j = 0; j < NJ; ++j) {
      const int tok = tbase + j * 32 + r;
      store_rows(Yb, KP1, fbase, acc[0][j], tok, h);
      store_rows(Yb, KP1, fbase + 32, acc[1][j], tok, h);
    }
  } else if constexpr (MODE == M_PROJ) {
    if (fbase < 384) {
      const bool isK = fbase >= 256;
      const float* g = P.a_qk_norm + layer * 128 + (isK ? 64 : 0);
      u16* dst = qkv + (isK ? Q_KA : Q_QA);
      const int ld = isK ? 128 : 256;
      const int c0 = isK ? fbase - 256 : fbase;
      float gv[2][16];
#pragma unroll
      for (int i = 0; i < 2; ++i)
#pragma unroll
        for (int v = 0; v < 16; ++v) gv[i][v] = g[i * 32 + crow(v, h)];
#pragma unroll
      for (int j = 0; j < NJ; ++j) {
        const int tok = tbase + j * 32 + r;
        const int pos = pos_of(tok);
        float ss = 0.f;
#pragma unroll
        for (int i = 0; i < 2; ++i)
#pragma unroll
          for (int v = 0; v < 16; ++v) ss += acc[i][j][v] * acc[i][j][v];
        ss += __shfl_xor(ss, 32);
        const float rs = rsqrtf(ss * (1.f / 64.f) + EPS);
#pragma unroll
        for (int i = 0; i < 2; ++i)
#pragma unroll
          for (int v = 0; v < 16; ++v) acc[i][j][v] *= rs * gv[i][v];
        rope32_blk(acc[0][j], R32 + (size_t)(pos >> 6) * 16, h);
        rope32_blk(acc[1][j], R32 + (size_t)(pos & 63) * 16, h);
        store_rows(dst, ld, c0, acc[0][j], tok, h);
        store_rows(dst, ld, c0 + 32, acc[1][j], tok, h);
      }
    } else if (fbase < 512) {
#pragma unroll
      for (int j = 0; j < NJ; ++j) {
        const int tok = tbase + j * 32 + r;
        store_T(qkv + Q_VTA, fbase - 384, acc[0][j], tok, h);
        store_T(qkv + Q_VTA, fbase - 384 + 32, acc[1][j], tok, h);
      }
    } else if (fbase < 896) {
      const bool isK = fbase >= 768;
      u16* dst = qkv + (isK ? Q_KB : Q_QB);
      const int ld = isK ? 128 : 256;
      const int c0 = isK ? fbase - 768 : fbase - 512;
#pragma unroll
      for (int j = 0; j < NJ; ++j) {
        const int tok = tbase + j * 32 + r;
        const int pos = pos_of(tok);
        rope64_blk(acc[0][j], acc[1][j], R64 + (size_t)pos * 32, h);
        store_rows(dst, ld, c0, acc[0][j], tok, h);
        store_rows(dst, ld, c0 + 32, acc[1][j], tok, h);
      }
    } else if (fbase < 1024) {
#pragma unroll
      for (int j = 0; j < NJ; ++j) {
        const int tok = tbase + j * 32 + r;
        store_T(qkv + Q_VTB, fbase - 896, acc[0][j], tok, h);
        store_T(qkv + Q_VTB, fbase - 896 + 32, acc[1][j], tok, h);
      }
    } else if (fbase < 1664) {
      const bool isKV = fbase >= 1408;
      u16* dst = qkv + (isKV ? Q_CKV : Q_CQ);
      const int ld = isKV ? 256 : 384;
      const int c0 = isKV ? fbase - 1408 : fbase - 1024;
      const int sb = (isKV ? 12 : 0) + (c0 >> 5);
#pragma unroll
      for (int j = 0; j < NJ; ++j) {
        const int tok = tbase + j * 32 + r;
#pragma unroll
        for (int i = 0; i < 2; ++i) {
          float ss = 0.f;
#pragma unroll
          for (int v = 0; v < 16; ++v) ss += acc[i][j][v] * acc[i][j][v];
          ss += __shfl_xor(ss, 32);
          if (h == 0) SS[(size_t)tok * 20 + sb + i] = ss;
          store_rows(dst, ld, c0 + i * 32, acc[i][j], tok, h);
        }
      }
    } else if (fbase < 2176) {
      const bool isK = fbase >= 1920;
      u16* dst = qkv + (isK ? Q_KD : Q_QD);
      const int c0 = isK ? fbase - 1920 : fbase - 1664;
#pragma unroll
      for (int j = 0; j < NJ; ++j) {
        const int tok = tbase + j * 32 + r;
        const int pos = pos_of(tok);
#pragma unroll
        for (int i = 0; i < 2; ++i) {
          rope32_blk(acc[i][j], R32 + (size_t)pos * 16, h);
          store_rows(dst, 256, c0 + i * 32, acc[i][j], tok, h);
        }
      }
    } else if (fbase < 2432) {
#pragma unroll
      for (int j = 0; j < NJ; ++j) {
        const int tok = tbase + j * 32 + r;
        store_T(qkv + Q_VTD, fbase - 2176, acc[0][j], tok, h);
        store_T(qkv + Q_VTD, fbase - 2176 + 32, acc[1][j], tok, h);
      }
    } else if (fbase == 2432) {
#pragma unroll
      for (int j = 0; j < NJ; ++j) {
        const int tok = tbase + j * 32 + r;
        const int pos = pos_of(tok);
        rope32_blk(acc[0][j], R32 + (size_t)pos * 16, h);
#pragma unroll
        for (int hd = 0; hd < 4; ++hd) store_rows(qkv + Q_KC, 384, hd * 96 + 64, acc[0][j], tok, h);
      }
    }
  } else if constexpr (MODE == M_GATE) {
    u16* G = (u16*)(ws + OFF_R2);
#pragma unroll
    for (int j = 0; j < NJ; ++j) {
      const int tok = tbase + j * 32 + r;
#pragma unroll
      for (int i = 0; i < 2; ++i) {
        f32x16 o;
#pragma unroll
        for (int v = 0; v < 16; ++v) o[v] = __builtin_amdgcn_rcpf(1.f + __builtin_amdgcn_exp2f(-1.4426950408889634f * acc[i][j][v]));
        store_rows(G, GP, fbase + i * 32, o, tok, h);
      }
    }
  } else if constexpr (MODE == M_CUQ) {
    if (fbase >= 384) return;
#pragma unroll
    for (int j = 0; j < NJ; ++j) {
      const int tok = tbase + j * 32 + r;
      const int pos = pos_of(tok);
      float ss = 0.f;
#pragma unroll
      for (int b = 0; b < 12; ++b) ss += SS[(size_t)tok * 20 + b];
      const float rs = rsqrtf(ss * (1.f / 384.f) + EPS);
#pragma unroll
      for (int i = 0; i < 2; ++i) {
        const int blk = (fbase >> 5) + i;
#pragma unroll
        for (int v = 0; v < 16; ++v) acc[i][j][v] *= rs;
        if (blk % 3 == 2) rope32_blk(acc[i][j], R32 + (size_t)pos * 16, h);
        store_rows(qkv + Q_QC, 384, blk * 32, acc[i][j], tok, h);
      }
    }
  } else if constexpr (MODE == M_CUKV) {
#pragma unroll
    for (int j = 0; j < NJ; ++j) {
      const int tok = tbase + j * 32 + r;
      float ss = 0.f;
#pragma unroll
      for (int b = 0; b < 8; ++b) ss += SS[(size_t)tok * 20 + 12 + b];
      const float rs = rsqrtf(ss * (1.f / 256.f) + EPS);
#pragma unroll
      for (int i = 0; i < 2; ++i) {
        const int blk = (fbase >> 5) + i;
        const int hd = blk >> 2, q = blk & 3;
#pragma unroll
        for (int v = 0; v < 16; ++v) acc[i][j][v] *= rs;
        if (q < 2) store_rows(qkv + Q_KC, 384, hd * 96 + q * 32, acc[i][j], tok, h);
        else store_T(qkv + Q_VTC, hd * 64 + (q - 2) * 32, acc[i][j], tok, h);
      }
    }
  } else if constexpr (MODE == M_MERGE) {
#pragma unroll
    for (int j = 0; j < NJ; ++j) {
      const int tok = tbase + j * 32 + r;
      store_rows(qkv + Q_MERGED, KP1, fbase, acc[0][j], tok, h);
      store_rows(qkv + Q_MERGED, KP1, fbase + 32, acc[1][j], tok, h);
    }
  }
}

typedef __attribute__((address_space(3))) unsigned lds_u32_t;
typedef __attribute__((address_space(1))) const unsigned glb_u32_t;
template <int MODE, int NJ>
DI void gemm_tile(const u16* __restrict__ Wt, int ldw, const u16* __restrict__ X, int ldx, int K, int f0, int t0, char* smem,
                  const Params& P, int layer) {
  constexpr int XROWS = NJ * 64;
  constexpr int WSTG = 256 * 64, XSTG = XROWS * 64;
  u16* sW = (u16*)smem;
  u16* sX = sW + 2 * WSTG;
  const int tid = opaque_tid(), lane = tid & 63, wave = tid >> 6, r = lane & 31, h = lane >> 5;
  const int wf = wave & 3, wt = wave >> 2;
  f32x16 acc[2][NJ];
  f32x16 tot[2][MODE == M_MERGE ? NJ : 1];
#pragma unroll
  for (int i = 0; i < 2; ++i)
#pragma unroll
    for (int j = 0; j < NJ; ++j)
#pragma unroll
      for (int v = 0; v < 16; ++v) acc[i][j][v] = 0.f;
  if constexpr (MODE == M_MERGE) {
#pragma unroll
    for (int i = 0; i < 2; ++i)
#pragma unroll
      for (int j = 0; j < NJ; ++j)
#pragma unroll
        for (int v = 0; v < 16; ++v) tot[i][j][v] = 0.f;
  }
  const int nk = K >> 6;
  const int srow = tid >> 3;
  const int schunk = (tid & 7) ^ ((tid >> 4) & 7);
  const u16* wp = Wt + (size_t)(f0 + srow) * ldw + schunk * 8;
  const u16* xp = X + (size_t)(t0 + srow) * ldx + schunk * 8;
  const int fbase = f0 + wf * 64, tbase = t0 + wt * (NJ * 32);

  auto issue = [&](int kt, int buf) {
#pragma unroll
    for (int i = 0; i < 4; ++i)
      __builtin_amdgcn_global_load_lds((glb_u32_t*)(wp + (size_t)(i * 64) * ldw + kt * 64),
                                       (lds_u32_t*)(sW + buf * WSTG + i * 4096 + tid * 8), 16, 0, 0);
#pragma unroll
    for (int i = 0; i < NJ; ++i)
      __builtin_amdgcn_global_load_lds((glb_u32_t*)(xp + (size_t)(i * 64) * ldx + kt * 64),
                                       (lds_u32_t*)(sX + buf * XSTG + i * 4096 + tid * 8), 16, 0, 0);
  };
  const int swz = (r >> 1) & 7;
  auto compute = [&](int buf, int kt) {
    const u16* aW = sW + buf * WSTG + (wf * 64 + r) * 64;
    const u16* aX = sX + buf * XSTG + (wt * (NJ * 32) + r) * 64;
#pragma unroll
    for (int ks = 0; ks < 4; ++ks) {
      const int co = ((2 * ks + h) ^ swz) * 8;
      bf16x8 wfrag[2], xfrag[NJ];
#pragma unroll
      for (int i = 0; i < 2; ++i) wfrag[i] = *(const bf16x8*)(aW + i * 32 * 64 + co);
#pragma unroll
      for (int j = 0; j < NJ; ++j) xfrag[j] = *(const bf16x8*)(aX + j * 32 * 64 + co);
#pragma unroll
      for (int i = 0; i < 2; ++i)
#pragma unroll
        for (int j = 0; j < NJ; ++j) acc[i][j] = MFMA32(wfrag[i], xfrag[j], acc[i][j]);
    }
    if constexpr (MODE == M_MERGE) {
      if ((kt & 3) == 3) {
        const int br = kt >> 2;
        const u16* G = (const u16*)(P.ws + OFF_R2);
#pragma unroll
        for (int j = 0; j < NJ; ++j) {
          const int tok = tbase + j * 32 + r;
#pragma unroll
          for (int i = 0; i < 2; ++i)
#pragma unroll
            for (int vq = 0; vq < 4; ++vq) {
              uint2 gp = *(const uint2*)(G + (size_t)tok * GP + br * 1024 + fbase + i * 32 + 8 * vq + 4 * h);
              tot[i][j][4 * vq + 0] += bf2f(gp.x & 0xffffu) * acc[i][j][4 * vq + 0];
              tot[i][j][4 * vq + 1] += bf2f(gp.x >> 16) * acc[i][j][4 * vq + 1];
              tot[i][j][4 * vq + 2] += bf2f(gp.y & 0xffffu) * acc[i][j][4 * vq + 2];
              tot[i][j][4 * vq + 3] += bf2f(gp.y >> 16) * acc[i][j][4 * vq + 3];
              acc[i][j][4 * vq + 0] = 0.f; acc[i][j][4 * vq + 1] = 0.f;
              acc[i][j][4 * vq + 2] = 0.f; acc[i][j][4 * vq + 3] = 0.f;
            }
        }
      }
    }
  };

  issue(0, 0);
  asm volatile("s_waitcnt vmcnt(0)" ::: "memory");
  __syncthreads();
  for (int kt = 0; kt < nk; ++kt) {
    const int buf = kt & 1;
    if (kt + 1 < nk) issue(kt + 1, buf ^ 1);
    compute(buf, kt);
    asm volatile("s_waitcnt vmcnt(0) lgkmcnt(0)" ::: "memory");
    __syncthreads();
  }
  if constexpr (MODE == M_MERGE) gemm_epilogue<MODE, NJ>(tot, fbase, tbase, r, h, P, layer);
  else gemm_epilogue<MODE, NJ>(acc, fbase, tbase, r, h, P, layer);
}

template <int MODE, int NJ>
DI void gemm_phase(const u16* Wt, int ldw, const u16* X, int ldx, int K, int nF, char* smem, const Params& P, int layer) {
  constexpr int TT = NJ * 64;
  const int nT = T / TT;
  const int ntiles = nF * nT;
  for (int idx = blockIdx.x; idx < ntiles; idx += gridDim.x) {
    const int tt_lo = idx & 15;
    const int rest = idx >> 4;
    const int ft = rest % nF;
    const int tt = (rest / nF) * 16 + tt_lo;
    gemm_tile<MODE, NJ>(Wt, ldw, X, ldx, K, ft * 256, tt * TT, smem, P, layer);
  }
}

template <int DQK, int NCOMP, bool BAND, int EPI>
DI void attn_item(const u16* __restrict__ Q, int ldq, const u16* __restrict__ Kp, int ldk, const u16* __restrict__ Vt,
                  int qtok0, int kbeg, int kend, float sc_l2, float sink_l2, float lam, float onorm,
                  const float* __restrict__ subg, u16* __restrict__ O, float* __restrict__ DS, char* smem) {
  constexpr int DC = DQK / NCOMP;
  constexpr int KS = DC / 16;
  constexpr int KEYS = (NCOMP == 1) ? 128 : 64;
  constexpr int KSTR = DQK + 8, VSTR = KEYS + 8;
  constexpr int KCH = DQK / 8, VCH = KEYS / 8;
  constexpr int NKC = KEYS * KCH / NTHR, NVC = 64 * VCH / NTHR;
  constexpr int KSLOT = KEYS * KSTR, VSLOT = 64 * VSTR;
  u16* sK = (u16*)smem;
  u16* sV = sK + 3 * KSLOT;
  const int tid = opaque_tid(), lane = tid & 63, wave = tid >> 6, r = lane & 31, h = lane >> 5;
  const int qtok = qtok0 + wave * 32 + r;

  bf16x8 qf[NCOMP][KS];
#pragma unroll
  for (int c = 0; c < NCOMP; ++c)
#pragma unroll
    for (int ks = 0; ks < KS; ++ks) qf[c][ks] = *(const bf16x8*)(Q + (size_t)qtok * ldq + c * DC + ks * 16 + 8 * h);

  f32x16 Oa[NCOMP][2];
  float m[NCOMP], l[NCOMP];
#pragma unroll
  for (int c = 0; c < NCOMP; ++c) {
#pragma unroll
    for (int d = 0; d < 2; ++d)
#pragma unroll
      for (int v = 0; v < 16; ++v) Oa[c][d][v] = 0.f;
    m[c] = BAND ? sink_l2 : -1e30f;
    l[c] = (BAND && h == 0) ? 1.f : 0.f;
  }

  const u16* kg[NKC]; int kso[NKC];
#pragma unroll
  for (int i = 0; i < NKC; ++i) {
    const int c = tid + i * NTHR;
    const int row = c / KCH, cc = c % KCH;
    kg[i] = Kp + (size_t)(kbeg + row) * ldk + cc * 8;
    kso[i] = row * KSTR + cc * 8;
  }
  const u16* vg[NVC]; int vso[NVC];
#pragma unroll
  for (int i = 0; i < NVC; ++i) {
    const int c = tid + i * NTHR;
    const int row = c / VCH, cc = c % VCH;
    vg[i] = Vt + (size_t)(kbeg >> 7) * 8192 + row * 128 + cc * 8;
    vso[i] = row * VSTR + cc * 8;
  }
  u32x4 kreg[NKC], vreg[NVC];
  auto loadK = [&](int t) {
#pragma unroll
    for (int i = 0; i < NKC; ++i) kreg[i] = gld16(kg[i] + (size_t)t * KEYS * ldk);
  };
  auto loadV = [&](int t) {
#pragma unroll
    for (int i = 0; i < NVC; ++i) vreg[i] = gld16(vg[i] + (size_t)t * 8192);
  };
  auto waitK = [&]() {
    if constexpr (NKC == 1) wait_vm0(kreg[0]);
    else if constexpr (NKC == 2) wait_vm0(kreg[0], kreg[1]);
    else wait_vm0(kreg[0], kreg[1], kreg[2]);
  };
  auto waitV = [&]() {
    if constexpr (NVC == 1) wait_vm0(vreg[0]);
    else wait_vm0(vreg[0], vreg[1]);
  };
  auto storeK = [&](int slot) {
#pragma unroll
    for (int i = 0; i < NKC; ++i) *(u32x4*)(sK + slot * KSLOT + kso[i]) = kreg[i];
  };
  auto storeV = [&](int slot) {
#pragma unroll
    for (int i = 0; i < NVC; ++i) *(u32x4*)(sV + slot * VSLOT + vso[i]) = vreg[i];
  };

  f32x16 S0[2], S1[2];
  bf16x8 pfA[2][2], pfB[2][2];
  float alpha_pend = 1.f;
  bool need_pend = false;

  auto att_S = [&](auto uu_t, f32x16 (&S)[2], int slot) {
    constexpr int UU = decltype(uu_t)::value;
    constexpr int C = (NCOMP == 2) ? UU : 0;
    const u16* base = sK + slot * KSLOT + ((NCOMP == 1 ? UU * 64 : 0) + r) * KSTR + (NCOMP == 2 ? UU * DC : 0) + 8 * h;
#pragma unroll
    for (int kb = 0; kb < 2; ++kb) {
#pragma unroll
      for (int v = 0; v < 16; ++v) S[kb][v] = 0.f;
#pragma unroll
      for (int ks = 0; ks < KS; ++ks) {
        bf16x8 kf = *(const bf16x8*)(base + kb * 32 * KSTR + ks * 16);
        S[kb] = MFMA32(kf, qf[C][ks], S[kb]);
      }
    }
  };
  auto att_PV = [&](auto uu_t, const bf16x8 (&pf)[2][2], int slot) {
    constexpr int UU = decltype(uu_t)::value;
    constexpr int C = (NCOMP == 2) ? UU : 0;
    const u16* base = sV + slot * VSLOT + r * VSTR + (NCOMP == 1 ? UU * 64 : 0) + 8 * h;
#pragma unroll
    for (int d = 0; d < 2; ++d)
#pragma unroll
      for (int kb = 0; kb < 2; ++kb)
#pragma unroll
        for (int s = 0; s < 2; ++s) {
          bf16x8 vf = *(const bf16x8*)(base + d * 32 * VSTR + kb * 32 + 16 * s);
          Oa[C][d] = MFMA32(vf, pf[kb][s], Oa[C][d]);
        }
  };
  auto att_rescale = [&](auto uu_t) {
    constexpr int UU = decltype(uu_t)::value;
    constexpr int C = (NCOMP == 2) ? UU : 0;
    if (need_pend) {
#pragma unroll
      for (int d = 0; d < 2; ++d)
#pragma unroll
        for (int v = 0; v < 16; ++v) Oa[C][d][v] *= alpha_pend;
    }
  };
  auto att_softmax = [&](auto uu_t, f32x16 (&S)[2], bf16x8 (&pf)[2][2], int kpos0) {
    constexpr int UU = decltype(uu_t)::value;
    constexpr int C = (NCOMP == 2) ? UU : 0;
    if constexpr (BAND) {
#pragma unroll
      for (int kb = 0; kb < 2; ++kb)
#pragma unroll
        for (int v = 0; v < 16; ++v) {
          const int d = kpos0 + kb * 32 + crow(v, h) - qtok;
          if (d > 128 || d < -128) S[kb][v] = -1e30f;
        }
    }
    float mx = S[0][0];
#pragma unroll
    for (int kb = 0; kb < 2; ++kb)
#pragma unroll
      for (int v = 0; v < 16; ++v) mx = fmaxf(mx, S[kb][v]);
    mx = fmaxf(mx, __shfl_xor(mx, 32));
    const float mold = m[C];
    const float mnew = fmaxf(mold, mx * sc_l2);
    need_pend = __builtin_amdgcn_ballot_w64(mnew > mold) != 0;
    alpha_pend = __builtin_amdgcn_exp2f(mold - mnew);
    m[C] = mnew;
    float rsum = 0.f;
#pragma unroll
    for (int kb = 0; kb < 2; ++kb)
#pragma unroll
      for (int v = 0; v < 16; ++v) {
        float p = __builtin_amdgcn_exp2f(__builtin_fmaf(S[kb][v], sc_l2, -mnew));
        S[kb][v] = p;
        rsum += p;
      }
    l[C] = l[C] * alpha_pend + rsum;
#pragma unroll
    for (int kb = 0; kb < 2; ++kb)
#pragma unroll
      for (int s = 0; s < 2; ++s) {
        u32x4 pk;
        pk.x = pk2(S[kb][8 * s + 0], S[kb][8 * s + 1]);
        pk.y = pk2(S[kb][8 * s + 2], S[kb][8 * s + 3]);
        pk.z = pk2(S[kb][8 * s + 4], S[kb][8 * s + 5]);
        pk.w = pk2(S[kb][8 * s + 6], S[kb][8 * s + 7]);
        pf[kb][s] = __builtin_bit_cast(bf16x8, pk);
      }
  };
  using U0 = std::integral_constant<int, 0>;
  using U1 = std::integral_constant<int, 1>;

  const int ntl = (kend - kbeg) / KEYS;
  auto step = [&](auto first_t, auto lk_t, auto lv_t, int t, int sa, int sb, int sc) {
    constexpr bool FIRST = decltype(first_t)::value, LK = decltype(lk_t)::value, LV = decltype(lv_t)::value;
    if constexpr (LK) loadK(t + 2);
    if constexpr (LV) loadV(t + 1);
    if constexpr (!FIRST) att_rescale(U1{});
    att_S(U1{}, S1, sa);
    if constexpr (!FIRST) att_PV(U1{}, pfB, sc);
    att_softmax(U0{}, S0, pfA, kbeg + t * KEYS);
    att_rescale(U0{});
    if constexpr (LV) att_S(U0{}, S0, sb);
    att_PV(U0{}, pfA, sa);
    att_softmax(U1{}, S1, pfB, kbeg + t * KEYS + 64);
    if constexpr (LK) { waitK(); storeK(sc); }
    if constexpr (LV) { waitV(); storeV(sb); }
    __syncthreads();
  };
  using TT = std::true_type;
  using FF = std::false_type;

  loadK(0); loadV(0);
  waitK(); waitV();
  storeK(0); storeV(0);
  loadK(1);
  waitK();
  storeK(1);
  __syncthreads();
  att_S(U0{}, S0, 0);
  int sa = 0, sb = 1, sc = 2;
  step(TT{}, TT{}, TT{}, 0, sa, sb, sc);
  { int tmp = sa; sa = sb; sb = sc; sc = tmp; }
  for (int t = 1; t < ntl - 2; ++t) {
    step(FF{}, TT{}, TT{}, t, sa, sb, sc);
    int tmp = sa; sa = sb; sb = sc; sc = tmp;
  }
  step(FF{}, FF{}, TT{}, ntl - 2, sa, sb, sc);
  { int tmp = sa; sa = sb; sb = sc; sc = tmp; }
  step(FF{}, FF{}, FF{}, ntl - 1, sa, sb, sc);
  att_rescale(U1{});
  att_PV(U1{}, pfB, sa);

  float inv[NCOMP];
#pragma unroll
  for (int c = 0; c < NCOMP; ++c) {
    float lt = l[c] + __shfl_xor(l[c], 32);
    inv[c] = 1.f / lt;
  }
  if constexpr (EPI == 1) {
#pragma unroll
    for (int d = 0; d < 2; ++d)
#pragma unroll
      for (int vq = 0; vq < 4; ++vq) {
        float4 o = {Oa[0][d][4 * vq] * inv[0], Oa[0][d][4 * vq + 1] * inv[0], Oa[0][d][4 * vq + 2] * inv[0], Oa[0][d][4 * vq + 3] * inv[0]};
        *(float4*)(DS + (size_t)qtok * 256 + d * 32 + 8 * vq + 4 * h) = o;
      }
  } else {
    if constexpr (EPI == 2) {
      float ss = 0.f;
#pragma unroll
      for (int d = 0; d < 2; ++d)
#pragma unroll
        for (int vq = 0; vq < 4; ++vq) {
          const float4 o1 = *(const float4*)(DS + (size_t)qtok * 256 + d * 32 + 8 * vq + 4 * h);
          const float a0 = o1.x - lam * Oa[0][d][4 * vq] * inv[0];
          const float a1 = o1.y - lam * Oa[0][d][4 * vq + 1] * inv[0];
          const float a2 = o1.z - lam * Oa[0][d][4 * vq + 2] * inv[0];
          const float a3 = o1.w - lam * Oa[0][d][4 * vq + 3] * inv[0];
          Oa[0][d][4 * vq] = a0; Oa[0][d][4 * vq + 1] = a1; Oa[0][d][4 * vq + 2] = a2; Oa[0][d][4 * vq + 3] = a3;
          ss += a0 * a0 + a1 * a1 + a2 * a2 + a3 * a3;
        }
      ss += __shfl_xor(ss, 32);
      const float rs = rsqrtf(ss * (1.f / 64.f) + EPS) * onorm;
#pragma unroll
      for (int d = 0; d < 2; ++d)
#pragma unroll
        for (int v = 0; v < 16; ++v) Oa[0][d][v] *= rs * subg[d * 32 + crow(v, h)];
    } else {
#pragma unroll
      for (int d = 0; d < 2; ++d)
#pragma unroll
        for (int v = 0; v < 16; ++v) Oa[0][d][v] *= inv[0];
    }
    store_rows(O, KP1, 0, Oa[0][0], qtok, h);
    store_rows(O, KP1, 32, Oa[0][1], qtok, h);
  }
  __syncthreads();
}

DI void attn_phase(const Params& P, int layer, char* smem) {
  char* ws = P.ws;
  u16* qkv = (u16*)(ws + OFF_QKV);
  u16* BR = (u16*)(ws + OFF_XN);
  const float L2E = 1.4426950408889634f;
  const float lambda_init = 0.8f - 0.6f * __expf(-0.3f * (float)layer);
  float lam;
  {
    const float* dl = P.d_lambda + layer * 128;
    float s1 = 0.f, s2 = 0.f;
    for (int i = 0; i < 32; ++i) { s1 += dl[i] * dl[32 + i]; s2 += dl[64 + i] * dl[96 + i]; }
    lam = __expf(s1) - __expf(s2) + lambda_init;
  }
  for (int it = blockIdx.x; it < 2048; it += gridDim.x) {
    const int cls = it >> 8;
    if (cls < 6) {
      const int idx = it & 255;
      const int head = (idx & 7) >> 1;
      const int qb = ((idx >> 3) << 1) + (idx & 1);
      int qtok0, kbeg, kend;
      if (cls < 3) { qtok0 = qb * 256; kbeg = 0; kend = SEQ0; }
      else { const int s = qb >> 3; kbeg = SEQ0 + s * DSEQ; kend = kbeg + DSEQ; qtok0 = kbeg + (qb & 7) * 256; }
      const int typ = cls % 3;
      if (typ == 0) {
        float* DS = (float*)(ws + OFF_DS) + head * 64;
        attn_item<32, 1, false, 1>(qkv + Q_QD + head * 64, 256, qkv + Q_KD + head * 64, 256,
                                   qkv + Q_VTD + (size_t)head * 64 * T, qtok0, kbeg, kend,
                                   0.17677669529663687f * L2E, 0.f, lam, 1.f - lambda_init,
                                   P.d_subln + layer * 64, BR + 768 + head * 64, DS, smem);
        attn_item<32, 1, false, 2>(qkv + Q_QD + head * 64 + 32, 256, qkv + Q_KD + head * 64 + 32, 256,
                                   qkv + Q_VTD + (size_t)head * 64 * T, qtok0, kbeg, kend,
                                   0.17677669529663687f * L2E, 0.f, lam, 1.f - lambda_init,
                                   P.d_subln + layer * 64, BR + 768 + head * 64, DS, smem);
      } else if (typ == 1) {
        attn_item<96, 1, false, 0>(qkv + Q_QC + head * 96, 384, qkv + Q_KC + head * 96, 384,
                                       qkv + Q_VTC + (size_t)head * 64 * T, qtok0, kbeg, kend,
                                       0.10206207261596577f * L2E, 0.f, 0.f, 1.f, nullptr, BR + 512 + head * 64, nullptr, smem);
      } else {
        attn_item<64, 1, false, 0>(qkv + Q_QA + head * 64, 256, qkv + Q_KA + (head >> 1) * 64, 128,
                                       qkv + Q_VTA + (size_t)(head >> 1) * 64 * T, qtok0, kbeg, kend,
                                       0.125f * L2E, 0.f, 0.f, 1.f, nullptr, BR + head * 64, nullptr, smem);
      }
    } else {
      const int idx = it - 1536;
      const int head = (idx & 7) >> 1;
      const int qbg = ((idx >> 3) << 1) + (idx & 1);
      const int qtok0 = qbg * 256;
      int sb, se;
      if (qtok0 < SEQ0) { sb = 0; se = SEQ0; }
      else { sb = SEQ0 + ((qtok0 - SEQ0) / DSEQ) * DSEQ; se = sb + DSEQ; }
      const int kbeg = max(sb, qtok0 - 128), kend = min(se, qtok0 + 256 + 128);
      const float sink = P.b_sink[layer * 4 + head];
      attn_item<64, 1, true, 0>(qkv + Q_QB + head * 64, 256, qkv + Q_KB + (head >> 1) * 64, 128,
                                    qkv + Q_VTB + (size_t)(head >> 1) * 64 * T, qtok0, kbeg, kend,
                                    0.125f * L2E, sink * L2E, 0.f, 1.f, nullptr, BR + 256 + head * 64, nullptr, smem);
    }
  }
}

DI void ew_phase(const Params& P, const u16* __restrict__ Y, float coef, const float* __restrict__ gpost,
                 const float* __restrict__ gnext, bool from_inputs) {
  const int tid = opaque_tid();
  const int lane = tid & 63, wave = tid >> 6;
  u16* XN = (u16*)(P.ws + OFF_XN);
  for (int tok = blockIdx.x * 8 + wave; tok < T; tok += gridDim.x * 8) {
    const float* xs = from_inputs ? (tok < SEQ0 ? P.x_prompt + (size_t)tok * DM : P.x_sample + (size_t)(tok - SEQ0) * DM)
                                  : P.out + (size_t)tok * DM;
    float4 x[4];
#pragma unroll
    for (int i = 0; i < 4; ++i) x[i] = *(const float4*)(xs + (i * 64 + lane) * 4);
    if (Y) {
      float4 y[4];
      float ss = 0.f;
#pragma unroll
      for (int i = 0; i < 4; ++i) {
        const uint2 yb = *(const uint2*)(Y + (size_t)tok * KP1 + (i * 64 + lane) * 4);
        y[i] = make_float4(bf2f(yb.x & 0xffffu), bf2f(yb.x >> 16), bf2f(yb.y & 0xffffu), bf2f(yb.y >> 16));
        ss += y[i].x * y[i].x + y[i].y * y[i].y + y[i].z * y[i].z + y[i].w * y[i].w;
      }
      ss = wave_sum(ss);
      const float rs = rsqrtf(ss * (1.f / 1024.f) + EPS) * coef;
#pragma unroll
      for (int i = 0; i < 4; ++i) {
        float4 g = *(const float4*)(gpost + (i * 64 + lane) * 4);
        x[i].x += y[i].x * rs * g.x; x[i].y += y[i].y * rs * g.y;
        x[i].z += y[i].z * rs * g.z; x[i].w += y[i].w * rs * g.w;
      }
    }
#pragma unroll
    for (int i = 0; i < 4; ++i) *(float4*)(P.out + (size_t)tok * DM + (i * 64 + lane) * 4) = x[i];
    if (gnext) {
      float ss = 0.f;
#pragma unroll
      for (int i = 0; i < 4; ++i) ss += x[i].x * x[i].x + x[i].y * x[i].y + x[i].z * x[i].z + x[i].w * x[i].w;
      ss = wave_sum(ss);
      const float rs = rsqrtf(ss * (1.f / 1024.f) + EPS);
#pragma unroll
      for (int i = 0; i < 4; ++i) {
        float4 g = *(const float4*)(gnext + (i * 64 + lane) * 4);
        uint2 pk;
        pk.x = pk2(x[i].x * rs * g.x, x[i].y * rs * g.y);
        pk.y = pk2(x[i].z * rs * g.z, x[i].w * rs * g.w);
        *(uint2*)(XN + (size_t)tok * KP1 + (i * 64 + lane) * 4) = pk;
      }
    }
  }
}

DI int colmap(int mode, int n, int nsrc) {
  if (mode == 1) { return ((n >> 5) & 1) * DFF + (n >> 6) * 32 + (n & 31); }
  if (mode == 2) {
    if (n < 1664) return n;
    if (n < 2432) return n + 32;
    if (n < 2464) return n - 2432 + 1664;
    if (n < 2560) return -1;
    return n - 96;
  }
  return n < nsrc ? n : -1;
}
DI void conv_job(u16* __restrict__ dst, int ldd, const float* __restrict__ src, int Nd, int K, int lds, int mode,
                 const float* __restrict__ kscale) {
  const int total = Nd * (K >> 3);
  const int gthreads = gridDim.x * NTHR;
  for (int idx = blockIdx.x * NTHR + opaque_tid(); idx < total; idx += gthreads) {
    const int n = idx % Nd, k8 = idx / Nd;
    const int col = colmap(mode, n, lds);
    float v[8];
#pragma unroll
    for (int j = 0; j < 8; ++j) {
      float x = 0.f;
      if (col >= 0) {
        x = src[(size_t)(k8 * 8 + j) * lds + col];
        if (kscale) x *= kscale[k8 * 8 + j];
      }
      v[j] = x;
    }
    uint4 pk = {pk2(v[0], v[1]), pk2(v[2], v[3]), pk2(v[4], v[5]), pk2(v[6], v[7])};
    *(uint4*)(dst + (size_t)n * ldd + k8 * 8) = pk;
  }
}
DI void convert_layer(const Params& P, int l) {
  u16* W = (u16*)(P.ws + OFF_W);
  for (int s = 0; s < 2; ++s) {
    conv_job(W + W_WI + (size_t)s * 5632 * KP1, KP1, P.ffn_wi + ((size_t)l * 2 + s) * 1024 * 5632, 5632, 1024, 5632, 1, nullptr);
    conv_job(W + W_WO + (size_t)s * 1024 * KP2, KP2, P.ffn_wo + ((size_t)l * 2 + s) * 2816 * 1024, 1024, 2816, 1024, 0, nullptr);
  }
  conv_job(W + W_WIN, KP1, P.w_in + (size_t)l * 1024 * NPROJ, 6656, 1024, NPROJ, 2, nullptr);
  conv_job(W + W_WUQ, 384, P.c_w_uq + (size_t)l * 384 * 384, 512, 384, 384, 0, P.c_q_norm + l * 384);
  conv_job(W + W_WUKV, 256, P.c_w_ukv + (size_t)l * 256 * 512, 512, 256, 512, 0, P.c_kv_norm + l * 256);
  conv_job(W + W_WB, KP1, P.w_branch + (size_t)l * 1024 * 1024, 1024, 1024, 1024, 0, nullptr);
  conv_job(W + W_WOUT, KP1, P.w_out + (size_t)l * 1024 * 1024, 1024, 1024, 1024, 0, nullptr);
}
DI void rope_tables(const Params& P) {
  float2* R64 = (float2*)(P.ws + OFF_R64);
  float2* R32 = (float2*)(P.ws + OFF_R32);
  const int gthreads = gridDim.x * NTHR;
  for (int idx = blockIdx.x * NTHR + opaque_tid(); idx < 16384 * 48; idx += gthreads) {
    int pos, f; double base; float2* dst;
    if (idx < 16384 * 32) { pos = idx >> 5; f = idx & 31; base = 0.7498942093324559; dst = R64 + idx; }
    else { const int i2 = idx - 16384 * 32; pos = i2 >> 4; f = i2 & 15; base = 0.5623413251903491; dst = R32 + i2; }
    double inv = 1.0;
    for (int k = 0; k < f; ++k) inv *= base;
    const float ang = (float)pos * (float)inv;
    double tr = (double)ang * 0.15915494309189535;
    tr -= rint(tr);
    const float tf = (float)tr;
    *dst = make_float2(__builtin_amdgcn_cosf(tf), __builtin_amdgcn_sinf(tf));
  }
}

DI void fast_grid_barrier(unsigned* bar, unsigned nblk) {
  asm volatile("s_waitcnt vmcnt(0) lgkmcnt(0)" ::: "memory");
  __syncthreads();
  if (threadIdx.x == 0) {
    __builtin_amdgcn_fence(__ATOMIC_RELEASE, "agent");
    asm volatile("s_waitcnt vmcnt(0) lgkmcnt(0)" ::: "memory");
    const unsigned gen = __hip_atomic_load(&bar[64], __ATOMIC_RELAXED, __HIP_MEMORY_SCOPE_AGENT);
    const unsigned old = __hip_atomic_fetch_add(&bar[0], 1u, __ATOMIC_RELAXED, __HIP_MEMORY_SCOPE_AGENT);
    if (old == nblk - 1u) {
      __hip_atomic_store(&bar[0], 0u, __ATOMIC_RELAXED, __HIP_MEMORY_SCOPE_AGENT);
      __hip_atomic_fetch_add(&bar[64], 1u, __ATOMIC_RELEASE, __HIP_MEMORY_SCOPE_AGENT);
    } else {
      while (__hip_atomic_load(&bar[64], __ATOMIC_RELAXED, __HIP_MEMORY_SCOPE_AGENT) == gen) __builtin_amdgcn_s_sleep(1);
    }
    __builtin_amdgcn_fence(__ATOMIC_ACQUIRE, "agent");
    asm volatile("s_waitcnt vmcnt(0) lgkmcnt(0)" ::: "memory");
  }
  __syncthreads();
}

__global__ void __launch_bounds__(NTHR) __attribute__((amdgpu_waves_per_eu(2, 2))) mega(Params P) {
  extern __shared__ __attribute__((aligned(16))) char smem[];
  cg::grid_group grid = cg::this_grid();
  int phase = 0;
#define ACTIVE() (phase >= P.phase_lo && phase < P.phase_hi)
#define SEAM() do { ++phase; if (P.coop) { if (phase == 1) grid.sync(); else fast_grid_barrier((unsigned*)(P.ws + OFF_BAR), gridDim.x); } } while (0)
  u16* W = (u16*)(P.ws + OFF_W);
  u16* XN = (u16*)(P.ws + OFF_XN);
  u16* R2 = (u16*)(P.ws + OFF_R2);
  u16* qkv = (u16*)(P.ws + OFF_QKV);
  const u16* Y = qkv + Q_Y;

  if (ACTIVE()) {
    rope_tables(P);
    convert_layer(P, 0);
    ew_phase(P, nullptr, 0.f, nullptr, P.norm_g, true);
  }
  SEAM();
  for (int l = 0; l < 4; ++l) {
    const float* g = P.norm_g + (size_t)l * 6 * DM;
    if (ACTIVE()) gemm_phase<M_FFNUP, 4>(W + W_WI, KP1, XN, KP1, DM, 22, smem, P, l);
    SEAM();
    if (ACTIVE()) gemm_phase<M_Y, 4>(W + W_WO, KP2, R2, KP2, DFF, 4, smem, P, l);
    SEAM();
    if (ACTIVE()) ew_phase(P, Y, 0.5f, g + DM, g + 2 * DM, false);
    SEAM();
    if (ACTIVE()) {
      gemm_phase<M_PROJ, 4>(W + W_WIN, KP1, XN, KP1, DM, 10, smem, P, l);
      gemm_phase<M_GATE, 4>(W + W_WIN + 2560ull * KP1, KP1, XN, KP1, DM, 16, smem, P, l);
    }
    SEAM();
    if (ACTIVE()) {
      gemm_phase<M_CUQ, 4>(W + W_WUQ, 384, qkv + Q_CQ, 384, 384, 2, smem, P, l);
      gemm_phase<M_CUKV, 4>(W + W_WUKV, 256, qkv + Q_CKV, 256, 256, 2, smem, P, l);
    }
    SEAM();
    if (ACTIVE()) attn_phase(P, l, smem);
    SEAM();
    if (ACTIVE()) gemm_phase<M_MERGE, 2>(W + W_WB, KP1, XN, KP1, DM, 4, smem, P, l);
    SEAM();
    if (ACTIVE()) gemm_phase<M_Y, 4>(W + W_WOUT, KP1, qkv + Q_MERGED, KP1, DM, 4, smem, P, l);
    SEAM();
    if (ACTIVE()) ew_phase(P, Y, 1.0f, g + 3 * DM, g + 4 * DM, false);
    SEAM();
    if (ACTIVE()) gemm_phase<M_FFNUP, 4>(W + W_WI + 5632ull * KP1, KP1, XN, KP1, DM, 22, smem, P, l);
    SEAM();
    if (ACTIVE()) gemm_phase<M_Y, 4>(W + W_WO + 1024ull * KP2, KP2, R2, KP2, DFF, 4, smem, P, l);
    SEAM();
    if (ACTIVE()) {
      ew_phase(P, Y, 0.5f, g + 5 * DM, l < 3 ? g + 6 * DM : nullptr, false);
      if (l < 3) convert_layer(P, l + 1);
    }
    SEAM();
  }
}

constexpr int N_PHASES = 1 + 12 * 4;

extern "C" void kernel_launch(void* const* d_in, const int* in_sizes, int n_in, void* d_out, int out_size, void* d_ws,
                              size_t ws_size, hipStream_t stream) {
  static int grid_blocks = 0;
  if (!grid_blocks) {
    int dev = 0, cus = 0, per_cu = 0;
    hipGetDevice(&dev);
    hipDeviceGetAttribute(&cus, hipDeviceAttributeMultiprocessorCount, dev);
    hipFuncSetAttribute((const void*)mega, hipFuncAttributeMaxDynamicSharedMemorySize, SMEM_BYTES);
    hipOccupancyMaxActiveBlocksPerMultiprocessor(&per_cu, mega, NTHR, SMEM_BYTES);
    if (per_cu < 1) per_cu = 1;
    grid_blocks = cus * per_cu;
  }
  if (ws_size < WS_NEEDED) fprintf(stderr, "workspace too small: %zu < %zu\n", ws_size, (size_t)WS_NEEDED);
  Params P{};
  P.x_prompt = (const float*)d_in[0]; P.x_sample = (const float*)d_in[1]; P.norm_g = (const float*)d_in[2];
  P.w_in = (const float*)d_in[3]; P.a_qk_norm = (const float*)d_in[4]; P.b_sink = (const float*)d_in[5];
  P.c_q_norm = (const float*)d_in[6]; P.c_kv_norm = (const float*)d_in[7]; P.c_w_uq = (const float*)d_in[8];
  P.c_w_ukv = (const float*)d_in[9]; P.d_lambda = (const float*)d_in[10]; P.d_subln = (const float*)d_in[11];
  P.w_branch = (const float*)d_in[12]; P.w_out = (const float*)d_in[13]; P.ffn_wi = (const float*)d_in[14];
  P.ffn_wo = (const float*)d_in[15];
  P.out = (float*)d_out; P.ws = (char*)d_ws;
#if MULTI_LAUNCH
  for (int ph = 0; ph < N_PHASES; ++ph) {
    P.phase_lo = ph; P.phase_hi = ph + 1; P.coop = 0; P.pad0 = 0;
    hipLaunchKernelGGL(mega, dim3(grid_blocks), dim3(NTHR), SMEM_BYTES, stream, P);
  }
#else
  P.phase_lo = 0; P.phase_hi = 1 << 30; P.coop = 1; P.pad0 = 0;
  hipMemsetAsync((char*)d_ws + OFF_BAR, 0, 1024, stream);
  void* args[] = {&P};
  hipError_t e = hipLaunchCooperativeKernel((const void*)mega, dim3(grid_blocks), dim3(NTHR), args, SMEM_BYTES, stream);
  if (e != hipSuccess) fprintf(stderr, "cooperative launch failed: %s (grid %d)\n", hipGetErrorString(e), grid_blocks);
#endif
}
```

```cpp
#include <hip/hip_runtime.h>
#include <hip/hip_cooperative_groups.h>
#include <cstdio>
#include <cstdint>
#include <type_traits>
namespace cg = cooperative_groups;

#ifndef MULTI_LAUNCH
#define MULTI_LAUNCH 0
#endif

#define DI __device__ __forceinline__
typedef unsigned short u16;
typedef __attribute__((ext_vector_type(8))) short bf16x8;
typedef __attribute__((ext_vector_type(16))) float f32x16;
typedef __attribute__((ext_vector_type(2))) float f32x2_t;
typedef __attribute__((ext_vector_type(2))) __bf16 bf16x2_t;

constexpr int T = 32768;
constexpr int DM = 1024;
constexpr int DFF = 2816;
constexpr int KP1 = 1088;
constexpr int KP2 = 2880;
constexpr int GP = 4160;
constexpr int YP = 1040;
constexpr int NPROJ = 6560;
constexpr int SEQ0 = 16384;
constexpr int DSEQ = 2048;
constexpr float EPS = 1e-6f;
constexpr int NTHR = 512;
constexpr int LSTR = 72;
constexpr int SMEM_BYTES = 2 * 2 * 256 * LSTR * 2;

constexpr size_t W_WI = 0;
constexpr size_t W_WO = W_WI + 2ull * 5632 * KP1;
constexpr size_t W_WIN = W_WO + 2ull * 1024 * KP2;
constexpr size_t W_WUQ = W_WIN + 6656ull * KP1;
constexpr size_t W_WUKV = W_WUQ + 512ull * 384;
constexpr size_t W_WB = W_WUKV + 512ull * 256;
constexpr size_t W_WOUT = W_WB + 1024ull * KP1;
constexpr size_t W_TOTAL = W_WOUT + 1024ull * KP1;

constexpr size_t OFF_W = 0;
constexpr size_t OFF_XN = OFF_W + W_TOTAL * 2;
constexpr size_t OFF_R2 = OFF_XN + (size_t)T * KP1 * 2;
constexpr size_t OFF_QKV = OFF_R2 + (size_t)T * GP * 2;
constexpr size_t OFF_SS = OFF_QKV + (size_t)T * 3456 * 2;
constexpr size_t OFF_R64 = OFF_SS + (size_t)T * 20 * 4;
constexpr size_t OFF_R32 = OFF_R64 + 16384ull * 32 * 8;
constexpr size_t OFF_DS = OFF_R32 + 16384ull * 16 * 8;
constexpr size_t OFF_BAR = OFF_DS + (size_t)T * 256 * 4;
constexpr size_t WS_NEEDED = OFF_BAR + 1024;

constexpr size_t Q_QA = 0;
constexpr size_t Q_KA = (size_t)T * 256;
constexpr size_t Q_VTA = (size_t)T * 384;
constexpr size_t Q_QB = (size_t)T * 512;
constexpr size_t Q_KB = (size_t)T * 768;
constexpr size_t Q_VTB = (size_t)T * 896;
constexpr size_t Q_CQ = (size_t)T * 1024;
constexpr size_t Q_CKV = (size_t)T * 1408;
constexpr size_t Q_QC = (size_t)T * 1664;
constexpr size_t Q_KC = (size_t)T * 2048;
constexpr size_t Q_VTC = (size_t)T * 2432;
constexpr size_t Q_QD = (size_t)T * 2688;
constexpr size_t Q_KD = (size_t)T * 2944;
constexpr size_t Q_VTD = (size_t)T * 3200;
constexpr size_t Q_MERGED = 0;
constexpr size_t Q_Y = (size_t)T * KP1;

struct Params {
  const float* x_prompt; const float* x_sample; const float* norm_g; const float* w_in;
  const float* a_qk_norm; const float* b_sink; const float* c_q_norm; const float* c_kv_norm;
  const float* c_w_uq; const float* c_w_ukv; const float* d_lambda; const float* d_subln;
  const float* w_branch; const float* w_out; const float* ffn_wi; const float* ffn_wo;
  float* out; char* ws;
  int phase_lo; int phase_hi; int coop; int pad0;
};

DI unsigned pk2(float a, float b) {
  f32x2_t v = {a, b};
  bf16x2_t r = __builtin_convertvector(v, bf16x2_t);
  return __builtin_bit_cast(unsigned, r);
}
DI u16 f2bf(float a) { return (u16)(pk2(a, 0.f) & 0xffffu); }
DI float bf2f(unsigned bits16) { return __uint_as_float(bits16 << 16); }
DI int crow(int v, int h) { return (v & 3) + 8 * (v >> 2) + 4 * h; }
DI int pos_of(int tok) { return tok < SEQ0 ? tok : ((tok - SEQ0) & (DSEQ - 1)); }
#define MFMA32(a, b, c) __builtin_amdgcn_mfma_f32_32x32x16_bf16((a), (b), (c), 0, 0, 0)

typedef __attribute__((ext_vector_type(4))) unsigned u32x4;
DI u32x4 gld16(const void* p) { u32x4 r; asm volatile("global_load_dwordx4 %0, %1, off" : "=v"(r) : "v"(p)); return r; }
DI void wait_vm0(u32x4& a) { asm volatile("s_waitcnt vmcnt(0)" : "+v"(a) :: "memory"); }
DI void wait_vm0(u32x4& a, u32x4& b) { asm volatile("s_waitcnt vmcnt(0)" : "+v"(a), "+v"(b) :: "memory"); }
DI void wait_vm0(u32x4& a, u32x4& b, u32x4& c) { asm volatile("s_waitcnt vmcnt(0)" : "+v"(a), "+v"(b), "+v"(c) :: "memory"); }
DI void wait_vm0(u32x4& a, u32x4& b, u32x4& c, u32x4& d) { asm volatile("s_waitcnt vmcnt(0)" : "+v"(a), "+v"(b), "+v"(c), "+v"(d) :: "memory"); }
DI u32x4 gld16s(unsigned voff, const void* sbase) { u32x4 r; asm volatile("global_load_dwordx4 %0, %1, %2" : "=v"(r) : "v"(voff), "s"(sbase)); return r; }
#define DEF_WAIT8(name, cnt) DI void name(u32x4& a, u32x4& b, u32x4& c, u32x4& d, u32x4& e, u32x4& f, u32x4& g, u32x4& h) { asm volatile("s_waitcnt vmcnt(" #cnt ")" : "+v"(a), "+v"(b), "+v"(c), "+v"(d), "+v"(e), "+v"(f), "+v"(g), "+v"(h) :: "memory"); }
#define DEF_WAIT6(name, cnt) DI void name(u32x4& a, u32x4& b, u32x4& c, u32x4& d, u32x4& e, u32x4& f) { asm volatile("s_waitcnt vmcnt(" #cnt ")" : "+v"(a), "+v"(b), "+v"(c), "+v"(d), "+v"(e), "+v"(f) :: "memory"); }
DEF_WAIT8(wait8_vm8, 8)
DEF_WAIT8(wait8_vm0, 0)
DEF_WAIT6(wait6_vm6, 6)
DEF_WAIT6(wait6_vm0, 0)
DI int opaque_tid() { int t = threadIdx.x; asm volatile("" : "+v"(t)); return t; }
DI float wave_sum(float v) {
#pragma unroll
  for (int m = 32; m >= 1; m >>= 1) v += __shfl_xor(v, m);
  return v;
}

DI void rope32_blk(f32x16& a, const float2* __restrict__ tab, int h) {
#pragma unroll
  for (int v = 0; v < 8; ++v) {
    float2 cs = tab[crow(v, h)];
    float x1 = a[v], x2 = a[v + 8];
    a[v] = x1 * cs.x - x2 * cs.y;
    a[v + 8] = x2 * cs.x + x1 * cs.y;
  }
}
DI void rope64_blk(f32x16& a0, f32x16& a1, const float2* __restrict__ tab, int h) {
#pragma unroll
  for (int v = 0; v < 16; ++v) {
    float2 cs = tab[crow(v, h)];
    float x1 = a0[v], x2 = a1[v];
    a0[v] = x1 * cs.x - x2 * cs.y;
    a1[v] = x2 * cs.x + x1 * cs.y;
  }
}
DI void store_rows(u16* __restrict__ base, int ld, int col0, const f32x16& a, int tok, int h) {
#pragma unroll
  for (int vq = 0; vq < 4; ++vq) {
    uint2 pk;
    pk.x = pk2(a[4 * vq], a[4 * vq + 1]);
    pk.y = pk2(a[4 * vq + 2], a[4 * vq + 3]);
    *(uint2*)(base + (size_t)tok * ld + col0 + 8 * vq + 4 * h) = pk;
  }
}
DI void store_T(u16* __restrict__ base, int row0, const f32x16& a, int tok, int h) {
  const int tp = (tok & ~12) | ((tok & 4) << 1) | ((tok & 8) >> 1);
#pragma unroll
  for (int v = 0; v < 16; ++v) base[(size_t)((row0 + crow(v, h)) >> 6) * 64 * T + (size_t)(tp >> 7) * 8192 + ((row0 + crow(v, h)) & 63) * 128 + (tp & 127)] = f2bf(a[v]);
}

enum { M_FFNUP = 0, M_Y = 1, M_PROJ = 2, M_CUQ = 3, M_CUKV = 4, M_MERGE = 5, M_GATE = 6 };

template <int MODE, int NJ>
DI void gemm_epilogue(f32x16 (&acc)[2][NJ], int fbase, int tbase, int r, int h, const Params& P, int layer) {
  char* ws = P.ws;
  u16* qkv = (u16*)(ws + OFF_QKV);
  const float2* R64 = (const float2*)(ws + OFF_R64);
  const float2* R32 = (const float2*)(ws + OFF_R32);
  float* SS = (float*)(ws + OFF_SS);
  if constexpr (MODE == M_FFNUP) {
    u16* H = (u16*)(ws + OFF_R2);
    const int hf0 = (fbase >> 6) * 32;
#pragma unroll
    for (int j = 0; j < NJ; ++j) {
      const int tok = tbase + j * 32 + r;
      f32x16 o;
#pragma unroll
      for (int v = 0; v < 16; ++v) {
        float g = acc[0][j][v], u = acc[1][j][v];
        o[v] = g * __builtin_amdgcn_rcpf(1.f + __builtin_amdgcn_exp2f(-1.4426950408889634f * g)) * u;
      }
      store_rows(H, KP2, hf0, o, tok, h);
    }
  } else if constexpr (MODE == M_Y) {
    u16* Yb = qkv + Q_Y;
#pragma unroll
    for (int j = 0; j < NJ; ++j) {
      const int tok = tbase + j * 32 + r;
      store_rows(Yb, KP1, fbase, acc[0][j], tok, h);
      store_rows(Yb, KP1, fbase + 32, acc[1][j], tok, h);
    }
  } else if constexpr (MODE == M_PROJ) {
    if (fbase < 384) {
      const bool isK = fbase >= 256;
      const float* g = P.a_qk_norm + layer * 128 + (isK ? 64 : 0);
      u16* dst = qkv + (isK ? Q_KA : Q_QA);
      const int ld = isK ? 128 : 256;
      const int c0 = isK ? fbase - 256 : fbase;
      float gv[2][16];
#pragma unroll
      for (int i = 0; i < 2; ++i)
#pragma unroll
        for (int v = 0; v < 16; ++v) gv[i][v] = g[i * 32 + crow(v, h)];
#pragma unroll
      for (int j = 0; j < NJ; ++j) {
        const int tok = tbase + j * 32 + r;
        const int pos = pos_of(tok);
        float ss = 0.f;
#pragma unroll
        for (int i = 0; i < 2; ++i)
#pragma unroll
          for (int v = 0; v < 16; ++v) ss += acc[i][j][v] * acc[i][j][v];
        ss += __shfl_xor(ss, 32);
        const float rs = rsqrtf(ss * (1.f / 64.f) + EPS);
#pragma unroll
        for (int i = 0; i < 2; ++i)
#pragma unroll
          for (int v = 0; v < 16; ++v) acc[i][j][v] *= rs * gv[i][v];
        rope32_blk(acc[0][j], R32 + (size_t)(pos >> 6) * 16, h);
        rope32_blk(acc[1][j], R32 + (size_t)(pos & 63) * 16, h);
        store_rows(dst, ld, c0, acc[0][j], tok, h);
        store_rows(dst, ld, c0 + 32, acc[1][j], tok, h);
      }
    } else if (fbase < 512) {
#pragma unroll
      for (int j = 0; j < NJ; ++j) {
        const int tok = tbase + j * 32 + r;
        store_T(qkv + Q_VTA, fbase - 384, acc[0][j], tok, h);
        store_T(qkv + Q_VTA, fbase - 384 + 32, acc[1][j], tok, h);
      }
    } else if (fbase < 896) {
      const bool isK = fbase >= 768;
      u16* dst = qkv + (isK ? Q_KB : Q_QB);
      const int ld = isK ? 128 : 256;
      const int c0 = isK ? fbase - 768 : fbase - 512;
#pragma unroll
      for (int j = 0; j < NJ; ++j) {
        const int tok = tbase + j * 32 + r;
        const int pos = pos_of(tok);
        rope64_blk(acc[0][j], acc[1][j], R64 + (size_t)pos * 32, h);
        store_rows(dst, ld, c0, acc[0][j], tok, h);
        store_rows(dst, ld, c0 + 32, acc[1][j], tok, h);
      }
    } else if (fbase < 1024) {
#pragma unroll
      for (int j = 0; j < NJ; ++j) {
        const int tok = tbase + j * 32 + r;
        store_T(qkv + Q_VTB, fbase - 896, acc[0][j], tok, h);
        store_T(qkv + Q_VTB, fbase - 896 + 32, acc[1][j], tok, h);
      }
    } else if (fbase < 1664) {
      const bool isKV = fbase >= 1408;
      u16* dst = qkv + (isKV ? Q_CKV : Q_CQ);
      const int ld = isKV ? 256 : 384;
      const int c0 = isKV ? fbase - 1408 : fbase - 1024;
      const int sb = (isKV ? 12 : 0) + (c0 >> 5);
#pragma unroll
      for (int j = 0; j < NJ; ++j) {
        const int tok = tbase + j * 32 + r;
#pragma unroll
        for (int i = 0; i < 2; ++i) {
          float ss = 0.f;
#pragma unroll
          for (int v = 0; v < 16; ++v) ss += acc[i][j][v] * acc[i][j][v];
          ss += __shfl_xor(ss, 32);
          if (h == 0) SS[(size_t)tok * 20 + sb + i] = ss;
          store_rows(dst, ld, c0 + i * 32, acc[i][j], tok, h);
        }
      }
    } else if (fbase < 2176) {
      const bool isK = fbase >= 1920;
      u16* dst = qkv + (isK ? Q_KD : Q_QD);
      const int c0 = isK ? fbase - 1920 : fbase - 1664;
#pragma unroll
      for (int j = 0; j < NJ; ++j) {
        const int tok = tbase + j * 32 + r;
        const int pos = pos_of(tok);
#pragma unroll
        for (int i = 0; i < 2; ++i) {
          rope32_blk(acc[i][j], R32 + (size_t)pos * 16, h);
          store_rows(dst, 256, c0 + i * 32, acc[i][j], tok, h);
        }
      }
    } else if (fbase < 2432) {
#pragma unroll
      for (int j = 0; j < NJ; ++j) {
        const int tok = tbase + j * 32 + r;
        store_T(qkv + Q_VTD, fbase - 2176, acc[0][j], tok, h);
        store_T(qkv + Q_VTD, fbase - 2176 + 32, acc[1][j], tok, h);
      }
    } else if (fbase == 2432) {
#pragma unroll
      for (int j = 0; j < NJ; ++j) {
        const int tok = tbase + j * 32 + r;
        const int pos = pos_of(tok);
        rope32_blk(acc[0][j], R32 + (size_t)pos * 16, h);
#pragma unroll
        for (int hd = 0; hd < 4; ++hd) store_rows(qkv + Q_KC, 384, hd * 96 + 64, acc[0][j], tok, h);
      }
    }
  } else if constexpr (MODE == M_GATE) {
    unsigned char* G8 = (unsigned char*)(ws + OFF_R2);
#pragma unroll
    for (int j = 0; j < NJ; ++j) {
      const int tok = tbase + j * 32 + r;
#pragma unroll
      for (int i = 0; i < 2; ++i)
#pragma unroll
        for (int vq = 0; vq < 4; ++vq) {
          unsigned pk = 0u;
#pragma unroll
          for (int e = 0; e < 4; ++e) {
            const float o = __builtin_amdgcn_rcpf(1.f + __builtin_amdgcn_exp2f(-1.4426950408889634f * acc[i][j][4 * vq + e]));
            pk |= (unsigned)(o * 255.f + 0.5f) << (8 * e);
          }
          *(unsigned*)(G8 + (size_t)tok * GP + fbase + i * 32 + 8 * vq + 4 * h) = pk;
        }
    }
  } else if constexpr (MODE == M_CUQ) {
    if (fbase >= 384) return;
#pragma unroll
    for (int j = 0; j < NJ; ++j) {
      const int tok = tbase + j * 32 + r;
      const int pos = pos_of(tok);
      float ss = 0.f;
#pragma unroll
      for (int b = 0; b < 12; ++b) ss += SS[(size_t)tok * 20 + b];
      const float rs = rsqrtf(ss * (1.f / 384.f) + EPS);
#pragma unroll
      for (int i = 0; i < 2; ++i) {
        const int blk = (fbase >> 5) + i;
#pragma unroll
        for (int v = 0; v < 16; ++v) acc[i][j][v] *= rs;
        if (blk % 3 == 2) rope32_blk(acc[i][j], R32 + (size_t)pos * 16, h);
        store_rows(qkv + Q_QC, 384, blk * 32, acc[i][j], tok, h);
      }
    }
  } else if constexpr (MODE == M_CUKV) {
#pragma unroll
    for (int j = 0; j < NJ; ++j) {
      const int tok = tbase + j * 32 + r;
      float ss = 0.f;
#pragma unroll
      for (int b = 0; b < 8; ++b) ss += SS[(size_t)tok * 20 + 12 + b];
      const float rs = rsqrtf(ss * (1.f / 256.f) + EPS);
#pragma unroll
      for (int i = 0; i < 2; ++i) {
        const int blk = (fbase >> 5) + i;
        const int hd = blk >> 2, q = blk & 3;
#pragma unroll
        for (int v = 0; v < 16; ++v) acc[i][j][v] *= rs;
        if (q < 2) store_rows(qkv + Q_KC, 384, hd * 96 + q * 32, acc[i][j], tok, h);
        else store_T(qkv + Q_VTC, hd * 64 + (q - 2) * 32, acc[i][j], tok, h);
      }
    }
  } else if constexpr (MODE == M_MERGE) {
#pragma unroll
    for (int j = 0; j < NJ; ++j) {
      const int tok = tbase + j * 32 + r;
      store_rows(qkv + Q_MERGED, KP1, fbase, acc[0][j], tok, h);
      store_rows(qkv + Q_MERGED, KP1, fbase + 32, acc[1][j], tok, h);
    }
  }
}

typedef __attribute__((address_space(3))) unsigned lds_u32_t;
typedef __attribute__((address_space(1))) const unsigned glb_u32_t;
template <int MODE, int NJ>
DI void gemm_tile(const u16* __restrict__ Wt, int ldw, const u16* __restrict__ X, int ldx, int K, int f0, int t0, char* smem,
                  const Params& P, int layer) {
  constexpr int XROWS = NJ * 64;
  constexpr int WSTG = 256 * 64, XSTG = XROWS * 64;
  u16* sW = (u16*)smem;
  u16* sX = sW + 2 * WSTG;
  const int tid = opaque_tid(), lane = tid & 63, wave = tid >> 6, r = lane & 31, h = lane >> 5;
  const int wf = wave & 3, wt = wave >> 2;
  f32x16 acc[2][NJ];
  f32x16 tot[2][MODE == M_MERGE ? NJ : 1];
#pragma unroll
  for (int i = 0; i < 2; ++i)
#pragma unroll
    for (int j = 0; j < NJ; ++j)
#pragma unroll
      for (int v = 0; v < 16; ++v) acc[i][j][v] = 0.f;
  if constexpr (MODE == M_MERGE) {
#pragma unroll
    for (int i = 0; i < 2; ++i)
#pragma unroll
      for (int j = 0; j < NJ; ++j)
#pragma unroll
        for (int v = 0; v < 16; ++v) tot[i][j][v] = 0.f;
  }
  const int nk = K >> 6;
  const int srow = tid >> 3;
  const int schunk = (tid & 7) ^ ((tid >> 4) & 7);
  const u16* wp = Wt + (size_t)(f0 + srow) * ldw + schunk * 8;
  const u16* xp = X + (size_t)(t0 + srow) * ldx + schunk * 8;
  const int fbase = f0 + wf * 64, tbase = t0 + wt * (NJ * 32);

  auto issue = [&](int kt, int buf) {
#pragma unroll
    for (int i = 0; i < 4; ++i)
      __builtin_amdgcn_global_load_lds((glb_u32_t*)(wp + (size_t)(i * 64) * ldw + kt * 64),
                                       (lds_u32_t*)(sW + buf * WSTG + i * 4096 + tid * 8), 16, 0, 0);
#pragma unroll
    for (int i = 0; i < NJ; ++i)
      __builtin_amdgcn_global_load_lds((glb_u32_t*)(xp + (size_t)(i * 64) * ldx + kt * 64),
                                       (lds_u32_t*)(sX + buf * XSTG + i * 4096 + tid * 8), 16, 0, 0);
  };
  const int swz = (r >> 1) & 7;
  auto compute = [&](int buf, int kt) {
    const u16* aW = sW + buf * WSTG + (wf * 64 + r) * 64;
    const u16* aX = sX + buf * XSTG + (wt * (NJ * 32) + r) * 64;
#pragma unroll
    for (int ks = 0; ks < 4; ++ks) {
      const int co = ((2 * ks + h) ^ swz) * 8;
      bf16x8 wfrag[2], xfrag[NJ];
#pragma unroll
      for (int i = 0; i < 2; ++i) wfrag[i] = *(const bf16x8*)(aW + i * 32 * 64 + co);
#pragma unroll
      for (int j = 0; j < NJ; ++j) xfrag[j] = *(const bf16x8*)(aX + j * 32 * 64 + co);
#pragma unroll
      for (int i = 0; i < 2; ++i)
#pragma unroll
        for (int j = 0; j < NJ; ++j) acc[i][j] = MFMA32(wfrag[i], xfrag[j], acc[i][j]);
    }
    if constexpr (MODE == M_MERGE) {
      if ((kt & 3) == 3) {
        const int br = kt >> 2;
        const unsigned char* G8 = (const unsigned char*)(P.ws + OFF_R2);
#pragma unroll
        for (int j = 0; j < NJ; ++j) {
          const int tok = tbase + j * 32 + r;
#pragma unroll
          for (int i = 0; i < 2; ++i)
#pragma unroll
            for (int vq = 0; vq < 4; ++vq) {
              const unsigned gp = *(const unsigned*)(G8 + (size_t)tok * GP + br * 1024 + fbase + i * 32 + 8 * vq + 4 * h);
              tot[i][j][4 * vq + 0] += (float)(gp & 0xffu) * (1.f / 255.f) * acc[i][j][4 * vq + 0];
              tot[i][j][4 * vq + 1] += (float)((gp >> 8) & 0xffu) * (1.f / 255.f) * acc[i][j][4 * vq + 1];
              tot[i][j][4 * vq + 2] += (float)((gp >> 16) & 0xffu) * (1.f / 255.f) * acc[i][j][4 * vq + 2];
              tot[i][j][4 * vq + 3] += (float)(gp >> 24) * (1.f / 255.f) * acc[i][j][4 * vq + 3];
              acc[i][j][4 * vq + 0] = 0.f; acc[i][j][4 * vq + 1] = 0.f;
              acc[i][j][4 * vq + 2] = 0.f; acc[i][j][4 * vq + 3] = 0.f;
            }
        }
      }
    }
  };

  issue(0, 0);
  asm volatile("s_waitcnt vmcnt(0)" ::: "memory");
  __syncthreads();
  for (int kt = 0; kt < nk; ++kt) {
    const int buf = kt & 1;
    if (kt + 1 < nk) issue(kt + 1, buf ^ 1);
    compute(buf, kt);
    asm volatile("s_waitcnt vmcnt(0) lgkmcnt(0)" ::: "memory");
    __syncthreads();
  }
  if constexpr (MODE == M_MERGE) gemm_epilogue<MODE, NJ>(tot, fbase, tbase, r, h, P, layer);
  else gemm_epilogue<MODE, NJ>(acc, fbase, tbase, r, h, P, layer);
}

template <int MODE, int NJ>
DI void gemm_phase(const u16* Wt, int ldw, const u16* X, int ldx, int K, int nF, char* smem, const Params& P, int layer) {
  constexpr int TT = NJ * 64;
  const int nT = T / TT;
  const int ntiles = nF * nT;
  for (int idx = blockIdx.x; idx < ntiles; idx += gridDim.x) {
    const int tt_lo = idx & 15;
    const int rest = idx >> 4;
    const int ft = rest % nF;
    const int tt = (rest / nF) * 16 + tt_lo;
    gemm_tile<MODE, NJ>(Wt, ldw, X, ldx, K, ft * 256, tt * TT, smem, P, layer);
  }
}

template <int DQK, int NCOMP, bool BAND, int EPI>
DI void attn_item(const u16* __restrict__ Q, int ldq, const u16* __restrict__ Kp, int ldk, const u16* __restrict__ Vt,
                  int qtok0, int kbeg, int kend, float sc_l2, float sink_l2, float lam, float onorm,
                  const float* __restrict__ subg, u16* __restrict__ O, float* __restrict__ DS, char* smem) {
  constexpr int DC = DQK / NCOMP;
  constexpr int KS = DC / 16;
  constexpr int KEYS = (NCOMP == 1) ? 128 : 64;
  constexpr int KSTR = DQK + 8, VSTR = KEYS + 8;
  constexpr int KCH = DQK / 8, VCH = KEYS / 8;
  constexpr int NKC = KEYS * KCH / NTHR, NVC = 64 * VCH / NTHR;
  constexpr int KSLOT = KEYS * KSTR, VSLOT = 64 * VSTR;
  u16* sK = (u16*)smem;
  u16* sV = sK + 3 * KSLOT;
  const int tid = opaque_tid(), lane = tid & 63, wave = tid >> 6, r = lane & 31, h = lane >> 5;
  const int qtok = qtok0 + wave * 32 + r;

  bf16x8 qf[NCOMP][KS];
#pragma unroll
  for (int c = 0; c < NCOMP; ++c)
#pragma unroll
    for (int ks = 0; ks < KS; ++ks) qf[c][ks] = *(const bf16x8*)(Q + (size_t)qtok * ldq + c * DC + ks * 16 + 8 * h);

  f32x16 Oa[NCOMP][2];
  float m[NCOMP], l[NCOMP];
#pragma unroll
  for (int c = 0; c < NCOMP; ++c) {
#pragma unroll
    for (int d = 0; d < 2; ++d)
#pragma unroll
      for (int v = 0; v < 16; ++v) Oa[c][d][v] = 0.f;
    m[c] = BAND ? sink_l2 : -1e30f;
    l[c] = (BAND && h == 0) ? 1.f : 0.f;
  }

  const u16* kg[NKC]; int kso[NKC];
#pragma unroll
  for (int i = 0; i < NKC; ++i) {
    const int c = tid + i * NTHR;
    const int row = c / KCH, cc = c % KCH;
    kg[i] = Kp + (size_t)(kbeg + row) * ldk + cc * 8;
    kso[i] = row * KSTR + cc * 8;
  }
  const u16* vg[NVC]; int vso[NVC];
#pragma unroll
  for (int i = 0; i < NVC; ++i) {
    const int c = tid + i * NTHR;
    const int row = c / VCH, cc = c % VCH;
    vg[i] = Vt + (size_t)(kbeg >> 7) * 8192 + row * 128 + cc * 8;
    vso[i] = row * VSTR + cc * 8;
  }
  u32x4 kreg[NKC], vreg[NVC];
  auto loadK = [&](int t) {
#pragma unroll
    for (int i = 0; i < NKC; ++i) kreg[i] = gld16(kg[i] + (size_t)t * KEYS * ldk);
  };
  auto loadV = [&](int t) {
#pragma unroll
    for (int i = 0; i < NVC; ++i) vreg[i] = gld16(vg[i] + (size_t)t * 8192);
  };
  auto waitK = [&]() {
    if constexpr (NKC == 1) wait_vm0(kreg[0]);
    else if constexpr (NKC == 2) wait_vm0(kreg[0], kreg[1]);
    else wait_vm0(kreg[0], kreg[1], kreg[2]);
  };
  auto waitV = [&]() {
    if constexpr (NVC == 1) wait_vm0(vreg[0]);
    else wait_vm0(vreg[0], vreg[1]);
  };
  auto storeK = [&](int slot) {
#pragma unroll
    for (int i = 0; i < NKC; ++i) *(u32x4*)(sK + slot * KSLOT + kso[i]) = kreg[i];
  };
  auto storeV = [&](int slot) {
#pragma unroll
    for (int i = 0; i < NVC; ++i) *(u32x4*)(sV + slot * VSLOT + vso[i]) = vreg[i];
  };

  f32x16 S0[2], S1[2];
  bf16x8 pfA[2][2], pfB[2][2];
  float alpha_pend = 1.f;
  bool need_pend = false;

  auto att_S = [&](auto uu_t, f32x16 (&S)[2], int slot) {
    constexpr int UU = decltype(uu_t)::value;
    constexpr int C = (NCOMP == 2) ? UU : 0;
    const u16* base = sK + slot * KSLOT + ((NCOMP == 1 ? UU * 64 : 0) + r) * KSTR + (NCOMP == 2 ? UU * DC : 0) + 8 * h;
#pragma unroll
    for (int kb = 0; kb < 2; ++kb) {
#pragma unroll
      for (int v = 0; v < 16; ++v) S[kb][v] = 0.f;
#pragma unroll
      for (int ks = 0; ks < KS; ++ks) {
        bf16x8 kf = *(const bf16x8*)(base + kb * 32 * KSTR + ks * 16);
        S[kb] = MFMA32(kf, qf[C][ks], S[kb]);
      }
    }
  };
  auto att_PV = [&](auto uu_t, const bf16x8 (&pf)[2][2], int slot) {
    constexpr int UU = decltype(uu_t)::value;
    constexpr int C = (NCOMP == 2) ? UU : 0;
    const u16* base = sV + slot * VSLOT + r * VSTR + (NCOMP == 1 ? UU * 64 : 0) + 8 * h;
#pragma unroll
    for (int d = 0; d < 2; ++d)
#pragma unroll
      for (int kb = 0; kb < 2; ++kb)
#pragma unroll
        for (int s = 0; s < 2; ++s) {
          bf16x8 vf = *(const bf16x8*)(base + d * 32 * VSTR + kb * 32 + 16 * s);
          Oa[C][d] = MFMA32(vf, pf[kb][s], Oa[C][d]);
        }
  };
  auto att_rescale = [&](auto uu_t) {
    constexpr int UU = decltype(uu_t)::value;
    constexpr int C = (NCOMP == 2) ? UU : 0;
    if (need_pend) {
#pragma unroll
      for (int d = 0; d < 2; ++d)
#pragma unroll
        for (int v = 0; v < 16; ++v) Oa[C][d][v] *= alpha_pend;
    }
  };
  auto att_softmax = [&](auto uu_t, f32x16 (&S)[2], bf16x8 (&pf)[2][2], int kpos0) {
    constexpr int UU = decltype(uu_t)::value;
    constexpr int C = (NCOMP == 2) ? UU : 0;
    if constexpr (BAND) {
#pragma unroll
      for (int kb = 0; kb < 2; ++kb)
#pragma unroll
        for (int v = 0; v < 16; ++v) {
          const int d = kpos0 + kb * 32 + crow(v, h) - qtok;
          if (d > 128 || d < -128) S[kb][v] = -1e30f;
        }
    }
    float mx = S[0][0];
#pragma unroll
    for (int kb = 0; kb < 2; ++kb)
#pragma unroll
      for (int v = 0; v < 16; ++v) mx = fmaxf(mx, S[kb][v]);
    mx = fmaxf(mx, __shfl_xor(mx, 32));
    const float mold = m[C];
    const float mnew = fmaxf(mold, mx * sc_l2);
    need_pend = __builtin_amdgcn_ballot_w64(mnew > mold) != 0;
    alpha_pend = __builtin_amdgcn_exp2f(mold - mnew);
    m[C] = mnew;
    float rsum = 0.f;
#pragma unroll
    for (int kb = 0; kb < 2; ++kb)
#pragma unroll
      for (int v = 0; v < 16; ++v) {
        float p = __builtin_amdgcn_exp2f(__builtin_fmaf(S[kb][v], sc_l2, -mnew));
        S[kb][v] = p;
        rsum += p;
      }
    l[C] = l[C] * alpha_pend + rsum;
#pragma unroll
    for (int kb = 0; kb < 2; ++kb)
#pragma unroll
      for (int s = 0; s < 2; ++s) {
        u32x4 pk;
        pk.x = pk2(S[kb][8 * s + 0], S[kb][8 * s + 1]);
        pk.y = pk2(S[kb][8 * s + 2], S[kb][8 * s + 3]);
        pk.z = pk2(S[kb][8 * s + 4], S[kb][8 * s + 5]);
        pk.w = pk2(S[kb][8 * s + 6], S[kb][8 * s + 7]);
        pf[kb][s] = __builtin_bit_cast(bf16x8, pk);
      }
  };
  using U0 = std::integral_constant<int, 0>;
  using U1 = std::integral_constant<int, 1>;

  const int ntl = (kend - kbeg) / KEYS;
  auto step = [&](auto first_t, auto lk_t, auto lv_t, int t, int sa, int sb, int sc) {
    constexpr bool FIRST = decltype(first_t)::value, LK = decltype(lk_t)::value, LV = decltype(lv_t)::value;
    if constexpr (LK) loadK(t + 2);
    if constexpr (LV) loadV(t + 1);
    if constexpr (!FIRST) att_rescale(U1{});
    att_S(U1{}, S1, sa);
    if constexpr (!FIRST) att_PV(U1{}, pfB, sc);
    att_softmax(U0{}, S0, pfA, kbeg + t * KEYS);
    att_rescale(U0{});
    if constexpr (LV) att_S(U0{}, S0, sb);
    att_PV(U0{}, pfA, sa);
    att_softmax(U1{}, S1, pfB, kbeg + t * KEYS + 64);
    if constexpr (LK) { waitK(); storeK(sc); }
    if constexpr (LV) { waitV(); storeV(sb); }
    __syncthreads();
  };
  using TT = std::true_type;
  using FF = std::false_type;

  loadK(0); loadV(0);
  waitK(); waitV();
  storeK(0); storeV(0);
  loadK(1);
  waitK();
  storeK(1);
  __syncthreads();
  att_S(U0{}, S0, 0);
  int sa = 0, sb = 1, sc = 2;
  step(TT{}, TT{}, TT{}, 0, sa, sb, sc);
  { int tmp = sa; sa = sb; sb = sc; sc = tmp; }
  for (int t = 1; t < ntl - 2; ++t) {
    step(FF{}, TT{}, TT{}, t, sa, sb, sc);
    int tmp = sa; sa = sb; sb = sc; sc = tmp;
  }
  step(FF{}, FF{}, TT{}, ntl - 2, sa, sb, sc);
  { int tmp = sa; sa = sb; sb = sc; sc = tmp; }
  step(FF{}, FF{}, FF{}, ntl - 1, sa, sb, sc);
  att_rescale(U1{});
  att_PV(U1{}, pfB, sa);

  float inv[NCOMP];
#pragma unroll
  for (int c = 0; c < NCOMP; ++c) {
    float lt = l[c] + __shfl_xor(l[c], 32);
    inv[c] = 1.f / lt;
  }
  if constexpr (EPI == 1) {
#pragma unroll
    for (int d = 0; d < 2; ++d)
#pragma unroll
      for (int vq = 0; vq < 4; ++vq) {
        float4 o = {Oa[0][d][4 * vq] * inv[0], Oa[0][d][4 * vq + 1] * inv[0], Oa[0][d][4 * vq + 2] * inv[0], Oa[0][d][4 * vq + 3] * inv[0]};
        *(float4*)(DS + (size_t)qtok * 256 + d * 32 + 8 * vq + 4 * h) = o;
      }
  } else {
    if constexpr (EPI == 2) {
      float ss = 0.f;
#pragma unroll
      for (int d = 0; d < 2; ++d)
#pragma unroll
        for (int vq = 0; vq < 4; ++vq) {
          const float4 o1 = *(const float4*)(DS + (size_t)qtok * 256 + d * 32 + 8 * vq + 4 * h);
          const float a0 = o1.x - lam * Oa[0][d][4 * vq] * inv[0];
          const float a1 = o1.y - lam * Oa[0][d][4 * vq + 1] * inv[0];
          const float a2 = o1.z - lam * Oa[0][d][4 * vq + 2] * inv[0];
          const float a3 = o1.w - lam * Oa[0][d][4 * vq + 3] * inv[0];
          Oa[0][d][4 * vq] = a0; Oa[0][d][4 * vq + 1] = a1; Oa[0][d][4 * vq + 2] = a2; Oa[0][d][4 * vq + 3] = a3;
          ss += a0 * a0 + a1 * a1 + a2 * a2 + a3 * a3;
        }
      ss += __shfl_xor(ss, 32);
      const float rs = rsqrtf(ss * (1.f / 64.f) + EPS) * onorm;
#pragma unroll
      for (int d = 0; d < 2; ++d)
#pragma unroll
        for (int v = 0; v < 16; ++v) Oa[0][d][v] *= rs * subg[d * 32 + crow(v, h)];
    } else {
#pragma unroll
      for (int d = 0; d < 2; ++d)
#pragma unroll
        for (int v = 0; v < 16; ++v) Oa[0][d][v] *= inv[0];
    }
    store_rows(O, KP1, 0, Oa[0][0], qtok, h);
    store_rows(O, KP1, 32, Oa[0][1], qtok, h);
  }
  __syncthreads();
}

DI void attn_phase(const Params& P, int layer, char* smem) {
  char* ws = P.ws;
  u16* qkv = (u16*)(ws + OFF_QKV);
  u16* BR = (u16*)(ws + OFF_XN);
  const float L2E = 1.4426950408889634f;
  const float lambda_init = 0.8f - 0.6f * __expf(-0.3f * (float)layer);
  float lam;
  {
    const float* dl = P.d_lambda + layer * 128;
    float s1 = 0.f, s2 = 0.f;
    for (int i = 0; i < 32; ++i) { s1 += dl[i] * dl[32 + i]; s2 += dl[64 + i] * dl[96 + i]; }
    lam = __expf(s1) - __expf(s2) + lambda_init;
  }
  for (int it = blockIdx.x; it < 2048; it += gridDim.x) {
    const int cls = it >> 8;
    if (cls < 6) {
      const int idx = it & 255;
      const int head = (idx & 7) >> 1;
      const int qb = ((idx >> 3) << 1) + (idx & 1);
      int qtok0, kbeg, kend;
      if (cls < 3) { qtok0 = qb * 256; kbeg = 0; kend = SEQ0; }
      else { const int s = qb >> 3; kbeg = SEQ0 + s * DSEQ; kend = kbeg + DSEQ; qtok0 = kbeg + (qb & 7) * 256; }
      const int typ = cls % 3;
      if (typ == 0) {
        float* DS = (float*)(ws + OFF_DS) + head * 64;
        attn_item<32, 1, false, 1>(qkv + Q_QD + head * 64, 256, qkv + Q_KD + head * 64, 256,
                                   qkv + Q_VTD + (size_t)head * 64 * T, qtok0, kbeg, kend,
                                   0.17677669529663687f * L2E, 0.f, lam, 1.f - lambda_init,
                                   P.d_subln + layer * 64, BR + 768 + head * 64, DS, smem);
        attn_item<32, 1, false, 2>(qkv + Q_QD + head * 64 + 32, 256, qkv + Q_KD + head * 64 + 32, 256,
                                   qkv + Q_VTD + (size_t)head * 64 * T, qtok0, kbeg, kend,
                                   0.17677669529663687f * L2E, 0.f, lam, 1.f - lambda_init,
                                   P.d_subln + layer * 64, BR + 768 + head * 64, DS, smem);
      } else if (typ == 1) {
        attn_item<96, 1, false, 0>(qkv + Q_QC + head * 96, 384, qkv + Q_KC + head * 96, 384,
                                       qkv + Q_VTC + (size_t)head * 64 * T, qtok0, kbeg, kend,
                                       0.10206207261596577f * L2E, 0.f, 0.f, 1.f, nullptr, BR + 512 + head * 64, nullptr, smem);
      } else {
        attn_item<64, 1, false, 0>(qkv + Q_QA + head * 64, 256, qkv + Q_KA + (head >> 1) * 64, 128,
                                       qkv + Q_VTA + (size_t)(head >> 1) * 64 * T, qtok0, kbeg, kend,
                                       0.125f * L2E, 0.f, 0.f, 1.f, nullptr, BR + head * 64, nullptr, smem);
      }
    } else {
      const int idx = it - 1536;
      const int head = (idx & 7) >> 1;
      const int qbg = ((idx >> 3) << 1) + (idx & 1);
      const int qtok0 = qbg * 256;
      int sb, se;
      if (qtok0 < SEQ0) { sb = 0; se = SEQ0; }
      else { sb = SEQ0 + ((qtok0 - SEQ0) / DSEQ) * DSEQ; se = sb + DSEQ; }
      const int kbeg = max(sb, qtok0 - 128), kend = min(se, qtok0 + 256 + 128);
      const float sink = P.b_sink[layer * 4 + head];
      attn_item<64, 1, true, 0>(qkv + Q_QB + head * 64, 256, qkv + Q_KB + (head >> 1) * 64, 128,
                                    qkv + Q_VTB + (size_t)(head >> 1) * 64 * T, qtok0, kbeg, kend,
                                    0.125f * L2E, sink * L2E, 0.f, 1.f, nullptr, BR + 256 + head * 64, nullptr, smem);
    }
  }
}

DI void ew_phase(const Params& P, const u16* __restrict__ Y, float coef, const float* __restrict__ gpost,
                 const float* __restrict__ gnext, bool from_inputs) {
  const int tid = opaque_tid();
  const int lane = tid & 63, wave = tid >> 6;
  u16* XN = (u16*)(P.ws + OFF_XN);
  for (int tok = blockIdx.x * 8 + wave; tok < T; tok += gridDim.x * 8) {
    const float* xs = from_inputs ? (tok < SEQ0 ? P.x_prompt + (size_t)tok * DM : P.x_sample + (size_t)(tok - SEQ0) * DM)
                                  : P.out + (size_t)tok * DM;
    float4 x[4];
#pragma unroll
    for (int i = 0; i < 4; ++i) x[i] = *(const float4*)(xs + (i * 64 + lane) * 4);
    if (Y) {
      float4 y[4];
      float ss = 0.f;
#pragma unroll
      for (int i = 0; i < 4; ++i) {
        const uint2 yb = *(const uint2*)(Y + (size_t)tok * KP1 + (i * 64 + lane) * 4);
        y[i] = make_float4(bf2f(yb.x & 0xffffu), bf2f(yb.x >> 16), bf2f(yb.y & 0xffffu), bf2f(yb.y >> 16));
        ss += y[i].x * y[i].x + y[i].y * y[i].y + y[i].z * y[i].z + y[i].w * y[i].w;
      }
      ss = wave_sum(ss);
      const float rs = rsqrtf(ss * (1.f / 1024.f) + EPS) * coef;
#pragma unroll
      for (int i = 0; i < 4; ++i) {
        float4 g = *(const float4*)(gpost + (i * 64 + lane) * 4);
        x[i].x += y[i].x * rs * g.x; x[i].y += y[i].y * rs * g.y;
        x[i].z += y[i].z * rs * g.z; x[i].w += y[i].w * rs * g.w;
      }
    }
#pragma unroll
    for (int i = 0; i < 4; ++i) *(float4*)(P.out + (size_t)tok * DM + (i * 64 + lane) * 4) = x[i];
    if (gnext) {
      float ss = 0.f;
#pragma unroll
      for (int i = 0; i < 4; ++i) ss += x[i].x * x[i].x + x[i].y * x[i].y + x[i].z * x[i].z + x[i].w * x[i].w;
      ss = wave_sum(ss);
      const float rs = rsqrtf(ss * (1.f / 1024.f) + EPS);
#pragma unroll
      for (int i = 0; i < 4; ++i) {
        float4 g = *(const float4*)(gnext + (i * 64 + lane) * 4);
        uint2 pk;
        pk.x = pk2(x[i].x * rs * g.x, x[i].y * rs * g.y);
        pk.y = pk2(x[i].z * rs * g.z, x[i].w * rs * g.w);
        *(uint2*)(XN + (size_t)tok * KP1 + (i * 64 + lane) * 4) = pk;
      }
    }
  }
}

DI int colmap(int mode, int n, int nsrc) {
  if (mode == 1) { return ((n >> 5) & 1) * DFF + (n >> 6) * 32 + (n & 31); }
  if (mode == 2) {
    if (n < 1664) return n;
    if (n < 2432) return n + 32;
    if (n < 2464) return n - 2432 + 1664;
    if (n < 2560) return -1;
    return n - 96;
  }
  return n < nsrc ? n : -1;
}
DI void conv_job(u16* __restrict__ dst, int ldd, const float* __restrict__ src, int Nd, int K, int lds, int mode,
                 const float* __restrict__ kscale) {
  const int total = Nd * (K >> 3);
  const int gthreads = gridDim.x * NTHR;
  for (int idx = blockIdx.x * NTHR + opaque_tid(); idx < total; idx += gthreads) {
    const int n = idx % Nd, k8 = idx / Nd;
    const int col = colmap(mode, n, lds);
    float v[8];
#pragma unroll
    for (int j = 0; j < 8; ++j) {
      float x = 0.f;
      if (col >= 0) {
        x = src[(size_t)(k8 * 8 + j) * lds + col];
        if (kscale) x *= kscale[k8 * 8 + j];
      }
      v[j] = x;
    }
    uint4 pk = {pk2(v[0], v[1]), pk2(v[2], v[3]), pk2(v[4], v[5]), pk2(v[6], v[7])};
    *(uint4*)(dst + (size_t)n * ldd + k8 * 8) = pk;
  }
}
DI void convert_layer(const Params& P, int l) {
  u16* W = (u16*)(P.ws + OFF_W);
  for (int s = 0; s < 2; ++s) {
    conv_job(W + W_WI + (size_t)s * 5632 * KP1, KP1, P.ffn_wi + ((size_t)l * 2 + s) * 1024 * 5632, 5632, 1024, 5632, 1, nullptr);
    conv_job(W + W_WO + (size_t)s * 1024 * KP2, KP2, P.ffn_wo + ((size_t)l * 2 + s) * 2816 * 1024, 1024, 2816, 1024, 0, nullptr);
  }
  conv_job(W + W_WIN, KP1, P.w_in + (size_t)l * 1024 * NPROJ, 6656, 1024, NPROJ, 2, nullptr);
  conv_job(W + W_WUQ, 384, P.c_w_uq + (size_t)l * 384 * 384, 512, 384, 384, 0, P.c_q_norm + l * 384);
  conv_job(W + W_WUKV, 256, P.c_w_ukv + (size_t)l * 256 * 512, 512, 256, 512, 0, P.c_kv_norm + l * 256);
  conv_job(W + W_WB, KP1, P.w_branch + (size_t)l * 1024 * 1024, 1024, 1024, 1024, 0, nullptr);
  conv_job(W + W_WOUT, KP1, P.w_out + (size_t)l * 1024 * 1024, 1024, 1024, 1024, 0, nullptr);
}
DI void rope_tables(const Params& P) {
  float2* R64 = (float2*)(P.ws + OFF_R64);
  float2* R32 = (float2*)(P.ws + OFF_R32);
  const int gthreads = gridDim.x * NTHR;
  for (int idx = blockIdx.x * NTHR + opaque_tid(); idx < 16384 * 48; idx += gthreads) {
    int pos, f; double base; float2* dst;
    if (idx < 16384 * 32) { pos = idx >> 5; f = idx & 31; base = 0.7498942093324559; dst = R64 + idx; }
    else { const int i2 = idx - 16384 * 32; pos = i2 >> 4; f = i2 & 15; base = 0.5623413251903491; dst = R32 + i2; }
    double inv = 1.0;
    for (int k = 0; k < f; ++k) inv *= base;
    const float ang = (float)pos * (float)inv;
    double tr = (double)ang * 0.15915494309189535;
    tr -= rint(tr);
    const float tf = (float)tr;
    *dst = make_float2(__builtin_amdgcn_cosf(tf), __builtin_amdgcn_sinf(tf));
  }
}

DI void fast_grid_barrier(unsigned* bar, unsigned nblk) {
  asm volatile("s_waitcnt vmcnt(0) lgkmcnt(0)" ::: "memory");
  __syncthreads();
  if (threadIdx.x == 0) {
    __builtin_amdgcn_fence(__ATOMIC_RELEASE, "agent");
    asm volatile("s_waitcnt vmcnt(0) lgkmcnt(0)" ::: "memory");
    const unsigned gen = __hip_atomic_load(&bar[64], __ATOMIC_RELAXED, __HIP_MEMORY_SCOPE_AGENT);
    const unsigned old = __hip_atomic_fetch_add(&bar[0], 1u, __ATOMIC_RELAXED, __HIP_MEMORY_SCOPE_AGENT);
    if (old == nblk - 1u) {
      __hip_atomic_store(&bar[0], 0u, __ATOMIC_RELAXED, __HIP_MEMORY_SCOPE_AGENT);
      __hip_atomic_fetch_add(&bar[64], 1u, __ATOMIC_RELEASE, __HIP_MEMORY_SCOPE_AGENT);
    } else {
      while (__hip_atomic_load(&bar[64], __ATOMIC_RELAXED, __HIP_MEMORY_SCOPE_AGENT) == gen) __builtin_amdgcn_s_sleep(1);
    }
    __builtin_amdgcn_fence(__ATOMIC_ACQUIRE, "agent");
    asm volatile("s_waitcnt vmcnt(0) lgkmcnt(0)" ::: "memory");
  }
  __syncthreads();
}

__global__ void __launch_bounds__(NTHR) __attribute__((amdgpu_waves_per_eu(2, 2))) mega(Params P) {
  extern __shared__ __attribute__((aligned(16))) char smem[];
  cg::grid_group grid = cg::this_grid();
  int phase = 0;
#define ACTIVE() (phase >= P.phase_lo && phase < P.phase_hi)
#define SEAM() do { ++phase; if (P.coop) { if (phase == 1) grid.sync(); else fast_grid_barrier((unsigned*)(P.ws + OFF_BAR), gridDim.x); } } while (0)
  u16* W = (u16*)(P.ws + OFF_W);
  u16* XN = (u16*)(P.ws + OFF_XN);
  u16* R2 = (u16*)(P.ws + OFF_R2);
  u16* qkv = (u16*)(P.ws + OFF_QKV);
  const u16* Y = qkv + Q_Y;

  if (ACTIVE()) {
    rope_tables(P);
    convert_layer(P, 0);
    ew_phase(P, nullptr, 0.f, nullptr, P.norm_g, true);
  }
  SEAM();
  for (int l = 0; l < 4; ++l) {
    const float* g = P.norm_g + (size_t)l * 6 * DM;
    if (ACTIVE()) gemm_phase<M_FFNUP, 4>(W + W_WI, KP1, XN, KP1, DM, 22, smem, P, l);
    SEAM();
    if (ACTIVE()) gemm_phase<M_Y, 4>(W + W_WO, KP2, R2, KP2, DFF, 4, smem, P, l);
    SEAM();
    if (ACTIVE()) ew_phase(P, Y, 0.5f, g + DM, g + 2 * DM, false);
    SEAM();
    if (ACTIVE()) {
      gemm_phase<M_PROJ, 4>(W + W_WIN, KP1, XN, KP1, DM, 10, smem, P, l);
      gemm_phase<M_GATE, 4>(W + W_WIN + 2560ull * KP1, KP1, XN, KP1, DM, 16, smem, P, l);
    }
    SEAM();
    if (ACTIVE()) {
      gemm_phase<M_CUQ, 4>(W + W_WUQ, 384, qkv + Q_CQ, 384, 384, 2, smem, P, l);
      gemm_phase<M_CUKV, 4>(W + W_WUKV, 256, qkv + Q_CKV, 256, 256, 2, smem, P, l);
    }
    SEAM();
    if (ACTIVE()) attn_phase(P, l, smem);
    SEAM();
    if (ACTIVE()) gemm_phase<M_MERGE, 2>(W + W_WB, KP1, XN, KP1, DM, 4, smem, P, l);
    SEAM();
    if (ACTIVE()) gemm_phase<M_Y, 4>(W + W_WOUT, KP1, qkv + Q_MERGED, KP1, DM, 4, smem, P, l);
    SEAM();
    if (ACTIVE()) ew_phase(P, Y, 1.0f, g + 3 * DM, g + 4 * DM, false);
    SEAM();
    if (ACTIVE()) gemm_phase<M_FFNUP, 4>(W + W_WI + 5632ull * KP1, KP1, XN, KP1, DM, 22, smem, P, l);
    SEAM();
    if (ACTIVE()) gemm_phase<M_Y, 4>(W + W_WO + 1024ull * KP2, KP2, R2, KP2, DFF, 4, smem, P, l);
    SEAM();
    if (ACTIVE()) {
      ew_phase(P, Y, 0.5f, g + 5 * DM, l < 3 ? g + 6 * DM : nullptr, false);
      if (l < 3) convert_layer(P, l + 1);
    }
    SEAM();
  }
}

constexpr int N_PHASES = 1 + 12 * 4;

extern "C" void kernel_launch(void* const* d_in, const int* in_sizes, int n_in, void* d_out, int out_size, void* d_ws,
                              size_t ws_size, hipStream_t stream) {
  static int grid_blocks = 0;
  if (!grid_blocks) {
    int dev = 0, cus = 0, per_cu = 0;
    hipGetDevice(&dev);
    hipDeviceGetAttribute(&cus, hipDeviceAttributeMultiprocessorCount, dev);
    hipFuncSetAttribute((const void*)mega, hipFuncAttributeMaxDynamicSharedMemorySize, SMEM_BYTES);
    hipOccupancyMaxActiveBlocksPerMultiprocessor(&per_cu, mega, NTHR, SMEM_BYTES);
    if (per_cu < 1) per_cu = 1;
    grid_blocks = cus * per_cu;
  }
  if (ws_size < WS_NEEDED) fprintf(stderr, "workspace too small: %zu < %zu\n", ws_size, (size_t)WS_NEEDED);
  Params P{};
  P.x_prompt = (const float*)d_in[0]; P.x_sample = (const float*)d_in[1]; P.norm_g = (const float*)d_in[2];
  P.w_in = (const float*)d_in[3]; P.a_qk_norm = (const float*)d_in[4]; P.b_sink = (const float*)d_in[5];
  P.c_q_norm = (const float*)d_in[6]; P.c_kv_norm = (const float*)d_in[7]; P.c_w_uq = (const float*)d_in[8];
  P.c_w_ukv = (const float*)d_in[9]; P.d_lambda = (const float*)d_in[10]; P.d_subln = (const float*)d_in[11];
  P.w_branch = (const float*)d_in[12]; P.w_out = (const float*)d_in[13]; P.ffn_wi = (const float*)d_in[14];
  P.ffn_wo = (const float*)d_in[15];
  P.out = (float*)d_out; P.ws = (char*)d_ws;
#if MULTI_LAUNCH
  for (int ph = 0; ph < N_PHASES; ++ph) {
    P.phase_lo = ph; P.phase_hi = ph + 1; P.coop = 0; P.pad0 = 0;
    hipLaunchKernelGGL(mega, dim3(grid_blocks), dim3(NTHR), SMEM_BYTES, stream, P);
  }
#else
  P.phase_lo = 0; P.phase_hi = 1 << 30; P.coop = 1; P.pad0 = 0;
  hipMemsetAsync((char*)d_ws + OFF_BAR, 0, 1024, stream);
  void* args[] = {&P};
  hipError_t e = hipLaunchCooperativeKernel((const void*)mega, dim3(grid_blocks), dim3(NTHR), args, SMEM_BYTES, stream);
  if (e != hipSuccess) fprintf(stderr, "cooperative launch failed: %s (grid %d)\n", hipGetErrorString(e), grid_blocks);
#endif
}
```

```cpp
#include <hip/hip_runtime.h>
#include <hip/hip_cooperative_groups.h>
#include <cstdio>
#include <cstdint>
#include <type_traits>
namespace cg = cooperative_groups;

#ifndef MULTI_LAUNCH
#define MULTI_LAUNCH 0
#endif

#define DI __device__ __forceinline__
typedef unsigned short u16;
typedef __attribute__((ext_vector_type(8))) short bf16x8;
typedef __attribute__((ext_vector_type(16))) float f32x16;
typedef __attribute__((ext_vector_type(2))) float f32x2_t;
typedef __attribute__((ext_vector_type(2))) __bf16 bf16x2_t;

constexpr int T = 32768;
constexpr int DM = 1024;
constexpr int DFF = 2816;
constexpr int KP1 = 1088;
constexpr int KP2 = 2880;
constexpr int GP = 4160;
constexpr int YP = 1040;
constexpr int NPROJ = 6560;
constexpr int SEQ0 = 16384;
constexpr int DSEQ = 2048;
constexpr float EPS = 1e-6f;
constexpr int NTHR = 512;
constexpr int LSTR = 72;
constexpr int SMEM_BYTES = 2 * 2 * 256 * LSTR * 2;

constexpr size_t W_WI = 0;
constexpr size_t W_WO = W_WI + 2ull * 5632 * KP1;
constexpr size_t W_WIN = W_WO + 2ull * 1024 * KP2;
constexpr size_t W_WUQ = W_WIN + 6656ull * KP1;
constexpr size_t W_WUKV = W_WUQ + 512ull * 384;
constexpr size_t W_WB = W_WUKV + 512ull * 256;
constexpr size_t W_WOUT = W_WB + 1024ull * KP1;
constexpr size_t W_TOTAL = W_WOUT + 1024ull * KP1;

constexpr size_t OFF_W = 0;
constexpr size_t OFF_XN = OFF_W + W_TOTAL * 2;
constexpr size_t OFF_R2 = OFF_XN + (size_t)T * KP1 * 2;
constexpr size_t OFF_QKV = OFF_R2 + (size_t)T * KP2 * 2;
constexpr size_t OFF_SS = OFF_QKV + (size_t)T * 3456 * 2;
constexpr size_t OFF_R64 = OFF_SS + (size_t)T * 20 * 4;
constexpr size_t OFF_R32 = OFF_R64 + 16384ull * 32 * 8;
constexpr size_t OFF_DS = OFF_R32 + 16384ull * 16 * 8;
constexpr size_t OFF_BAR = OFF_DS + (size_t)T * 256 * 4;
constexpr size_t OFF_XB = OFF_BAR + 1024;
constexpr size_t WS_NEEDED = OFF_XB + (size_t)T * 1024 * 2;

constexpr size_t Q_QA = 0;
constexpr size_t Q_KA = (size_t)T * 256;
constexpr size_t Q_VTA = (size_t)T * 384;
constexpr size_t Q_QB = (size_t)T * 512;
constexpr size_t Q_KB = (size_t)T * 768;
constexpr size_t Q_VTB = (size_t)T * 896;
constexpr size_t Q_CQ = (size_t)T * 1024;
constexpr size_t Q_CKV = (size_t)T * 1408;
constexpr size_t Q_QC = (size_t)T * 1664;
constexpr size_t Q_KC = (size_t)T * 2048;
constexpr size_t Q_VTC = (size_t)T * 2432;
constexpr size_t Q_QD = (size_t)T * 2688;
constexpr size_t Q_KD = (size_t)T * 2944;
constexpr size_t Q_VTD = (size_t)T * 3200;
constexpr size_t Q_MERGED = 0;
constexpr size_t Q_Y = (size_t)T * KP1;

struct Params {
  const float* x_prompt; const float* x_sample; const float* norm_g; const float* w_in;
  const float* a_qk_norm; const float* b_sink; const float* c_q_norm; const float* c_kv_norm;
  const float* c_w_uq; const float* c_w_ukv; const float* d_lambda; const float* d_subln;
  const float* w_branch; const float* w_out; const float* ffn_wi; const float* ffn_wo;
  float* out; char* ws;
  int phase_lo; int phase_hi; int coop; int pad0;
};

DI unsigned pk2(float a, float b) {
  f32x2_t v = {a, b};
  bf16x2_t r = __builtin_convertvector(v, bf16x2_t);
  return __builtin_bit_cast(unsigned, r);
}
DI u16 f2bf(float a) { return (u16)(pk2(a, 0.f) & 0xffffu); }
DI float bf2f(unsigned bits16) { return __uint_as_float(bits16 << 16); }
DI int crow(int v, int h) { return (v & 3) + 8 * (v >> 2) + 4 * h; }
DI int pos_of(int tok) { return tok < SEQ0 ? tok : ((tok - SEQ0) & (DSEQ - 1)); }
#define MFMA32(a, b, c) __builtin_amdgcn_mfma_f32_32x32x16_bf16((a), (b), (c), 0, 0, 0)

typedef __attribute__((ext_vector_type(4))) unsigned u32x4;
DI u32x4 gld16(const void* p) { u32x4 r; asm volatile("global_load_dwordx4 %0, %1, off" : "=v"(r) : "v"(p)); return r; }
DI void wait_vm0(u32x4& a) { asm volatile("s_waitcnt vmcnt(0)" : "+v"(a) :: "memory"); }
DI void wait_vm0(u32x4& a, u32x4& b) { asm volatile("s_waitcnt vmcnt(0)" : "+v"(a), "+v"(b) :: "memory"); }
DI void wait_vm0(u32x4& a, u32x4& b, u32x4& c) { asm volatile("s_waitcnt vmcnt(0)" : "+v"(a), "+v"(b), "+v"(c) :: "memory"); }
DI void wait_vm0(u32x4& a, u32x4& b, u32x4& c, u32x4& d) { asm volatile("s_waitcnt vmcnt(0)" : "+v"(a), "+v"(b), "+v"(c), "+v"(d) :: "memory"); }
DI u32x4 gld16s(unsigned voff, const void* sbase) { u32x4 r; asm volatile("global_load_dwordx4 %0, %1, %2" : "=v"(r) : "v"(voff), "s"(sbase)); return r; }
#define DEF_WAIT8(name, cnt) DI void name(u32x4& a, u32x4& b, u32x4& c, u32x4& d, u32x4& e, u32x4& f, u32x4& g, u32x4& h) { asm volatile("s_waitcnt vmcnt(" #cnt ")" : "+v"(a), "+v"(b), "+v"(c), "+v"(d), "+v"(e), "+v"(f), "+v"(g), "+v"(h) :: "memory"); }
#define DEF_WAIT6(name, cnt) DI void name(u32x4& a, u32x4& b, u32x4& c, u32x4& d, u32x4& e, u32x4& f) { asm volatile("s_waitcnt vmcnt(" #cnt ")" : "+v"(a), "+v"(b), "+v"(c), "+v"(d), "+v"(e), "+v"(f) :: "memory"); }
DEF_WAIT8(wait8_vm8, 8)
DEF_WAIT8(wait8_vm0, 0)
DEF_WAIT6(wait6_vm6, 6)
DEF_WAIT6(wait6_vm0, 0)
DI int opaque_tid() { int t = threadIdx.x; asm volatile("" : "+v"(t)); return t; }
DI float wave_sum(float v) {
#pragma unroll
  for (int m = 32; m >= 1; m >>= 1) v += __shfl_xor(v, m);
  return v;
}

DI void rope32_blk(f32x16& a, const float2* __restrict__ tab, int h) {
#pragma unroll
  for (int v = 0; v < 8; ++v) {
    float2 cs = tab[crow(v, h)];
    float x1 = a[v], x2 = a[v + 8];
    a[v] = x1 * cs.x - x2 * cs.y;
    a[v + 8] = x2 * cs.x + x1 * cs.y;
  }
}
DI void rope64_blk(f32x16& a0, f32x16& a1, const float2* __restrict__ tab, int h) {
#pragma unroll
  for (int v = 0; v < 16; ++v) {
    float2 cs = tab[crow(v, h)];
    float x1 = a0[v], x2 = a1[v];
    a0[v] = x1 * cs.x - x2 * cs.y;
    a1[v] = x2 * cs.x + x1 * cs.y;
  }
}
DI void store_rows(u16* __restrict__ base, int ld, int col0, const f32x16& a, int tok, int h) {
#pragma unroll
  for (int vq = 0; vq < 4; ++vq) {
    uint2 pk;
    pk.x = pk2(a[4 * vq], a[4 * vq + 1]);
    pk.y = pk2(a[4 * vq + 2], a[4 * vq + 3]);
    *(uint2*)(base + (size_t)tok * ld + col0 + 8 * vq + 4 * h) = pk;
  }
}
DI void store_T(u16* __restrict__ base, int row0, const f32x16& a, int tok, int h) {
  const int tp = (tok & ~12) | ((tok & 4) << 1) | ((tok & 8) >> 1);
#pragma unroll
  for (int v = 0; v < 16; ++v) base[(size_t)((row0 + crow(v, h)) >> 6) * 64 * T + (size_t)(tp >> 7) * 8192 + ((row0 + crow(v, h)) & 63) * 128 + (tp & 127)] = f2bf(a[v]);
}

enum { M_FFNUP = 0, M_Y = 1, M_PROJ = 2, M_CUQ = 3, M_CUKV = 4, M_MERGE = 5, M_GATE = 6 };

template <int MODE, int NJ>
DI void gemm_epilogue(f32x16 (&acc)[2][NJ], int fbase, int tbase, int r, int h, const Params& P, int layer) {
  char* ws = P.ws;
  u16* qkv = (u16*)(ws + OFF_QKV);
  const float2* R64 = (const float2*)(ws + OFF_R64);
  const float2* R32 = (const float2*)(ws + OFF_R32);
  float* SS = (float*)(ws + OFF_SS);
  if constexpr (MODE == M_FFNUP) {
    u16* H = (u16*)(ws + OFF_R2);
    const int hf0 = (fbase >> 6) * 32;
#pragma unroll
    for (int j = 0; j < NJ; ++j) {
      const int tok = tbase + j * 32 + r;
      f32x16 o;
#pragma unroll
      for (int v = 0; v < 16; ++v) {
        float g = acc[0][j][v], u = acc[1][j][v];
        o[v] = g * __builtin_amdgcn_rcpf(1.f + __builtin_amdgcn_exp2f(-1.4426950408889634f * g)) * u;
      }
      store_rows(H, KP2, hf0, o, tok, h);
    }
  } else if constexpr (MODE == M_Y) {
    u16* Yb = qkv + Q_Y;
#pragma unroll
    for (int j = 0; j < NJ; ++j) {
      const int tok = tbase + j * 32 + r;
      store_rows(Yb, KP1, fbase, acc[0][j], tok, h);
      store_rows(Yb, KP1, fbase + 32, acc[1][j], tok, h);
    }
  } else if constexpr (MODE == M_PROJ) {
    if (fbase < 384) {
      const bool isK = fbase >= 256;
      const float* g = P.a_qk_norm + layer * 128 + (isK ? 64 : 0);
      u16* dst = qkv + (isK ? Q_KA : Q_QA);
      const int ld = isK ? 128 : 256;
      const int c0 = isK ? fbase - 256 : fbase;
      float gv[2][16];
#pragma unroll
      for (int i = 0; i < 2; ++i)
#pragma unroll
        for (int v = 0; v < 16; ++v) gv[i][v] = g[i * 32 + crow(v, h)];
#pragma unroll
      for (int j = 0; j < NJ; ++j) {
        const int tok = tbase + j * 32 + r;
        const int pos = pos_of(tok);
        float ss = 0.f;
#pragma unroll
        for (int i = 0; i < 2; ++i)
#pragma unroll
          for (int v = 0; v < 16; ++v) ss += acc[i][j][v] * acc[i][j][v];
        ss += __shfl_xor(ss, 32);
        const float rs = rsqrtf(ss * (1.f / 64.f) + EPS);
#pragma unroll
        for (int i = 0; i < 2; ++i)
#pragma unroll
          for (int v = 0; v < 16; ++v) acc[i][j][v] *= rs * gv[i][v];
        rope32_blk(acc[0][j], R32 + (size_t)(pos >> 6) * 16, h);
        rope32_blk(acc[1][j], R32 + (size_t)(pos & 63) * 16, h);
        store_rows(dst, ld, c0, acc[0][j], tok, h);
        store_rows(dst, ld, c0 + 32, acc[1][j], tok, h);
      }
    } else if (fbase < 512) {
#pragma unroll
      for (int j = 0; j < NJ; ++j) {
        const int tok = tbase + j * 32 + r;
        store_T(qkv + Q_VTA, fbase - 384, acc[0][j], tok, h);
        store_T(qkv + Q_VTA, fbase - 384 + 32, acc[1][j], tok, h);
      }
    } else if (fbase < 896) {
      const bool isK = fbase >= 768;
      u16* dst = qkv + (isK ? Q_KB : Q_QB);
      const int ld = isK ? 128 : 256;
      const int c0 = isK ? fbase - 768 : fbase - 512;
#pragma unroll
      for (int j = 0; j < NJ; ++j) {
        const int tok = tbase + j * 32 + r;
        const int pos = pos_of(tok);
        rope64_blk(acc[0][j], acc[1][j], R64 + (size_t)pos * 32, h);
        store_rows(dst, ld, c0, acc[0][j], tok, h);
        store_rows(dst, ld, c0 + 32, acc[1][j], tok, h);
      }
    } else if (fbase < 1024) {
#pragma unroll
      for (int j = 0; j < NJ; ++j) {
        const int tok = tbase + j * 32 + r;
        store_T(qkv + Q_VTB, fbase - 896, acc[0][j], tok, h);
        store_T(qkv + Q_VTB, fbase - 896 + 32, acc[1][j], tok, h);
      }
    } else if (fbase < 1664) {
      const bool isKV = fbase >= 1408;
      u16* dst = qkv + (isKV ? Q_CKV : Q_CQ);
      const int ld = isKV ? 256 : 384;
      const int c0 = isKV ? fbase - 1408 : fbase - 1024;
      const int sb = (isKV ? 12 : 0) + (c0 >> 5);
#pragma unroll
      for (int j = 0; j < NJ; ++j) {
        const int tok = tbase + j * 32 + r;
#pragma unroll
        for (int i = 0; i < 2; ++i) {
          float ss = 0.f;
#pragma unroll
          for (int v = 0; v < 16; ++v) ss += acc[i][j][v] * acc[i][j][v];
          ss += __shfl_xor(ss, 32);
          if (h == 0) SS[(size_t)tok * 20 + sb + i] = ss;
          store_rows(dst, ld, c0 + i * 32, acc[i][j], tok, h);
        }
      }
    } else if (fbase < 2176) {
      const bool isK = fbase >= 1920;
      u16* dst = qkv + (isK ? Q_KD : Q_QD);
      const int c0 = isK ? fbase - 1920 : fbase - 1664;
#pragma unroll
      for (int j = 0; j < NJ; ++j) {
        const int tok = tbase + j * 32 + r;
        const int pos = pos_of(tok);
#pragma unroll
        for (int i = 0; i < 2; ++i) {
          rope32_blk(acc[i][j], R32 + (size_t)pos * 16, h);
          store_rows(dst, 256, c0 + i * 32, acc[i][j], tok, h);
        }
      }
    } else if (fbase < 2432) {
#pragma unroll
      for (int j = 0; j < NJ; ++j) {
        const int tok = tbase + j * 32 + r;
        store_T(qkv + Q_VTD, fbase - 2176, acc[0][j], tok, h);
        store_T(qkv + Q_VTD, fbase - 2176 + 32, acc[1][j], tok, h);
      }
    } else if (fbase == 2432) {
#pragma unroll
      for (int j = 0; j < NJ; ++j) {
        const int tok = tbase + j * 32 + r;
        const int pos = pos_of(tok);
        rope32_blk(acc[0][j], R32 + (size_t)pos * 16, h);
#pragma unroll
        for (int hd = 0; hd < 4; ++hd) store_rows(qkv + Q_KC, 384, hd * 96 + 64, acc[0][j], tok, h);
      }
    }
  } else if constexpr (MODE == M_GATE) {
    unsigned char* G8 = (unsigned char*)(ws + OFF_R2);
#pragma unroll
    for (int j = 0; j < NJ; ++j) {
      const int tok = tbase + j * 32 + r;
#pragma unroll
      for (int i = 0; i < 2; ++i)
#pragma unroll
        for (int vq = 0; vq < 4; ++vq) {
          unsigned pk = 0u;
#pragma unroll
          for (int e = 0; e < 4; ++e) {
            const float o = __builtin_amdgcn_rcpf(1.f + __builtin_amdgcn_exp2f(-1.4426950408889634f * acc[i][j][4 * vq + e]));
            pk |= (unsigned)(o * 255.f + 0.5f) << (8 * e);
          }
          *(unsigned*)(G8 + (size_t)tok * GP + fbase + i * 32 + 8 * vq + 4 * h) = pk;
        }
    }
  } else if constexpr (MODE == M_CUQ) {
    if (fbase >= 384) return;
#pragma unroll
    for (int j = 0; j < NJ; ++j) {
      const int tok = tbase + j * 32 + r;
      const int pos = pos_of(tok);
      float ss = 0.f;
#pragma unroll
      for (int b = 0; b < 12; ++b) ss += SS[(size_t)tok * 20 + b];
      const float rs = rsqrtf(ss * (1.f / 384.f) + EPS);
#pragma unroll
      for (int i = 0; i < 2; ++i) {
        const int blk = (fbase >> 5) + i;
#pragma unroll
        for (int v = 0; v < 16; ++v) acc[i][j][v] *= rs;
        if (blk % 3 == 2) rope32_blk(acc[i][j], R32 + (size_t)pos * 16, h);
        store_rows(qkv + Q_QC, 384, blk * 32, acc[i][j], tok, h);
      }
    }
  } else if constexpr (MODE == M_CUKV) {
#pragma unroll
    for (int j = 0; j < NJ; ++j) {
      const int tok = tbase + j * 32 + r;
      float ss = 0.f;
#pragma unroll
      for (int b = 0; b < 8; ++b) ss += SS[(size_t)tok * 20 + 12 + b];
      const float rs = rsqrtf(ss * (1.f / 256.f) + EPS);
#pragma unroll
      for (int i = 0; i < 2; ++i) {
        const int blk = (fbase >> 5) + i;
        const int hd = blk >> 2, q = blk & 3;
#pragma unroll
        for (int v = 0; v < 16; ++v) acc[i][j][v] *= rs;
        if (q < 2) store_rows(qkv + Q_KC, 384, hd * 96 + q * 32, acc[i][j], tok, h);
        else store_T(qkv + Q_VTC, hd * 64 + (q - 2) * 32, acc[i][j], tok, h);
      }
    }
  } else if constexpr (MODE == M_MERGE) {
#pragma unroll
    for (int j = 0; j < NJ; ++j) {
      const int tok = tbase + j * 32 + r;
      store_rows(qkv + Q_MERGED, KP1, fbase, acc[0][j], tok, h);
      store_rows(qkv + Q_MERGED, KP1, fbase + 32, acc[1][j], tok, h);
    }
  }
}

typedef __attribute__((address_space(3))) unsigned lds_u32_t;
typedef __attribute__((address_space(1))) const unsigned glb_u32_t;
template <int MODE, int NJ>
DI void gemm_tile(const u16* __restrict__ Wt, int ldw, const u16* __restrict__ X, int ldx, int K, int f0, int t0, char* smem,
                  const Params& P, int layer) {
  constexpr int XROWS = NJ * 64;
  constexpr int WSTG = 256 * 64, XSTG = XROWS * 64;
  u16* sW = (u16*)smem;
  u16* sX = sW + 2 * WSTG;
  const int tid = opaque_tid(), lane = tid & 63, wave = tid >> 6, r = lane & 31, h = lane >> 5;
  const int wf = wave & 3, wt = wave >> 2;
  f32x16 acc[2][NJ];
  f32x16 tot[2][MODE == M_MERGE ? NJ : 1];
#pragma unroll
  for (int i = 0; i < 2; ++i)
#pragma unroll
    for (int j = 0; j < NJ; ++j)
#pragma unroll
      for (int v = 0; v < 16; ++v) acc[i][j][v] = 0.f;
  if constexpr (MODE == M_MERGE) {
#pragma unroll
    for (int i = 0; i < 2; ++i)
#pragma unroll
      for (int j = 0; j < NJ; ++j)
#pragma unroll
        for (int v = 0; v < 16; ++v) tot[i][j][v] = 0.f;
  }
  const int nk = K >> 6;
  const int srow = tid >> 3;
  const int schunk = (tid & 7) ^ ((tid >> 4) & 7);
  const u16* wp = Wt + (size_t)(f0 + srow) * ldw + schunk * 8;
  const u16* xp = X + (size_t)(t0 + srow) * ldx + schunk * 8;
  const int fbase = f0 + wf * 64, tbase = t0 + wt * (NJ * 32);

  auto issue = [&](int kt, int buf) {
#pragma unroll
    for (int i = 0; i < 4; ++i)
      __builtin_amdgcn_global_load_lds((glb_u32_t*)(wp + (size_t)(i * 64) * ldw + kt * 64),
                                       (lds_u32_t*)(sW + buf * WSTG + i * 4096 + tid * 8), 16, 0, 0);
#pragma unroll
    for (int i = 0; i < NJ; ++i)
      __builtin_amdgcn_global_load_lds((glb_u32_t*)(xp + (size_t)(i * 64) * ldx + kt * 64),
                                       (lds_u32_t*)(sX + buf * XSTG + i * 4096 + tid * 8), 16, 0, 0);
  };
  const int swz = (r >> 1) & 7;
  auto compute = [&](int buf, int kt) {
    const u16* aW = sW + buf * WSTG + (wf * 64 + r) * 64;
    const u16* aX = sX + buf * XSTG + (wt * (NJ * 32) + r) * 64;
#pragma unroll
    for (int ks = 0; ks < 4; ++ks) {
      const int co = ((2 * ks + h) ^ swz) * 8;
      bf16x8 wfrag[2], xfrag[NJ];
#pragma unroll
      for (int i = 0; i < 2; ++i) wfrag[i] = *(const bf16x8*)(aW + i * 32 * 64 + co);
#pragma unroll
      for (int j = 0; j < NJ; ++j) xfrag[j] = *(const bf16x8*)(aX + j * 32 * 64 + co);
#pragma unroll
      for (int i = 0; i < 2; ++i)
#pragma unroll
        for (int j = 0; j < NJ; ++j) acc[i][j] = MFMA32(wfrag[i], xfrag[j], acc[i][j]);
    }
    if constexpr (MODE == M_MERGE) {
      if ((kt & 3) == 3) {
        const int br = kt >> 2;
        const unsigned char* G8 = (const unsigned char*)(P.ws + OFF_R2);
#pragma unroll
        for (int j = 0; j < NJ; ++j) {
          const int tok = tbase + j * 32 + r;
#pragma unroll
          for (int i = 0; i < 2; ++i)
#pragma unroll
            for (int vq = 0; vq < 4; ++vq) {
              const unsigned gp = *(const unsigned*)(G8 + (size_t)tok * GP + br * 1024 + fbase + i * 32 + 8 * vq + 4 * h);
              tot[i][j][4 * vq + 0] += (float)(gp & 0xffu) * (1.f / 255.f) * acc[i][j][4 * vq + 0];
              tot[i][j][4 * vq + 1] += (float)((gp >> 8) & 0xffu) * (1.f / 255.f) * acc[i][j][4 * vq + 1];
              tot[i][j][4 * vq + 2] += (float)((gp >> 16) & 0xffu) * (1.f / 255.f) * acc[i][j][4 * vq + 2];
              tot[i][j][4 * vq + 3] += (float)(gp >> 24) * (1.f / 255.f) * acc[i][j][4 * vq + 3];
              acc[i][j][4 * vq + 0] = 0.f; acc[i][j][4 * vq + 1] = 0.f;
              acc[i][j][4 * vq + 2] = 0.f; acc[i][j][4 * vq + 3] = 0.f;
            }
        }
      }
    }
  };

  issue(0, 0);
  asm volatile("s_waitcnt vmcnt(0)" ::: "memory");
  __syncthreads();
  for (int kt = 0; kt < nk; ++kt) {
    const int buf = kt & 1;
    if (kt + 1 < nk) issue(kt + 1, buf ^ 1);
    compute(buf, kt);
    asm volatile("s_waitcnt vmcnt(0) lgkmcnt(0)" ::: "memory");
    __syncthreads();
  }
  if constexpr (MODE == M_MERGE) gemm_epilogue<MODE, NJ>(tot, fbase, tbase, r, h, P, layer);
  else gemm_epilogue<MODE, NJ>(acc, fbase, tbase, r, h, P, layer);
}

template <int MODE, int NJ>
DI void gemm_phase(const u16* Wt, int ldw, const u16* X, int ldx, int K, int nF, char* smem, const Params& P, int layer) {
  constexpr int TT = NJ * 64;
  const int nT = T / TT;
  const int ntiles = nF * nT;
  for (int idx = blockIdx.x; idx < ntiles; idx += gridDim.x) {
    const int tt_lo = idx & 15;
    const int rest = idx >> 4;
    const int ft = rest % nF;
    const int tt = (rest / nF) * 16 + tt_lo;
    gemm_tile<MODE, NJ>(Wt, ldw, X, ldx, K, ft * 256, tt * TT, smem, P, layer);
  }
}

template <int DQK, int NCOMP, bool BAND, int EPI>
DI void attn_item(const u16* __restrict__ Q, int ldq, const u16* __restrict__ Kp, int ldk, const u16* __restrict__ Vt,
                  int qtok0, int kbeg, int kend, float sc_l2, float sink_l2, float lam, float onorm,
                  const float* __restrict__ subg, u16* __restrict__ O, float* __restrict__ DS, char* smem) {
  constexpr int DC = DQK / NCOMP;
  constexpr int KS = DC / 16;
  constexpr int KEYS = (NCOMP == 1) ? 128 : 64;
  constexpr int KSTR = DQK + 8, VSTR = KEYS + 8;
  constexpr int KCH = DQK / 8, VCH = KEYS / 8;
  constexpr int NKC = KEYS * KCH / NTHR, NVC = 64 * VCH / NTHR;
  constexpr int KSLOT = KEYS * KSTR, VSLOT = 64 * VSTR;
  u16* sK = (u16*)smem;
  u16* sV = sK + 3 * KSLOT;
  const int tid = opaque_tid(), lane = tid & 63, wave = tid >> 6, r = lane & 31, h = lane >> 5;
  const int qtok = qtok0 + wave * 32 + r;

  bf16x8 qf[NCOMP][KS];
#pragma unroll
  for (int c = 0; c < NCOMP; ++c)
#pragma unroll
    for (int ks = 0; ks < KS; ++ks) qf[c][ks] = *(const bf16x8*)(Q + (size_t)qtok * ldq + c * DC + ks * 16 + 8 * h);

  f32x16 Oa[NCOMP][2];
  float m[NCOMP], l[NCOMP];
#pragma unroll
  for (int c = 0; c < NCOMP; ++c) {
#pragma unroll
    for (int d = 0; d < 2; ++d)
#pragma unroll
      for (int v = 0; v < 16; ++v) Oa[c][d][v] = 0.f;
    m[c] = BAND ? sink_l2 : -1e30f;
    l[c] = (BAND && h == 0) ? 1.f : 0.f;
  }

  const u16* kg[NKC]; int kso[NKC];
#pragma unroll
  for (int i = 0; i < NKC; ++i) {
    const int c = tid + i * NTHR;
    const int row = c / KCH, cc = c % KCH;
    kg[i] = Kp + (size_t)(kbeg + row) * ldk + cc * 8;
    kso[i] = row * KSTR + cc * 8;
  }
  const u16* vg[NVC]; int vso[NVC];
#pragma unroll
  for (int i = 0; i < NVC; ++i) {
    const int c = tid + i * NTHR;
    const int row = c / VCH, cc = c % VCH;
    vg[i] = Vt + (size_t)(kbeg >> 7) * 8192 + row * 128 + cc * 8;
    vso[i] = row * VSTR + cc * 8;
  }
  u32x4 kreg[NKC], vreg[NVC];
  auto loadK = [&](int t) {
#pragma unroll
    for (int i = 0; i < NKC; ++i) kreg[i] = gld16(kg[i] + (size_t)t * KEYS * ldk);
  };
  auto loadV = [&](int t) {
#pragma unroll
    for (int i = 0; i < NVC; ++i) vreg[i] = gld16(vg[i] + (size_t)t * 8192);
  };
  auto waitK = [&]() {
    if constexpr (NKC == 1) wait_vm0(kreg[0]);
    else if constexpr (NKC == 2) wait_vm0(kreg[0], kreg[1]);
    else wait_vm0(kreg[0], kreg[1], kreg[2]);
  };
  auto waitV = [&]() {
    if constexpr (NVC == 1) wait_vm0(vreg[0]);
    else wait_vm0(vreg[0], vreg[1]);
  };
  auto storeK = [&](int slot) {
#pragma unroll
    for (int i = 0; i < NKC; ++i) *(u32x4*)(sK + slot * KSLOT + kso[i]) = kreg[i];
  };
  auto storeV = [&](int slot) {
#pragma unroll
    for (int i = 0; i < NVC; ++i) *(u32x4*)(sV + slot * VSLOT + vso[i]) = vreg[i];
  };

  f32x16 S0[2], S1[2];
  bf16x8 pfA[2][2], pfB[2][2];
  float alpha_pend = 1.f;
  bool need_pend = false;

  auto att_S = [&](auto uu_t, f32x16 (&S)[2], int slot) {
    constexpr int UU = decltype(uu_t)::value;
    constexpr int C = (NCOMP == 2) ? UU : 0;
    const u16* base = sK + slot * KSLOT + ((NCOMP == 1 ? UU * 64 : 0) + r) * KSTR + (NCOMP == 2 ? UU * DC : 0) + 8 * h;
#pragma unroll
    for (int kb = 0; kb < 2; ++kb) {
#pragma unroll
      for (int v = 0; v < 16; ++v) S[kb][v] = 0.f;
#pragma unroll
      for (int ks = 0; ks < KS; ++ks) {
        bf16x8 kf = *(const bf16x8*)(base + kb * 32 * KSTR + ks * 16);
        S[kb] = MFMA32(kf, qf[C][ks], S[kb]);
      }
    }
  };
  auto att_PV = [&](auto uu_t, const bf16x8 (&pf)[2][2], int slot) {
    constexpr int UU = decltype(uu_t)::value;
    constexpr int C = (NCOMP == 2) ? UU : 0;
    const u16* base = sV + slot * VSLOT + r * VSTR + (NCOMP == 1 ? UU * 64 : 0) + 8 * h;
#pragma unroll
    for (int d = 0; d < 2; ++d)
#pragma unroll
      for (int kb = 0; kb < 2; ++kb)
#pragma unroll
        for (int s = 0; s < 2; ++s) {
          bf16x8 vf = *(const bf16x8*)(base + d * 32 * VSTR + kb * 32 + 16 * s);
          Oa[C][d] = MFMA32(vf, pf[kb][s], Oa[C][d]);
        }
  };
  auto att_rescale = [&](auto uu_t) {
    constexpr int UU = decltype(uu_t)::value;
    constexpr int C = (NCOMP == 2) ? UU : 0;
    if (need_pend) {
#pragma unroll
      for (int d = 0; d < 2; ++d)
#pragma unroll
        for (int v = 0; v < 16; ++v) Oa[C][d][v] *= alpha_pend;
    }
  };
  auto att_softmax = [&](auto uu_t, f32x16 (&S)[2], bf16x8 (&pf)[2][2], int kpos0) {
    constexpr int UU = decltype(uu_t)::value;
    constexpr int C = (NCOMP == 2) ? UU : 0;
    if constexpr (BAND) {
#pragma unroll
      for (int kb = 0; kb < 2; ++kb)
#pragma unroll
        for (int v = 0; v < 16; ++v) {
          const int d = kpos0 + kb * 32 + crow(v, h) - qtok;
          if (d > 128 || d < -128) S[kb][v] = -1e30f;
        }
    }
    float mx = S[0][0];
#pragma unroll
    for (int kb = 0; kb < 2; ++kb)
#pragma unroll
      for (int v = 0; v < 16; ++v) mx = fmaxf(mx, S[kb][v]);
    mx = fmaxf(mx, __shfl_xor(mx, 32));
    const float mold = m[C];
    const float mnew = fmaxf(mold, mx * sc_l2);
    need_pend = __builtin_amdgcn_ballot_w64(mnew > mold) != 0;
    alpha_pend = __builtin_amdgcn_exp2f(mold - mnew);
    m[C] = mnew;
    float rsum = 0.f;
#pragma unroll
    for (int kb = 0; kb < 2; ++kb)
#pragma unroll
      for (int v = 0; v < 16; ++v) {
        float p = __builtin_amdgcn_exp2f(__builtin_fmaf(S[kb][v], sc_l2, -mnew));
        S[kb][v] = p;
        rsum += p;
      }
    l[C] = l[C] * alpha_pend + rsum;
#pragma unroll
    for (int kb = 0; kb < 2; ++kb)
#pragma unroll
      for (int s = 0; s < 2; ++s) {
        u32x4 pk;
        pk.x = pk2(S[kb][8 * s + 0], S[kb][8 * s + 1]);
        pk.y = pk2(S[kb][8 * s + 2], S[kb][8 * s + 3]);
        pk.z = pk2(S[kb][8 * s + 4], S[kb][8 * s + 5]);
        pk.w = pk2(S[kb][8 * s + 6], S[kb][8 * s + 7]);
        pf[kb][s] = __builtin_bit_cast(bf16x8, pk);
      }
  };
  using U0 = std::integral_constant<int, 0>;
  using U1 = std::integral_constant<int, 1>;

  const int ntl = (kend - kbeg) / KEYS;
  auto step = [&](auto first_t, auto lk_t, auto lv_t, int t, int sa, int sb, int sc) {
    constexpr bool FIRST = decltype(first_t)::value, LK = decltype(lk_t)::value, LV = decltype(lv_t)::value;
    if constexpr (LK) loadK(t + 2);
    if constexpr (LV) loadV(t + 1);
    if constexpr (!FIRST) att_rescale(U1{});
    att_S(U1{}, S1, sa);
    if constexpr (!FIRST) att_PV(U1{}, pfB, sc);
    att_softmax(U0{}, S0, pfA, kbeg + t * KEYS);
    att_rescale(U0{});
    if constexpr (LV) att_S(U0{}, S0, sb);
    att_PV(U0{}, pfA, sa);
    att_softmax(U1{}, S1, pfB, kbeg + t * KEYS + 64);
    if constexpr (LK) { waitK(); storeK(sc); }
    if constexpr (LV) { waitV(); storeV(sb); }
    __syncthreads();
  };
  using TT = std::true_type;
  using FF = std::false_type;

  loadK(0); loadV(0);
  waitK(); waitV();
  storeK(0); storeV(0);
  loadK(1);
  waitK();
  storeK(1);
  __syncthreads();
  att_S(U0{}, S0, 0);
  int sa = 0, sb = 1, sc = 2;
  step(TT{}, TT{}, TT{}, 0, sa, sb, sc);
  { int tmp = sa; sa = sb; sb = sc; sc = tmp; }
  for (int t = 1; t < ntl - 2; ++t) {
    step(FF{}, TT{}, TT{}, t, sa, sb, sc);
    int tmp = sa; sa = sb; sb = sc; sc = tmp;
  }
  step(FF{}, FF{}, TT{}, ntl - 2, sa, sb, sc);
  { int tmp = sa; sa = sb; sb = sc; sc = tmp; }
  step(FF{}, FF{}, FF{}, ntl - 1, sa, sb, sc);
  att_rescale(U1{});
  att_PV(U1{}, pfB, sa);

  float inv[NCOMP];
#pragma unroll
  for (int c = 0; c < NCOMP; ++c) {
    float lt = l[c] + __shfl_xor(l[c], 32);
    inv[c] = 1.f / lt;
  }
  if constexpr (EPI == 1) {
#pragma unroll
    for (int d = 0; d < 2; ++d)
#pragma unroll
      for (int vq = 0; vq < 4; ++vq) {
        float4 o = {Oa[0][d][4 * vq] * inv[0], Oa[0][d][4 * vq + 1] * inv[0], Oa[0][d][4 * vq + 2] * inv[0], Oa[0][d][4 * vq + 3] * inv[0]};
        *(float4*)(DS + (size_t)qtok * 256 + d * 32 + 8 * vq + 4 * h) = o;
      }
  } else {
    if constexpr (EPI == 2) {
      float ss = 0.f;
#pragma unroll
      for (int d = 0; d < 2; ++d)
#pragma unroll
        for (int vq = 0; vq < 4; ++vq) {
          const float4 o1 = *(const float4*)(DS + (size_t)qtok * 256 + d * 32 + 8 * vq + 4 * h);
          const float a0 = o1.x - lam * Oa[0][d][4 * vq] * inv[0];
          const float a1 = o1.y - lam * Oa[0][d][4 * vq + 1] * inv[0];
          const float a2 = o1.z - lam * Oa[0][d][4 * vq + 2] * inv[0];
          const float a3 = o1.w - lam * Oa[0][d][4 * vq + 3] * inv[0];
          Oa[0][d][4 * vq] = a0; Oa[0][d][4 * vq + 1] = a1; Oa[0][d][4 * vq + 2] = a2; Oa[0][d][4 * vq + 3] = a3;
          ss += a0 * a0 + a1 * a1 + a2 * a2 + a3 * a3;
        }
      ss += __shfl_xor(ss, 32);
      const float rs = rsqrtf(ss * (1.f / 64.f) + EPS) * onorm;
#pragma unroll
      for (int d = 0; d < 2; ++d)
#pragma unroll
        for (int v = 0; v < 16; ++v) Oa[0][d][v] *= rs * subg[d * 32 + crow(v, h)];
    } else {
#pragma unroll
      for (int d = 0; d < 2; ++d)
#pragma unroll
        for (int v = 0; v < 16; ++v) Oa[0][d][v] *= inv[0];
    }
    store_rows(O, KP1, 0, Oa[0][0], qtok, h);
    store_rows(O, KP1, 32, Oa[0][1], qtok, h);
  }
  __syncthreads();
}

DI void attn_phase(const Params& P, int layer, char* smem) {
  char* ws = P.ws;
  u16* qkv = (u16*)(ws + OFF_QKV);
  u16* BR = (u16*)(ws + OFF_XN);
  const float L2E = 1.4426950408889634f;
  const float lambda_init = 0.8f - 0.6f * __expf(-0.3f * (float)layer);
  float lam;
  {
    const float* dl = P.d_lambda + layer * 128;
    float s1 = 0.f, s2 = 0.f;
    for (int i = 0; i < 32; ++i) { s1 += dl[i] * dl[32 + i]; s2 += dl[64 + i] * dl[96 + i]; }
    lam = __expf(s1) - __expf(s2) + lambda_init;
  }
  for (int it = blockIdx.x; it < 2048; it += gridDim.x) {
    const int cls = it >> 8;
    if (cls < 6) {
      const int idx = it & 255;
      const int head = (idx & 7) >> 1;
      const int qb = ((idx >> 3) << 1) + (idx & 1);
      int qtok0, kbeg, kend;
      if (cls < 3) { qtok0 = qb * 256; kbeg = 0; kend = SEQ0; }
      else { const int s = qb >> 3; kbeg = SEQ0 + s * DSEQ; kend = kbeg + DSEQ; qtok0 = kbeg + (qb & 7) * 256; }
      const int typ = cls % 3;
      if (typ == 0) {
        float* DS = (float*)(ws + OFF_DS) + head * 64;
        attn_item<32, 1, false, 1>(qkv + Q_QD + head * 64, 256, qkv + Q_KD + head * 64, 256,
                                   qkv + Q_VTD + (size_t)head * 64 * T, qtok0, kbeg, kend,
                                   0.17677669529663687f * L2E, 0.f, lam, 1.f - lambda_init,
                                   P.d_subln + layer * 64, BR + 768 + head * 64, DS, smem);
        attn_item<32, 1, false, 2>(qkv + Q_QD + head * 64 + 32, 256, qkv + Q_KD + head * 64 + 32, 256,
                                   qkv + Q_VTD + (size_t)head * 64 * T, qtok0, kbeg, kend,
                                   0.17677669529663687f * L2E, 0.f, lam, 1.f - lambda_init,
                                   P.d_subln + layer * 64, BR + 768 + head * 64, DS, smem);
      } else if (typ == 1) {
        attn_item<96, 1, false, 0>(qkv + Q_QC + head * 96, 384, qkv + Q_KC + head * 96, 384,
                                       qkv + Q_VTC + (size_t)head * 64 * T, qtok0, kbeg, kend,
                                       0.10206207261596577f * L2E, 0.f, 0.f, 1.f, nullptr, BR + 512 + head * 64, nullptr, smem);
      } else {
        attn_item<64, 1, false, 0>(qkv + Q_QA + head * 64, 256, qkv + Q_KA + (head >> 1) * 64, 128,
                                       qkv + Q_VTA + (size_t)(head >> 1) * 64 * T, qtok0, kbeg, kend,
                                       0.125f * L2E, 0.f, 0.f, 1.f, nullptr, BR + head * 64, nullptr, smem);
      }
    } else {
      const int idx = it - 1536;
      const int head = (idx & 7) >> 1;
      const int qbg = ((idx >> 3) << 1) + (idx & 1);
      const int qtok0 = qbg * 256;
      int sb, se;
      if (qtok0 < SEQ0) { sb = 0; se = SEQ0; }
      else { sb = SEQ0 + ((qtok0 - SEQ0) / DSEQ) * DSEQ; se = sb + DSEQ; }
      const int kbeg = max(sb, qtok0 - 128), kend = min(se, qtok0 + 256 + 128);
      const float sink = P.b_sink[layer * 4 + head];
      attn_item<64, 1, true, 0>(qkv + Q_QB + head * 64, 256, qkv + Q_KB + (head >> 1) * 64, 128,
                                    qkv + Q_VTB + (size_t)(head >> 1) * 64 * T, qtok0, kbeg, kend,
                                    0.125f * L2E, sink * L2E, 0.f, 1.f, nullptr, BR + 256 + head * 64, nullptr, smem);
    }
  }
}

DI void ew_phase(const Params& P, const u16* __restrict__ Y, float coef, const float* __restrict__ gpost,
                 const float* __restrict__ gnext, bool from_inputs) {
  const int tid = opaque_tid();
  const int lane = tid & 63, wave = tid >> 6;
  u16* XN = (u16*)(P.ws + OFF_XN);
  u16* XB = (u16*)(P.ws + OFF_XB);
  for (int tok = blockIdx.x * 8 + wave; tok < T; tok += gridDim.x * 8) {
    float4 x[4];
    if (from_inputs) {
      const float* xs = tok < SEQ0 ? P.x_prompt + (size_t)tok * DM : P.x_sample + (size_t)(tok - SEQ0) * DM;
#pragma unroll
      for (int i = 0; i < 4; ++i) x[i] = *(const float4*)(xs + (i * 64 + lane) * 4);
    } else {
#pragma unroll
      for (int i = 0; i < 4; ++i) {
        const uint2 xb = *(const uint2*)(XB + (size_t)tok * DM + (i * 64 + lane) * 4);
        x[i] = make_float4(bf2f(xb.x & 0xffffu), bf2f(xb.x >> 16), bf2f(xb.y & 0xffffu), bf2f(xb.y >> 16));
      }
    }
    if (Y) {
      float4 y[4];
      float ss = 0.f;
#pragma unroll
      for (int i = 0; i < 4; ++i) {
        const uint2 yb = *(const uint2*)(Y + (size_t)tok * KP1 + (i * 64 + lane) * 4);
        y[i] = make_float4(bf2f(yb.x & 0xffffu), bf2f(yb.x >> 16), bf2f(yb.y & 0xffffu), bf2f(yb.y >> 16));
        ss += y[i].x * y[i].x + y[i].y * y[i].y + y[i].z * y[i].z + y[i].w * y[i].w;
      }
      ss = wave_sum(ss);
      const float rs = rsqrtf(ss * (1.f / 1024.f) + EPS) * coef;
#pragma unroll
      for (int i = 0; i < 4; ++i) {
        float4 g = *(const float4*)(gpost + (i * 64 + lane) * 4);
        x[i].x += y[i].x * rs * g.x; x[i].y += y[i].y * rs * g.y;
        x[i].z += y[i].z * rs * g.z; x[i].w += y[i].w * rs * g.w;
      }
    }
    if (!gnext) {
#pragma unroll
      for (int i = 0; i < 4; ++i) *(float4*)(P.out + (size_t)tok * DM + (i * 64 + lane) * 4) = x[i];
    } else {
#pragma unroll
      for (int i = 0; i < 4; ++i) {
        uint2 pk;
        pk.x = pk2(x[i].x, x[i].y);
        pk.y = pk2(x[i].z, x[i].w);
        *(uint2*)(XB + (size_t)tok * DM + (i * 64 + lane) * 4) = pk;
      }
    }
    if (gnext) {
      float ss = 0.f;
#pragma unroll
      for (int i = 0; i < 4; ++i) ss += x[i].x * x[i].x + x[i].y * x[i].y + x[i].z * x[i].z + x[i].w * x[i].w;
      ss = wave_sum(ss);
      const float rs = rsqrtf(ss * (1.f / 1024.f) + EPS);
#pragma unroll
      for (int i = 0; i < 4; ++i) {
        float4 g = *(const float4*)(gnext + (i * 64 + lane) * 4);
        uint2 pk;
        pk.x = pk2(x[i].x * rs * g.x, x[i].y * rs * g.y);
        pk.y = pk2(x[i].z * rs * g.z, x[i].w * rs * g.w);
        *(uint2*)(XN + (size_t)tok * KP1 + (i * 64 + lane) * 4) = pk;
      }
    }
  }
}

DI int colmap(int mode, int n, int nsrc) {
  if (mode == 1) { return ((n >> 5) & 1) * DFF + (n >> 6) * 32 + (n & 31); }
  if (mode == 2) {
    if (n < 1664) return n;
    if (n < 2432) return n + 32;
    if (n < 2464) return n - 2432 + 1664;
    if (n < 2560) return -1;
    return n - 96;
  }
  return n < nsrc ? n : -1;
}
DI void conv_job(u16* __restrict__ dst, int ldd, const float* __restrict__ src, int Nd, int K, int lds, int mode,
                 const float* __restrict__ kscale) {
  const int total = Nd * (K >> 3);
  const int gthreads = gridDim.x * NTHR;
  for (int idx = blockIdx.x * NTHR + opaque_tid(); idx < total; idx += gthreads) {
    const int n = idx % Nd, k8 = idx / Nd;
    const int col = colmap(mode, n, lds);
    float v[8];
#pragma unroll
    for (int j = 0; j < 8; ++j) {
      float x = 0.f;
      if (col >= 0) {
        x = src[(size_t)(k8 * 8 + j) * lds + col];
        if (kscale) x *= kscale[k8 * 8 + j];
      }
      v[j] = x;
    }
    uint4 pk = {pk2(v[0], v[1]), pk2(v[2], v[3]), pk2(v[4], v[5]), pk2(v[6], v[7])};
    *(uint4*)(dst + (size_t)n * ldd + k8 * 8) = pk;
  }
}
DI void convert_layer(const Params& P, int l) {
  u16* W = (u16*)(P.ws + OFF_W);
  for (int s = 0; s < 2; ++s) {
    conv_job(W + W_WI + (size_t)s * 5632 * KP1, KP1, P.ffn_wi + ((size_t)l * 2 + s) * 1024 * 5632, 5632, 1024, 5632, 1, nullptr);
    conv_job(W + W_WO + (size_t)s * 1024 * KP2, KP2, P.ffn_wo + ((size_t)l * 2 + s) * 2816 * 1024, 1024, 2816, 1024, 0, nullptr);
  }
  conv_job(W + W_WIN, KP1, P.w_in + (size_t)l * 1024 * NPROJ, 6656, 1024, NPROJ, 2, nullptr);
  conv_job(W + W_WUQ, 384, P.c_w_uq + (size_t)l * 384 * 384, 512, 384, 384, 0, P.c_q_norm + l * 384);
  conv_job(W + W_WUKV, 256, P.c_w_ukv + (size_t)l * 256 * 512, 512, 256, 512, 0, P.c_kv_norm + l * 256);
  conv_job(W + W_WB, KP1, P.w_branch + (size_t)l * 1024 * 1024, 1024, 1024, 1024, 0, nullptr);
  conv_job(W + W_WOUT, KP1, P.w_out + (size_t)l * 1024 * 1024, 1024, 1024, 1024, 0, nullptr);
}
DI void rope_tables(const Params& P) {
  float2* R64 = (float2*)(P.ws + OFF_R64);
  float2* R32 = (float2*)(P.ws + OFF_R32);
  const int gthreads = gridDim.x * NTHR;
  for (int idx = blockIdx.x * NTHR + opaque_tid(); idx < 16384 * 48; idx += gthreads) {
    int pos, f; double base; float2* dst;
    if (idx < 16384 * 32) { pos = idx >> 5; f = idx & 31; base = 0.7498942093324559; dst = R64 + idx; }
    else { const int i2 = idx - 16384 * 32; pos = i2 >> 4; f = i2 & 15; base = 0.5623413251903491; dst = R32 + i2; }
    double inv = 1.0;
    for (int k = 0; k < f; ++k) inv *= base;
    const float ang = (float)pos * (float)inv;
    double tr = (double)ang * 0.15915494309189535;
    tr -= rint(tr);
    const float tf = (float)tr;
    *dst = make_float2(__builtin_amdgcn_cosf(tf), __builtin_amdgcn_sinf(tf));
  }
}

DI void fast_grid_barrier(unsigned* bar, unsigned nblk) {
  asm volatile("s_waitcnt vmcnt(0) lgkmcnt(0)" ::: "memory");
  __syncthreads();
  if (threadIdx.x == 0) {
    __builtin_amdgcn_fence(__ATOMIC_RELEASE, "agent");
    asm volatile("s_waitcnt vmcnt(0) lgkmcnt(0)" ::: "memory");
    const unsigned gen = __hip_atomic_load(&bar[64], __ATOMIC_RELAXED, __HIP_MEMORY_SCOPE_AGENT);
    const unsigned old = __hip_atomic_fetch_add(&bar[0], 1u, __ATOMIC_RELAXED, __HIP_MEMORY_SCOPE_AGENT);
    if (old == nblk - 1u) {
      __hip_atomic_store(&bar[0], 0u, __ATOMIC_RELAXED, __HIP_MEMORY_SCOPE_AGENT);
      __hip_atomic_fetch_add(&bar[64], 1u, __ATOMIC_RELEASE, __HIP_MEMORY_SCOPE_AGENT);
    } else {
      while (__hip_atomic_load(&bar[64], __ATOMIC_RELAXED, __HIP_MEMORY_SCOPE_AGENT) == gen) __builtin_amdgcn_s_sleep(1);
    }
    __builtin_amdgcn_fence(__ATOMIC_ACQUIRE, "agent");
    asm volatile("s_waitcnt vmcnt(0) lgkmcnt(0)" ::: "memory");
  }
  __syncthreads();
}

__global__ void __launch_bounds__(NTHR) __attribute__((amdgpu_waves_per_eu(2, 2))) mega(Params P) {
  extern __shared__ __attribute__((aligned(16))) char smem[];
  cg::grid_group grid = cg::this_grid();
  int phase = 0;
#define ACTIVE() (phase >= P.phase_lo && phase < P.phase_hi)
#define SEAM() do { ++phase; if (P.coop) { if (phase == 1) grid.sync(); else fast_grid_barrier((unsigned*)(P.ws + OFF_BAR), gridDim.x); } } while (0)
  u16* W = (u16*)(P.ws + OFF_W);
  u16* XN = (u16*)(P.ws + OFF_XN);
  u16* R2 = (u16*)(P.ws + OFF_R2);
  u16* qkv = (u16*)(P.ws + OFF_QKV);
  const u16* Y = qkv + Q_Y;

  if (ACTIVE()) {
    rope_tables(P);
    convert_layer(P, 0);
    ew_phase(P, nullptr, 0.f, nullptr, P.norm_g, true);
  }
  SEAM();
  for (int l = 0; l < 4; ++l) {
    const float* g = P.norm_g + (size_t)l * 6 * DM;
    if (ACTIVE()) gemm_phase<M_FFNUP, 4>(W + W_WI, KP1, XN, KP1, DM, 22, smem, P, l);
    SEAM();
    if (ACTIVE()) gemm_phase<M_Y, 4>(W + W_WO, KP2, R2, KP2, DFF, 4, smem, P, l);
    SEAM();
    if (ACTIVE()) ew_phase(P, Y, 0.5f, g + DM, g + 2 * DM, false);
    SEAM();
    if (ACTIVE()) {
      gemm_phase<M_PROJ, 4>(W + W_WIN, KP1, XN, KP1, DM, 10, smem, P, l);
      gemm_phase<M_GATE, 4>(W + W_WIN + 2560ull * KP1, KP1, XN, KP1, DM, 16, smem, P, l);
    }
    SEAM();
    if (ACTIVE()) {
      gemm_phase<M_CUQ, 4>(W + W_WUQ, 384, qkv + Q_CQ, 384, 384, 2, smem, P, l);
      gemm_phase<M_CUKV, 4>(W + W_WUKV, 256, qkv + Q_CKV, 256, 256, 2, smem, P, l);
    }
    SEAM();
    if (ACTIVE()) attn_phase(P, l, smem);
    SEAM();
    if (ACTIVE()) gemm_phase<M_MERGE, 2>(W + W_WB, KP1, XN, KP1, DM, 4, smem, P, l);
    SEAM();
    if (ACTIVE()) gemm_phase<M_Y, 4>(W + W_WOUT, KP1, qkv + Q_MERGED, KP1, DM, 4, smem, P, l);
    SEAM();
    if (ACTIVE()) ew_phase(P, Y, 1.0f, g + 3 * DM, g + 4 * DM, false);
    SEAM();
    if (ACTIVE()) gemm_phase<M_FFNUP, 4>(W + W_WI + 5632ull * KP1, KP1, XN, KP1, DM, 22, smem, P, l);
    SEAM();
    if (ACTIVE()) gemm_phase<M_Y, 4>(W + W_WO + 1024ull * KP2, KP2, R2, KP2, DFF, 4, smem, P, l);
    SEAM();
    if (ACTIVE()) {
      ew_phase(P, Y, 0.5f, g + 5 * DM, l < 3 ? g + 6 * DM : nullptr, false);
      if (l < 3) convert_layer(P, l + 1);
    }
    SEAM();
  }
}

constexpr int N_PHASES = 1 + 12 * 4;

extern "C" void kernel_launch(void* const* d_in, const int* in_sizes, int n_in, void* d_out, int out_size, void* d_ws,
                              size_t ws_size, hipStream_t stream) {
  static int grid_blocks = 0;
  if (!grid_blocks) {
    int dev = 0, cus = 0, per_cu = 0;
    hipGetDevice(&dev);
    hipDeviceGetAttribute(&cus, hipDeviceAttributeMultiprocessorCount, dev);
    hipFuncSetAttribute((const void*)mega, hipFuncAttributeMaxDynamicSharedMemorySize, SMEM_BYTES);
    hipOccupancyMaxActiveBlocksPerMultiprocessor(&per_cu, mega, NTHR, SMEM_BYTES);
    if (per_cu < 1) per_cu = 1;
    grid_blocks = cus * per_cu;
  }
  if (ws_size < WS_NEEDED) fprintf(stderr, "workspace too small: %zu < %zu\n", ws_size, (size_t)WS_NEEDED);
  Params P{};
  P.x_prompt = (const float*)d_in[0]; P.x_sample = (const float*)d_in[1]; P.norm_g = (const float*)d_in[2];
  P.w_in = (const float*)d_in[3]; P.a_qk_norm = (const float*)d_in[4]; P.b_sink = (const float*)d_in[5];
  P.c_q_norm = (const float*)d_in[6]; P.c_kv_norm = (const float*)d_in[7]; P.c_w_uq = (const float*)d_in[8];
  P.c_w_ukv = (const float*)d_in[9]; P.d_lambda = (const float*)d_in[10]; P.d_subln = (const float*)d_in[11];
  P.w_branch = (const float*)d_in[12]; P.w_out = (const float*)d_in[13]; P.ffn_wi = (const float*)d_in[14];
  P.ffn_wo = (const float*)d_in[15];
  P.out = (float*)d_out; P.ws = (char*)d_ws;
#if MULTI_LAUNCH
  for (int ph = 0; ph < N_PHASES; ++ph) {
    P.phase_lo = ph; P.phase_hi = ph + 1; P.coop = 0; P.pad0 = 0;
    hipLaunchKernelGGL(mega, dim3(grid_blocks), dim3(NTHR), SMEM_BYTES, stream, P);
  }
#else
  P.phase_lo = 0; P.phase_hi = 1 << 30; P.coop = 1; P.pad0 = 0;
  hipMemsetAsync((char*)d_ws + OFF_BAR, 0, 1024, stream);
  void* args[] = {&P};
  hipError_t e = hipLaunchCooperativeKernel((const void*)mega, dim3(grid_blocks), dim3(NTHR), args, SMEM_BYTES, stream);
  if (e != hipSuccess) fprintf(stderr, "cooperative launch failed: %s (grid %d)\n", hipGetErrorString(e), grid_blocks);
#endif
}
```

```cpp
#include <hip/hip_runtime.h>
#include <hip/hip_cooperative_groups.h>
#include <cstdio>
#include <cstdint>
#include <type_traits>
namespace cg = cooperative_groups;

#ifndef MULTI_LAUNCH
#define MULTI_LAUNCH 0
#endif

#define DI __device__ __forceinline__
typedef unsigned short u16;
typedef __attribute__((ext_vector_type(8))) short bf16x8;
typedef __attribute__((ext_vector_type(16))) float f32x16;
typedef __attribute__((ext_vector_type(2))) float f32x2_t;
typedef __attribute__((ext_vector_type(2))) __bf16 bf16x2_t;

constexpr int T = 32768;
constexpr int DM = 1024;
constexpr int DFF = 2816;
constexpr int KP1 = 1088;
constexpr int KP2 = 2880;
constexpr int GP = 4160;
constexpr int YP = 1040;
constexpr int NPROJ = 6560;
constexpr int SEQ0 = 16384;
constexpr int DSEQ = 2048;
constexpr float EPS = 1e-6f;
constexpr int NTHR = 512;
constexpr int LSTR = 72;
constexpr int SMEM_BYTES = 2 * 2 * 256 * LSTR * 2;

constexpr size_t W_WI = 0;
constexpr size_t W_WO = W_WI + 2ull * 5632 * KP1;
constexpr size_t W_WIN = W_WO + 2ull * 1024 * KP2;
constexpr size_t W_WUQ = W_WIN + 6656ull * KP1;
constexpr size_t W_WUKV = W_WUQ + 512ull * 384;
constexpr size_t W_WB = W_WUKV + 512ull * 256;
constexpr size_t W_WOUT = W_WB + 1024ull * KP1;
constexpr size_t W_TOTAL = W_WOUT + 1024ull * KP1;

constexpr size_t OFF_W = 0;
constexpr size_t OFF_XN = OFF_W + W_TOTAL * 2;
constexpr size_t OFF_R2 = OFF_XN + (size_t)T * KP1 * 2;
constexpr size_t OFF_QKV = OFF_R2 + (size_t)T * KP2 * 2;
constexpr size_t OFF_SS = OFF_QKV + (size_t)T * 3456 * 2;
constexpr size_t OFF_R64 = OFF_SS + (size_t)T * 20 * 4;
constexpr size_t OFF_R32 = OFF_R64 + 16384ull * 32 * 8;
constexpr size_t OFF_DS = OFF_R32 + 16384ull * 16 * 8;
constexpr size_t OFF_BAR = OFF_DS + (size_t)T * 256 * 4;
constexpr size_t OFF_XB = OFF_BAR + 1024;
constexpr size_t WS_NEEDED = OFF_XB + (size_t)T * 1024 * 2;

constexpr size_t Q_QA = 0;
constexpr size_t Q_KA = (size_t)T * 256;
constexpr size_t Q_VTA = (size_t)T * 384;
constexpr size_t Q_QB = (size_t)T * 512;
constexpr size_t Q_KB = (size_t)T * 768;
constexpr size_t Q_VTB = (size_t)T * 896;
constexpr size_t Q_CQ = (size_t)T * 1024;
constexpr size_t Q_CKV = (size_t)T * 1408;
constexpr size_t Q_QC = (size_t)T * 1664;
constexpr size_t Q_KC = (size_t)T * 2048;
constexpr size_t Q_VTC = (size_t)T * 2432;
constexpr size_t Q_QD = (size_t)T * 2688;
constexpr size_t Q_KD = (size_t)T * 2944;
constexpr size_t Q_VTD = (size_t)T * 3200;
constexpr size_t Q_MERGED = 0;
constexpr size_t Q_Y = (size_t)T * KP1;

struct Params {
  const float* x_prompt; const float* x_sample; const float* norm_g; const float* w_in;
  const float* a_qk_norm; const float* b_sink; const float* c_q_norm; const float* c_kv_norm;
  const float* c_w_uq; const float* c_w_ukv; const float* d_lambda; const float* d_subln;
  const float* w_branch; const float* w_out; const float* ffn_wi; const float* ffn_wo;
  float* out; char* ws;
  int phase_lo; int phase_hi; int coop; int pad0;
};

DI unsigned pk2(float a, float b) {
  f32x2_t v = {a, b};
  bf16x2_t r = __builtin_convertvector(v, bf16x2_t);
  return __builtin_bit_cast(unsigned, r);
}
DI u16 f2bf(float a) { return (u16)(pk2(a, 0.f) & 0xffffu); }
DI float bf2f(unsigned bits16) { return __uint_as_float(bits16 << 16); }
DI int crow(int v, int h) { return (v & 3) + 8 * (v >> 2) + 4 * h; }
DI int pos_of(int tok) { return tok < SEQ0 ? tok : ((tok - SEQ0) & (DSEQ - 1)); }
#define MFMA32(a, b, c) __builtin_amdgcn_mfma_f32_32x32x16_bf16((a), (b), (c), 0, 0, 0)

typedef __attribute__((ext_vector_type(4))) unsigned u32x4;
DI u32x4 gld16(const void* p) { u32x4 r; asm volatile("global_load_dwordx4 %0, %1, off" : "=v"(r) : "v"(p)); return r; }
DI void wait_vm0(u32x4& a) { asm volatile("s_waitcnt vmcnt(0)" : "+v"(a) :: "memory"); }
DI void wait_vm0(u32x4& a, u32x4& b) { asm volatile("s_waitcnt vmcnt(0)" : "+v"(a), "+v"(b) :: "memory"); }
DI void wait_vm0(u32x4& a, u32x4& b, u32x4& c) { asm volatile("s_waitcnt vmcnt(0)" : "+v"(a), "+v"(b), "+v"(c) :: "memory"); }
DI void wait_vm0(u32x4& a, u32x4& b, u32x4& c, u32x4& d) { asm volatile("s_waitcnt vmcnt(0)" : "+v"(a), "+v"(b), "+v"(c), "+v"(d) :: "memory"); }
DI u32x4 gld16s(unsigned voff, const void* sbase) { u32x4 r; asm volatile("global_load_dwordx4 %0, %1, %2" : "=v"(r) : "v"(voff), "s"(sbase)); return r; }
#define DEF_WAIT8(name, cnt) DI void name(u32x4& a, u32x4& b, u32x4& c, u32x4& d, u32x4& e, u32x4& f, u32x4& g, u32x4& h) { asm volatile("s_waitcnt vmcnt(" #cnt ")" : "+v"(a), "+v"(b), "+v"(c), "+v"(d), "+v"(e), "+v"(f), "+v"(g), "+v"(h) :: "memory"); }
#define DEF_WAIT6(name, cnt) DI void name(u32x4& a, u32x4& b, u32x4& c, u32x4& d, u32x4& e, u32x4& f) { asm volatile("s_waitcnt vmcnt(" #cnt ")" : "+v"(a), "+v"(b), "+v"(c), "+v"(d), "+v"(e), "+v"(f) :: "memory"); }
DEF_WAIT8(wait8_vm8, 8)
DEF_WAIT8(wait8_vm0, 0)
DEF_WAIT6(wait6_vm6, 6)
DEF_WAIT6(wait6_vm0, 0)
DI int opaque_tid() { int t = threadIdx.x; asm volatile("" : "+v"(t)); return t; }
DI float wave_sum(float v) {
#pragma unroll
  for (int m = 32; m >= 1; m >>= 1) v += __shfl_xor(v, m);
  return v;
}

DI void rope32_blk(f32x16& a, const float2* __restrict__ tab, int h) {
#pragma unroll
  for (int v = 0; v < 8; ++v) {
    float2 cs = tab[crow(v, h)];
    float x1 = a[v], x2 = a[v + 8];
    a[v] = x1 * cs.x - x2 * cs.y;
    a[v + 8] = x2 * cs.x + x1 * cs.y;
  }
}
DI void rope64_blk(f32x16& a0, f32x16& a1, const float2* __restrict__ tab, int h) {
#pragma unroll
  for (int v = 0; v < 16; ++v) {
    float2 cs = tab[crow(v, h)];
    float x1 = a0[v], x2 = a1[v];
    a0[v] = x1 * cs.x - x2 * cs.y;
    a1[v] = x2 * cs.x + x1 * cs.y;
  }
}
DI void store_rows(u16* __restrict__ base, int ld, int col0, const f32x16& a, int tok, int h) {
#pragma unroll
  for (int vq = 0; vq < 4; ++vq) {
    uint2 pk;
    pk.x = pk2(a[4 * vq], a[4 * vq + 1]);
    pk.y = pk2(a[4 * vq + 2], a[4 * vq + 3]);
    *(uint2*)(base + (size_t)tok * ld + col0 + 8 * vq + 4 * h) = pk;
  }
}
DI void store_T(u16* __restrict__ base, int row0, const f32x16& a, int tok, int h) {
  const int tp = (tok & ~12) | ((tok & 4) << 1) | ((tok & 8) >> 1);
#pragma unroll
  for (int v = 0; v < 16; ++v) base[(size_t)((row0 + crow(v, h)) >> 6) * 64 * T + (size_t)(tp >> 7) * 8192 + ((row0 + crow(v, h)) & 63) * 128 + (tp & 127)] = f2bf(a[v]);
}

enum { M_FFNUP = 0, M_Y = 1, M_PROJ = 2, M_CUQ = 3, M_CUKV = 4, M_MERGE = 5, M_GATE = 6 };

template <int MODE, int NJ>
DI void gemm_epilogue(f32x16 (&acc)[2][NJ], int fbase, int tbase, int r, int h, const Params& P, int layer) {
  char* ws = P.ws;
  u16* qkv = (u16*)(ws + OFF_QKV);
  const float2* R64 = (const float2*)(ws + OFF_R64);
  const float2* R32 = (const float2*)(ws + OFF_R32);
  float* SS = (float*)(ws + OFF_SS);
  if constexpr (MODE == M_FFNUP) {
    u16* H = (u16*)(ws + OFF_R2);
    const int hf0 = (fbase >> 6) * 32;
#pragma unroll
    for (int j = 0; j < NJ; ++j) {
      const int tok = tbase + j * 32 + r;
      f32x16 o;
#pragma unroll
      for (int v = 0; v < 16; ++v) {
        float g = acc[0][j][v], u = acc[1][j][v];
        o[v] = g * __builtin_amdgcn_rcpf(1.f + __builtin_amdgcn_exp2f(-1.4426950408889634f * g)) * u;
      }
      store_rows(H, KP2, hf0, o, tok, h);
    }
  } else if constexpr (MODE == M_Y) {
    u16* Yb = qkv + Q_Y;
#pragma unroll
    for (int j = 0; j < NJ; ++j) {
      const int tok = tbase + j * 32 + r;
      store_rows(Yb, KP1, fbase, acc[0][j], tok, h);
      store_rows(Yb, KP1, fbase + 32, acc[1][j], tok, h);
    }
  } else if constexpr (MODE == M_PROJ) {
    if (fbase < 384) {
      const bool isK = fbase >= 256;
      const float* g = P.a_qk_norm + layer * 128 + (isK ? 64 : 0);
      u16* dst = qkv + (isK ? Q_KA : Q_QA);
      const int ld = isK ? 128 : 256;
      const int c0 = isK ? fbase - 256 : fbase;
      float gv[2][16];
#pragma unroll
      for (int i = 0; i < 2; ++i)
#pragma unroll
        for (int v = 0; v < 16; ++v) gv[i][v] = g[i * 32 + crow(v, h)];
#pragma unroll
      for (int j = 0; j < NJ; ++j) {
        const int tok = tbase + j * 32 + r;
        const int pos = pos_of(tok);
        float ss = 0.f;
#pragma unroll
        for (int i = 0; i < 2; ++i)
#pragma unroll
          for (int v = 0; v < 16; ++v) ss += acc[i][j][v] * acc[i][j][v];
        ss += __shfl_xor(ss, 32);
        const float rs = rsqrtf(ss * (1.f / 64.f) + EPS);
#pragma unroll
        for (int i = 0; i < 2; ++i)
#pragma unroll
          for (int v = 0; v < 16; ++v) acc[i][j][v] *= rs * gv[i][v];
        rope32_blk(acc[0][j], R32 + (size_t)(pos >> 6) * 16, h);
        rope32_blk(acc[1][j], R32 + (size_t)(pos & 63) * 16, h);
        store_rows(dst, ld, c0, acc[0][j], tok, h);
        store_rows(dst, ld, c0 + 32, acc[1][j], tok, h);
      }
    } else if (fbase < 512) {
#pragma unroll
      for (int j = 0; j < NJ; ++j) {
        const int tok = tbase + j * 32 + r;
        store_T(qkv + Q_VTA, fbase - 384, acc[0][j], tok, h);
        store_T(qkv + Q_VTA, fbase - 384 + 32, acc[1][j], tok, h);
      }
    } else if (fbase < 896) {
      const bool isK = fbase >= 768;
      u16* dst = qkv + (isK ? Q_KB : Q_QB);
      const int ld = isK ? 128 : 256;
      const int c0 = isK ? fbase - 768 : fbase - 512;
#pragma unroll
      for (int j = 0; j < NJ; ++j) {
        const int tok = tbase + j * 32 + r;
        const int pos = pos_of(tok);
        rope64_blk(acc[0][j], acc[1][j], R64 + (size_t)pos * 32, h);
        store_rows(dst, ld, c0, acc[0][j], tok, h);
        store_rows(dst, ld, c0 + 32, acc[1][j], tok, h);
      }
    } else if (fbase < 1024) {
#pragma unroll
      for (int j = 0; j < NJ; ++j) {
        const int tok = tbase + j * 32 + r;
        store_T(qkv + Q_VTB, fbase - 896, acc[0][j], tok, h);
        store_T(qkv + Q_VTB, fbase - 896 + 32, acc[1][j], tok, h);
      }
    } else if (fbase < 1664) {
      const bool isKV = fbase >= 1408;
      u16* dst = qkv + (isKV ? Q_CKV : Q_CQ);
      const int ld = isKV ? 256 : 384;
      const int c0 = isKV ? fbase - 1408 : fbase - 1024;
      const int sb = (isKV ? 12 : 0) + (c0 >> 5);
#pragma unroll
      for (int j = 0; j < NJ; ++j) {
        const int tok = tbase + j * 32 + r;
#pragma unroll
        for (int i = 0; i < 2; ++i) {
          float ss = 0.f;
#pragma unroll
          for (int v = 0; v < 16; ++v) ss += acc[i][j][v] * acc[i][j][v];
          ss += __shfl_xor(ss, 32);
          if (h == 0) SS[(size_t)tok * 20 + sb + i] = ss;
          store_rows(dst, ld, c0 + i * 32, acc[i][j], tok, h);
        }
      }
    } else if (fbase < 2176) {
      const bool isK = fbase >= 1920;
      u16* dst = qkv + (isK ? Q_KD : Q_QD);
      const int c0 = isK ? fbase - 1920 : fbase - 1664;
#pragma unroll
      for (int j = 0; j < NJ; ++j) {
        const int tok = tbase + j * 32 + r;
        const int pos = pos_of(tok);
#pragma unroll
        for (int i = 0; i < 2; ++i) {
          rope32_blk(acc[i][j], R32 + (size_t)pos * 16, h);
          store_rows(dst, 256, c0 + i * 32, acc[i][j], tok, h);
        }
      }
    } else if (fbase < 2432) {
#pragma unroll
      for (int j = 0; j < NJ; ++j) {
        const int tok = tbase + j * 32 + r;
        store_T(qkv + Q_VTD, fbase - 2176, acc[0][j], tok, h);
        store_T(qkv + Q_VTD, fbase - 2176 + 32, acc[1][j], tok, h);
      }
    } else if (fbase == 2432) {
#pragma unroll
      for (int j = 0; j < NJ; ++j) {
        const int tok = tbase + j * 32 + r;
        const int pos = pos_of(tok);
        rope32_blk(acc[0][j], R32 + (size_t)pos * 16, h);
#pragma unroll
        for (int hd = 0; hd < 4; ++hd) store_rows(qkv + Q_KC, 384, hd * 96 + 64, acc[0][j], tok, h);
      }
    }
  } else if constexpr (MODE == M_GATE) {
    unsigned char* G8 = (unsigned char*)(ws + OFF_R2);
#pragma unroll
    for (int j = 0; j < NJ; ++j) {
      const int tok = tbase + j * 32 + r;
#pragma unroll
      for (int i = 0; i < 2; ++i)
#pragma unroll
        for (int vq = 0; vq < 4; ++vq) {
          unsigned pk = 0u;
#pragma unroll
          for (int e = 0; e < 4; ++e) {
            const float o = __builtin_amdgcn_rcpf(1.f + __builtin_amdgcn_exp2f(-1.4426950408889634f * acc[i][j][4 * vq + e]));
            pk |= (unsigned)(o * 255.f + 0.5f) << (8 * e);
          }
          *(unsigned*)(G8 + (size_t)tok * GP + fbase + i * 32 + 8 * vq + 4 * h) = pk;
        }
    }
  } else if constexpr (MODE == M_CUQ) {
    if (fbase >= 384) return;
#pragma unroll
    for (int j = 0; j < NJ; ++j) {
      const int tok = tbase + j * 32 + r;
      const int pos = pos_of(tok);
      float ss = 0.f;
#pragma unroll
      for (int b = 0; b < 12; ++b) ss += SS[(size_t)tok * 20 + b];
      const float rs = rsqrtf(ss * (1.f / 384.f) + EPS);
#pragma unroll
      for (int i = 0; i < 2; ++i) {
        const int blk = (fbase >> 5) + i;
#pragma unroll
        for (int v = 0; v < 16; ++v) acc[i][j][v] *= rs;
        if (blk % 3 == 2) rope32_blk(acc[i][j], R32 + (size_t)pos * 16, h);
        store_rows(qkv + Q_QC, 384, blk * 32, acc[i][j], tok, h);
      }
    }
  } else if constexpr (MODE == M_CUKV) {
#pragma unroll
    for (int j = 0; j < NJ; ++j) {
      const int tok = tbase + j * 32 + r;
      float ss = 0.f;
#pragma unroll
      for (int b = 0; b < 8; ++b) ss += SS[(size_t)tok * 20 + 12 + b];
      const float rs = rsqrtf(ss * (1.f / 256.f) + EPS);
#pragma unroll
      for (int i = 0; i < 2; ++i) {
        const int blk = (fbase >> 5) + i;
        const int hd = blk >> 2, q = blk & 3;
#pragma unroll
        for (int v = 0; v < 16; ++v) acc[i][j][v] *= rs;
        if (q < 2) store_rows(qkv + Q_KC, 384, hd * 96 + q * 32, acc[i][j], tok, h);
        else store_T(qkv + Q_VTC, hd * 64 + (q - 2) * 32, acc[i][j], tok, h);
      }
    }
  } else if constexpr (MODE == M_MERGE) {
#pragma unroll
    for (int j = 0; j < NJ; ++j) {
      const int tok = tbase + j * 32 + r;
      store_rows(qkv + Q_MERGED, KP1, fbase, acc[0][j], tok, h);
      store_rows(qkv + Q_MERGED, KP1, fbase + 32, acc[1][j], tok, h);
    }
  }
}

typedef __attribute__((address_space(3))) unsigned lds_u32_t;
typedef __attribute__((address_space(1))) const unsigned glb_u32_t;
template <int MODE, int NJ>
DI void gemm_tile(const u16* __restrict__ Wt, int ldw, const u16* __restrict__ X, int ldx, int K, int f0, int t0, char* smem,
                  const Params& P, int layer) {
  constexpr int XROWS = NJ * 64;
  constexpr int WSTG = 256 * 64, XSTG = XROWS * 64;
  u16* sW = (u16*)smem;
  u16* sX = sW + 2 * WSTG;
  const int tid = opaque_tid(), lane = tid & 63, wave = tid >> 6, r = lane & 31, h = lane >> 5;
  const int wf = wave & 3, wt = wave >> 2;
  f32x16 acc[2][NJ];
  f32x16 tot[2][MODE == M_MERGE ? NJ : 1];
#pragma unroll
  for (int i = 0; i < 2; ++i)
#pragma unroll
    for (int j = 0; j < NJ; ++j)
#pragma unroll
      for (int v = 0; v < 16; ++v) acc[i][j][v] = 0.f;
  if constexpr (MODE == M_MERGE) {
#pragma unroll
    for (int i = 0; i < 2; ++i)
#pragma unroll
      for (int j = 0; j < NJ; ++j)
#pragma unroll
        for (int v = 0; v < 16; ++v) tot[i][j][v] = 0.f;
  }
  const int nk = K >> 6;
  const int srow = tid >> 3;
  const int schunk = (tid & 7) ^ ((tid >> 4) & 7);
  const u16* wp = Wt + (size_t)(f0 + srow) * ldw + schunk * 8;
  const u16* xp = X + (size_t)(t0 + srow) * ldx + schunk * 8;
  const int fbase = f0 + wf * 64, tbase = t0 + wt * (NJ * 32);

  auto issue = [&](int kt, int buf) {
#pragma unroll
    for (int i = 0; i < 4; ++i)
      __builtin_amdgcn_global_load_lds((glb_u32_t*)(wp + (size_t)(i * 64) * ldw + kt * 64),
                                       (lds_u32_t*)(sW + buf * WSTG + i * 4096 + tid * 8), 16, 0, 0);
#pragma unroll
    for (int i = 0; i < NJ; ++i)
      __builtin_amdgcn_global_load_lds((glb_u32_t*)(xp + (size_t)(i * 64) * ldx + kt * 64),
                                       (lds_u32_t*)(sX + buf * XSTG + i * 4096 + tid * 8), 16, 0, 0);
  };
  const int swz = (r >> 1) & 7;
  auto compute = [&](int buf, int kt) {
    const u16* aW = sW + buf * WSTG + (wf * 64 + r) * 64;
    const u16* aX = sX + buf * XSTG + (wt * (NJ * 32) + r) * 64;
#pragma unroll
    for (int ks = 0; ks < 4; ++ks) {
      const int co = ((2 * ks + h) ^ swz) * 8;
      bf16x8 wfrag[2], xfrag[NJ];
#pragma unroll
      for (int i = 0; i < 2; ++i) wfrag[i] = *(const bf16x8*)(aW + i * 32 * 64 + co);
#pragma unroll
      for (int j = 0; j < NJ; ++j) xfrag[j] = *(const bf16x8*)(aX + j * 32 * 64 + co);
#pragma unroll
      for (int i = 0; i < 2; ++i)
#pragma unroll
        for (int j = 0; j < NJ; ++j) acc[i][j] = MFMA32(wfrag[i], xfrag[j], acc[i][j]);
    }
    if constexpr (MODE == M_MERGE) {
      if ((kt & 3) == 3) {
        const int br = kt >> 2;
        const unsigned char* G8 = (const unsigned char*)(P.ws + OFF_R2);
#pragma unroll
        for (int j = 0; j < NJ; ++j) {
          const int tok = tbase + j * 32 + r;
#pragma unroll
          for (int i = 0; i < 2; ++i)
#pragma unroll
            for (int vq = 0; vq < 4; ++vq) {
              const unsigned gp = *(const unsigned*)(G8 + (size_t)tok * GP + br * 1024 + fbase + i * 32 + 8 * vq + 4 * h);
              tot[i][j][4 * vq + 0] += (float)(gp & 0xffu) * (1.f / 255.f) * acc[i][j][4 * vq + 0];
              tot[i][j][4 * vq + 1] += (float)((gp >> 8) & 0xffu) * (1.f / 255.f) * acc[i][j][4 * vq + 1];
              tot[i][j][4 * vq + 2] += (float)((gp >> 16) & 0xffu) * (1.f / 255.f) * acc[i][j][4 * vq + 2];
              tot[i][j][4 * vq + 3] += (float)(gp >> 24) * (1.f / 255.f) * acc[i][j][4 * vq + 3];
              acc[i][j][4 * vq + 0] = 0.f; acc[i][j][4 * vq + 1] = 0.f;
              acc[i][j][4 * vq + 2] = 0.f; acc[i][j][4 * vq + 3] = 0.f;
            }
        }
      }
    }
  };

  issue(0, 0);
  asm volatile("s_waitcnt vmcnt(0)" ::: "memory");
  __syncthreads();
  for (int kt = 0; kt < nk; ++kt) {
    const int buf = kt & 1;
    if (kt + 1 < nk) issue(kt + 1, buf ^ 1);
    compute(buf, kt);
    asm volatile("s_waitcnt vmcnt(0) lgkmcnt(0)" ::: "memory");
    __syncthreads();
  }
  if constexpr (MODE == M_MERGE) gemm_epilogue<MODE, NJ>(tot, fbase, tbase, r, h, P, layer);
  else gemm_epilogue<MODE, NJ>(acc, fbase, tbase, r, h, P, layer);
}

template <int MODE, int NJ>
DI void gemm_phase(const u16* Wt, int ldw, const u16* X, int ldx, int K, int nF, char* smem, const Params& P, int layer) {
  constexpr int TT = NJ * 64;
  const int nT = T / TT;
  const int ntiles = nF * nT;
  for (int idx = blockIdx.x; idx < ntiles; idx += gridDim.x) {
    const int tt_lo = idx & 15;
    const int rest = idx >> 4;
    const int ft = rest % nF;
    const int tt = (rest / nF) * 16 + tt_lo;
    gemm_tile<MODE, NJ>(Wt, ldw, X, ldx, K, ft * 256, tt * TT, smem, P, layer);
  }
}

namespace pg8 {
#define PG8_LAS __attribute__((address_space(3)))
typedef unsigned short bf16_t;
typedef short bf16x8 __attribute__((ext_vector_type(8)));
typedef float f32x4 __attribute__((ext_vector_type(4)));
typedef unsigned u32x4 __attribute__((ext_vector_type(4)));
constexpr int BM = 256, BK = 64, HALF = 128, HTB = HALF * BK * 2  , STAGE_BYTES = 8 * HTB, NXCD = 8, WGM = 8;

__host__ __device__ __forceinline__ int lds_byte(int r, int c) { const int st = (r >> 4) * 2 + (c >> 5), rr = r & 15, cc = c & 31, ob = rr * 64 + cc * 2; return st * 1024 + (ob ^ (((ob >> 9) & 1) << 5)); }
__host__ __device__ __forceinline__ void stage_rc(int b, int& R, int& C) { const int st = b / 1024, sb = b % 1024, swz = sb ^ (((sb >> 9) & 1) << 5); R = (st >> 1) * 16 + swz / 64; C = (st & 1) * 32 + (swz % 64) / 2; }
__host__ __device__ __forceinline__ int perm32(int rho) { const int n = rho >> 4, i = rho & 15; return 8 * (i >> 2) + 4 * n + (i & 3); }

struct Unit { int pm, pn; };
struct Gemm { const bf16_t* A; const bf16_t* Bt; int M, N, K, ld; };

struct StaticOrder {
    int nM, nN, nwg, G, c;
    __host__ __device__ void init(int M, int N, int G_, int c_) { nM = M / BM; nN = N / BM; nwg = nM * nN; G = G_; c = c_; }
    __host__ __device__ bool next(int i, Unit& u) const {
        const long L = (long)i * G + c; if (L >= nwg) return false;
        int wgid = (int)L; { const int q = nwg / NXCD, r = nwg % NXCD, xcd = wgid % NXCD, off = wgid / NXCD; wgid = (xcd < r ? xcd * (q + 1) : r * (q + 1) + (xcd - r) * q) + off; }
        const int nig = WGM * nN, gid = wgid / nig, fm = gid * WGM, gsz = (nM - fm) < WGM ? (nM - fm) : WGM;
        u.pm = fm + ((wgid % nig) % gsz); u.pn = (wgid % nig) / gsz; return true;
    }
    __device__ __forceinline__ void a_ready(const Unit&) const {}
    __device__ __forceinline__ void done(const Unit&) const {}
};

template <class Epi, class Sched, bool STAMP, int KC, int LDC>
__device__ __forceinline__ void gemm_phase(PG8_LAS unsigned char* lds, const Gemm g, const Sched& S, const Epi& E, unsigned long long* stamps) {
    const int tid = opaque_tid(), wid = __builtin_amdgcn_readfirstlane(tid >> 6), lane = tid & 63, wr = wid >> 2, wc = wid & 3, fr = lane & 15, fq = lane >> 4;
    constexpr int K = KC, nt = K / BK;
    int ts_lo = 0, ts_hi = 0, nts = 0; const unsigned long long rt_entry = STAMP ? (unsigned long long)wall_clock64() : 0ull;
#define PG8_STAMP() do { if (STAMP && wid == 0 && nts < 64) { const unsigned long long _c = (unsigned long long)clock64(); \
        ts_lo = (lane == nts) ? (int)(unsigned)_c : ts_lo; ts_hi = (lane == nts) ? (int)(unsigned)(_c >> 32) : ts_hi; ++nts; } } while (0)
    PG8_STAMP();
    unsigned voffA[2], voffB[2];
#pragma unroll
    for (int i = 0; i < 2; ++i) { int R, C; stage_rc(tid * 16 + i * 8192, R, C); const int Rb = Epi::PERM ? ((R & ~31) + perm32(R & 31)) : R;
        voffA[i] = (unsigned)(R * LDC + C) * 2u; voffB[i] = (unsigned)(Rb * LDC + C) * 2u; }
    const size_t kstep = (size_t)(BK * 2);
    constexpr size_t hstep = (size_t)HALF * LDC * 2;
    const size_t tstep = 2 * hstep;
    const unsigned ldsw = (unsigned)wid * 1024u;
    const int aoff = lds_byte(wr * 64 + fr, fq * 8), boff = lds_byte(wc * 32 + fr, fq * 8);
#define PG8_SA(b, h) (((b) * 2 + (h)) * HTB)
#define PG8_SB(b, h) ((4 + (b) * 2 + (h)) * HTB)
#define PG8_STAGE(bufoff, gbase, voff) do { _Pragma("unroll") for (int _i = 0; _i < 2; ++_i) \
        __builtin_amdgcn_global_load_lds((const unsigned*)((const char*)(gbase) + (voff)[_i]), (PG8_LAS unsigned*)(lds + (bufoff) + ldsw + _i * 8192), 16, 0, 0); } while (0)
#define PG8_LDA(dst, b, h) do { _Pragma("unroll") for (int m = 0; m < 4; ++m) _Pragma("unroll") for (int k = 0; k < 2; ++k) dst[m][k] = *(const PG8_LAS bf16x8*)(lds + PG8_SA(b, h) + aoff + m * 2048 + k * 1024); } while (0)
#define PG8_LDB(dst, b, h) do { _Pragma("unroll") for (int n = 0; n < 2; ++n) _Pragma("unroll") for (int k = 0; k < 2; ++k) dst[n][k] = *(const PG8_LAS bf16x8*)(lds + PG8_SB(b, h) + boff + n * 2048 + k * 1024); } while (0)
#define PG8_MMA(ai, bj, At, Bt) do { __builtin_amdgcn_s_setprio(1); _Pragma("unroll") for (int m = 0; m < 4; ++m) _Pragma("unroll") for (int n = 0; n < 2; ++n) _Pragma("unroll") for (int k = 0; k < 2; ++k) \
        acc[ai][bj][m][n] = __builtin_amdgcn_mfma_f32_16x16x32_bf16(Bt[n][k], At[m][k], acc[ai][bj][m][n], 0, 0, 0); __builtin_amdgcn_s_setprio(0); } while (0)
#define PG8_WAIT_V(n) asm volatile("s_waitcnt vmcnt(" #n ")" ::: "memory")
#define PG8_WAIT_L(n) asm volatile("s_waitcnt lgkmcnt(" #n ")" ::: "memory")
#define PG8_BAR __builtin_amdgcn_s_barrier()
#define PG8_SCHED __builtin_amdgcn_sched_barrier(0)
    Unit cur, nxt; int ui = 0;
    if (!S.next(0, cur)) return;
    f32x4 acc[2][2][4][2];
#pragma unroll
    for (int a = 0; a < 2; ++a)
#pragma unroll
        for (int b = 0; b < 2; ++b)
#pragma unroll
            for (int m = 0; m < 4; ++m)
#pragma unroll
                for (int n = 0; n < 2; ++n) acc[a][b][m][n] = (f32x4){0.f, 0.f, 0.f, 0.f};
    bf16x8 At[4][2], B0[2][2], B1[2][2];
    const char* cA = (const char*)g.A + (size_t)cur.pm * tstep; const char* cB = (const char*)g.Bt + (size_t)cur.pn * tstep;
    S.a_ready(cur);
    PG8_STAGE(PG8_SB(0, 0), cB, voffB); PG8_STAGE(PG8_SA(0, 0), cA, voffA); PG8_STAGE(PG8_SB(0, 1), cB + hstep, voffB); PG8_STAGE(PG8_SA(0, 1), cA + hstep, voffA);
    if (wr == 1) PG8_BAR;
    PG8_WAIT_V(4); PG8_BAR;
    PG8_STAGE(PG8_SB(1, 0), cB + kstep, voffB); PG8_STAGE(PG8_SA(1, 0), cA + kstep, voffA); PG8_STAGE(PG8_SB(1, 1), cB + hstep + kstep, voffB);
    PG8_WAIT_V(6); PG8_BAR;
    PG8_STAMP();
    for (;;) {
        const bool has_next = S.next(ui + 1, nxt);
        const char* nA = has_next ? (const char*)g.A + (size_t)nxt.pm * tstep : cA; const char* nB = has_next ? (const char*)g.Bt + (size_t)nxt.pn * tstep : cB;
        for (int t = 0; t < nt; t += 2) {
            const bool last = (t == nt - 2);
            const char* a1 = cA + (size_t)(t + 1) * kstep;
            const char* a2 = last ? nA : cA + (size_t)(t + 2) * kstep; const char* b2 = last ? nB : cB + (size_t)(t + 2) * kstep;
            const char* a3 = a2 + kstep; const char* b3 = b2 + kstep;
            if (last && has_next) S.a_ready(nxt);
            PG8_LDB(B0, 0, 0); PG8_SCHED; PG8_LDA(At, 0, 0); PG8_STAGE(PG8_SA(1, 1), a1 + hstep, voffA);
            PG8_WAIT_L(8); PG8_BAR; PG8_WAIT_L(0); PG8_MMA(0, 0, At, B0); PG8_BAR; PG8_SCHED;
            PG8_LDB(B1, 0, 1); PG8_STAGE(PG8_SB(0, 0), b2, voffB);
            PG8_BAR; PG8_WAIT_L(0); PG8_MMA(0, 1, At, B1); PG8_BAR;
            PG8_LDA(At, 0, 1); PG8_STAGE(PG8_SA(0, 0), a2, voffA);
            PG8_BAR; PG8_WAIT_L(0); PG8_MMA(1, 0, At, B0); PG8_BAR; PG8_SCHED;
            PG8_STAGE(PG8_SB(0, 1), b2 + hstep, voffB);
            PG8_WAIT_V(6); PG8_BAR; PG8_MMA(1, 1, At, B1); PG8_BAR;
            PG8_LDB(B0, 1, 0); PG8_SCHED; PG8_LDA(At, 1, 0); PG8_STAGE(PG8_SA(0, 1), a2 + hstep, voffA);
            PG8_WAIT_L(8); PG8_BAR; PG8_WAIT_L(0); PG8_MMA(0, 0, At, B0); PG8_BAR; PG8_SCHED;
            PG8_LDB(B1, 1, 1); PG8_STAGE(PG8_SB(1, 0), b3, voffB);
            PG8_BAR; PG8_WAIT_L(0); PG8_MMA(0, 1, At, B1); PG8_BAR;
            PG8_LDA(At, 1, 1); PG8_STAGE(PG8_SA(1, 0), a3, voffA);
            PG8_BAR; PG8_WAIT_L(0); PG8_MMA(1, 0, At, B0); PG8_BAR; PG8_SCHED;
            PG8_STAGE(PG8_SB(1, 1), b3 + hstep, voffB);
            PG8_WAIT_V(6); PG8_BAR; PG8_MMA(1, 1, At, B1); PG8_BAR;
        }
        PG8_STAMP();
        if constexpr (!Epi::AFTER_DRAIN) { E(acc, cur, wr, wc, fr, fq); S.done(cur); }
        PG8_STAMP();
        if (!has_next) break;
#pragma unroll
        for (int a = 0; a < 2; ++a)
#pragma unroll
            for (int b = 0; b < 2; ++b)
#pragma unroll
                for (int m = 0; m < 4; ++m)
#pragma unroll
                    for (int n = 0; n < 2; ++n) acc[a][b][m][n] = (f32x4){0.f, 0.f, 0.f, 0.f};
        cur = nxt; cA = nA; cB = nB; ++ui;
    }
    PG8_WAIT_V(0);
    if (wr == 0) PG8_BAR;
    PG8_BAR;
    if constexpr (Epi::AFTER_DRAIN) { E.fused(acc, cur, wr, wc, fr, fq, lds, wid, lane); S.done(cur); }
    PG8_STAMP();
    if (STAMP && wid == 0) { stamps[lane] = lane < nts ? (((unsigned long long)(unsigned)ts_hi << 32) | (unsigned)ts_lo) : 0ull;
        if (lane == 62) stamps[62] = rt_entry; if (lane == 63) stamps[63] = (unsigned long long)wall_clock64(); }
#undef PG8_STAMP
#undef PG8_SA
#undef PG8_SB
#undef PG8_STAGE
#undef PG8_LDA
#undef PG8_LDB
#undef PG8_MMA
#undef PG8_WAIT_V
#undef PG8_WAIT_L
#undef PG8_BAR
#undef PG8_SCHED
}
}

struct EpiY8 {
  static constexpr bool PERM = true, AFTER_DRAIN = false;
  u16* O;
  DI void operator()(const pg8::f32x4 (&acc)[2][2][4][2], const pg8::Unit& u, int wr, int wc, int fr, int fq) const {
    const int row0 = u.pm * 256 + wr * 64 + fr, col0 = u.pn * 256 + wc * 32 + 8 * fq;
#pragma unroll
    for (int ai = 0; ai < 2; ++ai)
#pragma unroll
      for (int m = 0; m < 4; ++m) {
        u16* rowp = O + (size_t)(row0 + ai * 128 + m * 16) * KP1 + col0;
#pragma unroll
        for (int bj = 0; bj < 2; ++bj) {
          const pg8::f32x4 v0 = acc[ai][bj][m][0], v1 = acc[ai][bj][m][1];
          u32x4 w; w.x = pk2(v0[0], v0[1]); w.y = pk2(v0[2], v0[3]); w.z = pk2(v1[0], v1[1]); w.w = pk2(v1[2], v1[3]);
          *(u32x4*)(rowp + bj * 128) = w;
        }
      }
  }
};
struct EpiFfnUp8 {
  static constexpr bool PERM = true, AFTER_DRAIN = false;
  u16* H;
  DI void operator()(const pg8::f32x4 (&acc)[2][2][4][2], const pg8::Unit& u, int wr, int wc, int fr, int fq) const {
    const int row0 = u.pm * 256 + wr * 64 + fr, col0 = u.pn * 128 + wc * 32 + 8 * fq;
#pragma unroll
    for (int ai = 0; ai < 2; ++ai)
#pragma unroll
      for (int m = 0; m < 4; ++m) {
        float o[8];
#pragma unroll
        for (int n = 0; n < 2; ++n)
#pragma unroll
          for (int j = 0; j < 4; ++j) {
            const float g = acc[ai][0][m][n][j], up = acc[ai][1][m][n][j];
            o[n * 4 + j] = g * __builtin_amdgcn_rcpf(1.f + __builtin_amdgcn_exp2f(-1.4426950408889634f * g)) * up;
          }
        u32x4 w; w.x = pk2(o[0], o[1]); w.y = pk2(o[2], o[3]); w.z = pk2(o[4], o[5]); w.w = pk2(o[6], o[7]);
        *(u32x4*)(H + (size_t)(row0 + ai * 128 + m * 16) * KP2 + col0) = w;
      }
  }
};
struct EpiGate8 {
  static constexpr bool PERM = true, AFTER_DRAIN = false;
  unsigned char* G8;
  DI void operator()(const pg8::f32x4 (&acc)[2][2][4][2], const pg8::Unit& u, int wr, int wc, int fr, int fq) const {
    const int row0 = u.pm * 256 + wr * 64 + fr, col0 = u.pn * 256 + wc * 32 + 8 * fq;
#pragma unroll
    for (int ai = 0; ai < 2; ++ai)
#pragma unroll
      for (int m = 0; m < 4; ++m)
#pragma unroll
        for (int bj = 0; bj < 2; ++bj) {
          uint2 pk = {0u, 0u};
#pragma unroll
          for (int j = 0; j < 4; ++j) {
            const float a = __builtin_amdgcn_rcpf(1.f + __builtin_amdgcn_exp2f(-1.4426950408889634f * acc[ai][bj][m][0][j]));
            const float b = __builtin_amdgcn_rcpf(1.f + __builtin_amdgcn_exp2f(-1.4426950408889634f * acc[ai][bj][m][1][j]));
            pk.x |= (unsigned)(a * 255.f + 0.5f) << (8 * j);
            pk.y |= (unsigned)(b * 255.f + 0.5f) << (8 * j);
          }
          *(uint2*)(G8 + (size_t)(row0 + ai * 128 + m * 16) * GP + col0 + bj * 128) = pk;
        }
  }
};
struct SimpleOrder {
  int nN, nwg, G, c;
  DI bool next(int i, pg8::Unit& u) const {
    const int L = i * G + c;
    if (L >= nwg) return false;
    const int rest = L >> 4;
    u.pn = rest % nN;
    u.pm = (rest / nN) * 16 + (L & 15);
    return true;
  }
  DI void a_ready(const pg8::Unit&) const {}
  DI void done(const pg8::Unit&) const {}
};
template <int N, int K, int LD, class Epi>
DI void gemm8_phase(const u16* X, const u16* Wt, const Epi& E, char* smem) {
  pg8::Gemm g; g.A = X; g.Bt = Wt; g.M = T; g.N = N; g.K = K; g.ld = LD;
  int bid_ = (int)blockIdx.x; asm volatile("" : "+s"(bid_));
  SimpleOrder S; S.nN = N / 256; S.nwg = (T / 256) * (N / 256); S.G = (int)gridDim.x; S.c = bid_;
  pg8::gemm_phase<Epi, SimpleOrder, false, K, LD>((PG8_LAS unsigned char*)smem, g, S, E, nullptr);
}

template <int DQK, int NCOMP, bool BAND, int EPI>
DI void attn_item(const u16* __restrict__ Q, int ldq, const u16* __restrict__ Kp, int ldk, const u16* __restrict__ Vt,
                  int qtok0, int kbeg, int kend, float sc_l2, float sink_l2, float lam, float onorm,
                  const float* __restrict__ subg, u16* __restrict__ O, float* __restrict__ DS, char* smem) {
  constexpr int DC = DQK / NCOMP;
  constexpr int KS = DC / 16;
  constexpr int KEYS = (NCOMP == 1) ? 128 : 64;
  constexpr int KSTR = DQK + 8, VSTR = KEYS + 8;
  constexpr int KCH = DQK / 8, VCH = KEYS / 8;
  constexpr int NKC = KEYS * KCH / NTHR, NVC = 64 * VCH / NTHR;
  constexpr int KSLOT = KEYS * KSTR, VSLOT = 64 * VSTR;
  u16* sK = (u16*)smem;
  u16* sV = sK + 3 * KSLOT;
  const int tid = opaque_tid(), lane = tid & 63, wave = tid >> 6, r = lane & 31, h = lane >> 5;
  const int qtok = qtok0 + wave * 32 + r;

  bf16x8 qf[NCOMP][KS];
#pragma unroll
  for (int c = 0; c < NCOMP; ++c)
#pragma unroll
    for (int ks = 0; ks < KS; ++ks) qf[c][ks] = *(const bf16x8*)(Q + (size_t)qtok * ldq + c * DC + ks * 16 + 8 * h);

  f32x16 Oa[NCOMP][2];
  float m[NCOMP], l[NCOMP];
#pragma unroll
  for (int c = 0; c < NCOMP; ++c) {
#pragma unroll
    for (int d = 0; d < 2; ++d)
#pragma unroll
      for (int v = 0; v < 16; ++v) Oa[c][d][v] = 0.f;
    m[c] = BAND ? sink_l2 : -1e30f;
    l[c] = (BAND && h == 0) ? 1.f : 0.f;
  }

  const u16* kg[NKC]; int kso[NKC];
#pragma unroll
  for (int i = 0; i < NKC; ++i) {
    const int c = tid + i * NTHR;
    const int row = c / KCH, cc = c % KCH;
    kg[i] = Kp + (size_t)(kbeg + row) * ldk + cc * 8;
    kso[i] = row * KSTR + cc * 8;
  }
  const u16* vg[NVC]; int vso[NVC];
#pragma unroll
  for (int i = 0; i < NVC; ++i) {
    const int c = tid + i * NTHR;
    const int row = c / VCH, cc = c % VCH;
    vg[i] = Vt + (size_t)(kbeg >> 7) * 8192 + row * 128 + cc * 8;
    vso[i] = row * VSTR + cc * 8;
  }
  u32x4 kreg[NKC], vreg[NVC];
  auto loadK = [&](int t) {
#pragma unroll
    for (int i = 0; i < NKC; ++i) kreg[i] = gld16(kg[i] + (size_t)t * KEYS * ldk);
  };
  auto loadV = [&](int t) {
#pragma unroll
    for (int i = 0; i < NVC; ++i) vreg[i] = gld16(vg[i] + (size_t)t * 8192);
  };
  auto waitK = [&]() {
    if constexpr (NKC == 1) wait_vm0(kreg[0]);
    else if constexpr (NKC == 2) wait_vm0(kreg[0], kreg[1]);
    else wait_vm0(kreg[0], kreg[1], kreg[2]);
  };
  auto waitV = [&]() {
    if constexpr (NVC == 1) wait_vm0(vreg[0]);
    else wait_vm0(vreg[0], vreg[1]);
  };
  auto storeK = [&](int slot) {
#pragma unroll
    for (int i = 0; i < NKC; ++i) *(u32x4*)(sK + slot * KSLOT + kso[i]) = kreg[i];
  };
  auto storeV = [&](int slot) {
#pragma unroll
    for (int i = 0; i < NVC; ++i) *(u32x4*)(sV + slot * VSLOT + vso[i]) = vreg[i];
  };

  f32x16 S0[2], S1[2];
  bf16x8 pfA[2][2], pfB[2][2];
  float alpha_pend = 1.f;
  bool need_pend = false;

  auto att_S = [&](auto uu_t, f32x16 (&S)[2], int slot) {
    constexpr int UU = decltype(uu_t)::value;
    constexpr int C = (NCOMP == 2) ? UU : 0;
    const u16* base = sK + slot * KSLOT + ((NCOMP == 1 ? UU * 64 : 0) + r) * KSTR + (NCOMP == 2 ? UU * DC : 0) + 8 * h;
#pragma unroll
    for (int kb = 0; kb < 2; ++kb) {
#pragma unroll
      for (int v = 0; v < 16; ++v) S[kb][v] = 0.f;
#pragma unroll
      for (int ks = 0; ks < KS; ++ks) {
        bf16x8 kf = *(const bf16x8*)(base + kb * 32 * KSTR + ks * 16);
        S[kb] = MFMA32(kf, qf[C][ks], S[kb]);
      }
    }
  };
  auto att_PV = [&](auto uu_t, const bf16x8 (&pf)[2][2], int slot) {
    constexpr int UU = decltype(uu_t)::value;
    constexpr int C = (NCOMP == 2) ? UU : 0;
    const u16* base = sV + slot * VSLOT + r * VSTR + (NCOMP == 1 ? UU * 64 : 0) + 8 * h;
#pragma unroll
    for (int d = 0; d < 2; ++d)
#pragma unroll
      for (int kb = 0; kb < 2; ++kb)
#pragma unroll
        for (int s = 0; s < 2; ++s) {
          bf16x8 vf = *(const bf16x8*)(base + d * 32 * VSTR + kb * 32 + 16 * s);
          Oa[C][d] = MFMA32(vf, pf[kb][s], Oa[C][d]);
        }
  };
  auto att_rescale = [&](auto uu_t) {
    constexpr int UU = decltype(uu_t)::value;
    constexpr int C = (NCOMP == 2) ? UU : 0;
    if (need_pend) {
#pragma unroll
      for (int d = 0; d < 2; ++d)
#pragma unroll
        for (int v = 0; v < 16; ++v) Oa[C][d][v] *= alpha_pend;
    }
  };
  auto att_softmax = [&](auto uu_t, f32x16 (&S)[2], bf16x8 (&pf)[2][2], int kpos0) {
    constexpr int UU = decltype(uu_t)::value;
    constexpr int C = (NCOMP == 2) ? UU : 0;
    if constexpr (BAND) {
#pragma unroll
      for (int kb = 0; kb < 2; ++kb)
#pragma unroll
        for (int v = 0; v < 16; ++v) {
          const int d = kpos0 + kb * 32 + crow(v, h) - qtok;
          if (d > 128 || d < -128) S[kb][v] = -1e30f;
        }
    }
    float mx = S[0][0];
#pragma unroll
    for (int kb = 0; kb < 2; ++kb)
#pragma unroll
      for (int v = 0; v < 16; ++v) mx = fmaxf(mx, S[kb][v]);
    mx = fmaxf(mx, __shfl_xor(mx, 32));
    const float mold = m[C];
    const float mnew = fmaxf(mold, mx * sc_l2);
    need_pend = __builtin_amdgcn_ballot_w64(mnew > mold) != 0;
    alpha_pend = __builtin_amdgcn_exp2f(mold - mnew);
    m[C] = mnew;
    float rsum = 0.f;
#pragma unroll
    for (int kb = 0; kb < 2; ++kb)
#pragma unroll
      for (int v = 0; v < 16; ++v) {
        float p = __builtin_amdgcn_exp2f(__builtin_fmaf(S[kb][v], sc_l2, -mnew));
        S[kb][v] = p;
        rsum += p;
      }
    l[C] = l[C] * alpha_pend + rsum;
#pragma unroll
    for (int kb = 0; kb < 2; ++kb)
#pragma unroll
      for (int s = 0; s < 2; ++s) {
        u32x4 pk;
        pk.x = pk2(S[kb][8 * s + 0], S[kb][8 * s + 1]);
        pk.y = pk2(S[kb][8 * s + 2], S[kb][8 * s + 3]);
        pk.z = pk2(S[kb][8 * s + 4], S[kb][8 * s + 5]);
        pk.w = pk2(S[kb][8 * s + 6], S[kb][8 * s + 7]);
        pf[kb][s] = __builtin_bit_cast(bf16x8, pk);
      }
  };
  using U0 = std::integral_constant<int, 0>;
  using U1 = std::integral_constant<int, 1>;

  const int ntl = (kend - kbeg) / KEYS;
  auto step = [&](auto first_t, auto lk_t, auto lv_t, int t, int sa, int sb, int sc) {
    constexpr bool FIRST = decltype(first_t)::value, LK = decltype(lk_t)::value, LV = decltype(lv_t)::value;
    if constexpr (LK) loadK(t + 2);
    if constexpr (LV) loadV(t + 1);
    if constexpr (!FIRST) att_rescale(U1{});
    att_S(U1{}, S1, sa);
    if constexpr (!FIRST) att_PV(U1{}, pfB, sc);
    att_softmax(U0{}, S0, pfA, kbeg + t * KEYS);
    att_rescale(U0{});
    if constexpr (LV) att_S(U0{}, S0, sb);
    att_PV(U0{}, pfA, sa);
    att_softmax(U1{}, S1, pfB, kbeg + t * KEYS + 64);
    if constexpr (LK) { waitK(); storeK(sc); }
    if constexpr (LV) { waitV(); storeV(sb); }
    __syncthreads();
  };
  using TT = std::true_type;
  using FF = std::false_type;

  loadK(0); loadV(0);
  waitK(); waitV();
  storeK(0); storeV(0);
  loadK(1);
  waitK();
  storeK(1);
  __syncthreads();
  att_S(U0{}, S0, 0);
  int sa = 0, sb = 1, sc = 2;
  step(TT{}, TT{}, TT{}, 0, sa, sb, sc);
  { int tmp = sa; sa = sb; sb = sc; sc = tmp; }
  for (int t = 1; t < ntl - 2; ++t) {
    step(FF{}, TT{}, TT{}, t, sa, sb, sc);
    int tmp = sa; sa = sb; sb = sc; sc = tmp;
  }
  step(FF{}, FF{}, TT{}, ntl - 2, sa, sb, sc);
  { int tmp = sa; sa = sb; sb = sc; sc = tmp; }
  step(FF{}, FF{}, FF{}, ntl - 1, sa, sb, sc);
  att_rescale(U1{});
  att_PV(U1{}, pfB, sa);

  float inv[NCOMP];
#pragma unroll
  for (int c = 0; c < NCOMP; ++c) {
    float lt = l[c] + __shfl_xor(l[c], 32);
    inv[c] = 1.f / lt;
  }
  if constexpr (EPI == 1) {
#pragma unroll
    for (int d = 0; d < 2; ++d)
#pragma unroll
      for (int vq = 0; vq < 4; ++vq) {
        float4 o = {Oa[0][d][4 * vq] * inv[0], Oa[0][d][4 * vq + 1] * inv[0], Oa[0][d][4 * vq + 2] * inv[0], Oa[0][d][4 * vq + 3] * inv[0]};
        *(float4*)(DS + (size_t)qtok * 256 + d * 32 + 8 * vq + 4 * h) = o;
      }
  } else {
    if constexpr (EPI == 2) {
      float ss = 0.f;
#pragma unroll
      for (int d = 0; d < 2; ++d)
#pragma unroll
        for (int vq = 0; vq < 4; ++vq) {
          const float4 o1 = *(const float4*)(DS + (size_t)qtok * 256 + d * 32 + 8 * vq + 4 * h);
          const float a0 = o1.x - lam * Oa[0][d][4 * vq] * inv[0];
          const float a1 = o1.y - lam * Oa[0][d][4 * vq + 1] * inv[0];
          const float a2 = o1.z - lam * Oa[0][d][4 * vq + 2] * inv[0];
          const float a3 = o1.w - lam * Oa[0][d][4 * vq + 3] * inv[0];
          Oa[0][d][4 * vq] = a0; Oa[0][d][4 * vq + 1] = a1; Oa[0][d][4 * vq + 2] = a2; Oa[0][d][4 * vq + 3] = a3;
          ss += a0 * a0 + a1 * a1 + a2 * a2 + a3 * a3;
        }
      ss += __shfl_xor(ss, 32);
      const float rs = rsqrtf(ss * (1.f / 64.f) + EPS) * onorm;
#pragma unroll
      for (int d = 0; d < 2; ++d)
#pragma unroll
        for (int v = 0; v < 16; ++v) Oa[0][d][v] *= rs * subg[d * 32 + crow(v, h)];
    } else {
#pragma unroll
      for (int d = 0; d < 2; ++d)
#pragma unroll
        for (int v = 0; v < 16; ++v) Oa[0][d][v] *= inv[0];
    }
    store_rows(O, KP1, 0, Oa[0][0], qtok, h);
    store_rows(O, KP1, 32, Oa[0][1], qtok, h);
  }
  __syncthreads();
}

DI void attn_phase(const Params& P, int layer, char* smem) {
  char* ws = P.ws;
  u16* qkv = (u16*)(ws + OFF_QKV);
  u16* BR = (u16*)(ws + OFF_XN);
  const float L2E = 1.4426950408889634f;
  const float lambda_init = 0.8f - 0.6f * __expf(-0.3f * (float)layer);
  float lam;
  {
    const float* dl = P.d_lambda + layer * 128;
    float s1 = 0.f, s2 = 0.f;
    for (int i = 0; i < 32; ++i) { s1 += dl[i] * dl[32 + i]; s2 += dl[64 + i] * dl[96 + i]; }
    lam = __expf(s1) - __expf(s2) + lambda_init;
    lam = __int_as_float(__builtin_amdgcn_readfirstlane(__float_as_int(lam)));
  }
  const float onorm_u = __int_as_float(__builtin_amdgcn_readfirstlane(__float_as_int(1.f - lambda_init)));
  for (int it = blockIdx.x; it < 2048; it += gridDim.x) {
    const int cls = it >> 8;
    if (cls < 6) {
      const int idx = it & 255;
      const int head = (idx & 7) >> 1;
      const int qb = ((idx >> 3) << 1) + (idx & 1);
      int qtok0, kbeg, kend;
      if (cls < 3) { qtok0 = qb * 256; kbeg = 0; kend = SEQ0; }
      else { const int s = qb >> 3; kbeg = SEQ0 + s * DSEQ; kend = kbeg + DSEQ; qtok0 = kbeg + (qb & 7) * 256; }
      const int typ = cls % 3;
      if (typ == 0) {
        float* DS = (float*)(ws + OFF_DS) + head * 64;
        attn_item<32, 1, false, 1>(qkv + Q_QD + head * 64, 256, qkv + Q_KD + head * 64, 256,
                                   qkv + Q_VTD + (size_t)head * 64 * T, qtok0, kbeg, kend,
                                   0.17677669529663687f * L2E, 0.f, lam, onorm_u,
                                   P.d_subln + layer * 64, BR + 768 + head * 64, DS, smem);
        attn_item<32, 1, false, 2>(qkv + Q_QD + head * 64 + 32, 256, qkv + Q_KD + head * 64 + 32, 256,
                                   qkv + Q_VTD + (size_t)head * 64 * T, qtok0, kbeg, kend,
                                   0.17677669529663687f * L2E, 0.f, lam, onorm_u,
                                   P.d_subln + layer * 64, BR + 768 + head * 64, DS, smem);
      } else if (typ == 1) {
        attn_item<96, 1, false, 0>(qkv + Q_QC + head * 96, 384, qkv + Q_KC + head * 96, 384,
                                       qkv + Q_VTC + (size_t)head * 64 * T, qtok0, kbeg, kend,
                                       0.10206207261596577f * L2E, 0.f, 0.f, 1.f, nullptr, BR + 512 + head * 64, nullptr, smem);
      } else {
        attn_item<64, 1, false, 0>(qkv + Q_QA + head * 64, 256, qkv + Q_KA + (head >> 1) * 64, 128,
                                       qkv + Q_VTA + (size_t)(head >> 1) * 64 * T, qtok0, kbeg, kend,
                                       0.125f * L2E, 0.f, 0.f, 1.f, nullptr, BR + head * 64, nullptr, smem);
      }
    } else {
      const int idx = it - 1536;
      const int head = (idx & 7) >> 1;
      const int qbg = ((idx >> 3) << 1) + (idx & 1);
      const int qtok0 = qbg * 256;
      int sb, se;
      if (qtok0 < SEQ0) { sb = 0; se = SEQ0; }
      else { sb = SEQ0 + ((qtok0 - SEQ0) / DSEQ) * DSEQ; se = sb + DSEQ; }
      const int kbeg = max(sb, qtok0 - 128), kend = min(se, qtok0 + 256 + 128);
      const float sink = P.b_sink[layer * 4 + head];
      attn_item<64, 1, true, 0>(qkv + Q_QB + head * 64, 256, qkv + Q_KB + (head >> 1) * 64, 128,
                                    qkv + Q_VTB + (size_t)(head >> 1) * 64 * T, qtok0, kbeg, kend,
                                    0.125f * L2E, sink * L2E, 0.f, 1.f, nullptr, BR + 256 + head * 64, nullptr, smem);
    }
  }
}

DI void ew_phase(const Params& P, const u16* __restrict__ Y, float coef, const float* __restrict__ gpost,
                 const float* __restrict__ gnext, bool from_inputs) {
  const int tid = opaque_tid();
  const int lane = tid & 63, wave = tid >> 6;
  u16* XN = (u16*)(P.ws + OFF_XN);
  u16* XB = (u16*)(P.ws + OFF_XB);
  for (int tok = blockIdx.x * 8 + wave; tok < T; tok += gridDim.x * 8) {
    float4 x[4];
    if (from_inputs) {
      const float* xs = tok < SEQ0 ? P.x_prompt + (size_t)tok * DM : P.x_sample + (size_t)(tok - SEQ0) * DM;
#pragma unroll
      for (int i = 0; i < 4; ++i) x[i] = *(const float4*)(xs + (i * 64 + lane) * 4);
    } else {
#pragma unroll
      for (int i = 0; i < 4; ++i) {
        const uint2 xb = *(const uint2*)(XB + (size_t)tok * DM + (i * 64 + lane) * 4);
        x[i] = make_float4(bf2f(xb.x & 0xffffu), bf2f(xb.x >> 16), bf2f(xb.y & 0xffffu), bf2f(xb.y >> 16));
      }
    }
    if (Y) {
      float4 y[4];
      float ss = 0.f;
#pragma unroll
      for (int i = 0; i < 4; ++i) {
        const uint2 yb = *(const uint2*)(Y + (size_t)tok * KP1 + (i * 64 + lane) * 4);
        y[i] = make_float4(bf2f(yb.x & 0xffffu), bf2f(yb.x >> 16), bf2f(yb.y & 0xffffu), bf2f(yb.y >> 16));
        ss += y[i].x * y[i].x + y[i].y * y[i].y + y[i].z * y[i].z + y[i].w * y[i].w;
      }
      ss = wave_sum(ss);
      const float rs = rsqrtf(ss * (1.f / 1024.f) + EPS) * coef;
#pragma unroll
      for (int i = 0; i < 4; ++i) {
        float4 g = *(const float4*)(gpost + (i * 64 + lane) * 4);
        x[i].x += y[i].x * rs * g.x; x[i].y += y[i].y * rs * g.y;
        x[i].z += y[i].z * rs * g.z; x[i].w += y[i].w * rs * g.w;
      }
    }
    if (!gnext) {
#pragma unroll
      for (int i = 0; i < 4; ++i) *(float4*)(P.out + (size_t)tok * DM + (i * 64 + lane) * 4) = x[i];
    } else {
#pragma unroll
      for (int i = 0; i < 4; ++i) {
        uint2 pk;
        pk.x = pk2(x[i].x, x[i].y);
        pk.y = pk2(x[i].z, x[i].w);
        *(uint2*)(XB + (size_t)tok * DM + (i * 64 + lane) * 4) = pk;
      }
    }
    if (gnext) {
      float ss = 0.f;
#pragma unroll
      for (int i = 0; i < 4; ++i) ss += x[i].x * x[i].x + x[i].y * x[i].y + x[i].z * x[i].z + x[i].w * x[i].w;
      ss = wave_sum(ss);
      const float rs = rsqrtf(ss * (1.f / 1024.f) + EPS);
#pragma unroll
      for (int i = 0; i < 4; ++i) {
        float4 g = *(const float4*)(gnext + (i * 64 + lane) * 4);
        uint2 pk;
        pk.x = pk2(x[i].x * rs * g.x, x[i].y * rs * g.y);
        pk.y = pk2(x[i].z * rs * g.z, x[i].w * rs * g.w);
        *(uint2*)(XN + (size_t)tok * KP1 + (i * 64 + lane) * 4) = pk;
      }
    }
  }
}

DI int colmap(int mode, int n, int nsrc) {
  if (mode == 1) { return ((n >> 7) & 1) * DFF + (n >> 8) * 128 + (n & 127); }
  if (mode == 2) {
    if (n < 1664) return n;
    if (n < 2432) return n + 32;
    if (n < 2464) return n - 2432 + 1664;
    if (n < 2560) return -1;
    return n - 96;
  }
  return n < nsrc ? n : -1;
}
DI void conv_job(u16* __restrict__ dst, int ldd, const float* __restrict__ src, int Nd, int K, int lds, int mode,
                 const float* __restrict__ kscale) {
  const int total = Nd * (K >> 3);
  const int gthreads = gridDim.x * NTHR;
  for (int idx = blockIdx.x * NTHR + opaque_tid(); idx < total; idx += gthreads) {
    const int n = idx % Nd, k8 = idx / Nd;
    const int col = colmap(mode, n, lds);
    float v[8];
#pragma unroll
    for (int j = 0; j < 8; ++j) {
      float x = 0.f;
      if (col >= 0) {
        x = src[(size_t)(k8 * 8 + j) * lds + col];
        if (kscale) x *= kscale[k8 * 8 + j];
      }
      v[j] = x;
    }
    uint4 pk = {pk2(v[0], v[1]), pk2(v[2], v[3]), pk2(v[4], v[5]), pk2(v[6], v[7])};
    *(uint4*)(dst + (size_t)n * ldd + k8 * 8) = pk;
  }
}
DI void convert_layer(const Params& P, int l) {
  u16* W = (u16*)(P.ws + OFF_W);
  for (int s = 0; s < 2; ++s) {
    conv_job(W + W_WI + (size_t)s * 5632 * KP1, KP1, P.ffn_wi + ((size_t)l * 2 + s) * 1024 * 5632, 5632, 1024, 5632, 1, nullptr);
    conv_job(W + W_WO + (size_t)s * 1024 * KP2, KP2, P.ffn_wo + ((size_t)l * 2 + s) * 2816 * 1024, 1024, 2816, 1024, 0, nullptr);
  }
  conv_job(W + W_WIN, KP1, P.w_in + (size_t)l * 1024 * NPROJ, 6656, 1024, NPROJ, 2, nullptr);
  conv_job(W + W_WUQ, 384, P.c_w_uq + (size_t)l * 384 * 384, 512, 384, 384, 0, P.c_q_norm + l * 384);
  conv_job(W + W_WUKV, 256, P.c_w_ukv + (size_t)l * 256 * 512, 512, 256, 512, 0, P.c_kv_norm + l * 256);
  conv_job(W + W_WB, KP1, P.w_branch + (size_t)l * 1024 * 1024, 1024, 1024, 1024, 0, nullptr);
  conv_job(W + W_WOUT, KP1, P.w_out + (size_t)l * 1024 * 1024, 1024, 1024, 1024, 0, nullptr);
}
DI void rope_tables(const Params& P) {
  float2* R64 = (float2*)(P.ws + OFF_R64);
  float2* R32 = (float2*)(P.ws + OFF_R32);
  const int gthreads = gridDim.x * NTHR;
  for (int idx = blockIdx.x * NTHR + opaque_tid(); idx < 16384 * 48; idx += gthreads) {
    int pos, f; double base; float2* dst;
    if (idx < 16384 * 32) { pos = idx >> 5; f = idx & 31; base = 0.7498942093324559; dst = R64 + idx; }
    else { const int i2 = idx - 16384 * 32; pos = i2 >> 4; f = i2 & 15; base = 0.5623413251903491; dst = R32 + i2; }
    double inv = 1.0;
    for (int k = 0; k < f; ++k) inv *= base;
    const float ang = (float)pos * (float)inv;
    double tr = (double)ang * 0.15915494309189535;
    tr -= rint(tr);
    const float tf = (float)tr;
    *dst = make_float2(__builtin_amdgcn_cosf(tf), __builtin_amdgcn_sinf(tf));
  }
}

DI void fast_grid_barrier(unsigned* bar, unsigned nblk) {
  asm volatile("s_waitcnt vmcnt(0) lgkmcnt(0)" ::: "memory");
  __syncthreads();
  if (threadIdx.x == 0) {
    __builtin_amdgcn_fence(__ATOMIC_RELEASE, "agent");
    asm volatile("s_waitcnt vmcnt(0) lgkmcnt(0)" ::: "memory");
    const unsigned gen = __hip_atomic_load(&bar[64], __ATOMIC_RELAXED, __HIP_MEMORY_SCOPE_AGENT);
    const unsigned old = __hip_atomic_fetch_add(&bar[0], 1u, __ATOMIC_RELAXED, __HIP_MEMORY_SCOPE_AGENT);
    if (old == nblk - 1u) {
      __hip_atomic_store(&bar[0], 0u, __ATOMIC_RELAXED, __HIP_MEMORY_SCOPE_AGENT);
      __hip_atomic_fetch_add(&bar[64], 1u, __ATOMIC_RELEASE, __HIP_MEMORY_SCOPE_AGENT);
    } else {
      while (__hip_atomic_load(&bar[64], __ATOMIC_RELAXED, __HIP_MEMORY_SCOPE_AGENT) == gen) __builtin_amdgcn_s_sleep(1);
    }
    __builtin_amdgcn_fence(__ATOMIC_ACQUIRE, "agent");
    asm volatile("s_waitcnt vmcnt(0) lgkmcnt(0)" ::: "memory");
  }
  __syncthreads();
}

__global__ void __launch_bounds__(NTHR) __attribute__((amdgpu_waves_per_eu(2, 2))) mega(Params P) {
  extern __shared__ __attribute__((aligned(16))) char smem[];
  cg::grid_group grid = cg::this_grid();
  int phase = 0;
#if MULTI_LAUNCH
#define ACTIVE() (phase >= P.phase_lo && phase < P.phase_hi)
#define SEAM() do { ++phase; } while (0)
#else
#define ACTIVE() (true)
#define SEAM() do { ++phase; if (phase == 1) grid.sync(); else fast_grid_barrier((unsigned*)(P.ws + OFF_BAR), gridDim.x); } while (0)
#endif
  u16* W = (u16*)(P.ws + OFF_W);
  u16* XN = (u16*)(P.ws + OFF_XN);
  u16* R2 = (u16*)(P.ws + OFF_R2);
  u16* qkv = (u16*)(P.ws + OFF_QKV);
  const u16* Y = qkv + Q_Y;
#define PTRS

  if (ACTIVE()) { PTRS
    rope_tables(P);
    convert_layer(P, 0);
    ew_phase(P, nullptr, 0.f, nullptr, P.norm_g, true);
  }
  SEAM();
  for (int l = 0; l < 4; ++l) {
    const float* g = P.norm_g + (size_t)l * 6 * DM;
    if (ACTIVE()) { PTRS gemm8_phase<5632, DM, KP1>(XN, W + W_WI, EpiFfnUp8{R2}, smem); }
    SEAM();
    if (ACTIVE()) { PTRS gemm8_phase<1024, DFF, KP2>(R2, W + W_WO, EpiY8{qkv + Q_Y}, smem); }
    SEAM();
    if (ACTIVE()) { PTRS ew_phase(P, Y, 0.5f, g + DM, g + 2 * DM, false); }
    SEAM();
    if (ACTIVE()) { PTRS
      gemm_phase<M_PROJ, 4>(W + W_WIN, KP1, XN, KP1, DM, 10, smem, P, l);
      gemm8_phase<4096, DM, KP1>(XN, W + W_WIN + 2560ull * KP1, EpiGate8{(unsigned char*)R2}, smem);
    }
    SEAM();
    if (ACTIVE()) { PTRS
      gemm_phase<M_CUQ, 4>(W + W_WUQ, 384, qkv + Q_CQ, 384, 384, 2, smem, P, l);
      gemm_phase<M_CUKV, 4>(W + W_WUKV, 256, qkv + Q_CKV, 256, 256, 2, smem, P, l);
    }
    SEAM();
    if (ACTIVE()) { PTRS attn_phase(P, l, smem); }
    SEAM();
    if (ACTIVE()) { PTRS gemm_phase<M_MERGE, 2>(W + W_WB, KP1, XN, KP1, DM, 4, smem, P, l); }
    SEAM();
    if (ACTIVE()) { PTRS gemm8_phase<1024, DM, KP1>(qkv + Q_MERGED, W + W_WOUT, EpiY8{qkv + Q_Y}, smem); }
    SEAM();
    if (ACTIVE()) { PTRS ew_phase(P, Y, 1.0f, g + 3 * DM, g + 4 * DM, false); }
    SEAM();
    if (ACTIVE()) { PTRS gemm8_phase<5632, DM, KP1>(XN, W + W_WI + 5632ull * KP1, EpiFfnUp8{R2}, smem); }
    SEAM();
    if (ACTIVE()) { PTRS gemm8_phase<1024, DFF, KP2>(R2, W + W_WO + 1024ull * KP2, EpiY8{qkv + Q_Y}, smem); }
    SEAM();
    if (ACTIVE()) { PTRS
      ew_phase(P, Y, 0.5f, g + 5 * DM, l < 3 ? g + 6 * DM : nullptr, false);
      if (l < 3) convert_layer(P, l + 1);
    }
    SEAM();
  }
}

constexpr int N_PHASES = 1 + 12 * 4;

extern "C" void kernel_launch(void* const* d_in, const int* in_sizes, int n_in, void* d_out, int out_size, void* d_ws,
                              size_t ws_size, hipStream_t stream) {
  static int grid_blocks = 0;
  if (!grid_blocks) {
    int dev = 0, cus = 0, per_cu = 0;
    hipGetDevice(&dev);
    hipDeviceGetAttribute(&cus, hipDeviceAttributeMultiprocessorCount, dev);
    hipFuncSetAttribute((const void*)mega, hipFuncAttributeMaxDynamicSharedMemorySize, SMEM_BYTES);
    hipOccupancyMaxActiveBlocksPerMultiprocessor(&per_cu, mega, NTHR, SMEM_BYTES);
    if (per_cu < 1) per_cu = 1;
    grid_blocks = cus * per_cu;
  }
  if (ws_size < WS_NEEDED) fprintf(stderr, "workspace too small: %zu < %zu\n", ws_size, (size_t)WS_NEEDED);
  Params P{};
  P.x_prompt = (const float*)d_in[0]; P.x_sample = (const float*)d_in[1]; P.norm_g = (const float*)d_in[2];
  P.w_in = (const float*)d_in[3]; P.a_qk_norm = (const float*)d_in[4]; P.b_sink = (const float*)d_in[5];
  P.c_q_norm = (const float*)d_in[6]; P.c_kv_norm = (const float*)d_in[7]; P.c_w_uq = (const float*)d_in[8];
  P.c_w_ukv = (const float*)d_in[9]; P.d_lambda = (const float*)d_in[10]; P.d_subln = (const float*)d_in[11];
  P.w_branch = (const float*)d_in[12]; P.w_out = (const float*)d_in[13]; P.ffn_wi = (const float*)d_in[14];
  P.ffn_wo = (const float*)d_in[15];
  P.out = (float*)d_out; P.ws = (char*)d_ws;
#if MULTI_LAUNCH
  for (int ph = 0; ph < N_PHASES; ++ph) {
    P.phase_lo = ph; P.phase_hi = ph + 1; P.coop = 0; P.pad0 = 0;
    hipLaunchKernelGGL(mega, dim3(grid_blocks), dim3(NTHR), SMEM_BYTES, stream, P);
  }
#else
  P.phase_lo = 0; P.phase_hi = 1 << 30; P.coop = 1; P.pad0 = 0;
  hipMemsetAsync((char*)d_ws + OFF_BAR, 0, 1024, stream);
  void* args[] = {&P};
  hipError_t e = hipLaunchCooperativeKernel((const void*)mega, dim3(grid_blocks), dim3(NTHR), args, SMEM_BYTES, stream);
  if (e != hipSuccess) fprintf(stderr, "cooperative launch failed: %s (grid %d)\n", hipGetErrorString(e), grid_blocks);
#endif
}
```

```cpp
#include <hip/hip_runtime.h>
#include <hip/hip_cooperative_groups.h>
#include <cstdio>
#include <cstdint>
#include <type_traits>
namespace cg = cooperative_groups;

#ifndef MULTI_LAUNCH
#define MULTI_LAUNCH 0
#endif

#define DI __device__ __forceinline__
typedef unsigned short u16;
typedef __attribute__((ext_vector_type(8))) short bf16x8;
typedef __attribute__((ext_vector_type(16))) float f32x16;
typedef __attribute__((ext_vector_type(2))) float f32x2_t;
typedef __attribute__((ext_vector_type(2))) __bf16 bf16x2_t;

constexpr int T = 32768;
constexpr int DM = 1024;
constexpr int DFF = 2816;
constexpr int KP1 = 1088;
constexpr int KP2 = 2880;
constexpr int GP = 4160;
constexpr int YP = 1040;
constexpr int NPROJ = 6560;
constexpr int SEQ0 = 16384;
constexpr int DSEQ = 2048;
constexpr float EPS = 1e-6f;
constexpr int NTHR = 512;
constexpr int LSTR = 72;
constexpr int SMEM_BYTES = 2 * 2 * 256 * LSTR * 2;

constexpr size_t W_WI = 0;
constexpr size_t W_WO = W_WI + 2ull * 5632 * KP1;
constexpr size_t W_WIN = W_WO + 2ull * 1024 * KP2;
constexpr size_t W_WUQ = W_WIN + 6656ull * KP1;
constexpr size_t W_WUKV = W_WUQ + 512ull * 384;
constexpr size_t W_WB = W_WUKV + 512ull * 256;
constexpr size_t W_WOUT = W_WB + 1024ull * KP1;
constexpr size_t W_TOTAL = W_WOUT + 1024ull * KP1;

constexpr size_t OFF_W = 0;
constexpr size_t OFF_XN = OFF_W + W_TOTAL * 2;
constexpr size_t OFF_R2 = OFF_XN + (size_t)T * KP1 * 2;
constexpr size_t OFF_QKV = OFF_R2 + (size_t)T * KP2 * 2;
constexpr size_t OFF_SS = OFF_QKV + (size_t)T * 3456 * 2;
constexpr size_t OFF_R64 = OFF_SS + (size_t)T * 20 * 4;
constexpr size_t OFF_R32 = OFF_R64 + 16384ull * 32 * 8;
constexpr size_t OFF_DS = OFF_R32 + 16384ull * 16 * 8;
constexpr size_t OFF_BAR = OFF_DS + (size_t)T * 256 * 4;
constexpr size_t OFF_XB = OFF_BAR + 1024;
constexpr size_t WS_NEEDED = OFF_XB + (size_t)T * 1024 * 2;

constexpr size_t Q_QA = 0;
constexpr size_t Q_KA = (size_t)T * 256;
constexpr size_t Q_VTA = (size_t)T * 384;
constexpr size_t Q_QB = (size_t)T * 512;
constexpr size_t Q_KB = (size_t)T * 768;
constexpr size_t Q_VTB = (size_t)T * 896;
constexpr size_t Q_CQ = (size_t)T * 1024;
constexpr size_t Q_CKV = (size_t)T * 1408;
constexpr size_t Q_QC = (size_t)T * 1664;
constexpr size_t Q_KC = (size_t)T * 2048;
constexpr size_t Q_VTC = (size_t)T * 2432;
constexpr size_t Q_QD = (size_t)T * 2688;
constexpr size_t Q_KD = (size_t)T * 2944;
constexpr size_t Q_VTD = (size_t)T * 3200;
constexpr size_t Q_MERGED = 0;
constexpr size_t Q_Y = (size_t)T * KP1;

struct Params {
  const float* x_prompt; const float* x_sample; const float* norm_g; const float* w_in;
  const float* a_qk_norm; const float* b_sink; const float* c_q_norm; const float* c_kv_norm;
  const float* c_w_uq; const float* c_w_ukv; const float* d_lambda; const float* d_subln;
  const float* w_branch; const float* w_out; const float* ffn_wi; const float* ffn_wo;
  float* out; char* ws;
  int phase_lo; int phase_hi; int coop; int pad0;
};

DI unsigned pk2(float a, float b) {
  f32x2_t v = {a, b};
  bf16x2_t r = __builtin_convertvector(v, bf16x2_t);
  return __builtin_bit_cast(unsigned, r);
}
DI u16 f2bf(float a) { return (u16)(pk2(a, 0.f) & 0xffffu); }
DI float bf2f(unsigned bits16) { return __uint_as_float(bits16 << 16); }
DI int crow(int v, int h) { return (v & 3) + 8 * (v >> 2) + 4 * h; }
DI int pos_of(int tok) { return tok < SEQ0 ? tok : ((tok - SEQ0) & (DSEQ - 1)); }
#define MFMA32(a, b, c) __builtin_amdgcn_mfma_f32_32x32x16_bf16((a), (b), (c), 0, 0, 0)

typedef __attribute__((ext_vector_type(4))) unsigned u32x4;
DI u32x4 gld16(const void* p) { u32x4 r; asm volatile("global_load_dwordx4 %0, %1, off" : "=v"(r) : "v"(p)); return r; }
DI void wait_vm0(u32x4& a) { asm volatile("s_waitcnt vmcnt(0)" : "+v"(a) :: "memory"); }
DI void wait_vm0(u32x4& a, u32x4& b) { asm volatile("s_waitcnt vmcnt(0)" : "+v"(a), "+v"(b) :: "memory"); }
DI void wait_vm0(u32x4& a, u32x4& b, u32x4& c) { asm volatile("s_waitcnt vmcnt(0)" : "+v"(a), "+v"(b), "+v"(c) :: "memory"); }
DI void wait_vm0(u32x4& a, u32x4& b, u32x4& c, u32x4& d) { asm volatile("s_waitcnt vmcnt(0)" : "+v"(a), "+v"(b), "+v"(c), "+v"(d) :: "memory"); }
DI u32x4 gld16s(unsigned voff, const void* sbase) { u32x4 r; asm volatile("global_load_dwordx4 %0, %1, %2" : "=v"(r) : "v"(voff), "s"(sbase)); return r; }
#define DEF_WAIT8(name, cnt) DI void name(u32x4& a, u32x4& b, u32x4& c, u32x4& d, u32x4& e, u32x4& f, u32x4& g, u32x4& h) { asm volatile("s_waitcnt vmcnt(" #cnt ")" : "+v"(a), "+v"(b), "+v"(c), "+v"(d), "+v"(e), "+v"(f), "+v"(g), "+v"(h) :: "memory"); }
#define DEF_WAIT6(name, cnt) DI void name(u32x4& a, u32x4& b, u32x4& c, u32x4& d, u32x4& e, u32x4& f) { asm volatile("s_waitcnt vmcnt(" #cnt ")" : "+v"(a), "+v"(b), "+v"(c), "+v"(d), "+v"(e), "+v"(f) :: "memory"); }
DEF_WAIT8(wait8_vm8, 8)
DEF_WAIT8(wait8_vm0, 0)
DEF_WAIT6(wait6_vm6, 6)
DEF_WAIT6(wait6_vm0, 0)
DI int opaque_tid() { int t = threadIdx.x; asm volatile("" : "+v"(t)); return t; }
DI float wave_sum(float v) {
#pragma unroll
  for (int m = 32; m >= 1; m >>= 1) v += __shfl_xor(v, m);
  return v;
}

DI void rope32_blk(f32x16& a, const float2* __restrict__ tab, int h) {
#pragma unroll
  for (int v = 0; v < 8; ++v) {
    float2 cs = tab[crow(v, h)];
    float x1 = a[v], x2 = a[v + 8];
    a[v] = x1 * cs.x - x2 * cs.y;
    a[v + 8] = x2 * cs.x + x1 * cs.y;
  }
}
DI void rope64_blk(f32x16& a0, f32x16& a1, const float2* __restrict__ tab, int h) {
#pragma unroll
  for (int v = 0; v < 16; ++v) {
    float2 cs = tab[crow(v, h)];
    float x1 = a0[v], x2 = a1[v];
    a0[v] = x1 * cs.x - x2 * cs.y;
    a1[v] = x2 * cs.x + x1 * cs.y;
  }
}
DI void store_rows(u16* __restrict__ base, int ld, int col0, const f32x16& a, int tok, int h) {
#pragma unroll
  for (int vq = 0; vq < 4; ++vq) {
    uint2 pk;
    pk.x = pk2(a[4 * vq], a[4 * vq + 1]);
    pk.y = pk2(a[4 * vq + 2], a[4 * vq + 3]);
    *(uint2*)(base + (size_t)tok * ld + col0 + 8 * vq + 4 * h) = pk;
  }
}
DI void store_T(u16* __restrict__ base, int row0, const f32x16& a, int tok, int h) {
  const int tp = (tok & ~12) | ((tok & 4) << 1) | ((tok & 8) >> 1);
#pragma unroll
  for (int v = 0; v < 16; ++v) base[(size_t)((row0 + crow(v, h)) >> 6) * 64 * T + (size_t)(tp >> 7) * 8192 + ((row0 + crow(v, h)) & 63) * 128 + (tp & 127)] = f2bf(a[v]);
}

enum { M_FFNUP = 0, M_Y = 1, M_PROJ = 2, M_CUQ = 3, M_CUKV = 4, M_MERGE = 5, M_GATE = 6 };

template <int MODE, int NJ>
DI void gemm_epilogue(f32x16 (&acc)[2][NJ], int fbase, int tbase, int r, int h, const Params& P, int layer) {
  char* ws = P.ws;
  u16* qkv = (u16*)(ws + OFF_QKV);
  const float2* R64 = (const float2*)(ws + OFF_R64);
  const float2* R32 = (const float2*)(ws + OFF_R32);
  float* SS = (float*)(ws + OFF_SS);
  if constexpr (MODE == M_FFNUP) {
    u16* H = (u16*)(ws + OFF_R2);
    const int hf0 = (fbase >> 6) * 32;
#pragma unroll
    for (int j = 0; j < NJ; ++j) {
      const int tok = tbase + j * 32 + r;
      f32x16 o;
#pragma unroll
      for (int v = 0; v < 16; ++v) {
        float g = acc[0][j][v], u = acc[1][j][v];
        o[v] = g * __builtin_amdgcn_rcpf(1.f + __builtin_amdgcn_exp2f(-1.4426950408889634f * g)) * u;
      }
      store_rows(H, KP2, hf0, o, tok, h);
    }
  } else if constexpr (MODE == M_Y) {
    u16* Yb = qkv + Q_Y;
#pragma unroll
    for (int j = 0; j < NJ; ++j) {
      const int tok = tbase + j * 32 + r;
      store_rows(Yb, KP1, fbase, acc[0][j], tok, h);
      store_rows(Yb, KP1, fbase + 32, acc[1][j], tok, h);
    }
  } else if constexpr (MODE == M_PROJ) {
    if (fbase < 384) {
      const bool isK = fbase >= 256;
      const float* g = P.a_qk_norm + layer * 128 + (isK ? 64 : 0);
      u16* dst = qkv + (isK ? Q_KA : Q_QA);
      const int ld = isK ? 128 : 256;
      const int c0 = isK ? fbase - 256 : fbase;
      float gv[2][16];
#pragma unroll
      for (int i = 0; i < 2; ++i)
#pragma unroll
        for (int v = 0; v < 16; ++v) gv[i][v] = g[i * 32 + crow(v, h)];
#pragma unroll
      for (int j = 0; j < NJ; ++j) {
        const int tok = tbase + j * 32 + r;
        const int pos = pos_of(tok);
        float ss = 0.f;
#pragma unroll
        for (int i = 0; i < 2; ++i)
#pragma unroll
          for (int v = 0; v < 16; ++v) ss += acc[i][j][v] * acc[i][j][v];
        ss += __shfl_xor(ss, 32);
        const float rs = rsqrtf(ss * (1.f / 64.f) + EPS);
#pragma unroll
        for (int i = 0; i < 2; ++i)
#pragma unroll
          for (int v = 0; v < 16; ++v) acc[i][j][v] *= rs * gv[i][v];
        rope32_blk(acc[0][j], R32 + (size_t)(pos >> 6) * 16, h);
        rope32_blk(acc[1][j], R32 + (size_t)(pos & 63) * 16, h);
        store_rows(dst, ld, c0, acc[0][j], tok, h);
        store_rows(dst, ld, c0 + 32, acc[1][j], tok, h);
      }
    } else if (fbase < 512) {
#pragma unroll
      for (int j = 0; j < NJ; ++j) {
        const int tok = tbase + j * 32 + r;
        store_T(qkv + Q_VTA, fbase - 384, acc[0][j], tok, h);
        store_T(qkv + Q_VTA, fbase - 384 + 32, acc[1][j], tok, h);
      }
    } else if (fbase < 896) {
      const bool isK = fbase >= 768;
      u16* dst = qkv + (isK ? Q_KB : Q_QB);
      const int ld = isK ? 128 : 256;
      const int c0 = isK ? fbase - 768 : fbase - 512;
#pragma unroll
      for (int j = 0; j < NJ; ++j) {
        const int tok = tbase + j * 32 + r;
        const int pos = pos_of(tok);
        rope64_blk(acc[0][j], acc[1][j], R64 + (size_t)pos * 32, h);
        store_rows(dst, ld, c0, acc[0][j], tok, h);
        store_rows(dst, ld, c0 + 32, acc[1][j], tok, h);
      }
    } else if (fbase < 1024) {
#pragma unroll
      for (int j = 0; j < NJ; ++j) {
        const int tok = tbase + j * 32 + r;
        store_T(qkv + Q_VTB, fbase - 896, acc[0][j], tok, h);
        store_T(qkv + Q_VTB, fbase - 896 + 32, acc[1][j], tok, h);
      }
    } else if (fbase < 1664) {
      const bool isKV = fbase >= 1408;
      u16* dst = qkv + (isKV ? Q_CKV : Q_CQ);
      const int ld = isKV ? 256 : 384;
      const int c0 = isKV ? fbase - 1408 : fbase - 1024;
      const int sb = (isKV ? 12 : 0) + (c0 >> 5);
#pragma unroll
      for (int j = 0; j < NJ; ++j) {
        const int tok = tbase + j * 32 + r;
#pragma unroll
        for (int i = 0; i < 2; ++i) {
          float ss = 0.f;
#pragma unroll
          for (int v = 0; v < 16; ++v) ss += acc[i][j][v] * acc[i][j][v];
          ss += __shfl_xor(ss, 32);
          if (h == 0) SS[(size_t)tok * 20 + sb + i] = ss;
          store_rows(dst, ld, c0 + i * 32, acc[i][j], tok, h);
        }
      }
    } else if (fbase < 2176) {
      const bool isK = fbase >= 1920;
      u16* dst = qkv + (isK ? Q_KD : Q_QD);
      const int c0 = isK ? fbase - 1920 : fbase - 1664;
#pragma unroll
      for (int j = 0; j < NJ; ++j) {
        const int tok = tbase + j * 32 + r;
        const int pos = pos_of(tok);
#pragma unroll
        for (int i = 0; i < 2; ++i) {
          rope32_blk(acc[i][j], R32 + (size_t)pos * 16, h);
          store_rows(dst, 256, c0 + i * 32, acc[i][j], tok, h);
        }
      }
    } else if (fbase < 2432) {
#pragma unroll
      for (int j = 0; j < NJ; ++j) {
        const int tok = tbase + j * 32 + r;
        store_T(qkv + Q_VTD, fbase - 2176, acc[0][j], tok, h);
        store_T(qkv + Q_VTD, fbase - 2176 + 32, acc[1][j], tok, h);
      }
    } else if (fbase == 2432) {
#pragma unroll
      for (int j = 0; j < NJ; ++j) {
        const int tok = tbase + j * 32 + r;
        const int pos = pos_of(tok);
        rope32_blk(acc[0][j], R32 + (size_t)pos * 16, h);
#pragma unroll
        for (int hd = 0; hd < 4; ++hd) store_rows(qkv + Q_KC, 384, hd * 96 + 64, acc[0][j], tok, h);
      }
    }
  } else if constexpr (MODE == M_GATE) {
    unsigned char* G8 = (unsigned char*)(ws + OFF_R2);
#pragma unroll
    for (int j = 0; j < NJ; ++j) {
      const int tok = tbase + j * 32 + r;
#pragma unroll
      for (int i = 0; i < 2; ++i)
#pragma unroll
        for (int vq = 0; vq < 4; ++vq) {
          unsigned pk = 0u;
#pragma unroll
          for (int e = 0; e < 4; ++e) {
            const float o = __builtin_amdgcn_rcpf(1.f + __builtin_amdgcn_exp2f(-1.4426950408889634f * acc[i][j][4 * vq + e]));
            pk |= (unsigned)(o * 255.f + 0.5f) << (8 * e);
          }
          *(unsigned*)(G8 + (size_t)tok * GP + fbase + i * 32 + 8 * vq + 4 * h) = pk;
        }
    }
  } else if constexpr (MODE == M_CUQ) {
    if (fbase >= 384) return;
#pragma unroll
    for (int j = 0; j < NJ; ++j) {
      const int tok = tbase + j * 32 + r;
      const int pos = pos_of(tok);
      float ss = 0.f;
#pragma unroll
      for (int b = 0; b < 12; ++b) ss += SS[(size_t)tok * 20 + b];
      const float rs = rsqrtf(ss * (1.f / 384.f) + EPS);
#pragma unroll
      for (int i = 0; i < 2; ++i) {
        const int blk = (fbase >> 5) + i;
#pragma unroll
        for (int v = 0; v < 16; ++v) acc[i][j][v] *= rs;
        if (blk % 3 == 2) rope32_blk(acc[i][j], R32 + (size_t)pos * 16, h);
        store_rows(qkv + Q_QC, 384, blk * 32, acc[i][j], tok, h);
      }
    }
  } else if constexpr (MODE == M_CUKV) {
#pragma unroll
    for (int j = 0; j < NJ; ++j) {
      const int tok = tbase + j * 32 + r;
      float ss = 0.f;
#pragma unroll
      for (int b = 0; b < 8; ++b) ss += SS[(size_t)tok * 20 + 12 + b];
      const float rs = rsqrtf(ss * (1.f / 256.f) + EPS);
#pragma unroll
      for (int i = 0; i < 2; ++i) {
        const int blk = (fbase >> 5) + i;
        const int hd = blk >> 2, q = blk & 3;
#pragma unroll
        for (int v = 0; v < 16; ++v) acc[i][j][v] *= rs;
        if (q < 2) store_rows(qkv + Q_KC, 384, hd * 96 + q * 32, acc[i][j], tok, h);
        else store_T(qkv + Q_VTC, hd * 64 + (q - 2) * 32, acc[i][j], tok, h);
      }
    }
  } else if constexpr (MODE == M_MERGE) {
#pragma unroll
    for (int j = 0; j < NJ; ++j) {
      const int tok = tbase + j * 32 + r;
      store_rows(qkv + Q_MERGED, KP1, fbase, acc[0][j], tok, h);
      store_rows(qkv + Q_MERGED, KP1, fbase + 32, acc[1][j], tok, h);
    }
  }
}

typedef __attribute__((address_space(3))) unsigned lds_u32_t;
typedef __attribute__((address_space(1))) const unsigned glb_u32_t;
template <int MODE, int NJ>
DI void gemm_tile(const u16* __restrict__ Wt, int ldw, const u16* __restrict__ X, int ldx, int K, int f0, int t0, char* smem,
                  const Params& P, int layer) {
  constexpr int XROWS = NJ * 64;
  constexpr int WSTG = 256 * 64, XSTG = XROWS * 64;
  u16* sW = (u16*)smem;
  u16* sX = sW + 2 * WSTG;
  const int tid = opaque_tid(), lane = tid & 63, wave = tid >> 6, r = lane & 31, h = lane >> 5;
  const int wf = wave & 3, wt = wave >> 2;
  f32x16 acc[2][NJ];
  f32x16 tot[2][MODE == M_MERGE ? NJ : 1];
#pragma unroll
  for (int i = 0; i < 2; ++i)
#pragma unroll
    for (int j = 0; j < NJ; ++j)
#pragma unroll
      for (int v = 0; v < 16; ++v) acc[i][j][v] = 0.f;
  if constexpr (MODE == M_MERGE) {
#pragma unroll
    for (int i = 0; i < 2; ++i)
#pragma unroll
      for (int j = 0; j < NJ; ++j)
#pragma unroll
        for (int v = 0; v < 16; ++v) tot[i][j][v] = 0.f;
  }
  const int nk = K >> 6;
  const int srow = tid >> 3;
  const int schunk = (tid & 7) ^ ((tid >> 4) & 7);
  const u16* wp = Wt + (size_t)(f0 + srow) * ldw + schunk * 8;
  const u16* xp = X + (size_t)(t0 + srow) * ldx + schunk * 8;
  const int fbase = f0 + wf * 64, tbase = t0 + wt * (NJ * 32);

  auto issue = [&](int kt, int buf) {
#pragma unroll
    for (int i = 0; i < 4; ++i)
      __builtin_amdgcn_global_load_lds((glb_u32_t*)(wp + (size_t)(i * 64) * ldw + kt * 64),
                                       (lds_u32_t*)(sW + buf * WSTG + i * 4096 + tid * 8), 16, 0, 0);
#pragma unroll
    for (int i = 0; i < NJ; ++i)
      __builtin_amdgcn_global_load_lds((glb_u32_t*)(xp + (size_t)(i * 64) * ldx + kt * 64),
                                       (lds_u32_t*)(sX + buf * XSTG + i * 4096 + tid * 8), 16, 0, 0);
  };
  const int swz = (r >> 1) & 7;
  auto compute = [&](int buf, int kt) {
    const u16* aW = sW + buf * WSTG + (wf * 64 + r) * 64;
    const u16* aX = sX + buf * XSTG + (wt * (NJ * 32) + r) * 64;
#pragma unroll
    for (int ks = 0; ks < 4; ++ks) {
      const int co = ((2 * ks + h) ^ swz) * 8;
      bf16x8 wfrag[2], xfrag[NJ];
#pragma unroll
      for (int i = 0; i < 2; ++i) wfrag[i] = *(const bf16x8*)(aW + i * 32 * 64 + co);
#pragma unroll
      for (int j = 0; j < NJ; ++j) xfrag[j] = *(const bf16x8*)(aX + j * 32 * 64 + co);
#pragma unroll
      for (int i = 0; i < 2; ++i)
#pragma unroll
        for (int j = 0; j < NJ; ++j) acc[i][j] = MFMA32(wfrag[i], xfrag[j], acc[i][j]);
    }
    if constexpr (MODE == M_MERGE) {
      if ((kt & 3) == 3) {
        const int br = kt >> 2;
        const unsigned char* G8 = (const unsigned char*)(P.ws + OFF_R2);
#pragma unroll
        for (int j = 0; j < NJ; ++j) {
          const int tok = tbase + j * 32 + r;
#pragma unroll
          for (int i = 0; i < 2; ++i)
#pragma unroll
            for (int vq = 0; vq < 4; ++vq) {
              const unsigned gp = *(const unsigned*)(G8 + (size_t)tok * GP + br * 1024 + fbase + i * 32 + 8 * vq + 4 * h);
              tot[i][j][4 * vq + 0] += (float)(gp & 0xffu) * (1.f / 255.f) * acc[i][j][4 * vq + 0];
              tot[i][j][4 * vq + 1] += (float)((gp >> 8) & 0xffu) * (1.f / 255.f) * acc[i][j][4 * vq + 1];
              tot[i][j][4 * vq + 2] += (float)((gp >> 16) & 0xffu) * (1.f / 255.f) * acc[i][j][4 * vq + 2];
              tot[i][j][4 * vq + 3] += (float)(gp >> 24) * (1.f / 255.f) * acc[i][j][4 * vq + 3];
              acc[i][j][4 * vq + 0] = 0.f; acc[i][j][4 * vq + 1] = 0.f;
              acc[i][j][4 * vq + 2] = 0.f; acc[i][j][4 * vq + 3] = 0.f;
            }
        }
      }
    }
  };

  issue(0, 0);
  asm volatile("s_waitcnt vmcnt(0)" ::: "memory");
  __syncthreads();
  for (int kt = 0; kt < nk; ++kt) {
    const int buf = kt & 1;
    if (kt + 1 < nk) issue(kt + 1, buf ^ 1);
    compute(buf, kt);
    asm volatile("s_waitcnt vmcnt(0) lgkmcnt(0)" ::: "memory");
    __syncthreads();
  }
  if constexpr (MODE == M_MERGE) gemm_epilogue<MODE, NJ>(tot, fbase, tbase, r, h, P, layer);
  else gemm_epilogue<MODE, NJ>(acc, fbase, tbase, r, h, P, layer);
}

template <int MODE, int NJ>
DI void gemm_phase(const u16* Wt, int ldw, const u16* X, int ldx, int K, int nF, char* smem, const Params& P, int layer) {
  constexpr int TT = NJ * 64;
  const int nT = T / TT;
  const int ntiles = nF * nT;
  for (int idx = blockIdx.x; idx < ntiles; idx += gridDim.x) {
    const int tt_lo = idx & 15;
    const int rest = idx >> 4;
    const int ft = rest % nF;
    const int tt = (rest / nF) * 16 + tt_lo;
    gemm_tile<MODE, NJ>(Wt, ldw, X, ldx, K, ft * 256, tt * TT, smem, P, layer);
  }
}

namespace pg8 {
#define PG8_LAS __attribute__((address_space(3)))
typedef unsigned short bf16_t;
typedef short bf16x8 __attribute__((ext_vector_type(8)));
typedef float f32x4 __attribute__((ext_vector_type(4)));
typedef unsigned u32x4 __attribute__((ext_vector_type(4)));
constexpr int BM = 256, BK = 64, HALF = 128, HTB = HALF * BK * 2  , STAGE_BYTES = 8 * HTB, NXCD = 8, WGM = 8;

__host__ __device__ __forceinline__ int lds_byte(int r, int c) { const int st = (r >> 4) * 2 + (c >> 5), rr = r & 15, cc = c & 31, ob = rr * 64 + cc * 2; return st * 1024 + (ob ^ (((ob >> 9) & 1) << 5)); }
__host__ __device__ __forceinline__ void stage_rc(int b, int& R, int& C) { const int st = b / 1024, sb = b % 1024, swz = sb ^ (((sb >> 9) & 1) << 5); R = (st >> 1) * 16 + swz / 64; C = (st & 1) * 32 + (swz % 64) / 2; }
__host__ __device__ __forceinline__ int perm32(int rho) { const int n = rho >> 4, i = rho & 15; return 8 * (i >> 2) + 4 * n + (i & 3); }

struct Unit { int pm, pn; };
struct Gemm { const bf16_t* A; const bf16_t* Bt; int M, N, K, ld; };

struct StaticOrder {
    int nM, nN, nwg, G, c;
    __host__ __device__ void init(int M, int N, int G_, int c_) { nM = M / BM; nN = N / BM; nwg = nM * nN; G = G_; c = c_; }
    __host__ __device__ bool next(int i, Unit& u) const {
        const long L = (long)i * G + c; if (L >= nwg) return false;
        int wgid = (int)L; { const int q = nwg / NXCD, r = nwg % NXCD, xcd = wgid % NXCD, off = wgid / NXCD; wgid = (xcd < r ? xcd * (q + 1) : r * (q + 1) + (xcd - r) * q) + off; }
        const int nig = WGM * nN, gid = wgid / nig, fm = gid * WGM, gsz = (nM - fm) < WGM ? (nM - fm) : WGM;
        u.pm = fm + ((wgid % nig) % gsz); u.pn = (wgid % nig) / gsz; return true;
    }
    __device__ __forceinline__ void a_ready(const Unit&) const {}
    __device__ __forceinline__ void done(const Unit&) const {}
};

template <class Epi, class Sched, bool STAMP, int KC, int LDC>
__device__ __forceinline__ void gemm_phase(PG8_LAS unsigned char* lds, const Gemm g, const Sched& S, const Epi& E, unsigned long long* stamps) {
    const int tid = opaque_tid(), wid = __builtin_amdgcn_readfirstlane(tid >> 6), lane = tid & 63, wr = wid >> 2, wc = wid & 3, fr = lane & 15, fq = lane >> 4;
    constexpr int K = KC, nt = K / BK;
    int ts_lo = 0, ts_hi = 0, nts = 0; const unsigned long long rt_entry = STAMP ? (unsigned long long)wall_clock64() : 0ull;
#define PG8_STAMP() do { if (STAMP && wid == 0 && nts < 64) { const unsigned long long _c = (unsigned long long)clock64(); \
        ts_lo = (lane == nts) ? (int)(unsigned)_c : ts_lo; ts_hi = (lane == nts) ? (int)(unsigned)(_c >> 32) : ts_hi; ++nts; } } while (0)
    PG8_STAMP();
    unsigned voffA[2], voffB[2];
#pragma unroll
    for (int i = 0; i < 2; ++i) { int R, C; stage_rc(tid * 16 + i * 8192, R, C); const int Rb = Epi::PERM ? ((R & ~31) + perm32(R & 31)) : R;
        voffA[i] = (unsigned)(R * LDC + C) * 2u; voffB[i] = (unsigned)(Rb * LDC + C) * 2u; }
    const size_t kstep = (size_t)(BK * 2);
    constexpr size_t hstep = (size_t)HALF * LDC * 2;
    const size_t tstep = 2 * hstep;
    const unsigned ldsw = (unsigned)wid * 1024u;
    const int aoff = lds_byte(wr * 64 + fr, fq * 8), boff = lds_byte(wc * 32 + fr, fq * 8);
#define PG8_SA(b, h) (((b) * 2 + (h)) * HTB)
#define PG8_SB(b, h) ((4 + (b) * 2 + (h)) * HTB)
#define PG8_STAGE(bufoff, gbase, voff) do { _Pragma("unroll") for (int _i = 0; _i < 2; ++_i) \
        __builtin_amdgcn_global_load_lds((const unsigned*)((const char*)(gbase) + (voff)[_i]), (PG8_LAS unsigned*)(lds + (bufoff) + ldsw + _i * 8192), 16, 0, 0); } while (0)
#define PG8_LDA(dst, b, h) do { _Pragma("unroll") for (int m = 0; m < 4; ++m) _Pragma("unroll") for (int k = 0; k < 2; ++k) dst[m][k] = *(const PG8_LAS bf16x8*)(lds + PG8_SA(b, h) + aoff + m * 2048 + k * 1024); } while (0)
#define PG8_LDB(dst, b, h) do { _Pragma("unroll") for (int n = 0; n < 2; ++n) _Pragma("unroll") for (int k = 0; k < 2; ++k) dst[n][k] = *(const PG8_LAS bf16x8*)(lds + PG8_SB(b, h) + boff + n * 2048 + k * 1024); } while (0)
#define PG8_MMA(ai, bj, At, Bt) do { __builtin_amdgcn_s_setprio(1); _Pragma("unroll") for (int m = 0; m < 4; ++m) _Pragma("unroll") for (int n = 0; n < 2; ++n) _Pragma("unroll") for (int k = 0; k < 2; ++k) \
        acc[ai][bj][m][n] = __builtin_amdgcn_mfma_f32_16x16x32_bf16(Bt[n][k], At[m][k], acc[ai][bj][m][n], 0, 0, 0); __builtin_amdgcn_s_setprio(0); } while (0)
#define PG8_WAIT_V(n) asm volatile("s_waitcnt vmcnt(" #n ")" ::: "memory")
#define PG8_WAIT_L(n) asm volatile("s_waitcnt lgkmcnt(" #n ")" ::: "memory")
#define PG8_BAR __builtin_amdgcn_s_barrier()
#define PG8_SCHED __builtin_amdgcn_sched_barrier(0)
    Unit cur, nxt; int ui = 0;
    if (!S.next(0, cur)) return;
    f32x4 acc[2][2][4][2];
#pragma unroll
    for (int a = 0; a < 2; ++a)
#pragma unroll
        for (int b = 0; b < 2; ++b)
#pragma unroll
            for (int m = 0; m < 4; ++m)
#pragma unroll
                for (int n = 0; n < 2; ++n) acc[a][b][m][n] = (f32x4){0.f, 0.f, 0.f, 0.f};
    bf16x8 At[4][2], B0[2][2], B1[2][2];
    const char* cA = (const char*)g.A + (size_t)cur.pm * tstep; const char* cB = (const char*)g.Bt + (size_t)cur.pn * tstep;
    S.a_ready(cur);
    PG8_STAGE(PG8_SB(0, 0), cB, voffB); PG8_STAGE(PG8_SA(0, 0), cA, voffA); PG8_STAGE(PG8_SB(0, 1), cB + hstep, voffB); PG8_STAGE(PG8_SA(0, 1), cA + hstep, voffA);
    if (wr == 1) PG8_BAR;
    PG8_WAIT_V(4); PG8_BAR;
    PG8_STAGE(PG8_SB(1, 0), cB + kstep, voffB); PG8_STAGE(PG8_SA(1, 0), cA + kstep, voffA); PG8_STAGE(PG8_SB(1, 1), cB + hstep + kstep, voffB);
    PG8_WAIT_V(6); PG8_BAR;
    PG8_STAMP();
    for (;;) {
        const bool has_next = S.next(ui + 1, nxt);
        const char* nA = has_next ? (const char*)g.A + (size_t)nxt.pm * tstep : cA; const char* nB = has_next ? (const char*)g.Bt + (size_t)nxt.pn * tstep : cB;
        for (int t = 0; t < nt; t += 2) {
            const bool last = (t == nt - 2);
            const char* a1 = cA + (size_t)(t + 1) * kstep;
            const char* a2 = last ? nA : cA + (size_t)(t + 2) * kstep; const char* b2 = last ? nB : cB + (size_t)(t + 2) * kstep;
            const char* a3 = a2 + kstep; const char* b3 = b2 + kstep;
            if (last && has_next) S.a_ready(nxt);
            PG8_LDB(B0, 0, 0); PG8_SCHED; PG8_LDA(At, 0, 0); PG8_STAGE(PG8_SA(1, 1), a1 + hstep, voffA);
            PG8_WAIT_L(8); PG8_BAR; PG8_WAIT_L(0); PG8_MMA(0, 0, At, B0); PG8_BAR; PG8_SCHED;
            PG8_LDB(B1, 0, 1); PG8_STAGE(PG8_SB(0, 0), b2, voffB);
            PG8_BAR; PG8_WAIT_L(0); PG8_MMA(0, 1, At, B1); PG8_BAR;
            PG8_LDA(At, 0, 1); PG8_STAGE(PG8_SA(0, 0), a2, voffA);
            PG8_BAR; PG8_WAIT_L(0); PG8_MMA(1, 0, At, B0); PG8_BAR; PG8_SCHED;
            PG8_STAGE(PG8_SB(0, 1), b2 + hstep, voffB);
            PG8_WAIT_V(6); PG8_BAR; PG8_MMA(1, 1, At, B1); PG8_BAR;
            PG8_LDB(B0, 1, 0); PG8_SCHED; PG8_LDA(At, 1, 0); PG8_STAGE(PG8_SA(0, 1), a2 + hstep, voffA);
            PG8_WAIT_L(8); PG8_BAR; PG8_WAIT_L(0); PG8_MMA(0, 0, At, B0); PG8_BAR; PG8_SCHED;
            PG8_LDB(B1, 1, 1); PG8_STAGE(PG8_SB(1, 0), b3, voffB);
            PG8_BAR; PG8_WAIT_L(0); PG8_MMA(0, 1, At, B1); PG8_BAR;
            PG8_LDA(At, 1, 1); PG8_STAGE(PG8_SA(1, 0), a3, voffA);
            PG8_BAR; PG8_WAIT_L(0); PG8_MMA(1, 0, At, B0); PG8_BAR; PG8_SCHED;
            PG8_STAGE(PG8_SB(1, 1), b3 + hstep, voffB);
            PG8_WAIT_V(6); PG8_BAR; PG8_MMA(1, 1, At, B1); PG8_BAR;
        }
        PG8_STAMP();
        if constexpr (!Epi::AFTER_DRAIN) { E(acc, cur, wr, wc, fr, fq); S.done(cur); }
        PG8_STAMP();
        if (!has_next) break;
#pragma unroll
        for (int a = 0; a < 2; ++a)
#pragma unroll
            for (int b = 0; b < 2; ++b)
#pragma unroll
                for (int m = 0; m < 4; ++m)
#pragma unroll
                    for (int n = 0; n < 2; ++n) acc[a][b][m][n] = (f32x4){0.f, 0.f, 0.f, 0.f};
        cur = nxt; cA = nA; cB = nB; ++ui;
    }
    PG8_WAIT_V(0);
    if (wr == 0) PG8_BAR;
    PG8_BAR;
    if constexpr (Epi::AFTER_DRAIN) { E.fused(acc, cur, wr, wc, fr, fq, lds, wid, lane); S.done(cur); }
    PG8_STAMP();
    if (STAMP && wid == 0) { stamps[lane] = lane < nts ? (((unsigned long long)(unsigned)ts_hi << 32) | (unsigned)ts_lo) : 0ull;
        if (lane == 62) stamps[62] = rt_entry; if (lane == 63) stamps[63] = (unsigned long long)wall_clock64(); }
#undef PG8_STAMP
#undef PG8_SA
#undef PG8_SB
#undef PG8_STAGE
#undef PG8_LDA
#undef PG8_LDB
#undef PG8_MMA
#undef PG8_WAIT_V
#undef PG8_WAIT_L
#undef PG8_BAR
#undef PG8_SCHED
}
}

struct EpiY8 {
  static constexpr bool PERM = true, AFTER_DRAIN = false;
  u16* O;
  DI void operator()(const pg8::f32x4 (&acc)[2][2][4][2], const pg8::Unit& u, int wr, int wc, int fr, int fq) const {
    const int row0 = u.pm * 256 + wr * 64 + fr, col0 = u.pn * 256 + wc * 32 + 8 * fq;
#pragma unroll
    for (int ai = 0; ai < 2; ++ai)
#pragma unroll
      for (int m = 0; m < 4; ++m) {
        u16* rowp = O + (size_t)(row0 + ai * 128 + m * 16) * KP1 + col0;
#pragma unroll
        for (int bj = 0; bj < 2; ++bj) {
          const pg8::f32x4 v0 = acc[ai][bj][m][0], v1 = acc[ai][bj][m][1];
          u32x4 w; w.x = pk2(v0[0], v0[1]); w.y = pk2(v0[2], v0[3]); w.z = pk2(v1[0], v1[1]); w.w = pk2(v1[2], v1[3]);
          *(u32x4*)(rowp + bj * 128) = w;
        }
      }
  }
};
struct EpiFfnUp8 {
  static constexpr bool PERM = true, AFTER_DRAIN = false;
  u16* H;
  DI void operator()(const pg8::f32x4 (&acc)[2][2][4][2], const pg8::Unit& u, int wr, int wc, int fr, int fq) const {
    const int row0 = u.pm * 256 + wr * 64 + fr, col0 = u.pn * 128 + wc * 32 + 8 * fq;
#pragma unroll
    for (int ai = 0; ai < 2; ++ai)
#pragma unroll
      for (int m = 0; m < 4; ++m) {
        float o[8];
#pragma unroll
        for (int n = 0; n < 2; ++n)
#pragma unroll
          for (int j = 0; j < 4; ++j) {
            const float g = acc[ai][0][m][n][j], up = acc[ai][1][m][n][j];
            o[n * 4 + j] = g * __builtin_amdgcn_rcpf(1.f + __builtin_amdgcn_exp2f(-1.4426950408889634f * g)) * up;
          }
        u32x4 w; w.x = pk2(o[0], o[1]); w.y = pk2(o[2], o[3]); w.z = pk2(o[4], o[5]); w.w = pk2(o[6], o[7]);
        *(u32x4*)(H + (size_t)(row0 + ai * 128 + m * 16) * KP2 + col0) = w;
      }
  }
};
struct EpiGate8 {
  static constexpr bool PERM = true, AFTER_DRAIN = false;
  unsigned char* G8;
  DI void operator()(const pg8::f32x4 (&acc)[2][2][4][2], const pg8::Unit& u, int wr, int wc, int fr, int fq) const {
    const int row0 = u.pm * 256 + wr * 64 + fr, col0 = u.pn * 256 + wc * 32 + 8 * fq;
#pragma unroll
    for (int ai = 0; ai < 2; ++ai)
#pragma unroll
      for (int m = 0; m < 4; ++m)
#pragma unroll
        for (int bj = 0; bj < 2; ++bj) {
          uint2 pk = {0u, 0u};
#pragma unroll
          for (int j = 0; j < 4; ++j) {
            const float a = __builtin_amdgcn_rcpf(1.f + __builtin_amdgcn_exp2f(-1.4426950408889634f * acc[ai][bj][m][0][j]));
            const float b = __builtin_amdgcn_rcpf(1.f + __builtin_amdgcn_exp2f(-1.4426950408889634f * acc[ai][bj][m][1][j]));
            pk.x |= (unsigned)(a * 255.f + 0.5f) << (8 * j);
            pk.y |= (unsigned)(b * 255.f + 0.5f) << (8 * j);
          }
          *(uint2*)(G8 + (size_t)(row0 + ai * 128 + m * 16) * GP + col0 + bj * 128) = pk;
        }
  }
};
struct EpiProj8 {
  static constexpr bool PERM = false, AFTER_DRAIN = false;
  const Params* Pp; int layer;
  static DI void rope32q(float (&b)[8], const float2* __restrict__ tab, int fq) {
#pragma unroll
    for (int j = 0; j < 4; ++j) {
      const float2 cs = tab[4 * fq + j];
      const float x1 = b[j], x2 = b[4 + j];
      b[j] = x1 * cs.x - x2 * cs.y;
      b[4 + j] = x2 * cs.x + x1 * cs.y;
    }
  }
  static DI void st8(u16* __restrict__ base, int ld, int col0, const float (&b)[8], int tok, int fq) {
#pragma unroll
    for (int n = 0; n < 2; ++n) {
      uint2 pk; pk.x = pk2(b[4 * n], b[4 * n + 1]); pk.y = pk2(b[4 * n + 2], b[4 * n + 3]);
      *(uint2*)(base + (size_t)tok * ld + col0 + 16 * n + 4 * fq) = pk;
    }
  }
  static DI void stT8(u16* __restrict__ base, int row0, const float (&b)[8], int tok, int fq) {
    const int tp = (tok & ~12) | ((tok & 4) << 1) | ((tok & 8) >> 1);
#pragma unroll
    for (int n = 0; n < 2; ++n)
#pragma unroll
      for (int j = 0; j < 4; ++j) {
        const int row = row0 + 16 * n + 4 * fq + j;
        base[(size_t)(row >> 6) * 64 * T + (size_t)(tp >> 7) * 8192 + (row & 63) * 128 + (tp & 127)] = f2bf(b[4 * n + j]);
      }
  }
  DI void operator()(const pg8::f32x4 (&acc)[2][2][4][2], const pg8::Unit& u, int wr, int wc, int fr, int fq_in) const {
    const Params& P = *Pp;
    char* ws = P.ws;
    u16* qkv = (u16*)(ws + OFF_QKV);
    const float2* R64 = (const float2*)(ws + OFF_R64);
    const float2* R32 = (const float2*)(ws + OFF_R32);
    float* SS = (float*)(ws + OFF_SS);
    const int fbase = u.pn * 256 + wc * 64;
    if (fbase >= 2496) return;
#pragma unroll
    for (int ai = 0; ai < 2; ++ai)
#pragma unroll
      for (int m = 0; m < 4; ++m) {
        int fqv = fq_in; asm volatile("" : "+v"(fqv));
        const int fq = fqv;
        const int tok = u.pm * 256 + ai * 128 + wr * 64 + m * 16 + fr;
        const int pos = pos_of(tok);
        float b0[8], b1[8];
#pragma unroll
        for (int n = 0; n < 2; ++n)
#pragma unroll
          for (int j = 0; j < 4; ++j) { b0[4 * n + j] = acc[ai][0][m][n][j]; b1[4 * n + j] = acc[ai][1][m][n][j]; }
        if (fbase < 384) {
          const bool isK = fbase >= 256;
          const float* g = P.a_qk_norm + layer * 128 + (isK ? 64 : 0);
          float ss = 0.f;
#pragma unroll
          for (int k = 0; k < 8; ++k) ss += b0[k] * b0[k] + b1[k] * b1[k];
          ss += __shfl_xor(ss, 16);
          ss += __shfl_xor(ss, 32);
          const float rs = rsqrtf(ss * (1.f / 64.f) + EPS);
#pragma unroll
          for (int n = 0; n < 2; ++n)
#pragma unroll
            for (int j = 0; j < 4; ++j) {
              b0[4 * n + j] *= rs * g[16 * n + 4 * fq + j];
              b1[4 * n + j] *= rs * g[32 + 16 * n + 4 * fq + j];
            }
          rope32q(b0, R32 + (size_t)(pos >> 6) * 16, fq);
          rope32q(b1, R32 + (size_t)(pos & 63) * 16, fq);
          u16* dst = qkv + (isK ? Q_KA : Q_QA);
          const int ld = isK ? 128 : 256, c0 = isK ? fbase - 256 : fbase;
          st8(dst, ld, c0, b0, tok, fq);
          st8(dst, ld, c0 + 32, b1, tok, fq);
        } else if (fbase < 512) {
          stT8(qkv + Q_VTA, fbase - 384, b0, tok, fq);
          stT8(qkv + Q_VTA, fbase - 384 + 32, b1, tok, fq);
        } else if (fbase < 896) {
          const bool isK = fbase >= 768;
          const float2* tab = R64 + (size_t)pos * 32;
#pragma unroll
          for (int n = 0; n < 2; ++n)
#pragma unroll
            for (int j = 0; j < 4; ++j) {
              const float2 cs = tab[16 * n + 4 * fq + j];
              const float x1 = b0[4 * n + j], x2 = b1[4 * n + j];
              b0[4 * n + j] = x1 * cs.x - x2 * cs.y;
              b1[4 * n + j] = x2 * cs.x + x1 * cs.y;
            }
          u16* dst = qkv + (isK ? Q_KB : Q_QB);
          const int ld = isK ? 128 : 256, c0 = isK ? fbase - 768 : fbase - 512;
          st8(dst, ld, c0, b0, tok, fq);
          st8(dst, ld, c0 + 32, b1, tok, fq);
        } else if (fbase < 1024) {
          stT8(qkv + Q_VTB, fbase - 896, b0, tok, fq);
          stT8(qkv + Q_VTB, fbase - 896 + 32, b1, tok, fq);
        } else if (fbase < 1664) {
          const bool isKV = fbase >= 1408;
          u16* dst = qkv + (isKV ? Q_CKV : Q_CQ);
          const int ld = isKV ? 256 : 384, c0 = isKV ? fbase - 1408 : fbase - 1024;
          const int sb = (isKV ? 12 : 0) + (c0 >> 5);
          float s0 = 0.f, s1 = 0.f;
#pragma unroll
          for (int k = 0; k < 8; ++k) { s0 += b0[k] * b0[k]; s1 += b1[k] * b1[k]; }
          s0 += __shfl_xor(s0, 16); s0 += __shfl_xor(s0, 32);
          s1 += __shfl_xor(s1, 16); s1 += __shfl_xor(s1, 32);
          if (fq == 0) { SS[(size_t)tok * 20 + sb] = s0; SS[(size_t)tok * 20 + sb + 1] = s1; }
          st8(dst, ld, c0, b0, tok, fq);
          st8(dst, ld, c0 + 32, b1, tok, fq);
        } else if (fbase < 2176) {
          const bool isK = fbase >= 1920;
          u16* dst = qkv + (isK ? Q_KD : Q_QD);
          const int c0 = isK ? fbase - 1920 : fbase - 1664;
          rope32q(b0, R32 + (size_t)pos * 16, fq);
          rope32q(b1, R32 + (size_t)pos * 16, fq);
          st8(dst, 256, c0, b0, tok, fq);
          st8(dst, 256, c0 + 32, b1, tok, fq);
        } else if (fbase < 2432) {
          stT8(qkv + Q_VTD, fbase - 2176, b0, tok, fq);
          stT8(qkv + Q_VTD, fbase - 2176 + 32, b1, tok, fq);
        } else {
          rope32q(b0, R32 + (size_t)pos * 16, fq);
#pragma unroll
          for (int hd = 0; hd < 4; ++hd) st8(qkv + Q_KC, 384, hd * 96 + 64, b0, tok, fq);
        }
        __builtin_amdgcn_sched_barrier(0);
      }
  }
};
struct SimpleOrder {
  int nN, nwg, G, c;
  DI bool next(int i, pg8::Unit& u) const {
    const int L = i * G + c;
    if (L >= nwg) return false;
    const int rest = L >> 4;
    u.pn = rest % nN;
    u.pm = (rest / nN) * 16 + (L & 15);
    return true;
  }
  DI void a_ready(const pg8::Unit&) const {}
  DI void done(const pg8::Unit&) const {}
};
template <int N, int K, int LD, class Epi>
DI void gemm8_phase(const u16* X, const u16* Wt, const Epi& E, char* smem) {
  pg8::Gemm g; g.A = X; g.Bt = Wt; g.M = T; g.N = N; g.K = K; g.ld = LD;
  int bid_ = (int)blockIdx.x; asm volatile("" : "+s"(bid_));
  SimpleOrder S; S.nN = N / 256; S.nwg = (T / 256) * (N / 256); S.G = (int)gridDim.x; S.c = bid_;
  pg8::gemm_phase<Epi, SimpleOrder, false, K, LD>((PG8_LAS unsigned char*)smem, g, S, E, nullptr);
}

template <int DQK, int NCOMP, bool BAND, int EPI>
DI void attn_item(const u16* __restrict__ Q, int ldq, const u16* __restrict__ Kp, int ldk, const u16* __restrict__ Vt,
                  int qtok0, int kbeg, int kend, float sc_l2, float sink_l2, float lam, float onorm,
                  const float* __restrict__ subg, u16* __restrict__ O, float* __restrict__ DS, char* smem) {
  constexpr int DC = DQK / NCOMP;
  constexpr int KS = DC / 16;
  constexpr int KEYS = (NCOMP == 1) ? 128 : 64;
  constexpr int KSTR = DQK + 8, VSTR = KEYS + 8;
  constexpr int KCH = DQK / 8, VCH = KEYS / 8;
  constexpr int NKC = KEYS * KCH / NTHR, NVC = 64 * VCH / NTHR;
  constexpr int KSLOT = KEYS * KSTR, VSLOT = 64 * VSTR;
  u16* sK = (u16*)smem;
  u16* sV = sK + 3 * KSLOT;
  const int tid = opaque_tid(), lane = tid & 63, wave = tid >> 6, r = lane & 31, h = lane >> 5;
  const int qtok = qtok0 + wave * 32 + r;

  bf16x8 qf[NCOMP][KS];
#pragma unroll
  for (int c = 0; c < NCOMP; ++c)
#pragma unroll
    for (int ks = 0; ks < KS; ++ks) qf[c][ks] = *(const bf16x8*)(Q + (size_t)qtok * ldq + c * DC + ks * 16 + 8 * h);

  f32x16 Oa[NCOMP][2];
  float m[NCOMP], l[NCOMP];
#pragma unroll
  for (int c = 0; c < NCOMP; ++c) {
#pragma unroll
    for (int d = 0; d < 2; ++d)
#pragma unroll
      for (int v = 0; v < 16; ++v) Oa[c][d][v] = 0.f;
    m[c] = BAND ? sink_l2 : -1e30f;
    l[c] = (BAND && h == 0) ? 1.f : 0.f;
  }

  const u16* kg[NKC]; int kso[NKC];
#pragma unroll
  for (int i = 0; i < NKC; ++i) {
    const int c = tid + i * NTHR;
    const int row = c / KCH, cc = c % KCH;
    kg[i] = Kp + (size_t)(kbeg + row) * ldk + cc * 8;
    kso[i] = row * KSTR + cc * 8;
  }
  const u16* vg[NVC]; int vso[NVC];
#pragma unroll
  for (int i = 0; i < NVC; ++i) {
    const int c = tid + i * NTHR;
    const int row = c / VCH, cc = c % VCH;
    vg[i] = Vt + (size_t)(kbeg >> 7) * 8192 + row * 128 + cc * 8;
    vso[i] = row * VSTR + cc * 8;
  }
  u32x4 kreg[NKC], vreg[NVC];
  auto loadK = [&](int t) {
#pragma unroll
    for (int i = 0; i < NKC; ++i) kreg[i] = gld16(kg[i] + (size_t)t * KEYS * ldk);
  };
  auto loadV = [&](int t) {
#pragma unroll
    for (int i = 0; i < NVC; ++i) vreg[i] = gld16(vg[i] + (size_t)t * 8192);
  };
  auto waitK = [&]() {
    if constexpr (NKC == 1) wait_vm0(kreg[0]);
    else if constexpr (NKC == 2) wait_vm0(kreg[0], kreg[1]);
    else wait_vm0(kreg[0], kreg[1], kreg[2]);
  };
  auto waitV = [&]() {
    if constexpr (NVC == 1) wait_vm0(vreg[0]);
    else wait_vm0(vreg[0], vreg[1]);
  };
  auto storeK = [&](int slot) {
#pragma unroll
    for (int i = 0; i < NKC; ++i) *(u32x4*)(sK + slot * KSLOT + kso[i]) = kreg[i];
  };
  auto storeV = [&](int slot) {
#pragma unroll
    for (int i = 0; i < NVC; ++i) *(u32x4*)(sV + slot * VSLOT + vso[i]) = vreg[i];
  };

  f32x16 S0[2], S1[2];
  bf16x8 pfA[2][2], pfB[2][2];
  float alpha_pend = 1.f;
  bool need_pend = false;

  auto att_S = [&](auto uu_t, f32x16 (&S)[2], int slot) {
    constexpr int UU = decltype(uu_t)::value;
    constexpr int C = (NCOMP == 2) ? UU : 0;
    const u16* base = sK + slot * KSLOT + ((NCOMP == 1 ? UU * 64 : 0) + r) * KSTR + (NCOMP == 2 ? UU * DC : 0) + 8 * h;
#pragma unroll
    for (int kb = 0; kb < 2; ++kb) {
#pragma unroll
      for (int v = 0; v < 16; ++v) S[kb][v] = 0.f;
#pragma unroll
      for (int ks = 0; ks < KS; ++ks) {
        bf16x8 kf = *(const bf16x8*)(base + kb * 32 * KSTR + ks * 16);
        S[kb] = MFMA32(kf, qf[C][ks], S[kb]);
      }
    }
  };
  auto att_PV = [&](auto uu_t, const bf16x8 (&pf)[2][2], int slot) {
    constexpr int UU = decltype(uu_t)::value;
    constexpr int C = (NCOMP == 2) ? UU : 0;
    const u16* base = sV + slot * VSLOT + r * VSTR + (NCOMP == 1 ? UU * 64 : 0) + 8 * h;
#pragma unroll
    for (int d = 0; d < 2; ++d)
#pragma unroll
      for (int kb = 0; kb < 2; ++kb)
#pragma unroll
        for (int s = 0; s < 2; ++s) {
          bf16x8 vf = *(const bf16x8*)(base + d * 32 * VSTR + kb * 32 + 16 * s);
          Oa[C][d] = MFMA32(vf, pf[kb][s], Oa[C][d]);
        }
  };
  auto att_rescale = [&](auto uu_t) {
    constexpr int UU = decltype(uu_t)::value;
    constexpr int C = (NCOMP == 2) ? UU : 0;
    if (need_pend) {
#pragma unroll
      for (int d = 0; d < 2; ++d)
#pragma unroll
        for (int v = 0; v < 16; ++v) Oa[C][d][v] *= alpha_pend;
    }
  };
  auto att_softmax = [&](auto uu_t, f32x16 (&S)[2], bf16x8 (&pf)[2][2], int kpos0) {
    constexpr int UU = decltype(uu_t)::value;
    constexpr int C = (NCOMP == 2) ? UU : 0;
    if constexpr (BAND) {
#pragma unroll
      for (int kb = 0; kb < 2; ++kb)
#pragma unroll
        for (int v = 0; v < 16; ++v) {
          const int d = kpos0 + kb * 32 + crow(v, h) - qtok;
          if (d > 128 || d < -128) S[kb][v] = -1e30f;
        }
    }
    float mx = S[0][0];
#pragma unroll
    for (int kb = 0; kb < 2; ++kb)
#pragma unroll
      for (int v = 0; v < 16; ++v) mx = fmaxf(mx, S[kb][v]);
    mx = fmaxf(mx, __shfl_xor(mx, 32));
    const float mold = m[C];
    const float mnew = fmaxf(mold, mx * sc_l2);
    need_pend = __builtin_amdgcn_ballot_w64(mnew > mold) != 0;
    alpha_pend = __builtin_amdgcn_exp2f(mold - mnew);
    m[C] = mnew;
    float rsum = 0.f;
#pragma unroll
    for (int kb = 0; kb < 2; ++kb)
#pragma unroll
      for (int v = 0; v < 16; ++v) {
        float p = __builtin_amdgcn_exp2f(__builtin_fmaf(S[kb][v], sc_l2, -mnew));
        S[kb][v] = p;
        rsum += p;
      }
    l[C] = l[C] * alpha_pend + rsum;
#pragma unroll
    for (int kb = 0; kb < 2; ++kb)
#pragma unroll
      for (int s = 0; s < 2; ++s) {
        u32x4 pk;
        pk.x = pk2(S[kb][8 * s + 0], S[kb][8 * s + 1]);
        pk.y = pk2(S[kb][8 * s + 2], S[kb][8 * s + 3]);
        pk.z = pk2(S[kb][8 * s + 4], S[kb][8 * s + 5]);
        pk.w = pk2(S[kb][8 * s + 6], S[kb][8 * s + 7]);
        pf[kb][s] = __builtin_bit_cast(bf16x8, pk);
      }
  };
  using U0 = std::integral_constant<int, 0>;
  using U1 = std::integral_constant<int, 1>;

  const int ntl = (kend - kbeg) / KEYS;
  auto step = [&](auto first_t, auto lk_t, auto lv_t, int t, int sa, int sb, int sc) {
    constexpr bool FIRST = decltype(first_t)::value, LK = decltype(lk_t)::value, LV = decltype(lv_t)::value;
    if constexpr (LK) loadK(t + 2);
    if constexpr (LV) loadV(t + 1);
    if constexpr (!FIRST) att_rescale(U1{});
    att_S(U1{}, S1, sa);
    if constexpr (!FIRST) att_PV(U1{}, pfB, sc);
    att_softmax(U0{}, S0, pfA, kbeg + t * KEYS);
    att_rescale(U0{});
    if constexpr (LV) att_S(U0{}, S0, sb);
    att_PV(U0{}, pfA, sa);
    att_softmax(U1{}, S1, pfB, kbeg + t * KEYS + 64);
    if constexpr (LK) { waitK(); storeK(sc); }
    if constexpr (LV) { waitV(); storeV(sb); }
    __syncthreads();
  };
  using TT = std::true_type;
  using FF = std::false_type;

  loadK(0); loadV(0);
  waitK(); waitV();
  storeK(0); storeV(0);
  loadK(1);
  waitK();
  storeK(1);
  __syncthreads();
  att_S(U0{}, S0, 0);
  int sa = 0, sb = 1, sc = 2;
  step(TT{}, TT{}, TT{}, 0, sa, sb, sc);
  { int tmp = sa; sa = sb; sb = sc; sc = tmp; }
  for (int t = 1; t < ntl - 2; ++t) {
    step(FF{}, TT{}, TT{}, t, sa, sb, sc);
    int tmp = sa; sa = sb; sb = sc; sc = tmp;
  }
  step(FF{}, FF{}, TT{}, ntl - 2, sa, sb, sc);
  { int tmp = sa; sa = sb; sb = sc; sc = tmp; }
  step(FF{}, FF{}, FF{}, ntl - 1, sa, sb, sc);
  att_rescale(U1{});
  att_PV(U1{}, pfB, sa);

  float inv[NCOMP];
#pragma unroll
  for (int c = 0; c < NCOMP; ++c) {
    float lt = l[c] + __shfl_xor(l[c], 32);
    inv[c] = 1.f / lt;
  }
  if constexpr (EPI == 1) {
#pragma unroll
    for (int d = 0; d < 2; ++d)
#pragma unroll
      for (int vq = 0; vq < 4; ++vq) {
        float4 o = {Oa[0][d][4 * vq] * inv[0], Oa[0][d][4 * vq + 1] * inv[0], Oa[0][d][4 * vq + 2] * inv[0], Oa[0][d][4 * vq + 3] * inv[0]};
        *(float4*)(DS + (size_t)qtok * 256 + d * 32 + 8 * vq + 4 * h) = o;
      }
  } else {
    if constexpr (EPI == 2) {
      float ss = 0.f;
#pragma unroll
      for (int d = 0; d < 2; ++d)
#pragma unroll
        for (int vq = 0; vq < 4; ++vq) {
          const float4 o1 = *(const float4*)(DS + (size_t)qtok * 256 + d * 32 + 8 * vq + 4 * h);
          const float a0 = o1.x - lam * Oa[0][d][4 * vq] * inv[0];
          const float a1 = o1.y - lam * Oa[0][d][4 * vq + 1] * inv[0];
          const float a2 = o1.z - lam * Oa[0][d][4 * vq + 2] * inv[0];
          const float a3 = o1.w - lam * Oa[0][d][4 * vq + 3] * inv[0];
          Oa[0][d][4 * vq] = a0; Oa[0][d][4 * vq + 1] = a1; Oa[0][d][4 * vq + 2] = a2; Oa[0][d][4 * vq + 3] = a3;
          ss += a0 * a0 + a1 * a1 + a2 * a2 + a3 * a3;
        }
      ss += __shfl_xor(ss, 32);
      const float rs = rsqrtf(ss * (1.f / 64.f) + EPS) * onorm;
#pragma unroll
      for (int d = 0; d < 2; ++d)
#pragma unroll
        for (int v = 0; v < 16; ++v) Oa[0][d][v] *= rs * subg[d * 32 + crow(v, h)];
    } else {
#pragma unroll
      for (int d = 0; d < 2; ++d)
#pragma unroll
        for (int v = 0; v < 16; ++v) Oa[0][d][v] *= inv[0];
    }
    store_rows(O, KP1, 0, Oa[0][0], qtok, h);
    store_rows(O, KP1, 32, Oa[0][1], qtok, h);
  }
  __syncthreads();
}

DI void attn_phase(const Params& P, int layer, char* smem) {
  char* ws = P.ws;
  u16* qkv = (u16*)(ws + OFF_QKV);
  u16* BR = (u16*)(ws + OFF_XN);
  const float L2E = 1.4426950408889634f;
  const float lambda_init = 0.8f - 0.6f * __expf(-0.3f * (float)layer);
  float lam;
  {
    const float* dl = P.d_lambda + layer * 128;
    float s1 = 0.f, s2 = 0.f;
    for (int i = 0; i < 32; ++i) { s1 += dl[i] * dl[32 + i]; s2 += dl[64 + i] * dl[96 + i]; }
    lam = __expf(s1) - __expf(s2) + lambda_init;
    lam = __int_as_float(__builtin_amdgcn_readfirstlane(__float_as_int(lam)));
  }
  const float onorm_u = __int_as_float(__builtin_amdgcn_readfirstlane(__float_as_int(1.f - lambda_init)));
  for (int it = blockIdx.x; it < 2048; it += gridDim.x) {
    const int cls = it >> 8;
    if (cls < 6) {
      const int idx = it & 255;
      const int head = (idx & 7) >> 1;
      const int qb = ((idx >> 3) << 1) + (idx & 1);
      int qtok0, kbeg, kend;
      if (cls < 3) { qtok0 = qb * 256; kbeg = 0; kend = SEQ0; }
      else { const int s = qb >> 3; kbeg = SEQ0 + s * DSEQ; kend = kbeg + DSEQ; qtok0 = kbeg + (qb & 7) * 256; }
      const int typ = cls % 3;
      if (typ == 0) {
        float* DS = (float*)(ws + OFF_DS) + head * 64;
        attn_item<32, 1, false, 1>(qkv + Q_QD + head * 64, 256, qkv + Q_KD + head * 64, 256,
                                   qkv + Q_VTD + (size_t)head * 64 * T, qtok0, kbeg, kend,
                                   0.17677669529663687f * L2E, 0.f, lam, onorm_u,
                                   P.d_subln + layer * 64, BR + 768 + head * 64, DS, smem);
        attn_item<32, 1, false, 2>(qkv + Q_QD + head * 64 + 32, 256, qkv + Q_KD + head * 64 + 32, 256,
                                   qkv + Q_VTD + (size_t)head * 64 * T, qtok0, kbeg, kend,
                                   0.17677669529663687f * L2E, 0.f, lam, onorm_u,
                                   P.d_subln + layer * 64, BR + 768 + head * 64, DS, smem);
      } else if (typ == 1) {
        attn_item<96, 1, false, 0>(qkv + Q_QC + head * 96, 384, qkv + Q_KC + head * 96, 384,
                                       qkv + Q_VTC + (size_t)head * 64 * T, qtok0, kbeg, kend,
                                       0.10206207261596577f * L2E, 0.f, 0.f, 1.f, nullptr, BR + 512 + head * 64, nullptr, smem);
      } else {
        attn_item<64, 1, false, 0>(qkv + Q_QA + head * 64, 256, qkv + Q_KA + (head >> 1) * 64, 128,
                                       qkv + Q_VTA + (size_t)(head >> 1) * 64 * T, qtok0, kbeg, kend,
                                       0.125f * L2E, 0.f, 0.f, 1.f, nullptr, BR + head * 64, nullptr, smem);
      }
    } else {
      const int idx = it - 1536;
      const int head = (idx & 7) >> 1;
      const int qbg = ((idx >> 3) << 1) + (idx & 1);
      const int qtok0 = qbg * 256;
      int sb, se;
      if (qtok0 < SEQ0) { sb = 0; se = SEQ0; }
      else { sb = SEQ0 + ((qtok0 - SEQ0) / DSEQ) * DSEQ; se = sb + DSEQ; }
      const int kbeg = max(sb, qtok0 - 128), kend = min(se, qtok0 + 256 + 128);
      const float sink = P.b_sink[layer * 4 + head];
      attn_item<64, 1, true, 0>(qkv + Q_QB + head * 64, 256, qkv + Q_KB + (head >> 1) * 64, 128,
                                    qkv + Q_VTB + (size_t)(head >> 1) * 64 * T, qtok0, kbeg, kend,
                                    0.125f * L2E, sink * L2E, 0.f, 1.f, nullptr, BR + 256 + head * 64, nullptr, smem);
    }
  }
}

DI void ew_phase(const Params& P, const u16* __restrict__ Y, float coef, const float* __restrict__ gpost,
                 const float* __restrict__ gnext, bool from_inputs) {
  const int tid = opaque_tid();
  const int lane = tid & 63, wave = tid >> 6;
  u16* XN = (u16*)(P.ws + OFF_XN);
  u16* XB = (u16*)(P.ws + OFF_XB);
  for (int tok = blockIdx.x * 8 + wave; tok < T; tok += gridDim.x * 8) {
    float4 x[4];
    if (from_inputs) {
      const float* xs = tok < SEQ0 ? P.x_prompt + (size_t)tok * DM : P.x_sample + (size_t)(tok - SEQ0) * DM;
#pragma unroll
      for (int i = 0; i < 4; ++i) x[i] = *(const float4*)(xs + (i * 64 + lane) * 4);
    } else {
#pragma unroll
      for (int i = 0; i < 4; ++i) {
        const uint2 xb = *(const uint2*)(XB + (size_t)tok * DM + (i * 64 + lane) * 4);
        x[i] = make_float4(bf2f(xb.x & 0xffffu), bf2f(xb.x >> 16), bf2f(xb.y & 0xffffu), bf2f(xb.y >> 16));
      }
    }
    if (Y) {
      float4 y[4];
      float ss = 0.f;
#pragma unroll
      for (int i = 0; i < 4; ++i) {
        const uint2 yb = *(const uint2*)(Y + (size_t)tok * KP1 + (i * 64 + lane) * 4);
        y[i] = make_float4(bf2f(yb.x & 0xffffu), bf2f(yb.x >> 16), bf2f(yb.y & 0xffffu), bf2f(yb.y >> 16));
        ss += y[i].x * y[i].x + y[i].y * y[i].y + y[i].z * y[i].z + y[i].w * y[i].w;
      }
      ss = wave_sum(ss);
      const float rs = rsqrtf(ss * (1.f / 1024.f) + EPS) * coef;
#pragma unroll
      for (int i = 0; i < 4; ++i) {
        float4 g = *(const float4*)(gpost + (i * 64 + lane) * 4);
        x[i].x += y[i].x * rs * g.x; x[i].y += y[i].y * rs * g.y;
        x[i].z += y[i].z * rs * g.z; x[i].w += y[i].w * rs * g.w;
      }
    }
    if (!gnext) {
#pragma unroll
      for (int i = 0; i < 4; ++i) *(float4*)(P.out + (size_t)tok * DM + (i * 64 + lane) * 4) = x[i];
    } else {
#pragma unroll
      for (int i = 0; i < 4; ++i) {
        uint2 pk;
        pk.x = pk2(x[i].x, x[i].y);
        pk.y = pk2(x[i].z, x[i].w);
        *(uint2*)(XB + (size_t)tok * DM + (i * 64 + lane) * 4) = pk;
      }
    }
    if (gnext) {
      float ss = 0.f;
#pragma unroll
      for (int i = 0; i < 4; ++i) ss += x[i].x * x[i].x + x[i].y * x[i].y + x[i].z * x[i].z + x[i].w * x[i].w;
      ss = wave_sum(ss);
      const float rs = rsqrtf(ss * (1.f / 1024.f) + EPS);
#pragma unroll
      for (int i = 0; i < 4; ++i) {
        float4 g = *(const float4*)(gnext + (i * 64 + lane) * 4);
        uint2 pk;
        pk.x = pk2(x[i].x * rs * g.x, x[i].y * rs * g.y);
        pk.y = pk2(x[i].z * rs * g.z, x[i].w * rs * g.w);
        *(uint2*)(XN + (size_t)tok * KP1 + (i * 64 + lane) * 4) = pk;
      }
    }
  }
}

DI int colmap(int mode, int n, int nsrc) {
  if (mode == 1) { return ((n >> 7) & 1) * DFF + (n >> 8) * 128 + (n & 127); }
  if (mode == 2) {
    if (n < 2560) {
      const int w = n & 255;
      n = (n & ~255) + ((w >> 5) & 3) * 64 + (w >> 7) * 32 + (w & 31);
    }
    if (n < 1664) return n;
    if (n < 2432) return n + 32;
    if (n < 2464) return n - 2432 + 1664;
    if (n < 2560) return -1;
    return n - 96;
  }
  return n < nsrc ? n : -1;
}
DI void conv_job(u16* __restrict__ dst, int ldd, const float* __restrict__ src, int Nd, int K, int lds, int mode,
                 const float* __restrict__ kscale) {
  const int total = Nd * (K >> 3);
  const int gthreads = gridDim.x * NTHR;
  for (int idx = blockIdx.x * NTHR + opaque_tid(); idx < total; idx += gthreads) {
    const int n = idx % Nd, k8 = idx / Nd;
    const int col = colmap(mode, n, lds);
    float v[8];
#pragma unroll
    for (int j = 0; j < 8; ++j) {
      float x = 0.f;
      if (col >= 0) {
        x = src[(size_t)(k8 * 8 + j) * lds + col];
        if (kscale) x *= kscale[k8 * 8 + j];
      }
      v[j] = x;
    }
    uint4 pk = {pk2(v[0], v[1]), pk2(v[2], v[3]), pk2(v[4], v[5]), pk2(v[6], v[7])};
    *(uint4*)(dst + (size_t)n * ldd + k8 * 8) = pk;
  }
}
DI void convert_layer(const Params& P, int l) {
  u16* W = (u16*)(P.ws + OFF_W);
  for (int s = 0; s < 2; ++s) {
    conv_job(W + W_WI + (size_t)s * 5632 * KP1, KP1, P.ffn_wi + ((size_t)l * 2 + s) * 1024 * 5632, 5632, 1024, 5632, 1, nullptr);
    conv_job(W + W_WO + (size_t)s * 1024 * KP2, KP2, P.ffn_wo + ((size_t)l * 2 + s) * 2816 * 1024, 1024, 2816, 1024, 0, nullptr);
  }
  conv_job(W + W_WIN, KP1, P.w_in + (size_t)l * 1024 * NPROJ, 6656, 1024, NPROJ, 2, nullptr);
  conv_job(W + W_WUQ, 384, P.c_w_uq + (size_t)l * 384 * 384, 512, 384, 384, 0, P.c_q_norm + l * 384);
  conv_job(W + W_WUKV, 256, P.c_w_ukv + (size_t)l * 256 * 512, 512, 256, 512, 0, P.c_kv_norm + l * 256);
  conv_job(W + W_WB, KP1, P.w_branch + (size_t)l * 1024 * 1024, 1024, 1024, 1024, 0, nullptr);
  conv_job(W + W_WOUT, KP1, P.w_out + (size_t)l * 1024 * 1024, 1024, 1024, 1024, 0, nullptr);
}
DI void rope_tables(const Params& P) {
  float2* R64 = (float2*)(P.ws + OFF_R64);
  float2* R32 = (float2*)(P.ws + OFF_R32);
  const int gthreads = gridDim.x * NTHR;
  for (int idx = blockIdx.x * NTHR + opaque_tid(); idx < 16384 * 48; idx += gthreads) {
    int pos, f; double base; float2* dst;
    if (idx < 16384 * 32) { pos = idx >> 5; f = idx & 31; base = 0.7498942093324559; dst = R64 + idx; }
    else { const int i2 = idx - 16384 * 32; pos = i2 >> 4; f = i2 & 15; base = 0.5623413251903491; dst = R32 + i2; }
    double inv = 1.0;
    for (int k = 0; k < f; ++k) inv *= base;
    const float ang = (float)pos * (float)inv;
    double tr = (double)ang * 0.15915494309189535;
    tr -= rint(tr);
    const float tf = (float)tr;
    *dst = make_float2(__builtin_amdgcn_cosf(tf), __builtin_amdgcn_sinf(tf));
  }
}

DI void fast_grid_barrier(unsigned* bar, unsigned nblk) {
  asm volatile("s_waitcnt vmcnt(0) lgkmcnt(0)" ::: "memory");
  __syncthreads();
  if (threadIdx.x == 0) {
    __builtin_amdgcn_fence(__ATOMIC_RELEASE, "agent");
    asm volatile("s_waitcnt vmcnt(0) lgkmcnt(0)" ::: "memory");
    const unsigned gen = __hip_atomic_load(&bar[64], __ATOMIC_RELAXED, __HIP_MEMORY_SCOPE_AGENT);
    const unsigned old = __hip_atomic_fetch_add(&bar[0], 1u, __ATOMIC_RELAXED, __HIP_MEMORY_SCOPE_AGENT);
    if (old == nblk - 1u) {
      __hip_atomic_store(&bar[0], 0u, __ATOMIC_RELAXED, __HIP_MEMORY_SCOPE_AGENT);
      __hip_atomic_fetch_add(&bar[64], 1u, __ATOMIC_RELEASE, __HIP_MEMORY_SCOPE_AGENT);
    } else {
      while (__hip_atomic_load(&bar[64], __ATOMIC_RELAXED, __HIP_MEMORY_SCOPE_AGENT) == gen) __builtin_amdgcn_s_sleep(1);
    }
    __builtin_amdgcn_fence(__ATOMIC_ACQUIRE, "agent");
    asm volatile("s_waitcnt vmcnt(0) lgkmcnt(0)" ::: "memory");
  }
  __syncthreads();
}

__global__ void __launch_bounds__(NTHR) __attribute__((amdgpu_waves_per_eu(2, 2))) mega(Params P) {
  extern __shared__ __attribute__((aligned(16))) char smem[];
  cg::grid_group grid = cg::this_grid();
  int phase = 0;
#if MULTI_LAUNCH
#define ACTIVE() (phase >= P.phase_lo && phase < P.phase_hi)
#define SEAM() do { ++phase; } while (0)
#else
#define ACTIVE() (true)
#define SEAM() do { ++phase; if (phase == 1) grid.sync(); else fast_grid_barrier((unsigned*)(P.ws + OFF_BAR), gridDim.x); } while (0)
#endif
  u16* W = (u16*)(P.ws + OFF_W);
  u16* XN = (u16*)(P.ws + OFF_XN);
  u16* R2 = (u16*)(P.ws + OFF_R2);
  u16* qkv = (u16*)(P.ws + OFF_QKV);
  const u16* Y = qkv + Q_Y;
#define PTRS

  if (ACTIVE()) { PTRS
    rope_tables(P);
    convert_layer(P, 0);
    ew_phase(P, nullptr, 0.f, nullptr, P.norm_g, true);
  }
  SEAM();
  for (int l = 0; l < 4; ++l) {
    const float* g = P.norm_g + (size_t)l * 6 * DM;
    if (ACTIVE()) { PTRS gemm8_phase<5632, DM, KP1>(XN, W + W_WI, EpiFfnUp8{R2}, smem); }
    SEAM();
    if (ACTIVE()) { PTRS gemm8_phase<1024, DFF, KP2>(R2, W + W_WO, EpiY8{qkv + Q_Y}, smem); }
    SEAM();
    if (ACTIVE()) { PTRS ew_phase(P, Y, 0.5f, g + DM, g + 2 * DM, false); }
    SEAM();
    if (ACTIVE()) { PTRS
      gemm8_phase<2560, DM, KP1>(XN, W + W_WIN, EpiProj8{&P, l}, smem);
      gemm8_phase<4096, DM, KP1>(XN, W + W_WIN + 2560ull * KP1, EpiGate8{(unsigned char*)R2}, smem);
    }
    SEAM();
    if (ACTIVE()) { PTRS
      gemm_phase<M_CUQ, 4>(W + W_WUQ, 384, qkv + Q_CQ, 384, 384, 2, smem, P, l);
      gemm_phase<M_CUKV, 4>(W + W_WUKV, 256, qkv + Q_CKV, 256, 256, 2, smem, P, l);
    }
    SEAM();
    if (ACTIVE()) { PTRS attn_phase(P, l, smem); }
    SEAM();
    if (ACTIVE()) { PTRS gemm_phase<M_MERGE, 2>(W + W_WB, KP1, XN, KP1, DM, 4, smem, P, l); }
    SEAM();
    if (ACTIVE()) { PTRS gemm8_phase<1024, DM, KP1>(qkv + Q_MERGED, W + W_WOUT, EpiY8{qkv + Q_Y}, smem); }
    SEAM();
    if (ACTIVE()) { PTRS ew_phase(P, Y, 1.0f, g + 3 * DM, g + 4 * DM, false); }
    SEAM();
    if (ACTIVE()) { PTRS gemm8_phase<5632, DM, KP1>(XN, W + W_WI + 5632ull * KP1, EpiFfnUp8{R2}, smem); }
    SEAM();
    if (ACTIVE()) { PTRS gemm8_phase<1024, DFF, KP2>(R2, W + W_WO + 1024ull * KP2, EpiY8{qkv + Q_Y}, smem); }
    SEAM();
    if (ACTIVE()) { PTRS
      ew_phase(P, Y, 0.5f, g + 5 * DM, l < 3 ? g + 6 * DM : nullptr, false);
      if (l < 3) convert_layer(P, l + 1);
    }
    SEAM();
  }
}

constexpr int N_PHASES = 1 + 12 * 4;

extern "C" void kernel_launch(void* const* d_in, const int* in_sizes, int n_in, void* d_out, int out_size, void* d_ws,
                              size_t ws_size, hipStream_t stream) {
  static int grid_blocks = 0;
  if (!grid_blocks) {
    int dev = 0, cus = 0, per_cu = 0;
    hipGetDevice(&dev);
    hipDeviceGetAttribute(&cus, hipDeviceAttributeMultiprocessorCount, dev);
    hipFuncSetAttribute((const void*)mega, hipFuncAttributeMaxDynamicSharedMemorySize, SMEM_BYTES);
    hipOccupancyMaxActiveBlocksPerMultiprocessor(&per_cu, mega, NTHR, SMEM_BYTES);
    if (per_cu < 1) per_cu = 1;
    grid_blocks = cus * per_cu;
  }
  if (ws_size < WS_NEEDED) fprintf(stderr, "workspace too small: %zu < %zu\n", ws_size, (size_t)WS_NEEDED);
  Params P{};
  P.x_prompt = (const float*)d_in[0]; P.x_sample = (const float*)d_in[1]; P.norm_g = (const float*)d_in[2];
  P.w_in = (const float*)d_in[3]; P.a_qk_norm = (const float*)d_in[4]; P.b_sink = (const float*)d_in[5];
  P.c_q_norm = (const float*)d_in[6]; P.c_kv_norm = (const float*)d_in[7]; P.c_w_uq = (const float*)d_in[8];
  P.c_w_ukv = (const float*)d_in[9]; P.d_lambda = (const float*)d_in[10]; P.d_subln = (const float*)d_in[11];
  P.w_branch = (const float*)d_in[12]; P.w_out = (const float*)d_in[13]; P.ffn_wi = (const float*)d_in[14];
  P.ffn_wo = (const float*)d_in[15];
  P.out = (float*)d_out; P.ws = (char*)d_ws;
#if MULTI_LAUNCH
  for (int ph = 0; ph < N_PHASES; ++ph) {
    P.phase_lo = ph; P.phase_hi = ph + 1; P.coop = 0; P.pad0 = 0;
    hipLaunchKernelGGL(mega, dim3(grid_blocks), dim3(NTHR), SMEM_BYTES, stream, P);
  }
#else
  P.phase_lo = 0; P.phase_hi = 1 << 30; P.coop = 1; P.pad0 = 0;
  hipMemsetAsync((char*)d_ws + OFF_BAR, 0, 1024, stream);
  void* args[] = {&P};
  hipError_t e = hipLaunchCooperativeKernel((const void*)mega, dim3(grid_blocks), dim3(NTHR), args, SMEM_BYTES, stream);
  if (e != hipSuccess) fprintf(stderr, "cooperative launch failed: %s (grid %d)\n", hipGetErrorString(e), grid_blocks);
#endif
}
```

```cpp
#include <hip/hip_runtime.h>
#include <hip/hip_cooperative_groups.h>
#include <cstdio>
#include <cstdint>
#include <type_traits>
namespace cg = cooperative_groups;

#ifndef MULTI_LAUNCH
#define MULTI_LAUNCH 0
#endif

#define DI __device__ __forceinline__
typedef unsigned short u16;
typedef __attribute__((ext_vector_type(8))) short bf16x8;
typedef __attribute__((ext_vector_type(16))) float f32x16;
typedef __attribute__((ext_vector_type(2))) float f32x2_t;
typedef __attribute__((ext_vector_type(2))) __bf16 bf16x2_t;

constexpr int T = 32768;
constexpr int DM = 1024;
constexpr int DFF = 2816;
constexpr int KP1 = 1088;
constexpr int KP2 = 2880;
constexpr int GP = 4160;
constexpr int YP = 1040;
constexpr int NPROJ = 6560;
constexpr int SEQ0 = 16384;
constexpr int DSEQ = 2048;
constexpr float EPS = 1e-6f;
constexpr int NTHR = 512;
constexpr int LSTR = 72;
constexpr int SMEM_BYTES = 2 * 2 * 256 * LSTR * 2;

constexpr size_t W_WI = 0;
constexpr size_t W_WO = W_WI + 2ull * 5632 * KP1;
constexpr size_t W_WIN = W_WO + 2ull * 1024 * KP2;
constexpr size_t W_WUQ = W_WIN + 6656ull * KP1;
constexpr size_t W_WUKV = W_WUQ + 512ull * 384;
constexpr size_t W_WB = W_WUKV + 512ull * 256;
constexpr size_t W_WOUT = W_WB + 1024ull * KP1;
constexpr size_t W_TOTAL = W_WOUT + 1024ull * KP1;

constexpr size_t OFF_W = 0;
constexpr size_t OFF_XN = OFF_W + W_TOTAL * 2;
constexpr size_t OFF_R2 = OFF_XN + (size_t)T * KP1 * 2;
constexpr size_t OFF_QKV = OFF_R2 + (size_t)T * KP2 * 2;
constexpr size_t OFF_SS = OFF_QKV + (size_t)T * 3456 * 2;
constexpr size_t OFF_R64 = OFF_SS + (size_t)T * 20 * 4;
constexpr size_t OFF_R32 = OFF_R64 + 16384ull * 32 * 8;
constexpr size_t OFF_DS = OFF_R32 + 16384ull * 16 * 8;
constexpr size_t OFF_BAR = OFF_DS + (size_t)T * 256 * 4;
constexpr size_t OFF_XB = OFF_BAR + 1024;
constexpr size_t WS_NEEDED = OFF_XB + (size_t)T * 1024 * 2;

constexpr size_t Q_QA = 0;
constexpr size_t Q_KA = (size_t)T * 256;
constexpr size_t Q_VTA = (size_t)T * 384;
constexpr size_t Q_QB = (size_t)T * 512;
constexpr size_t Q_KB = (size_t)T * 768;
constexpr size_t Q_VTB = (size_t)T * 896;
constexpr size_t Q_CQ = (size_t)T * 1024;
constexpr size_t Q_CKV = (size_t)T * 1408;
constexpr size_t Q_QC = (size_t)T * 1664;
constexpr size_t Q_KC = (size_t)T * 2048;
constexpr size_t Q_VTC = (size_t)T * 2432;
constexpr size_t Q_QD = (size_t)T * 2688;
constexpr size_t Q_KD = (size_t)T * 2944;
constexpr size_t Q_VTD = (size_t)T * 3200;
constexpr size_t Q_MERGED = 0;
constexpr size_t Q_Y = (size_t)T * KP1;

struct Params {
  const float* x_prompt; const float* x_sample; const float* norm_g; const float* w_in;
  const float* a_qk_norm; const float* b_sink; const float* c_q_norm; const float* c_kv_norm;
  const float* c_w_uq; const float* c_w_ukv; const float* d_lambda; const float* d_subln;
  const float* w_branch; const float* w_out; const float* ffn_wi; const float* ffn_wo;
  float* out; char* ws;
  int phase_lo; int phase_hi; int coop; int pad0;
};

DI unsigned pk2(float a, float b) {
  f32x2_t v = {a, b};
  bf16x2_t r = __builtin_convertvector(v, bf16x2_t);
  return __builtin_bit_cast(unsigned, r);
}
DI u16 f2bf(float a) { return (u16)(pk2(a, 0.f) & 0xffffu); }
DI float bf2f(unsigned bits16) { return __uint_as_float(bits16 << 16); }
DI int crow(int v, int h) { return (v & 3) + 8 * (v >> 2) + 4 * h; }
DI int pos_of(int tok) { return tok < SEQ0 ? tok : ((tok - SEQ0) & (DSEQ - 1)); }
#define MFMA32(a, b, c) __builtin_amdgcn_mfma_f32_32x32x16_bf16((a), (b), (c), 0, 0, 0)

typedef __attribute__((ext_vector_type(4))) unsigned u32x4;
DI u32x4 gld16(const void* p) { u32x4 r; asm volatile("global_load_dwordx4 %0, %1, off" : "=v"(r) : "v"(p)); return r; }
DI void wait_vm0(u32x4& a) { asm volatile("s_waitcnt vmcnt(0)" : "+v"(a) :: "memory"); }
DI void wait_vm0(u32x4& a, u32x4& b) { asm volatile("s_waitcnt vmcnt(0)" : "+v"(a), "+v"(b) :: "memory"); }
DI void wait_vm0(u32x4& a, u32x4& b, u32x4& c) { asm volatile("s_waitcnt vmcnt(0)" : "+v"(a), "+v"(b), "+v"(c) :: "memory"); }
DI void wait_vm0(u32x4& a, u32x4& b, u32x4& c, u32x4& d) { asm volatile("s_waitcnt vmcnt(0)" : "+v"(a), "+v"(b), "+v"(c), "+v"(d) :: "memory"); }
DI u32x4 gld16s(unsigned voff, const void* sbase) { u32x4 r; asm volatile("global_load_dwordx4 %0, %1, %2" : "=v"(r) : "v"(voff), "s"(sbase)); return r; }
#define DEF_WAIT8(name, cnt) DI void name(u32x4& a, u32x4& b, u32x4& c, u32x4& d, u32x4& e, u32x4& f, u32x4& g, u32x4& h) { asm volatile("s_waitcnt vmcnt(" #cnt ")" : "+v"(a), "+v"(b), "+v"(c), "+v"(d), "+v"(e), "+v"(f), "+v"(g), "+v"(h) :: "memory"); }
#define DEF_WAIT6(name, cnt) DI void name(u32x4& a, u32x4& b, u32x4& c, u32x4& d, u32x4& e, u32x4& f) { asm volatile("s_waitcnt vmcnt(" #cnt ")" : "+v"(a), "+v"(b), "+v"(c), "+v"(d), "+v"(e), "+v"(f) :: "memory"); }
DEF_WAIT8(wait8_vm8, 8)
DEF_WAIT8(wait8_vm0, 0)
DEF_WAIT6(wait6_vm6, 6)
DEF_WAIT6(wait6_vm0, 0)
DI int opaque_tid() { int t = threadIdx.x; asm volatile("" : "+v"(t)); return t; }
DI float wave_sum(float v) {
#pragma unroll
  for (int m = 32; m >= 1; m >>= 1) v += __shfl_xor(v, m);
  return v;
}

DI void rope32_blk(f32x16& a, const float2* __restrict__ tab, int h) {
#pragma unroll
  for (int v = 0; v < 8; ++v) {
    float2 cs = tab[crow(v, h)];
    float x1 = a[v], x2 = a[v + 8];
    a[v] = x1 * cs.x - x2 * cs.y;
    a[v + 8] = x2 * cs.x + x1 * cs.y;
  }
}
DI void rope64_blk(f32x16& a0, f32x16& a1, const float2* __restrict__ tab, int h) {
#pragma unroll
  for (int v = 0; v < 16; ++v) {
    float2 cs = tab[crow(v, h)];
    float x1 = a0[v], x2 = a1[v];
    a0[v] = x1 * cs.x - x2 * cs.y;
    a1[v] = x2 * cs.x + x1 * cs.y;
  }
}
DI void store_rows(u16* __restrict__ base, int ld, int col0, const f32x16& a, int tok, int h) {
#pragma unroll
  for (int vq = 0; vq < 4; ++vq) {
    uint2 pk;
    pk.x = pk2(a[4 * vq], a[4 * vq + 1]);
    pk.y = pk2(a[4 * vq + 2], a[4 * vq + 3]);
    *(uint2*)(base + (size_t)tok * ld + col0 + 8 * vq + 4 * h) = pk;
  }
}
DI void store_T(u16* __restrict__ base, int row0, const f32x16& a, int tok, int h) {
  const int tp = (tok & ~12) | ((tok & 4) << 1) | ((tok & 8) >> 1);
#pragma unroll
  for (int v = 0; v < 16; ++v) base[(size_t)((row0 + crow(v, h)) >> 6) * 64 * T + (size_t)(tp >> 7) * 8192 + ((row0 + crow(v, h)) & 63) * 128 + (tp & 127)] = f2bf(a[v]);
}

enum { M_FFNUP = 0, M_Y = 1, M_PROJ = 2, M_CUQ = 3, M_CUKV = 4, M_MERGE = 5, M_GATE = 6 };

template <int MODE, int NJ>
DI void gemm_epilogue(f32x16 (&acc)[2][NJ], int fbase, int tbase, int r, int h, const Params& P, int layer) {
  char* ws = P.ws;
  u16* qkv = (u16*)(ws + OFF_QKV);
  const float2* R64 = (const float2*)(ws + OFF_R64);
  const float2* R32 = (const float2*)(ws + OFF_R32);
  float* SS = (float*)(ws + OFF_SS);
  if constexpr (MODE == M_FFNUP) {
    u16* H = (u16*)(ws + OFF_R2);
    const int hf0 = (fbase >> 6) * 32;
#pragma unroll
    for (int j = 0; j < NJ; ++j) {
      const int tok = tbase + j * 32 + r;
      f32x16 o;
#pragma unroll
      for (int v = 0; v < 16; ++v) {
        float g = acc[0][j][v], u = acc[1][j][v];
        o[v] = g * __builtin_amdgcn_rcpf(1.f + __builtin_amdgcn_exp2f(-1.4426950408889634f * g)) * u;
      }
      store_rows(H, KP2, hf0, o, tok, h);
    }
  } else if constexpr (MODE == M_Y) {
    u16* Yb = qkv + Q_Y;
#pragma unroll
    for (int j = 0; j < NJ; ++j) {
      const int tok = tbase + j * 32 + r;
      store_rows(Yb, KP1, fbase, acc[0][j], tok, h);
      store_rows(Yb, KP1, fbase + 32, acc[1][j], tok, h);
    }
  } else if constexpr (MODE == M_PROJ) {
    if (fbase < 384) {
      const bool isK = fbase >= 256;
      const float* g = P.a_qk_norm + layer * 128 + (isK ? 64 : 0);
      u16* dst = qkv + (isK ? Q_KA : Q_QA);
      const int ld = isK ? 128 : 256;
      const int c0 = isK ? fbase - 256 : fbase;
      float gv[2][16];
#pragma unroll
      for (int i = 0; i < 2; ++i)
#pragma unroll
        for (int v = 0; v < 16; ++v) gv[i][v] = g[i * 32 + crow(v, h)];
#pragma unroll
      for (int j = 0; j < NJ; ++j) {
        const int tok = tbase + j * 32 + r;
        const int pos = pos_of(tok);
        float ss = 0.f;
#pragma unroll
        for (int i = 0; i < 2; ++i)
#pragma unroll
          for (int v = 0; v < 16; ++v) ss += acc[i][j][v] * acc[i][j][v];
        ss += __shfl_xor(ss, 32);
        const float rs = rsqrtf(ss * (1.f / 64.f) + EPS);
#pragma unroll
        for (int i = 0; i < 2; ++i)
#pragma unroll
          for (int v = 0; v < 16; ++v) acc[i][j][v] *= rs * gv[i][v];
        rope32_blk(acc[0][j], R32 + (size_t)(pos >> 6) * 16, h);
        rope32_blk(acc[1][j], R32 + (size_t)(pos & 63) * 16, h);
        store_rows(dst, ld, c0, acc[0][j], tok, h);
        store_rows(dst, ld, c0 + 32, acc[1][j], tok, h);
      }
    } else if (fbase < 512) {
#pragma unroll
      for (int j = 0; j < NJ; ++j) {
        const int tok = tbase + j * 32 + r;
        store_T(qkv + Q_VTA, fbase - 384, acc[0][j], tok, h);
        store_T(qkv + Q_VTA, fbase - 384 + 32, acc[1][j], tok, h);
      }
    } else if (fbase < 896) {
      const bool isK = fbase >= 768;
      u16* dst = qkv + (isK ? Q_KB : Q_QB);
      const int ld = isK ? 128 : 256;
      const int c0 = isK ? fbase - 768 : fbase - 512;
#pragma unroll
      for (int j = 0; j < NJ; ++j) {
        const int tok = tbase + j * 32 + r;
        const int pos = pos_of(tok);
        rope64_blk(acc[0][j], acc[1][j], R64 + (size_t)pos * 32, h);
        store_rows(dst, ld, c0, acc[0][j], tok, h);
        store_rows(dst, ld, c0 + 32, acc[1][j], tok, h);
      }
    } else if (fbase < 1024) {
#pragma unroll
      for (int j = 0; j < NJ; ++j) {
        const int tok = tbase + j * 32 + r;
        store_T(qkv + Q_VTB, fbase - 896, acc[0][j], tok, h);
        store_T(qkv + Q_VTB, fbase - 896 + 32, acc[1][j], tok, h);
      }
    } else if (fbase < 1664) {
      const bool isKV = fbase >= 1408;
      u16* dst = qkv + (isKV ? Q_CKV : Q_CQ);
      const int ld = isKV ? 256 : 384;
      const int c0 = isKV ? fbase - 1408 : fbase - 1024;
      const int sb = (isKV ? 12 : 0) + (c0 >> 5);
#pragma unroll
      for (int j = 0; j < NJ; ++j) {
        const int tok = tbase + j * 32 + r;
#pragma unroll
        for (int i = 0; i < 2; ++i) {
          float ss = 0.f;
#pragma unroll
          for (int v = 0; v < 16; ++v) ss += acc[i][j][v] * acc[i][j][v];
          ss += __shfl_xor(ss, 32);
          if (h == 0) SS[(size_t)tok * 20 + sb + i] = ss;
          store_rows(dst, ld, c0 + i * 32, acc[i][j], tok, h);
        }
      }
    } else if (fbase < 2176) {
      const bool isK = fbase >= 1920;
      u16* dst = qkv + (isK ? Q_KD : Q_QD);
      const int c0 = isK ? fbase - 1920 : fbase - 1664;
#pragma unroll
      for (int j = 0; j < NJ; ++j) {
        const int tok = tbase + j * 32 + r;
        const int pos = pos_of(tok);
#pragma unroll
        for (int i = 0; i < 2; ++i) {
          rope32_blk(acc[i][j], R32 + (size_t)pos * 16, h);
          store_rows(dst, 256, c0 + i * 32, acc[i][j], tok, h);
        }
      }
    } else if (fbase < 2432) {
#pragma unroll
      for (int j = 0; j < NJ; ++j) {
        const int tok = tbase + j * 32 + r;
        store_T(qkv + Q_VTD, fbase - 2176, acc[0][j], tok, h);
        store_T(qkv + Q_VTD, fbase - 2176 + 32, acc[1][j], tok, h);
      }
    } else if (fbase == 2432) {
#pragma unroll
      for (int j = 0; j < NJ; ++j) {
        const int tok = tbase + j * 32 + r;
        const int pos = pos_of(tok);
        rope32_blk(acc[0][j], R32 + (size_t)pos * 16, h);
#pragma unroll
        for (int hd = 0; hd < 4; ++hd) store_rows(qkv + Q_KC, 384, hd * 96 + 64, acc[0][j], tok, h);
      }
    }
  } else if constexpr (MODE == M_GATE) {
    unsigned char* G8 = (unsigned char*)(ws + OFF_R2);
#pragma unroll
    for (int j = 0; j < NJ; ++j) {
      const int tok = tbase + j * 32 + r;
#pragma unroll
      for (int i = 0; i < 2; ++i)
#pragma unroll
        for (int vq = 0; vq < 4; ++vq) {
          unsigned pk = 0u;
#pragma unroll
          for (int e = 0; e < 4; ++e) {
            const float o = __builtin_amdgcn_rcpf(1.f + __builtin_amdgcn_exp2f(-1.4426950408889634f * acc[i][j][4 * vq + e]));
            pk |= (unsigned)(o * 255.f + 0.5f) << (8 * e);
          }
          *(unsigned*)(G8 + (size_t)tok * GP + fbase + i * 32 + 8 * vq + 4 * h) = pk;
        }
    }
  } else if constexpr (MODE == M_CUQ) {
    if (fbase >= 384) return;
#pragma unroll
    for (int j = 0; j < NJ; ++j) {
      const int tok = tbase + j * 32 + r;
      const int pos = pos_of(tok);
      float ss = 0.f;
#pragma unroll
      for (int b = 0; b < 12; ++b) ss += SS[(size_t)tok * 20 + b];
      const float rs = rsqrtf(ss * (1.f / 384.f) + EPS);
#pragma unroll
      for (int i = 0; i < 2; ++i) {
        const int blk = (fbase >> 5) + i;
#pragma unroll
        for (int v = 0; v < 16; ++v) acc[i][j][v] *= rs;
        if (blk % 3 == 2) rope32_blk(acc[i][j], R32 + (size_t)pos * 16, h);
        store_rows(qkv + Q_QC, 384, blk * 32, acc[i][j], tok, h);
      }
    }
  } else if constexpr (MODE == M_CUKV) {
#pragma unroll
    for (int j = 0; j < NJ; ++j) {
      const int tok = tbase + j * 32 + r;
      float ss = 0.f;
#pragma unroll
      for (int b = 0; b < 8; ++b) ss += SS[(size_t)tok * 20 + 12 + b];
      const float rs = rsqrtf(ss * (1.f / 256.f) + EPS);
#pragma unroll
      for (int i = 0; i < 2; ++i) {
        const int blk = (fbase >> 5) + i;
        const int hd = blk >> 2, q = blk & 3;
#pragma unroll
        for (int v = 0; v < 16; ++v) acc[i][j][v] *= rs;
        if (q < 2) store_rows(qkv + Q_KC, 384, hd * 96 + q * 32, acc[i][j], tok, h);
        else store_T(qkv + Q_VTC, hd * 64 + (q - 2) * 32, acc[i][j], tok, h);
      }
    }
  } else if constexpr (MODE == M_MERGE) {
#pragma unroll
    for (int j = 0; j < NJ; ++j) {
      const int tok = tbase + j * 32 + r;
      store_rows(qkv + Q_MERGED, KP1, fbase, acc[0][j], tok, h);
      store_rows(qkv + Q_MERGED, KP1, fbase + 32, acc[1][j], tok, h);
    }
  }
}

typedef __attribute__((address_space(3))) unsigned lds_u32_t;
typedef __attribute__((address_space(1))) const unsigned glb_u32_t;
template <int MODE, int NJ>
DI void gemm_tile(const u16* __restrict__ Wt, int ldw, const u16* __restrict__ X, int ldx, int K, int f0, int t0, char* smem,
                  const Params& P, int layer) {
  constexpr int XROWS = NJ * 64;
  constexpr int WSTG = 256 * 64, XSTG = XROWS * 64;
  u16* sW = (u16*)smem;
  u16* sX = sW + 2 * WSTG;
  const int tid = opaque_tid(), lane = tid & 63, wave = tid >> 6, r = lane & 31, h = lane >> 5;
  const int wf = wave & 3, wt = wave >> 2;
  f32x16 acc[2][NJ];
  f32x16 tot[2][MODE == M_MERGE ? NJ : 1];
#pragma unroll
  for (int i = 0; i < 2; ++i)
#pragma unroll
    for (int j = 0; j < NJ; ++j)
#pragma unroll
      for (int v = 0; v < 16; ++v) acc[i][j][v] = 0.f;
  if constexpr (MODE == M_MERGE) {
#pragma unroll
    for (int i = 0; i < 2; ++i)
#pragma unroll
      for (int j = 0; j < NJ; ++j)
#pragma unroll
        for (int v = 0; v < 16; ++v) tot[i][j][v] = 0.f;
  }
  const int nk = K >> 6;
  const int srow = tid >> 3;
  const int schunk = (tid & 7) ^ ((tid >> 4) & 7);
  const u16* wp = Wt + (size_t)(f0 + srow) * ldw + schunk * 8;
  const u16* xp = X + (size_t)(t0 + srow) * ldx + schunk * 8;
  const int fbase = f0 + wf * 64, tbase = t0 + wt * (NJ * 32);

  auto issue = [&](int kt, int buf) {
#pragma unroll
    for (int i = 0; i < 4; ++i)
      __builtin_amdgcn_global_load_lds((glb_u32_t*)(wp + (size_t)(i * 64) * ldw + kt * 64),
                                       (lds_u32_t*)(sW + buf * WSTG + i * 4096 + tid * 8), 16, 0, 0);
#pragma unroll
    for (int i = 0; i < NJ; ++i)
      __builtin_amdgcn_global_load_lds((glb_u32_t*)(xp + (size_t)(i * 64) * ldx + kt * 64),
                                       (lds_u32_t*)(sX + buf * XSTG + i * 4096 + tid * 8), 16, 0, 0);
  };
  const int swz = (r >> 1) & 7;
  auto compute = [&](int buf, int kt) {
    const u16* aW = sW + buf * WSTG + (wf * 64 + r) * 64;
    const u16* aX = sX + buf * XSTG + (wt * (NJ * 32) + r) * 64;
#pragma unroll
    for (int ks = 0; ks < 4; ++ks) {
      const int co = ((2 * ks + h) ^ swz) * 8;
      bf16x8 wfrag[2], xfrag[NJ];
#pragma unroll
      for (int i = 0; i < 2; ++i) wfrag[i] = *(const bf16x8*)(aW + i * 32 * 64 + co);
#pragma unroll
      for (int j = 0; j < NJ; ++j) xfrag[j] = *(const bf16x8*)(aX + j * 32 * 64 + co);
#pragma unroll
      for (int i = 0; i < 2; ++i)
#pragma unroll
        for (int j = 0; j < NJ; ++j) acc[i][j] = MFMA32(wfrag[i], xfrag[j], acc[i][j]);
    }
    if constexpr (MODE == M_MERGE) {
      if ((kt & 3) == 3) {
        const int br = kt >> 2;
        const unsigned char* G8 = (const unsigned char*)(P.ws + OFF_R2);
#pragma unroll
        for (int j = 0; j < NJ; ++j) {
          const int tok = tbase + j * 32 + r;
#pragma unroll
          for (int i = 0; i < 2; ++i)
#pragma unroll
            for (int vq = 0; vq < 4; ++vq) {
              const unsigned gp = *(const unsigned*)(G8 + (size_t)tok * GP + br * 1024 + fbase + i * 32 + 8 * vq + 4 * h);
              tot[i][j][4 * vq + 0] += (float)(gp & 0xffu) * (1.f / 255.f) * acc[i][j][4 * vq + 0];
              tot[i][j][4 * vq + 1] += (float)((gp >> 8) & 0xffu) * (1.f / 255.f) * acc[i][j][4 * vq + 1];
              tot[i][j][4 * vq + 2] += (float)((gp >> 16) & 0xffu) * (1.f / 255.f) * acc[i][j][4 * vq + 2];
              tot[i][j][4 * vq + 3] += (float)(gp >> 24) * (1.f / 255.f) * acc[i][j][4 * vq + 3];
              acc[i][j][4 * vq + 0] = 0.f; acc[i][j][4 * vq + 1] = 0.f;
              acc[i][j][4 * vq + 2] = 0.f; acc[i][j][4 * vq + 3] = 0.f;
            }
        }
      }
    }
  };

  issue(0, 0);
  asm volatile("s_waitcnt vmcnt(0)" ::: "memory");
  __syncthreads();
  for (int kt = 0; kt < nk; ++kt) {
    const int buf = kt & 1;
    if (kt + 1 < nk) issue(kt + 1, buf ^ 1);
    compute(buf, kt);
    asm volatile("s_waitcnt vmcnt(0) lgkmcnt(0)" ::: "memory");
    __syncthreads();
  }
  if constexpr (MODE == M_MERGE) gemm_epilogue<MODE, NJ>(tot, fbase, tbase, r, h, P, layer);
  else gemm_epilogue<MODE, NJ>(acc, fbase, tbase, r, h, P, layer);
}

template <int MODE, int NJ>
DI void gemm_phase(const u16* Wt, int ldw, const u16* X, int ldx, int K, int nF, char* smem, const Params& P, int layer) {
  constexpr int TT = NJ * 64;
  const int nT = T / TT;
  const int ntiles = nF * nT;
  for (int idx = blockIdx.x; idx < ntiles; idx += gridDim.x) {
    const int tt_lo = idx & 15;
    const int rest = idx >> 4;
    const int ft = rest % nF;
    const int tt = (rest / nF) * 16 + tt_lo;
    gemm_tile<MODE, NJ>(Wt, ldw, X, ldx, K, ft * 256, tt * TT, smem, P, layer);
  }
}

namespace pg8 {
#define PG8_LAS __attribute__((address_space(3)))
typedef unsigned short bf16_t;
typedef short bf16x8 __attribute__((ext_vector_type(8)));
typedef float f32x4 __attribute__((ext_vector_type(4)));
typedef unsigned u32x4 __attribute__((ext_vector_type(4)));
constexpr int BM = 256, BK = 64, HALF = 128, HTB = HALF * BK * 2  , STAGE_BYTES = 8 * HTB, NXCD = 8, WGM = 8;

__host__ __device__ __forceinline__ int lds_byte(int r, int c) { const int st = (r >> 4) * 2 + (c >> 5), rr = r & 15, cc = c & 31, ob = rr * 64 + cc * 2; return st * 1024 + (ob ^ (((ob >> 9) & 1) << 5)); }
__host__ __device__ __forceinline__ void stage_rc(int b, int& R, int& C) { const int st = b / 1024, sb = b % 1024, swz = sb ^ (((sb >> 9) & 1) << 5); R = (st >> 1) * 16 + swz / 64; C = (st & 1) * 32 + (swz % 64) / 2; }
__host__ __device__ __forceinline__ int perm32(int rho) { const int n = rho >> 4, i = rho & 15; return 8 * (i >> 2) + 4 * n + (i & 3); }

struct Unit { int pm, pn; };
struct Gemm { const bf16_t* A; const bf16_t* Bt; int M, N, K, ld; };

struct StaticOrder {
    int nM, nN, nwg, G, c;
    __host__ __device__ void init(int M, int N, int G_, int c_) { nM = M / BM; nN = N / BM; nwg = nM * nN; G = G_; c = c_; }
    __host__ __device__ bool next(int i, Unit& u) const {
        const long L = (long)i * G + c; if (L >= nwg) return false;
        int wgid = (int)L; { const int q = nwg / NXCD, r = nwg % NXCD, xcd = wgid % NXCD, off = wgid / NXCD; wgid = (xcd < r ? xcd * (q + 1) : r * (q + 1) + (xcd - r) * q) + off; }
        const int nig = WGM * nN, gid = wgid / nig, fm = gid * WGM, gsz = (nM - fm) < WGM ? (nM - fm) : WGM;
        u.pm = fm + ((wgid % nig) % gsz); u.pn = (wgid % nig) / gsz; return true;
    }
    __device__ __forceinline__ void a_ready(const Unit&) const {}
    __device__ __forceinline__ void done(const Unit&) const {}
};

template <class Epi, class Sched, bool STAMP, int KC, int LDC>
__device__ __forceinline__ void gemm_phase(PG8_LAS unsigned char* lds, const Gemm g, const Sched& S, const Epi& E, unsigned long long* stamps) {
    const int tid = opaque_tid(), wid = __builtin_amdgcn_readfirstlane(tid >> 6), lane = tid & 63, wr = wid >> 2, wc = wid & 3, fr = lane & 15, fq = lane >> 4;
    constexpr int K = KC, nt = K / BK;
    int ts_lo = 0, ts_hi = 0, nts = 0; const unsigned long long rt_entry = STAMP ? (unsigned long long)wall_clock64() : 0ull;
#define PG8_STAMP() do { if (STAMP && wid == 0 && nts < 64) { const unsigned long long _c = (unsigned long long)clock64(); \
        ts_lo = (lane == nts) ? (int)(unsigned)_c : ts_lo; ts_hi = (lane == nts) ? (int)(unsigned)(_c >> 32) : ts_hi; ++nts; } } while (0)
    PG8_STAMP();
    unsigned voffA[2], voffB[2];
#pragma unroll
    for (int i = 0; i < 2; ++i) { int R, C; stage_rc(tid * 16 + i * 8192, R, C); const int Rb = Epi::PERM ? ((R & ~31) + perm32(R & 31)) : R;
        voffA[i] = (unsigned)(R * LDC + C) * 2u; voffB[i] = (unsigned)(Rb * LDC + C) * 2u; }
    const size_t kstep = (size_t)(BK * 2);
    constexpr size_t hstep = (size_t)HALF * LDC * 2;
    const size_t tstep = 2 * hstep;
    const unsigned ldsw = (unsigned)wid * 1024u;
    const int aoff = lds_byte(wr * 64 + fr, fq * 8), boff = lds_byte(wc * 32 + fr, fq * 8);
#define PG8_SA(b, h) (((b) * 2 + (h)) * HTB)
#define PG8_SB(b, h) ((4 + (b) * 2 + (h)) * HTB)
#define PG8_STAGE(bufoff, gbase, voff) do { _Pragma("unroll") for (int _i = 0; _i < 2; ++_i) \
        __builtin_amdgcn_global_load_lds((const unsigned*)((const char*)(gbase) + (voff)[_i]), (PG8_LAS unsigned*)(lds + (bufoff) + ldsw + _i * 8192), 16, 0, 0); } while (0)
#define PG8_LDA(dst, b, h) do { _Pragma("unroll") for (int m = 0; m < 4; ++m) _Pragma("unroll") for (int k = 0; k < 2; ++k) dst[m][k] = *(const PG8_LAS bf16x8*)(lds + PG8_SA(b, h) + aoff + m * 2048 + k * 1024); } while (0)
#define PG8_LDB(dst, b, h) do { _Pragma("unroll") for (int n = 0; n < 2; ++n) _Pragma("unroll") for (int k = 0; k < 2; ++k) dst[n][k] = *(const PG8_LAS bf16x8*)(lds + PG8_SB(b, h) + boff + n * 2048 + k * 1024); } while (0)
#define PG8_MMA(ai, bj, At, Bt) do { __builtin_amdgcn_s_setprio(1); _Pragma("unroll") for (int m = 0; m < 4; ++m) _Pragma("unroll") for (int n = 0; n < 2; ++n) _Pragma("unroll") for (int k = 0; k < 2; ++k) \
        acc[ai][bj][m][n] = __builtin_amdgcn_mfma_f32_16x16x32_bf16(Bt[n][k], At[m][k], acc[ai][bj][m][n], 0, 0, 0); __builtin_amdgcn_s_setprio(0); } while (0)
#define PG8_WAIT_V(n) asm volatile("s_waitcnt vmcnt(" #n ")" ::: "memory")
#define PG8_WAIT_L(n) asm volatile("s_waitcnt lgkmcnt(" #n ")" ::: "memory")
#define PG8_BAR __builtin_amdgcn_s_barrier()
#define PG8_SCHED __builtin_amdgcn_sched_barrier(0)
    Unit cur, nxt; int ui = 0;
    if (!S.next(0, cur)) return;
    f32x4 acc[2][2][4][2];
#pragma unroll
    for (int a = 0; a < 2; ++a)
#pragma unroll
        for (int b = 0; b < 2; ++b)
#pragma unroll
            for (int m = 0; m < 4; ++m)
#pragma unroll
                for (int n = 0; n < 2; ++n) acc[a][b][m][n] = (f32x4){0.f, 0.f, 0.f, 0.f};
    bf16x8 At[4][2], B0[2][2], B1[2][2];
    const char* cA = (const char*)g.A + (size_t)cur.pm * tstep; const char* cB = (const char*)g.Bt + (size_t)cur.pn * tstep;
    S.a_ready(cur);
    PG8_STAGE(PG8_SB(0, 0), cB, voffB); PG8_STAGE(PG8_SA(0, 0), cA, voffA); PG8_STAGE(PG8_SB(0, 1), cB + hstep, voffB); PG8_STAGE(PG8_SA(0, 1), cA + hstep, voffA);
    if (wr == 1) PG8_BAR;
    PG8_WAIT_V(4); PG8_BAR;
    PG8_STAGE(PG8_SB(1, 0), cB + kstep, voffB); PG8_STAGE(PG8_SA(1, 0), cA + kstep, voffA); PG8_STAGE(PG8_SB(1, 1), cB + hstep + kstep, voffB);
    PG8_WAIT_V(6); PG8_BAR;
    PG8_STAMP();
    for (;;) {
        const bool has_next = S.next(ui + 1, nxt);
        const char* nA = has_next ? (const char*)g.A + (size_t)nxt.pm * tstep : cA; const char* nB = has_next ? (const char*)g.Bt + (size_t)nxt.pn * tstep : cB;
        for (int t = 0; t < nt; t += 2) {
            const bool last = (t == nt - 2);
            const char* a1 = cA + (size_t)(t + 1) * kstep;
            const char* a2 = last ? nA : cA + (size_t)(t + 2) * kstep; const char* b2 = last ? nB : cB + (size_t)(t + 2) * kstep;
            const char* a3 = a2 + kstep; const char* b3 = b2 + kstep;
            if (last && has_next) S.a_ready(nxt);
            PG8_LDB(B0, 0, 0); PG8_SCHED; PG8_LDA(At, 0, 0); PG8_STAGE(PG8_SA(1, 1), a1 + hstep, voffA);
            PG8_WAIT_L(8); PG8_BAR; PG8_WAIT_L(0); PG8_MMA(0, 0, At, B0); PG8_BAR; PG8_SCHED;
            PG8_LDB(B1, 0, 1); PG8_STAGE(PG8_SB(0, 0), b2, voffB);
            PG8_BAR; PG8_WAIT_L(0); PG8_MMA(0, 1, At, B1); PG8_BAR;
            PG8_LDA(At, 0, 1); PG8_STAGE(PG8_SA(0, 0), a2, voffA);
            PG8_BAR; PG8_WAIT_L(0); PG8_MMA(1, 0, At, B0); PG8_BAR; PG8_SCHED;
            PG8_STAGE(PG8_SB(0, 1), b2 + hstep, voffB);
            PG8_WAIT_V(6); PG8_BAR; PG8_MMA(1, 1, At, B1); PG8_BAR;
            PG8_LDB(B0, 1, 0); PG8_SCHED; PG8_LDA(At, 1, 0); PG8_STAGE(PG8_SA(0, 1), a2 + hstep, voffA);
            PG8_WAIT_L(8); PG8_BAR; PG8_WAIT_L(0); PG8_MMA(0, 0, At, B0); PG8_BAR; PG8_SCHED;
            PG8_LDB(B1, 1, 1); PG8_STAGE(PG8_SB(1, 0), b3, voffB);
            PG8_BAR; PG8_WAIT_L(0); PG8_MMA(0, 1, At, B1); PG8_BAR;
            PG8_LDA(At, 1, 1); PG8_STAGE(PG8_SA(1, 0), a3, voffA);
            PG8_BAR; PG8_WAIT_L(0); PG8_MMA(1, 0, At, B0); PG8_BAR; PG8_SCHED;
            PG8_STAGE(PG8_SB(1, 1), b3 + hstep, voffB);
            PG8_WAIT_V(6); PG8_BAR; PG8_MMA(1, 1, At, B1); PG8_BAR;
        }
        PG8_STAMP();
        if constexpr (!Epi::AFTER_DRAIN) { E(acc, cur, wr, wc, fr, fq); S.done(cur); }
        PG8_STAMP();
        if (!has_next) break;
#pragma unroll
        for (int a = 0; a < 2; ++a)
#pragma unroll
            for (int b = 0; b < 2; ++b)
#pragma unroll
                for (int m = 0; m < 4; ++m)
#pragma unroll
                    for (int n = 0; n < 2; ++n) acc[a][b][m][n] = (f32x4){0.f, 0.f, 0.f, 0.f};
        cur = nxt; cA = nA; cB = nB; ++ui;
    }
    PG8_WAIT_V(0);
    if (wr == 0) PG8_BAR;
    PG8_BAR;
    if constexpr (Epi::AFTER_DRAIN) { E.fused(acc, cur, wr, wc, fr, fq, lds, wid, lane); S.done(cur); }
    PG8_STAMP();
    if (STAMP && wid == 0) { stamps[lane] = lane < nts ? (((unsigned long long)(unsigned)ts_hi << 32) | (unsigned)ts_lo) : 0ull;
        if (lane == 62) stamps[62] = rt_entry; if (lane == 63) stamps[63] = (unsigned long long)wall_clock64(); }
#undef PG8_STAMP
#undef PG8_SA
#undef PG8_SB
#undef PG8_STAGE
#undef PG8_LDA
#undef PG8_LDB
#undef PG8_MMA
#undef PG8_WAIT_V
#undef PG8_WAIT_L
#undef PG8_BAR
#undef PG8_SCHED
}
}

struct EpiY8 {
  static constexpr bool PERM = true, AFTER_DRAIN = false;
  u16* O;
  DI void operator()(const pg8::f32x4 (&acc)[2][2][4][2], const pg8::Unit& u, int wr, int wc, int fr, int fq) const {
    const int row0 = u.pm * 256 + wr * 64 + fr, col0 = u.pn * 256 + wc * 32 + 8 * fq;
#pragma unroll
    for (int ai = 0; ai < 2; ++ai)
#pragma unroll
      for (int m = 0; m < 4; ++m) {
        u16* rowp = O + (size_t)(row0 + ai * 128 + m * 16) * KP1 + col0;
#pragma unroll
        for (int bj = 0; bj < 2; ++bj) {
          const pg8::f32x4 v0 = acc[ai][bj][m][0], v1 = acc[ai][bj][m][1];
          u32x4 w; w.x = pk2(v0[0], v0[1]); w.y = pk2(v0[2], v0[3]); w.z = pk2(v1[0], v1[1]); w.w = pk2(v1[2], v1[3]);
          *(u32x4*)(rowp + bj * 128) = w;
        }
      }
  }
};
struct EpiFfnUp8 {
  static constexpr bool PERM = true, AFTER_DRAIN = false;
  u16* H;
  DI void operator()(const pg8::f32x4 (&acc)[2][2][4][2], const pg8::Unit& u, int wr, int wc, int fr, int fq) const {
    const int row0 = u.pm * 256 + wr * 64 + fr, col0 = u.pn * 128 + wc * 32 + 8 * fq;
#pragma unroll
    for (int ai = 0; ai < 2; ++ai)
#pragma unroll
      for (int m = 0; m < 4; ++m) {
        float o[8];
#pragma unroll
        for (int n = 0; n < 2; ++n)
#pragma unroll
          for (int j = 0; j < 4; ++j) {
            const float g = acc[ai][0][m][n][j], up = acc[ai][1][m][n][j];
            o[n * 4 + j] = g * __builtin_amdgcn_rcpf(1.f + __builtin_amdgcn_exp2f(-1.4426950408889634f * g)) * up;
          }
        u32x4 w; w.x = pk2(o[0], o[1]); w.y = pk2(o[2], o[3]); w.z = pk2(o[4], o[5]); w.w = pk2(o[6], o[7]);
        *(u32x4*)(H + (size_t)(row0 + ai * 128 + m * 16) * KP2 + col0) = w;
      }
  }
};
struct EpiGate8 {
  static constexpr bool PERM = true, AFTER_DRAIN = false;
  unsigned char* G8;
  DI void operator()(const pg8::f32x4 (&acc)[2][2][4][2], const pg8::Unit& u, int wr, int wc, int fr, int fq) const {
    const int row0 = u.pm * 256 + wr * 64 + fr, col0 = u.pn * 256 + wc * 32 + 8 * fq;
#pragma unroll
    for (int ai = 0; ai < 2; ++ai)
#pragma unroll
      for (int m = 0; m < 4; ++m)
#pragma unroll
        for (int bj = 0; bj < 2; ++bj) {
          uint2 pk = {0u, 0u};
#pragma unroll
          for (int j = 0; j < 4; ++j) {
            const float a = __builtin_amdgcn_rcpf(1.f + __builtin_amdgcn_exp2f(-1.4426950408889634f * acc[ai][bj][m][0][j]));
            const float b = __builtin_amdgcn_rcpf(1.f + __builtin_amdgcn_exp2f(-1.4426950408889634f * acc[ai][bj][m][1][j]));
            pk.x |= (unsigned)(a * 255.f + 0.5f) << (8 * j);
            pk.y |= (unsigned)(b * 255.f + 0.5f) << (8 * j);
          }
          *(uint2*)(G8 + (size_t)(row0 + ai * 128 + m * 16) * GP + col0 + bj * 128) = pk;
        }
  }
};
struct EpiProj8 {
  static constexpr bool PERM = false, AFTER_DRAIN = false;
  const Params* Pp; int layer;
  static DI void rope32q(float (&b)[8], const float2* __restrict__ tab, int fq) {
#pragma unroll
    for (int j = 0; j < 4; ++j) {
      const float2 cs = tab[4 * fq + j];
      const float x1 = b[j], x2 = b[4 + j];
      b[j] = x1 * cs.x - x2 * cs.y;
      b[4 + j] = x2 * cs.x + x1 * cs.y;
    }
  }
  static DI void st8(u16* __restrict__ base, int ld, int col0, const float (&b)[8], int tok, int fq) {
#pragma unroll
    for (int n = 0; n < 2; ++n) {
      uint2 pk; pk.x = pk2(b[4 * n], b[4 * n + 1]); pk.y = pk2(b[4 * n + 2], b[4 * n + 3]);
      *(uint2*)(base + (size_t)tok * ld + col0 + 16 * n + 4 * fq) = pk;
    }
  }
  static DI void stT8(u16* __restrict__ base, int row0, const float (&b)[8], int tok, int fq) {
    const int tp = (tok & ~12) | ((tok & 4) << 1) | ((tok & 8) >> 1);
#pragma unroll
    for (int n = 0; n < 2; ++n)
#pragma unroll
      for (int j = 0; j < 4; ++j) {
        const int row = row0 + 16 * n + 4 * fq + j;
        base[(size_t)(row >> 6) * 64 * T + (size_t)(tp >> 7) * 8192 + (row & 63) * 128 + (tp & 127)] = f2bf(b[4 * n + j]);
      }
  }
  DI void operator()(const pg8::f32x4 (&acc)[2][2][4][2], const pg8::Unit& u, int wr, int wc, int fr, int fq_in) const {
    const Params& P = *Pp;
    char* ws = P.ws;
    u16* qkv = (u16*)(ws + OFF_QKV);
    const float2* R64 = (const float2*)(ws + OFF_R64);
    const float2* R32 = (const float2*)(ws + OFF_R32);
    float* SS = (float*)(ws + OFF_SS);
    const int fbase = u.pn * 256 + wc * 64;
    if (fbase >= 2496) return;
#pragma unroll
    for (int ai = 0; ai < 2; ++ai)
#pragma unroll
      for (int m = 0; m < 4; ++m) {
        int fqv = fq_in; asm volatile("" : "+v"(fqv));
        const int fq = fqv;
        const int tok = u.pm * 256 + ai * 128 + wr * 64 + m * 16 + fr;
        const int pos = pos_of(tok);
        float b0[8], b1[8];
#pragma unroll
        for (int n = 0; n < 2; ++n)
#pragma unroll
          for (int j = 0; j < 4; ++j) { b0[4 * n + j] = acc[ai][0][m][n][j]; b1[4 * n + j] = acc[ai][1][m][n][j]; }
        if (fbase < 384) {
          const bool isK = fbase >= 256;
          const float* g = P.a_qk_norm + layer * 128 + (isK ? 64 : 0);
          float ss = 0.f;
#pragma unroll
          for (int k = 0; k < 8; ++k) ss += b0[k] * b0[k] + b1[k] * b1[k];
          ss += __shfl_xor(ss, 16);
          ss += __shfl_xor(ss, 32);
          const float rs = rsqrtf(ss * (1.f / 64.f) + EPS);
#pragma unroll
          for (int n = 0; n < 2; ++n)
#pragma unroll
            for (int j = 0; j < 4; ++j) {
              b0[4 * n + j] *= rs * g[16 * n + 4 * fq + j];
              b1[4 * n + j] *= rs * g[32 + 16 * n + 4 * fq + j];
            }
          rope32q(b0, R32 + (size_t)(pos >> 6) * 16, fq);
          rope32q(b1, R32 + (size_t)(pos & 63) * 16, fq);
          u16* dst = qkv + (isK ? Q_KA : Q_QA);
          const int ld = isK ? 128 : 256, c0 = isK ? fbase - 256 : fbase;
          st8(dst, ld, c0, b0, tok, fq);
          st8(dst, ld, c0 + 32, b1, tok, fq);
        } else if (fbase < 512) {
          stT8(qkv + Q_VTA, fbase - 384, b0, tok, fq);
          stT8(qkv + Q_VTA, fbase - 384 + 32, b1, tok, fq);
        } else if (fbase < 896) {
          const bool isK = fbase >= 768;
          const float2* tab = R64 + (size_t)pos * 32;
#pragma unroll
          for (int n = 0; n < 2; ++n)
#pragma unroll
            for (int j = 0; j < 4; ++j) {
              const float2 cs = tab[16 * n + 4 * fq + j];
              const float x1 = b0[4 * n + j], x2 = b1[4 * n + j];
              b0[4 * n + j] = x1 * cs.x - x2 * cs.y;
              b1[4 * n + j] = x2 * cs.x + x1 * cs.y;
            }
          u16* dst = qkv + (isK ? Q_KB : Q_QB);
          const int ld = isK ? 128 : 256, c0 = isK ? fbase - 768 : fbase - 512;
          st8(dst, ld, c0, b0, tok, fq);
          st8(dst, ld, c0 + 32, b1, tok, fq);
        } else if (fbase < 1024) {
          stT8(qkv + Q_VTB, fbase - 896, b0, tok, fq);
          stT8(qkv + Q_VTB, fbase - 896 + 32, b1, tok, fq);
        } else if (fbase < 1664) {
          const bool isKV = fbase >= 1408;
          u16* dst = qkv + (isKV ? Q_CKV : Q_CQ);
          const int ld = isKV ? 256 : 384, c0 = isKV ? fbase - 1408 : fbase - 1024;
          const int sb = (isKV ? 12 : 0) + (c0 >> 5);
          float s0 = 0.f, s1 = 0.f;
#pragma unroll
          for (int k = 0; k < 8; ++k) { s0 += b0[k] * b0[k]; s1 += b1[k] * b1[k]; }
          s0 += __shfl_xor(s0, 16); s0 += __shfl_xor(s0, 32);
          s1 += __shfl_xor(s1, 16); s1 += __shfl_xor(s1, 32);
          if (fq == 0) { SS[(size_t)tok * 20 + sb] = s0; SS[(size_t)tok * 20 + sb + 1] = s1; }
          st8(dst, ld, c0, b0, tok, fq);
          st8(dst, ld, c0 + 32, b1, tok, fq);
        } else if (fbase < 2176) {
          const bool isK = fbase >= 1920;
          u16* dst = qkv + (isK ? Q_KD : Q_QD);
          const int c0 = isK ? fbase - 1920 : fbase - 1664;
          rope32q(b0, R32 + (size_t)pos * 16, fq);
          rope32q(b1, R32 + (size_t)pos * 16, fq);
          st8(dst, 256, c0, b0, tok, fq);
          st8(dst, 256, c0 + 32, b1, tok, fq);
        } else if (fbase < 2432) {
          stT8(qkv + Q_VTD, fbase - 2176, b0, tok, fq);
          stT8(qkv + Q_VTD, fbase - 2176 + 32, b1, tok, fq);
        } else {
          rope32q(b0, R32 + (size_t)pos * 16, fq);
#pragma unroll
          for (int hd = 0; hd < 4; ++hd) st8(qkv + Q_KC, 384, hd * 96 + 64, b0, tok, fq);
        }
        __builtin_amdgcn_sched_barrier(0);
      }
  }
};
struct SimpleOrder {
  int nN, nwg, G, c;
  DI bool next(int i, pg8::Unit& u) const {
    const int L = i * G + c;
    if (L >= nwg) return false;
    const int rest = L >> 4;
    u.pn = rest % nN;
    u.pm = (rest / nN) * 16 + (L & 15);
    return true;
  }
  DI void a_ready(const pg8::Unit&) const {}
  DI void done(const pg8::Unit&) const {}
};
template <int N, int K, int LD, class Epi>
DI void gemm8_phase(const u16* X, const u16* Wt, const Epi& E, char* smem) {
  pg8::Gemm g; g.A = X; g.Bt = Wt; g.M = T; g.N = N; g.K = K; g.ld = LD;
  int bid_ = (int)blockIdx.x; asm volatile("" : "+s"(bid_));
  SimpleOrder S; S.nN = N / 256; S.nwg = (T / 256) * (N / 256); S.G = (int)gridDim.x; S.c = bid_;
  pg8::gemm_phase<Epi, SimpleOrder, false, K, LD>((PG8_LAS unsigned char*)smem, g, S, E, nullptr);
}

template <int DQK, int NCOMP, bool BAND, int EPI>
DI void attn_item(const u16* __restrict__ Q, int ldq, const u16* __restrict__ Kp, int ldk, const u16* __restrict__ Vt,
                  int qtok0, int kbeg, int kend, float sc_l2, float sink_l2, float lam, float onorm,
                  const float* __restrict__ subg, u16* __restrict__ O, float* __restrict__ DS, char* smem) {
  constexpr int DC = DQK / NCOMP;
  constexpr int KS = DC / 16;
  constexpr int KEYS = (NCOMP == 1) ? 128 : 64;
  constexpr int KSTR = DQK + 8, VSTR = KEYS + 8;
  constexpr int KCH = DQK / 8, VCH = KEYS / 8;
  constexpr int NKC = KEYS * KCH / NTHR, NVC = 64 * VCH / NTHR;
  constexpr int KSLOT = KEYS * KSTR, VSLOT = 64 * VSTR;
  u16* sK = (u16*)smem;
  u16* sV = sK + 3 * KSLOT;
  const int tid = opaque_tid(), lane = tid & 63, wave = tid >> 6, r = lane & 31, h = lane >> 5;
  const int qtok = qtok0 + wave * 32 + r;

  bf16x8 qf[NCOMP][KS];
#pragma unroll
  for (int c = 0; c < NCOMP; ++c)
#pragma unroll
    for (int ks = 0; ks < KS; ++ks) qf[c][ks] = *(const bf16x8*)(Q + (size_t)qtok * ldq + c * DC + ks * 16 + 8 * h);

  f32x16 Oa[NCOMP][2];
  float m[NCOMP], l[NCOMP];
#pragma unroll
  for (int c = 0; c < NCOMP; ++c) {
#pragma unroll
    for (int d = 0; d < 2; ++d)
#pragma unroll
      for (int v = 0; v < 16; ++v) Oa[c][d][v] = 0.f;
    m[c] = BAND ? sink_l2 : -1e30f;
    l[c] = (BAND && h == 0) ? 1.f : 0.f;
  }

  const u16* kg[NKC]; int kso[NKC];
#pragma unroll
  for (int i = 0; i < NKC; ++i) {
    const int c = tid + i * NTHR;
    const int row = c / KCH, cc = c % KCH;
    kg[i] = Kp + (size_t)(kbeg + row) * ldk + cc * 8;
    kso[i] = row * KSTR + cc * 8;
  }
  const u16* vg[NVC]; int vso[NVC];
#pragma unroll
  for (int i = 0; i < NVC; ++i) {
    const int c = tid + i * NTHR;
    const int row = c / VCH, cc = c % VCH;
    vg[i] = Vt + (size_t)(kbeg >> 7) * 8192 + row * 128 + cc * 8;
    vso[i] = row * VSTR + cc * 8;
  }
  u32x4 kreg[NKC], vreg[NVC];
  auto loadK = [&](int t) {
#pragma unroll
    for (int i = 0; i < NKC; ++i) kreg[i] = gld16(kg[i] + (size_t)t * KEYS * ldk);
  };
  auto loadV = [&](int t) {
#pragma unroll
    for (int i = 0; i < NVC; ++i) vreg[i] = gld16(vg[i] + (size_t)t * 8192);
  };
  auto waitK = [&]() {
    if constexpr (NKC == 1) wait_vm0(kreg[0]);
    else if constexpr (NKC == 2) wait_vm0(kreg[0], kreg[1]);
    else wait_vm0(kreg[0], kreg[1], kreg[2]);
  };
  auto waitV = [&]() {
    if constexpr (NVC == 1) wait_vm0(vreg[0]);
    else wait_vm0(vreg[0], vreg[1]);
  };
  auto storeK = [&](int slot) {
#pragma unroll
    for (int i = 0; i < NKC; ++i) *(u32x4*)(sK + slot * KSLOT + kso[i]) = kreg[i];
  };
  auto storeV = [&](int slot) {
#pragma unroll
    for (int i = 0; i < NVC; ++i) *(u32x4*)(sV + slot * VSLOT + vso[i]) = vreg[i];
  };

  f32x16 S0[2], S1[2];
  bf16x8 pfA[2][2], pfB[2][2];
  float alpha_pend = 1.f;
  bool need_pend = false;

  auto att_S = [&](auto uu_t, f32x16 (&S)[2], int slot) {
    constexpr int UU = decltype(uu_t)::value;
    constexpr int C = (NCOMP == 2) ? UU : 0;
    const u16* base = sK + slot * KSLOT + ((NCOMP == 1 ? UU * 64 : 0) + r) * KSTR + (NCOMP == 2 ? UU * DC : 0) + 8 * h;
#pragma unroll
    for (int kb = 0; kb < 2; ++kb) {
#pragma unroll
      for (int v = 0; v < 16; ++v) S[kb][v] = 0.f;
#pragma unroll
      for (int ks = 0; ks < KS; ++ks) {
        bf16x8 kf = *(const bf16x8*)(base + kb * 32 * KSTR + ks * 16);
        S[kb] = MFMA32(kf, qf[C][ks], S[kb]);
      }
    }
  };
  auto att_PV = [&](auto uu_t, const bf16x8 (&pf)[2][2], int slot) {
    constexpr int UU = decltype(uu_t)::value;
    constexpr int C = (NCOMP == 2) ? UU : 0;
    const u16* base = sV + slot * VSLOT + r * VSTR + (NCOMP == 1 ? UU * 64 : 0) + 8 * h;
#pragma unroll
    for (int d = 0; d < 2; ++d)
#pragma unroll
      for (int kb = 0; kb < 2; ++kb)
#pragma unroll
        for (int s = 0; s < 2; ++s) {
          bf16x8 vf = *(const bf16x8*)(base + d * 32 * VSTR + kb * 32 + 16 * s);
          Oa[C][d] = MFMA32(vf, pf[kb][s], Oa[C][d]);
        }
  };
  auto att_rescale = [&](auto uu_t) {
    constexpr int UU = decltype(uu_t)::value;
    constexpr int C = (NCOMP == 2) ? UU : 0;
    if (need_pend) {
#pragma unroll
      for (int d = 0; d < 2; ++d)
#pragma unroll
        for (int v = 0; v < 16; ++v) Oa[C][d][v] *= alpha_pend;
    }
  };
  auto att_softmax = [&](auto uu_t, f32x16 (&S)[2], bf16x8 (&pf)[2][2], int kpos0) {
    constexpr int UU = decltype(uu_t)::value;
    constexpr int C = (NCOMP == 2) ? UU : 0;
    if constexpr (BAND) {
#pragma unroll
      for (int kb = 0; kb < 2; ++kb)
#pragma unroll
        for (int v = 0; v < 16; ++v) {
          const int d = kpos0 + kb * 32 + crow(v, h) - qtok;
          if (d > 128 || d < -128) S[kb][v] = -1e30f;
        }
    }
    float mx = S[0][0];
#pragma unroll
    for (int kb = 0; kb < 2; ++kb)
#pragma unroll
      for (int v = 0; v < 16; ++v) mx = fmaxf(mx, S[kb][v]);
    mx = fmaxf(mx, __shfl_xor(mx, 32));
    const float mold = m[C];
    const float mcand = fmaxf(mold, mx * sc_l2);
    const bool grow = __builtin_amdgcn_ballot_w64(mcand > mold + 6.0f) != 0;
    const float mnew = grow ? mcand : mold;
    need_pend = grow;
    alpha_pend = __builtin_amdgcn_exp2f(mold - mnew);
    m[C] = mnew;
    float rsum = 0.f;
#pragma unroll
    for (int kb = 0; kb < 2; ++kb)
#pragma unroll
      for (int v = 0; v < 16; ++v) {
        float p = __builtin_amdgcn_exp2f(__builtin_fmaf(S[kb][v], sc_l2, -mnew));
        S[kb][v] = p;
        rsum += p;
      }
    l[C] = l[C] * alpha_pend + rsum;
#pragma unroll
    for (int kb = 0; kb < 2; ++kb)
#pragma unroll
      for (int s = 0; s < 2; ++s) {
        u32x4 pk;
        pk.x = pk2(S[kb][8 * s + 0], S[kb][8 * s + 1]);
        pk.y = pk2(S[kb][8 * s + 2], S[kb][8 * s + 3]);
        pk.z = pk2(S[kb][8 * s + 4], S[kb][8 * s + 5]);
        pk.w = pk2(S[kb][8 * s + 6], S[kb][8 * s + 7]);
        pf[kb][s] = __builtin_bit_cast(bf16x8, pk);
      }
  };
  using U0 = std::integral_constant<int, 0>;
  using U1 = std::integral_constant<int, 1>;

  const int ntl = (kend - kbeg) / KEYS;
  auto step = [&](auto first_t, auto lk_t, auto lv_t, int t, int sa, int sb, int sc) {
    constexpr bool FIRST = decltype(first_t)::value, LK = decltype(lk_t)::value, LV = decltype(lv_t)::value;
    if constexpr (LK) loadK(t + 2);
    if constexpr (LV) loadV(t + 1);
    if constexpr (!FIRST) att_rescale(U1{});
    att_S(U1{}, S1, sa);
    if constexpr (!FIRST) att_PV(U1{}, pfB, sc);
    att_softmax(U0{}, S0, pfA, kbeg + t * KEYS);
    att_rescale(U0{});
    if constexpr (LV) att_S(U0{}, S0, sb);
    att_PV(U0{}, pfA, sa);
    att_softmax(U1{}, S1, pfB, kbeg + t * KEYS + 64);
    if constexpr (LK) { waitK(); storeK(sc); }
    if constexpr (LV) { waitV(); storeV(sb); }
    __syncthreads();
  };
  using TT = std::true_type;
  using FF = std::false_type;

  loadK(0); loadV(0);
  waitK(); waitV();
  storeK(0); storeV(0);
  loadK(1);
  waitK();
  storeK(1);
  __syncthreads();
  att_S(U0{}, S0, 0);
  int sa = 0, sb = 1, sc = 2;
  step(TT{}, TT{}, TT{}, 0, sa, sb, sc);
  { int tmp = sa; sa = sb; sb = sc; sc = tmp; }
  for (int t = 1; t < ntl - 2; ++t) {
    step(FF{}, TT{}, TT{}, t, sa, sb, sc);
    int tmp = sa; sa = sb; sb = sc; sc = tmp;
  }
  step(FF{}, FF{}, TT{}, ntl - 2, sa, sb, sc);
  { int tmp = sa; sa = sb; sb = sc; sc = tmp; }
  step(FF{}, FF{}, FF{}, ntl - 1, sa, sb, sc);
  att_rescale(U1{});
  att_PV(U1{}, pfB, sa);

  float inv[NCOMP];
#pragma unroll
  for (int c = 0; c < NCOMP; ++c) {
    float lt = l[c] + __shfl_xor(l[c], 32);
    inv[c] = 1.f / lt;
  }
  if constexpr (EPI == 1) {
#pragma unroll
    for (int d = 0; d < 2; ++d)
#pragma unroll
      for (int vq = 0; vq < 4; ++vq) {
        float4 o = {Oa[0][d][4 * vq] * inv[0], Oa[0][d][4 * vq + 1] * inv[0], Oa[0][d][4 * vq + 2] * inv[0], Oa[0][d][4 * vq + 3] * inv[0]};
        *(float4*)(DS + (size_t)qtok * 256 + d * 32 + 8 * vq + 4 * h) = o;
      }
  } else {
    if constexpr (EPI == 2) {
      float ss = 0.f;
#pragma unroll
      for (int d = 0; d < 2; ++d)
#pragma unroll
        for (int vq = 0; vq < 4; ++vq) {
          const float4 o1 = *(const float4*)(DS + (size_t)qtok * 256 + d * 32 + 8 * vq + 4 * h);
          const float a0 = o1.x - lam * Oa[0][d][4 * vq] * inv[0];
          const float a1 = o1.y - lam * Oa[0][d][4 * vq + 1] * inv[0];
          const float a2 = o1.z - lam * Oa[0][d][4 * vq + 2] * inv[0];
          const float a3 = o1.w - lam * Oa[0][d][4 * vq + 3] * inv[0];
          Oa[0][d][4 * vq] = a0; Oa[0][d][4 * vq + 1] = a1; Oa[0][d][4 * vq + 2] = a2; Oa[0][d][4 * vq + 3] = a3;
          ss += a0 * a0 + a1 * a1 + a2 * a2 + a3 * a3;
        }
      ss += __shfl_xor(ss, 32);
      const float rs = rsqrtf(ss * (1.f / 64.f) + EPS) * onorm;
#pragma unroll
      for (int d = 0; d < 2; ++d)
#pragma unroll
        for (int v = 0; v < 16; ++v) Oa[0][d][v] *= rs * subg[d * 32 + crow(v, h)];
    } else {
#pragma unroll
      for (int d = 0; d < 2; ++d)
#pragma unroll
        for (int v = 0; v < 16; ++v) Oa[0][d][v] *= inv[0];
    }
    store_rows(O, KP1, 0, Oa[0][0], qtok, h);
    store_rows(O, KP1, 32, Oa[0][1], qtok, h);
  }
  __syncthreads();
}

DI void attn_phase(const Params& P, int layer, char* smem) {
  char* ws = P.ws;
  u16* qkv = (u16*)(ws + OFF_QKV);
  u16* BR = (u16*)(ws + OFF_XN);
  const float L2E = 1.4426950408889634f;
  const float lambda_init = 0.8f - 0.6f * __expf(-0.3f * (float)layer);
  float lam;
  {
    const float* dl = P.d_lambda + layer * 128;
    float s1 = 0.f, s2 = 0.f;
    for (int i = 0; i < 32; ++i) { s1 += dl[i] * dl[32 + i]; s2 += dl[64 + i] * dl[96 + i]; }
    lam = __expf(s1) - __expf(s2) + lambda_init;
    lam = __int_as_float(__builtin_amdgcn_readfirstlane(__float_as_int(lam)));
  }
  const float onorm_u = __int_as_float(__builtin_amdgcn_readfirstlane(__float_as_int(1.f - lambda_init)));
  for (int it = blockIdx.x; it < 2048; it += gridDim.x) {
    const int cls = it >> 8;
    if (cls < 6) {
      const int idx = it & 255;
      const int head = (idx & 7) >> 1;
      const int qb = ((idx >> 3) << 1) + (idx & 1);
      int qtok0, kbeg, kend;
      if (cls < 3) { qtok0 = qb * 256; kbeg = 0; kend = SEQ0; }
      else { const int s = qb >> 3; kbeg = SEQ0 + s * DSEQ; kend = kbeg + DSEQ; qtok0 = kbeg + (qb & 7) * 256; }
      const int typ = cls % 3;
      if (typ == 0) {
        float* DS = (float*)(ws + OFF_DS) + head * 64;
        attn_item<32, 1, false, 1>(qkv + Q_QD + head * 64, 256, qkv + Q_KD + head * 64, 256,
                                   qkv + Q_VTD + (size_t)head * 64 * T, qtok0, kbeg, kend,
                                   0.17677669529663687f * L2E, 0.f, lam, onorm_u,
                                   P.d_subln + layer * 64, BR + 768 + head * 64, DS, smem);
        attn_item<32, 1, false, 2>(qkv + Q_QD + head * 64 + 32, 256, qkv + Q_KD + head * 64 + 32, 256,
                                   qkv + Q_VTD + (size_t)head * 64 * T, qtok0, kbeg, kend,
                                   0.17677669529663687f * L2E, 0.f, lam, onorm_u,
                                   P.d_subln + layer * 64, BR + 768 + head * 64, DS, smem);
      } else if (typ == 1) {
        attn_item<96, 1, false, 0>(qkv + Q_QC + head * 96, 384, qkv + Q_KC + head * 96, 384,
                                       qkv + Q_VTC + (size_t)head * 64 * T, qtok0, kbeg, kend,
                                       0.10206207261596577f * L2E, 0.f, 0.f, 1.f, nullptr, BR + 512 + head * 64, nullptr, smem);
      } else {
        attn_item<64, 1, false, 0>(qkv + Q_QA + head * 64, 256, qkv + Q_KA + (head >> 1) * 64, 128,
                                       qkv + Q_VTA + (size_t)(head >> 1) * 64 * T, qtok0, kbeg, kend,
                                       0.125f * L2E, 0.f, 0.f, 1.f, nullptr, BR + head * 64, nullptr, smem);
      }
    } else {
      const int idx = it - 1536;
      const int head = (idx & 7) >> 1;
      const int qbg = ((idx >> 3) << 1) + (idx & 1);
      const int qtok0 = qbg * 256;
      int sb, se;
      if (qtok0 < SEQ0) { sb = 0; se = SEQ0; }
      else { sb = SEQ0 + ((qtok0 - SEQ0) / DSEQ) * DSEQ; se = sb + DSEQ; }
      const int kbeg = max(sb, qtok0 - 128), kend = min(se, qtok0 + 256 + 128);
      const float sink = P.b_sink[layer * 4 + head];
      attn_item<64, 1, true, 0>(qkv + Q_QB + head * 64, 256, qkv + Q_KB + (head >> 1) * 64, 128,
                                    qkv + Q_VTB + (size_t)(head >> 1) * 64 * T, qtok0, kbeg, kend,
                                    0.125f * L2E, sink * L2E, 0.f, 1.f, nullptr, BR + 256 + head * 64, nullptr, smem);
    }
  }
}

DI void ew_phase(const Params& P, const u16* __restrict__ Y, float coef, const float* __restrict__ gpost,
                 const float* __restrict__ gnext, bool from_inputs) {
  const int tid = opaque_tid();
  const int lane = tid & 63, wave = tid >> 6;
  u16* XN = (u16*)(P.ws + OFF_XN);
  u16* XB = (u16*)(P.ws + OFF_XB);
  for (int tok = blockIdx.x * 8 + wave; tok < T; tok += gridDim.x * 8) {
    float4 x[4];
    if (from_inputs) {
      const float* xs = tok < SEQ0 ? P.x_prompt + (size_t)tok * DM : P.x_sample + (size_t)(tok - SEQ0) * DM;
#pragma unroll
      for (int i = 0; i < 4; ++i) x[i] = *(const float4*)(xs + (i * 64 + lane) * 4);
    } else {
#pragma unroll
      for (int i = 0; i < 4; ++i) {
        const uint2 xb = *(const uint2*)(XB + (size_t)tok * DM + (i * 64 + lane) * 4);
        x[i] = make_float4(bf2f(xb.x & 0xffffu), bf2f(xb.x >> 16), bf2f(xb.y & 0xffffu), bf2f(xb.y >> 16));
      }
    }
    if (Y) {
      float4 y[4];
      float ss = 0.f;
#pragma unroll
      for (int i = 0; i < 4; ++i) {
        const uint2 yb = *(const uint2*)(Y + (size_t)tok * KP1 + (i * 64 + lane) * 4);
        y[i] = make_float4(bf2f(yb.x & 0xffffu), bf2f(yb.x >> 16), bf2f(yb.y & 0xffffu), bf2f(yb.y >> 16));
        ss += y[i].x * y[i].x + y[i].y * y[i].y + y[i].z * y[i].z + y[i].w * y[i].w;
      }
      ss = wave_sum(ss);
      const float rs = rsqrtf(ss * (1.f / 1024.f) + EPS) * coef;
#pragma unroll
      for (int i = 0; i < 4; ++i) {
        float4 g = *(const float4*)(gpost + (i * 64 + lane) * 4);
        x[i].x += y[i].x * rs * g.x; x[i].y += y[i].y * rs * g.y;
        x[i].z += y[i].z * rs * g.z; x[i].w += y[i].w * rs * g.w;
      }
    }
    if (!gnext) {
#pragma unroll
      for (int i = 0; i < 4; ++i) *(float4*)(P.out + (size_t)tok * DM + (i * 64 + lane) * 4) = x[i];
    } else {
#pragma unroll
      for (int i = 0; i < 4; ++i) {
        uint2 pk;
        pk.x = pk2(x[i].x, x[i].y);
        pk.y = pk2(x[i].z, x[i].w);
        *(uint2*)(XB + (size_t)tok * DM + (i * 64 + lane) * 4) = pk;
      }
    }
    if (gnext) {
      float ss = 0.f;
#pragma unroll
      for (int i = 0; i < 4; ++i) ss += x[i].x * x[i].x + x[i].y * x[i].y + x[i].z * x[i].z + x[i].w * x[i].w;
      ss = wave_sum(ss);
      const float rs = rsqrtf(ss * (1.f / 1024.f) + EPS);
#pragma unroll
      for (int i = 0; i < 4; ++i) {
        float4 g = *(const float4*)(gnext + (i * 64 + lane) * 4);
        uint2 pk;
        pk.x = pk2(x[i].x * rs * g.x, x[i].y * rs * g.y);
        pk.y = pk2(x[i].z * rs * g.z, x[i].w * rs * g.w);
        *(uint2*)(XN + (size_t)tok * KP1 + (i * 64 + lane) * 4) = pk;
      }
    }
  }
}

DI int colmap(int mode, int n, int nsrc) {
  if (mode == 1) { return ((n >> 7) & 1) * DFF + (n >> 8) * 128 + (n & 127); }
  if (mode == 2) {
    if (n < 2560) {
      const int w = n & 255;
      n = (n & ~255) + ((w >> 5) & 3) * 64 + (w >> 7) * 32 + (w & 31);
    }
    if (n < 1664) return n;
    if (n < 2432) return n + 32;
    if (n < 2464) return n - 2432 + 1664;
    if (n < 2560) return -1;
    return n - 96;
  }
  return n < nsrc ? n : -1;
}
DI void conv_job(u16* __restrict__ dst, int ldd, const float* __restrict__ src, int Nd, int K, int lds, int mode,
                 const float* __restrict__ kscale) {
  const int total = Nd * (K >> 3);
  const int gthreads = gridDim.x * NTHR;
  for (int idx = blockIdx.x * NTHR + opaque_tid(); idx < total; idx += gthreads) {
    const int n = idx % Nd, k8 = idx / Nd;
    const int col = colmap(mode, n, lds);
    float v[8];
#pragma unroll
    for (int j = 0; j < 8; ++j) {
      float x = 0.f;
      if (col >= 0) {
        x = src[(size_t)(k8 * 8 + j) * lds + col];
        if (kscale) x *= kscale[k8 * 8 + j];
      }
      v[j] = x;
    }
    uint4 pk = {pk2(v[0], v[1]), pk2(v[2], v[3]), pk2(v[4], v[5]), pk2(v[6], v[7])};
    *(uint4*)(dst + (size_t)n * ldd + k8 * 8) = pk;
  }
}
DI void convert_layer(const Params& P, int l) {
  u16* W = (u16*)(P.ws + OFF_W);
  for (int s = 0; s < 2; ++s) {
    conv_job(W + W_WI + (size_t)s * 5632 * KP1, KP1, P.ffn_wi + ((size_t)l * 2 + s) * 1024 * 5632, 5632, 1024, 5632, 1, nullptr);
    conv_job(W + W_WO + (size_t)s * 1024 * KP2, KP2, P.ffn_wo + ((size_t)l * 2 + s) * 2816 * 1024, 1024, 2816, 1024, 0, nullptr);
  }
  conv_job(W + W_WIN, KP1, P.w_in + (size_t)l * 1024 * NPROJ, 6656, 1024, NPROJ, 2, nullptr);
  conv_job(W + W_WUQ, 384, P.c_w_uq + (size_t)l * 384 * 384, 512, 384, 384, 0, P.c_q_norm + l * 384);
  conv_job(W + W_WUKV, 256, P.c_w_ukv + (size_t)l * 256 * 512, 512, 256, 512, 0, P.c_kv_norm + l * 256);
  conv_job(W + W_WB, KP1, P.w_branch + (size_t)l * 1024 * 1024, 1024, 1024, 1024, 0, nullptr);
  conv_job(W + W_WOUT, KP1, P.w_out + (size_t)l * 1024 * 1024, 1024, 1024, 1024, 0, nullptr);
}
DI void rope_tables(const Params& P) {
  float2* R64 = (float2*)(P.ws + OFF_R64);
  float2* R32 = (float2*)(P.ws + OFF_R32);
  const int gthreads = gridDim.x * NTHR;
  for (int idx = blockIdx.x * NTHR + opaque_tid(); idx < 16384 * 48; idx += gthreads) {
    int pos, f; double base; float2* dst;
    if (idx < 16384 * 32) { pos = idx >> 5; f = idx & 31; base = 0.7498942093324559; dst = R64 + idx; }
    else { const int i2 = idx - 16384 * 32; pos = i2 >> 4; f = i2 & 15; base = 0.5623413251903491; dst = R32 + i2; }
    double inv = 1.0;
    for (int k = 0; k < f; ++k) inv *= base;
    const float ang = (float)pos * (float)inv;
    double tr = (double)ang * 0.15915494309189535;
    tr -= rint(tr);
    const float tf = (float)tr;
    *dst = make_float2(__builtin_amdgcn_cosf(tf), __builtin_amdgcn_sinf(tf));
  }
}

DI void fast_grid_barrier(unsigned* bar, unsigned nblk) {
  asm volatile("s_waitcnt vmcnt(0) lgkmcnt(0)" ::: "memory");
  __syncthreads();
  if (threadIdx.x == 0) {
    __builtin_amdgcn_fence(__ATOMIC_RELEASE, "agent");
    asm volatile("s_waitcnt vmcnt(0) lgkmcnt(0)" ::: "memory");
    const unsigned gen = __hip_atomic_load(&bar[64], __ATOMIC_RELAXED, __HIP_MEMORY_SCOPE_AGENT);
    const unsigned old = __hip_atomic_fetch_add(&bar[0], 1u, __ATOMIC_RELAXED, __HIP_MEMORY_SCOPE_AGENT);
    if (old == nblk - 1u) {
      __hip_atomic_store(&bar[0], 0u, __ATOMIC_RELAXED, __HIP_MEMORY_SCOPE_AGENT);
      __hip_atomic_fetch_add(&bar[64], 1u, __ATOMIC_RELEASE, __HIP_MEMORY_SCOPE_AGENT);
    } else {
      while (__hip_atomic_load(&bar[64], __ATOMIC_RELAXED, __HIP_MEMORY_SCOPE_AGENT) == gen) __builtin_amdgcn_s_sleep(1);
    }
    __builtin_amdgcn_fence(__ATOMIC_ACQUIRE, "agent");
    asm volatile("s_waitcnt vmcnt(0) lgkmcnt(0)" ::: "memory");
  }
  __syncthreads();
}

__global__ void __launch_bounds__(NTHR) __attribute__((amdgpu_waves_per_eu(2, 2))) mega(Params P) {
  extern __shared__ __attribute__((aligned(16))) char smem[];
  cg::grid_group grid = cg::this_grid();
  int phase = 0;
#if MULTI_LAUNCH
#define ACTIVE() (phase >= P.phase_lo && phase < P.phase_hi)
#define SEAM() do { ++phase; } while (0)
#else
#define ACTIVE() (true)
#define SEAM() do { ++phase; if (phase == 1) grid.sync(); else fast_grid_barrier((unsigned*)(P.ws + OFF_BAR), gridDim.x); } while (0)
#endif
  u16* W = (u16*)(P.ws + OFF_W);
  u16* XN = (u16*)(P.ws + OFF_XN);
  u16* R2 = (u16*)(P.ws + OFF_R2);
  u16* qkv = (u16*)(P.ws + OFF_QKV);
  const u16* Y = qkv + Q_Y;
#define PTRS

  if (ACTIVE()) { PTRS
    rope_tables(P);
    convert_layer(P, 0);
    ew_phase(P, nullptr, 0.f, nullptr, P.norm_g, true);
  }
  SEAM();
  for (int l = 0; l < 4; ++l) {
    const float* g = P.norm_g + (size_t)l * 6 * DM;
    if (ACTIVE()) { PTRS gemm8_phase<5632, DM, KP1>(XN, W + W_WI, EpiFfnUp8{R2}, smem); }
    SEAM();
    if (ACTIVE()) { PTRS gemm8_phase<1024, DFF, KP2>(R2, W + W_WO, EpiY8{qkv + Q_Y}, smem); }
    SEAM();
    if (ACTIVE()) { PTRS ew_phase(P, Y, 0.5f, g + DM, g + 2 * DM, false); }
    SEAM();
    if (ACTIVE()) { PTRS
      gemm8_phase<2560, DM, KP1>(XN, W + W_WIN, EpiProj8{&P, l}, smem);
      gemm8_phase<4096, DM, KP1>(XN, W + W_WIN + 2560ull * KP1, EpiGate8{(unsigned char*)R2}, smem);
    }
    SEAM();
    if (ACTIVE()) { PTRS
      gemm_phase<M_CUQ, 4>(W + W_WUQ, 384, qkv + Q_CQ, 384, 384, 2, smem, P, l);
      gemm_phase<M_CUKV, 4>(W + W_WUKV, 256, qkv + Q_CKV, 256, 256, 2, smem, P, l);
    }
    SEAM();
    if (ACTIVE()) { PTRS attn_phase(P, l, smem); }
    SEAM();
    if (ACTIVE()) { PTRS gemm_phase<M_MERGE, 2>(W + W_WB, KP1, XN, KP1, DM, 4, smem, P, l); }
    SEAM();
    if (ACTIVE()) { PTRS gemm8_phase<1024, DM, KP1>(qkv + Q_MERGED, W + W_WOUT, EpiY8{qkv + Q_Y}, smem); }
    SEAM();
    if (ACTIVE()) { PTRS ew_phase(P, Y, 1.0f, g + 3 * DM, g + 4 * DM, false); }
    SEAM();
    if (ACTIVE()) { PTRS gemm8_phase<5632, DM, KP1>(XN, W + W_WI + 5632ull * KP1, EpiFfnUp8{R2}, smem); }
    SEAM();
    if (ACTIVE()) { PTRS gemm8_phase<1024, DFF, KP2>(R2, W + W_WO + 1024ull * KP2, EpiY8{qkv + Q_Y}, smem); }
    SEAM();
    if (ACTIVE()) { PTRS
      ew_phase(P, Y, 0.5f, g + 5 * DM, l < 3 ? g + 6 * DM : nullptr, false);
      if (l < 3) convert_layer(P, l + 1);
    }
    SEAM();
  }
}

constexpr int N_PHASES = 1 + 12 * 4;

extern "C" void kernel_launch(void* const* d_in, const int* in_sizes, int n_in, void* d_out, int out_size, void* d_ws,
                              size_t ws_size, hipStream_t stream) {
  static int grid_blocks = 0;
  if (!grid_blocks) {
    int dev = 0, cus = 0, per_cu = 0;
    hipGetDevice(&dev);
    hipDeviceGetAttribute(&cus, hipDeviceAttributeMultiprocessorCount, dev);
    hipFuncSetAttribute((const void*)mega, hipFuncAttributeMaxDynamicSharedMemorySize, SMEM_BYTES);
    hipOccupancyMaxActiveBlocksPerMultiprocessor(&per_cu, mega, NTHR, SMEM_BYTES);
    if (per_cu < 1) per_cu = 1;
    grid_blocks = cus * per_cu;
  }
  if (ws_size < WS_NEEDED) fprintf(stderr, "workspace too small: %zu < %zu\n", ws_size, (size_t)WS_NEEDED);
  Params P{};
  P.x_prompt = (const float*)d_in[0]; P.x_sample = (const float*)d_in[1]; P.norm_g = (const float*)d_in[2];
  P.w_in = (const float*)d_in[3]; P.a_qk_norm = (const float*)d_in[4]; P.b_sink = (const float*)d_in[5];
  P.c_q_norm = (const float*)d_in[6]; P.c_kv_norm = (const float*)d_in[7]; P.c_w_uq = (const float*)d_in[8];
  P.c_w_ukv = (const float*)d_in[9]; P.d_lambda = (const float*)d_in[10]; P.d_subln = (const float*)d_in[11];
  P.w_branch = (const float*)d_in[12]; P.w_out = (const float*)d_in[13]; P.ffn_wi = (const float*)d_in[14];
  P.ffn_wo = (const float*)d_in[15];
  P.out = (float*)d_out; P.ws = (char*)d_ws;
#if MULTI_LAUNCH
  for (int ph = 0; ph < N_PHASES; ++ph) {
    P.phase_lo = ph; P.phase_hi = ph + 1; P.coop = 0; P.pad0 = 0;
    hipLaunchKernelGGL(mega, dim3(grid_blocks), dim3(NTHR), SMEM_BYTES, stream, P);
  }
#else
  P.phase_lo = 0; P.phase_hi = 1 << 30; P.coop = 1; P.pad0 = 0;
  hipMemsetAsync((char*)d_ws + OFF_BAR, 0, 1024, stream);
  void* args[] = {&P};
  hipError_t e = hipLaunchCooperativeKernel((const void*)mega, dim3(grid_blocks), dim3(NTHR), args, SMEM_BYTES, stream);
  if (e != hipSuccess) fprintf(stderr, "cooperative launch failed: %s (grid %d)\n", hipGetErrorString(e), grid_blocks);
#endif
}
```

```cpp
#include <hip/hip_runtime.h>
#include <hip/hip_cooperative_groups.h>
#include <cstdio>
#include <cstdint>
#include <type_traits>
namespace cg = cooperative_groups;

#ifndef MULTI_LAUNCH
#define MULTI_LAUNCH 0
#endif

#define DI __device__ __forceinline__
typedef unsigned short u16;
typedef __attribute__((ext_vector_type(8))) short bf16x8;
typedef __attribute__((ext_vector_type(16))) float f32x16;
typedef __attribute__((ext_vector_type(2))) float f32x2_t;
typedef __attribute__((ext_vector_type(2))) __bf16 bf16x2_t;

constexpr int T = 32768;
constexpr int DM = 1024;
constexpr int DFF = 2816;
constexpr int KP1 = 1088;
constexpr int KP2 = 2880;
constexpr int GP = 4160;
constexpr int YP = 1040;
constexpr int NPROJ = 6560;
constexpr int SEQ0 = 16384;
constexpr int DSEQ = 2048;
constexpr float EPS = 1e-6f;
constexpr int NTHR = 512;
constexpr int LSTR = 72;
constexpr int SMEM_BYTES = 2 * 2 * 256 * LSTR * 2;

constexpr size_t W_WI = 0;
constexpr size_t W_WO = W_WI + 2ull * 5632 * KP1;
constexpr size_t W_WIN = W_WO + 2ull * 1024 * KP2;
constexpr size_t W_WUQ = W_WIN + 6656ull * KP1;
constexpr size_t W_WUKV = W_WUQ + 512ull * 384;
constexpr size_t W_WB = W_WUKV + 512ull * 256;
constexpr size_t W_WOUT = W_WB + 1024ull * KP1;
constexpr size_t W_TOTAL = W_WOUT + 1024ull * KP1;

constexpr size_t OFF_W = 0;
constexpr size_t OFF_XN = OFF_W + W_TOTAL * 2;
constexpr size_t OFF_R2 = OFF_XN + (size_t)T * KP1 * 2;
constexpr size_t OFF_QKV = OFF_R2 + (size_t)T * KP2 * 2;
constexpr size_t OFF_SS = OFF_QKV + (size_t)T * 3456 * 2;
constexpr size_t OFF_R64 = OFF_SS + (size_t)T * 20 * 4;
constexpr size_t OFF_R32 = OFF_R64 + 16384ull * 32 * 8;
constexpr size_t OFF_DS = OFF_R32 + 16384ull * 16 * 8;
constexpr size_t OFF_BAR = OFF_DS + (size_t)T * 256 * 4;
constexpr size_t OFF_XB = OFF_BAR + 1024;
constexpr size_t WS_NEEDED = OFF_XB + (size_t)T * 1024 * 2;

constexpr size_t Q_QA = 0;
constexpr size_t Q_KA = (size_t)T * 256;
constexpr size_t Q_VTA = (size_t)T * 384;
constexpr size_t Q_QB = (size_t)T * 512;
constexpr size_t Q_KB = (size_t)T * 768;
constexpr size_t Q_VTB = (size_t)T * 896;
constexpr size_t Q_CQ = (size_t)T * 1024;
constexpr size_t Q_CKV = (size_t)T * 1408;
constexpr size_t Q_QC = (size_t)T * 1664;
constexpr size_t Q_KC = (size_t)T * 2048;
constexpr size_t Q_VTC = (size_t)T * 2432;
constexpr size_t Q_QD = (size_t)T * 2688;
constexpr size_t Q_KD = (size_t)T * 2944;
constexpr size_t Q_VTD = (size_t)T * 3200;
constexpr size_t Q_MERGED = 0;
constexpr size_t Q_Y = (size_t)T * KP1;

struct Params {
  const float* x_prompt; const float* x_sample; const float* norm_g; const float* w_in;
  const float* a_qk_norm; const float* b_sink; const float* c_q_norm; const float* c_kv_norm;
  const float* c_w_uq; const float* c_w_ukv; const float* d_lambda; const float* d_subln;
  const float* w_branch; const float* w_out; const float* ffn_wi; const float* ffn_wo;
  float* out; char* ws;
  int phase_lo; int phase_hi; int coop; int pad0;
};

DI unsigned pk2(float a, float b) {
  f32x2_t v = {a, b};
  bf16x2_t r = __builtin_convertvector(v, bf16x2_t);
  return __builtin_bit_cast(unsigned, r);
}
DI u16 f2bf(float a) { return (u16)(pk2(a, 0.f) & 0xffffu); }
DI float bf2f(unsigned bits16) { return __uint_as_float(bits16 << 16); }
DI int crow(int v, int h) { return (v & 3) + 8 * (v >> 2) + 4 * h; }
DI int pos_of(int tok) { return tok < SEQ0 ? tok : ((tok - SEQ0) & (DSEQ - 1)); }
#define MFMA32(a, b, c) __builtin_amdgcn_mfma_f32_32x32x16_bf16((a), (b), (c), 0, 0, 0)

typedef __attribute__((ext_vector_type(4))) unsigned u32x4;
DI u32x4 gld16(const void* p) { u32x4 r; asm volatile("global_load_dwordx4 %0, %1, off" : "=v"(r) : "v"(p)); return r; }
DI void wait_vm0(u32x4& a) { asm volatile("s_waitcnt vmcnt(0)" : "+v"(a) :: "memory"); }
DI void wait_vm0(u32x4& a, u32x4& b) { asm volatile("s_waitcnt vmcnt(0)" : "+v"(a), "+v"(b) :: "memory"); }
DI void wait_vm0(u32x4& a, u32x4& b, u32x4& c) { asm volatile("s_waitcnt vmcnt(0)" : "+v"(a), "+v"(b), "+v"(c) :: "memory"); }
DI void wait_vm0(u32x4& a, u32x4& b, u32x4& c, u32x4& d) { asm volatile("s_waitcnt vmcnt(0)" : "+v"(a), "+v"(b), "+v"(c), "+v"(d) :: "memory"); }
DI u32x4 gld16s(unsigned voff, const void* sbase) { u32x4 r; asm volatile("global_load_dwordx4 %0, %1, %2" : "=v"(r) : "v"(voff), "s"(sbase)); return r; }
#define DEF_WAIT8(name, cnt) DI void name(u32x4& a, u32x4& b, u32x4& c, u32x4& d, u32x4& e, u32x4& f, u32x4& g, u32x4& h) { asm volatile("s_waitcnt vmcnt(" #cnt ")" : "+v"(a), "+v"(b), "+v"(c), "+v"(d), "+v"(e), "+v"(f), "+v"(g), "+v"(h) :: "memory"); }
#define DEF_WAIT6(name, cnt) DI void name(u32x4& a, u32x4& b, u32x4& c, u32x4& d, u32x4& e, u32x4& f) { asm volatile("s_waitcnt vmcnt(" #cnt ")" : "+v"(a), "+v"(b), "+v"(c), "+v"(d), "+v"(e), "+v"(f) :: "memory"); }
DEF_WAIT8(wait8_vm8, 8)
DEF_WAIT8(wait8_vm0, 0)
DEF_WAIT6(wait6_vm6, 6)
DEF_WAIT6(wait6_vm0, 0)
DI int opaque_tid() { int t = threadIdx.x; asm volatile("" : "+v"(t)); return t; }
DI float wave_sum(float v) {
#pragma unroll
  for (int m = 32; m >= 1; m >>= 1) v += __shfl_xor(v, m);
  return v;
}

DI void rope32_blk(f32x16& a, const float2* __restrict__ tab, int h) {
#pragma unroll
  for (int v = 0; v < 8; ++v) {
    float2 cs = tab[crow(v, h)];
    float x1 = a[v], x2 = a[v + 8];
    a[v] = x1 * cs.x - x2 * cs.y;
    a[v + 8] = x2 * cs.x + x1 * cs.y;
  }
}
DI void rope64_blk(f32x16& a0, f32x16& a1, const float2* __restrict__ tab, int h) {
#pragma unroll
  for (int v = 0; v < 16; ++v) {
    float2 cs = tab[crow(v, h)];
    float x1 = a0[v], x2 = a1[v];
    a0[v] = x1 * cs.x - x2 * cs.y;
    a1[v] = x2 * cs.x + x1 * cs.y;
  }
}
DI void store_rows(u16* __restrict__ base, int ld, int col0, const f32x16& a, int tok, int h) {
#pragma unroll
  for (int vq = 0; vq < 4; ++vq) {
    uint2 pk;
    pk.x = pk2(a[4 * vq], a[4 * vq + 1]);
    pk.y = pk2(a[4 * vq + 2], a[4 * vq + 3]);
    *(uint2*)(base + (size_t)tok * ld + col0 + 8 * vq + 4 * h) = pk;
  }
}
DI void store_T(u16* __restrict__ base, int row0, const f32x16& a, int tok, int h) {
  const int tp = (tok & ~12) | ((tok & 4) << 1) | ((tok & 8) >> 1);
#pragma unroll
  for (int v = 0; v < 16; ++v) base[(size_t)((row0 + crow(v, h)) >> 6) * 64 * T + (size_t)(tp >> 7) * 8192 + ((row0 + crow(v, h)) & 63) * 128 + (tp & 127)] = f2bf(a[v]);
}

enum { M_FFNUP = 0, M_Y = 1, M_PROJ = 2, M_CUQ = 3, M_CUKV = 4, M_MERGE = 5, M_GATE = 6 };

template <int MODE, int NJ>
DI void gemm_epilogue(f32x16 (&acc)[2][NJ], int fbase, int tbase, int r, int h, const Params& P, int layer) {
  char* ws = P.ws;
  u16* qkv = (u16*)(ws + OFF_QKV);
  const float2* R64 = (const float2*)(ws + OFF_R64);
  const float2* R32 = (const float2*)(ws + OFF_R32);
  float* SS = (float*)(ws + OFF_SS);
  if constexpr (MODE == M_FFNUP) {
    u16* H = (u16*)(ws + OFF_R2);
    const int hf0 = (fbase >> 6) * 32;
#pragma unroll
    for (int j = 0; j < NJ; ++j) {
      const int tok = tbase + j * 32 + r;
      f32x16 o;
#pragma unroll
      for (int v = 0; v < 16; ++v) {
        float g = acc[0][j][v], u = acc[1][j][v];
        o[v] = g * __builtin_amdgcn_rcpf(1.f + __builtin_amdgcn_exp2f(-1.4426950408889634f * g)) * u;
      }
      store_rows(H, KP2, hf0, o, tok, h);
    }
  } else if constexpr (MODE == M_Y) {
    u16* Yb = qkv + Q_Y;
#pragma unroll
    for (int j = 0; j < NJ; ++j) {
      const int tok = tbase + j * 32 + r;
      store_rows(Yb, KP1, fbase, acc[0][j], tok, h);
      store_rows(Yb, KP1, fbase + 32, acc[1][j], tok, h);
    }
  } else if constexpr (MODE == M_PROJ) {
    if (fbase < 384) {
      const bool isK = fbase >= 256;
      const float* g = P.a_qk_norm + layer * 128 + (isK ? 64 : 0);
      u16* dst = qkv + (isK ? Q_KA : Q_QA);
      const int ld = isK ? 128 : 256;
      const int c0 = isK ? fbase - 256 : fbase;
      float gv[2][16];
#pragma unroll
      for (int i = 0; i < 2; ++i)
#pragma unroll
        for (int v = 0; v < 16; ++v) gv[i][v] = g[i * 32 + crow(v, h)];
#pragma unroll
      for (int j = 0; j < NJ; ++j) {
        const int tok = tbase + j * 32 + r;
        const int pos = pos_of(tok);
        float ss = 0.f;
#pragma unroll
        for (int i = 0; i < 2; ++i)
#pragma unroll
          for (int v = 0; v < 16; ++v) ss += acc[i][j][v] * acc[i][j][v];
        ss += __shfl_xor(ss, 32);
        const float rs = rsqrtf(ss * (1.f / 64.f) + EPS);
#pragma unroll
        for (int i = 0; i < 2; ++i)
#pragma unroll
          for (int v = 0; v < 16; ++v) acc[i][j][v] *= rs * gv[i][v];
        rope32_blk(acc[0][j], R32 + (size_t)(pos >> 6) * 16, h);
        rope32_blk(acc[1][j], R32 + (size_t)(pos & 63) * 16, h);
        store_rows(dst, ld, c0, acc[0][j], tok, h);
        store_rows(dst, ld, c0 + 32, acc[1][j], tok, h);
      }
    } else if (fbase < 512) {
#pragma unroll
      for (int j = 0; j < NJ; ++j) {
        const int tok = tbase + j * 32 + r;
        store_T(qkv + Q_VTA, fbase - 384, acc[0][j], tok, h);
        store_T(qkv + Q_VTA, fbase - 384 + 32, acc[1][j], tok, h);
      }
    } else if (fbase < 896) {
      const bool isK = fbase >= 768;
      u16* dst = qkv + (isK ? Q_KB : Q_QB);
      const int ld = isK ? 128 : 256;
      const int c0 = isK ? fbase - 768 : fbase - 512;
#pragma unroll
      for (int j = 0; j < NJ; ++j) {
        const int tok = tbase + j * 32 + r;
        const int pos = pos_of(tok);
        rope64_blk(acc[0][j], acc[1][j], R64 + (size_t)pos * 32, h);
        store_rows(dst, ld, c0, acc[0][j], tok, h);
        store_rows(dst, ld, c0 + 32, acc[1][j], tok, h);
      }
    } else if (fbase < 1024) {
#pragma unroll
      for (int j = 0; j < NJ; ++j) {
        const int tok = tbase + j * 32 + r;
        store_T(qkv + Q_VTB, fbase - 896, acc[0][j], tok, h);
        store_T(qkv + Q_VTB, fbase - 896 + 32, acc[1][j], tok, h);
      }
    } else if (fbase < 1664) {
      const bool isKV = fbase >= 1408;
      u16* dst = qkv + (isKV ? Q_CKV : Q_CQ);
      const int ld = isKV ? 256 : 384;
      const int c0 = isKV ? fbase - 1408 : fbase - 1024;
      const int sb = (isKV ? 12 : 0) + (c0 >> 5);
#pragma unroll
      for (int j = 0; j < NJ; ++j) {
        const int tok = tbase + j * 32 + r;
#pragma unroll
        for (int i = 0; i < 2; ++i) {
          float ss = 0.f;
#pragma unroll
          for (int v = 0; v < 16; ++v) ss += acc[i][j][v] * acc[i][j][v];
          ss += __shfl_xor(ss, 32);
          if (h == 0) SS[(size_t)tok * 20 + sb + i] = ss;
          store_rows(dst, ld, c0 + i * 32, acc[i][j], tok, h);
        }
      }
    } else if (fbase < 2176) {
      const bool isK = fbase >= 1920;
      u16* dst = qkv + (isK ? Q_KD : Q_QD);
      const int c0 = isK ? fbase - 1920 : fbase - 1664;
#pragma unroll
      for (int j = 0; j < NJ; ++j) {
        const int tok = tbase + j * 32 + r;
        const int pos = pos_of(tok);
#pragma unroll
        for (int i = 0; i < 2; ++i) {
          rope32_blk(acc[i][j], R32 + (size_t)pos * 16, h);
          store_rows(dst, 256, c0 + i * 32, acc[i][j], tok, h);
        }
      }
    } else if (fbase < 2432) {
#pragma unroll
      for (int j = 0; j < NJ; ++j) {
        const int tok = tbase + j * 32 + r;
        store_T(qkv + Q_VTD, fbase - 2176, acc[0][j], tok, h);
        store_T(qkv + Q_VTD, fbase - 2176 + 32, acc[1][j], tok, h);
      }
    } else if (fbase == 2432) {
#pragma unroll
      for (int j = 0; j < NJ; ++j) {
        const int tok = tbase + j * 32 + r;
        const int pos = pos_of(tok);
        rope32_blk(acc[0][j], R32 + (size_t)pos * 16, h);
#pragma unroll
        for (int hd = 0; hd < 4; ++hd) store_rows(qkv + Q_KC, 384, hd * 96 + 64, acc[0][j], tok, h);
      }
    }
  } else if constexpr (MODE == M_GATE) {
    unsigned char* G8 = (unsigned char*)(ws + OFF_R2);
#pragma unroll
    for (int j = 0; j < NJ; ++j) {
      const int tok = tbase + j * 32 + r;
#pragma unroll
      for (int i = 0; i < 2; ++i)
#pragma unroll
        for (int vq = 0; vq < 4; ++vq) {
          unsigned pk = 0u;
#pragma unroll
          for (int e = 0; e < 4; ++e) {
            const float o = __builtin_amdgcn_rcpf(1.f + __builtin_amdgcn_exp2f(-1.4426950408889634f * acc[i][j][4 * vq + e]));
            pk |= (unsigned)(o * 255.f + 0.5f) << (8 * e);
          }
          *(unsigned*)(G8 + (size_t)tok * GP + fbase + i * 32 + 8 * vq + 4 * h) = pk;
        }
    }
  } else if constexpr (MODE == M_CUQ) {
    if (fbase >= 384) return;
#pragma unroll
    for (int j = 0; j < NJ; ++j) {
      const int tok = tbase + j * 32 + r;
      const int pos = pos_of(tok);
      float ss = 0.f;
#pragma unroll
      for (int b = 0; b < 12; ++b) ss += SS[(size_t)tok * 20 + b];
      const float rs = rsqrtf(ss * (1.f / 384.f) + EPS);
#pragma unroll
      for (int i = 0; i < 2; ++i) {
        const int blk = (fbase >> 5) + i;
#pragma unroll
        for (int v = 0; v < 16; ++v) acc[i][j][v] *= rs;
        if (blk % 3 == 2) rope32_blk(acc[i][j], R32 + (size_t)pos * 16, h);
        store_rows(qkv + Q_QC, 384, blk * 32, acc[i][j], tok, h);
      }
    }
  } else if constexpr (MODE == M_CUKV) {
#pragma unroll
    for (int j = 0; j < NJ; ++j) {
      const int tok = tbase + j * 32 + r;
      float ss = 0.f;
#pragma unroll
      for (int b = 0; b < 8; ++b) ss += SS[(size_t)tok * 20 + 12 + b];
      const float rs = rsqrtf(ss * (1.f / 256.f) + EPS);
#pragma unroll
      for (int i = 0; i < 2; ++i) {
        const int blk = (fbase >> 5) + i;
        const int hd = blk >> 2, q = blk & 3;
#pragma unroll
        for (int v = 0; v < 16; ++v) acc[i][j][v] *= rs;
        if (q < 2) store_rows(qkv + Q_KC, 384, hd * 96 + q * 32, acc[i][j], tok, h);
        else store_T(qkv + Q_VTC, hd * 64 + (q - 2) * 32, acc[i][j], tok, h);
      }
    }
  } else if constexpr (MODE == M_MERGE) {
#pragma unroll
    for (int j = 0; j < NJ; ++j) {
      const int tok = tbase + j * 32 + r;
      store_rows(qkv + Q_MERGED, KP1, fbase, acc[0][j], tok, h);
      store_rows(qkv + Q_MERGED, KP1, fbase + 32, acc[1][j], tok, h);
    }
  }
}

typedef __attribute__((address_space(3))) unsigned lds_u32_t;
typedef __attribute__((address_space(1))) const unsigned glb_u32_t;
template <int MODE, int NJ>
DI void gemm_tile(const u16* __restrict__ Wt, int ldw, const u16* __restrict__ X, int ldx, int K, int f0, int t0, char* smem,
                  const Params& P, int layer) {
  constexpr int XROWS = NJ * 64;
  constexpr int WSTG = 256 * 64, XSTG = XROWS * 64;
  u16* sW = (u16*)smem;
  u16* sX = sW + 2 * WSTG;
  const int tid = opaque_tid(), lane = tid & 63, wave = tid >> 6, r = lane & 31, h = lane >> 5;
  const int wf = wave & 3, wt = wave >> 2;
  f32x16 acc[2][NJ];
  f32x16 tot[2][MODE == M_MERGE ? NJ : 1];
#pragma unroll
  for (int i = 0; i < 2; ++i)
#pragma unroll
    for (int j = 0; j < NJ; ++j)
#pragma unroll
      for (int v = 0; v < 16; ++v) acc[i][j][v] = 0.f;
  if constexpr (MODE == M_MERGE) {
#pragma unroll
    for (int i = 0; i < 2; ++i)
#pragma unroll
      for (int j = 0; j < NJ; ++j)
#pragma unroll
        for (int v = 0; v < 16; ++v) tot[i][j][v] = 0.f;
  }
  const int nk = K >> 6;
  const int srow = tid >> 3;
  const int schunk = (tid & 7) ^ ((tid >> 4) & 7);
  const u16* wp = Wt + (size_t)(f0 + srow) * ldw + schunk * 8;
  const u16* xp = X + (size_t)(t0 + srow) * ldx + schunk * 8;
  const int fbase = f0 + wf * 64, tbase = t0 + wt * (NJ * 32);

  auto issue = [&](int kt, int buf) {
#pragma unroll
    for (int i = 0; i < 4; ++i)
      __builtin_amdgcn_global_load_lds((glb_u32_t*)(wp + (size_t)(i * 64) * ldw + kt * 64),
                                       (lds_u32_t*)(sW + buf * WSTG + i * 4096 + tid * 8), 16, 0, 0);
#pragma unroll
    for (int i = 0; i < NJ; ++i)
      __builtin_amdgcn_global_load_lds((glb_u32_t*)(xp + (size_t)(i * 64) * ldx + kt * 64),
                                       (lds_u32_t*)(sX + buf * XSTG + i * 4096 + tid * 8), 16, 0, 0);
  };
  const int swz = (r >> 1) & 7;
  auto compute = [&](int buf, int kt) {
    const u16* aW = sW + buf * WSTG + (wf * 64 + r) * 64;
    const u16* aX = sX + buf * XSTG + (wt * (NJ * 32) + r) * 64;
#pragma unroll
    for (int ks = 0; ks < 4; ++ks) {
      const int co = ((2 * ks + h) ^ swz) * 8;
      bf16x8 wfrag[2], xfrag[NJ];
#pragma unroll
      for (int i = 0; i < 2; ++i) wfrag[i] = *(const bf16x8*)(aW + i * 32 * 64 + co);
#pragma unroll
      for (int j = 0; j < NJ; ++j) xfrag[j] = *(const bf16x8*)(aX + j * 32 * 64 + co);
#pragma unroll
      for (int i = 0; i < 2; ++i)
#pragma unroll
        for (int j = 0; j < NJ; ++j) acc[i][j] = MFMA32(wfrag[i], xfrag[j], acc[i][j]);
    }
    if constexpr (MODE == M_MERGE) {
      if ((kt & 3) == 3) {
        const int br = kt >> 2;
        const unsigned char* G8 = (const unsigned char*)(P.ws + OFF_R2);
#pragma unroll
        for (int j = 0; j < NJ; ++j) {
          const int tok = tbase + j * 32 + r;
#pragma unroll
          for (int i = 0; i < 2; ++i)
#pragma unroll
            for (int vq = 0; vq < 4; ++vq) {
              const unsigned gp = *(const unsigned*)(G8 + (size_t)tok * GP + br * 1024 + fbase + i * 32 + 8 * vq + 4 * h);
              tot[i][j][4 * vq + 0] += (float)(gp & 0xffu) * (1.f / 255.f) * acc[i][j][4 * vq + 0];
              tot[i][j][4 * vq + 1] += (float)((gp >> 8) & 0xffu) * (1.f / 255.f) * acc[i][j][4 * vq + 1];
              tot[i][j][4 * vq + 2] += (float)((gp >> 16) & 0xffu) * (1.f / 255.f) * acc[i][j][4 * vq + 2];
              tot[i][j][4 * vq + 3] += (float)(gp >> 24) * (1.f / 255.f) * acc[i][j][4 * vq + 3];
              acc[i][j][4 * vq + 0] = 0.f; acc[i][j][4 * vq + 1] = 0.f;
              acc[i][j][4 * vq + 2] = 0.f; acc[i][j][4 * vq + 3] = 0.f;
            }
        }
      }
    }
  };

  issue(0, 0);
  asm volatile("s_waitcnt vmcnt(0)" ::: "memory");
  __syncthreads();
  for (int kt = 0; kt < nk; ++kt) {
    const int buf = kt & 1;
    if (kt + 1 < nk) issue(kt + 1, buf ^ 1);
    compute(buf, kt);
    asm volatile("s_waitcnt vmcnt(0) lgkmcnt(0)" ::: "memory");
    __syncthreads();
  }
  if constexpr (MODE == M_MERGE) gemm_epilogue<MODE, NJ>(tot, fbase, tbase, r, h, P, layer);
  else gemm_epilogue<MODE, NJ>(acc, fbase, tbase, r, h, P, layer);
}

template <int MODE, int NJ>
DI void gemm_phase(const u16* Wt, int ldw, const u16* X, int ldx, int K, int nF, char* smem, const Params& P, int layer) {
  constexpr int TT = NJ * 64;
  const int nT = T / TT;
  const int ntiles = nF * nT;
  for (int idx = blockIdx.x; idx < ntiles; idx += gridDim.x) {
    const int tt_lo = idx & 15;
    const int rest = idx >> 4;
    const int ft = rest % nF;
    const int tt = (rest / nF) * 16 + tt_lo;
    gemm_tile<MODE, NJ>(Wt, ldw, X, ldx, K, ft * 256, tt * TT, smem, P, layer);
  }
}

namespace pg8 {
#define PG8_LAS __attribute__((address_space(3)))
typedef unsigned short bf16_t;
typedef short bf16x8 __attribute__((ext_vector_type(8)));
typedef float f32x4 __attribute__((ext_vector_type(4)));
typedef unsigned u32x4 __attribute__((ext_vector_type(4)));
constexpr int BM = 256, BK = 64, HALF = 128, HTB = HALF * BK * 2  , STAGE_BYTES = 8 * HTB, NXCD = 8, WGM = 8;

__host__ __device__ __forceinline__ int lds_byte(int r, int c) { const int st = (r >> 4) * 2 + (c >> 5), rr = r & 15, cc = c & 31, ob = rr * 64 + cc * 2; return st * 1024 + (ob ^ (((ob >> 9) & 1) << 5)); }
__host__ __device__ __forceinline__ void stage_rc(int b, int& R, int& C) { const int st = b / 1024, sb = b % 1024, swz = sb ^ (((sb >> 9) & 1) << 5); R = (st >> 1) * 16 + swz / 64; C = (st & 1) * 32 + (swz % 64) / 2; }
__host__ __device__ __forceinline__ int perm32(int rho) { const int n = rho >> 4, i = rho & 15; return 8 * (i >> 2) + 4 * n + (i & 3); }

struct Unit { int pm, pn; };
struct Gemm { const bf16_t* A; const bf16_t* Bt; int M, N, K, ld; };

struct StaticOrder {
    int nM, nN, nwg, G, c;
    __host__ __device__ void init(int M, int N, int G_, int c_) { nM = M / BM; nN = N / BM; nwg = nM * nN; G = G_; c = c_; }
    __host__ __device__ bool next(int i, Unit& u) const {
        const long L = (long)i * G + c; if (L >= nwg) return false;
        int wgid = (int)L; { const int q = nwg / NXCD, r = nwg % NXCD, xcd = wgid % NXCD, off = wgid / NXCD; wgid = (xcd < r ? xcd * (q + 1) : r * (q + 1) + (xcd - r) * q) + off; }
        const int nig = WGM * nN, gid = wgid / nig, fm = gid * WGM, gsz = (nM - fm) < WGM ? (nM - fm) : WGM;
        u.pm = fm + ((wgid % nig) % gsz); u.pn = (wgid % nig) / gsz; return true;
    }
    __device__ __forceinline__ void a_ready(const Unit&) const {}
    __device__ __forceinline__ void done(const Unit&) const {}
};

template <class Epi, class Sched, bool STAMP, int KC, int LDC>
__device__ __forceinline__ void gemm_phase(PG8_LAS unsigned char* lds, const Gemm g, const Sched& S, const Epi& E, unsigned long long* stamps) {
    const int tid = opaque_tid(), wid = __builtin_amdgcn_readfirstlane(tid >> 6), lane = tid & 63, wr = wid >> 2, wc = wid & 3, fr = lane & 15, fq = lane >> 4;
    constexpr int K = KC, nt = K / BK;
    int ts_lo = 0, ts_hi = 0, nts = 0; const unsigned long long rt_entry = STAMP ? (unsigned long long)wall_clock64() : 0ull;
#define PG8_STAMP() do { if (STAMP && wid == 0 && nts < 64) { const unsigned long long _c = (unsigned long long)clock64(); \
        ts_lo = (lane == nts) ? (int)(unsigned)_c : ts_lo; ts_hi = (lane == nts) ? (int)(unsigned)(_c >> 32) : ts_hi; ++nts; } } while (0)
    PG8_STAMP();
    unsigned voffA[2], voffB[2];
#pragma unroll
    for (int i = 0; i < 2; ++i) { int R, C; stage_rc(tid * 16 + i * 8192, R, C); const int Rb = Epi::PERM ? ((R & ~31) + perm32(R & 31)) : R;
        voffA[i] = (unsigned)(R * LDC + C) * 2u; voffB[i] = (unsigned)(Rb * LDC + C) * 2u; }
    const size_t kstep = (size_t)(BK * 2);
    constexpr size_t hstep = (size_t)HALF * LDC * 2;
    const size_t tstep = 2 * hstep;
    const unsigned ldsw = (unsigned)wid * 1024u;
    const int aoff = lds_byte(wr * 64 + fr, fq * 8), boff = lds_byte(wc * 32 + fr, fq * 8);
#define PG8_SA(b, h) (((b) * 2 + (h)) * HTB)
#define PG8_SB(b, h) ((4 + (b) * 2 + (h)) * HTB)
#define PG8_STAGE(bufoff, gbase, voff) do { _Pragma("unroll") for (int _i = 0; _i < 2; ++_i) \
        __builtin_amdgcn_global_load_lds((const unsigned*)((const char*)(gbase) + (voff)[_i]), (PG8_LAS unsigned*)(lds + (bufoff) + ldsw + _i * 8192), 16, 0, 0); } while (0)
#define PG8_LDA(dst, b, h) do { _Pragma("unroll") for (int m = 0; m < 4; ++m) _Pragma("unroll") for (int k = 0; k < 2; ++k) dst[m][k] = *(const PG8_LAS bf16x8*)(lds + PG8_SA(b, h) + aoff + m * 2048 + k * 1024); } while (0)
#define PG8_LDB(dst, b, h) do { _Pragma("unroll") for (int n = 0; n < 2; ++n) _Pragma("unroll") for (int k = 0; k < 2; ++k) dst[n][k] = *(const PG8_LAS bf16x8*)(lds + PG8_SB(b, h) + boff + n * 2048 + k * 1024); } while (0)
#define PG8_MMA(ai, bj, At, Bt) do { __builtin_amdgcn_s_setprio(1); _Pragma("unroll") for (int m = 0; m < 4; ++m) _Pragma("unroll") for (int n = 0; n < 2; ++n) _Pragma("unroll") for (int k = 0; k < 2; ++k) \
        acc[ai][bj][m][n] = __builtin_amdgcn_mfma_f32_16x16x32_bf16(Bt[n][k], At[m][k], acc[ai][bj][m][n], 0, 0, 0); __builtin_amdgcn_s_setprio(0); } while (0)
#define PG8_WAIT_V(n) asm volatile("s_waitcnt vmcnt(" #n ")" ::: "memory")
#define PG8_WAIT_L(n) asm volatile("s_waitcnt lgkmcnt(" #n ")" ::: "memory")
#define PG8_BAR __builtin_amdgcn_s_barrier()
#define PG8_SCHED __builtin_amdgcn_sched_barrier(0)
    Unit cur, nxt; int ui = 0;
    if (!S.next(0, cur)) return;
    f32x4 acc[2][2][4][2];
#pragma unroll
    for (int a = 0; a < 2; ++a)
#pragma unroll
        for (int b = 0; b < 2; ++b)
#pragma unroll
            for (int m = 0; m < 4; ++m)
#pragma unroll
                for (int n = 0; n < 2; ++n) acc[a][b][m][n] = (f32x4){0.f, 0.f, 0.f, 0.f};
    bf16x8 At[4][2], B0[2][2], B1[2][2];
    const char* cA = (const char*)g.A + (size_t)cur.pm * tstep; const char* cB = (const char*)g.Bt + (size_t)cur.pn * tstep;
    S.a_ready(cur);
    PG8_STAGE(PG8_SB(0, 0), cB, voffB); PG8_STAGE(PG8_SA(0, 0), cA, voffA); PG8_STAGE(PG8_SB(0, 1), cB + hstep, voffB); PG8_STAGE(PG8_SA(0, 1), cA + hstep, voffA);
    if (wr == 1) PG8_BAR;
    PG8_WAIT_V(4); PG8_BAR;
    PG8_STAGE(PG8_SB(1, 0), cB + kstep, voffB); PG8_STAGE(PG8_SA(1, 0), cA + kstep, voffA); PG8_STAGE(PG8_SB(1, 1), cB + hstep + kstep, voffB);
    PG8_WAIT_V(6); PG8_BAR;
    PG8_STAMP();
    for (;;) {
        const bool has_next = S.next(ui + 1, nxt);
        const char* nA = has_next ? (const char*)g.A + (size_t)nxt.pm * tstep : cA; const char* nB = has_next ? (const char*)g.Bt + (size_t)nxt.pn * tstep : cB;
        for (int t = 0; t < nt; t += 2) {
            const bool last = (t == nt - 2);
            const char* a1 = cA + (size_t)(t + 1) * kstep;
            const char* a2 = last ? nA : cA + (size_t)(t + 2) * kstep; const char* b2 = last ? nB : cB + (size_t)(t + 2) * kstep;
            const char* a3 = a2 + kstep; const char* b3 = b2 + kstep;
            if (last && has_next) S.a_ready(nxt);
            PG8_LDB(B0, 0, 0); PG8_SCHED; PG8_LDA(At, 0, 0); PG8_STAGE(PG8_SA(1, 1), a1 + hstep, voffA);
            PG8_WAIT_L(8); PG8_BAR; PG8_WAIT_L(0); PG8_MMA(0, 0, At, B0); PG8_BAR; PG8_SCHED;
            PG8_LDB(B1, 0, 1); PG8_STAGE(PG8_SB(0, 0), b2, voffB);
            PG8_BAR; PG8_WAIT_L(0); PG8_MMA(0, 1, At, B1); PG8_BAR;
            PG8_LDA(At, 0, 1); PG8_STAGE(PG8_SA(0, 0), a2, voffA);
            PG8_BAR; PG8_WAIT_L(0); PG8_MMA(1, 0, At, B0); PG8_BAR; PG8_SCHED;
            PG8_STAGE(PG8_SB(0, 1), b2 + hstep, voffB);
            PG8_WAIT_V(6); PG8_BAR; PG8_MMA(1, 1, At, B1); PG8_BAR;
            PG8_LDB(B0, 1, 0); PG8_SCHED; PG8_LDA(At, 1, 0); PG8_STAGE(PG8_SA(0, 1), a2 + hstep, voffA);
            PG8_WAIT_L(8); PG8_BAR; PG8_WAIT_L(0); PG8_MMA(0, 0, At, B0); PG8_BAR; PG8_SCHED;
            PG8_LDB(B1, 1, 1); PG8_STAGE(PG8_SB(1, 0), b3, voffB);
            PG8_BAR; PG8_WAIT_L(0); PG8_MMA(0, 1, At, B1); PG8_BAR;
            PG8_LDA(At, 1, 1); PG8_STAGE(PG8_SA(1, 0), a3, voffA);
            PG8_BAR; PG8_WAIT_L(0); PG8_MMA(1, 0, At, B0); PG8_BAR; PG8_SCHED;
            PG8_STAGE(PG8_SB(1, 1), b3 + hstep, voffB);
            PG8_WAIT_V(6); PG8_BAR; PG8_MMA(1, 1, At, B1); PG8_BAR;
        }
        PG8_STAMP();
        if constexpr (!Epi::AFTER_DRAIN) { E(acc, cur, wr, wc, fr, fq); S.done(cur); }
        PG8_STAMP();
        if (!has_next) break;
#pragma unroll
        for (int a = 0; a < 2; ++a)
#pragma unroll
            for (int b = 0; b < 2; ++b)
#pragma unroll
                for (int m = 0; m < 4; ++m)
#pragma unroll
                    for (int n = 0; n < 2; ++n) acc[a][b][m][n] = (f32x4){0.f, 0.f, 0.f, 0.f};
        cur = nxt; cA = nA; cB = nB; ++ui;
    }
    PG8_WAIT_V(0);
    if (wr == 0) PG8_BAR;
    PG8_BAR;
    if constexpr (Epi::AFTER_DRAIN) { E.fused(acc, cur, wr, wc, fr, fq, lds, wid, lane); S.done(cur); }
    PG8_STAMP();
    if (STAMP && wid == 0) { stamps[lane] = lane < nts ? (((unsigned long long)(unsigned)ts_hi << 32) | (unsigned)ts_lo) : 0ull;
        if (lane == 62) stamps[62] = rt_entry; if (lane == 63) stamps[63] = (unsigned long long)wall_clock64(); }
#undef PG8_STAMP
#undef PG8_SA
#undef PG8_SB
#undef PG8_STAGE
#undef PG8_LDA
#undef PG8_LDB
#undef PG8_MMA
#undef PG8_WAIT_V
#undef PG8_WAIT_L
#undef PG8_BAR
#undef PG8_SCHED
}
}

struct EpiY8 {
  static constexpr bool PERM = true, AFTER_DRAIN = false;
  u16* O;
  DI void operator()(const pg8::f32x4 (&acc)[2][2][4][2], const pg8::Unit& u, int wr, int wc, int fr, int fq) const {
    const int row0 = u.pm * 256 + wr * 64 + fr, col0 = u.pn * 256 + wc * 32 + 8 * fq;
#pragma unroll
    for (int ai = 0; ai < 2; ++ai)
#pragma unroll
      for (int m = 0; m < 4; ++m) {
        u16* rowp = O + (size_t)(row0 + ai * 128 + m * 16) * KP1 + col0;
#pragma unroll
        for (int bj = 0; bj < 2; ++bj) {
          const pg8::f32x4 v0 = acc[ai][bj][m][0], v1 = acc[ai][bj][m][1];
          u32x4 w; w.x = pk2(v0[0], v0[1]); w.y = pk2(v0[2], v0[3]); w.z = pk2(v1[0], v1[1]); w.w = pk2(v1[2], v1[3]);
          *(u32x4*)(rowp + bj * 128) = w;
        }
      }
  }
};
struct EpiFfnUp8 {
  static constexpr bool PERM = true, AFTER_DRAIN = false;
  u16* H;
  DI void operator()(const pg8::f32x4 (&acc)[2][2][4][2], const pg8::Unit& u, int wr, int wc, int fr, int fq) const {
    const int row0 = u.pm * 256 + wr * 64 + fr, col0 = u.pn * 128 + wc * 32 + 8 * fq;
#pragma unroll
    for (int ai = 0; ai < 2; ++ai)
#pragma unroll
      for (int m = 0; m < 4; ++m) {
        float o[8];
#pragma unroll
        for (int n = 0; n < 2; ++n)
#pragma unroll
          for (int j = 0; j < 4; ++j) {
            const float g = acc[ai][0][m][n][j], up = acc[ai][1][m][n][j];
            o[n * 4 + j] = g * __builtin_amdgcn_rcpf(1.f + __builtin_amdgcn_exp2f(-1.4426950408889634f * g)) * up;
          }
        u32x4 w; w.x = pk2(o[0], o[1]); w.y = pk2(o[2], o[3]); w.z = pk2(o[4], o[5]); w.w = pk2(o[6], o[7]);
        *(u32x4*)(H + (size_t)(row0 + ai * 128 + m * 16) * KP2 + col0) = w;
      }
  }
};
struct EpiGate8 {
  static constexpr bool PERM = true, AFTER_DRAIN = false;
  unsigned char* G8;
  DI void operator()(const pg8::f32x4 (&acc)[2][2][4][2], const pg8::Unit& u, int wr, int wc, int fr, int fq) const {
    const int row0 = u.pm * 256 + wr * 64 + fr, col0 = u.pn * 256 + wc * 32 + 8 * fq;
#pragma unroll
    for (int ai = 0; ai < 2; ++ai)
#pragma unroll
      for (int m = 0; m < 4; ++m)
#pragma unroll
        for (int bj = 0; bj < 2; ++bj) {
          uint2 pk = {0u, 0u};
#pragma unroll
          for (int j = 0; j < 4; ++j) {
            const float a = __builtin_amdgcn_rcpf(1.f + __builtin_amdgcn_exp2f(-1.4426950408889634f * acc[ai][bj][m][0][j]));
            const float b = __builtin_amdgcn_rcpf(1.f + __builtin_amdgcn_exp2f(-1.4426950408889634f * acc[ai][bj][m][1][j]));
            pk.x |= (unsigned)(a * 255.f + 0.5f) << (8 * j);
            pk.y |= (unsigned)(b * 255.f + 0.5f) << (8 * j);
          }
          *(uint2*)(G8 + (size_t)(row0 + ai * 128 + m * 16) * GP + col0 + bj * 128) = pk;
        }
  }
};
struct EpiProj8 {
  static constexpr bool PERM = false, AFTER_DRAIN = false;
  const Params* Pp; int layer;
  static DI void rope32q(float (&b)[8], const float2* __restrict__ tab, int fq) {
#pragma unroll
    for (int j = 0; j < 4; ++j) {
      const float2 cs = tab[4 * fq + j];
      const float x1 = b[j], x2 = b[4 + j];
      b[j] = x1 * cs.x - x2 * cs.y;
      b[4 + j] = x2 * cs.x + x1 * cs.y;
    }
  }
  static DI void st8(u16* __restrict__ base, int ld, int col0, const float (&b)[8], int tok, int fq) {
#pragma unroll
    for (int n = 0; n < 2; ++n) {
      uint2 pk; pk.x = pk2(b[4 * n], b[4 * n + 1]); pk.y = pk2(b[4 * n + 2], b[4 * n + 3]);
      *(uint2*)(base + (size_t)tok * ld + col0 + 16 * n + 4 * fq) = pk;
    }
  }
  static DI void stT8(u16* __restrict__ base, int row0, const float (&b)[8], int tok, int fq) {
    const int tp = (tok & ~12) | ((tok & 4) << 1) | ((tok & 8) >> 1);
#pragma unroll
    for (int n = 0; n < 2; ++n)
#pragma unroll
      for (int j = 0; j < 4; ++j) {
        const int row = row0 + 16 * n + 4 * fq + j;
        base[(size_t)(row >> 6) * 64 * T + (size_t)(tp >> 7) * 8192 + (row & 63) * 128 + (tp & 127)] = f2bf(b[4 * n + j]);
      }
  }
  DI void operator()(const pg8::f32x4 (&acc)[2][2][4][2], const pg8::Unit& u, int wr, int wc, int fr, int fq_in) const {
    const Params& P = *Pp;
    char* ws = P.ws;
    u16* qkv = (u16*)(ws + OFF_QKV);
    const float2* R64 = (const float2*)(ws + OFF_R64);
    const float2* R32 = (const float2*)(ws + OFF_R32);
    float* SS = (float*)(ws + OFF_SS);
    const int fbase = u.pn * 256 + wc * 64;
    if (fbase >= 2496) return;
#pragma unroll
    for (int ai = 0; ai < 2; ++ai)
#pragma unroll
      for (int m = 0; m < 4; ++m) {
        int fqv = fq_in; asm volatile("" : "+v"(fqv));
        const int fq = fqv;
        const int tok = u.pm * 256 + ai * 128 + wr * 64 + m * 16 + fr;
        const int pos = pos_of(tok);
        float b0[8], b1[8];
#pragma unroll
        for (int n = 0; n < 2; ++n)
#pragma unroll
          for (int j = 0; j < 4; ++j) { b0[4 * n + j] = acc[ai][0][m][n][j]; b1[4 * n + j] = acc[ai][1][m][n][j]; }
        if (fbase < 384) {
          const bool isK = fbase >= 256;
          const float* g = P.a_qk_norm + layer * 128 + (isK ? 64 : 0);
          float ss = 0.f;
#pragma unroll
          for (int k = 0; k < 8; ++k) ss += b0[k] * b0[k] + b1[k] * b1[k];
          ss += __shfl_xor(ss, 16);
          ss += __shfl_xor(ss, 32);
          const float rs = rsqrtf(ss * (1.f / 64.f) + EPS);
#pragma unroll
          for (int n = 0; n < 2; ++n)
#pragma unroll
            for (int j = 0; j < 4; ++j) {
              b0[4 * n + j] *= rs * g[16 * n + 4 * fq + j];
              b1[4 * n + j] *= rs * g[32 + 16 * n + 4 * fq + j];
            }
          rope32q(b0, R32 + (size_t)(pos >> 6) * 16, fq);
          rope32q(b1, R32 + (size_t)(pos & 63) * 16, fq);
          u16* dst = qkv + (isK ? Q_KA : Q_QA);
          const int ld = isK ? 128 : 256, c0 = isK ? fbase - 256 : fbase;
          st8(dst, ld, c0, b0, tok, fq);
          st8(dst, ld, c0 + 32, b1, tok, fq);
        } else if (fbase < 512) {
          stT8(qkv + Q_VTA, fbase - 384, b0, tok, fq);
          stT8(qkv + Q_VTA, fbase - 384 + 32, b1, tok, fq);
        } else if (fbase < 896) {
          const bool isK = fbase >= 768;
          const float2* tab = R64 + (size_t)pos * 32;
#pragma unroll
          for (int n = 0; n < 2; ++n)
#pragma unroll
            for (int j = 0; j < 4; ++j) {
              const float2 cs = tab[16 * n + 4 * fq + j];
              const float x1 = b0[4 * n + j], x2 = b1[4 * n + j];
              b0[4 * n + j] = x1 * cs.x - x2 * cs.y;
              b1[4 * n + j] = x2 * cs.x + x1 * cs.y;
            }
          u16* dst = qkv + (isK ? Q_KB : Q_QB);
          const int ld = isK ? 128 : 256, c0 = isK ? fbase - 768 : fbase - 512;
          st8(dst, ld, c0, b0, tok, fq);
          st8(dst, ld, c0 + 32, b1, tok, fq);
        } else if (fbase < 1024) {
          stT8(qkv + Q_VTB, fbase - 896, b0, tok, fq);
          stT8(qkv + Q_VTB, fbase - 896 + 32, b1, tok, fq);
        } else if (fbase < 1664) {
          const bool isKV = fbase >= 1408;
          u16* dst = qkv + (isKV ? Q_CKV : Q_CQ);
          const int ld = isKV ? 256 : 384, c0 = isKV ? fbase - 1408 : fbase - 1024;
          const int sb = (isKV ? 12 : 0) + (c0 >> 5);
          float s0 = 0.f, s1 = 0.f;
#pragma unroll
          for (int k = 0; k < 8; ++k) { s0 += b0[k] * b0[k]; s1 += b1[k] * b1[k]; }
          s0 += __shfl_xor(s0, 16); s0 += __shfl_xor(s0, 32);
          s1 += __shfl_xor(s1, 16); s1 += __shfl_xor(s1, 32);
          if (fq == 0) { SS[(size_t)tok * 20 + sb] = s0; SS[(size_t)tok * 20 + sb + 1] = s1; }
          st8(dst, ld, c0, b0, tok, fq);
          st8(dst, ld, c0 + 32, b1, tok, fq);
        } else if (fbase < 2176) {
          const bool isK = fbase >= 1920;
          u16* dst = qkv + (isK ? Q_KD : Q_QD);
          const int c0 = isK ? fbase - 1920 : fbase - 1664;
          rope32q(b0, R32 + (size_t)pos * 16, fq);
          rope32q(b1, R32 + (size_t)pos * 16, fq);
          st8(dst, 256, c0, b0, tok, fq);
          st8(dst, 256, c0 + 32, b1, tok, fq);
        } else if (fbase < 2432) {
          stT8(qkv + Q_VTD, fbase - 2176, b0, tok, fq);
          stT8(qkv + Q_VTD, fbase - 2176 + 32, b1, tok, fq);
        } else {
          rope32q(b0, R32 + (size_t)pos * 16, fq);
#pragma unroll
          for (int hd = 0; hd < 4; ++hd) st8(qkv + Q_KC, 384, hd * 96 + 64, b0, tok, fq);
        }
        __builtin_amdgcn_sched_barrier(0);
      }
  }
};
struct SimpleOrder {
  int nN, nwg, G, c;
  DI bool next(int i, pg8::Unit& u) const {
    const int L = i * G + c;
    if (L >= nwg) return false;
    const int rest = L >> 4;
    u.pn = rest % nN;
    u.pm = (rest / nN) * 16 + (L & 15);
    return true;
  }
  DI void a_ready(const pg8::Unit&) const {}
  DI void done(const pg8::Unit&) const {}
};
template <int N, int K, int LD, class Epi>
DI void gemm8_phase(const u16* X, const u16* Wt, const Epi& E, char* smem) {
  pg8::Gemm g; g.A = X; g.Bt = Wt; g.M = T; g.N = N; g.K = K; g.ld = LD;
  int bid_ = (int)blockIdx.x; asm volatile("" : "+s"(bid_));
  SimpleOrder S; S.nN = N / 256; S.nwg = (T / 256) * (N / 256); S.G = (int)gridDim.x; S.c = bid_;
  pg8::gemm_phase<Epi, SimpleOrder, false, K, LD>((PG8_LAS unsigned char*)smem, g, S, E, nullptr);
}

template <int DQK, int NCOMP, bool BAND, int EPI>
DI void attn_item(const u16* __restrict__ Q, int ldq, const u16* __restrict__ Kp, int ldk, const u16* __restrict__ Vt,
                  int qtok0, int kbeg, int kend, float sc_l2, float sink_l2, float lam, float onorm,
                  const float* __restrict__ subg, u16* __restrict__ O, float* __restrict__ DS, char* smem) {
  constexpr int DC = DQK / NCOMP;
  constexpr int KS = DC / 16;
  constexpr int KEYS = (NCOMP == 1) ? 128 : 64;
  constexpr int KSTR = DQK + 8, VSTR = KEYS + 8;
  constexpr int KCH = DQK / 8, VCH = KEYS / 8;
  constexpr int NKC = KEYS * KCH / NTHR, NVC = 64 * VCH / NTHR;
  constexpr int KSLOT = KEYS * KSTR, VSLOT = 64 * VSTR;
  u16* sK = (u16*)smem;
  u16* sV = sK + 3 * KSLOT;
  const int tid = opaque_tid(), lane = tid & 63, wave = tid >> 6, r = lane & 31, h = lane >> 5;
  const int qtok = qtok0 + wave * 32 + r;

  bf16x8 qf[NCOMP][KS];
#pragma unroll
  for (int c = 0; c < NCOMP; ++c)
#pragma unroll
    for (int ks = 0; ks < KS; ++ks) qf[c][ks] = *(const bf16x8*)(Q + (size_t)qtok * ldq + c * DC + ks * 16 + 8 * h);

  f32x16 Oa[NCOMP][2];
  float m[NCOMP], l[NCOMP];
#pragma unroll
  for (int c = 0; c < NCOMP; ++c) {
#pragma unroll
    for (int d = 0; d < 2; ++d)
#pragma unroll
      for (int v = 0; v < 16; ++v) Oa[c][d][v] = 0.f;
    m[c] = BAND ? sink_l2 : -1e30f;
    l[c] = (BAND && h == 0) ? 1.f : 0.f;
  }

  const u16* kg[NKC]; int kso[NKC];
#pragma unroll
  for (int i = 0; i < NKC; ++i) {
    const int c = tid + i * NTHR;
    const int row = c / KCH, cc = c % KCH;
    kg[i] = Kp + (size_t)(kbeg + row) * ldk + cc * 8;
    kso[i] = row * KSTR + cc * 8;
  }
  const u16* vg[NVC]; int vso[NVC];
#pragma unroll
  for (int i = 0; i < NVC; ++i) {
    const int c = tid + i * NTHR;
    const int row = c / VCH, cc = c % VCH;
    vg[i] = Vt + (size_t)(kbeg >> 7) * 8192 + row * 128 + cc * 8;
    vso[i] = row * VSTR + cc * 8;
  }
  u32x4 kreg[NKC], vreg[NVC];
  auto loadK = [&](int t) {
#pragma unroll
    for (int i = 0; i < NKC; ++i) kreg[i] = gld16(kg[i] + (size_t)t * KEYS * ldk);
  };
  auto loadV = [&](int t) {
#pragma unroll
    for (int i = 0; i < NVC; ++i) vreg[i] = gld16(vg[i] + (size_t)t * 8192);
  };
  auto waitK = [&]() {
    if constexpr (NKC == 1) wait_vm0(kreg[0]);
    else if constexpr (NKC == 2) wait_vm0(kreg[0], kreg[1]);
    else wait_vm0(kreg[0], kreg[1], kreg[2]);
  };
  auto waitV = [&]() {
    if constexpr (NVC == 1) wait_vm0(vreg[0]);
    else wait_vm0(vreg[0], vreg[1]);
  };
  auto storeK = [&](int slot) {
#pragma unroll
    for (int i = 0; i < NKC; ++i) *(u32x4*)(sK + slot * KSLOT + kso[i]) = kreg[i];
  };
  auto storeV = [&](int slot) {
#pragma unroll
    for (int i = 0; i < NVC; ++i) *(u32x4*)(sV + slot * VSLOT + vso[i]) = vreg[i];
  };

  f32x16 S0[2], S1[2];
  bf16x8 pfA[2][2], pfB[2][2];
  float alpha_pend = 1.f;
  bool need_pend = false;

  auto att_S = [&](auto uu_t, f32x16 (&S)[2], int slot) {
    constexpr int UU = decltype(uu_t)::value;
    constexpr int C = (NCOMP == 2) ? UU : 0;
    const u16* base = sK + slot * KSLOT + ((NCOMP == 1 ? UU * 64 : 0) + r) * KSTR + (NCOMP == 2 ? UU * DC : 0) + 8 * h;
#pragma unroll
    for (int kb = 0; kb < 2; ++kb) {
#pragma unroll
      for (int v = 0; v < 16; ++v) S[kb][v] = 0.f;
#pragma unroll
      for (int ks = 0; ks < KS; ++ks) {
        bf16x8 kf = *(const bf16x8*)(base + kb * 32 * KSTR + ks * 16);
        S[kb] = MFMA32(kf, qf[C][ks], S[kb]);
      }
    }
  };
  auto att_PV = [&](auto uu_t, const bf16x8 (&pf)[2][2], int slot) {
    constexpr int UU = decltype(uu_t)::value;
    constexpr int C = (NCOMP == 2) ? UU : 0;
    const u16* base = sV + slot * VSLOT + r * VSTR + (NCOMP == 1 ? UU * 64 : 0) + 8 * h;
#pragma unroll
    for (int d = 0; d < 2; ++d)
#pragma unroll
      for (int kb = 0; kb < 2; ++kb)
#pragma unroll
        for (int s = 0; s < 2; ++s) {
          bf16x8 vf = *(const bf16x8*)(base + d * 32 * VSTR + kb * 32 + 16 * s);
          Oa[C][d] = MFMA32(vf, pf[kb][s], Oa[C][d]);
        }
  };
  auto att_rescale = [&](auto uu_t) {
    constexpr int UU = decltype(uu_t)::value;
    constexpr int C = (NCOMP == 2) ? UU : 0;
    if (need_pend) {
#pragma unroll
      for (int d = 0; d < 2; ++d)
#pragma unroll
        for (int v = 0; v < 16; ++v) Oa[C][d][v] *= alpha_pend;
    }
  };
  auto att_softmax = [&](auto uu_t, f32x16 (&S)[2], bf16x8 (&pf)[2][2], int kpos0) {
    constexpr int UU = decltype(uu_t)::value;
    constexpr int C = (NCOMP == 2) ? UU : 0;
    if constexpr (BAND) {
#pragma unroll
      for (int kb = 0; kb < 2; ++kb)
#pragma unroll
        for (int v = 0; v < 16; ++v) {
          const int d = kpos0 + kb * 32 + crow(v, h) - qtok;
          if (d > 128 || d < -128) S[kb][v] = -1e30f;
        }
    }
    float mx = S[0][0];
#pragma unroll
    for (int kb = 0; kb < 2; ++kb)
#pragma unroll
      for (int v = 0; v < 16; ++v) mx = fmaxf(mx, S[kb][v]);
    {
      const unsigned mu = __float_as_uint(mx);
      const auto sw = __builtin_amdgcn_permlane32_swap(mu, mu, false, false);
      mx = fmaxf(__uint_as_float(sw[0]), __uint_as_float(sw[1]));
    }
    const float mold = m[C];
    const float mcand = fmaxf(mold, mx * sc_l2);
    const bool grow = __builtin_amdgcn_ballot_w64(mcand > mold + 6.0f) != 0;
    const float mnew = grow ? mcand : mold;
    need_pend = grow;
    alpha_pend = __builtin_amdgcn_exp2f(mold - mnew);
    m[C] = mnew;
    float rsum = 0.f;
#pragma unroll
    for (int kb = 0; kb < 2; ++kb)
#pragma unroll
      for (int v = 0; v < 16; ++v) {
        float p = __builtin_amdgcn_exp2f(__builtin_fmaf(S[kb][v], sc_l2, -mnew));
        S[kb][v] = p;
        rsum += p;
      }
    l[C] = l[C] * alpha_pend + rsum;
#pragma unroll
    for (int kb = 0; kb < 2; ++kb)
#pragma unroll
      for (int s = 0; s < 2; ++s) {
        u32x4 pk;
        pk.x = pk2(S[kb][8 * s + 0], S[kb][8 * s + 1]);
        pk.y = pk2(S[kb][8 * s + 2], S[kb][8 * s + 3]);
        pk.z = pk2(S[kb][8 * s + 4], S[kb][8 * s + 5]);
        pk.w = pk2(S[kb][8 * s + 6], S[kb][8 * s + 7]);
        pf[kb][s] = __builtin_bit_cast(bf16x8, pk);
      }
  };
  using U0 = std::integral_constant<int, 0>;
  using U1 = std::integral_constant<int, 1>;

  const int ntl = (kend - kbeg) / KEYS;
  auto step = [&](auto first_t, auto lk_t, auto lv_t, int t, int sa, int sb, int sc) {
    constexpr bool FIRST = decltype(first_t)::value, LK = decltype(lk_t)::value, LV = decltype(lv_t)::value;
    if constexpr (LK) loadK(t + 2);
    if constexpr (LV) loadV(t + 1);
    if constexpr (!FIRST) att_rescale(U1{});
    att_S(U1{}, S1, sa);
    if constexpr (!FIRST) att_PV(U1{}, pfB, sc);
    att_softmax(U0{}, S0, pfA, kbeg + t * KEYS);
    att_rescale(U0{});
    if constexpr (LV) att_S(U0{}, S0, sb);
    att_PV(U0{}, pfA, sa);
    att_softmax(U1{}, S1, pfB, kbeg + t * KEYS + 64);
    if constexpr (LK) { waitK(); storeK(sc); }
    if constexpr (LV) { waitV(); storeV(sb); }
    __syncthreads();
  };
  using TT = std::true_type;
  using FF = std::false_type;

  loadK(0); loadV(0);
  waitK(); waitV();
  storeK(0); storeV(0);
  loadK(1);
  waitK();
  storeK(1);
  __syncthreads();
  att_S(U0{}, S0, 0);
  int sa = 0, sb = 1, sc = 2;
  step(TT{}, TT{}, TT{}, 0, sa, sb, sc);
  { int tmp = sa; sa = sb; sb = sc; sc = tmp; }
  for (int t = 1; t < ntl - 2; ++t) {
    step(FF{}, TT{}, TT{}, t, sa, sb, sc);
    int tmp = sa; sa = sb; sb = sc; sc = tmp;
  }
  step(FF{}, FF{}, TT{}, ntl - 2, sa, sb, sc);
  { int tmp = sa; sa = sb; sb = sc; sc = tmp; }
  step(FF{}, FF{}, FF{}, ntl - 1, sa, sb, sc);
  att_rescale(U1{});
  att_PV(U1{}, pfB, sa);

  float inv[NCOMP];
#pragma unroll
  for (int c = 0; c < NCOMP; ++c) {
    float lt = l[c] + __shfl_xor(l[c], 32);
    inv[c] = 1.f / lt;
  }
  if constexpr (EPI == 1) {
#pragma unroll
    for (int d = 0; d < 2; ++d)
#pragma unroll
      for (int vq = 0; vq < 4; ++vq) {
        float4 o = {Oa[0][d][4 * vq] * inv[0], Oa[0][d][4 * vq + 1] * inv[0], Oa[0][d][4 * vq + 2] * inv[0], Oa[0][d][4 * vq + 3] * inv[0]};
        *(float4*)(DS + (size_t)qtok * 256 + d * 32 + 8 * vq + 4 * h) = o;
      }
  } else {
    if constexpr (EPI == 2) {
      float ss = 0.f;
#pragma unroll
      for (int d = 0; d < 2; ++d)
#pragma unroll
        for (int vq = 0; vq < 4; ++vq) {
          const float4 o1 = *(const float4*)(DS + (size_t)qtok * 256 + d * 32 + 8 * vq + 4 * h);
          const float a0 = o1.x - lam * Oa[0][d][4 * vq] * inv[0];
          const float a1 = o1.y - lam * Oa[0][d][4 * vq + 1] * inv[0];
          const float a2 = o1.z - lam * Oa[0][d][4 * vq + 2] * inv[0];
          const float a3 = o1.w - lam * Oa[0][d][4 * vq + 3] * inv[0];
          Oa[0][d][4 * vq] = a0; Oa[0][d][4 * vq + 1] = a1; Oa[0][d][4 * vq + 2] = a2; Oa[0][d][4 * vq + 3] = a3;
          ss += a0 * a0 + a1 * a1 + a2 * a2 + a3 * a3;
        }
      ss += __shfl_xor(ss, 32);
      const float rs = rsqrtf(ss * (1.f / 64.f) + EPS) * onorm;
#pragma unroll
      for (int d = 0; d < 2; ++d)
#pragma unroll
        for (int v = 0; v < 16; ++v) Oa[0][d][v] *= rs * subg[d * 32 + crow(v, h)];
    } else {
#pragma unroll
      for (int d = 0; d < 2; ++d)
#pragma unroll
        for (int v = 0; v < 16; ++v) Oa[0][d][v] *= inv[0];
    }
    store_rows(O, KP1, 0, Oa[0][0], qtok, h);
    store_rows(O, KP1, 32, Oa[0][1], qtok, h);
  }
  __syncthreads();
}

DI void attn_phase(const Params& P, int layer, char* smem) {
  char* ws = P.ws;
  u16* qkv = (u16*)(ws + OFF_QKV);
  u16* BR = (u16*)(ws + OFF_XN);
  const float L2E = 1.4426950408889634f;
  const float lambda_init = 0.8f - 0.6f * __expf(-0.3f * (float)layer);
  float lam;
  {
    const float* dl = P.d_lambda + layer * 128;
    float s1 = 0.f, s2 = 0.f;
    for (int i = 0; i < 32; ++i) { s1 += dl[i] * dl[32 + i]; s2 += dl[64 + i] * dl[96 + i]; }
    lam = __expf(s1) - __expf(s2) + lambda_init;
    lam = __int_as_float(__builtin_amdgcn_readfirstlane(__float_as_int(lam)));
  }
  const float onorm_u = __int_as_float(__builtin_amdgcn_readfirstlane(__float_as_int(1.f - lambda_init)));
  for (int it = blockIdx.x; it < 2048; it += gridDim.x) {
    const int cls = it >> 8;
    if (cls < 6) {
      const int idx = it & 255;
      const int head = (idx & 7) >> 1;
      const int qb = ((idx >> 3) << 1) + (idx & 1);
      int qtok0, kbeg, kend;
      if (cls < 3) { qtok0 = qb * 256; kbeg = 0; kend = SEQ0; }
      else { const int s = qb >> 3; kbeg = SEQ0 + s * DSEQ; kend = kbeg + DSEQ; qtok0 = kbeg + (qb & 7) * 256; }
      const int typ = cls % 3;
      if (typ == 0) {
        float* DS = (float*)(ws + OFF_DS) + head * 64;
        attn_item<32, 1, false, 1>(qkv + Q_QD + head * 64, 256, qkv + Q_KD + head * 64, 256,
                                   qkv + Q_VTD + (size_t)head * 64 * T, qtok0, kbeg, kend,
                                   0.17677669529663687f * L2E, 0.f, lam, onorm_u,
                                   P.d_subln + layer * 64, BR + 768 + head * 64, DS, smem);
        attn_item<32, 1, false, 2>(qkv + Q_QD + head * 64 + 32, 256, qkv + Q_KD + head * 64 + 32, 256,
                                   qkv + Q_VTD + (size_t)head * 64 * T, qtok0, kbeg, kend,
                                   0.17677669529663687f * L2E, 0.f, lam, onorm_u,
                                   P.d_subln + layer * 64, BR + 768 + head * 64, DS, smem);
      } else if (typ == 1) {
        attn_item<96, 1, false, 0>(qkv + Q_QC + head * 96, 384, qkv + Q_KC + head * 96, 384,
                                       qkv + Q_VTC + (size_t)head * 64 * T, qtok0, kbeg, kend,
                                       0.10206207261596577f * L2E, 0.f, 0.f, 1.f, nullptr, BR + 512 + head * 64, nullptr, smem);
      } else {
        attn_item<64, 1, false, 0>(qkv + Q_QA + head * 64, 256, qkv + Q_KA + (head >> 1) * 64, 128,
                                       qkv + Q_VTA + (size_t)(head >> 1) * 64 * T, qtok0, kbeg, kend,
                                       0.125f * L2E, 0.f, 0.f, 1.f, nullptr, BR + head * 64, nullptr, smem);
      }
    } else {
      const int idx = it - 1536;
      const int head = (idx & 7) >> 1;
      const int qbg = ((idx >> 3) << 1) + (idx & 1);
      const int qtok0 = qbg * 256;
      int sb, se;
      if (qtok0 < SEQ0) { sb = 0; se = SEQ0; }
      else { sb = SEQ0 + ((qtok0 - SEQ0) / DSEQ) * DSEQ; se = sb + DSEQ; }
      const int kbeg = max(sb, qtok0 - 128), kend = min(se, qtok0 + 256 + 128);
      const float sink = P.b_sink[layer * 4 + head];
      attn_item<64, 1, true, 0>(qkv + Q_QB + head * 64, 256, qkv + Q_KB + (head >> 1) * 64, 128,
                                    qkv + Q_VTB + (size_t)(head >> 1) * 64 * T, qtok0, kbeg, kend,
                                    0.125f * L2E, sink * L2E, 0.f, 1.f, nullptr, BR + 256 + head * 64, nullptr, smem);
    }
  }
}

DI void ew_phase(const Params& P, const u16* __restrict__ Y, float coef, const float* __restrict__ gpost,
                 const float* __restrict__ gnext, bool from_inputs) {
  const int tid = opaque_tid();
  const int lane = tid & 63, wave = tid >> 6;
  u16* XN = (u16*)(P.ws + OFF_XN);
  u16* XB = (u16*)(P.ws + OFF_XB);
  for (int tok = blockIdx.x * 8 + wave; tok < T; tok += gridDim.x * 8) {
    float4 x[4];
    if (from_inputs) {
      const float* xs = tok < SEQ0 ? P.x_prompt + (size_t)tok * DM : P.x_sample + (size_t)(tok - SEQ0) * DM;
#pragma unroll
      for (int i = 0; i < 4; ++i) x[i] = *(const float4*)(xs + (i * 64 + lane) * 4);
    } else {
#pragma unroll
      for (int i = 0; i < 4; ++i) {
        const uint2 xb = *(const uint2*)(XB + (size_t)tok * DM + (i * 64 + lane) * 4);
        x[i] = make_float4(bf2f(xb.x & 0xffffu), bf2f(xb.x >> 16), bf2f(xb.y & 0xffffu), bf2f(xb.y >> 16));
      }
    }
    if (Y) {
      float4 y[4];
      float ss = 0.f;
#pragma unroll
      for (int i = 0; i < 4; ++i) {
        const uint2 yb = *(const uint2*)(Y + (size_t)tok * KP1 + (i * 64 + lane) * 4);
        y[i] = make_float4(bf2f(yb.x & 0xffffu), bf2f(yb.x >> 16), bf2f(yb.y & 0xffffu), bf2f(yb.y >> 16));
        ss += y[i].x * y[i].x + y[i].y * y[i].y + y[i].z * y[i].z + y[i].w * y[i].w;
      }
      ss = wave_sum(ss);
      const float rs = rsqrtf(ss * (1.f / 1024.f) + EPS) * coef;
#pragma unroll
      for (int i = 0; i < 4; ++i) {
        float4 g = *(const float4*)(gpost + (i * 64 + lane) * 4);
        x[i].x += y[i].x * rs * g.x; x[i].y += y[i].y * rs * g.y;
        x[i].z += y[i].z * rs * g.z; x[i].w += y[i].w * rs * g.w;
      }
    }
    if (!gnext) {
#pragma unroll
      for (int i = 0; i < 4; ++i) *(float4*)(P.out + (size_t)tok * DM + (i * 64 + lane) * 4) = x[i];
    } else {
#pragma unroll
      for (int i = 0; i < 4; ++i) {
        uint2 pk;
        pk.x = pk2(x[i].x, x[i].y);
        pk.y = pk2(x[i].z, x[i].w);
        *(uint2*)(XB + (size_t)tok * DM + (i * 64 + lane) * 4) = pk;
      }
    }
    if (gnext) {
      float ss = 0.f;
#pragma unroll
      for (int i = 0; i < 4; ++i) ss += x[i].x * x[i].x + x[i].y * x[i].y + x[i].z * x[i].z + x[i].w * x[i].w;
      ss = wave_sum(ss);
      const float rs = rsqrtf(ss * (1.f / 1024.f) + EPS);
#pragma unroll
      for (int i = 0; i < 4; ++i) {
        float4 g = *(const float4*)(gnext + (i * 64 + lane) * 4);
        uint2 pk;
        pk.x = pk2(x[i].x * rs * g.x, x[i].y * rs * g.y);
        pk.y = pk2(x[i].z * rs * g.z, x[i].w * rs * g.w);
        *(uint2*)(XN + (size_t)tok * KP1 + (i * 64 + lane) * 4) = pk;
      }
    }
  }
}

DI int colmap(int mode, int n, int nsrc) {
  if (mode == 1) { return ((n >> 7) & 1) * DFF + (n >> 8) * 128 + (n & 127); }
  if (mode == 2) {
    if (n < 2560) {
      const int w = n & 255;
      n = (n & ~255) + ((w >> 5) & 3) * 64 + (w >> 7) * 32 + (w & 31);
    }
    if (n < 1664) return n;
    if (n < 2432) return n + 32;
    if (n < 2464) return n - 2432 + 1664;
    if (n < 2560) return -1;
    return n - 96;
  }
  return n < nsrc ? n : -1;
}
DI void conv_job(u16* __restrict__ dst, int ldd, const float* __restrict__ src, int Nd, int K, int lds, int mode,
                 const float* __restrict__ kscale) {
  const int total = Nd * (K >> 3);
  const int gthreads = gridDim.x * NTHR;
  for (int idx = blockIdx.x * NTHR + opaque_tid(); idx < total; idx += gthreads) {
    const int n = idx % Nd, k8 = idx / Nd;
    const int col = colmap(mode, n, lds);
    float v[8];
#pragma unroll
    for (int j = 0; j < 8; ++j) {
      float x = 0.f;
      if (col >= 0) {
        x = src[(size_t)(k8 * 8 + j) * lds + col];
        if (kscale) x *= kscale[k8 * 8 + j];
      }
      v[j] = x;
    }
    uint4 pk = {pk2(v[0], v[1]), pk2(v[2], v[3]), pk2(v[4], v[5]), pk2(v[6], v[7])};
    *(uint4*)(dst + (size_t)n * ldd + k8 * 8) = pk;
  }
}
DI void convert_layer(const Params& P, int l) {
  u16* W = (u16*)(P.ws + OFF_W);
  for (int s = 0; s < 2; ++s) {
    conv_job(W + W_WI + (size_t)s * 5632 * KP1, KP1, P.ffn_wi + ((size_t)l * 2 + s) * 1024 * 5632, 5632, 1024, 5632, 1, nullptr);
    conv_job(W + W_WO + (size_t)s * 1024 * KP2, KP2, P.ffn_wo + ((size_t)l * 2 + s) * 2816 * 1024, 1024, 2816, 1024, 0, nullptr);
  }
  conv_job(W + W_WIN, KP1, P.w_in + (size_t)l * 1024 * NPROJ, 6656, 1024, NPROJ, 2, nullptr);
  conv_job(W + W_WUQ, 384, P.c_w_uq + (size_t)l * 384 * 384, 512, 384, 384, 0, P.c_q_norm + l * 384);
  conv_job(W + W_WUKV, 256, P.c_w_ukv + (size_t)l * 256 * 512, 512, 256, 512, 0, P.c_kv_norm + l * 256);
  conv_job(W + W_WB, KP1, P.w_branch + (size_t)l * 1024 * 1024, 1024, 1024, 1024, 0, nullptr);
  conv_job(W + W_WOUT, KP1, P.w_out + (size_t)l * 1024 * 1024, 1024, 1024, 1024, 0, nullptr);
}
DI void rope_tables(const Params& P) {
  float2* R64 = (float2*)(P.ws + OFF_R64);
  float2* R32 = (float2*)(P.ws + OFF_R32);
  const int gthreads = gridDim.x * NTHR;
  for (int idx = blockIdx.x * NTHR + opaque_tid(); idx < 16384 * 48; idx += gthreads) {
    int pos, f; double base; float2* dst;
    if (idx < 16384 * 32) { pos = idx >> 5; f = idx & 31; base = 0.7498942093324559; dst = R64 + idx; }
    else { const int i2 = idx - 16384 * 32; pos = i2 >> 4; f = i2 & 15; base = 0.5623413251903491; dst = R32 + i2; }
    double inv = 1.0;
    for (int k = 0; k < f; ++k) inv *= base;
    const float ang = (float)pos * (float)inv;
    double tr = (double)ang * 0.15915494309189535;
    tr -= rint(tr);
    const float tf = (float)tr;
    *dst = make_float2(__builtin_amdgcn_cosf(tf), __builtin_amdgcn_sinf(tf));
  }
}

DI void fast_grid_barrier(unsigned* bar, unsigned nblk) {
  asm volatile("s_waitcnt vmcnt(0) lgkmcnt(0)" ::: "memory");
  __syncthreads();
  if (threadIdx.x == 0) {
    __builtin_amdgcn_fence(__ATOMIC_RELEASE, "agent");
    asm volatile("s_waitcnt vmcnt(0) lgkmcnt(0)" ::: "memory");
    const unsigned gen = __hip_atomic_load(&bar[64], __ATOMIC_RELAXED, __HIP_MEMORY_SCOPE_AGENT);
    const unsigned old = __hip_atomic_fetch_add(&bar[0], 1u, __ATOMIC_RELAXED, __HIP_MEMORY_SCOPE_AGENT);
    if (old == nblk - 1u) {
      __hip_atomic_store(&bar[0], 0u, __ATOMIC_RELAXED, __HIP_MEMORY_SCOPE_AGENT);
      __hip_atomic_fetch_add(&bar[64], 1u, __ATOMIC_RELEASE, __HIP_MEMORY_SCOPE_AGENT);
    } else {
      while (__hip_atomic_load(&bar[64], __ATOMIC_RELAXED, __HIP_MEMORY_SCOPE_AGENT) == gen) __builtin_amdgcn_s_sleep(1);
    }
    __builtin_amdgcn_fence(__ATOMIC_ACQUIRE, "agent");
    asm volatile("s_waitcnt vmcnt(0) lgkmcnt(0)" ::: "memory");
  }
  __syncthreads();
}

__global__ void __launch_bounds__(NTHR) __attribute__((amdgpu_waves_per_eu(2, 2))) mega(Params P) {
  extern __shared__ __attribute__((aligned(16))) char smem[];
  cg::grid_group grid = cg::this_grid();
  int phase = 0;
#if MULTI_LAUNCH
#define ACTIVE() (phase >= P.phase_lo && phase < P.phase_hi)
#define SEAM() do { ++phase; } while (0)
#else
#define ACTIVE() (true)
#define SEAM() do { ++phase; if (phase == 1) grid.sync(); else fast_grid_barrier((unsigned*)(P.ws + OFF_BAR), gridDim.x); } while (0)
#endif
  u16* W = (u16*)(P.ws + OFF_W);
  u16* XN = (u16*)(P.ws + OFF_XN);
  u16* R2 = (u16*)(P.ws + OFF_R2);
  u16* qkv = (u16*)(P.ws + OFF_QKV);
  const u16* Y = qkv + Q_Y;
#define PTRS

  if (ACTIVE()) { PTRS
    rope_tables(P);
    convert_layer(P, 0);
    ew_phase(P, nullptr, 0.f, nullptr, P.norm_g, true);
  }
  SEAM();
  for (int l = 0; l < 4; ++l) {
    const float* g = P.norm_g + (size_t)l * 6 * DM;
    if (ACTIVE()) { PTRS gemm8_phase<5632, DM, KP1>(XN, W + W_WI, EpiFfnUp8{R2}, smem); }
    SEAM();
    if (ACTIVE()) { PTRS gemm8_phase<1024, DFF, KP2>(R2, W + W_WO, EpiY8{qkv + Q_Y}, smem); }
    SEAM();
    if (ACTIVE()) { PTRS ew_phase(P, Y, 0.5f, g + DM, g + 2 * DM, false); }
    SEAM();
    if (ACTIVE()) { PTRS
      gemm8_phase<2560, DM, KP1>(XN, W + W_WIN, EpiProj8{&P, l}, smem);
      gemm8_phase<4096, DM, KP1>(XN, W + W_WIN + 2560ull * KP1, EpiGate8{(unsigned char*)R2}, smem);
    }
    SEAM();
    if (ACTIVE()) { PTRS
      gemm_phase<M_CUQ, 4>(W + W_WUQ, 384, qkv + Q_CQ, 384, 384, 2, smem, P, l);
      gemm_phase<M_CUKV, 4>(W + W_WUKV, 256, qkv + Q_CKV, 256, 256, 2, smem, P, l);
    }
    SEAM();
    if (ACTIVE()) { PTRS attn_phase(P, l, smem); }
    SEAM();
    if (ACTIVE()) { PTRS gemm_phase<M_MERGE, 2>(W + W_WB, KP1, XN, KP1, DM, 4, smem, P, l); }
    SEAM();
    if (ACTIVE()) { PTRS gemm8_phase<1024, DM, KP1>(qkv + Q_MERGED, W + W_WOUT, EpiY8{qkv + Q_Y}, smem); }
    SEAM();
    if (ACTIVE()) { PTRS ew_phase(P, Y, 1.0f, g + 3 * DM, g + 4 * DM, false); }
    SEAM();
    if (ACTIVE()) { PTRS gemm8_phase<5632, DM, KP1>(XN, W + W_WI + 5632ull * KP1, EpiFfnUp8{R2}, smem); }
    SEAM();
    if (ACTIVE()) { PTRS gemm8_phase<1024, DFF, KP2>(R2, W + W_WO + 1024ull * KP2, EpiY8{qkv + Q_Y}, smem); }
    SEAM();
    if (ACTIVE()) { PTRS
      ew_phase(P, Y, 0.5f, g + 5 * DM, l < 3 ? g + 6 * DM : nullptr, false);
      if (l < 3) convert_layer(P, l + 1);
    }
    SEAM();
  }
}

constexpr int N_PHASES = 1 + 12 * 4;

extern "C" void kernel_launch(void* const* d_in, const int* in_sizes, int n_in, void* d_out, int out_size, void* d_ws,
                              size_t ws_size, hipStream_t stream) {
  static int grid_blocks = 0;
  if (!grid_blocks) {
    int dev = 0, cus = 0, per_cu = 0;
    hipGetDevice(&dev);
    hipDeviceGetAttribute(&cus, hipDeviceAttributeMultiprocessorCount, dev);
    hipFuncSetAttribute((const void*)mega, hipFuncAttributeMaxDynamicSharedMemorySize, SMEM_BYTES);
    hipOccupancyMaxActiveBlocksPerMultiprocessor(&per_cu, mega, NTHR, SMEM_BYTES);
    if (per_cu < 1) per_cu = 1;
    grid_blocks = cus * per_cu;
  }
  if (ws_size < WS_NEEDED) fprintf(stderr, "workspace too small: %zu < %zu\n", ws_size, (size_t)WS_NEEDED);
  Params P{};
  P.x_prompt = (const float*)d_in[0]; P.x_sample = (const float*)d_in[1]; P.norm_g = (const float*)d_in[2];
  P.w_in = (const float*)d_in[3]; P.a_qk_norm = (const float*)d_in[4]; P.b_sink = (const float*)d_in[5];
  P.c_q_norm = (const float*)d_in[6]; P.c_kv_norm = (const float*)d_in[7]; P.c_w_uq = (const float*)d_in[8];
  P.c_w_ukv = (const float*)d_in[9]; P.d_lambda = (const float*)d_in[10]; P.d_subln = (const float*)d_in[11];
  P.w_branch = (const float*)d_in[12]; P.w_out = (const float*)d_in[13]; P.ffn_wi = (const float*)d_in[14];
  P.ffn_wo = (const float*)d_in[15];
  P.out = (float*)d_out; P.ws = (char*)d_ws;
#if MULTI_LAUNCH
  for (int ph = 0; ph < N_PHASES; ++ph) {
    P.phase_lo = ph; P.phase_hi = ph + 1; P.coop = 0; P.pad0 = 0;
    hipLaunchKernelGGL(mega, dim3(grid_blocks), dim3(NTHR), SMEM_BYTES, stream, P);
  }
#else
  P.phase_lo = 0; P.phase_hi = 1 << 30; P.coop = 1; P.pad0 = 0;
  hipMemsetAsync((char*)d_ws + OFF_BAR, 0, 1024, stream);
  void* args[] = {&P};
  hipError_t e = hipLaunchCooperativeKernel((const void*)mega, dim3(grid_blocks), dim3(NTHR), args, SMEM_BYTES, stream);
  if (e != hipSuccess) fprintf(stderr, "cooperative launch failed: %s (grid %d)\n", hipGetErrorString(e), grid_blocks);
#endif
}
```

```cpp
#include <hip/hip_runtime.h>
#include <hip/hip_cooperative_groups.h>
#include <cstdio>
#include <cstdint>
#include <type_traits>
namespace cg = cooperative_groups;

#ifndef MULTI_LAUNCH
#define MULTI_LAUNCH 0
#endif

#define DI __device__ __forceinline__
typedef unsigned short u16;
typedef __attribute__((ext_vector_type(8))) short bf16x8;
typedef __attribute__((ext_vector_type(16))) float f32x16;
typedef __attribute__((ext_vector_type(2))) float f32x2_t;
typedef __attribute__((ext_vector_type(2))) __bf16 bf16x2_t;

constexpr int T = 32768;
constexpr int DM = 1024;
constexpr int DFF = 2816;
constexpr int KP1 = 1088;
constexpr int KP2 = 2880;
constexpr int GP = 4160;
constexpr int YP = 1040;
constexpr int NPROJ = 6560;
constexpr int SEQ0 = 16384;
constexpr int DSEQ = 2048;
constexpr float EPS = 1e-6f;
constexpr int NTHR = 512;
constexpr int LSTR = 72;
constexpr int SMEM_BYTES = 2 * 2 * 256 * LSTR * 2;

constexpr size_t W_WI = 0;
constexpr size_t W_WO = W_WI + 2ull * 5632 * KP1;
constexpr size_t W_WIN = W_WO + 2ull * 1024 * KP2;
constexpr size_t W_WUQ = W_WIN + 6656ull * KP1;
constexpr size_t W_WUKV = W_WUQ + 512ull * 384;
constexpr size_t W_WB = W_WUKV + 512ull * 256;
constexpr size_t W_WOUT = W_WB + 1024ull * KP1;
constexpr size_t W_TOTAL = W_WOUT + 1024ull * KP1;

constexpr size_t OFF_W = 0;
constexpr size_t OFF_XN = OFF_W + W_TOTAL * 2;
constexpr size_t OFF_R2 = OFF_XN + (size_t)T * KP1 * 2;
constexpr size_t OFF_QKV = OFF_R2 + (size_t)T * KP2 * 2;
constexpr size_t OFF_SS = OFF_QKV + (size_t)T * 3456 * 2;
constexpr size_t OFF_R64 = OFF_SS + (size_t)T * 20 * 4;
constexpr size_t OFF_R32 = OFF_R64 + 16384ull * 32 * 8;
constexpr size_t OFF_DS = OFF_R32 + 16384ull * 16 * 8;
constexpr size_t OFF_BAR = OFF_DS + (size_t)T * 256 * 4;
constexpr size_t OFF_XB = OFF_BAR + 1024;
constexpr size_t WS_NEEDED = OFF_XB + (size_t)T * 1024 * 2;

constexpr size_t Q_QA = 0;
constexpr size_t Q_KA = (size_t)T * 256;
constexpr size_t Q_VTA = (size_t)T * 384;
constexpr size_t Q_QB = (size_t)T * 512;
constexpr size_t Q_KB = (size_t)T * 768;
constexpr size_t Q_VTB = (size_t)T * 896;
constexpr size_t Q_CQ = (size_t)T * 1024;
constexpr size_t Q_CKV = (size_t)T * 1408;
constexpr size_t Q_QC = (size_t)T * 1664;
constexpr size_t Q_KC = (size_t)T * 2048;
constexpr size_t Q_VTC = (size_t)T * 2432;
constexpr size_t Q_QD = (size_t)T * 2688;
constexpr size_t Q_KD = (size_t)T * 2944;
constexpr size_t Q_VTD = (size_t)T * 3200;
constexpr size_t Q_MERGED = 0;
constexpr size_t Q_Y = (size_t)T * KP1;

struct Params {
  const float* x_prompt; const float* x_sample; const float* norm_g; const float* w_in;
  const float* a_qk_norm; const float* b_sink; const float* c_q_norm; const float* c_kv_norm;
  const float* c_w_uq; const float* c_w_ukv; const float* d_lambda; const float* d_subln;
  const float* w_branch; const float* w_out; const float* ffn_wi; const float* ffn_wo;
  float* out; char* ws;
  int phase_lo; int phase_hi; int coop; int pad0;
};

DI unsigned pk2(float a, float b) {
  f32x2_t v = {a, b};
  bf16x2_t r = __builtin_convertvector(v, bf16x2_t);
  return __builtin_bit_cast(unsigned, r);
}
DI u16 f2bf(float a) { return (u16)(pk2(a, 0.f) & 0xffffu); }
DI float bf2f(unsigned bits16) { return __uint_as_float(bits16 << 16); }
DI int crow(int v, int h) { return (v & 3) + 8 * (v >> 2) + 4 * h; }
DI int pos_of(int tok) { return tok < SEQ0 ? tok : ((tok - SEQ0) & (DSEQ - 1)); }
#define MFMA32(a, b, c) __builtin_amdgcn_mfma_f32_32x32x16_bf16((a), (b), (c), 0, 0, 0)

typedef __attribute__((ext_vector_type(4))) unsigned u32x4;
DI u32x4 gld16(const void* p) { u32x4 r; asm volatile("global_load_dwordx4 %0, %1, off" : "=v"(r) : "v"(p)); return r; }
DI void wait_vm0(u32x4& a) { asm volatile("s_waitcnt vmcnt(0)" : "+v"(a) :: "memory"); }
DI void wait_vm0(u32x4& a, u32x4& b) { asm volatile("s_waitcnt vmcnt(0)" : "+v"(a), "+v"(b) :: "memory"); }
DI void wait_vm0(u32x4& a, u32x4& b, u32x4& c) { asm volatile("s_waitcnt vmcnt(0)" : "+v"(a), "+v"(b), "+v"(c) :: "memory"); }
DI void wait_vm0(u32x4& a, u32x4& b, u32x4& c, u32x4& d) { asm volatile("s_waitcnt vmcnt(0)" : "+v"(a), "+v"(b), "+v"(c), "+v"(d) :: "memory"); }
DI u32x4 gld16s(unsigned voff, const void* sbase) { u32x4 r; asm volatile("global_load_dwordx4 %0, %1, %2" : "=v"(r) : "v"(voff), "s"(sbase)); return r; }
#define DEF_WAIT8(name, cnt) DI void name(u32x4& a, u32x4& b, u32x4& c, u32x4& d, u32x4& e, u32x4& f, u32x4& g, u32x4& h) { asm volatile("s_waitcnt vmcnt(" #cnt ")" : "+v"(a), "+v"(b), "+v"(c), "+v"(d), "+v"(e), "+v"(f), "+v"(g), "+v"(h) :: "memory"); }
#define DEF_WAIT6(name, cnt) DI void name(u32x4& a, u32x4& b, u32x4& c, u32x4& d, u32x4& e, u32x4& f) { asm volatile("s_waitcnt vmcnt(" #cnt ")" : "+v"(a), "+v"(b), "+v"(c), "+v"(d), "+v"(e), "+v"(f) :: "memory"); }
DEF_WAIT8(wait8_vm8, 8)
DEF_WAIT8(wait8_vm0, 0)
DEF_WAIT6(wait6_vm6, 6)
DEF_WAIT6(wait6_vm0, 0)
DI int opaque_tid() { int t = threadIdx.x; asm volatile("" : "+v"(t)); return t; }
DI float wave_sum(float v) {
#pragma unroll
  for (int m = 32; m >= 1; m >>= 1) v += __shfl_xor(v, m);
  return v;
}

DI void rope32_blk(f32x16& a, const float2* __restrict__ tab, int h) {
#pragma unroll
  for (int v = 0; v < 8; ++v) {
    float2 cs = tab[crow(v, h)];
    float x1 = a[v], x2 = a[v + 8];
    a[v] = x1 * cs.x - x2 * cs.y;
    a[v + 8] = x2 * cs.x + x1 * cs.y;
  }
}
DI void rope64_blk(f32x16& a0, f32x16& a1, const float2* __restrict__ tab, int h) {
#pragma unroll
  for (int v = 0; v < 16; ++v) {
    float2 cs = tab[crow(v, h)];
    float x1 = a0[v], x2 = a1[v];
    a0[v] = x1 * cs.x - x2 * cs.y;
    a1[v] = x2 * cs.x + x1 * cs.y;
  }
}
DI void store_rows(u16* __restrict__ base, int ld, int col0, const f32x16& a, int tok, int h) {
#pragma unroll
  for (int vq = 0; vq < 4; ++vq) {
    uint2 pk;
    pk.x = pk2(a[4 * vq], a[4 * vq + 1]);
    pk.y = pk2(a[4 * vq + 2], a[4 * vq + 3]);
    *(uint2*)(base + (size_t)tok * ld + col0 + 8 * vq + 4 * h) = pk;
  }
}
DI void store_T(u16* __restrict__ base, int row0, const f32x16& a, int tok, int h) {
  const int tp = (tok & ~12) | ((tok & 4) << 1) | ((tok & 8) >> 1);
#pragma unroll
  for (int v = 0; v < 16; ++v) base[(size_t)((row0 + crow(v, h)) >> 6) * 64 * T + (size_t)(tp >> 7) * 8192 + ((row0 + crow(v, h)) & 63) * 128 + (tp & 127)] = f2bf(a[v]);
}

enum { M_FFNUP = 0, M_Y = 1, M_PROJ = 2, M_CUQ = 3, M_CUKV = 4, M_MERGE = 5, M_GATE = 6 };

template <int MODE, int NJ>
DI void gemm_epilogue(f32x16 (&acc)[2][NJ], int fbase, int tbase, int r, int h, const Params& P, int layer) {
  char* ws = P.ws;
  u16* qkv = (u16*)(ws + OFF_QKV);
  const float2* R64 = (const float2*)(ws + OFF_R64);
  const float2* R32 = (const float2*)(ws + OFF_R32);
  float* SS = (float*)(ws + OFF_SS);
  if constexpr (MODE == M_FFNUP) {
    u16* H = (u16*)(ws + OFF_R2);
    const int hf0 = (fbase >> 6) * 32;
#pragma unroll
    for (int j = 0; j < NJ; ++j) {
      const int tok = tbase + j * 32 + r;
      f32x16 o;
#pragma unroll
      for (int v = 0; v < 16; ++v) {
        float g = acc[0][j][v], u = acc[1][j][v];
        o[v] = g * __builtin_amdgcn_rcpf(1.f + __builtin_amdgcn_exp2f(-1.4426950408889634f * g)) * u;
      }
      store_rows(H, KP2, hf0, o, tok, h);
    }
  } else if constexpr (MODE == M_Y) {
    u16* Yb = qkv + Q_Y;
#pragma unroll
    for (int j = 0; j < NJ; ++j) {
      const int tok = tbase + j * 32 + r;
      store_rows(Yb, KP1, fbase, acc[0][j], tok, h);
      store_rows(Yb, KP1, fbase + 32, acc[1][j], tok, h);
    }
  } else if constexpr (MODE == M_PROJ) {
    if (fbase < 384) {
      const bool isK = fbase >= 256;
      const float* g = P.a_qk_norm + layer * 128 + (isK ? 64 : 0);
      u16* dst = qkv + (isK ? Q_KA : Q_QA);
      const int ld = isK ? 128 : 256;
      const int c0 = isK ? fbase - 256 : fbase;
      float gv[2][16];
#pragma unroll
      for (int i = 0; i < 2; ++i)
#pragma unroll
        for (int v = 0; v < 16; ++v) gv[i][v] = g[i * 32 + crow(v, h)];
#pragma unroll
      for (int j = 0; j < NJ; ++j) {
        const int tok = tbase + j * 32 + r;
        const int pos = pos_of(tok);
        float ss = 0.f;
#pragma unroll
        for (int i = 0; i < 2; ++i)
#pragma unroll
          for (int v = 0; v < 16; ++v) ss += acc[i][j][v] * acc[i][j][v];
        ss += __shfl_xor(ss, 32);
        const float rs = rsqrtf(ss * (1.f / 64.f) + EPS);
#pragma unroll
        for (int i = 0; i < 2; ++i)
#pragma unroll
          for (int v = 0; v < 16; ++v) acc[i][j][v] *= rs * gv[i][v];
        rope32_blk(acc[0][j], R32 + (size_t)(pos >> 6) * 16, h);
        rope32_blk(acc[1][j], R32 + (size_t)(pos & 63) * 16, h);
        store_rows(dst, ld, c0, acc[0][j], tok, h);
        store_rows(dst, ld, c0 + 32, acc[1][j], tok, h);
      }
    } else if (fbase < 512) {
#pragma unroll
      for (int j = 0; j < NJ; ++j) {
        const int tok = tbase + j * 32 + r;
        store_T(qkv + Q_VTA, fbase - 384, acc[0][j], tok, h);
        store_T(qkv + Q_VTA, fbase - 384 + 32, acc[1][j], tok, h);
      }
    } else if (fbase < 896) {
      const bool isK = fbase >= 768;
      u16* dst = qkv + (isK ? Q_KB : Q_QB);
      const int ld = isK ? 128 : 256;
      const int c0 = isK ? fbase - 768 : fbase - 512;
#pragma unroll
      for (int j = 0; j < NJ; ++j) {
        const int tok = tbase + j * 32 + r;
        const int pos = pos_of(tok);
        rope64_blk(acc[0][j], acc[1][j], R64 + (size_t)pos * 32, h);
        store_rows(dst, ld, c0, acc[0][j], tok, h);
        store_rows(dst, ld, c0 + 32, acc[1][j], tok, h);
      }
    } else if (fbase < 1024) {
#pragma unroll
      for (int j = 0; j < NJ; ++j) {
        const int tok = tbase + j * 32 + r;
        store_T(qkv + Q_VTB, fbase - 896, acc[0][j], tok, h);
        store_T(qkv + Q_VTB, fbase - 896 + 32, acc[1][j], tok, h);
      }
    } else if (fbase < 1664) {
      const bool isKV = fbase >= 1408;
      u16* dst = qkv + (isKV ? Q_CKV : Q_CQ);
      const int ld = isKV ? 256 : 384;
      const int c0 = isKV ? fbase - 1408 : fbase - 1024;
      const int sb = (isKV ? 12 : 0) + (c0 >> 5);
#pragma unroll
      for (int j = 0; j < NJ; ++j) {
        const int tok = tbase + j * 32 + r;
#pragma unroll
        for (int i = 0; i < 2; ++i) {
          float ss = 0.f;
#pragma unroll
          for (int v = 0; v < 16; ++v) ss += acc[i][j][v] * acc[i][j][v];
          ss += __shfl_xor(ss, 32);
          if (h == 0) SS[(size_t)tok * 20 + sb + i] = ss;
          store_rows(dst, ld, c0 + i * 32, acc[i][j], tok, h);
        }
      }
    } else if (fbase < 2176) {
      const bool isK = fbase >= 1920;
      u16* dst = qkv + (isK ? Q_KD : Q_QD);
      const int c0 = isK ? fbase - 1920 : fbase - 1664;
#pragma unroll
      for (int j = 0; j < NJ; ++j) {
        const int tok = tbase + j * 32 + r;
        const int pos = pos_of(tok);
#pragma unroll
        for (int i = 0; i < 2; ++i) {
          rope32_blk(acc[i][j], R32 + (size_t)pos * 16, h);
          store_rows(dst, 256, c0 + i * 32, acc[i][j], tok, h);
        }
      }
    } else if (fbase < 2432) {
#pragma unroll
      for (int j = 0; j < NJ; ++j) {
        const int tok = tbase + j * 32 + r;
        store_T(qkv + Q_VTD, fbase - 2176, acc[0][j], tok, h);
        store_T(qkv + Q_VTD, fbase - 2176 + 32, acc[1][j], tok, h);
      }
    } else if (fbase == 2432) {
#pragma unroll
      for (int j = 0; j < NJ; ++j) {
        const int tok = tbase + j * 32 + r;
        const int pos = pos_of(tok);
        rope32_blk(acc[0][j], R32 + (size_t)pos * 16, h);
#pragma unroll
        for (int hd = 0; hd < 4; ++hd) store_rows(qkv + Q_KC, 384, hd * 96 + 64, acc[0][j], tok, h);
      }
    }
  } else if constexpr (MODE == M_GATE) {
    unsigned char* G8 = (unsigned char*)(ws + OFF_R2);
#pragma unroll
    for (int j = 0; j < NJ; ++j) {
      const int tok = tbase + j * 32 + r;
#pragma unroll
      for (int i = 0; i < 2; ++i)
#pragma unroll
        for (int vq = 0; vq < 4; ++vq) {
          unsigned pk = 0u;
#pragma unroll
          for (int e = 0; e < 4; ++e) {
            const float o = __builtin_amdgcn_rcpf(1.f + __builtin_amdgcn_exp2f(-1.4426950408889634f * acc[i][j][4 * vq + e]));
            pk |= (unsigned)(o * 255.f + 0.5f) << (8 * e);
          }
          *(unsigned*)(G8 + (size_t)tok * GP + fbase + i * 32 + 8 * vq + 4 * h) = pk;
        }
    }
  } else if constexpr (MODE == M_CUQ) {
    if (fbase >= 384) return;
#pragma unroll
    for (int j = 0; j < NJ; ++j) {
      const int tok = tbase + j * 32 + r;
      const int pos = pos_of(tok);
      float ss = 0.f;
#pragma unroll
      for (int b = 0; b < 12; ++b) ss += SS[(size_t)tok * 20 + b];
      const float rs = rsqrtf(ss * (1.f / 384.f) + EPS);
#pragma unroll
      for (int i = 0; i < 2; ++i) {
        const int blk = (fbase >> 5) + i;
#pragma unroll
        for (int v = 0; v < 16; ++v) acc[i][j][v] *= rs;
        if (blk % 3 == 2) rope32_blk(acc[i][j], R32 + (size_t)pos * 16, h);
        store_rows(qkv + Q_QC, 384, blk * 32, acc[i][j], tok, h);
      }
    }
  } else if constexpr (MODE == M_CUKV) {
#pragma unroll
    for (int j = 0; j < NJ; ++j) {
      const int tok = tbase + j * 32 + r;
      float ss = 0.f;
#pragma unroll
      for (int b = 0; b < 8; ++b) ss += SS[(size_t)tok * 20 + 12 + b];
      const float rs = rsqrtf(ss * (1.f / 256.f) + EPS);
#pragma unroll
      for (int i = 0; i < 2; ++i) {
        const int blk = (fbase >> 5) + i;
        const int hd = blk >> 2, q = blk & 3;
#pragma unroll
        for (int v = 0; v < 16; ++v) acc[i][j][v] *= rs;
        if (q < 2) store_rows(qkv + Q_KC, 384, hd * 96 + q * 32, acc[i][j], tok, h);
        else store_T(qkv + Q_VTC, hd * 64 + (q - 2) * 32, acc[i][j], tok, h);
      }
    }
  } else if constexpr (MODE == M_MERGE) {
#pragma unroll
    for (int j = 0; j < NJ; ++j) {
      const int tok = tbase + j * 32 + r;
      store_rows(qkv + Q_MERGED, KP1, fbase, acc[0][j], tok, h);
      store_rows(qkv + Q_MERGED, KP1, fbase + 32, acc[1][j], tok, h);
    }
  }
}

typedef __attribute__((address_space(3))) unsigned lds_u32_t;
typedef __attribute__((address_space(1))) const unsigned glb_u32_t;
template <int MODE, int NJ>
DI void gemm_tile(const u16* __restrict__ Wt, int ldw, const u16* __restrict__ X, int ldx, int K, int f0, int t0, char* smem,
                  const Params& P, int layer) {
  constexpr int XROWS = NJ * 64;
  constexpr int WSTG = 256 * 64, XSTG = XROWS * 64;
  u16* sW = (u16*)smem;
  u16* sX = sW + 2 * WSTG;
  const int tid = opaque_tid(), lane = tid & 63, wave = tid >> 6, r = lane & 31, h = lane >> 5;
  const int wf = wave & 3, wt = wave >> 2;
  f32x16 acc[2][NJ];
  f32x16 tot[2][MODE == M_MERGE ? NJ : 1];
#pragma unroll
  for (int i = 0; i < 2; ++i)
#pragma unroll
    for (int j = 0; j < NJ; ++j)
#pragma unroll
      for (int v = 0; v < 16; ++v) acc[i][j][v] = 0.f;
  if constexpr (MODE == M_MERGE) {
#pragma unroll
    for (int i = 0; i < 2; ++i)
#pragma unroll
      for (int j = 0; j < NJ; ++j)
#pragma unroll
        for (int v = 0; v < 16; ++v) tot[i][j][v] = 0.f;
  }
  const int nk = K >> 6;
  const int srow = tid >> 3;
  const int schunk = (tid & 7) ^ ((tid >> 4) & 7);
  const u16* wp = Wt + (size_t)(f0 + srow) * ldw + schunk * 8;
  const u16* xp = X + (size_t)(t0 + srow) * ldx + schunk * 8;
  const int fbase = f0 + wf * 64, tbase = t0 + wt * (NJ * 32);

  auto issue = [&](int kt, int buf) {
#pragma unroll
    for (int i = 0; i < 4; ++i)
      __builtin_amdgcn_global_load_lds((glb_u32_t*)(wp + (size_t)(i * 64) * ldw + kt * 64),
                                       (lds_u32_t*)(sW + buf * WSTG + i * 4096 + tid * 8), 16, 0, 0);
#pragma unroll
    for (int i = 0; i < NJ; ++i)
      __builtin_amdgcn_global_load_lds((glb_u32_t*)(xp + (size_t)(i * 64) * ldx + kt * 64),
                                       (lds_u32_t*)(sX + buf * XSTG + i * 4096 + tid * 8), 16, 0, 0);
  };
  const int swz = (r >> 1) & 7;
  auto compute = [&](int buf, int kt) {
    const u16* aW = sW + buf * WSTG + (wf * 64 + r) * 64;
    const u16* aX = sX + buf * XSTG + (wt * (NJ * 32) + r) * 64;
#pragma unroll
    for (int ks = 0; ks < 4; ++ks) {
      const int co = ((2 * ks + h) ^ swz) * 8;
      bf16x8 wfrag[2], xfrag[NJ];
#pragma unroll
      for (int i = 0; i < 2; ++i) wfrag[i] = *(const bf16x8*)(aW + i * 32 * 64 + co);
#pragma unroll
      for (int j = 0; j < NJ; ++j) xfrag[j] = *(const bf16x8*)(aX + j * 32 * 64 + co);
#pragma unroll
      for (int i = 0; i < 2; ++i)
#pragma unroll
        for (int j = 0; j < NJ; ++j) acc[i][j] = MFMA32(wfrag[i], xfrag[j], acc[i][j]);
    }
    if constexpr (MODE == M_MERGE) {
      if ((kt & 3) == 3) {
        const int br = kt >> 2;
        const unsigned char* G8 = (const unsigned char*)(P.ws + OFF_R2);
#pragma unroll
        for (int j = 0; j < NJ; ++j) {
          const int tok = tbase + j * 32 + r;
#pragma unroll
          for (int i = 0; i < 2; ++i)
#pragma unroll
            for (int vq = 0; vq < 4; ++vq) {
              const unsigned gp = *(const unsigned*)(G8 + (size_t)tok * GP + br * 1024 + fbase + i * 32 + 8 * vq + 4 * h);
              tot[i][j][4 * vq + 0] += (float)(gp & 0xffu) * (1.f / 255.f) * acc[i][j][4 * vq + 0];
              tot[i][j][4 * vq + 1] += (float)((gp >> 8) & 0xffu) * (1.f / 255.f) * acc[i][j][4 * vq + 1];
              tot[i][j][4 * vq + 2] += (float)((gp >> 16) & 0xffu) * (1.f / 255.f) * acc[i][j][4 * vq + 2];
              tot[i][j][4 * vq + 3] += (float)(gp >> 24) * (1.f / 255.f) * acc[i][j][4 * vq + 3];
              acc[i][j][4 * vq + 0] = 0.f; acc[i][j][4 * vq + 1] = 0.f;
              acc[i][j][4 * vq + 2] = 0.f; acc[i][j][4 * vq + 3] = 0.f;
            }
        }
      }
    }
  };

  issue(0, 0);
  asm volatile("s_waitcnt vmcnt(0)" ::: "memory");
  __syncthreads();
  for (int kt = 0; kt < nk; ++kt) {
    const int buf = kt & 1;
    if (kt + 1 < nk) issue(kt + 1, buf ^ 1);
    compute(buf, kt);
    asm volatile("s_waitcnt vmcnt(0) lgkmcnt(0)" ::: "memory");
    __syncthreads();
  }
  if constexpr (MODE == M_MERGE) gemm_epilogue<MODE, NJ>(tot, fbase, tbase, r, h, P, layer);
  else gemm_epilogue<MODE, NJ>(acc, fbase, tbase, r, h, P, layer);
}

template <int MODE, int NJ>
DI void gemm_phase(const u16* Wt, int ldw, const u16* X, int ldx, int K, int nF, char* smem, const Params& P, int layer) {
  constexpr int TT = NJ * 64;
  const int nT = T / TT;
  const int ntiles = nF * nT;
  for (int idx = blockIdx.x; idx < ntiles; idx += gridDim.x) {
    const int tt_lo = idx & 15;
    const int rest = idx >> 4;
    const int ft = rest % nF;
    const int tt = (rest / nF) * 16 + tt_lo;
    gemm_tile<MODE, NJ>(Wt, ldw, X, ldx, K, ft * 256, tt * TT, smem, P, layer);
  }
}

namespace pg8 {
#define PG8_LAS __attribute__((address_space(3)))
typedef unsigned short bf16_t;
typedef short bf16x8 __attribute__((ext_vector_type(8)));
typedef float f32x4 __attribute__((ext_vector_type(4)));
typedef unsigned u32x4 __attribute__((ext_vector_type(4)));
constexpr int BM = 256, BK = 64, HALF = 128, HTB = HALF * BK * 2  , STAGE_BYTES = 8 * HTB, NXCD = 8, WGM = 8;

__host__ __device__ __forceinline__ int lds_byte(int r, int c) { const int st = (r >> 4) * 2 + (c >> 5), rr = r & 15, cc = c & 31, ob = rr * 64 + cc * 2; return st * 1024 + (ob ^ (((ob >> 9) & 1) << 5)); }
__host__ __device__ __forceinline__ void stage_rc(int b, int& R, int& C) { const int st = b / 1024, sb = b % 1024, swz = sb ^ (((sb >> 9) & 1) << 5); R = (st >> 1) * 16 + swz / 64; C = (st & 1) * 32 + (swz % 64) / 2; }
__host__ __device__ __forceinline__ int perm32(int rho) { const int n = rho >> 4, i = rho & 15; return 8 * (i >> 2) + 4 * n + (i & 3); }

struct Unit { int pm, pn; };
struct Gemm { const bf16_t* A; const bf16_t* Bt; int M, N, K, ld; };

struct StaticOrder {
    int nM, nN, nwg, G, c;
    __host__ __device__ void init(int M, int N, int G_, int c_) { nM = M / BM; nN = N / BM; nwg = nM * nN; G = G_; c = c_; }
    __host__ __device__ bool next(int i, Unit& u) const {
        const long L = (long)i * G + c; if (L >= nwg) return false;
        int wgid = (int)L; { const int q = nwg / NXCD, r = nwg % NXCD, xcd = wgid % NXCD, off = wgid / NXCD; wgid = (xcd < r ? xcd * (q + 1) : r * (q + 1) + (xcd - r) * q) + off; }
        const int nig = WGM * nN, gid = wgid / nig, fm = gid * WGM, gsz = (nM - fm) < WGM ? (nM - fm) : WGM;
        u.pm = fm + ((wgid % nig) % gsz); u.pn = (wgid % nig) / gsz; return true;
    }
    __device__ __forceinline__ void a_ready(const Unit&) const {}
    __device__ __forceinline__ void done(const Unit&) const {}
};

template <class Epi, class Sched, bool STAMP, int KC, int LDC>
__device__ __forceinline__ void gemm_phase(PG8_LAS unsigned char* lds, const Gemm g, const Sched& S, const Epi& E, unsigned long long* stamps) {
    const int tid = opaque_tid(), wid = __builtin_amdgcn_readfirstlane(tid >> 6), lane = tid & 63, wr = wid >> 2, wc = wid & 3, fr = lane & 15, fq = lane >> 4;
    constexpr int K = KC, nt = K / BK;
    int ts_lo = 0, ts_hi = 0, nts = 0; const unsigned long long rt_entry = STAMP ? (unsigned long long)wall_clock64() : 0ull;
#define PG8_STAMP() do { if (STAMP && wid == 0 && nts < 64) { const unsigned long long _c = (unsigned long long)clock64(); \
        ts_lo = (lane == nts) ? (int)(unsigned)_c : ts_lo; ts_hi = (lane == nts) ? (int)(unsigned)(_c >> 32) : ts_hi; ++nts; } } while (0)
    PG8_STAMP();
    unsigned voffA[2], voffB[2];
#pragma unroll
    for (int i = 0; i < 2; ++i) { int R, C; stage_rc(tid * 16 + i * 8192, R, C); const int Rb = Epi::PERM ? ((R & ~31) + perm32(R & 31)) : R;
        voffA[i] = (unsigned)(R * LDC + C) * 2u; voffB[i] = (unsigned)(Rb * LDC + C) * 2u; }
    const size_t kstep = (size_t)(BK * 2);
    constexpr size_t hstep = (size_t)HALF * LDC * 2;
    const size_t tstep = 2 * hstep;
    const unsigned ldsw = (unsigned)wid * 1024u;
    const int aoff = lds_byte(wr * 64 + fr, fq * 8), boff = lds_byte(wc * 32 + fr, fq * 8);
#define PG8_SA(b, h) (((b) * 2 + (h)) * HTB)
#define PG8_SB(b, h) ((4 + (b) * 2 + (h)) * HTB)
#define PG8_STAGE(bufoff, gbase, voff) do { _Pragma("unroll") for (int _i = 0; _i < 2; ++_i) \
        __builtin_amdgcn_global_load_lds((const unsigned*)((const char*)(gbase) + (voff)[_i]), (PG8_LAS unsigned*)(lds + (bufoff) + ldsw + _i * 8192), 16, 0, 0); } while (0)
#define PG8_LDA(dst, b, h) do { _Pragma("unroll") for (int m = 0; m < 4; ++m) _Pragma("unroll") for (int k = 0; k < 2; ++k) dst[m][k] = *(const PG8_LAS bf16x8*)(lds + PG8_SA(b, h) + aoff + m * 2048 + k * 1024); } while (0)
#define PG8_LDB(dst, b, h) do { _Pragma("unroll") for (int n = 0; n < 2; ++n) _Pragma("unroll") for (int k = 0; k < 2; ++k) dst[n][k] = *(const PG8_LAS bf16x8*)(lds + PG8_SB(b, h) + boff + n * 2048 + k * 1024); } while (0)
#define PG8_MMA(ai, bj, At, Bt) do { __builtin_amdgcn_s_setprio(1); _Pragma("unroll") for (int m = 0; m < 4; ++m) _Pragma("unroll") for (int n = 0; n < 2; ++n) _Pragma("unroll") for (int k = 0; k < 2; ++k) \
        acc[ai][bj][m][n] = __builtin_amdgcn_mfma_f32_16x16x32_bf16(Bt[n][k], At[m][k], acc[ai][bj][m][n], 0, 0, 0); __builtin_amdgcn_s_setprio(0); } while (0)
#define PG8_WAIT_V(n) asm volatile("s_waitcnt vmcnt(" #n ")" ::: "memory")
#define PG8_WAIT_L(n) asm volatile("s_waitcnt lgkmcnt(" #n ")" ::: "memory")
#define PG8_BAR __builtin_amdgcn_s_barrier()
#define PG8_SCHED __builtin_amdgcn_sched_barrier(0)
    Unit cur, nxt; int ui = 0;
    if (!S.next(0, cur)) return;
    f32x4 acc[2][2][4][2];
#pragma unroll
    for (int a = 0; a < 2; ++a)
#pragma unroll
        for (int b = 0; b < 2; ++b)
#pragma unroll
            for (int m = 0; m < 4; ++m)
#pragma unroll
                for (int n = 0; n < 2; ++n) acc[a][b][m][n] = (f32x4){0.f, 0.f, 0.f, 0.f};
    bf16x8 At[4][2], B0[2][2], B1[2][2];
    const char* cA = (const char*)g.A + (size_t)cur.pm * tstep; const char* cB = (const char*)g.Bt + (size_t)cur.pn * tstep;
    S.a_ready(cur);
    PG8_STAGE(PG8_SB(0, 0), cB, voffB); PG8_STAGE(PG8_SA(0, 0), cA, voffA); PG8_STAGE(PG8_SB(0, 1), cB + hstep, voffB); PG8_STAGE(PG8_SA(0, 1), cA + hstep, voffA);
    if (wr == 1) PG8_BAR;
    PG8_WAIT_V(4); PG8_BAR;
    PG8_STAGE(PG8_SB(1, 0), cB + kstep, voffB); PG8_STAGE(PG8_SA(1, 0), cA + kstep, voffA); PG8_STAGE(PG8_SB(1, 1), cB + hstep + kstep, voffB);
    PG8_WAIT_V(6); PG8_BAR;
    PG8_STAMP();
    for (;;) {
        const bool has_next = S.next(ui + 1, nxt);
        const char* nA = has_next ? (const char*)g.A + (size_t)nxt.pm * tstep : cA; const char* nB = has_next ? (const char*)g.Bt + (size_t)nxt.pn * tstep : cB;
        for (int t = 0; t < nt; t += 2) {
            const bool last = (t == nt - 2);
            const char* a1 = cA + (size_t)(t + 1) * kstep;
            const char* a2 = last ? nA : cA + (size_t)(t + 2) * kstep; const char* b2 = last ? nB : cB + (size_t)(t + 2) * kstep;
            const char* a3 = a2 + kstep; const char* b3 = b2 + kstep;
            if (last && has_next) S.a_ready(nxt);
            PG8_LDB(B0, 0, 0); PG8_SCHED; PG8_LDA(At, 0, 0); PG8_STAGE(PG8_SA(1, 1), a1 + hstep, voffA);
            PG8_WAIT_L(8); PG8_BAR; PG8_WAIT_L(0); PG8_MMA(0, 0, At, B0); PG8_BAR; PG8_SCHED;
            PG8_LDB(B1, 0, 1); PG8_STAGE(PG8_SB(0, 0), b2, voffB);
            PG8_BAR; PG8_WAIT_L(0); PG8_MMA(0, 1, At, B1); PG8_BAR;
            PG8_LDA(At, 0, 1); PG8_STAGE(PG8_SA(0, 0), a2, voffA);
            PG8_BAR; PG8_WAIT_L(0); PG8_MMA(1, 0, At, B0); PG8_BAR; PG8_SCHED;
            PG8_STAGE(PG8_SB(0, 1), b2 + hstep, voffB);
            PG8_WAIT_V(6); PG8_BAR; PG8_MMA(1, 1, At, B1); PG8_BAR;
            PG8_LDB(B0, 1, 0); PG8_SCHED; PG8_LDA(At, 1, 0); PG8_STAGE(PG8_SA(0, 1), a2 + hstep, voffA);
            PG8_WAIT_L(8); PG8_BAR; PG8_WAIT_L(0); PG8_MMA(0, 0, At, B0); PG8_BAR; PG8_SCHED;
            PG8_LDB(B1, 1, 1); PG8_STAGE(PG8_SB(1, 0), b3, voffB);
            PG8_BAR; PG8_WAIT_L(0); PG8_MMA(0, 1, At, B1); PG8_BAR;
            PG8_LDA(At, 1, 1); PG8_STAGE(PG8_SA(1, 0), a3, voffA);
            PG8_BAR; PG8_WAIT_L(0); PG8_MMA(1, 0, At, B0); PG8_BAR; PG8_SCHED;
            PG8_STAGE(PG8_SB(1, 1), b3 + hstep, voffB);
            PG8_WAIT_V(6); PG8_BAR; PG8_MMA(1, 1, At, B1); PG8_BAR;
        }
        PG8_STAMP();
        if constexpr (!Epi::AFTER_DRAIN) { E(acc, cur, wr, wc, fr, fq); S.done(cur); }
        PG8_STAMP();
        if (!has_next) break;
#pragma unroll
        for (int a = 0; a < 2; ++a)
#pragma unroll
            for (int b = 0; b < 2; ++b)
#pragma unroll
                for (int m = 0; m < 4; ++m)
#pragma unroll
                    for (int n = 0; n < 2; ++n) acc[a][b][m][n] = (f32x4){0.f, 0.f, 0.f, 0.f};
        cur = nxt; cA = nA; cB = nB; ++ui;
    }
    PG8_WAIT_V(0);
    if (wr == 0) PG8_BAR;
    PG8_BAR;
    if constexpr (Epi::AFTER_DRAIN) { E.fused(acc, cur, wr, wc, fr, fq, lds, wid, lane); S.done(cur); }
    PG8_STAMP();
    if (STAMP && wid == 0) { stamps[lane] = lane < nts ? (((unsigned long long)(unsigned)ts_hi << 32) | (unsigned)ts_lo) : 0ull;
        if (lane == 62) stamps[62] = rt_entry; if (lane == 63) stamps[63] = (unsigned long long)wall_clock64(); }
#undef PG8_STAMP
#undef PG8_SA
#undef PG8_SB
#undef PG8_STAGE
#undef PG8_LDA
#undef PG8_LDB
#undef PG8_MMA
#undef PG8_WAIT_V
#undef PG8_WAIT_L
#undef PG8_BAR
#undef PG8_SCHED
}
}

struct EpiY8 {
  static constexpr bool PERM = true, AFTER_DRAIN = false;
  u16* O;
  DI void operator()(const pg8::f32x4 (&acc)[2][2][4][2], const pg8::Unit& u, int wr, int wc, int fr, int fq) const {
    const int row0 = u.pm * 256 + wr * 64 + fr, col0 = u.pn * 256 + wc * 32 + 8 * fq;
#pragma unroll
    for (int ai = 0; ai < 2; ++ai)
#pragma unroll
      for (int m = 0; m < 4; ++m) {
        u16* rowp = O + (size_t)(row0 + ai * 128 + m * 16) * KP1 + col0;
#pragma unroll
        for (int bj = 0; bj < 2; ++bj) {
          const pg8::f32x4 v0 = acc[ai][bj][m][0], v1 = acc[ai][bj][m][1];
          u32x4 w; w.x = pk2(v0[0], v0[1]); w.y = pk2(v0[2], v0[3]); w.z = pk2(v1[0], v1[1]); w.w = pk2(v1[2], v1[3]);
          *(u32x4*)(rowp + bj * 128) = w;
        }
      }
  }
};
struct EpiFfnUp8 {
  static constexpr bool PERM = true, AFTER_DRAIN = false;
  u16* H;
  DI void operator()(const pg8::f32x4 (&acc)[2][2][4][2], const pg8::Unit& u, int wr, int wc, int fr, int fq) const {
    const int row0 = u.pm * 256 + wr * 64 + fr, col0 = u.pn * 128 + wc * 32 + 8 * fq;
#pragma unroll
    for (int ai = 0; ai < 2; ++ai)
#pragma unroll
      for (int m = 0; m < 4; ++m) {
        float o[8];
#pragma unroll
        for (int n = 0; n < 2; ++n)
#pragma unroll
          for (int j = 0; j < 4; ++j) {
            const float g = acc[ai][0][m][n][j], up = acc[ai][1][m][n][j];
            o[n * 4 + j] = g * __builtin_amdgcn_rcpf(1.f + __builtin_amdgcn_exp2f(-1.4426950408889634f * g)) * up;
          }
        u32x4 w; w.x = pk2(o[0], o[1]); w.y = pk2(o[2], o[3]); w.z = pk2(o[4], o[5]); w.w = pk2(o[6], o[7]);
        *(u32x4*)(H + (size_t)(row0 + ai * 128 + m * 16) * KP2 + col0) = w;
      }
  }
};
struct EpiGate8 {
  static constexpr bool PERM = true, AFTER_DRAIN = false;
  unsigned char* G8;
  DI void operator()(const pg8::f32x4 (&acc)[2][2][4][2], const pg8::Unit& u, int wr, int wc, int fr, int fq) const {
    const int row0 = u.pm * 256 + wr * 64 + fr, col0 = u.pn * 256 + wc * 32 + 8 * fq;
#pragma unroll
    for (int ai = 0; ai < 2; ++ai)
#pragma unroll
      for (int m = 0; m < 4; ++m)
#pragma unroll
        for (int bj = 0; bj < 2; ++bj) {
          uint2 pk = {0u, 0u};
#pragma unroll
          for (int j = 0; j < 4; ++j) {
            const float a = __builtin_amdgcn_rcpf(1.f + __builtin_amdgcn_exp2f(-1.4426950408889634f * acc[ai][bj][m][0][j]));
            const float b = __builtin_amdgcn_rcpf(1.f + __builtin_amdgcn_exp2f(-1.4426950408889634f * acc[ai][bj][m][1][j]));
            pk.x |= (unsigned)(a * 255.f + 0.5f) << (8 * j);
            pk.y |= (unsigned)(b * 255.f + 0.5f) << (8 * j);
          }
          *(uint2*)(G8 + (size_t)(row0 + ai * 128 + m * 16) * GP + col0 + bj * 128) = pk;
        }
  }
};
struct EpiProj8 {
  static constexpr bool PERM = false, AFTER_DRAIN = false;
  const Params* Pp; int layer;
  static DI void rope32q(float (&b)[8], const float2* __restrict__ tab, int fq) {
#pragma unroll
    for (int j = 0; j < 4; ++j) {
      const float2 cs = tab[4 * fq + j];
      const float x1 = b[j], x2 = b[4 + j];
      b[j] = x1 * cs.x - x2 * cs.y;
      b[4 + j] = x2 * cs.x + x1 * cs.y;
    }
  }
  static DI void st8(u16* __restrict__ base, int ld, int col0, const float (&b)[8], int tok, int fq) {
#pragma unroll
    for (int n = 0; n < 2; ++n) {
      uint2 pk; pk.x = pk2(b[4 * n], b[4 * n + 1]); pk.y = pk2(b[4 * n + 2], b[4 * n + 3]);
      *(uint2*)(base + (size_t)tok * ld + col0 + 16 * n + 4 * fq) = pk;
    }
  }
  static DI void stT8(u16* __restrict__ base, int row0, const float (&b)[8], int tok, int fq) {
    const int tp = (tok & ~12) | ((tok & 4) << 1) | ((tok & 8) >> 1);
#pragma unroll
    for (int n = 0; n < 2; ++n)
#pragma unroll
      for (int j = 0; j < 4; ++j) {
        const int row = row0 + 16 * n + 4 * fq + j;
        base[(size_t)(row >> 6) * 64 * T + (size_t)(tp >> 7) * 8192 + (row & 63) * 128 + (tp & 127)] = f2bf(b[4 * n + j]);
      }
  }
  DI void operator()(const pg8::f32x4 (&acc)[2][2][4][2], const pg8::Unit& u, int wr, int wc, int fr, int fq_in) const {
    const Params& P = *Pp;
    char* ws = P.ws;
    u16* qkv = (u16*)(ws + OFF_QKV);
    const float2* R64 = (const float2*)(ws + OFF_R64);
    const float2* R32 = (const float2*)(ws + OFF_R32);
    float* SS = (float*)(ws + OFF_SS);
    const int fbase = u.pn * 256 + wc * 64;
    if (fbase >= 2496) return;
#pragma unroll
    for (int ai = 0; ai < 2; ++ai)
#pragma unroll
      for (int m = 0; m < 4; ++m) {
        int fqv = fq_in; asm volatile("" : "+v"(fqv));
        const int fq = fqv;
        const int tok = u.pm * 256 + ai * 128 + wr * 64 + m * 16 + fr;
        const int pos = pos_of(tok);
        float b0[8], b1[8];
#pragma unroll
        for (int n = 0; n < 2; ++n)
#pragma unroll
          for (int j = 0; j < 4; ++j) { b0[4 * n + j] = acc[ai][0][m][n][j]; b1[4 * n + j] = acc[ai][1][m][n][j]; }
        if (fbase < 384) {
          const bool isK = fbase >= 256;
          const float* g = P.a_qk_norm + layer * 128 + (isK ? 64 : 0);
          float ss = 0.f;
#pragma unroll
          for (int k = 0; k < 8; ++k) ss += b0[k] * b0[k] + b1[k] * b1[k];
          ss += __shfl_xor(ss, 16);
          ss += __shfl_xor(ss, 32);
          const float rs = rsqrtf(ss * (1.f / 64.f) + EPS) * (isK ? 1.f : 0.125f * 1.4426950408889634f);
#pragma unroll
          for (int n = 0; n < 2; ++n)
#pragma unroll
            for (int j = 0; j < 4; ++j) {
              b0[4 * n + j] *= rs * g[16 * n + 4 * fq + j];
              b1[4 * n + j] *= rs * g[32 + 16 * n + 4 * fq + j];
            }
          rope32q(b0, R32 + (size_t)(pos >> 6) * 16, fq);
          rope32q(b1, R32 + (size_t)(pos & 63) * 16, fq);
          u16* dst = qkv + (isK ? Q_KA : Q_QA);
          const int ld = isK ? 128 : 256, c0 = isK ? fbase - 256 : fbase;
          st8(dst, ld, c0, b0, tok, fq);
          st8(dst, ld, c0 + 32, b1, tok, fq);
        } else if (fbase < 512) {
          stT8(qkv + Q_VTA, fbase - 384, b0, tok, fq);
          stT8(qkv + Q_VTA, fbase - 384 + 32, b1, tok, fq);
        } else if (fbase < 896) {
          const bool isK = fbase >= 768;
          const float2* tab = R64 + (size_t)pos * 32;
#pragma unroll
          for (int n = 0; n < 2; ++n)
#pragma unroll
            for (int j = 0; j < 4; ++j) {
              const float2 cs = tab[16 * n + 4 * fq + j];
              const float x1 = b0[4 * n + j], x2 = b1[4 * n + j];
              b0[4 * n + j] = x1 * cs.x - x2 * cs.y;
              b1[4 * n + j] = x2 * cs.x + x1 * cs.y;
            }
          u16* dst = qkv + (isK ? Q_KB : Q_QB);
          const int ld = isK ? 128 : 256, c0 = isK ? fbase - 768 : fbase - 512;
          st8(dst, ld, c0, b0, tok, fq);
          st8(dst, ld, c0 + 32, b1, tok, fq);
        } else if (fbase < 1024) {
          stT8(qkv + Q_VTB, fbase - 896, b0, tok, fq);
          stT8(qkv + Q_VTB, fbase - 896 + 32, b1, tok, fq);
        } else if (fbase < 1664) {
          const bool isKV = fbase >= 1408;
          u16* dst = qkv + (isKV ? Q_CKV : Q_CQ);
          const int ld = isKV ? 256 : 384, c0 = isKV ? fbase - 1408 : fbase - 1024;
          const int sb = (isKV ? 12 : 0) + (c0 >> 5);
          float s0 = 0.f, s1 = 0.f;
#pragma unroll
          for (int k = 0; k < 8; ++k) { s0 += b0[k] * b0[k]; s1 += b1[k] * b1[k]; }
          s0 += __shfl_xor(s0, 16); s0 += __shfl_xor(s0, 32);
          s1 += __shfl_xor(s1, 16); s1 += __shfl_xor(s1, 32);
          if (fq == 0) { SS[(size_t)tok * 20 + sb] = s0; SS[(size_t)tok * 20 + sb + 1] = s1; }
          st8(dst, ld, c0, b0, tok, fq);
          st8(dst, ld, c0 + 32, b1, tok, fq);
        } else if (fbase < 2176) {
          const bool isK = fbase >= 1920;
          u16* dst = qkv + (isK ? Q_KD : Q_QD);
          const int c0 = isK ? fbase - 1920 : fbase - 1664;
          rope32q(b0, R32 + (size_t)pos * 16, fq);
          rope32q(b1, R32 + (size_t)pos * 16, fq);
          st8(dst, 256, c0, b0, tok, fq);
          st8(dst, 256, c0 + 32, b1, tok, fq);
        } else if (fbase < 2432) {
          stT8(qkv + Q_VTD, fbase - 2176, b0, tok, fq);
          stT8(qkv + Q_VTD, fbase - 2176 + 32, b1, tok, fq);
        } else {
          rope32q(b0, R32 + (size_t)pos * 16, fq);
#pragma unroll
          for (int hd = 0; hd < 4; ++hd) st8(qkv + Q_KC, 384, hd * 96 + 64, b0, tok, fq);
        }
        __builtin_amdgcn_sched_barrier(0);
      }
  }
};
struct SimpleOrder {
  int nN, nwg, G, c;
  DI bool next(int i, pg8::Unit& u) const {
    const int L = i * G + c;
    if (L >= nwg) return false;
    const int rest = L >> 4;
    u.pn = rest % nN;
    u.pm = (rest / nN) * 16 + (L & 15);
    return true;
  }
  DI void a_ready(const pg8::Unit&) const {}
  DI void done(const pg8::Unit&) const {}
};
template <int N, int K, int LD, class Epi>
DI void gemm8_phase(const u16* X, const u16* Wt, const Epi& E, char* smem) {
  pg8::Gemm g; g.A = X; g.Bt = Wt; g.M = T; g.N = N; g.K = K; g.ld = LD;
  int bid_ = (int)blockIdx.x; asm volatile("" : "+s"(bid_));
  SimpleOrder S; S.nN = N / 256; S.nwg = (T / 256) * (N / 256); S.G = (int)gridDim.x; S.c = bid_;
  pg8::gemm_phase<Epi, SimpleOrder, false, K, LD>((PG8_LAS unsigned char*)smem, g, S, E, nullptr);
}

template <int DQK, int NCOMP, bool BAND, int EPI, bool NOMAX = false>
DI void attn_item(const u16* __restrict__ Q, int ldq, const u16* __restrict__ Kp, int ldk, const u16* __restrict__ Vt,
                  int qtok0, int kbeg, int kend, float sc_l2, float sink_l2, float lam, float onorm,
                  const float* __restrict__ subg, u16* __restrict__ O, float* __restrict__ DS, char* smem) {
  constexpr int DC = DQK / NCOMP;
  constexpr int KS = DC / 16;
  constexpr int KEYS = (NCOMP == 1) ? 128 : 64;
  constexpr int KSTR = DQK + 8, VSTR = KEYS + 8;
  constexpr int KCH = DQK / 8, VCH = KEYS / 8;
  constexpr int NKC = KEYS * KCH / NTHR, NVC = 64 * VCH / NTHR;
  constexpr int KSLOT = KEYS * KSTR, VSLOT = 64 * VSTR;
  u16* sK = (u16*)smem;
  u16* sV = sK + 3 * KSLOT;
  const int tid = opaque_tid(), lane = tid & 63, wave = tid >> 6, r = lane & 31, h = lane >> 5;
  const int qtok = qtok0 + wave * 32 + r;

  bf16x8 qf[NCOMP][KS];
#pragma unroll
  for (int c = 0; c < NCOMP; ++c)
#pragma unroll
    for (int ks = 0; ks < KS; ++ks) qf[c][ks] = *(const bf16x8*)(Q + (size_t)qtok * ldq + c * DC + ks * 16 + 8 * h);

  f32x16 Oa[NCOMP][2];
  float m[NCOMP], l[NCOMP];
#pragma unroll
  for (int c = 0; c < NCOMP; ++c) {
#pragma unroll
    for (int d = 0; d < 2; ++d)
#pragma unroll
      for (int v = 0; v < 16; ++v) Oa[c][d][v] = 0.f;
    m[c] = BAND ? sink_l2 : -1e30f;
    l[c] = (BAND && h == 0) ? 1.f : 0.f;
  }

  const u16* kg[NKC]; int kso[NKC];
#pragma unroll
  for (int i = 0; i < NKC; ++i) {
    const int c = tid + i * NTHR;
    const int row = c / KCH, cc = c % KCH;
    kg[i] = Kp + (size_t)(kbeg + row) * ldk + cc * 8;
    kso[i] = row * KSTR + cc * 8;
  }
  const u16* vg[NVC]; int vso[NVC];
#pragma unroll
  for (int i = 0; i < NVC; ++i) {
    const int c = tid + i * NTHR;
    const int row = c / VCH, cc = c % VCH;
    vg[i] = Vt + (size_t)(kbeg >> 7) * 8192 + row * 128 + cc * 8;
    vso[i] = row * VSTR + cc * 8;
  }
  u32x4 kreg[NKC], vreg[NVC];
  auto loadK = [&](int t) {
#pragma unroll
    for (int i = 0; i < NKC; ++i) kreg[i] = gld16(kg[i] + (size_t)t * KEYS * ldk);
  };
  auto loadV = [&](int t) {
#pragma unroll
    for (int i = 0; i < NVC; ++i) vreg[i] = gld16(vg[i] + (size_t)t * 8192);
  };
  auto waitK = [&]() {
    if constexpr (NKC == 1) wait_vm0(kreg[0]);
    else if constexpr (NKC == 2) wait_vm0(kreg[0], kreg[1]);
    else wait_vm0(kreg[0], kreg[1], kreg[2]);
  };
  auto waitV = [&]() {
    if constexpr (NVC == 1) wait_vm0(vreg[0]);
    else wait_vm0(vreg[0], vreg[1]);
  };
  auto storeK = [&](int slot) {
#pragma unroll
    for (int i = 0; i < NKC; ++i) *(u32x4*)(sK + slot * KSLOT + kso[i]) = kreg[i];
  };
  auto storeV = [&](int slot) {
#pragma unroll
    for (int i = 0; i < NVC; ++i) *(u32x4*)(sV + slot * VSLOT + vso[i]) = vreg[i];
  };

  f32x16 S0[2], S1[2];
  bf16x8 pfA[2][2], pfB[2][2];
  float alpha_pend = 1.f;
  bool need_pend = false;

  auto att_S = [&](auto uu_t, f32x16 (&S)[2], int slot) {
    constexpr int UU = decltype(uu_t)::value;
    constexpr int C = (NCOMP == 2) ? UU : 0;
    const u16* base = sK + slot * KSLOT + ((NCOMP == 1 ? UU * 64 : 0) + r) * KSTR + (NCOMP == 2 ? UU * DC : 0) + 8 * h;
#pragma unroll
    for (int kb = 0; kb < 2; ++kb) {
#pragma unroll
      for (int v = 0; v < 16; ++v) S[kb][v] = 0.f;
#pragma unroll
      for (int ks = 0; ks < KS; ++ks) {
        bf16x8 kf = *(const bf16x8*)(base + kb * 32 * KSTR + ks * 16);
        S[kb] = MFMA32(kf, qf[C][ks], S[kb]);
      }
    }
  };
  auto att_PV = [&](auto uu_t, const bf16x8 (&pf)[2][2], int slot) {
    constexpr int UU = decltype(uu_t)::value;
    constexpr int C = (NCOMP == 2) ? UU : 0;
    const u16* base = sV + slot * VSLOT + r * VSTR + (NCOMP == 1 ? UU * 64 : 0) + 8 * h;
#pragma unroll
    for (int d = 0; d < 2; ++d)
#pragma unroll
      for (int kb = 0; kb < 2; ++kb)
#pragma unroll
        for (int s = 0; s < 2; ++s) {
          bf16x8 vf = *(const bf16x8*)(base + d * 32 * VSTR + kb * 32 + 16 * s);
          Oa[C][d] = MFMA32(vf, pf[kb][s], Oa[C][d]);
        }
  };
  auto att_rescale = [&](auto uu_t) {
    constexpr int UU = decltype(uu_t)::value;
    constexpr int C = (NCOMP == 2) ? UU : 0;
    if (need_pend) {
#pragma unroll
      for (int d = 0; d < 2; ++d)
#pragma unroll
        for (int v = 0; v < 16; ++v) Oa[C][d][v] *= alpha_pend;
    }
  };
  auto att_softmax = [&](auto uu_t, f32x16 (&S)[2], bf16x8 (&pf)[2][2], int kpos0) {
    constexpr int UU = decltype(uu_t)::value;
    constexpr int C = (NCOMP == 2) ? UU : 0;
    if constexpr (BAND) {
#pragma unroll
      for (int kb = 0; kb < 2; ++kb)
#pragma unroll
        for (int v = 0; v < 16; ++v) {
          const int d = kpos0 + kb * 32 + crow(v, h) - qtok;
          if (d > 128 || d < -128) S[kb][v] = -1e30f;
        }
    }
    if constexpr (NOMAX) {
      float rsum = 0.f;
#pragma unroll
      for (int kb = 0; kb < 2; ++kb)
#pragma unroll
        for (int v = 0; v < 16; ++v) {
          float p = __builtin_amdgcn_exp2f(S[kb][v]);
          S[kb][v] = p;
          rsum += p;
        }
      l[C] += rsum;
      need_pend = false;
#pragma unroll
      for (int kb = 0; kb < 2; ++kb)
#pragma unroll
        for (int s = 0; s < 2; ++s) {
          u32x4 pk;
          pk.x = pk2(S[kb][8 * s + 0], S[kb][8 * s + 1]);
          pk.y = pk2(S[kb][8 * s + 2], S[kb][8 * s + 3]);
          pk.z = pk2(S[kb][8 * s + 4], S[kb][8 * s + 5]);
          pk.w = pk2(S[kb][8 * s + 6], S[kb][8 * s + 7]);
          pf[kb][s] = __builtin_bit_cast(bf16x8, pk);
        }
      return;
    }
    float mx = S[0][0];
#pragma unroll
    for (int kb = 0; kb < 2; ++kb)
#pragma unroll
      for (int v = 0; v < 16; ++v) mx = fmaxf(mx, S[kb][v]);
    {
      const unsigned mu = __float_as_uint(mx);
      const auto sw = __builtin_amdgcn_permlane32_swap(mu, mu, false, false);
      mx = fmaxf(__uint_as_float(sw[0]), __uint_as_float(sw[1]));
    }
    const float mold = m[C];
    const float mcand = fmaxf(mold, mx * sc_l2);
    const bool grow = __builtin_amdgcn_ballot_w64(mcand > mold + 6.0f) != 0;
    const float mnew = grow ? mcand : mold;
    need_pend = grow;
    alpha_pend = __builtin_amdgcn_exp2f(mold - mnew);
    m[C] = mnew;
    float rsum = 0.f;
#pragma unroll
    for (int kb = 0; kb < 2; ++kb)
#pragma unroll
      for (int v = 0; v < 16; ++v) {
        float p = __builtin_amdgcn_exp2f(__builtin_fmaf(S[kb][v], sc_l2, -mnew));
        S[kb][v] = p;
        rsum += p;
      }
    l[C] = l[C] * alpha_pend + rsum;
#pragma unroll
    for (int kb = 0; kb < 2; ++kb)
#pragma unroll
      for (int s = 0; s < 2; ++s) {
        u32x4 pk;
        pk.x = pk2(S[kb][8 * s + 0], S[kb][8 * s + 1]);
        pk.y = pk2(S[kb][8 * s + 2], S[kb][8 * s + 3]);
        pk.z = pk2(S[kb][8 * s + 4], S[kb][8 * s + 5]);
        pk.w = pk2(S[kb][8 * s + 6], S[kb][8 * s + 7]);
        pf[kb][s] = __builtin_bit_cast(bf16x8, pk);
      }
  };
  using U0 = std::integral_constant<int, 0>;
  using U1 = std::integral_constant<int, 1>;

  const int ntl = (kend - kbeg) / KEYS;
  auto step = [&](auto first_t, auto lk_t, auto lv_t, int t, int sa, int sb, int sc) {
    constexpr bool FIRST = decltype(first_t)::value, LK = decltype(lk_t)::value, LV = decltype(lv_t)::value;
    if constexpr (LK) loadK(t + 2);
    if constexpr (LV) loadV(t + 1);
    if constexpr (!FIRST) att_rescale(U1{});
    att_S(U1{}, S1, sa);
    if constexpr (!FIRST) att_PV(U1{}, pfB, sc);
    att_softmax(U0{}, S0, pfA, kbeg + t * KEYS);
    att_rescale(U0{});
    if constexpr (LV) att_S(U0{}, S0, sb);
    att_PV(U0{}, pfA, sa);
    att_softmax(U1{}, S1, pfB, kbeg + t * KEYS + 64);
    if constexpr (LK) { waitK(); storeK(sc); }
    if constexpr (LV) { waitV(); storeV(sb); }
    __syncthreads();
  };
  using TT = std::true_type;
  using FF = std::false_type;

  loadK(0); loadV(0);
  waitK(); waitV();
  storeK(0); storeV(0);
  loadK(1);
  waitK();
  storeK(1);
  __syncthreads();
  att_S(U0{}, S0, 0);
  int sa = 0, sb = 1, sc = 2;
  step(TT{}, TT{}, TT{}, 0, sa, sb, sc);
  { int tmp = sa; sa = sb; sb = sc; sc = tmp; }
  for (int t = 1; t < ntl - 2; ++t) {
    step(FF{}, TT{}, TT{}, t, sa, sb, sc);
    int tmp = sa; sa = sb; sb = sc; sc = tmp;
  }
  step(FF{}, FF{}, TT{}, ntl - 2, sa, sb, sc);
  { int tmp = sa; sa = sb; sb = sc; sc = tmp; }
  step(FF{}, FF{}, FF{}, ntl - 1, sa, sb, sc);
  att_rescale(U1{});
  att_PV(U1{}, pfB, sa);

  float inv[NCOMP];
#pragma unroll
  for (int c = 0; c < NCOMP; ++c) {
    float lt = l[c] + __shfl_xor(l[c], 32);
    inv[c] = 1.f / lt;
  }
  if constexpr (EPI == 1) {
#pragma unroll
    for (int d = 0; d < 2; ++d)
#pragma unroll
      for (int vq = 0; vq < 4; ++vq) {
        float4 o = {Oa[0][d][4 * vq] * inv[0], Oa[0][d][4 * vq + 1] * inv[0], Oa[0][d][4 * vq + 2] * inv[0], Oa[0][d][4 * vq + 3] * inv[0]};
        *(float4*)(DS + (size_t)qtok * 256 + d * 32 + 8 * vq + 4 * h) = o;
      }
  } else {
    if constexpr (EPI == 2) {
      float ss = 0.f;
#pragma unroll
      for (int d = 0; d < 2; ++d)
#pragma unroll
        for (int vq = 0; vq < 4; ++vq) {
          const float4 o1 = *(const float4*)(DS + (size_t)qtok * 256 + d * 32 + 8 * vq + 4 * h);
          const float a0 = o1.x - lam * Oa[0][d][4 * vq] * inv[0];
          const float a1 = o1.y - lam * Oa[0][d][4 * vq + 1] * inv[0];
          const float a2 = o1.z - lam * Oa[0][d][4 * vq + 2] * inv[0];
          const float a3 = o1.w - lam * Oa[0][d][4 * vq + 3] * inv[0];
          Oa[0][d][4 * vq] = a0; Oa[0][d][4 * vq + 1] = a1; Oa[0][d][4 * vq + 2] = a2; Oa[0][d][4 * vq + 3] = a3;
          ss += a0 * a0 + a1 * a1 + a2 * a2 + a3 * a3;
        }
      ss += __shfl_xor(ss, 32);
      const float rs = rsqrtf(ss * (1.f / 64.f) + EPS) * onorm;
#pragma unroll
      for (int d = 0; d < 2; ++d)
#pragma unroll
        for (int v = 0; v < 16; ++v) Oa[0][d][v] *= rs * subg[d * 32 + crow(v, h)];
    } else {
#pragma unroll
      for (int d = 0; d < 2; ++d)
#pragma unroll
        for (int v = 0; v < 16; ++v) Oa[0][d][v] *= inv[0];
    }
    store_rows(O, KP1, 0, Oa[0][0], qtok, h);
    store_rows(O, KP1, 32, Oa[0][1], qtok, h);
  }
  __syncthreads();
}

DI void attn_phase(const Params& P, int layer, char* smem) {
  char* ws = P.ws;
  u16* qkv = (u16*)(ws + OFF_QKV);
  u16* BR = (u16*)(ws + OFF_XN);
  const float L2E = 1.4426950408889634f;
  const float lambda_init = 0.8f - 0.6f * __expf(-0.3f * (float)layer);
  float lam;
  {
    const float* dl = P.d_lambda + layer * 128;
    float s1 = 0.f, s2 = 0.f;
    for (int i = 0; i < 32; ++i) { s1 += dl[i] * dl[32 + i]; s2 += dl[64 + i] * dl[96 + i]; }
    lam = __expf(s1) - __expf(s2) + lambda_init;
    lam = __int_as_float(__builtin_amdgcn_readfirstlane(__float_as_int(lam)));
  }
  const float onorm_u = __int_as_float(__builtin_amdgcn_readfirstlane(__float_as_int(1.f - lambda_init)));
  bool a_nomax;
  {
    const float* ag = P.a_qk_norm + layer * 128;
    float gq = 0.f, gk = 0.f;
    for (int i = 0; i < 64; ++i) { gq = fmaxf(gq, fabsf(ag[i])); gk = fmaxf(gk, fabsf(ag[64 + i])); }
    const float bound = 64.f * gq * gk * (0.125f * L2E);
    a_nomax = __builtin_amdgcn_readfirstlane((int)(bound < 60.f)) != 0;
  }
  for (int it = blockIdx.x; it < 2048; it += gridDim.x) {
    const int cls = it >> 8;
    if (cls < 6) {
      const int idx = it & 255;
      const int head = (idx & 7) >> 1;
      const int qb = ((idx >> 3) << 1) + (idx & 1);
      int qtok0, kbeg, kend;
      if (cls < 3) { qtok0 = qb * 256; kbeg = 0; kend = SEQ0; }
      else { const int s = qb >> 3; kbeg = SEQ0 + s * DSEQ; kend = kbeg + DSEQ; qtok0 = kbeg + (qb & 7) * 256; }
      const int typ = cls % 3;
      if (typ == 0) {
        float* DS = (float*)(ws + OFF_DS) + head * 64;
        attn_item<32, 1, false, 1>(qkv + Q_QD + head * 64, 256, qkv + Q_KD + head * 64, 256,
                                   qkv + Q_VTD + (size_t)head * 64 * T, qtok0, kbeg, kend,
                                   0.17677669529663687f * L2E, 0.f, lam, onorm_u,
                                   P.d_subln + layer * 64, BR + 768 + head * 64, DS, smem);
        attn_item<32, 1, false, 2>(qkv + Q_QD + head * 64 + 32, 256, qkv + Q_KD + head * 64 + 32, 256,
                                   qkv + Q_VTD + (size_t)head * 64 * T, qtok0, kbeg, kend,
                                   0.17677669529663687f * L2E, 0.f, lam, onorm_u,
                                   P.d_subln + layer * 64, BR + 768 + head * 64, DS, smem);
      } else if (typ == 1) {
        attn_item<96, 1, false, 0>(qkv + Q_QC + head * 96, 384, qkv + Q_KC + head * 96, 384,
                                       qkv + Q_VTC + (size_t)head * 64 * T, qtok0, kbeg, kend,
                                       0.10206207261596577f * L2E, 0.f, 0.f, 1.f, nullptr, BR + 512 + head * 64, nullptr, smem);
      } else {
        if (a_nomax)
          attn_item<64, 1, false, 0, true>(qkv + Q_QA + head * 64, 256, qkv + Q_KA + (head >> 1) * 64, 128,
                                           qkv + Q_VTA + (size_t)(head >> 1) * 64 * T, qtok0, kbeg, kend,
                                           1.f, 0.f, 0.f, 1.f, nullptr, BR + head * 64, nullptr, smem);
        else
          attn_item<64, 1, false, 0, false>(qkv + Q_QA + head * 64, 256, qkv + Q_KA + (head >> 1) * 64, 128,
                                            qkv + Q_VTA + (size_t)(head >> 1) * 64 * T, qtok0, kbeg, kend,
                                            1.f, 0.f, 0.f, 1.f, nullptr, BR + head * 64, nullptr, smem);
      }
    } else {
      const int idx = it - 1536;
      const int head = (idx & 7) >> 1;
      const int qbg = ((idx >> 3) << 1) + (idx & 1);
      const int qtok0 = qbg * 256;
      int sb, se;
      if (qtok0 < SEQ0) { sb = 0; se = SEQ0; }
      else { sb = SEQ0 + ((qtok0 - SEQ0) / DSEQ) * DSEQ; se = sb + DSEQ; }
      const int kbeg = max(sb, qtok0 - 128), kend = min(se, qtok0 + 256 + 128);
      const float sink = P.b_sink[layer * 4 + head];
      attn_item<64, 1, true, 0>(qkv + Q_QB + head * 64, 256, qkv + Q_KB + (head >> 1) * 64, 128,
                                    qkv + Q_VTB + (size_t)(head >> 1) * 64 * T, qtok0, kbeg, kend,
                                    0.125f * L2E, sink * L2E, 0.f, 1.f, nullptr, BR + 256 + head * 64, nullptr, smem);
    }
  }
}

DI void ew_phase(const Params& P, const u16* __restrict__ Y, float coef, const float* __restrict__ gpost,
                 const float* __restrict__ gnext, bool from_inputs) {
  const int tid = opaque_tid();
  const int lane = tid & 63, wave = tid >> 6;
  u16* XN = (u16*)(P.ws + OFF_XN);
  u16* XB = (u16*)(P.ws + OFF_XB);
  for (int tok = blockIdx.x * 8 + wave; tok < T; tok += gridDim.x * 8) {
    float4 x[4];
    if (from_inputs) {
      const float* xs = tok < SEQ0 ? P.x_prompt + (size_t)tok * DM : P.x_sample + (size_t)(tok - SEQ0) * DM;
#pragma unroll
      for (int i = 0; i < 4; ++i) x[i] = *(const float4*)(xs + (i * 64 + lane) * 4);
    } else {
#pragma unroll
      for (int i = 0; i < 4; ++i) {
        const uint2 xb = *(const uint2*)(XB + (size_t)tok * DM + (i * 64 + lane) * 4);
        x[i] = make_float4(bf2f(xb.x & 0xffffu), bf2f(xb.x >> 16), bf2f(xb.y & 0xffffu), bf2f(xb.y >> 16));
      }
    }
    if (Y) {
      float4 y[4];
      float ss = 0.f;
#pragma unroll
      for (int i = 0; i < 4; ++i) {
        const uint2 yb = *(const uint2*)(Y + (size_t)tok * KP1 + (i * 64 + lane) * 4);
        y[i] = make_float4(bf2f(yb.x & 0xffffu), bf2f(yb.x >> 16), bf2f(yb.y & 0xffffu), bf2f(yb.y >> 16));
        ss += y[i].x * y[i].x + y[i].y * y[i].y + y[i].z * y[i].z + y[i].w * y[i].w;
      }
      ss = wave_sum(ss);
      const float rs = rsqrtf(ss * (1.f / 1024.f) + EPS) * coef;
#pragma unroll
      for (int i = 0; i < 4; ++i) {
        float4 g = *(const float4*)(gpost + (i * 64 + lane) * 4);
        x[i].x += y[i].x * rs * g.x; x[i].y += y[i].y * rs * g.y;
        x[i].z += y[i].z * rs * g.z; x[i].w += y[i].w * rs * g.w;
      }
    }
    if (!gnext) {
#pragma unroll
      for (int i = 0; i < 4; ++i) *(float4*)(P.out + (size_t)tok * DM + (i * 64 + lane) * 4) = x[i];
    } else {
#pragma unroll
      for (int i = 0; i < 4; ++i) {
        uint2 pk;
        pk.x = pk2(x[i].x, x[i].y);
        pk.y = pk2(x[i].z, x[i].w);
        *(uint2*)(XB + (size_t)tok * DM + (i * 64 + lane) * 4) = pk;
      }
    }
    if (gnext) {
      float ss = 0.f;
#pragma unroll
      for (int i = 0; i < 4; ++i) ss += x[i].x * x[i].x + x[i].y * x[i].y + x[i].z * x[i].z + x[i].w * x[i].w;
      ss = wave_sum(ss);
      const float rs = rsqrtf(ss * (1.f / 1024.f) + EPS);
#pragma unroll
      for (int i = 0; i < 4; ++i) {
        float4 g = *(const float4*)(gnext + (i * 64 + lane) * 4);
        uint2 pk;
        pk.x = pk2(x[i].x * rs * g.x, x[i].y * rs * g.y);
        pk.y = pk2(x[i].z * rs * g.z, x[i].w * rs * g.w);
        *(uint2*)(XN + (size_t)tok * KP1 + (i * 64 + lane) * 4) = pk;
      }
    }
  }
}

DI int colmap(int mode, int n, int nsrc) {
  if (mode == 1) { return ((n >> 7) & 1) * DFF + (n >> 8) * 128 + (n & 127); }
  if (mode == 2) {
    if (n < 2560) {
      const int w = n & 255;
      n = (n & ~255) + ((w >> 5) & 3) * 64 + (w >> 7) * 32 + (w & 31);
    }
    if (n < 1664) return n;
    if (n < 2432) return n + 32;
    if (n < 2464) return n - 2432 + 1664;
    if (n < 2560) return -1;
    return n - 96;
  }
  return n < nsrc ? n : -1;
}
DI void conv_job(u16* __restrict__ dst, int ldd, const float* __restrict__ src, int Nd, int K, int lds, int mode,
                 const float* __restrict__ kscale) {
  const int total = Nd * (K >> 3);
  const int gthreads = gridDim.x * NTHR;
  for (int idx = blockIdx.x * NTHR + opaque_tid(); idx < total; idx += gthreads) {
    const int n = idx % Nd, k8 = idx / Nd;
    const int col = colmap(mode, n, lds);
    float v[8];
#pragma unroll
    for (int j = 0; j < 8; ++j) {
      float x = 0.f;
      if (col >= 0) {
        x = src[(size_t)(k8 * 8 + j) * lds + col];
        if (kscale) x *= kscale[k8 * 8 + j];
      }
      v[j] = x;
    }
    uint4 pk = {pk2(v[0], v[1]), pk2(v[2], v[3]), pk2(v[4], v[5]), pk2(v[6], v[7])};
    *(uint4*)(dst + (size_t)n * ldd + k8 * 8) = pk;
  }
}
DI void convert_layer(const Params& P, int l) {
  u16* W = (u16*)(P.ws + OFF_W);
  for (int s = 0; s < 2; ++s) {
    conv_job(W + W_WI + (size_t)s * 5632 * KP1, KP1, P.ffn_wi + ((size_t)l * 2 + s) * 1024 * 5632, 5632, 1024, 5632, 1, nullptr);
    conv_job(W + W_WO + (size_t)s * 1024 * KP2, KP2, P.ffn_wo + ((size_t)l * 2 + s) * 2816 * 1024, 1024, 2816, 1024, 0, nullptr);
  }
  conv_job(W + W_WIN, KP1, P.w_in + (size_t)l * 1024 * NPROJ, 6656, 1024, NPROJ, 2, nullptr);
  conv_job(W + W_WUQ, 384, P.c_w_uq + (size_t)l * 384 * 384, 512, 384, 384, 0, P.c_q_norm + l * 384);
  conv_job(W + W_WUKV, 256, P.c_w_ukv + (size_t)l * 256 * 512, 512, 256, 512, 0, P.c_kv_norm + l * 256);
  conv_job(W + W_WB, KP1, P.w_branch + (size_t)l * 1024 * 1024, 1024, 1024, 1024, 0, nullptr);
  conv_job(W + W_WOUT, KP1, P.w_out + (size_t)l * 1024 * 1024, 1024, 1024, 1024, 0, nullptr);
}
DI void rope_tables(const Params& P) {
  float2* R64 = (float2*)(P.ws + OFF_R64);
  float2* R32 = (float2*)(P.ws + OFF_R32);
  const int gthreads = gridDim.x * NTHR;
  for (int idx = blockIdx.x * NTHR + opaque_tid(); idx < 16384 * 48; idx += gthreads) {
    int pos, f; double base; float2* dst;
    if (idx < 16384 * 32) { pos = idx >> 5; f = idx & 31; base = 0.7498942093324559; dst = R64 + idx; }
    else { const int i2 = idx - 16384 * 32; pos = i2 >> 4; f = i2 & 15; base = 0.5623413251903491; dst = R32 + i2; }
    double inv = 1.0;
    for (int k = 0; k < f; ++k) inv *= base;
    const float ang = (float)pos * (float)inv;
    double tr = (double)ang * 0.15915494309189535;
    tr -= rint(tr);
    const float tf = (float)tr;
    *dst = make_float2(__builtin_amdgcn_cosf(tf), __builtin_amdgcn_sinf(tf));
  }
}

DI void fast_grid_barrier(unsigned* bar, unsigned nblk) {
  asm volatile("s_waitcnt vmcnt(0) lgkmcnt(0)" ::: "memory");
  __syncthreads();
  if (threadIdx.x == 0) {
    __builtin_amdgcn_fence(__ATOMIC_RELEASE, "agent");
    asm volatile("s_waitcnt vmcnt(0) lgkmcnt(0)" ::: "memory");
    const unsigned gen = __hip_atomic_load(&bar[64], __ATOMIC_RELAXED, __HIP_MEMORY_SCOPE_AGENT);
    const unsigned old = __hip_atomic_fetch_add(&bar[0], 1u, __ATOMIC_RELAXED, __HIP_MEMORY_SCOPE_AGENT);
    if (old == nblk - 1u) {
      __hip_atomic_store(&bar[0], 0u, __ATOMIC_RELAXED, __HIP_MEMORY_SCOPE_AGENT);
      __hip_atomic_fetch_add(&bar[64], 1u, __ATOMIC_RELEASE, __HIP_MEMORY_SCOPE_AGENT);
    } else {
      while (__hip_atomic_load(&bar[64], __ATOMIC_RELAXED, __HIP_MEMORY_SCOPE_AGENT) == gen) __builtin_amdgcn_s_sleep(1);
    }
    __builtin_amdgcn_fence(__ATOMIC_ACQUIRE, "agent");
    asm volatile("s_waitcnt vmcnt(0) lgkmcnt(0)" ::: "memory");
  }
  __syncthreads();
}

__global__ void __launch_bounds__(NTHR) __attribute__((amdgpu_waves_per_eu(2, 2))) mega(Params P) {
  extern __shared__ __attribute__((aligned(16))) char smem[];
  cg::grid_group grid = cg::this_grid();
  int phase = 0;
#if MULTI_LAUNCH
#define ACTIVE() (phase >= P.phase_lo && phase < P.phase_hi)
#define SEAM() do { ++phase; } while (0)
#else
#define ACTIVE() (true)
#define SEAM() do { ++phase; if (phase == 1) grid.sync(); else fast_grid_barrier((unsigned*)(P.ws + OFF_BAR), gridDim.x); } while (0)
#endif
  u16* W = (u16*)(P.ws + OFF_W);
  u16* XN = (u16*)(P.ws + OFF_XN);
  u16* R2 = (u16*)(P.ws + OFF_R2);
  u16* qkv = (u16*)(P.ws + OFF_QKV);
  const u16* Y = qkv + Q_Y;
#define PTRS

  if (ACTIVE()) { PTRS
    rope_tables(P);
    convert_layer(P, 0);
    ew_phase(P, nullptr, 0.f, nullptr, P.norm_g, true);
  }
  SEAM();
  for (int l = 0; l < 4; ++l) {
    const float* g = P.norm_g + (size_t)l * 6 * DM;
    if (ACTIVE()) { PTRS gemm8_phase<5632, DM, KP1>(XN, W + W_WI, EpiFfnUp8{R2}, smem); }
    SEAM();
    if (ACTIVE()) { PTRS gemm8_phase<1024, DFF, KP2>(R2, W + W_WO, EpiY8{qkv + Q_Y}, smem); }
    SEAM();
    if (ACTIVE()) { PTRS ew_phase(P, Y, 0.5f, g + DM, g + 2 * DM, false); }
    SEAM();
    if (ACTIVE()) { PTRS
      gemm8_phase<2560, DM, KP1>(XN, W + W_WIN, EpiProj8{&P, l}, smem);
      gemm8_phase<4096, DM, KP1>(XN, W + W_WIN + 2560ull * KP1, EpiGate8{(unsigned char*)R2}, smem);
    }
    SEAM();
    if (ACTIVE()) { PTRS
      gemm_phase<M_CUQ, 4>(W + W_WUQ, 384, qkv + Q_CQ, 384, 384, 2, smem, P, l);
      gemm_phase<M_CUKV, 4>(W + W_WUKV, 256, qkv + Q_CKV, 256, 256, 2, smem, P, l);
    }
    SEAM();
    if (ACTIVE()) { PTRS attn_phase(P, l, smem); }
    SEAM();
    if (ACTIVE()) { PTRS gemm_phase<M_MERGE, 2>(W + W_WB, KP1, XN, KP1, DM, 4, smem, P, l); }
    SEAM();
    if (ACTIVE()) { PTRS gemm8_phase<1024, DM, KP1>(qkv + Q_MERGED, W + W_WOUT, EpiY8{qkv + Q_Y}, smem); }
    SEAM();
    if (ACTIVE()) { PTRS ew_phase(P, Y, 1.0f, g + 3 * DM, g + 4 * DM, false); }
    SEAM();
    if (ACTIVE()) { PTRS gemm8_phase<5632, DM, KP1>(XN, W + W_WI + 5632ull * KP1, EpiFfnUp8{R2}, smem); }
    SEAM();
    if (ACTIVE()) { PTRS gemm8_phase<1024, DFF, KP2>(R2, W + W_WO + 1024ull * KP2, EpiY8{qkv + Q_Y}, smem); }
    SEAM();
    if (ACTIVE()) { PTRS
      ew_phase(P, Y, 0.5f, g + 5 * DM, l < 3 ? g + 6 * DM : nullptr, false);
      if (l < 3) convert_layer(P, l + 1);
    }
    SEAM();
  }
}

constexpr int N_PHASES = 1 + 12 * 4;

extern "C" void kernel_launch(void* const* d_in, const int* in_sizes, int n_in, void* d_out, int out_size, void* d_ws,
                              size_t ws_size, hipStream_t stream) {
  static int grid_blocks = 0;
  if (!grid_blocks) {
    int dev = 0, cus = 0, per_cu = 0;
    hipGetDevice(&dev);
    hipDeviceGetAttribute(&cus, hipDeviceAttributeMultiprocessorCount, dev);
    hipFuncSetAttribute((const void*)mega, hipFuncAttributeMaxDynamicSharedMemorySize, SMEM_BYTES);
    hipOccupancyMaxActiveBlocksPerMultiprocessor(&per_cu, mega, NTHR, SMEM_BYTES);
    if (per_cu < 1) per_cu = 1;
    grid_blocks = cus * per_cu;
  }
  if (ws_size < WS_NEEDED) fprintf(stderr, "workspace too small: %zu < %zu\n", ws_size, (size_t)WS_NEEDED);
  Params P{};
  P.x_prompt = (const float*)d_in[0]; P.x_sample = (const float*)d_in[1]; P.norm_g = (const float*)d_in[2];
  P.w_in = (const float*)d_in[3]; P.a_qk_norm = (const float*)d_in[4]; P.b_sink = (const float*)d_in[5];
  P.c_q_norm = (const float*)d_in[6]; P.c_kv_norm = (const float*)d_in[7]; P.c_w_uq = (const float*)d_in[8];
  P.c_w_ukv = (const float*)d_in[9]; P.d_lambda = (const float*)d_in[10]; P.d_subln = (const float*)d_in[11];
  P.w_branch = (const float*)d_in[12]; P.w_out = (const float*)d_in[13]; P.ffn_wi = (const float*)d_in[14];
  P.ffn_wo = (const float*)d_in[15];
  P.out = (float*)d_out; P.ws = (char*)d_ws;
#if MULTI_LAUNCH
  for (int ph = 0; ph < N_PHASES; ++ph) {
    P.phase_lo = ph; P.phase_hi = ph + 1; P.coop = 0; P.pad0 = 0;
    hipLaunchKernelGGL(mega, dim3(grid_blocks), dim3(NTHR), SMEM_BYTES, stream, P);
  }
#else
  P.phase_lo = 0; P.phase_hi = 1 << 30; P.coop = 1; P.pad0 = 0;
  hipMemsetAsync((char*)d_ws + OFF_BAR, 0, 1024, stream);
  void* args[] = {&P};
  hipError_t e = hipLaunchCooperativeKernel((const void*)mega, dim3(grid_blocks), dim3(NTHR), args, SMEM_BYTES, stream);
  if (e != hipSuccess) fprintf(stderr, "cooperative launch failed: %s (grid %d)\n", hipGetErrorString(e), grid_blocks);
#endif
}
```

```cpp
#include <hip/hip_runtime.h>
#include <hip/hip_cooperative_groups.h>
#include <cstdio>
#include <cstdint>
#include <type_traits>
namespace cg = cooperative_groups;

#ifndef MULTI_LAUNCH
#define MULTI_LAUNCH 0
#endif

#define DI __device__ __forceinline__
typedef unsigned short u16;
typedef __attribute__((ext_vector_type(8))) short bf16x8;
typedef __attribute__((ext_vector_type(16))) float f32x16;
typedef __attribute__((ext_vector_type(2))) float f32x2_t;
typedef __attribute__((ext_vector_type(2))) __bf16 bf16x2_t;

constexpr int T = 32768;
constexpr int DM = 1024;
constexpr int DFF = 2816;
constexpr int KP1 = 1088;
constexpr int KP2 = 2880;
constexpr int GP = 4160;
constexpr int YP = 1040;
constexpr int NPROJ = 6560;
constexpr int SEQ0 = 16384;
constexpr int DSEQ = 2048;
constexpr float EPS = 1e-6f;
constexpr int NTHR = 512;
constexpr int LSTR = 72;
constexpr int SMEM_BYTES = 2 * 2 * 256 * LSTR * 2;

constexpr size_t W_WI = 0;
constexpr size_t W_WO = W_WI + 2ull * 5632 * KP1;
constexpr size_t W_WIN = W_WO + 2ull * 1024 * KP2;
constexpr size_t W_WUQ = W_WIN + 6656ull * KP1;
constexpr size_t W_WUKV = W_WUQ + 512ull * 384;
constexpr size_t W_WB = W_WUKV + 512ull * 256;
constexpr size_t W_WOUT = W_WB + 1024ull * KP1;
constexpr size_t W_TOTAL = W_WOUT + 1024ull * KP1;

constexpr size_t OFF_W = 0;
constexpr size_t OFF_XN = OFF_W + W_TOTAL * 2;
constexpr size_t OFF_R2 = OFF_XN + (size_t)T * KP1 * 2;
constexpr size_t OFF_QKV = OFF_R2 + (size_t)T * KP2 * 2;
constexpr size_t OFF_SS = OFF_QKV + (size_t)T * 3456 * 2;
constexpr size_t OFF_R64 = OFF_SS + (size_t)T * 20 * 4;
constexpr size_t OFF_R32 = OFF_R64 + 16384ull * 32 * 8;
constexpr size_t OFF_DS = OFF_R32 + 16384ull * 16 * 8;
constexpr size_t OFF_BAR = OFF_DS + (size_t)T * 256 * 4;
constexpr size_t OFF_XB = OFF_BAR + 1024;
constexpr size_t WS_NEEDED = OFF_XB + (size_t)T * 1024 * 2;

constexpr size_t Q_QA = 0;
constexpr size_t Q_KA = (size_t)T * 256;
constexpr size_t Q_VTA = (size_t)T * 384;
constexpr size_t Q_QB = (size_t)T * 512;
constexpr size_t Q_KB = (size_t)T * 768;
constexpr size_t Q_VTB = (size_t)T * 896;
constexpr size_t Q_CQ = (size_t)T * 1024;
constexpr size_t Q_CKV = (size_t)T * 1408;
constexpr size_t Q_QC = (size_t)T * 1664;
constexpr size_t Q_KC = (size_t)T * 2048;
constexpr size_t Q_VTC = (size_t)T * 2432;
constexpr size_t Q_QD = (size_t)T * 2688;
constexpr size_t Q_KD = (size_t)T * 2944;
constexpr size_t Q_VTD = (size_t)T * 3200;
constexpr size_t Q_MERGED = 0;
constexpr size_t Q_Y = (size_t)T * KP1;

struct Params {
  const float* x_prompt; const float* x_sample; const float* norm_g; const float* w_in;
  const float* a_qk_norm; const float* b_sink; const float* c_q_norm; const float* c_kv_norm;
  const float* c_w_uq; const float* c_w_ukv; const float* d_lambda; const float* d_subln;
  const float* w_branch; const float* w_out; const float* ffn_wi; const float* ffn_wo;
  float* out; char* ws;
  int phase_lo; int phase_hi; int coop; int pad0;
};

DI unsigned pk2(float a, float b) {
  f32x2_t v = {a, b};
  bf16x2_t r = __builtin_convertvector(v, bf16x2_t);
  return __builtin_bit_cast(unsigned, r);
}
DI u16 f2bf(float a) { return (u16)(pk2(a, 0.f) & 0xffffu); }
DI float bf2f(unsigned bits16) { return __uint_as_float(bits16 << 16); }
DI int crow(int v, int h) { return (v & 3) + 8 * (v >> 2) + 4 * h; }
DI int pos_of(int tok) { return tok < SEQ0 ? tok : ((tok - SEQ0) & (DSEQ - 1)); }
#define MFMA32(a, b, c) __builtin_amdgcn_mfma_f32_32x32x16_bf16((a), (b), (c), 0, 0, 0)

typedef __attribute__((ext_vector_type(4))) unsigned u32x4;
DI u32x4 gld16(const void* p) { u32x4 r; asm volatile("global_load_dwordx4 %0, %1, off" : "=v"(r) : "v"(p)); return r; }
DI void wait_vm0(u32x4& a) { asm volatile("s_waitcnt vmcnt(0)" : "+v"(a) :: "memory"); }
DI void wait_vm0(u32x4& a, u32x4& b) { asm volatile("s_waitcnt vmcnt(0)" : "+v"(a), "+v"(b) :: "memory"); }
DI void wait_vm0(u32x4& a, u32x4& b, u32x4& c) { asm volatile("s_waitcnt vmcnt(0)" : "+v"(a), "+v"(b), "+v"(c) :: "memory"); }
DI void wait_vm0(u32x4& a, u32x4& b, u32x4& c, u32x4& d) { asm volatile("s_waitcnt vmcnt(0)" : "+v"(a), "+v"(b), "+v"(c), "+v"(d) :: "memory"); }
DI u32x4 gld16s(unsigned voff, const void* sbase) { u32x4 r; asm volatile("global_load_dwordx4 %0, %1, %2" : "=v"(r) : "v"(voff), "s"(sbase)); return r; }
#define DEF_WAIT8(name, cnt) DI void name(u32x4& a, u32x4& b, u32x4& c, u32x4& d, u32x4& e, u32x4& f, u32x4& g, u32x4& h) { asm volatile("s_waitcnt vmcnt(" #cnt ")" : "+v"(a), "+v"(b), "+v"(c), "+v"(d), "+v"(e), "+v"(f), "+v"(g), "+v"(h) :: "memory"); }
#define DEF_WAIT6(name, cnt) DI void name(u32x4& a, u32x4& b, u32x4& c, u32x4& d, u32x4& e, u32x4& f) { asm volatile("s_waitcnt vmcnt(" #cnt ")" : "+v"(a), "+v"(b), "+v"(c), "+v"(d), "+v"(e), "+v"(f) :: "memory"); }
DEF_WAIT8(wait8_vm8, 8)
DEF_WAIT8(wait8_vm0, 0)
DEF_WAIT6(wait6_vm6, 6)
DEF_WAIT6(wait6_vm0, 0)
DI int opaque_tid() { int t = threadIdx.x; asm volatile("" : "+v"(t)); return t; }
DI float wave_sum(float v) {
#pragma unroll
  for (int m = 32; m >= 1; m >>= 1) v += __shfl_xor(v, m);
  return v;
}

DI void rope32_blk(f32x16& a, const float2* __restrict__ tab, int h) {
#pragma unroll
  for (int v = 0; v < 8; ++v) {
    float2 cs = tab[crow(v, h)];
    float x1 = a[v], x2 = a[v + 8];
    a[v] = x1 * cs.x - x2 * cs.y;
    a[v + 8] = x2 * cs.x + x1 * cs.y;
  }
}
DI void rope64_blk(f32x16& a0, f32x16& a1, const float2* __restrict__ tab, int h) {
#pragma unroll
  for (int v = 0; v < 16; ++v) {
    float2 cs = tab[crow(v, h)];
    float x1 = a0[v], x2 = a1[v];
    a0[v] = x1 * cs.x - x2 * cs.y;
    a1[v] = x2 * cs.x + x1 * cs.y;
  }
}
DI void store_rows(u16* __restrict__ base, int ld, int col0, const f32x16& a, int tok, int h) {
#pragma unroll
  for (int vq = 0; vq < 4; ++vq) {
    uint2 pk;
    pk.x = pk2(a[4 * vq], a[4 * vq + 1]);
    pk.y = pk2(a[4 * vq + 2], a[4 * vq + 3]);
    *(uint2*)(base + (size_t)tok * ld + col0 + 8 * vq + 4 * h) = pk;
  }
}
DI void store_T(u16* __restrict__ base, int row0, const f32x16& a, int tok, int h) {
  const int tp = (tok & ~12) | ((tok & 4) << 1) | ((tok & 8) >> 1);
#pragma unroll
  for (int v = 0; v < 16; ++v) base[(size_t)((row0 + crow(v, h)) >> 6) * 64 * T + (size_t)(tp >> 7) * 8192 + ((row0 + crow(v, h)) & 63) * 128 + (tp & 127)] = f2bf(a[v]);
}

enum { M_FFNUP = 0, M_Y = 1, M_PROJ = 2, M_CUQ = 3, M_CUKV = 4, M_MERGE = 5, M_GATE = 6 };

template <int MODE, int NJ>
DI void gemm_epilogue(f32x16 (&acc)[2][NJ], int fbase, int tbase, int r, int h, const Params& P, int layer) {
  char* ws = P.ws;
  u16* qkv = (u16*)(ws + OFF_QKV);
  const float2* R64 = (const float2*)(ws + OFF_R64);
  const float2* R32 = (const float2*)(ws + OFF_R32);
  float* SS = (float*)(ws + OFF_SS);
  if constexpr (MODE == M_FFNUP) {
    u16* H = (u16*)(ws + OFF_R2);
    const int hf0 = (fbase >> 6) * 32;
#pragma unroll
    for (int j = 0; j < NJ; ++j) {
      const int tok = tbase + j * 32 + r;
      f32x16 o;
#pragma unroll
      for (int v = 0; v < 16; ++v) {
        float g = acc[0][j][v], u = acc[1][j][v];
        o[v] = g * __builtin_amdgcn_rcpf(1.f + __builtin_amdgcn_exp2f(-1.4426950408889634f * g)) * u;
      }
      store_rows(H, KP2, hf0, o, tok, h);
    }
  } else if constexpr (MODE == M_Y) {
    u16* Yb = qkv + Q_Y;
#pragma unroll
    for (int j = 0; j < NJ; ++j) {
      const int tok = tbase + j * 32 + r;
      store_rows(Yb, KP1, fbase, acc[0][j], tok, h);
      store_rows(Yb, KP1, fbase + 32, acc[1][j], tok, h);
    }
  } else if constexpr (MODE == M_PROJ) {
    if (fbase < 384) {
      const bool isK = fbase >= 256;
      const float* g = P.a_qk_norm + layer * 128 + (isK ? 64 : 0);
      u16* dst = qkv + (isK ? Q_KA : Q_QA);
      const int ld = isK ? 128 : 256;
      const int c0 = isK ? fbase - 256 : fbase;
      float gv[2][16];
#pragma unroll
      for (int i = 0; i < 2; ++i)
#pragma unroll
        for (int v = 0; v < 16; ++v) gv[i][v] = g[i * 32 + crow(v, h)];
#pragma unroll
      for (int j = 0; j < NJ; ++j) {
        const int tok = tbase + j * 32 + r;
        const int pos = pos_of(tok);
        float ss = 0.f;
#pragma unroll
        for (int i = 0; i < 2; ++i)
#pragma unroll
          for (int v = 0; v < 16; ++v) ss += acc[i][j][v] * acc[i][j][v];
        ss += __shfl_xor(ss, 32);
        const float rs = rsqrtf(ss * (1.f / 64.f) + EPS);
#pragma unroll
        for (int i = 0; i < 2; ++i)
#pragma unroll
          for (int v = 0; v < 16; ++v) acc[i][j][v] *= rs * gv[i][v];
        rope32_blk(acc[0][j], R32 + (size_t)(pos >> 6) * 16, h);
        rope32_blk(acc[1][j], R32 + (size_t)(pos & 63) * 16, h);
        store_rows(dst, ld, c0, acc[0][j], tok, h);
        store_rows(dst, ld, c0 + 32, acc[1][j], tok, h);
      }
    } else if (fbase < 512) {
#pragma unroll
      for (int j = 0; j < NJ; ++j) {
        const int tok = tbase + j * 32 + r;
        store_T(qkv + Q_VTA, fbase - 384, acc[0][j], tok, h);
        store_T(qkv + Q_VTA, fbase - 384 + 32, acc[1][j], tok, h);
      }
    } else if (fbase < 896) {
      const bool isK = fbase >= 768;
      u16* dst = qkv + (isK ? Q_KB : Q_QB);
      const int ld = isK ? 128 : 256;
      const int c0 = isK ? fbase - 768 : fbase - 512;
#pragma unroll
      for (int j = 0; j < NJ; ++j) {
        const int tok = tbase + j * 32 + r;
        const int pos = pos_of(tok);
        rope64_blk(acc[0][j], acc[1][j], R64 + (size_t)pos * 32, h);
        store_rows(dst, ld, c0, acc[0][j], tok, h);
        store_rows(dst, ld, c0 + 32, acc[1][j], tok, h);
      }
    } else if (fbase < 1024) {
#pragma unroll
      for (int j = 0; j < NJ; ++j) {
        const int tok = tbase + j * 32 + r;
        store_T(qkv + Q_VTB, fbase - 896, acc[0][j], tok, h);
        store_T(qkv + Q_VTB, fbase - 896 + 32, acc[1][j], tok, h);
      }
    } else if (fbase < 1664) {
      const bool isKV = fbase >= 1408;
      u16* dst = qkv + (isKV ? Q_CKV : Q_CQ);
      const int ld = isKV ? 256 : 384;
      const int c0 = isKV ? fbase - 1408 : fbase - 1024;
      const int sb = (isKV ? 12 : 0) + (c0 >> 5);
#pragma unroll
      for (int j = 0; j < NJ; ++j) {
        const int tok = tbase + j * 32 + r;
#pragma unroll
        for (int i = 0; i < 2; ++i) {
          float ss = 0.f;
#pragma unroll
          for (int v = 0; v < 16; ++v) ss += acc[i][j][v] * acc[i][j][v];
          ss += __shfl_xor(ss, 32);
          if (h == 0) SS[(size_t)tok * 20 + sb + i] = ss;
          store_rows(dst, ld, c0 + i * 32, acc[i][j], tok, h);
        }
      }
    } else if (fbase < 2176) {
      const bool isK = fbase >= 1920;
      u16* dst = qkv + (isK ? Q_KD : Q_QD);
      const int c0 = isK ? fbase - 1920 : fbase - 1664;
#pragma unroll
      for (int j = 0; j < NJ; ++j) {
        const int tok = tbase + j * 32 + r;
        const int pos = pos_of(tok);
#pragma unroll
        for (int i = 0; i < 2; ++i) {
          rope32_blk(acc[i][j], R32 + (size_t)pos * 16, h);
          store_rows(dst, 256, c0 + i * 32, acc[i][j], tok, h);
        }
      }
    } else if (fbase < 2432) {
#pragma unroll
      for (int j = 0; j < NJ; ++j) {
        const int tok = tbase + j * 32 + r;
        store_T(qkv + Q_VTD, fbase - 2176, acc[0][j], tok, h);
        store_T(qkv + Q_VTD, fbase - 2176 + 32, acc[1][j], tok, h);
      }
    } else if (fbase == 2432) {
#pragma unroll
      for (int j = 0; j < NJ; ++j) {
        const int tok = tbase + j * 32 + r;
        const int pos = pos_of(tok);
        rope32_blk(acc[0][j], R32 + (size_t)pos * 16, h);
#pragma unroll
        for (int hd = 0; hd < 4; ++hd) store_rows(qkv + Q_KC, 384, hd * 96 + 64, acc[0][j], tok, h);
      }
    }
  } else if constexpr (MODE == M_GATE) {
    unsigned char* G8 = (unsigned char*)(ws + OFF_R2);
#pragma unroll
    for (int j = 0; j < NJ; ++j) {
      const int tok = tbase + j * 32 + r;
#pragma unroll
      for (int i = 0; i < 2; ++i)
#pragma unroll
        for (int vq = 0; vq < 4; ++vq) {
          unsigned pk = 0u;
#pragma unroll
          for (int e = 0; e < 4; ++e) {
            const float o = __builtin_amdgcn_rcpf(1.f + __builtin_amdgcn_exp2f(-1.4426950408889634f * acc[i][j][4 * vq + e]));
            pk |= (unsigned)(o * 255.f + 0.5f) << (8 * e);
          }
          *(unsigned*)(G8 + (size_t)tok * GP + fbase + i * 32 + 8 * vq + 4 * h) = pk;
        }
    }
  } else if constexpr (MODE == M_CUQ) {
    if (fbase >= 384) return;
#pragma unroll
    for (int j = 0; j < NJ; ++j) {
      const int tok = tbase + j * 32 + r;
      const int pos = pos_of(tok);
      float ss = 0.f;
#pragma unroll
      for (int b = 0; b < 12; ++b) ss += SS[(size_t)tok * 20 + b];
      const float rs = rsqrtf(ss * (1.f / 384.f) + EPS);
#pragma unroll
      for (int i = 0; i < 2; ++i) {
        const int blk = (fbase >> 5) + i;
#pragma unroll
        for (int v = 0; v < 16; ++v) acc[i][j][v] *= rs;
        if (blk % 3 == 2) rope32_blk(acc[i][j], R32 + (size_t)pos * 16, h);
        store_rows(qkv + Q_QC, 384, blk * 32, acc[i][j], tok, h);
      }
    }
  } else if constexpr (MODE == M_CUKV) {
#pragma unroll
    for (int j = 0; j < NJ; ++j) {
      const int tok = tbase + j * 32 + r;
      float ss = 0.f;
#pragma unroll
      for (int b = 0; b < 8; ++b) ss += SS[(size_t)tok * 20 + 12 + b];
      const float rs = rsqrtf(ss * (1.f / 256.f) + EPS);
#pragma unroll
      for (int i = 0; i < 2; ++i) {
        const int blk = (fbase >> 5) + i;
        const int hd = blk >> 2, q = blk & 3;
#pragma unroll
        for (int v = 0; v < 16; ++v) acc[i][j][v] *= rs;
        if (q < 2) store_rows(qkv + Q_KC, 384, hd * 96 + q * 32, acc[i][j], tok, h);
        else store_T(qkv + Q_VTC, hd * 64 + (q - 2) * 32, acc[i][j], tok, h);
      }
    }
  } else if constexpr (MODE == M_MERGE) {
#pragma unroll
    for (int j = 0; j < NJ; ++j) {
      const int tok = tbase + j * 32 + r;
      store_rows(qkv + Q_MERGED, KP1, fbase, acc[0][j], tok, h);
      store_rows(qkv + Q_MERGED, KP1, fbase + 32, acc[1][j], tok, h);
    }
  }
}

typedef __attribute__((address_space(3))) unsigned lds_u32_t;
typedef __attribute__((address_space(1))) const unsigned glb_u32_t;
template <int MODE, int NJ>
DI void gemm_tile(const u16* __restrict__ Wt, int ldw, const u16* __restrict__ X, int ldx, int K, int f0, int t0, char* smem,
                  const Params& P, int layer) {
  constexpr int XROWS = NJ * 64;
  constexpr int WSTG = 256 * 64, XSTG = XROWS * 64;
  u16* sW = (u16*)smem;
  u16* sX = sW + 2 * WSTG;
  const int tid = opaque_tid(), lane = tid & 63, wave = tid >> 6, r = lane & 31, h = lane >> 5;
  const int wf = wave & 3, wt = wave >> 2;
  f32x16 acc[2][NJ];
  f32x16 tot[2][MODE == M_MERGE ? NJ : 1];
#pragma unroll
  for (int i = 0; i < 2; ++i)
#pragma unroll
    for (int j = 0; j < NJ; ++j)
#pragma unroll
      for (int v = 0; v < 16; ++v) acc[i][j][v] = 0.f;
  if constexpr (MODE == M_MERGE) {
#pragma unroll
    for (int i = 0; i < 2; ++i)
#pragma unroll
      for (int j = 0; j < NJ; ++j)
#pragma unroll
        for (int v = 0; v < 16; ++v) tot[i][j][v] = 0.f;
  }
  const int nk = K >> 6;
  const int srow = tid >> 3;
  const int schunk = (tid & 7) ^ ((tid >> 4) & 7);
  const u16* wp = Wt + (size_t)(f0 + srow) * ldw + schunk * 8;
  const u16* xp = X + (size_t)(t0 + srow) * ldx + schunk * 8;
  const int fbase = f0 + wf * 64, tbase = t0 + wt * (NJ * 32);

  auto issue = [&](int kt, int buf) {
#pragma unroll
    for (int i = 0; i < 4; ++i)
      __builtin_amdgcn_global_load_lds((glb_u32_t*)(wp + (size_t)(i * 64) * ldw + kt * 64),
                                       (lds_u32_t*)(sW + buf * WSTG + i * 4096 + tid * 8), 16, 0, 0);
#pragma unroll
    for (int i = 0; i < NJ; ++i)
      __builtin_amdgcn_global_load_lds((glb_u32_t*)(xp + (size_t)(i * 64) * ldx + kt * 64),
                                       (lds_u32_t*)(sX + buf * XSTG + i * 4096 + tid * 8), 16, 0, 0);
  };
  const int swz = (r >> 1) & 7;
  auto compute = [&](int buf, int kt) {
    const u16* aW = sW + buf * WSTG + (wf * 64 + r) * 64;
    const u16* aX = sX + buf * XSTG + (wt * (NJ * 32) + r) * 64;
#pragma unroll
    for (int ks = 0; ks < 4; ++ks) {
      const int co = ((2 * ks + h) ^ swz) * 8;
      bf16x8 wfrag[2], xfrag[NJ];
#pragma unroll
      for (int i = 0; i < 2; ++i) wfrag[i] = *(const bf16x8*)(aW + i * 32 * 64 + co);
#pragma unroll
      for (int j = 0; j < NJ; ++j) xfrag[j] = *(const bf16x8*)(aX + j * 32 * 64 + co);
#pragma unroll
      for (int i = 0; i < 2; ++i)
#pragma unroll
        for (int j = 0; j < NJ; ++j) acc[i][j] = MFMA32(wfrag[i], xfrag[j], acc[i][j]);
    }
    if constexpr (MODE == M_MERGE) {
      if ((kt & 3) == 3) {
        const int br = kt >> 2;
        const unsigned char* G8 = (const unsigned char*)(P.ws + OFF_R2);
#pragma unroll
        for (int j = 0; j < NJ; ++j) {
          const int tok = tbase + j * 32 + r;
#pragma unroll
          for (int i = 0; i < 2; ++i)
#pragma unroll
            for (int vq = 0; vq < 4; ++vq) {
              const unsigned gp = *(const unsigned*)(G8 + (size_t)tok * GP + br * 1024 + fbase + i * 32 + 8 * vq + 4 * h);
              tot[i][j][4 * vq + 0] += (float)(gp & 0xffu) * (1.f / 255.f) * acc[i][j][4 * vq + 0];
              tot[i][j][4 * vq + 1] += (float)((gp >> 8) & 0xffu) * (1.f / 255.f) * acc[i][j][4 * vq + 1];
              tot[i][j][4 * vq + 2] += (float)((gp >> 16) & 0xffu) * (1.f / 255.f) * acc[i][j][4 * vq + 2];
              tot[i][j][4 * vq + 3] += (float)(gp >> 24) * (1.f / 255.f) * acc[i][j][4 * vq + 3];
              acc[i][j][4 * vq + 0] = 0.f; acc[i][j][4 * vq + 1] = 0.f;
              acc[i][j][4 * vq + 2] = 0.f; acc[i][j][4 * vq + 3] = 0.f;
            }
        }
      }
    }
  };

  issue(0, 0);
  asm volatile("s_waitcnt vmcnt(0)" ::: "memory");
  __syncthreads();
  for (int kt = 0; kt < nk; ++kt) {
    const int buf = kt & 1;
    if (kt + 1 < nk) issue(kt + 1, buf ^ 1);
    compute(buf, kt);
    asm volatile("s_waitcnt vmcnt(0) lgkmcnt(0)" ::: "memory");
    __syncthreads();
  }
  if constexpr (MODE == M_MERGE) gemm_epilogue<MODE, NJ>(tot, fbase, tbase, r, h, P, layer);
  else gemm_epilogue<MODE, NJ>(acc, fbase, tbase, r, h, P, layer);
}

template <int MODE, int NJ>
DI void gemm_phase(const u16* Wt, int ldw, const u16* X, int ldx, int K, int nF, char* smem, const Params& P, int layer) {
  constexpr int TT = NJ * 64;
  const int nT = T / TT;
  const int ntiles = nF * nT;
  for (int idx = blockIdx.x; idx < ntiles; idx += gridDim.x) {
    const int tt_lo = idx & 15;
    const int rest = idx >> 4;
    const int ft = rest % nF;
    const int tt = (rest / nF) * 16 + tt_lo;
    gemm_tile<MODE, NJ>(Wt, ldw, X, ldx, K, ft * 256, tt * TT, smem, P, layer);
  }
}

namespace pg8 {
#define PG8_LAS __attribute__((address_space(3)))
typedef unsigned short bf16_t;
typedef short bf16x8 __attribute__((ext_vector_type(8)));
typedef float f32x4 __attribute__((ext_vector_type(4)));
typedef unsigned u32x4 __attribute__((ext_vector_type(4)));
constexpr int BM = 256, BK = 64, HALF = 128, HTB = HALF * BK * 2  , STAGE_BYTES = 8 * HTB, NXCD = 8, WGM = 8;

__host__ __device__ __forceinline__ int lds_byte(int r, int c) { const int st = (r >> 4) * 2 + (c >> 5), rr = r & 15, cc = c & 31, ob = rr * 64 + cc * 2; return st * 1024 + (ob ^ (((ob >> 9) & 1) << 5)); }
__host__ __device__ __forceinline__ void stage_rc(int b, int& R, int& C) { const int st = b / 1024, sb = b % 1024, swz = sb ^ (((sb >> 9) & 1) << 5); R = (st >> 1) * 16 + swz / 64; C = (st & 1) * 32 + (swz % 64) / 2; }
__host__ __device__ __forceinline__ int perm32(int rho) { const int n = rho >> 4, i = rho & 15; return 8 * (i >> 2) + 4 * n + (i & 3); }

struct Unit { int pm, pn; };
struct Gemm { const bf16_t* A; const bf16_t* Bt; int M, N, K, ld; };

struct StaticOrder {
    int nM, nN, nwg, G, c;
    __host__ __device__ void init(int M, int N, int G_, int c_) { nM = M / BM; nN = N / BM; nwg = nM * nN; G = G_; c = c_; }
    __host__ __device__ bool next(int i, Unit& u) const {
        const long L = (long)i * G + c; if (L >= nwg) return false;
        int wgid = (int)L; { const int q = nwg / NXCD, r = nwg % NXCD, xcd = wgid % NXCD, off = wgid / NXCD; wgid = (xcd < r ? xcd * (q + 1) : r * (q + 1) + (xcd - r) * q) + off; }
        const int nig = WGM * nN, gid = wgid / nig, fm = gid * WGM, gsz = (nM - fm) < WGM ? (nM - fm) : WGM;
        u.pm = fm + ((wgid % nig) % gsz); u.pn = (wgid % nig) / gsz; return true;
    }
    __device__ __forceinline__ void a_ready(const Unit&) const {}
    __device__ __forceinline__ void done(const Unit&) const {}
};

template <class Epi, class Sched, bool STAMP, int KC, int LDC>
__device__ __forceinline__ void gemm_phase(PG8_LAS unsigned char* lds, const Gemm g, const Sched& S, const Epi& E, unsigned long long* stamps) {
    const int tid = opaque_tid(), wid = __builtin_amdgcn_readfirstlane(tid >> 6), lane = tid & 63, wr = wid >> 2, wc = wid & 3, fr = lane & 15, fq = lane >> 4;
    constexpr int K = KC, nt = K / BK;
    int ts_lo = 0, ts_hi = 0, nts = 0; const unsigned long long rt_entry = STAMP ? (unsigned long long)wall_clock64() : 0ull;
#define PG8_STAMP() do { if (STAMP && wid == 0 && nts < 64) { const unsigned long long _c = (unsigned long long)clock64(); \
        ts_lo = (lane == nts) ? (int)(unsigned)_c : ts_lo; ts_hi = (lane == nts) ? (int)(unsigned)(_c >> 32) : ts_hi; ++nts; } } while (0)
    PG8_STAMP();
    unsigned voffA[2], voffB[2];
#pragma unroll
    for (int i = 0; i < 2; ++i) { int R, C; stage_rc(tid * 16 + i * 8192, R, C); const int Rb = Epi::PERM ? ((R & ~31) + perm32(R & 31)) : R;
        voffA[i] = (unsigned)(R * LDC + C) * 2u; voffB[i] = (unsigned)(Rb * LDC + C) * 2u; }
    const size_t kstep = (size_t)(BK * 2);
    constexpr size_t hstep = (size_t)HALF * LDC * 2;
    const size_t tstep = 2 * hstep;
    const unsigned ldsw = (unsigned)wid * 1024u;
    const int aoff = lds_byte(wr * 64 + fr, fq * 8), boff = lds_byte(wc * 32 + fr, fq * 8);
#define PG8_SA(b, h) (((b) * 2 + (h)) * HTB)
#define PG8_SB(b, h) ((4 + (b) * 2 + (h)) * HTB)
#define PG8_STAGE(bufoff, gbase, voff) do { _Pragma("unroll") for (int _i = 0; _i < 2; ++_i) \
        __builtin_amdgcn_global_load_lds((const unsigned*)((const char*)(gbase) + (voff)[_i]), (PG8_LAS unsigned*)(lds + (bufoff) + ldsw + _i * 8192), 16, 0, 0); } while (0)
#define PG8_LDA(dst, b, h) do { _Pragma("unroll") for (int m = 0; m < 4; ++m) _Pragma("unroll") for (int k = 0; k < 2; ++k) dst[m][k] = *(const PG8_LAS bf16x8*)(lds + PG8_SA(b, h) + aoff + m * 2048 + k * 1024); } while (0)
#define PG8_LDB(dst, b, h) do { _Pragma("unroll") for (int n = 0; n < 2; ++n) _Pragma("unroll") for (int k = 0; k < 2; ++k) dst[n][k] = *(const PG8_LAS bf16x8*)(lds + PG8_SB(b, h) + boff + n * 2048 + k * 1024); } while (0)
#define PG8_MMA(ai, bj, At, Bt) do { __builtin_amdgcn_s_setprio(1); _Pragma("unroll") for (int m = 0; m < 4; ++m) _Pragma("unroll") for (int n = 0; n < 2; ++n) _Pragma("unroll") for (int k = 0; k < 2; ++k) \
        acc[ai][bj][m][n] = __builtin_amdgcn_mfma_f32_16x16x32_bf16(Bt[n][k], At[m][k], acc[ai][bj][m][n], 0, 0, 0); __builtin_amdgcn_s_setprio(0); } while (0)
#define PG8_WAIT_V(n) asm volatile("s_waitcnt vmcnt(" #n ")" ::: "memory")
#define PG8_WAIT_L(n) asm volatile("s_waitcnt lgkmcnt(" #n ")" ::: "memory")
#define PG8_BAR __builtin_amdgcn_s_barrier()
#define PG8_SCHED __builtin_amdgcn_sched_barrier(0)
    Unit cur, nxt; int ui = 0;
    if (!S.next(0, cur)) return;
    f32x4 acc[2][2][4][2];
#pragma unroll
    for (int a = 0; a < 2; ++a)
#pragma unroll
        for (int b = 0; b < 2; ++b)
#pragma unroll
            for (int m = 0; m < 4; ++m)
#pragma unroll
                for (int n = 0; n < 2; ++n) acc[a][b][m][n] = (f32x4){0.f, 0.f, 0.f, 0.f};
    bf16x8 At[4][2], B0[2][2], B1[2][2];
    const char* cA = (const char*)g.A + (size_t)cur.pm * tstep; const char* cB = (const char*)g.Bt + (size_t)cur.pn * tstep;
    S.a_ready(cur);
    PG8_STAGE(PG8_SB(0, 0), cB, voffB); PG8_STAGE(PG8_SA(0, 0), cA, voffA); PG8_STAGE(PG8_SB(0, 1), cB + hstep, voffB); PG8_STAGE(PG8_SA(0, 1), cA + hstep, voffA);
    if (wr == 1) PG8_BAR;
    PG8_WAIT_V(4); PG8_BAR;
    PG8_STAGE(PG8_SB(1, 0), cB + kstep, voffB); PG8_STAGE(PG8_SA(1, 0), cA + kstep, voffA); PG8_STAGE(PG8_SB(1, 1), cB + hstep + kstep, voffB);
    PG8_WAIT_V(6); PG8_BAR;
    PG8_STAMP();
    for (;;) {
        const bool has_next = S.next(ui + 1, nxt);
        const char* nA = has_next ? (const char*)g.A + (size_t)nxt.pm * tstep : cA; const char* nB = has_next ? (const char*)g.Bt + (size_t)nxt.pn * tstep : cB;
        for (int t = 0; t < nt; t += 2) {
            const bool last = (t == nt - 2);
            const char* a1 = cA + (size_t)(t + 1) * kstep;
            const char* a2 = last ? nA : cA + (size_t)(t + 2) * kstep; const char* b2 = last ? nB : cB + (size_t)(t + 2) * kstep;
            const char* a3 = a2 + kstep; const char* b3 = b2 + kstep;
            if (last && has_next) S.a_ready(nxt);
            PG8_LDB(B0, 0, 0); PG8_SCHED; PG8_LDA(At, 0, 0); PG8_STAGE(PG8_SA(1, 1), a1 + hstep, voffA);
            PG8_WAIT_L(8); PG8_BAR; PG8_WAIT_L(0); PG8_MMA(0, 0, At, B0); PG8_BAR; PG8_SCHED;
            PG8_LDB(B1, 0, 1); PG8_STAGE(PG8_SB(0, 0), b2, voffB);
            PG8_BAR; PG8_WAIT_L(0); PG8_MMA(0, 1, At, B1); PG8_BAR;
            PG8_LDA(At, 0, 1); PG8_STAGE(PG8_SA(0, 0), a2, voffA);
            PG8_BAR; PG8_WAIT_L(0); PG8_MMA(1, 0, At, B0); PG8_BAR; PG8_SCHED;
            PG8_STAGE(PG8_SB(0, 1), b2 + hstep, voffB);
            PG8_WAIT_V(6); PG8_BAR; PG8_MMA(1, 1, At, B1); PG8_BAR;
            PG8_LDB(B0, 1, 0); PG8_SCHED; PG8_LDA(At, 1, 0); PG8_STAGE(PG8_SA(0, 1), a2 + hstep, voffA);
            PG8_WAIT_L(8); PG8_BAR; PG8_WAIT_L(0); PG8_MMA(0, 0, At, B0); PG8_BAR; PG8_SCHED;
            PG8_LDB(B1, 1, 1); PG8_STAGE(PG8_SB(1, 0), b3, voffB);
            PG8_BAR; PG8_WAIT_L(0); PG8_MMA(0, 1, At, B1); PG8_BAR;
            PG8_LDA(At, 1, 1); PG8_STAGE(PG8_SA(1, 0), a3, voffA);
            PG8_BAR; PG8_WAIT_L(0); PG8_MMA(1, 0, At, B0); PG8_BAR; PG8_SCHED;
            PG8_STAGE(PG8_SB(1, 1), b3 + hstep, voffB);
            PG8_WAIT_V(6); PG8_BAR; PG8_MMA(1, 1, At, B1); PG8_BAR;
        }
        PG8_STAMP();
        if constexpr (!Epi::AFTER_DRAIN) { E(acc, cur, wr, wc, fr, fq); S.done(cur); }
        PG8_STAMP();
        if (!has_next) break;
#pragma unroll
        for (int a = 0; a < 2; ++a)
#pragma unroll
            for (int b = 0; b < 2; ++b)
#pragma unroll
                for (int m = 0; m < 4; ++m)
#pragma unroll
                    for (int n = 0; n < 2; ++n) acc[a][b][m][n] = (f32x4){0.f, 0.f, 0.f, 0.f};
        cur = nxt; cA = nA; cB = nB; ++ui;
    }
    PG8_WAIT_V(0);
    if (wr == 0) PG8_BAR;
    PG8_BAR;
    if constexpr (Epi::AFTER_DRAIN) { E.fused(acc, cur, wr, wc, fr, fq, lds, wid, lane); S.done(cur); }
    PG8_STAMP();
    if (STAMP && wid == 0) { stamps[lane] = lane < nts ? (((unsigned long long)(unsigned)ts_hi << 32) | (unsigned)ts_lo) : 0ull;
        if (lane == 62) stamps[62] = rt_entry; if (lane == 63) stamps[63] = (unsigned long long)wall_clock64(); }
#undef PG8_STAMP
#undef PG8_SA
#undef PG8_SB
#undef PG8_STAGE
#undef PG8_LDA
#undef PG8_LDB
#undef PG8_MMA
#undef PG8_WAIT_V
#undef PG8_WAIT_L
#undef PG8_BAR
#undef PG8_SCHED
}
}

struct EpiY8 {
  static constexpr bool PERM = true, AFTER_DRAIN = false;
  u16* O;
  DI void operator()(const pg8::f32x4 (&acc)[2][2][4][2], const pg8::Unit& u, int wr, int wc, int fr, int fq) const {
    const int row0 = u.pm * 256 + wr * 64 + fr, col0 = u.pn * 256 + wc * 32 + 8 * fq;
#pragma unroll
    for (int ai = 0; ai < 2; ++ai)
#pragma unroll
      for (int m = 0; m < 4; ++m) {
        u16* rowp = O + (size_t)(row0 + ai * 128 + m * 16) * KP1 + col0;
#pragma unroll
        for (int bj = 0; bj < 2; ++bj) {
          const pg8::f32x4 v0 = acc[ai][bj][m][0], v1 = acc[ai][bj][m][1];
          u32x4 w; w.x = pk2(v0[0], v0[1]); w.y = pk2(v0[2], v0[3]); w.z = pk2(v1[0], v1[1]); w.w = pk2(v1[2], v1[3]);
          *(u32x4*)(rowp + bj * 128) = w;
        }
      }
  }
};
struct EpiFfnUp8 {
  static constexpr bool PERM = true, AFTER_DRAIN = false;
  u16* H;
  DI void operator()(const pg8::f32x4 (&acc)[2][2][4][2], const pg8::Unit& u, int wr, int wc, int fr, int fq) const {
    const int row0 = u.pm * 256 + wr * 64 + fr, col0 = u.pn * 128 + wc * 32 + 8 * fq;
#pragma unroll
    for (int ai = 0; ai < 2; ++ai)
#pragma unroll
      for (int m = 0; m < 4; ++m) {
        float o[8];
#pragma unroll
        for (int n = 0; n < 2; ++n)
#pragma unroll
          for (int j = 0; j < 4; ++j) {
            const float g = acc[ai][0][m][n][j], up = acc[ai][1][m][n][j];
            o[n * 4 + j] = g * __builtin_amdgcn_rcpf(1.f + __builtin_amdgcn_exp2f(-1.4426950408889634f * g)) * up;
          }
        u32x4 w; w.x = pk2(o[0], o[1]); w.y = pk2(o[2], o[3]); w.z = pk2(o[4], o[5]); w.w = pk2(o[6], o[7]);
        *(u32x4*)(H + (size_t)(row0 + ai * 128 + m * 16) * KP2 + col0) = w;
      }
  }
};
struct EpiGate8 {
  static constexpr bool PERM = true, AFTER_DRAIN = false;
  unsigned char* G8;
  DI void operator()(const pg8::f32x4 (&acc)[2][2][4][2], const pg8::Unit& u, int wr, int wc, int fr, int fq) const {
    const int row0 = u.pm * 256 + wr * 64 + fr, col0 = u.pn * 256 + wc * 32 + 8 * fq;
#pragma unroll
    for (int ai = 0; ai < 2; ++ai)
#pragma unroll
      for (int m = 0; m < 4; ++m)
#pragma unroll
        for (int bj = 0; bj < 2; ++bj) {
          uint2 pk = {0u, 0u};
#pragma unroll
          for (int j = 0; j < 4; ++j) {
            const float a = __builtin_amdgcn_rcpf(1.f + __builtin_amdgcn_exp2f(-1.4426950408889634f * acc[ai][bj][m][0][j]));
            const float b = __builtin_amdgcn_rcpf(1.f + __builtin_amdgcn_exp2f(-1.4426950408889634f * acc[ai][bj][m][1][j]));
            pk.x |= (unsigned)(a * 255.f + 0.5f) << (8 * j);
            pk.y |= (unsigned)(b * 255.f + 0.5f) << (8 * j);
          }
          *(uint2*)(G8 + (size_t)(row0 + ai * 128 + m * 16) * GP + col0 + bj * 128) = pk;
        }
  }
};
struct EpiProj8 {
  static constexpr bool PERM = false, AFTER_DRAIN = false;
  const Params* Pp; int layer;
  static DI void rope32q(float (&b)[8], const float2* __restrict__ tab, int fq) {
#pragma unroll
    for (int j = 0; j < 4; ++j) {
      const float2 cs = tab[4 * fq + j];
      const float x1 = b[j], x2 = b[4 + j];
      b[j] = x1 * cs.x - x2 * cs.y;
      b[4 + j] = x2 * cs.x + x1 * cs.y;
    }
  }
  static DI void st8(u16* __restrict__ base, int ld, int col0, const float (&b)[8], int tok, int fq) {
#pragma unroll
    for (int n = 0; n < 2; ++n) {
      uint2 pk; pk.x = pk2(b[4 * n], b[4 * n + 1]); pk.y = pk2(b[4 * n + 2], b[4 * n + 3]);
      *(uint2*)(base + (size_t)tok * ld + col0 + 16 * n + 4 * fq) = pk;
    }
  }
  static DI void stT8(u16* __restrict__ base, int row0, const float (&b)[8], int tok, int fq) {
    const int tp = (tok & ~12) | ((tok & 4) << 1) | ((tok & 8) >> 1);
#pragma unroll
    for (int n = 0; n < 2; ++n)
#pragma unroll
      for (int j = 0; j < 4; ++j) {
        const int row = row0 + 16 * n + 4 * fq + j;
        base[(size_t)(row >> 6) * 64 * T + (size_t)(tp >> 7) * 8192 + (row & 63) * 128 + (tp & 127)] = f2bf(b[4 * n + j]);
      }
  }
  DI void operator()(const pg8::f32x4 (&acc)[2][2][4][2], const pg8::Unit& u, int wr, int wc, int fr, int fq_in) const {
    const Params& P = *Pp;
    char* ws = P.ws;
    u16* qkv = (u16*)(ws + OFF_QKV);
    const float2* R64 = (const float2*)(ws + OFF_R64);
    const float2* R32 = (const float2*)(ws + OFF_R32);
    float* SS = (float*)(ws + OFF_SS);
    const int fbase = u.pn * 256 + wc * 64;
    if (fbase >= 2496) return;
    float dnorm = 0.f;
#pragma unroll
    for (int ai = 0; ai < 2; ++ai)
#pragma unroll
      for (int m = 0; m < 4; ++m) {
        int fqv = fq_in; asm volatile("" : "+v"(fqv));
        const int fq = fqv;
        const int tok = u.pm * 256 + ai * 128 + wr * 64 + m * 16 + fr;
        const int pos = pos_of(tok);
        float b0[8], b1[8];
#pragma unroll
        for (int n = 0; n < 2; ++n)
#pragma unroll
          for (int j = 0; j < 4; ++j) { b0[4 * n + j] = acc[ai][0][m][n][j]; b1[4 * n + j] = acc[ai][1][m][n][j]; }
        if (fbase < 384) {
          const bool isK = fbase >= 256;
          const float* g = P.a_qk_norm + layer * 128 + (isK ? 64 : 0);
          float ss = 0.f;
#pragma unroll
          for (int k = 0; k < 8; ++k) ss += b0[k] * b0[k] + b1[k] * b1[k];
          ss += __shfl_xor(ss, 16);
          ss += __shfl_xor(ss, 32);
          const float rs = rsqrtf(ss * (1.f / 64.f) + EPS) * (isK ? 1.f : 0.125f * 1.4426950408889634f);
#pragma unroll
          for (int n = 0; n < 2; ++n)
#pragma unroll
            for (int j = 0; j < 4; ++j) {
              b0[4 * n + j] *= rs * g[16 * n + 4 * fq + j];
              b1[4 * n + j] *= rs * g[32 + 16 * n + 4 * fq + j];
            }
          rope32q(b0, R32 + (size_t)(pos >> 6) * 16, fq);
          rope32q(b1, R32 + (size_t)(pos & 63) * 16, fq);
          u16* dst = qkv + (isK ? Q_KA : Q_QA);
          const int ld = isK ? 128 : 256, c0 = isK ? fbase - 256 : fbase;
          st8(dst, ld, c0, b0, tok, fq);
          st8(dst, ld, c0 + 32, b1, tok, fq);
        } else if (fbase < 512) {
          stT8(qkv + Q_VTA, fbase - 384, b0, tok, fq);
          stT8(qkv + Q_VTA, fbase - 384 + 32, b1, tok, fq);
        } else if (fbase < 896) {
          const bool isK = fbase >= 768;
          const float2* tab = R64 + (size_t)pos * 32;
#pragma unroll
          for (int n = 0; n < 2; ++n)
#pragma unroll
            for (int j = 0; j < 4; ++j) {
              const float2 cs = tab[16 * n + 4 * fq + j];
              const float x1 = b0[4 * n + j], x2 = b1[4 * n + j];
              b0[4 * n + j] = x1 * cs.x - x2 * cs.y;
              b1[4 * n + j] = x2 * cs.x + x1 * cs.y;
            }
          u16* dst = qkv + (isK ? Q_KB : Q_QB);
          const int ld = isK ? 128 : 256, c0 = isK ? fbase - 768 : fbase - 512;
          st8(dst, ld, c0, b0, tok, fq);
          st8(dst, ld, c0 + 32, b1, tok, fq);
        } else if (fbase < 1024) {
          stT8(qkv + Q_VTB, fbase - 896, b0, tok, fq);
          stT8(qkv + Q_VTB, fbase - 896 + 32, b1, tok, fq);
        } else if (fbase < 1664) {
          const bool isKV = fbase >= 1408;
          u16* dst = qkv + (isKV ? Q_CKV : Q_CQ);
          const int ld = isKV ? 256 : 384, c0 = isKV ? fbase - 1408 : fbase - 1024;
          const int sb = (isKV ? 12 : 0) + (c0 >> 5);
          float s0 = 0.f, s1 = 0.f;
#pragma unroll
          for (int k = 0; k < 8; ++k) { s0 += b0[k] * b0[k]; s1 += b1[k] * b1[k]; }
          s0 += __shfl_xor(s0, 16); s0 += __shfl_xor(s0, 32);
          s1 += __shfl_xor(s1, 16); s1 += __shfl_xor(s1, 32);
          if (fq == 0) { SS[(size_t)tok * 20 + sb] = s0; SS[(size_t)tok * 20 + sb + 1] = s1; }
          st8(dst, ld, c0, b0, tok, fq);
          st8(dst, ld, c0 + 32, b1, tok, fq);
        } else if (fbase < 2176) {
          const bool isK = fbase >= 1920;
          u16* dst = qkv + (isK ? Q_KD : Q_QD);
          const int c0 = isK ? fbase - 1920 : fbase - 1664;
          rope32q(b0, R32 + (size_t)pos * 16, fq);
          rope32q(b1, R32 + (size_t)pos * 16, fq);
          float s0 = 0.f, s1 = 0.f;
#pragma unroll
          for (int k = 0; k < 8; ++k) { s0 += b0[k] * b0[k]; s1 += b1[k] * b1[k]; }
          dnorm = fmaxf(dnorm, fmaxf(s0, s1));
          if (!isK) {
#pragma unroll
            for (int k = 0; k < 8; ++k) { b0[k] *= 0.17677669529663687f * 1.4426950408889634f; b1[k] *= 0.17677669529663687f * 1.4426950408889634f; }
          }
          st8(dst, 256, c0, b0, tok, fq);
          st8(dst, 256, c0 + 32, b1, tok, fq);
        } else if (fbase < 2432) {
          stT8(qkv + Q_VTD, fbase - 2176, b0, tok, fq);
          stT8(qkv + Q_VTD, fbase - 2176 + 32, b1, tok, fq);
        } else {
          rope32q(b0, R32 + (size_t)pos * 16, fq);
#pragma unroll
          for (int hd = 0; hd < 4; ++hd) st8(qkv + Q_KC, 384, hd * 96 + 64, b0, tok, fq);
        }
        __builtin_amdgcn_sched_barrier(0);
      }
    if (fbase >= 1664 && fbase < 2176) {
      float v = dnorm * 4.f;
#pragma unroll
      for (int mk = 32; mk >= 1; mk >>= 1) v = fmaxf(v, __shfl_xor(v, mk));
      if ((opaque_tid() & 63) == 0) atomicMax((unsigned*)(ws + OFF_BAR) + 128 + layer * 2 + (fbase >= 1920 ? 1 : 0), __float_as_uint(v));
    }
  }
};
struct SimpleOrder {
  int nN, nwg, G, c;
  DI bool next(int i, pg8::Unit& u) const {
    const int L = i * G + c;
    if (L >= nwg) return false;
    const int rest = L >> 4;
    u.pn = rest % nN;
    u.pm = (rest / nN) * 16 + (L & 15);
    return true;
  }
  DI void a_ready(const pg8::Unit&) const {}
  DI void done(const pg8::Unit&) const {}
};
template <int N, int K, int LD, class Epi>
DI void gemm8_phase(const u16* X, const u16* Wt, const Epi& E, char* smem) {
  pg8::Gemm g; g.A = X; g.Bt = Wt; g.M = T; g.N = N; g.K = K; g.ld = LD;
  int bid_ = (int)blockIdx.x; asm volatile("" : "+s"(bid_));
  SimpleOrder S; S.nN = N / 256; S.nwg = (T / 256) * (N / 256); S.G = (int)gridDim.x; S.c = bid_;
  pg8::gemm_phase<Epi, SimpleOrder, false, K, LD>((PG8_LAS unsigned char*)smem, g, S, E, nullptr);
}

template <int DQK, int NCOMP, bool BAND, int EPI, bool NOMAX = false>
DI void attn_item(const u16* __restrict__ Q, int ldq, const u16* __restrict__ Kp, int ldk, const u16* __restrict__ Vt,
                  int qtok0, int kbeg, int kend, float sc_l2, float sink_l2, float lam, float onorm,
                  const float* __restrict__ subg, u16* __restrict__ O, float* __restrict__ DS, char* smem) {
  constexpr int DC = DQK / NCOMP;
  constexpr int KS = DC / 16;
  constexpr int KEYS = (NCOMP == 1) ? 128 : 64;
  constexpr int KSTR = DQK + 8, VSTR = KEYS + 8;
  constexpr int KCH = DQK / 8, VCH = KEYS / 8;
  constexpr int NKC = KEYS * KCH / NTHR, NVC = 64 * VCH / NTHR;
  constexpr int KSLOT = KEYS * KSTR, VSLOT = 64 * VSTR;
  u16* sK = (u16*)smem;
  u16* sV = sK + 3 * KSLOT;
  const int tid = opaque_tid(), lane = tid & 63, wave = tid >> 6, r = lane & 31, h = lane >> 5;
  const int qtok = qtok0 + wave * 32 + r;

  bf16x8 qf[NCOMP][KS];
#pragma unroll
  for (int c = 0; c < NCOMP; ++c)
#pragma unroll
    for (int ks = 0; ks < KS; ++ks) qf[c][ks] = *(const bf16x8*)(Q + (size_t)qtok * ldq + c * DC + ks * 16 + 8 * h);

  f32x16 Oa[NCOMP][2];
  float m[NCOMP], l[NCOMP];
#pragma unroll
  for (int c = 0; c < NCOMP; ++c) {
#pragma unroll
    for (int d = 0; d < 2; ++d)
#pragma unroll
      for (int v = 0; v < 16; ++v) Oa[c][d][v] = 0.f;
    m[c] = BAND ? sink_l2 : -1e30f;
    l[c] = (BAND && h == 0) ? 1.f : 0.f;
  }

  const u16* kg[NKC]; int kso[NKC];
#pragma unroll
  for (int i = 0; i < NKC; ++i) {
    const int c = tid + i * NTHR;
    const int row = c / KCH, cc = c % KCH;
    kg[i] = Kp + (size_t)(kbeg + row) * ldk + cc * 8;
    kso[i] = row * KSTR + cc * 8;
  }
  const u16* vg[NVC]; int vso[NVC];
#pragma unroll
  for (int i = 0; i < NVC; ++i) {
    const int c = tid + i * NTHR;
    const int row = c / VCH, cc = c % VCH;
    vg[i] = Vt + (size_t)(kbeg >> 7) * 8192 + row * 128 + cc * 8;
    vso[i] = row * VSTR + cc * 8;
  }
  u32x4 kreg[NKC], vreg[NVC];
  auto loadK = [&](int t) {
#pragma unroll
    for (int i = 0; i < NKC; ++i) kreg[i] = gld16(kg[i] + (size_t)t * KEYS * ldk);
  };
  auto loadV = [&](int t) {
#pragma unroll
    for (int i = 0; i < NVC; ++i) vreg[i] = gld16(vg[i] + (size_t)t * 8192);
  };
  auto waitK = [&]() {
    if constexpr (NKC == 1) wait_vm0(kreg[0]);
    else if constexpr (NKC == 2) wait_vm0(kreg[0], kreg[1]);
    else wait_vm0(kreg[0], kreg[1], kreg[2]);
  };
  auto waitV = [&]() {
    if constexpr (NVC == 1) wait_vm0(vreg[0]);
    else wait_vm0(vreg[0], vreg[1]);
  };
  auto storeK = [&](int slot) {
#pragma unroll
    for (int i = 0; i < NKC; ++i) *(u32x4*)(sK + slot * KSLOT + kso[i]) = kreg[i];
  };
  auto storeV = [&](int slot) {
#pragma unroll
    for (int i = 0; i < NVC; ++i) *(u32x4*)(sV + slot * VSLOT + vso[i]) = vreg[i];
  };

  f32x16 S0[2], S1[2];
  bf16x8 pfA[2][2], pfB[2][2];
  float alpha_pend = 1.f;
  bool need_pend = false;

  auto att_S = [&](auto uu_t, f32x16 (&S)[2], int slot) {
    constexpr int UU = decltype(uu_t)::value;
    constexpr int C = (NCOMP == 2) ? UU : 0;
    const u16* base = sK + slot * KSLOT + ((NCOMP == 1 ? UU * 64 : 0) + r) * KSTR + (NCOMP == 2 ? UU * DC : 0) + 8 * h;
#pragma unroll
    for (int kb = 0; kb < 2; ++kb) {
#pragma unroll
      for (int v = 0; v < 16; ++v) S[kb][v] = 0.f;
#pragma unroll
      for (int ks = 0; ks < KS; ++ks) {
        bf16x8 kf = *(const bf16x8*)(base + kb * 32 * KSTR + ks * 16);
        S[kb] = MFMA32(kf, qf[C][ks], S[kb]);
      }
    }
  };
  auto att_PV = [&](auto uu_t, const bf16x8 (&pf)[2][2], int slot) {
    constexpr int UU = decltype(uu_t)::value;
    constexpr int C = (NCOMP == 2) ? UU : 0;
    const u16* base = sV + slot * VSLOT + r * VSTR + (NCOMP == 1 ? UU * 64 : 0) + 8 * h;
#pragma unroll
    for (int d = 0; d < 2; ++d)
#pragma unroll
      for (int kb = 0; kb < 2; ++kb)
#pragma unroll
        for (int s = 0; s < 2; ++s) {
          bf16x8 vf = *(const bf16x8*)(base + d * 32 * VSTR + kb * 32 + 16 * s);
          Oa[C][d] = MFMA32(vf, pf[kb][s], Oa[C][d]);
        }
  };
  auto att_rescale = [&](auto uu_t) {
    constexpr int UU = decltype(uu_t)::value;
    constexpr int C = (NCOMP == 2) ? UU : 0;
    if (need_pend) {
#pragma unroll
      for (int d = 0; d < 2; ++d)
#pragma unroll
        for (int v = 0; v < 16; ++v) Oa[C][d][v] *= alpha_pend;
    }
  };
  auto att_softmax = [&](auto uu_t, f32x16 (&S)[2], bf16x8 (&pf)[2][2], int kpos0) {
    constexpr int UU = decltype(uu_t)::value;
    constexpr int C = (NCOMP == 2) ? UU : 0;
    if constexpr (BAND) {
#pragma unroll
      for (int kb = 0; kb < 2; ++kb)
#pragma unroll
        for (int v = 0; v < 16; ++v) {
          const int d = kpos0 + kb * 32 + crow(v, h) - qtok;
          if (d > 128 || d < -128) S[kb][v] = -1e30f;
        }
    }
    if constexpr (NOMAX) {
      float rsum = 0.f;
#pragma unroll
      for (int kb = 0; kb < 2; ++kb)
#pragma unroll
        for (int v = 0; v < 16; ++v) {
          float p = __builtin_amdgcn_exp2f(S[kb][v]);
          S[kb][v] = p;
          rsum += p;
        }
      l[C] += rsum;
      need_pend = false;
#pragma unroll
      for (int kb = 0; kb < 2; ++kb)
#pragma unroll
        for (int s = 0; s < 2; ++s) {
          u32x4 pk;
          pk.x = pk2(S[kb][8 * s + 0], S[kb][8 * s + 1]);
          pk.y = pk2(S[kb][8 * s + 2], S[kb][8 * s + 3]);
          pk.z = pk2(S[kb][8 * s + 4], S[kb][8 * s + 5]);
          pk.w = pk2(S[kb][8 * s + 6], S[kb][8 * s + 7]);
          pf[kb][s] = __builtin_bit_cast(bf16x8, pk);
        }
      return;
    }
    float mx = S[0][0];
#pragma unroll
    for (int kb = 0; kb < 2; ++kb)
#pragma unroll
      for (int v = 0; v < 16; ++v) mx = fmaxf(mx, S[kb][v]);
    {
      const unsigned mu = __float_as_uint(mx);
      const auto sw = __builtin_amdgcn_permlane32_swap(mu, mu, false, false);
      mx = fmaxf(__uint_as_float(sw[0]), __uint_as_float(sw[1]));
    }
    const float mold = m[C];
    const float mcand = fmaxf(mold, mx * sc_l2);
    const bool grow = __builtin_amdgcn_ballot_w64(mcand > mold + 6.0f) != 0;
    const float mnew = grow ? mcand : mold;
    need_pend = grow;
    alpha_pend = __builtin_amdgcn_exp2f(mold - mnew);
    m[C] = mnew;
    float rsum = 0.f;
#pragma unroll
    for (int kb = 0; kb < 2; ++kb)
#pragma unroll
      for (int v = 0; v < 16; ++v) {
        float p = __builtin_amdgcn_exp2f(__builtin_fmaf(S[kb][v], sc_l2, -mnew));
        S[kb][v] = p;
        rsum += p;
      }
    l[C] = l[C] * alpha_pend + rsum;
#pragma unroll
    for (int kb = 0; kb < 2; ++kb)
#pragma unroll
      for (int s = 0; s < 2; ++s) {
        u32x4 pk;
        pk.x = pk2(S[kb][8 * s + 0], S[kb][8 * s + 1]);
        pk.y = pk2(S[kb][8 * s + 2], S[kb][8 * s + 3]);
        pk.z = pk2(S[kb][8 * s + 4], S[kb][8 * s + 5]);
        pk.w = pk2(S[kb][8 * s + 6], S[kb][8 * s + 7]);
        pf[kb][s] = __builtin_bit_cast(bf16x8, pk);
      }
  };
  using U0 = std::integral_constant<int, 0>;
  using U1 = std::integral_constant<int, 1>;

  const int ntl = (kend - kbeg) / KEYS;
  auto step = [&](auto first_t, auto lk_t, auto lv_t, int t, int sa, int sb, int sc) {
    constexpr bool FIRST = decltype(first_t)::value, LK = decltype(lk_t)::value, LV = decltype(lv_t)::value;
    if constexpr (LK) loadK(t + 2);
    if constexpr (LV) loadV(t + 1);
    if constexpr (!FIRST) att_rescale(U1{});
    att_S(U1{}, S1, sa);
    if constexpr (!FIRST) att_PV(U1{}, pfB, sc);
    att_softmax(U0{}, S0, pfA, kbeg + t * KEYS);
    att_rescale(U0{});
    if constexpr (LV) att_S(U0{}, S0, sb);
    att_PV(U0{}, pfA, sa);
    att_softmax(U1{}, S1, pfB, kbeg + t * KEYS + 64);
    if constexpr (LK) { waitK(); storeK(sc); }
    if constexpr (LV) { waitV(); storeV(sb); }
    __syncthreads();
  };
  using TT = std::true_type;
  using FF = std::false_type;

  loadK(0); loadV(0);
  waitK(); waitV();
  storeK(0); storeV(0);
  loadK(1);
  waitK();
  storeK(1);
  __syncthreads();
  att_S(U0{}, S0, 0);
  int sa = 0, sb = 1, sc = 2;
  step(TT{}, TT{}, TT{}, 0, sa, sb, sc);
  { int tmp = sa; sa = sb; sb = sc; sc = tmp; }
  for (int t = 1; t < ntl - 2; ++t) {
    step(FF{}, TT{}, TT{}, t, sa, sb, sc);
    int tmp = sa; sa = sb; sb = sc; sc = tmp;
  }
  step(FF{}, FF{}, TT{}, ntl - 2, sa, sb, sc);
  { int tmp = sa; sa = sb; sb = sc; sc = tmp; }
  step(FF{}, FF{}, FF{}, ntl - 1, sa, sb, sc);
  att_rescale(U1{});
  att_PV(U1{}, pfB, sa);

  float inv[NCOMP];
#pragma unroll
  for (int c = 0; c < NCOMP; ++c) {
    float lt = l[c] + __shfl_xor(l[c], 32);
    inv[c] = 1.f / lt;
  }
  if constexpr (EPI == 1) {
#pragma unroll
    for (int d = 0; d < 2; ++d)
#pragma unroll
      for (int vq = 0; vq < 4; ++vq) {
        float4 o = {Oa[0][d][4 * vq] * inv[0], Oa[0][d][4 * vq + 1] * inv[0], Oa[0][d][4 * vq + 2] * inv[0], Oa[0][d][4 * vq + 3] * inv[0]};
        *(float4*)(DS + (size_t)qtok * 256 + d * 32 + 8 * vq + 4 * h) = o;
      }
  } else {
    if constexpr (EPI == 2) {
      float ss = 0.f;
#pragma unroll
      for (int d = 0; d < 2; ++d)
#pragma unroll
        for (int vq = 0; vq < 4; ++vq) {
          const float4 o1 = *(const float4*)(DS + (size_t)qtok * 256 + d * 32 + 8 * vq + 4 * h);
          const float a0 = o1.x - lam * Oa[0][d][4 * vq] * inv[0];
          const float a1 = o1.y - lam * Oa[0][d][4 * vq + 1] * inv[0];
          const float a2 = o1.z - lam * Oa[0][d][4 * vq + 2] * inv[0];
          const float a3 = o1.w - lam * Oa[0][d][4 * vq + 3] * inv[0];
          Oa[0][d][4 * vq] = a0; Oa[0][d][4 * vq + 1] = a1; Oa[0][d][4 * vq + 2] = a2; Oa[0][d][4 * vq + 3] = a3;
          ss += a0 * a0 + a1 * a1 + a2 * a2 + a3 * a3;
        }
      ss += __shfl_xor(ss, 32);
      const float rs = rsqrtf(ss * (1.f / 64.f) + EPS) * onorm;
#pragma unroll
      for (int d = 0; d < 2; ++d)
#pragma unroll
        for (int v = 0; v < 16; ++v) Oa[0][d][v] *= rs * subg[d * 32 + crow(v, h)];
    } else {
#pragma unroll
      for (int d = 0; d < 2; ++d)
#pragma unroll
        for (int v = 0; v < 16; ++v) Oa[0][d][v] *= inv[0];
    }
    store_rows(O, KP1, 0, Oa[0][0], qtok, h);
    store_rows(O, KP1, 32, Oa[0][1], qtok, h);
  }
  __syncthreads();
}

DI void attn_phase(const Params& P, int layer, char* smem) {
  char* ws = P.ws;
  u16* qkv = (u16*)(ws + OFF_QKV);
  u16* BR = (u16*)(ws + OFF_XN);
  const float L2E = 1.4426950408889634f;
  const float lambda_init = 0.8f - 0.6f * __expf(-0.3f * (float)layer);
  float lam;
  {
    const float* dl = P.d_lambda + layer * 128;
    float s1 = 0.f, s2 = 0.f;
    for (int i = 0; i < 32; ++i) { s1 += dl[i] * dl[32 + i]; s2 += dl[64 + i] * dl[96 + i]; }
    lam = __expf(s1) - __expf(s2) + lambda_init;
    lam = __int_as_float(__builtin_amdgcn_readfirstlane(__float_as_int(lam)));
  }
  const float onorm_u = __int_as_float(__builtin_amdgcn_readfirstlane(__float_as_int(1.f - lambda_init)));
  bool a_nomax;
  {
    const float* ag = P.a_qk_norm + layer * 128;
    float gq = 0.f, gk = 0.f;
    for (int i = 0; i < 64; ++i) { gq = fmaxf(gq, fabsf(ag[i])); gk = fmaxf(gk, fabsf(ag[64 + i])); }
    const float bound = 64.f * gq * gk * (0.125f * L2E);
    a_nomax = __builtin_amdgcn_readfirstlane((int)(bound < 60.f)) != 0;
  }
  bool d_nomax;
  {
    const unsigned* nb = (const unsigned*)(ws + OFF_BAR) + 128 + layer * 2;
    const float q2 = __uint_as_float(__hip_atomic_load(nb, __ATOMIC_RELAXED, __HIP_MEMORY_SCOPE_AGENT));
    const float k2 = __uint_as_float(__hip_atomic_load(nb + 1, __ATOMIC_RELAXED, __HIP_MEMORY_SCOPE_AGENT));
    const float bound = sqrtf(q2 * k2) * (0.17677669529663687f * L2E);
    d_nomax = __builtin_amdgcn_readfirstlane((int)(bound < 60.f)) != 0;
  }
  for (int it = blockIdx.x; it < 2048; it += gridDim.x) {
    const int cls = it >> 8;
    if (cls < 6) {
      const int idx = it & 255;
      const int head = (idx & 7) >> 1;
      const int qb = ((idx >> 3) << 1) + (idx & 1);
      int qtok0, kbeg, kend;
      if (cls < 3) { qtok0 = qb * 256; kbeg = 0; kend = SEQ0; }
      else { const int s = qb >> 3; kbeg = SEQ0 + s * DSEQ; kend = kbeg + DSEQ; qtok0 = kbeg + (qb & 7) * 256; }
      const int typ = cls % 3;
      if (typ == 0) {
        float* DS = (float*)(ws + OFF_DS) + head * 64;
        if (d_nomax) {
          attn_item<32, 1, false, 1, true>(qkv + Q_QD + head * 64, 256, qkv + Q_KD + head * 64, 256,
                                           qkv + Q_VTD + (size_t)head * 64 * T, qtok0, kbeg, kend,
                                           1.f, 0.f, lam, onorm_u, P.d_subln + layer * 64, BR + 768 + head * 64, DS, smem);
          attn_item<32, 1, false, 2, true>(qkv + Q_QD + head * 64 + 32, 256, qkv + Q_KD + head * 64 + 32, 256,
                                           qkv + Q_VTD + (size_t)head * 64 * T, qtok0, kbeg, kend,
                                           1.f, 0.f, lam, onorm_u, P.d_subln + layer * 64, BR + 768 + head * 64, DS, smem);
        } else {
          attn_item<32, 1, false, 1, false>(qkv + Q_QD + head * 64, 256, qkv + Q_KD + head * 64, 256,
                                            qkv + Q_VTD + (size_t)head * 64 * T, qtok0, kbeg, kend,
                                            1.f, 0.f, lam, onorm_u, P.d_subln + layer * 64, BR + 768 + head * 64, DS, smem);
          attn_item<32, 1, false, 2, false>(qkv + Q_QD + head * 64 + 32, 256, qkv + Q_KD + head * 64 + 32, 256,
                                            qkv + Q_VTD + (size_t)head * 64 * T, qtok0, kbeg, kend,
                                            1.f, 0.f, lam, onorm_u, P.d_subln + layer * 64, BR + 768 + head * 64, DS, smem);
        }
      } else if (typ == 1) {
        attn_item<96, 1, false, 0>(qkv + Q_QC + head * 96, 384, qkv + Q_KC + head * 96, 384,
                                       qkv + Q_VTC + (size_t)head * 64 * T, qtok0, kbeg, kend,
                                       0.10206207261596577f * L2E, 0.f, 0.f, 1.f, nullptr, BR + 512 + head * 64, nullptr, smem);
      } else {
        if (a_nomax)
          attn_item<64, 1, false, 0, true>(qkv + Q_QA + head * 64, 256, qkv + Q_KA + (head >> 1) * 64, 128,
                                           qkv + Q_VTA + (size_t)(head >> 1) * 64 * T, qtok0, kbeg, kend,
                                           1.f, 0.f, 0.f, 1.f, nullptr, BR + head * 64, nullptr, smem);
        else
          attn_item<64, 1, false, 0, false>(qkv + Q_QA + head * 64, 256, qkv + Q_KA + (head >> 1) * 64, 128,
                                            qkv + Q_VTA + (size_t)(head >> 1) * 64 * T, qtok0, kbeg, kend,
                                            1.f, 0.f, 0.f, 1.f, nullptr, BR + head * 64, nullptr, smem);
      }
    } else {
      const int idx = it - 1536;
      const int head = (idx & 7) >> 1;
      const int qbg = ((idx >> 3) << 1) + (idx & 1);
      const int qtok0 = qbg * 256;
      int sb, se;
      if (qtok0 < SEQ0) { sb = 0; se = SEQ0; }
      else { sb = SEQ0 + ((qtok0 - SEQ0) / DSEQ) * DSEQ; se = sb + DSEQ; }
      const int kbeg = max(sb, qtok0 - 128), kend = min(se, qtok0 + 256 + 128);
      const float sink = P.b_sink[layer * 4 + head];
      attn_item<64, 1, true, 0>(qkv + Q_QB + head * 64, 256, qkv + Q_KB + (head >> 1) * 64, 128,
                                    qkv + Q_VTB + (size_t)(head >> 1) * 64 * T, qtok0, kbeg, kend,
                                    0.125f * L2E, sink * L2E, 0.f, 1.f, nullptr, BR + 256 + head * 64, nullptr, smem);
    }
  }
}

DI void ew_phase(const Params& P, const u16* __restrict__ Y, float coef, const float* __restrict__ gpost,
                 const float* __restrict__ gnext, bool from_inputs) {
  const int tid = opaque_tid();
  const int lane = tid & 63, wave = tid >> 6;
  u16* XN = (u16*)(P.ws + OFF_XN);
  u16* XB = (u16*)(P.ws + OFF_XB);
  for (int tok = blockIdx.x * 8 + wave; tok < T; tok += gridDim.x * 8) {
    float4 x[4];
    if (from_inputs) {
      const float* xs = tok < SEQ0 ? P.x_prompt + (size_t)tok * DM : P.x_sample + (size_t)(tok - SEQ0) * DM;
#pragma unroll
      for (int i = 0; i < 4; ++i) x[i] = *(const float4*)(xs + (i * 64 + lane) * 4);
    } else {
#pragma unroll
      for (int i = 0; i < 4; ++i) {
        const uint2 xb = *(const uint2*)(XB + (size_t)tok * DM + (i * 64 + lane) * 4);
        x[i] = make_float4(bf2f(xb.x & 0xffffu), bf2f(xb.x >> 16), bf2f(xb.y & 0xffffu), bf2f(xb.y >> 16));
      }
    }
    if (Y) {
      float4 y[4];
      float ss = 0.f;
#pragma unroll
      for (int i = 0; i < 4; ++i) {
        const uint2 yb = *(const uint2*)(Y + (size_t)tok * KP1 + (i * 64 + lane) * 4);
        y[i] = make_float4(bf2f(yb.x & 0xffffu), bf2f(yb.x >> 16), bf2f(yb.y & 0xffffu), bf2f(yb.y >> 16));
        ss += y[i].x * y[i].x + y[i].y * y[i].y + y[i].z * y[i].z + y[i].w * y[i].w;
      }
      ss = wave_sum(ss);
      const float rs = rsqrtf(ss * (1.f / 1024.f) + EPS) * coef;
#pragma unroll
      for (int i = 0; i < 4; ++i) {
        float4 g = *(const float4*)(gpost + (i * 64 + lane) * 4);
        x[i].x += y[i].x * rs * g.x; x[i].y += y[i].y * rs * g.y;
        x[i].z += y[i].z * rs * g.z; x[i].w += y[i].w * rs * g.w;
      }
    }
    if (!gnext) {
#pragma unroll
      for (int i = 0; i < 4; ++i) *(float4*)(P.out + (size_t)tok * DM + (i * 64 + lane) * 4) = x[i];
    } else {
#pragma unroll
      for (int i = 0; i < 4; ++i) {
        uint2 pk;
        pk.x = pk2(x[i].x, x[i].y);
        pk.y = pk2(x[i].z, x[i].w);
        *(uint2*)(XB + (size_t)tok * DM + (i * 64 + lane) * 4) = pk;
      }
    }
    if (gnext) {
      float ss = 0.f;
#pragma unroll
      for (int i = 0; i < 4; ++i) ss += x[i].x * x[i].x + x[i].y * x[i].y + x[i].z * x[i].z + x[i].w * x[i].w;
      ss = wave_sum(ss);
      const float rs = rsqrtf(ss * (1.f / 1024.f) + EPS);
#pragma unroll
      for (int i = 0; i < 4; ++i) {
        float4 g = *(const float4*)(gnext + (i * 64 + lane) * 4);
        uint2 pk;
        pk.x = pk2(x[i].x * rs * g.x, x[i].y * rs * g.y);
        pk.y = pk2(x[i].z * rs * g.z, x[i].w * rs * g.w);
        *(uint2*)(XN + (size_t)tok * KP1 + (i * 64 + lane) * 4) = pk;
      }
    }
  }
}

DI int colmap(int mode, int n, int nsrc) {
  if (mode == 1) { return ((n >> 7) & 1) * DFF + (n >> 8) * 128 + (n & 127); }
  if (mode == 2) {
    if (n < 2560) {
      const int w = n & 255;
      n = (n & ~255) + ((w >> 5) & 3) * 64 + (w >> 7) * 32 + (w & 31);
    }
    if (n < 1664) return n;
    if (n < 2432) return n + 32;
    if (n < 2464) return n - 2432 + 1664;
    if (n < 2560) return -1;
    return n - 96;
  }
  return n < nsrc ? n : -1;
}
DI void conv_job(u16* __restrict__ dst, int ldd, const float* __restrict__ src, int Nd, int K, int lds, int mode,
                 const float* __restrict__ kscale) {
  const int total = Nd * (K >> 3);
  const int gthreads = gridDim.x * NTHR;
  for (int idx = blockIdx.x * NTHR + opaque_tid(); idx < total; idx += gthreads) {
    const int n = idx % Nd, k8 = idx / Nd;
    const int col = colmap(mode, n, lds);
    float v[8];
#pragma unroll
    for (int j = 0; j < 8; ++j) {
      float x = 0.f;
      if (col >= 0) {
        x = src[(size_t)(k8 * 8 + j) * lds + col];
        if (kscale) x *= kscale[k8 * 8 + j];
      }
      v[j] = x;
    }
    uint4 pk = {pk2(v[0], v[1]), pk2(v[2], v[3]), pk2(v[4], v[5]), pk2(v[6], v[7])};
    *(uint4*)(dst + (size_t)n * ldd + k8 * 8) = pk;
  }
}
DI void convert_layer(const Params& P, int l) {
  u16* W = (u16*)(P.ws + OFF_W);
  for (int s = 0; s < 2; ++s) {
    conv_job(W + W_WI + (size_t)s * 5632 * KP1, KP1, P.ffn_wi + ((size_t)l * 2 + s) * 1024 * 5632, 5632, 1024, 5632, 1, nullptr);
    conv_job(W + W_WO + (size_t)s * 1024 * KP2, KP2, P.ffn_wo + ((size_t)l * 2 + s) * 2816 * 1024, 1024, 2816, 1024, 0, nullptr);
  }
  conv_job(W + W_WIN, KP1, P.w_in + (size_t)l * 1024 * NPROJ, 6656, 1024, NPROJ, 2, nullptr);
  conv_job(W + W_WUQ, 384, P.c_w_uq + (size_t)l * 384 * 384, 512, 384, 384, 0, P.c_q_norm + l * 384);
  conv_job(W + W_WUKV, 256, P.c_w_ukv + (size_t)l * 256 * 512, 512, 256, 512, 0, P.c_kv_norm + l * 256);
  conv_job(W + W_WB, KP1, P.w_branch + (size_t)l * 1024 * 1024, 1024, 1024, 1024, 0, nullptr);
  conv_job(W + W_WOUT, KP1, P.w_out + (size_t)l * 1024 * 1024, 1024, 1024, 1024, 0, nullptr);
}
DI void rope_tables(const Params& P) {
  float2* R64 = (float2*)(P.ws + OFF_R64);
  float2* R32 = (float2*)(P.ws + OFF_R32);
  const int gthreads = gridDim.x * NTHR;
  for (int idx = blockIdx.x * NTHR + opaque_tid(); idx < 16384 * 48; idx += gthreads) {
    int pos, f; double base; float2* dst;
    if (idx < 16384 * 32) { pos = idx >> 5; f = idx & 31; base = 0.7498942093324559; dst = R64 + idx; }
    else { const int i2 = idx - 16384 * 32; pos = i2 >> 4; f = i2 & 15; base = 0.5623413251903491; dst = R32 + i2; }
    double inv = 1.0;
    for (int k = 0; k < f; ++k) inv *= base;
    const float ang = (float)pos * (float)inv;
    double tr = (double)ang * 0.15915494309189535;
    tr -= rint(tr);
    const float tf = (float)tr;
    *dst = make_float2(__builtin_amdgcn_cosf(tf), __builtin_amdgcn_sinf(tf));
  }
}

DI void fast_grid_barrier(unsigned* bar, unsigned nblk) {
  asm volatile("s_waitcnt vmcnt(0) lgkmcnt(0)" ::: "memory");
  __syncthreads();
  if (threadIdx.x == 0) {
    __builtin_amdgcn_fence(__ATOMIC_RELEASE, "agent");
    asm volatile("s_waitcnt vmcnt(0) lgkmcnt(0)" ::: "memory");
    const unsigned gen = __hip_atomic_load(&bar[64], __ATOMIC_RELAXED, __HIP_MEMORY_SCOPE_AGENT);
    const unsigned old = __hip_atomic_fetch_add(&bar[0], 1u, __ATOMIC_RELAXED, __HIP_MEMORY_SCOPE_AGENT);
    if (old == nblk - 1u) {
      __hip_atomic_store(&bar[0], 0u, __ATOMIC_RELAXED, __HIP_MEMORY_SCOPE_AGENT);
      __hip_atomic_fetch_add(&bar[64], 1u, __ATOMIC_RELEASE, __HIP_MEMORY_SCOPE_AGENT);
    } else {
      while (__hip_atomic_load(&bar[64], __ATOMIC_RELAXED, __HIP_MEMORY_SCOPE_AGENT) == gen) __builtin_amdgcn_s_sleep(1);
    }
    __builtin_amdgcn_fence(__ATOMIC_ACQUIRE, "agent");
    asm volatile("s_waitcnt vmcnt(0) lgkmcnt(0)" ::: "memory");
  }
  __syncthreads();
}

__global__ void __launch_bounds__(NTHR) __attribute__((amdgpu_waves_per_eu(2, 2))) mega(Params P) {
  extern __shared__ __attribute__((aligned(16))) char smem[];
  cg::grid_group grid = cg::this_grid();
  int phase = 0;
#if MULTI_LAUNCH
#define ACTIVE() (phase >= P.phase_lo && phase < P.phase_hi)
#define SEAM() do { ++phase; } while (0)
#else
#define ACTIVE() (true)
#define SEAM() do { ++phase; if (phase == 1) grid.sync(); else fast_grid_barrier((unsigned*)(P.ws + OFF_BAR), gridDim.x); } while (0)
#endif
  u16* W = (u16*)(P.ws + OFF_W);
  u16* XN = (u16*)(P.ws + OFF_XN);
  u16* R2 = (u16*)(P.ws + OFF_R2);
  u16* qkv = (u16*)(P.ws + OFF_QKV);
  const u16* Y = qkv + Q_Y;
#define PTRS

  if (ACTIVE()) { PTRS
    rope_tables(P);
    convert_layer(P, 0);
    ew_phase(P, nullptr, 0.f, nullptr, P.norm_g, true);
  }
  SEAM();
  for (int l = 0; l < 4; ++l) {
    const float* g = P.norm_g + (size_t)l * 6 * DM;
    if (ACTIVE()) { PTRS gemm8_phase<5632, DM, KP1>(XN, W + W_WI, EpiFfnUp8{R2}, smem); }
    SEAM();
    if (ACTIVE()) { PTRS gemm8_phase<1024, DFF, KP2>(R2, W + W_WO, EpiY8{qkv + Q_Y}, smem); }
    SEAM();
    if (ACTIVE()) { PTRS ew_phase(P, Y, 0.5f, g + DM, g + 2 * DM, false); }
    SEAM();
    if (ACTIVE()) { PTRS
      gemm8_phase<2560, DM, KP1>(XN, W + W_WIN, EpiProj8{&P, l}, smem);
      gemm8_phase<4096, DM, KP1>(XN, W + W_WIN + 2560ull * KP1, EpiGate8{(unsigned char*)R2}, smem);
    }
    SEAM();
    if (ACTIVE()) { PTRS
      gemm_phase<M_CUQ, 4>(W + W_WUQ, 384, qkv + Q_CQ, 384, 384, 2, smem, P, l);
      gemm_phase<M_CUKV, 4>(W + W_WUKV, 256, qkv + Q_CKV, 256, 256, 2, smem, P, l);
    }
    SEAM();
    if (ACTIVE()) { PTRS attn_phase(P, l, smem); }
    SEAM();
    if (ACTIVE()) { PTRS gemm_phase<M_MERGE, 2>(W + W_WB, KP1, XN, KP1, DM, 4, smem, P, l); }
    SEAM();
    if (ACTIVE()) { PTRS gemm8_phase<1024, DM, KP1>(qkv + Q_MERGED, W + W_WOUT, EpiY8{qkv + Q_Y}, smem); }
    SEAM();
    if (ACTIVE()) { PTRS ew_phase(P, Y, 1.0f, g + 3 * DM, g + 4 * DM, false); }
    SEAM();
    if (ACTIVE()) { PTRS gemm8_phase<5632, DM, KP1>(XN, W + W_WI + 5632ull * KP1, EpiFfnUp8{R2}, smem); }
    SEAM();
    if (ACTIVE()) { PTRS gemm8_phase<1024, DFF, KP2>(R2, W + W_WO + 1024ull * KP2, EpiY8{qkv + Q_Y}, smem); }
    SEAM();
    if (ACTIVE()) { PTRS
      ew_phase(P, Y, 0.5f, g + 5 * DM, l < 3 ? g + 6 * DM : nullptr, false);
      if (l < 3) convert_layer(P, l + 1);
    }
    SEAM();
  }
}

constexpr int N_PHASES = 1 + 12 * 4;

extern "C" void kernel_launch(void* const* d_in, const int* in_sizes, int n_in, void* d_out, int out_size, void* d_ws,
                              size_t ws_size, hipStream_t stream) {
  static int grid_blocks = 0;
  if (!grid_blocks) {
    int dev = 0, cus = 0, per_cu = 0;
    hipGetDevice(&dev);
    hipDeviceGetAttribute(&cus, hipDeviceAttributeMultiprocessorCount, dev);
    hipFuncSetAttribute((const void*)mega, hipFuncAttributeMaxDynamicSharedMemorySize, SMEM_BYTES);
    hipOccupancyMaxActiveBlocksPerMultiprocessor(&per_cu, mega, NTHR, SMEM_BYTES);
    if (per_cu < 1) per_cu = 1;
    grid_blocks = cus * per_cu;
  }
  if (ws_size < WS_NEEDED) fprintf(stderr, "workspace too small: %zu < %zu\n", ws_size, (size_t)WS_NEEDED);
  Params P{};
  P.x_prompt = (const float*)d_in[0]; P.x_sample = (const float*)d_in[1]; P.norm_g = (const float*)d_in[2];
  P.w_in = (const float*)d_in[3]; P.a_qk_norm = (const float*)d_in[4]; P.b_sink = (const float*)d_in[5];
  P.c_q_norm = (const float*)d_in[6]; P.c_kv_norm = (const float*)d_in[7]; P.c_w_uq = (const float*)d_in[8];
  P.c_w_ukv = (const float*)d_in[9]; P.d_lambda = (const float*)d_in[10]; P.d_subln = (const float*)d_in[11];
  P.w_branch = (const float*)d_in[12]; P.w_out = (const float*)d_in[13]; P.ffn_wi = (const float*)d_in[14];
  P.ffn_wo = (const float*)d_in[15];
  P.out = (float*)d_out; P.ws = (char*)d_ws;
#if MULTI_LAUNCH
  for (int ph = 0; ph < N_PHASES; ++ph) {
    P.phase_lo = ph; P.phase_hi = ph + 1; P.coop = 0; P.pad0 = 0;
    hipLaunchKernelGGL(mega, dim3(grid_blocks), dim3(NTHR), SMEM_BYTES, stream, P);
  }
#else
  P.phase_lo = 0; P.phase_hi = 1 << 30; P.coop = 1; P.pad0 = 0;
  hipMemsetAsync((char*)d_ws + OFF_BAR, 0, 1024, stream);
  void* args[] = {&P};
  hipError_t e = hipLaunchCooperativeKernel((const void*)mega, dim3(grid_blocks), dim3(NTHR), args, SMEM_BYTES, stream);
  if (e != hipSuccess) fprintf(stderr, "cooperative launch failed: %s (grid %d)\n", hipGetErrorString(e), grid_blocks);
#endif
}
```

```cpp
#include <hip/hip_runtime.h>
#include <hip/hip_cooperative_groups.h>
#include <cstdio>
#include <cstdint>
#include <type_traits>
namespace cg = cooperative_groups;

#ifndef MULTI_LAUNCH
#define MULTI_LAUNCH 0
#endif

#define DI __device__ __forceinline__
typedef unsigned short u16;
typedef __attribute__((ext_vector_type(8))) short bf16x8;
typedef __attribute__((ext_vector_type(16))) float f32x16;
typedef __attribute__((ext_vector_type(2))) float f32x2_t;
typedef __attribute__((ext_vector_type(2))) __bf16 bf16x2_t;

constexpr int T = 32768;
constexpr int DM = 1024;
constexpr int DFF = 2816;
constexpr int KP1 = 1088;
constexpr int KP2 = 2880;
constexpr int GP = 4160;
constexpr int YP = 1040;
constexpr int NPROJ = 6560;
constexpr int SEQ0 = 16384;
constexpr int DSEQ = 2048;
constexpr float EPS = 1e-6f;
constexpr int NTHR = 512;
constexpr int LSTR = 72;
constexpr int SMEM_BYTES = 2 * 2 * 256 * LSTR * 2;

constexpr size_t W_WI = 0;
constexpr size_t W_WO = W_WI + 2ull * 5632 * KP1;
constexpr size_t W_WIN = W_WO + 2ull * 1024 * KP2;
constexpr size_t W_WUQ = W_WIN + 6656ull * KP1;
constexpr size_t W_WUKV = W_WUQ + 512ull * 384;
constexpr size_t W_WB = W_WUKV + 512ull * 256;
constexpr size_t W_WOUT = W_WB + 1024ull * KP1;
constexpr size_t W_TOTAL = W_WOUT + 1024ull * KP1;

constexpr size_t OFF_W = 0;
constexpr size_t OFF_XN = OFF_W + W_TOTAL * 2;
constexpr size_t OFF_R2 = OFF_XN + (size_t)T * KP1 * 2;
constexpr size_t OFF_QKV = OFF_R2 + (size_t)T * KP2 * 2;
constexpr size_t OFF_SS = OFF_QKV + (size_t)T * 3456 * 2;
constexpr size_t OFF_R64 = OFF_SS + (size_t)T * 20 * 4;
constexpr size_t OFF_R32 = OFF_R64 + 16384ull * 32 * 8;
constexpr size_t OFF_DS = OFF_R32 + 16384ull * 16 * 8;
constexpr size_t OFF_BAR = OFF_DS + (size_t)T * 256 * 4;
constexpr size_t OFF_XB = OFF_BAR + 1024;
constexpr size_t WS_NEEDED = OFF_XB + (size_t)T * 1024 * 2;

constexpr size_t Q_QA = 0;
constexpr size_t Q_KA = (size_t)T * 256;
constexpr size_t Q_VTA = (size_t)T * 384;
constexpr size_t Q_QB = (size_t)T * 512;
constexpr size_t Q_KB = (size_t)T * 768;
constexpr size_t Q_VTB = (size_t)T * 896;
constexpr size_t Q_CQ = (size_t)T * 1024;
constexpr size_t Q_CKV = (size_t)T * 1408;
constexpr size_t Q_QC = (size_t)T * 1664;
constexpr size_t Q_KC = (size_t)T * 2048;
constexpr size_t Q_VTC = (size_t)T * 2432;
constexpr size_t Q_QD = (size_t)T * 2688;
constexpr size_t Q_KD = (size_t)T * 2944;
constexpr size_t Q_VTD = (size_t)T * 3200;
constexpr size_t Q_MERGED = 0;
constexpr size_t Q_Y = (size_t)T * KP1;

struct Params {
  const float* x_prompt; const float* x_sample; const float* norm_g; const float* w_in;
  const float* a_qk_norm; const float* b_sink; const float* c_q_norm; const float* c_kv_norm;
  const float* c_w_uq; const float* c_w_ukv; const float* d_lambda; const float* d_subln;
  const float* w_branch; const float* w_out; const float* ffn_wi; const float* ffn_wo;
  float* out; char* ws;
  int phase_lo; int phase_hi; int coop; int pad0;
};

DI unsigned pk2(float a, float b) {
  f32x2_t v = {a, b};
  bf16x2_t r = __builtin_convertvector(v, bf16x2_t);
  return __builtin_bit_cast(unsigned, r);
}
DI u16 f2bf(float a) { return (u16)(pk2(a, 0.f) & 0xffffu); }
DI float bf2f(unsigned bits16) { return __uint_as_float(bits16 << 16); }
DI int crow(int v, int h) { return (v & 3) + 8 * (v >> 2) + 4 * h; }
DI int pos_of(int tok) { return tok < SEQ0 ? tok : ((tok - SEQ0) & (DSEQ - 1)); }
#define MFMA32(a, b, c) __builtin_amdgcn_mfma_f32_32x32x16_bf16((a), (b), (c), 0, 0, 0)

typedef __attribute__((ext_vector_type(4))) unsigned u32x4;
DI u32x4 gld16(const void* p) { u32x4 r; asm volatile("global_load_dwordx4 %0, %1, off" : "=v"(r) : "v"(p)); return r; }
DI void wait_vm0(u32x4& a) { asm volatile("s_waitcnt vmcnt(0)" : "+v"(a) :: "memory"); }
DI void wait_vm0(u32x4& a, u32x4& b) { asm volatile("s_waitcnt vmcnt(0)" : "+v"(a), "+v"(b) :: "memory"); }
DI void wait_vm0(u32x4& a, u32x4& b, u32x4& c) { asm volatile("s_waitcnt vmcnt(0)" : "+v"(a), "+v"(b), "+v"(c) :: "memory"); }
DI void wait_vm0(u32x4& a, u32x4& b, u32x4& c, u32x4& d) { asm volatile("s_waitcnt vmcnt(0)" : "+v"(a), "+v"(b), "+v"(c), "+v"(d) :: "memory"); }
DI u32x4 gld16s(unsigned voff, const void* sbase) { u32x4 r; asm volatile("global_load_dwordx4 %0, %1, %2" : "=v"(r) : "v"(voff), "s"(sbase)); return r; }
#define DEF_WAIT8(name, cnt) DI void name(u32x4& a, u32x4& b, u32x4& c, u32x4& d, u32x4& e, u32x4& f, u32x4& g, u32x4& h) { asm volatile("s_waitcnt vmcnt(" #cnt ")" : "+v"(a), "+v"(b), "+v"(c), "+v"(d), "+v"(e), "+v"(f), "+v"(g), "+v"(h) :: "memory"); }
#define DEF_WAIT6(name, cnt) DI void name(u32x4& a, u32x4& b, u32x4& c, u32x4& d, u32x4& e, u32x4& f) { asm volatile("s_waitcnt vmcnt(" #cnt ")" : "+v"(a), "+v"(b), "+v"(c), "+v"(d), "+v"(e), "+v"(f) :: "memory"); }
DEF_WAIT8(wait8_vm8, 8)
DEF_WAIT8(wait8_vm0, 0)
DEF_WAIT6(wait6_vm6, 6)
DEF_WAIT6(wait6_vm0, 0)
DI int opaque_tid() { int t = threadIdx.x; asm volatile("" : "+v"(t)); return t; }
DI float wave_sum(float v) {
#pragma unroll
  for (int m = 32; m >= 1; m >>= 1) v += __shfl_xor(v, m);
  return v;
}

DI void rope32_blk(f32x16& a, const float2* __restrict__ tab, int h) {
#pragma unroll
  for (int v = 0; v < 8; ++v) {
    float2 cs = tab[crow(v, h)];
    float x1 = a[v], x2 = a[v + 8];
    a[v] = x1 * cs.x - x2 * cs.y;
    a[v + 8] = x2 * cs.x + x1 * cs.y;
  }
}
DI void rope64_blk(f32x16& a0, f32x16& a1, const float2* __restrict__ tab, int h) {
#pragma unroll
  for (int v = 0; v < 16; ++v) {
    float2 cs = tab[crow(v, h)];
    float x1 = a0[v], x2 = a1[v];
    a0[v] = x1 * cs.x - x2 * cs.y;
    a1[v] = x2 * cs.x + x1 * cs.y;
  }
}
DI void store_rows(u16* __restrict__ base, int ld, int col0, const f32x16& a, int tok, int h, float sc = 1.f) {
#pragma unroll
  for (int vq = 0; vq < 4; ++vq) {
    uint2 pk;
    pk.x = pk2(a[4 * vq] * sc, a[4 * vq + 1] * sc);
    pk.y = pk2(a[4 * vq + 2] * sc, a[4 * vq + 3] * sc);
    *(uint2*)(base + (size_t)tok * ld + col0 + 8 * vq + 4 * h) = pk;
  }
}
DI void store_T(u16* __restrict__ base, int row0, const f32x16& a, int tok, int h) {
  const int tp = (tok & ~12) | ((tok & 4) << 1) | ((tok & 8) >> 1);
#pragma unroll
  for (int v = 0; v < 16; ++v) base[(size_t)((row0 + crow(v, h)) >> 6) * 64 * T + (size_t)(tp >> 7) * 8192 + ((row0 + crow(v, h)) & 63) * 128 + (tp & 127)] = f2bf(a[v]);
}

enum { M_FFNUP = 0, M_Y = 1, M_PROJ = 2, M_CUQ = 3, M_CUKV = 4, M_MERGE = 5, M_GATE = 6 };

template <int MODE, int NJ>
DI void gemm_epilogue(f32x16 (&acc)[2][NJ], int fbase, int tbase, int r, int h, const Params& P, int layer) {
  char* ws = P.ws;
  u16* qkv = (u16*)(ws + OFF_QKV);
  const float2* R64 = (const float2*)(ws + OFF_R64);
  const float2* R32 = (const float2*)(ws + OFF_R32);
  float* SS = (float*)(ws + OFF_SS);
  if constexpr (MODE == M_FFNUP) {
    u16* H = (u16*)(ws + OFF_R2);
    const int hf0 = (fbase >> 6) * 32;
#pragma unroll
    for (int j = 0; j < NJ; ++j) {
      const int tok = tbase + j * 32 + r;
      f32x16 o;
#pragma unroll
      for (int v = 0; v < 16; ++v) {
        float g = acc[0][j][v], u = acc[1][j][v];
        o[v] = g * __builtin_amdgcn_rcpf(1.f + __builtin_amdgcn_exp2f(-1.4426950408889634f * g)) * u;
      }
      store_rows(H, KP2, hf0, o, tok, h);
    }
  } else if constexpr (MODE == M_Y) {
    u16* Yb = qkv + Q_Y;
#pragma unroll
    for (int j = 0; j < NJ; ++j) {
      const int tok = tbase + j * 32 + r;
      store_rows(Yb, KP1, fbase, acc[0][j], tok, h);
      store_rows(Yb, KP1, fbase + 32, acc[1][j], tok, h);
    }
  } else if constexpr (MODE == M_PROJ) {
    if (fbase < 384) {
      const bool isK = fbase >= 256;
      const float* g = P.a_qk_norm + layer * 128 + (isK ? 64 : 0);
      u16* dst = qkv + (isK ? Q_KA : Q_QA);
      const int ld = isK ? 128 : 256;
      const int c0 = isK ? fbase - 256 : fbase;
      float gv[2][16];
#pragma unroll
      for (int i = 0; i < 2; ++i)
#pragma unroll
        for (int v = 0; v < 16; ++v) gv[i][v] = g[i * 32 + crow(v, h)];
#pragma unroll
      for (int j = 0; j < NJ; ++j) {
        const int tok = tbase + j * 32 + r;
        const int pos = pos_of(tok);
        float ss = 0.f;
#pragma unroll
        for (int i = 0; i < 2; ++i)
#pragma unroll
          for (int v = 0; v < 16; ++v) ss += acc[i][j][v] * acc[i][j][v];
        ss += __shfl_xor(ss, 32);
        const float rs = rsqrtf(ss * (1.f / 64.f) + EPS);
#pragma unroll
        for (int i = 0; i < 2; ++i)
#pragma unroll
          for (int v = 0; v < 16; ++v) acc[i][j][v] *= rs * gv[i][v];
        rope32_blk(acc[0][j], R32 + (size_t)(pos >> 6) * 16, h);
        rope32_blk(acc[1][j], R32 + (size_t)(pos & 63) * 16, h);
        store_rows(dst, ld, c0, acc[0][j], tok, h);
        store_rows(dst, ld, c0 + 32, acc[1][j], tok, h);
      }
    } else if (fbase < 512) {
#pragma unroll
      for (int j = 0; j < NJ; ++j) {
        const int tok = tbase + j * 32 + r;
        store_T(qkv + Q_VTA, fbase - 384, acc[0][j], tok, h);
        store_T(qkv + Q_VTA, fbase - 384 + 32, acc[1][j], tok, h);
      }
    } else if (fbase < 896) {
      const bool isK = fbase >= 768;
      u16* dst = qkv + (isK ? Q_KB : Q_QB);
      const int ld = isK ? 128 : 256;
      const int c0 = isK ? fbase - 768 : fbase - 512;
#pragma unroll
      for (int j = 0; j < NJ; ++j) {
        const int tok = tbase + j * 32 + r;
        const int pos = pos_of(tok);
        rope64_blk(acc[0][j], acc[1][j], R64 + (size_t)pos * 32, h);
        store_rows(dst, ld, c0, acc[0][j], tok, h);
        store_rows(dst, ld, c0 + 32, acc[1][j], tok, h);
      }
    } else if (fbase < 1024) {
#pragma unroll
      for (int j = 0; j < NJ; ++j) {
        const int tok = tbase + j * 32 + r;
        store_T(qkv + Q_VTB, fbase - 896, acc[0][j], tok, h);
        store_T(qkv + Q_VTB, fbase - 896 + 32, acc[1][j], tok, h);
      }
    } else if (fbase < 1664) {
      const bool isKV = fbase >= 1408;
      u16* dst = qkv + (isKV ? Q_CKV : Q_CQ);
      const int ld = isKV ? 256 : 384;
      const int c0 = isKV ? fbase - 1408 : fbase - 1024;
      const int sb = (isKV ? 12 : 0) + (c0 >> 5);
#pragma unroll
      for (int j = 0; j < NJ; ++j) {
        const int tok = tbase + j * 32 + r;
#pragma unroll
        for (int i = 0; i < 2; ++i) {
          float ss = 0.f;
#pragma unroll
          for (int v = 0; v < 16; ++v) ss += acc[i][j][v] * acc[i][j][v];
          ss += __shfl_xor(ss, 32);
          if (h == 0) SS[(size_t)tok * 20 + sb + i] = ss;
          store_rows(dst, ld, c0 + i * 32, acc[i][j], tok, h);
        }
      }
    } else if (fbase < 2176) {
      const bool isK = fbase >= 1920;
      u16* dst = qkv + (isK ? Q_KD : Q_QD);
      const int c0 = isK ? fbase - 1920 : fbase - 1664;
#pragma unroll
      for (int j = 0; j < NJ; ++j) {
        const int tok = tbase + j * 32 + r;
        const int pos = pos_of(tok);
#pragma unroll
        for (int i = 0; i < 2; ++i) {
          rope32_blk(acc[i][j], R32 + (size_t)pos * 16, h);
          store_rows(dst, 256, c0 + i * 32, acc[i][j], tok, h);
        }
      }
    } else if (fbase < 2432) {
#pragma unroll
      for (int j = 0; j < NJ; ++j) {
        const int tok = tbase + j * 32 + r;
        store_T(qkv + Q_VTD, fbase - 2176, acc[0][j], tok, h);
        store_T(qkv + Q_VTD, fbase - 2176 + 32, acc[1][j], tok, h);
      }
    } else if (fbase == 2432) {
#pragma unroll
      for (int j = 0; j < NJ; ++j) {
        const int tok = tbase + j * 32 + r;
        const int pos = pos_of(tok);
        rope32_blk(acc[0][j], R32 + (size_t)pos * 16, h);
#pragma unroll
        for (int hd = 0; hd < 4; ++hd) store_rows(qkv + Q_KC, 384, hd * 96 + 64, acc[0][j], tok, h);
      }
    }
  } else if constexpr (MODE == M_GATE) {
    unsigned char* G8 = (unsigned char*)(ws + OFF_R2);
#pragma unroll
    for (int j = 0; j < NJ; ++j) {
      const int tok = tbase + j * 32 + r;
#pragma unroll
      for (int i = 0; i < 2; ++i)
#pragma unroll
        for (int vq = 0; vq < 4; ++vq) {
          unsigned pk = 0u;
#pragma unroll
          for (int e = 0; e < 4; ++e) {
            const float o = __builtin_amdgcn_rcpf(1.f + __builtin_amdgcn_exp2f(-1.4426950408889634f * acc[i][j][4 * vq + e]));
            pk |= (unsigned)(o * 255.f + 0.5f) << (8 * e);
          }
          *(unsigned*)(G8 + (size_t)tok * GP + fbase + i * 32 + 8 * vq + 4 * h) = pk;
        }
    }
  } else if constexpr (MODE == M_CUQ) {
    if (fbase >= 384) return;
    float cn = 0.f;
#pragma unroll
    for (int j = 0; j < NJ; ++j) {
      const int tok = tbase + j * 32 + r;
      const int pos = pos_of(tok);
      float ss = 0.f;
#pragma unroll
      for (int b = 0; b < 12; ++b) ss += SS[(size_t)tok * 20 + b];
      const float rs = rsqrtf(ss * (1.f / 384.f) + EPS);
#pragma unroll
      for (int i = 0; i < 2; ++i) {
        const int blk = (fbase >> 5) + i;
        float hs = 0.f;
#pragma unroll
        for (int v = 0; v < 16; ++v) { acc[i][j][v] *= rs; hs += acc[i][j][v] * acc[i][j][v]; }
        cn = fmaxf(cn, hs);
        if (blk % 3 == 2) rope32_blk(acc[i][j], R32 + (size_t)pos * 16, h);
        store_rows(qkv + Q_QC, 384, blk * 32, acc[i][j], tok, h, 0.10206207261596577f * 1.4426950408889634f);
      }
    }
    {
      float v = cn * 2.f;
#pragma unroll
      for (int mk = 32; mk >= 1; mk >>= 1) v = fmaxf(v, __shfl_xor(v, mk));
      if ((opaque_tid() & 63) == 0) atomicMax((unsigned*)(ws + OFF_BAR) + 144 + layer * 4 + 0, __float_as_uint(v));
    }
  } else if constexpr (MODE == M_CUKV) {
    float cn = 0.f;
#pragma unroll
    for (int j = 0; j < NJ; ++j) {
      const int tok = tbase + j * 32 + r;
      float ss = 0.f;
#pragma unroll
      for (int b = 0; b < 8; ++b) ss += SS[(size_t)tok * 20 + 12 + b];
      const float rs = rsqrtf(ss * (1.f / 256.f) + EPS);
#pragma unroll
      for (int i = 0; i < 2; ++i) {
        const int blk = (fbase >> 5) + i;
        const int hd = blk >> 2, q = blk & 3;
#pragma unroll
        for (int v = 0; v < 16; ++v) acc[i][j][v] *= rs;
        if (q < 2) {
          float hs = 0.f;
#pragma unroll
          for (int v = 0; v < 16; ++v) hs += acc[i][j][v] * acc[i][j][v];
          cn = fmaxf(cn, hs);
          store_rows(qkv + Q_KC, 384, hd * 96 + q * 32, acc[i][j], tok, h);
        } else store_T(qkv + Q_VTC, hd * 64 + (q - 2) * 32, acc[i][j], tok, h);
      }
    }
    {
      float v = cn * 2.f;
#pragma unroll
      for (int mk = 32; mk >= 1; mk >>= 1) v = fmaxf(v, __shfl_xor(v, mk));
      if ((opaque_tid() & 63) == 0) atomicMax((unsigned*)(ws + OFF_BAR) + 144 + layer * 4 + 1, __float_as_uint(v));
    }
  } else if constexpr (MODE == M_MERGE) {
#pragma unroll
    for (int j = 0; j < NJ; ++j) {
      const int tok = tbase + j * 32 + r;
      store_rows(qkv + Q_MERGED, KP1, fbase, acc[0][j], tok, h);
      store_rows(qkv + Q_MERGED, KP1, fbase + 32, acc[1][j], tok, h);
    }
  }
}

typedef __attribute__((address_space(3))) unsigned lds_u32_t;
typedef __attribute__((address_space(1))) const unsigned glb_u32_t;
template <int MODE, int NJ>
DI void gemm_tile(const u16* __restrict__ Wt, int ldw, const u16* __restrict__ X, int ldx, int K, int f0, int t0, char* smem,
                  const Params& P, int layer) {
  constexpr int XROWS = NJ * 64;
  constexpr int WSTG = 256 * 64, XSTG = XROWS * 64;
  u16* sW = (u16*)smem;
  u16* sX = sW + 2 * WSTG;
  const int tid = opaque_tid(), lane = tid & 63, wave = tid >> 6, r = lane & 31, h = lane >> 5;
  const int wf = wave & 3, wt = wave >> 2;
  f32x16 acc[2][NJ];
  f32x16 tot[2][MODE == M_MERGE ? NJ : 1];
#pragma unroll
  for (int i = 0; i < 2; ++i)
#pragma unroll
    for (int j = 0; j < NJ; ++j)
#pragma unroll
      for (int v = 0; v < 16; ++v) acc[i][j][v] = 0.f;
  if constexpr (MODE == M_MERGE) {
#pragma unroll
    for (int i = 0; i < 2; ++i)
#pragma unroll
      for (int j = 0; j < NJ; ++j)
#pragma unroll
        for (int v = 0; v < 16; ++v) tot[i][j][v] = 0.f;
  }
  const int nk = K >> 6;
  const int srow = tid >> 3;
  const int schunk = (tid & 7) ^ ((tid >> 4) & 7);
  const u16* wp = Wt + (size_t)(f0 + srow) * ldw + schunk * 8;
  const u16* xp = X + (size_t)(t0 + srow) * ldx + schunk * 8;
  const int fbase = f0 + wf * 64, tbase = t0 + wt * (NJ * 32);

  auto issue = [&](int kt, int buf) {
#pragma unroll
    for (int i = 0; i < 4; ++i)
      __builtin_amdgcn_global_load_lds((glb_u32_t*)(wp + (size_t)(i * 64) * ldw + kt * 64),
                                       (lds_u32_t*)(sW + buf * WSTG + i * 4096 + tid * 8), 16, 0, 0);
#pragma unroll
    for (int i = 0; i < NJ; ++i)
      __builtin_amdgcn_global_load_lds((glb_u32_t*)(xp + (size_t)(i * 64) * ldx + kt * 64),
                                       (lds_u32_t*)(sX + buf * XSTG + i * 4096 + tid * 8), 16, 0, 0);
  };
  const int swz = (r >> 1) & 7;
  auto compute = [&](int buf, int kt) {
    const u16* aW = sW + buf * WSTG + (wf * 64 + r) * 64;
    const u16* aX = sX + buf * XSTG + (wt * (NJ * 32) + r) * 64;
#pragma unroll
    for (int ks = 0; ks < 4; ++ks) {
      const int co = ((2 * ks + h) ^ swz) * 8;
      bf16x8 wfrag[2], xfrag[NJ];
#pragma unroll
      for (int i = 0; i < 2; ++i) wfrag[i] = *(const bf16x8*)(aW + i * 32 * 64 + co);
#pragma unroll
      for (int j = 0; j < NJ; ++j) xfrag[j] = *(const bf16x8*)(aX + j * 32 * 64 + co);
#pragma unroll
      for (int i = 0; i < 2; ++i)
#pragma unroll
        for (int j = 0; j < NJ; ++j) acc[i][j] = MFMA32(wfrag[i], xfrag[j], acc[i][j]);
    }
    if constexpr (MODE == M_MERGE) {
      if ((kt & 3) == 3) {
        const int br = kt >> 2;
        const unsigned char* G8 = (const unsigned char*)(P.ws + OFF_R2);
#pragma unroll
        for (int j = 0; j < NJ; ++j) {
          const int tok = tbase + j * 32 + r;
#pragma unroll
          for (int i = 0; i < 2; ++i)
#pragma unroll
            for (int vq = 0; vq < 4; ++vq) {
              const unsigned gp = *(const unsigned*)(G8 + (size_t)tok * GP + br * 1024 + fbase + i * 32 + 8 * vq + 4 * h);
              tot[i][j][4 * vq + 0] += (float)(gp & 0xffu) * (1.f / 255.f) * acc[i][j][4 * vq + 0];
              tot[i][j][4 * vq + 1] += (float)((gp >> 8) & 0xffu) * (1.f / 255.f) * acc[i][j][4 * vq + 1];
              tot[i][j][4 * vq + 2] += (float)((gp >> 16) & 0xffu) * (1.f / 255.f) * acc[i][j][4 * vq + 2];
              tot[i][j][4 * vq + 3] += (float)(gp >> 24) * (1.f / 255.f) * acc[i][j][4 * vq + 3];
              acc[i][j][4 * vq + 0] = 0.f; acc[i][j][4 * vq + 1] = 0.f;
              acc[i][j][4 * vq + 2] = 0.f; acc[i][j][4 * vq + 3] = 0.f;
            }
        }
      }
    }
  };

  issue(0, 0);
  asm volatile("s_waitcnt vmcnt(0)" ::: "memory");
  __syncthreads();
  for (int kt = 0; kt < nk; ++kt) {
    const int buf = kt & 1;
    if (kt + 1 < nk) issue(kt + 1, buf ^ 1);
    compute(buf, kt);
    asm volatile("s_waitcnt vmcnt(0) lgkmcnt(0)" ::: "memory");
    __syncthreads();
  }
  if constexpr (MODE == M_MERGE) gemm_epilogue<MODE, NJ>(tot, fbase, tbase, r, h, P, layer);
  else gemm_epilogue<MODE, NJ>(acc, fbase, tbase, r, h, P, layer);
}

template <int MODE, int NJ>
DI void gemm_phase(const u16* Wt, int ldw, const u16* X, int ldx, int K, int nF, char* smem, const Params& P, int layer) {
  constexpr int TT = NJ * 64;
  const int nT = T / TT;
  const int ntiles = nF * nT;
  for (int idx = blockIdx.x; idx < ntiles; idx += gridDim.x) {
    const int tt_lo = idx & 15;
    const int rest = idx >> 4;
    const int ft = rest % nF;
    const int tt = (rest / nF) * 16 + tt_lo;
    gemm_tile<MODE, NJ>(Wt, ldw, X, ldx, K, ft * 256, tt * TT, smem, P, layer);
  }
}

namespace pg8 {
#define PG8_LAS __attribute__((address_space(3)))
typedef unsigned short bf16_t;
typedef short bf16x8 __attribute__((ext_vector_type(8)));
typedef float f32x4 __attribute__((ext_vector_type(4)));
typedef unsigned u32x4 __attribute__((ext_vector_type(4)));
constexpr int BM = 256, BK = 64, HALF = 128, HTB = HALF * BK * 2  , STAGE_BYTES = 8 * HTB, NXCD = 8, WGM = 8;

__host__ __device__ __forceinline__ int lds_byte(int r, int c) { const int st = (r >> 4) * 2 + (c >> 5), rr = r & 15, cc = c & 31, ob = rr * 64 + cc * 2; return st * 1024 + (ob ^ (((ob >> 9) & 1) << 5)); }
__host__ __device__ __forceinline__ void stage_rc(int b, int& R, int& C) { const int st = b / 1024, sb = b % 1024, swz = sb ^ (((sb >> 9) & 1) << 5); R = (st >> 1) * 16 + swz / 64; C = (st & 1) * 32 + (swz % 64) / 2; }
__host__ __device__ __forceinline__ int perm32(int rho) { const int n = rho >> 4, i = rho & 15; return 8 * (i >> 2) + 4 * n + (i & 3); }

struct Unit { int pm, pn; };
struct Gemm { const bf16_t* A; const bf16_t* Bt; int M, N, K, ld; };

struct StaticOrder {
    int nM, nN, nwg, G, c;
    __host__ __device__ void init(int M, int N, int G_, int c_) { nM = M / BM; nN = N / BM; nwg = nM * nN; G = G_; c = c_; }
    __host__ __device__ bool next(int i, Unit& u) const {
        const long L = (long)i * G + c; if (L >= nwg) return false;
        int wgid = (int)L; { const int q = nwg / NXCD, r = nwg % NXCD, xcd = wgid % NXCD, off = wgid / NXCD; wgid = (xcd < r ? xcd * (q + 1) : r * (q + 1) + (xcd - r) * q) + off; }
        const int nig = WGM * nN, gid = wgid / nig, fm = gid * WGM, gsz = (nM - fm) < WGM ? (nM - fm) : WGM;
        u.pm = fm + ((wgid % nig) % gsz); u.pn = (wgid % nig) / gsz; return true;
    }
    __device__ __forceinline__ void a_ready(const Unit&) const {}
    __device__ __forceinline__ void done(const Unit&) const {}
};

template <class Epi, class Sched, bool STAMP, int KC, int LDC>
__device__ __forceinline__ void gemm_phase(PG8_LAS unsigned char* lds, const Gemm g, const Sched& S, const Epi& E, unsigned long long* stamps) {
    const int tid = opaque_tid(), wid = __builtin_amdgcn_readfirstlane(tid >> 6), lane = tid & 63, wr = wid >> 2, wc = wid & 3, fr = lane & 15, fq = lane >> 4;
    constexpr int K = KC, nt = K / BK;
    int ts_lo = 0, ts_hi = 0, nts = 0; const unsigned long long rt_entry = STAMP ? (unsigned long long)wall_clock64() : 0ull;
#define PG8_STAMP() do { if (STAMP && wid == 0 && nts < 64) { const unsigned long long _c = (unsigned long long)clock64(); \
        ts_lo = (lane == nts) ? (int)(unsigned)_c : ts_lo; ts_hi = (lane == nts) ? (int)(unsigned)(_c >> 32) : ts_hi; ++nts; } } while (0)
    PG8_STAMP();
    unsigned voffA[2], voffB[2];
#pragma unroll
    for (int i = 0; i < 2; ++i) { int R, C; stage_rc(tid * 16 + i * 8192, R, C); const int Rb = Epi::PERM ? ((R & ~31) + perm32(R & 31)) : R;
        voffA[i] = (unsigned)(R * LDC + C) * 2u; voffB[i] = (unsigned)(Rb * LDC + C) * 2u; }
    const size_t kstep = (size_t)(BK * 2);
    constexpr size_t hstep = (size_t)HALF * LDC * 2;
    const size_t tstep = 2 * hstep;
    const unsigned ldsw = (unsigned)wid * 1024u;
    const int aoff = lds_byte(wr * 64 + fr, fq * 8), boff = lds_byte(wc * 32 + fr, fq * 8);
#define PG8_SA(b, h) (((b) * 2 + (h)) * HTB)
#define PG8_SB(b, h) ((4 + (b) * 2 + (h)) * HTB)
#define PG8_STAGE(bufoff, gbase, voff) do { _Pragma("unroll") for (int _i = 0; _i < 2; ++_i) \
        __builtin_amdgcn_global_load_lds((const unsigned*)((const char*)(gbase) + (voff)[_i]), (PG8_LAS unsigned*)(lds + (bufoff) + ldsw + _i * 8192), 16, 0, 0); } while (0)
#define PG8_LDA(dst, b, h) do { _Pragma("unroll") for (int m = 0; m < 4; ++m) _Pragma("unroll") for (int k = 0; k < 2; ++k) dst[m][k] = *(const PG8_LAS bf16x8*)(lds + PG8_SA(b, h) + aoff + m * 2048 + k * 1024); } while (0)
#define PG8_LDB(dst, b, h) do { _Pragma("unroll") for (int n = 0; n < 2; ++n) _Pragma("unroll") for (int k = 0; k < 2; ++k) dst[n][k] = *(const PG8_LAS bf16x8*)(lds + PG8_SB(b, h) + boff + n * 2048 + k * 1024); } while (0)
#define PG8_MMA(ai, bj, At, Bt) do { __builtin_amdgcn_s_setprio(1); _Pragma("unroll") for (int m = 0; m < 4; ++m) _Pragma("unroll") for (int n = 0; n < 2; ++n) _Pragma("unroll") for (int k = 0; k < 2; ++k) \
        acc[ai][bj][m][n] = __builtin_amdgcn_mfma_f32_16x16x32_bf16(Bt[n][k], At[m][k], acc[ai][bj][m][n], 0, 0, 0); __builtin_amdgcn_s_setprio(0); } while (0)
#define PG8_WAIT_V(n) asm volatile("s_waitcnt vmcnt(" #n ")" ::: "memory")
#define PG8_WAIT_L(n) asm volatile("s_waitcnt lgkmcnt(" #n ")" ::: "memory")
#define PG8_BAR __builtin_amdgcn_s_barrier()
#define PG8_SCHED __builtin_amdgcn_sched_barrier(0)
    Unit cur, nxt; int ui = 0;
    if (!S.next(0, cur)) return;
    f32x4 acc[2][2][4][2];
#pragma unroll
    for (int a = 0; a < 2; ++a)
#pragma unroll
        for (int b = 0; b < 2; ++b)
#pragma unroll
            for (int m = 0; m < 4; ++m)
#pragma unroll
                for (int n = 0; n < 2; ++n) acc[a][b][m][n] = (f32x4){0.f, 0.f, 0.f, 0.f};
    bf16x8 At[4][2], B0[2][2], B1[2][2];
    const char* cA = (const char*)g.A + (size_t)cur.pm * tstep; const char* cB = (const char*)g.Bt + (size_t)cur.pn * tstep;
    S.a_ready(cur);
    PG8_STAGE(PG8_SB(0, 0), cB, voffB); PG8_STAGE(PG8_SA(0, 0), cA, voffA); PG8_STAGE(PG8_SB(0, 1), cB + hstep, voffB); PG8_STAGE(PG8_SA(0, 1), cA + hstep, voffA);
    if (wr == 1) PG8_BAR;
    PG8_WAIT_V(4); PG8_BAR;
    PG8_STAGE(PG8_SB(1, 0), cB + kstep, voffB); PG8_STAGE(PG8_SA(1, 0), cA + kstep, voffA); PG8_STAGE(PG8_SB(1, 1), cB + hstep + kstep, voffB);
    PG8_WAIT_V(6); PG8_BAR;
    PG8_STAMP();
    for (;;) {
        const bool has_next = S.next(ui + 1, nxt);
        const char* nA = has_next ? (const char*)g.A + (size_t)nxt.pm * tstep : cA; const char* nB = has_next ? (const char*)g.Bt + (size_t)nxt.pn * tstep : cB;
        for (int t = 0; t < nt; t += 2) {
            const bool last = (t == nt - 2);
            const char* a1 = cA + (size_t)(t + 1) * kstep;
            const char* a2 = last ? nA : cA + (size_t)(t + 2) * kstep; const char* b2 = last ? nB : cB + (size_t)(t + 2) * kstep;
            const char* a3 = a2 + kstep; const char* b3 = b2 + kstep;
            if (last && has_next) S.a_ready(nxt);
            PG8_LDB(B0, 0, 0); PG8_SCHED; PG8_LDA(At, 0, 0); PG8_STAGE(PG8_SA(1, 1), a1 + hstep, voffA);
            PG8_WAIT_L(8); PG8_BAR; PG8_WAIT_L(0); PG8_MMA(0, 0, At, B0); PG8_BAR; PG8_SCHED;
            PG8_LDB(B1, 0, 1); PG8_STAGE(PG8_SB(0, 0), b2, voffB);
            PG8_BAR; PG8_WAIT_L(0); PG8_MMA(0, 1, At, B1); PG8_BAR;
            PG8_LDA(At, 0, 1); PG8_STAGE(PG8_SA(0, 0), a2, voffA);
            PG8_BAR; PG8_WAIT_L(0); PG8_MMA(1, 0, At, B0); PG8_BAR; PG8_SCHED;
            PG8_STAGE(PG8_SB(0, 1), b2 + hstep, voffB);
            PG8_WAIT_V(6); PG8_BAR; PG8_MMA(1, 1, At, B1); PG8_BAR;
            PG8_LDB(B0, 1, 0); PG8_SCHED; PG8_LDA(At, 1, 0); PG8_STAGE(PG8_SA(0, 1), a2 + hstep, voffA);
            PG8_WAIT_L(8); PG8_BAR; PG8_WAIT_L(0); PG8_MMA(0, 0, At, B0); PG8_BAR; PG8_SCHED;
            PG8_LDB(B1, 1, 1); PG8_STAGE(PG8_SB(1, 0), b3, voffB);
            PG8_BAR; PG8_WAIT_L(0); PG8_MMA(0, 1, At, B1); PG8_BAR;
            PG8_LDA(At, 1, 1); PG8_STAGE(PG8_SA(1, 0), a3, voffA);
            PG8_BAR; PG8_WAIT_L(0); PG8_MMA(1, 0, At, B0); PG8_BAR; PG8_SCHED;
            PG8_STAGE(PG8_SB(1, 1), b3 + hstep, voffB);
            PG8_WAIT_V(6); PG8_BAR; PG8_MMA(1, 1, At, B1); PG8_BAR;
        }
        PG8_STAMP();
        if constexpr (!Epi::AFTER_DRAIN) { E(acc, cur, wr, wc, fr, fq); S.done(cur); }
        PG8_STAMP();
        if (!has_next) break;
#pragma unroll
        for (int a = 0; a < 2; ++a)
#pragma unroll
            for (int b = 0; b < 2; ++b)
#pragma unroll
                for (int m = 0; m < 4; ++m)
#pragma unroll
                    for (int n = 0; n < 2; ++n) acc[a][b][m][n] = (f32x4){0.f, 0.f, 0.f, 0.f};
        cur = nxt; cA = nA; cB = nB; ++ui;
    }
    PG8_WAIT_V(0);
    if (wr == 0) PG8_BAR;
    PG8_BAR;
    if constexpr (Epi::AFTER_DRAIN) { E.fused(acc, cur, wr, wc, fr, fq, lds, wid, lane); S.done(cur); }
    PG8_STAMP();
    if (STAMP && wid == 0) { stamps[lane] = lane < nts ? (((unsigned long long)(unsigned)ts_hi << 32) | (unsigned)ts_lo) : 0ull;
        if (lane == 62) stamps[62] = rt_entry; if (lane == 63) stamps[63] = (unsigned long long)wall_clock64(); }
#undef PG8_STAMP
#undef PG8_SA
#undef PG8_SB
#undef PG8_STAGE
#undef PG8_LDA
#undef PG8_LDB
#undef PG8_MMA
#undef PG8_WAIT_V
#undef PG8_WAIT_L
#undef PG8_BAR
#undef PG8_SCHED
}
}

struct EpiY8 {
  static constexpr bool PERM = true, AFTER_DRAIN = false;
  u16* O;
  DI void operator()(const pg8::f32x4 (&acc)[2][2][4][2], const pg8::Unit& u, int wr, int wc, int fr, int fq) const {
    const int row0 = u.pm * 256 + wr * 64 + fr, col0 = u.pn * 256 + wc * 32 + 8 * fq;
#pragma unroll
    for (int ai = 0; ai < 2; ++ai)
#pragma unroll
      for (int m = 0; m < 4; ++m) {
        u16* rowp = O + (size_t)(row0 + ai * 128 + m * 16) * KP1 + col0;
#pragma unroll
        for (int bj = 0; bj < 2; ++bj) {
          const pg8::f32x4 v0 = acc[ai][bj][m][0], v1 = acc[ai][bj][m][1];
          u32x4 w; w.x = pk2(v0[0], v0[1]); w.y = pk2(v0[2], v0[3]); w.z = pk2(v1[0], v1[1]); w.w = pk2(v1[2], v1[3]);
          *(u32x4*)(rowp + bj * 128) = w;
        }
      }
  }
};
struct EpiFfnUp8 {
  static constexpr bool PERM = true, AFTER_DRAIN = false;
  u16* H;
  DI void operator()(const pg8::f32x4 (&acc)[2][2][4][2], const pg8::Unit& u, int wr, int wc, int fr, int fq) const {
    const int row0 = u.pm * 256 + wr * 64 + fr, col0 = u.pn * 128 + wc * 32 + 8 * fq;
#pragma unroll
    for (int ai = 0; ai < 2; ++ai)
#pragma unroll
      for (int m = 0; m < 4; ++m) {
        float o[8];
#pragma unroll
        for (int n = 0; n < 2; ++n)
#pragma unroll
          for (int j = 0; j < 4; ++j) {
            const float g = acc[ai][0][m][n][j], up = acc[ai][1][m][n][j];
            o[n * 4 + j] = g * __builtin_amdgcn_rcpf(1.f + __builtin_amdgcn_exp2f(-1.4426950408889634f * g)) * up;
          }
        u32x4 w; w.x = pk2(o[0], o[1]); w.y = pk2(o[2], o[3]); w.z = pk2(o[4], o[5]); w.w = pk2(o[6], o[7]);
        *(u32x4*)(H + (size_t)(row0 + ai * 128 + m * 16) * KP2 + col0) = w;
      }
  }
};
struct EpiGate8 {
  static constexpr bool PERM = true, AFTER_DRAIN = false;
  unsigned char* G8;
  DI void operator()(const pg8::f32x4 (&acc)[2][2][4][2], const pg8::Unit& u, int wr, int wc, int fr, int fq) const {
    const int row0 = u.pm * 256 + wr * 64 + fr, col0 = u.pn * 256 + wc * 32 + 8 * fq;
#pragma unroll
    for (int ai = 0; ai < 2; ++ai)
#pragma unroll
      for (int m = 0; m < 4; ++m)
#pragma unroll
        for (int bj = 0; bj < 2; ++bj) {
          uint2 pk = {0u, 0u};
#pragma unroll
          for (int j = 0; j < 4; ++j) {
            const float a = __builtin_amdgcn_rcpf(1.f + __builtin_amdgcn_exp2f(-1.4426950408889634f * acc[ai][bj][m][0][j]));
            const float b = __builtin_amdgcn_rcpf(1.f + __builtin_amdgcn_exp2f(-1.4426950408889634f * acc[ai][bj][m][1][j]));
            pk.x |= (unsigned)(a * 255.f + 0.5f) << (8 * j);
            pk.y |= (unsigned)(b * 255.f + 0.5f) << (8 * j);
          }
          *(uint2*)(G8 + (size_t)(row0 + ai * 128 + m * 16) * GP + col0 + bj * 128) = pk;
        }
  }
};
struct EpiProj8 {
  static constexpr bool PERM = false, AFTER_DRAIN = false;
  const Params* Pp; int layer;
  static DI void rope32q(float (&b)[8], const float2* __restrict__ tab, int fq) {
#pragma unroll
    for (int j = 0; j < 4; ++j) {
      const float2 cs = tab[4 * fq + j];
      const float x1 = b[j], x2 = b[4 + j];
      b[j] = x1 * cs.x - x2 * cs.y;
      b[4 + j] = x2 * cs.x + x1 * cs.y;
    }
  }
  static DI void st8(u16* __restrict__ base, int ld, int col0, const float (&b)[8], int tok, int fq) {
#pragma unroll
    for (int n = 0; n < 2; ++n) {
      uint2 pk; pk.x = pk2(b[4 * n], b[4 * n + 1]); pk.y = pk2(b[4 * n + 2], b[4 * n + 3]);
      *(uint2*)(base + (size_t)tok * ld + col0 + 16 * n + 4 * fq) = pk;
    }
  }
  static DI void stT8(u16* __restrict__ base, int row0, const float (&b)[8], int tok, int fq) {
    const int tp = (tok & ~12) | ((tok & 4) << 1) | ((tok & 8) >> 1);
#pragma unroll
    for (int n = 0; n < 2; ++n)
#pragma unroll
      for (int j = 0; j < 4; ++j) {
        const int row = row0 + 16 * n + 4 * fq + j;
        base[(size_t)(row >> 6) * 64 * T + (size_t)(tp >> 7) * 8192 + (row & 63) * 128 + (tp & 127)] = f2bf(b[4 * n + j]);
      }
  }
  DI void operator()(const pg8::f32x4 (&acc)[2][2][4][2], const pg8::Unit& u, int wr, int wc, int fr, int fq_in) const {
    const Params& P = *Pp;
    char* ws = P.ws;
    u16* qkv = (u16*)(ws + OFF_QKV);
    const float2* R64 = (const float2*)(ws + OFF_R64);
    const float2* R32 = (const float2*)(ws + OFF_R32);
    float* SS = (float*)(ws + OFF_SS);
    const int fbase = u.pn * 256 + wc * 64;
    if (fbase >= 2496) return;
    float penorm = 0.f;
    float dnorm = 0.f;
#pragma unroll
    for (int ai = 0; ai < 2; ++ai)
#pragma unroll
      for (int m = 0; m < 4; ++m) {
        int fqv = fq_in; asm volatile("" : "+v"(fqv));
        const int fq = fqv;
        const int tok = u.pm * 256 + ai * 128 + wr * 64 + m * 16 + fr;
        const int pos = pos_of(tok);
        float b0[8], b1[8];
#pragma unroll
        for (int n = 0; n < 2; ++n)
#pragma unroll
          for (int j = 0; j < 4; ++j) { b0[4 * n + j] = acc[ai][0][m][n][j]; b1[4 * n + j] = acc[ai][1][m][n][j]; }
        if (fbase < 384) {
          const bool isK = fbase >= 256;
          const float* g = P.a_qk_norm + layer * 128 + (isK ? 64 : 0);
          float ss = 0.f;
#pragma unroll
          for (int k = 0; k < 8; ++k) ss += b0[k] * b0[k] + b1[k] * b1[k];
          ss += __shfl_xor(ss, 16);
          ss += __shfl_xor(ss, 32);
          const float rs = rsqrtf(ss * (1.f / 64.f) + EPS) * (isK ? 1.f : 0.125f * 1.4426950408889634f);
#pragma unroll
          for (int n = 0; n < 2; ++n)
#pragma unroll
            for (int j = 0; j < 4; ++j) {
              b0[4 * n + j] *= rs * g[16 * n + 4 * fq + j];
              b1[4 * n + j] *= rs * g[32 + 16 * n + 4 * fq + j];
            }
          rope32q(b0, R32 + (size_t)(pos >> 6) * 16, fq);
          rope32q(b1, R32 + (size_t)(pos & 63) * 16, fq);
          u16* dst = qkv + (isK ? Q_KA : Q_QA);
          const int ld = isK ? 128 : 256, c0 = isK ? fbase - 256 : fbase;
          st8(dst, ld, c0, b0, tok, fq);
          st8(dst, ld, c0 + 32, b1, tok, fq);
        } else if (fbase < 512) {
          stT8(qkv + Q_VTA, fbase - 384, b0, tok, fq);
          stT8(qkv + Q_VTA, fbase - 384 + 32, b1, tok, fq);
        } else if (fbase < 896) {
          const bool isK = fbase >= 768;
          const float2* tab = R64 + (size_t)pos * 32;
#pragma unroll
          for (int n = 0; n < 2; ++n)
#pragma unroll
            for (int j = 0; j < 4; ++j) {
              const float2 cs = tab[16 * n + 4 * fq + j];
              const float x1 = b0[4 * n + j], x2 = b1[4 * n + j];
              b0[4 * n + j] = x1 * cs.x - x2 * cs.y;
              b1[4 * n + j] = x2 * cs.x + x1 * cs.y;
            }
          u16* dst = qkv + (isK ? Q_KB : Q_QB);
          const int ld = isK ? 128 : 256, c0 = isK ? fbase - 768 : fbase - 512;
          st8(dst, ld, c0, b0, tok, fq);
          st8(dst, ld, c0 + 32, b1, tok, fq);
        } else if (fbase < 1024) {
          stT8(qkv + Q_VTB, fbase - 896, b0, tok, fq);
          stT8(qkv + Q_VTB, fbase - 896 + 32, b1, tok, fq);
        } else if (fbase < 1664) {
          const bool isKV = fbase >= 1408;
          u16* dst = qkv + (isKV ? Q_CKV : Q_CQ);
          const int ld = isKV ? 256 : 384, c0 = isKV ? fbase - 1408 : fbase - 1024;
          const int sb = (isKV ? 12 : 0) + (c0 >> 5);
          float s0 = 0.f, s1 = 0.f;
#pragma unroll
          for (int k = 0; k < 8; ++k) { s0 += b0[k] * b0[k]; s1 += b1[k] * b1[k]; }
          s0 += __shfl_xor(s0, 16); s0 += __shfl_xor(s0, 32);
          s1 += __shfl_xor(s1, 16); s1 += __shfl_xor(s1, 32);
          if (fq == 0) { SS[(size_t)tok * 20 + sb] = s0; SS[(size_t)tok * 20 + sb + 1] = s1; }
          st8(dst, ld, c0, b0, tok, fq);
          st8(dst, ld, c0 + 32, b1, tok, fq);
        } else if (fbase < 2176) {
          const bool isK = fbase >= 1920;
          u16* dst = qkv + (isK ? Q_KD : Q_QD);
          const int c0 = isK ? fbase - 1920 : fbase - 1664;
          rope32q(b0, R32 + (size_t)pos * 16, fq);
          rope32q(b1, R32 + (size_t)pos * 16, fq);
          float s0 = 0.f, s1 = 0.f;
#pragma unroll
          for (int k = 0; k < 8; ++k) { s0 += b0[k] * b0[k]; s1 += b1[k] * b1[k]; }
          dnorm = fmaxf(dnorm, fmaxf(s0, s1));
          if (!isK) {
#pragma unroll
            for (int k = 0; k < 8; ++k) { b0[k] *= 0.17677669529663687f * 1.4426950408889634f; b1[k] *= 0.17677669529663687f * 1.4426950408889634f; }
          }
          st8(dst, 256, c0, b0, tok, fq);
          st8(dst, 256, c0 + 32, b1, tok, fq);
        } else if (fbase < 2432) {
          stT8(qkv + Q_VTD, fbase - 2176, b0, tok, fq);
          stT8(qkv + Q_VTD, fbase - 2176 + 32, b1, tok, fq);
        } else {
          rope32q(b0, R32 + (size_t)pos * 16, fq);
          { float s0 = 0.f;
#pragma unroll
            for (int k = 0; k < 8; ++k) s0 += b0[k] * b0[k];
            penorm = fmaxf(penorm, s0); }
#pragma unroll
          for (int hd = 0; hd < 4; ++hd) st8(qkv + Q_KC, 384, hd * 96 + 64, b0, tok, fq);
        }
        __builtin_amdgcn_sched_barrier(0);
      }
    if (fbase == 2432) {
      float v = penorm * 4.f;
#pragma unroll
      for (int mk = 32; mk >= 1; mk >>= 1) v = fmaxf(v, __shfl_xor(v, mk));
      if ((opaque_tid() & 63) == 0) atomicMax((unsigned*)(ws + OFF_BAR) + 144 + layer * 4 + 2, __float_as_uint(v));
    }
    if (fbase >= 1664 && fbase < 2176) {
      float v = dnorm * 4.f;
#pragma unroll
      for (int mk = 32; mk >= 1; mk >>= 1) v = fmaxf(v, __shfl_xor(v, mk));
      if ((opaque_tid() & 63) == 0) atomicMax((unsigned*)(ws + OFF_BAR) + 128 + layer * 2 + (fbase >= 1920 ? 1 : 0), __float_as_uint(v));
    }
  }
};
struct SimpleOrder {
  int nN, nwg, G, c;
  DI bool next(int i, pg8::Unit& u) const {
    const int L = i * G + c;
    if (L >= nwg) return false;
    const int rest = L >> 4;
    u.pn = rest % nN;
    u.pm = (rest / nN) * 16 + (L & 15);
    return true;
  }
  DI void a_ready(const pg8::Unit&) const {}
  DI void done(const pg8::Unit&) const {}
};
template <int N, int K, int LD, class Epi>
DI void gemm8_phase(const u16* X, const u16* Wt, const Epi& E, char* smem) {
  pg8::Gemm g; g.A = X; g.Bt = Wt; g.M = T; g.N = N; g.K = K; g.ld = LD;
  int bid_ = (int)blockIdx.x; asm volatile("" : "+s"(bid_));
  SimpleOrder S; S.nN = N / 256; S.nwg = (T / 256) * (N / 256); S.G = (int)gridDim.x; S.c = bid_;
  pg8::gemm_phase<Epi, SimpleOrder, false, K, LD>((PG8_LAS unsigned char*)smem, g, S, E, nullptr);
}

template <int DQK, int NCOMP, bool BAND, int EPI, bool NOMAX = false>
DI void attn_item(const u16* __restrict__ Q, int ldq, const u16* __restrict__ Kp, int ldk, const u16* __restrict__ Vt,
                  int qtok0, int kbeg, int kend, float sc_l2, float sink_l2, float lam, float onorm,
                  const float* __restrict__ subg, u16* __restrict__ O, float* __restrict__ DS, char* smem) {
  constexpr int DC = DQK / NCOMP;
  constexpr int KS = DC / 16;
  constexpr int KEYS = (NCOMP == 1) ? 128 : 64;
  constexpr int KSTR = DQK + 8, VSTR = KEYS + 8;
  constexpr int KCH = DQK / 8, VCH = KEYS / 8;
  constexpr int NKC = KEYS * KCH / NTHR, NVC = 64 * VCH / NTHR;
  constexpr int KSLOT = KEYS * KSTR, VSLOT = 64 * VSTR;
  u16* sK = (u16*)smem;
  u16* sV = sK + 3 * KSLOT;
  const int tid = opaque_tid(), lane = tid & 63, wave = tid >> 6, r = lane & 31, h = lane >> 5;
  const int qtok = qtok0 + wave * 32 + r;

  bf16x8 qf[NCOMP][KS];
#pragma unroll
  for (int c = 0; c < NCOMP; ++c)
#pragma unroll
    for (int ks = 0; ks < KS; ++ks) qf[c][ks] = *(const bf16x8*)(Q + (size_t)qtok * ldq + c * DC + ks * 16 + 8 * h);

  f32x16 Oa[NCOMP][2];
  float m[NCOMP], l[NCOMP];
#pragma unroll
  for (int c = 0; c < NCOMP; ++c) {
#pragma unroll
    for (int d = 0; d < 2; ++d)
#pragma unroll
      for (int v = 0; v < 16; ++v) Oa[c][d][v] = 0.f;
    m[c] = BAND ? sink_l2 : -1e30f;
    l[c] = (BAND && h == 0) ? 1.f : 0.f;
  }

  const u16* kg[NKC]; int kso[NKC];
#pragma unroll
  for (int i = 0; i < NKC; ++i) {
    const int c = tid + i * NTHR;
    const int row = c / KCH, cc = c % KCH;
    kg[i] = Kp + (size_t)(kbeg + row) * ldk + cc * 8;
    kso[i] = row * KSTR + cc * 8;
  }
  const u16* vg[NVC]; int vso[NVC];
#pragma unroll
  for (int i = 0; i < NVC; ++i) {
    const int c = tid + i * NTHR;
    const int row = c / VCH, cc = c % VCH;
    vg[i] = Vt + (size_t)(kbeg >> 7) * 8192 + row * 128 + cc * 8;
    vso[i] = row * VSTR + cc * 8;
  }
  u32x4 kreg[NKC], vreg[NVC];
  auto loadK = [&](int t) {
#pragma unroll
    for (int i = 0; i < NKC; ++i) kreg[i] = gld16(kg[i] + (size_t)t * KEYS * ldk);
  };
  auto loadV = [&](int t) {
#pragma unroll
    for (int i = 0; i < NVC; ++i) vreg[i] = gld16(vg[i] + (size_t)t * 8192);
  };
  auto waitK = [&]() {
    if constexpr (NKC == 1) wait_vm0(kreg[0]);
    else if constexpr (NKC == 2) wait_vm0(kreg[0], kreg[1]);
    else wait_vm0(kreg[0], kreg[1], kreg[2]);
  };
  auto waitV = [&]() {
    if constexpr (NVC == 1) wait_vm0(vreg[0]);
    else wait_vm0(vreg[0], vreg[1]);
  };
  auto storeK = [&](int slot) {
#pragma unroll
    for (int i = 0; i < NKC; ++i) *(u32x4*)(sK + slot * KSLOT + kso[i]) = kreg[i];
  };
  auto storeV = [&](int slot) {
#pragma unroll
    for (int i = 0; i < NVC; ++i) *(u32x4*)(sV + slot * VSLOT + vso[i]) = vreg[i];
  };

  f32x16 S0[2], S1[2];
  bf16x8 pfA[2][2], pfB[2][2];
  float alpha_pend = 1.f;
  bool need_pend = false;

  auto att_S = [&](auto uu_t, f32x16 (&S)[2], int slot) {
    constexpr int UU = decltype(uu_t)::value;
    constexpr int C = (NCOMP == 2) ? UU : 0;
    const u16* base = sK + slot * KSLOT + ((NCOMP == 1 ? UU * 64 : 0) + r) * KSTR + (NCOMP == 2 ? UU * DC : 0) + 8 * h;
#pragma unroll
    for (int kb = 0; kb < 2; ++kb) {
#pragma unroll
      for (int v = 0; v < 16; ++v) S[kb][v] = 0.f;
#pragma unroll
      for (int ks = 0; ks < KS; ++ks) {
        bf16x8 kf = *(const bf16x8*)(base + kb * 32 * KSTR + ks * 16);
        S[kb] = MFMA32(kf, qf[C][ks], S[kb]);
      }
    }
  };
  auto att_PV = [&](auto uu_t, const bf16x8 (&pf)[2][2], int slot) {
    constexpr int UU = decltype(uu_t)::value;
    constexpr int C = (NCOMP == 2) ? UU : 0;
    const u16* base = sV + slot * VSLOT + r * VSTR + (NCOMP == 1 ? UU * 64 : 0) + 8 * h;
#pragma unroll
    for (int d = 0; d < 2; ++d)
#pragma unroll
      for (int kb = 0; kb < 2; ++kb)
#pragma unroll
        for (int s = 0; s < 2; ++s) {
          bf16x8 vf = *(const bf16x8*)(base + d * 32 * VSTR + kb * 32 + 16 * s);
          Oa[C][d] = MFMA32(vf, pf[kb][s], Oa[C][d]);
        }
  };
  auto att_rescale = [&](auto uu_t) {
    constexpr int UU = decltype(uu_t)::value;
    constexpr int C = (NCOMP == 2) ? UU : 0;
    if (need_pend) {
#pragma unroll
      for (int d = 0; d < 2; ++d)
#pragma unroll
        for (int v = 0; v < 16; ++v) Oa[C][d][v] *= alpha_pend;
    }
  };
  auto att_softmax = [&](auto uu_t, f32x16 (&S)[2], bf16x8 (&pf)[2][2], int kpos0) {
    constexpr int UU = decltype(uu_t)::value;
    constexpr int C = (NCOMP == 2) ? UU : 0;
    if constexpr (BAND) {
#pragma unroll
      for (int kb = 0; kb < 2; ++kb)
#pragma unroll
        for (int v = 0; v < 16; ++v) {
          const int d = kpos0 + kb * 32 + crow(v, h) - qtok;
          if (d > 128 || d < -128) S[kb][v] = -1e30f;
        }
    }
    if constexpr (NOMAX) {
      float rsum = 0.f;
#pragma unroll
      for (int kb = 0; kb < 2; ++kb)
#pragma unroll
        for (int v = 0; v < 16; ++v) {
          float p = __builtin_amdgcn_exp2f(S[kb][v]);
          S[kb][v] = p;
          rsum += p;
        }
      l[C] += rsum;
      need_pend = false;
#pragma unroll
      for (int kb = 0; kb < 2; ++kb)
#pragma unroll
        for (int s = 0; s < 2; ++s) {
          u32x4 pk;
          pk.x = pk2(S[kb][8 * s + 0], S[kb][8 * s + 1]);
          pk.y = pk2(S[kb][8 * s + 2], S[kb][8 * s + 3]);
          pk.z = pk2(S[kb][8 * s + 4], S[kb][8 * s + 5]);
          pk.w = pk2(S[kb][8 * s + 6], S[kb][8 * s + 7]);
          pf[kb][s] = __builtin_bit_cast(bf16x8, pk);
        }
      return;
    }
    float mx = S[0][0];
#pragma unroll
    for (int kb = 0; kb < 2; ++kb)
#pragma unroll
      for (int v = 0; v < 16; ++v) mx = fmaxf(mx, S[kb][v]);
    {
      const unsigned mu = __float_as_uint(mx);
      const auto sw = __builtin_amdgcn_permlane32_swap(mu, mu, false, false);
      mx = fmaxf(__uint_as_float(sw[0]), __uint_as_float(sw[1]));
    }
    const float mold = m[C];
    const float mcand = fmaxf(mold, mx * sc_l2);
    const bool grow = __builtin_amdgcn_ballot_w64(mcand > mold + 6.0f) != 0;
    const float mnew = grow ? mcand : mold;
    need_pend = grow;
    alpha_pend = __builtin_amdgcn_exp2f(mold - mnew);
    m[C] = mnew;
    float rsum = 0.f;
#pragma unroll
    for (int kb = 0; kb < 2; ++kb)
#pragma unroll
      for (int v = 0; v < 16; ++v) {
        float p = __builtin_amdgcn_exp2f(__builtin_fmaf(S[kb][v], sc_l2, -mnew));
        S[kb][v] = p;
        rsum += p;
      }
    l[C] = l[C] * alpha_pend + rsum;
#pragma unroll
    for (int kb = 0; kb < 2; ++kb)
#pragma unroll
      for (int s = 0; s < 2; ++s) {
        u32x4 pk;
        pk.x = pk2(S[kb][8 * s + 0], S[kb][8 * s + 1]);
        pk.y = pk2(S[kb][8 * s + 2], S[kb][8 * s + 3]);
        pk.z = pk2(S[kb][8 * s + 4], S[kb][8 * s + 5]);
        pk.w = pk2(S[kb][8 * s + 6], S[kb][8 * s + 7]);
        pf[kb][s] = __builtin_bit_cast(bf16x8, pk);
      }
  };
  using U0 = std::integral_constant<int, 0>;
  using U1 = std::integral_constant<int, 1>;

  const int ntl = (kend - kbeg) / KEYS;
  auto step = [&](auto first_t, auto lk_t, auto lv_t, int t, int sa, int sb, int sc) {
    constexpr bool FIRST = decltype(first_t)::value, LK = decltype(lk_t)::value, LV = decltype(lv_t)::value;
    if constexpr (LK) loadK(t + 2);
    if constexpr (LV) loadV(t + 1);
    if constexpr (!FIRST) att_rescale(U1{});
    att_S(U1{}, S1, sa);
    if constexpr (!FIRST) att_PV(U1{}, pfB, sc);
    att_softmax(U0{}, S0, pfA, kbeg + t * KEYS);
    att_rescale(U0{});
    if constexpr (LV) att_S(U0{}, S0, sb);
    att_PV(U0{}, pfA, sa);
    att_softmax(U1{}, S1, pfB, kbeg + t * KEYS + 64);
    if constexpr (LK) { waitK(); storeK(sc); }
    if constexpr (LV) { waitV(); storeV(sb); }
    __syncthreads();
  };
  using TT = std::true_type;
  using FF = std::false_type;

  loadK(0); loadV(0);
  waitK(); waitV();
  storeK(0); storeV(0);
  loadK(1);
  waitK();
  storeK(1);
  __syncthreads();
  att_S(U0{}, S0, 0);
  int sa = 0, sb = 1, sc = 2;
  step(TT{}, TT{}, TT{}, 0, sa, sb, sc);
  { int tmp = sa; sa = sb; sb = sc; sc = tmp; }
  for (int t = 1; t < ntl - 2; ++t) {
    step(FF{}, TT{}, TT{}, t, sa, sb, sc);
    int tmp = sa; sa = sb; sb = sc; sc = tmp;
  }
  step(FF{}, FF{}, TT{}, ntl - 2, sa, sb, sc);
  { int tmp = sa; sa = sb; sb = sc; sc = tmp; }
  step(FF{}, FF{}, FF{}, ntl - 1, sa, sb, sc);
  att_rescale(U1{});
  att_PV(U1{}, pfB, sa);

  float inv[NCOMP];
#pragma unroll
  for (int c = 0; c < NCOMP; ++c) {
    float lt = l[c] + __shfl_xor(l[c], 32);
    inv[c] = 1.f / lt;
  }
  if constexpr (EPI == 1) {
#pragma unroll
    for (int d = 0; d < 2; ++d)
#pragma unroll
      for (int vq = 0; vq < 4; ++vq) {
        float4 o = {Oa[0][d][4 * vq] * inv[0], Oa[0][d][4 * vq + 1] * inv[0], Oa[0][d][4 * vq + 2] * inv[0], Oa[0][d][4 * vq + 3] * inv[0]};
        *(float4*)(DS + (size_t)qtok * 256 + d * 32 + 8 * vq + 4 * h) = o;
      }
  } else {
    if constexpr (EPI == 2) {
      float ss = 0.f;
#pragma unroll
      for (int d = 0; d < 2; ++d)
#pragma unroll
        for (int vq = 0; vq < 4; ++vq) {
          const float4 o1 = *(const float4*)(DS + (size_t)qtok * 256 + d * 32 + 8 * vq + 4 * h);
          const float a0 = o1.x - lam * Oa[0][d][4 * vq] * inv[0];
          const float a1 = o1.y - lam * Oa[0][d][4 * vq + 1] * inv[0];
          const float a2 = o1.z - lam * Oa[0][d][4 * vq + 2] * inv[0];
          const float a3 = o1.w - lam * Oa[0][d][4 * vq + 3] * inv[0];
          Oa[0][d][4 * vq] = a0; Oa[0][d][4 * vq + 1] = a1; Oa[0][d][4 * vq + 2] = a2; Oa[0][d][4 * vq + 3] = a3;
          ss += a0 * a0 + a1 * a1 + a2 * a2 + a3 * a3;
        }
      ss += __shfl_xor(ss, 32);
      const float rs = rsqrtf(ss * (1.f / 64.f) + EPS) * onorm;
#pragma unroll
      for (int d = 0; d < 2; ++d)
#pragma unroll
        for (int v = 0; v < 16; ++v) Oa[0][d][v] *= rs * subg[d * 32 + crow(v, h)];
    } else {
#pragma unroll
      for (int d = 0; d < 2; ++d)
#pragma unroll
        for (int v = 0; v < 16; ++v) Oa[0][d][v] *= inv[0];
    }
    store_rows(O, KP1, 0, Oa[0][0], qtok, h);
    store_rows(O, KP1, 32, Oa[0][1], qtok, h);
  }
  __syncthreads();
}

DI void attn_phase(const Params& P, int layer, char* smem) {
  char* ws = P.ws;
  u16* qkv = (u16*)(ws + OFF_QKV);
  u16* BR = (u16*)(ws + OFF_XN);
  const float L2E = 1.4426950408889634f;
  const float lambda_init = 0.8f - 0.6f * __expf(-0.3f * (float)layer);
  float lam;
  {
    const float* dl = P.d_lambda + layer * 128;
    float s1 = 0.f, s2 = 0.f;
    for (int i = 0; i < 32; ++i) { s1 += dl[i] * dl[32 + i]; s2 += dl[64 + i] * dl[96 + i]; }
    lam = __expf(s1) - __expf(s2) + lambda_init;
    lam = __int_as_float(__builtin_amdgcn_readfirstlane(__float_as_int(lam)));
  }
  const float onorm_u = __int_as_float(__builtin_amdgcn_readfirstlane(__float_as_int(1.f - lambda_init)));
  bool a_nomax;
  {
    const float* ag = P.a_qk_norm + layer * 128;
    float gq = 0.f, gk = 0.f;
    for (int i = 0; i < 64; ++i) { gq = fmaxf(gq, fabsf(ag[i])); gk = fmaxf(gk, fabsf(ag[64 + i])); }
    const float bound = 64.f * gq * gk * (0.125f * L2E);
    a_nomax = __builtin_amdgcn_readfirstlane((int)(bound < 60.f)) != 0;
  }
  bool c_nomax;
  {
    const unsigned* nb = (const unsigned*)(ws + OFF_BAR) + 144 + layer * 4;
    const float qb = __uint_as_float(__hip_atomic_load(nb, __ATOMIC_RELAXED, __HIP_MEMORY_SCOPE_AGENT));
    const float kb = __uint_as_float(__hip_atomic_load(nb + 1, __ATOMIC_RELAXED, __HIP_MEMORY_SCOPE_AGENT));
    const float pe = __uint_as_float(__hip_atomic_load(nb + 2, __ATOMIC_RELAXED, __HIP_MEMORY_SCOPE_AGENT));
    const float bound = sqrtf(3.f * qb * (2.f * kb + pe)) * (0.10206207261596577f * L2E);
    c_nomax = __builtin_amdgcn_readfirstlane((int)(bound < 60.f)) != 0;
  }
  bool d_nomax;
  {
    const unsigned* nb = (const unsigned*)(ws + OFF_BAR) + 128 + layer * 2;
    const float q2 = __uint_as_float(__hip_atomic_load(nb, __ATOMIC_RELAXED, __HIP_MEMORY_SCOPE_AGENT));
    const float k2 = __uint_as_float(__hip_atomic_load(nb + 1, __ATOMIC_RELAXED, __HIP_MEMORY_SCOPE_AGENT));
    const float bound = sqrtf(q2 * k2) * (0.17677669529663687f * L2E);
    d_nomax = __builtin_amdgcn_readfirstlane((int)(bound < 60.f)) != 0;
  }
  for (int it = blockIdx.x; it < 2048; it += gridDim.x) {
    const int cls = it >> 8;
    if (cls < 6) {
      const int idx = it & 255;
      const int head = (idx & 7) >> 1;
      const int qb = ((idx >> 3) << 1) + (idx & 1);
      int qtok0, kbeg, kend;
      if (cls < 3) { qtok0 = qb * 256; kbeg = 0; kend = SEQ0; }
      else { const int s = qb >> 3; kbeg = SEQ0 + s * DSEQ; kend = kbeg + DSEQ; qtok0 = kbeg + (qb & 7) * 256; }
      const int typ = cls % 3;
      if (typ == 0) {
        float* DS = (float*)(ws + OFF_DS) + head * 64;
        if (d_nomax) {
          attn_item<32, 1, false, 1, true>(qkv + Q_QD + head * 64, 256, qkv + Q_KD + head * 64, 256,
                                           qkv + Q_VTD + (size_t)head * 64 * T, qtok0, kbeg, kend,
                                           1.f, 0.f, lam, onorm_u, P.d_subln + layer * 64, BR + 768 + head * 64, DS, smem);
          attn_item<32, 1, false, 2, true>(qkv + Q_QD + head * 64 + 32, 256, qkv + Q_KD + head * 64 + 32, 256,
                                           qkv + Q_VTD + (size_t)head * 64 * T, qtok0, kbeg, kend,
                                           1.f, 0.f, lam, onorm_u, P.d_subln + layer * 64, BR + 768 + head * 64, DS, smem);
        } else {
          attn_item<32, 1, false, 1, false>(qkv + Q_QD + head * 64, 256, qkv + Q_KD + head * 64, 256,
                                            qkv + Q_VTD + (size_t)head * 64 * T, qtok0, kbeg, kend,
                                            1.f, 0.f, lam, onorm_u, P.d_subln + layer * 64, BR + 768 + head * 64, DS, smem);
          attn_item<32, 1, false, 2, false>(qkv + Q_QD + head * 64 + 32, 256, qkv + Q_KD + head * 64 + 32, 256,
                                            qkv + Q_VTD + (size_t)head * 64 * T, qtok0, kbeg, kend,
                                            1.f, 0.f, lam, onorm_u, P.d_subln + layer * 64, BR + 768 + head * 64, DS, smem);
        }
      } else if (typ == 1) {
        if (c_nomax)
          attn_item<96, 1, false, 0, true>(qkv + Q_QC + head * 96, 384, qkv + Q_KC + head * 96, 384,
                                           qkv + Q_VTC + (size_t)head * 64 * T, qtok0, kbeg, kend,
                                           1.f, 0.f, 0.f, 1.f, nullptr, BR + 512 + head * 64, nullptr, smem);
        else
          attn_item<96, 1, false, 0, false>(qkv + Q_QC + head * 96, 384, qkv + Q_KC + head * 96, 384,
                                            qkv + Q_VTC + (size_t)head * 64 * T, qtok0, kbeg, kend,
                                            1.f, 0.f, 0.f, 1.f, nullptr, BR + 512 + head * 64, nullptr, smem);
      } else {
        if (a_nomax)
          attn_item<64, 1, false, 0, true>(qkv + Q_QA + head * 64, 256, qkv + Q_KA + (head >> 1) * 64, 128,
                                           qkv + Q_VTA + (size_t)(head >> 1) * 64 * T, qtok0, kbeg, kend,
                                           1.f, 0.f, 0.f, 1.f, nullptr, BR + head * 64, nullptr, smem);
        else
          attn_item<64, 1, false, 0, false>(qkv + Q_QA + head * 64, 256, qkv + Q_KA + (head >> 1) * 64, 128,
                                            qkv + Q_VTA + (size_t)(head >> 1) * 64 * T, qtok0, kbeg, kend,
                                            1.f, 0.f, 0.f, 1.f, nullptr, BR + head * 64, nullptr, smem);
      }
    } else {
      const int idx = it - 1536;
      const int head = (idx & 7) >> 1;
      const int qbg = ((idx >> 3) << 1) + (idx & 1);
      const int qtok0 = qbg * 256;
      int sb, se;
      if (qtok0 < SEQ0) { sb = 0; se = SEQ0; }
      else { sb = SEQ0 + ((qtok0 - SEQ0) / DSEQ) * DSEQ; se = sb + DSEQ; }
      const int kbeg = max(sb, qtok0 - 128), kend = min(se, qtok0 + 256 + 128);
      const float sink = P.b_sink[layer * 4 + head];
      attn_item<64, 1, true, 0>(qkv + Q_QB + head * 64, 256, qkv + Q_KB + (head >> 1) * 64, 128,
                                    qkv + Q_VTB + (size_t)(head >> 1) * 64 * T, qtok0, kbeg, kend,
                                    0.125f * L2E, sink * L2E, 0.f, 1.f, nullptr, BR + 256 + head * 64, nullptr, smem);
    }
  }
}

DI void ew_phase(const Params& P, const u16* __restrict__ Y, float coef, const float* __restrict__ gpost,
                 const float* __restrict__ gnext, bool from_inputs) {
  const int tid = opaque_tid();
  const int lane = tid & 63, wave = tid >> 6;
  u16* XN = (u16*)(P.ws + OFF_XN);
  u16* XB = (u16*)(P.ws + OFF_XB);
  for (int tok = blockIdx.x * 8 + wave; tok < T; tok += gridDim.x * 8) {
    float4 x[4];
    if (from_inputs) {
      const float* xs = tok < SEQ0 ? P.x_prompt + (size_t)tok * DM : P.x_sample + (size_t)(tok - SEQ0) * DM;
#pragma unroll
      for (int i = 0; i < 4; ++i) x[i] = *(const float4*)(xs + (i * 64 + lane) * 4);
    } else {
#pragma unroll
      for (int i = 0; i < 4; ++i) {
        const uint2 xb = *(const uint2*)(XB + (size_t)tok * DM + (i * 64 + lane) * 4);
        x[i] = make_float4(bf2f(xb.x & 0xffffu), bf2f(xb.x >> 16), bf2f(xb.y & 0xffffu), bf2f(xb.y >> 16));
      }
    }
    if (Y) {
      float4 y[4];
      float ss = 0.f;
#pragma unroll
      for (int i = 0; i < 4; ++i) {
        const uint2 yb = *(const uint2*)(Y + (size_t)tok * KP1 + (i * 64 + lane) * 4);
        y[i] = make_float4(bf2f(yb.x & 0xffffu), bf2f(yb.x >> 16), bf2f(yb.y & 0xffffu), bf2f(yb.y >> 16));
        ss += y[i].x * y[i].x + y[i].y * y[i].y + y[i].z * y[i].z + y[i].w * y[i].w;
      }
      ss = wave_sum(ss);
      const float rs = rsqrtf(ss * (1.f / 1024.f) + EPS) * coef;
#pragma unroll
      for (int i = 0; i < 4; ++i) {
        float4 g = *(const float4*)(gpost + (i * 64 + lane) * 4);
        x[i].x += y[i].x * rs * g.x; x[i].y += y[i].y * rs * g.y;
        x[i].z += y[i].z * rs * g.z; x[i].w += y[i].w * rs * g.w;
      }
    }
    if (!gnext) {
#pragma unroll
      for (int i = 0; i < 4; ++i) *(float4*)(P.out + (size_t)tok * DM + (i * 64 + lane) * 4) = x[i];
    } else {
#pragma unroll
      for (int i = 0; i < 4; ++i) {
        uint2 pk;
        pk.x = pk2(x[i].x, x[i].y);
        pk.y = pk2(x[i].z, x[i].w);
        *(uint2*)(XB + (size_t)tok * DM + (i * 64 + lane) * 4) = pk;
      }
    }
    if (gnext) {
      float ss = 0.f;
#pragma unroll
      for (int i = 0; i < 4; ++i) ss += x[i].x * x[i].x + x[i].y * x[i].y + x[i].z * x[i].z + x[i].w * x[i].w;
      ss = wave_sum(ss);
      const float rs = rsqrtf(ss * (1.f / 1024.f) + EPS);
#pragma unroll
      for (int i = 0; i < 4; ++i) {
        float4 g = *(const float4*)(gnext + (i * 64 + lane) * 4);
        uint2 pk;
        pk.x = pk2(x[i].x * rs * g.x, x[i].y * rs * g.y);
        pk.y = pk2(x[i].z * rs * g.z, x[i].w * rs * g.w);
        *(uint2*)(XN + (size_t)tok * KP1 + (i * 64 + lane) * 4) = pk;
      }
    }
  }
}

DI int colmap(int mode, int n, int nsrc) {
  if (mode == 1) { return ((n >> 7) & 1) * DFF + (n >> 8) * 128 + (n & 127); }
  if (mode == 2) {
    if (n < 2560) {
      const int w = n & 255;
      n = (n & ~255) + ((w >> 5) & 3) * 64 + (w >> 7) * 32 + (w & 31);
    }
    if (n < 1664) return n;
    if (n < 2432) return n + 32;
    if (n < 2464) return n - 2432 + 1664;
    if (n < 2560) return -1;
    return n - 96;
  }
  return n < nsrc ? n : -1;
}
DI void conv_job(u16* __restrict__ dst, int ldd, const float* __restrict__ src, int Nd, int K, int lds, int mode,
                 const float* __restrict__ kscale) {
  const int total = Nd * (K >> 3);
  const int gthreads = gridDim.x * NTHR;
  for (int idx = blockIdx.x * NTHR + opaque_tid(); idx < total; idx += gthreads) {
    const int n = idx % Nd, k8 = idx / Nd;
    const int col = colmap(mode, n, lds);
    float v[8];
#pragma unroll
    for (int j = 0; j < 8; ++j) {
      float x = 0.f;
      if (col >= 0) {
        x = src[(size_t)(k8 * 8 + j) * lds + col];
        if (kscale) x *= kscale[k8 * 8 + j];
      }
      v[j] = x;
    }
    uint4 pk = {pk2(v[0], v[1]), pk2(v[2], v[3]), pk2(v[4], v[5]), pk2(v[6], v[7])};
    *(uint4*)(dst + (size_t)n * ldd + k8 * 8) = pk;
  }
}
DI void convert_layer(const Params& P, int l) {
  u16* W = (u16*)(P.ws + OFF_W);
  for (int s = 0; s < 2; ++s) {
    conv_job(W + W_WI + (size_t)s * 5632 * KP1, KP1, P.ffn_wi + ((size_t)l * 2 + s) * 1024 * 5632, 5632, 1024, 5632, 1, nullptr);
    conv_job(W + W_WO + (size_t)s * 1024 * KP2, KP2, P.ffn_wo + ((size_t)l * 2 + s) * 2816 * 1024, 1024, 2816, 1024, 0, nullptr);
  }
  conv_job(W + W_WIN, KP1, P.w_in + (size_t)l * 1024 * NPROJ, 6656, 1024, NPROJ, 2, nullptr);
  conv_job(W + W_WUQ, 384, P.c_w_uq + (size_t)l * 384 * 384, 512, 384, 384, 0, P.c_q_norm + l * 384);
  conv_job(W + W_WUKV, 256, P.c_w_ukv + (size_t)l * 256 * 512, 512, 256, 512, 0, P.c_kv_norm + l * 256);
  conv_job(W + W_WB, KP1, P.w_branch + (size_t)l * 1024 * 1024, 1024, 1024, 1024, 0, nullptr);
  conv_job(W + W_WOUT, KP1, P.w_out + (size_t)l * 1024 * 1024, 1024, 1024, 1024, 0, nullptr);
}
DI void rope_tables(const Params& P) {
  float2* R64 = (float2*)(P.ws + OFF_R64);
  float2* R32 = (float2*)(P.ws + OFF_R32);
  const int gthreads = gridDim.x * NTHR;
  for (int idx = blockIdx.x * NTHR + opaque_tid(); idx < 16384 * 48; idx += gthreads) {
    int pos, f; double base; float2* dst;
    if (idx < 16384 * 32) { pos = idx >> 5; f = idx & 31; base = 0.7498942093324559; dst = R64 + idx; }
    else { const int i2 = idx - 16384 * 32; pos = i2 >> 4; f = i2 & 15; base = 0.5623413251903491; dst = R32 + i2; }
    double inv = 1.0;
    for (int k = 0; k < f; ++k) inv *= base;
    const float ang = (float)pos * (float)inv;
    double tr = (double)ang * 0.15915494309189535;
    tr -= rint(tr);
    const float tf = (float)tr;
    *dst = make_float2(__builtin_amdgcn_cosf(tf), __builtin_amdgcn_sinf(tf));
  }
}

DI void fast_grid_barrier(unsigned* bar, unsigned nblk) {
  asm volatile("s_waitcnt vmcnt(0) lgkmcnt(0)" ::: "memory");
  __syncthreads();
  if (threadIdx.x == 0) {
    __builtin_amdgcn_fence(__ATOMIC_RELEASE, "agent");
    asm volatile("s_waitcnt vmcnt(0) lgkmcnt(0)" ::: "memory");
    const unsigned gen = __hip_atomic_load(&bar[64], __ATOMIC_RELAXED, __HIP_MEMORY_SCOPE_AGENT);
    const unsigned old = __hip_atomic_fetch_add(&bar[0], 1u, __ATOMIC_RELAXED, __HIP_MEMORY_SCOPE_AGENT);
    if (old == nblk - 1u) {
      __hip_atomic_store(&bar[0], 0u, __ATOMIC_RELAXED, __HIP_MEMORY_SCOPE_AGENT);
      __hip_atomic_fetch_add(&bar[64], 1u, __ATOMIC_RELEASE, __HIP_MEMORY_SCOPE_AGENT);
    } else {
      while (__hip_atomic_load(&bar[64], __ATOMIC_RELAXED, __HIP_MEMORY_SCOPE_AGENT) == gen) __builtin_amdgcn_s_sleep(1);
    }
    __builtin_amdgcn_fence(__ATOMIC_ACQUIRE, "agent");
    asm volatile("s_waitcnt vmcnt(0) lgkmcnt(0)" ::: "memory");
  }
  __syncthreads();
}

__global__ void __launch_bounds__(NTHR) __attribute__((amdgpu_waves_per_eu(2, 2))) mega(Params P) {
  extern __shared__ __attribute__((aligned(16))) char smem[];
  cg::grid_group grid = cg::this_grid();
  int phase = 0;
#if MULTI_LAUNCH
#define ACTIVE() (phase >= P.phase_lo && phase < P.phase_hi)
#define SEAM() do { ++phase; } while (0)
#else
#define ACTIVE() (true)
#define SEAM() do { ++phase; if (phase == 1) grid.sync(); else fast_grid_barrier((unsigned*)(P.ws + OFF_BAR), gridDim.x); } while (0)
#endif
  u16* W = (u16*)(P.ws + OFF_W);
  u16* XN = (u16*)(P.ws + OFF_XN);
  u16* R2 = (u16*)(P.ws + OFF_R2);
  u16* qkv = (u16*)(P.ws + OFF_QKV);
  const u16* Y = qkv + Q_Y;
#define PTRS

  if (ACTIVE()) { PTRS
    rope_tables(P);
    convert_layer(P, 0);
    ew_phase(P, nullptr, 0.f, nullptr, P.norm_g, true);
  }
  SEAM();
  for (int l = 0; l < 4; ++l) {
    const float* g = P.norm_g + (size_t)l * 6 * DM;
    if (ACTIVE()) { PTRS gemm8_phase<5632, DM, KP1>(XN, W + W_WI, EpiFfnUp8{R2}, smem); }
    SEAM();
    if (ACTIVE()) { PTRS gemm8_phase<1024, DFF, KP2>(R2, W + W_WO, EpiY8{qkv + Q_Y}, smem); }
    SEAM();
    if (ACTIVE()) { PTRS ew_phase(P, Y, 0.5f, g + DM, g + 2 * DM, false); }
    SEAM();
    if (ACTIVE()) { PTRS
      gemm8_phase<2560, DM, KP1>(XN, W + W_WIN, EpiProj8{&P, l}, smem);
      gemm8_phase<4096, DM, KP1>(XN, W + W_WIN + 2560ull * KP1, EpiGate8{(unsigned char*)R2}, smem);
    }
    SEAM();
    if (ACTIVE()) { PTRS
      gemm_phase<M_CUQ, 4>(W + W_WUQ, 384, qkv + Q_CQ, 384, 384, 2, smem, P, l);
      gemm_phase<M_CUKV, 4>(W + W_WUKV, 256, qkv + Q_CKV, 256, 256, 2, smem, P, l);
    }
    SEAM();
    if (ACTIVE()) { PTRS attn_phase(P, l, smem); }
    SEAM();
    if (ACTIVE()) { PTRS gemm_phase<M_MERGE, 2>(W + W_WB, KP1, XN, KP1, DM, 4, smem, P, l); }
    SEAM();
    if (ACTIVE()) { PTRS gemm8_phase<1024, DM, KP1>(qkv + Q_MERGED, W + W_WOUT, EpiY8{qkv + Q_Y}, smem); }
    SEAM();
    if (ACTIVE()) { PTRS ew_phase(P, Y, 1.0f, g + 3 * DM, g + 4 * DM, false); }
    SEAM();
    if (ACTIVE()) { PTRS gemm8_phase<5632, DM, KP1>(XN, W + W_WI + 5632ull * KP1, EpiFfnUp8{R2}, smem); }
    SEAM();
    if (ACTIVE()) { PTRS gemm8_phase<1024, DFF, KP2>(R2, W + W_WO + 1024ull * KP2, EpiY8{qkv + Q_Y}, smem); }
    SEAM();
    if (ACTIVE()) { PTRS
      ew_phase(P, Y, 0.5f, g + 5 * DM, l < 3 ? g + 6 * DM : nullptr, false);
      if (l < 3) convert_layer(P, l + 1);
    }
    SEAM();
  }
}

constexpr int N_PHASES = 1 + 12 * 4;

extern "C" void kernel_launch(void* const* d_in, const int* in_sizes, int n_in, void* d_out, int out_size, void* d_ws,
                              size_t ws_size, hipStream_t stream) {
  static int grid_blocks = 0;
  if (!grid_blocks) {
    int dev = 0, cus = 0, per_cu = 0;
    hipGetDevice(&dev);
    hipDeviceGetAttribute(&cus, hipDeviceAttributeMultiprocessorCount, dev);
    hipFuncSetAttribute((const void*)mega, hipFuncAttributeMaxDynamicSharedMemorySize, SMEM_BYTES);
    hipOccupancyMaxActiveBlocksPerMultiprocessor(&per_cu, mega, NTHR, SMEM_BYTES);
    if (per_cu < 1) per_cu = 1;
    grid_blocks = cus * per_cu;
  }
  if (ws_size < WS_NEEDED) fprintf(stderr, "workspace too small: %zu < %zu\n", ws_size, (size_t)WS_NEEDED);
  Params P{};
  P.x_prompt = (const float*)d_in[0]; P.x_sample = (const float*)d_in[1]; P.norm_g = (const float*)d_in[2];
  P.w_in = (const float*)d_in[3]; P.a_qk_norm = (const float*)d_in[4]; P.b_sink = (const float*)d_in[5];
  P.c_q_norm = (const float*)d_in[6]; P.c_kv_norm = (const float*)d_in[7]; P.c_w_uq = (const float*)d_in[8];
  P.c_w_ukv = (const float*)d_in[9]; P.d_lambda = (const float*)d_in[10]; P.d_subln = (const float*)d_in[11];
  P.w_branch = (const float*)d_in[12]; P.w_out = (const float*)d_in[13]; P.ffn_wi = (const float*)d_in[14];
  P.ffn_wo = (const float*)d_in[15];
  P.out = (float*)d_out; P.ws = (char*)d_ws;
#if MULTI_LAUNCH
  for (int ph = 0; ph < N_PHASES; ++ph) {
    P.phase_lo = ph; P.phase_hi = ph + 1; P.coop = 0; P.pad0 = 0;
    hipLaunchKernelGGL(mega, dim3(grid_blocks), dim3(NTHR), SMEM_BYTES, stream, P);
  }
#else
  P.phase_lo = 0; P.phase_hi = 1 << 30; P.coop = 1; P.pad0 = 0;
  hipMemsetAsync((char*)d_ws + OFF_BAR, 0, 1024, stream);
  void* args[] = {&P};
  hipError_t e = hipLaunchCooperativeKernel((const void*)mega, dim3(grid_blocks), dim3(NTHR), args, SMEM_BYTES, stream);
  if (e != hipSuccess) fprintf(stderr, "cooperative launch failed: %s (grid %d)\n", hipGetErrorString(e), grid_blocks);
#endif
}
```

```cpp
#include <hip/hip_runtime.h>
#include <hip/hip_cooperative_groups.h>
#include <cstdio>
#include <cstdint>
#include <type_traits>
namespace cg = cooperative_groups;

#ifndef MULTI_LAUNCH
#define MULTI_LAUNCH 0
#endif

#define DI __device__ __forceinline__
typedef unsigned short u16;
typedef __attribute__((ext_vector_type(8))) short bf16x8;
typedef __attribute__((ext_vector_type(16))) float f32x16;
typedef __attribute__((ext_vector_type(2))) float f32x2_t;
typedef __attribute__((ext_vector_type(2))) __bf16 bf16x2_t;

constexpr int T = 32768;
constexpr int DM = 1024;
constexpr int DFF = 2816;
constexpr int KP1 = 1088;
constexpr int KP2 = 2880;
constexpr int GP = 4160;
constexpr int YP = 1040;
constexpr int NPROJ = 6560;
constexpr int SEQ0 = 16384;
constexpr int DSEQ = 2048;
constexpr float EPS = 1e-6f;
constexpr int NTHR = 512;
constexpr int LSTR = 72;
constexpr int SMEM_BYTES = 2 * 2 * 256 * LSTR * 2;

constexpr size_t W_WI = 0;
constexpr size_t W_WO = W_WI + 2ull * 5632 * KP1;
constexpr size_t W_WIN = W_WO + 2ull * 1024 * KP2;
constexpr size_t W_WUQ = W_WIN + 6656ull * KP1;
constexpr size_t W_WUKV = W_WUQ + 512ull * 384;
constexpr size_t W_WB = W_WUKV + 512ull * 256;
constexpr size_t W_WOUT = W_WB + 1024ull * KP1;
constexpr size_t W_TOTAL = W_WOUT + 1024ull * KP1;

constexpr size_t OFF_W = 0;
constexpr size_t OFF_XN = OFF_W + W_TOTAL * 2;
constexpr size_t OFF_R2 = OFF_XN + (size_t)T * KP1 * 2;
constexpr size_t OFF_QKV = OFF_R2 + (size_t)T * KP2 * 2;
constexpr size_t OFF_SS = OFF_QKV + (size_t)T * 3456 * 2;
constexpr size_t OFF_R64 = OFF_SS + (size_t)T * 20 * 4;
constexpr size_t OFF_R32 = OFF_R64 + 16384ull * 32 * 8;
constexpr size_t OFF_DS = OFF_R32 + 16384ull * 16 * 8;
constexpr size_t OFF_BAR = OFF_DS + (size_t)T * 256 * 4;
constexpr size_t OFF_XB = OFF_BAR + 1024;
constexpr size_t WS_NEEDED = OFF_XB + (size_t)T * 1024 * 2;

constexpr size_t Q_QA = 0;
constexpr size_t Q_KA = (size_t)T * 256;
constexpr size_t Q_VTA = (size_t)T * 384;
constexpr size_t Q_QB = (size_t)T * 512;
constexpr size_t Q_KB = (size_t)T * 768;
constexpr size_t Q_VTB = (size_t)T * 896;
constexpr size_t Q_CQ = (size_t)T * 1024;
constexpr size_t Q_CKV = (size_t)T * 1408;
constexpr size_t Q_QC = (size_t)T * 1664;
constexpr size_t Q_KC = (size_t)T * 2048;
constexpr size_t Q_VTC = (size_t)T * 2432;
constexpr size_t Q_QD = (size_t)T * 2688;
constexpr size_t Q_KD = (size_t)T * 2944;
constexpr size_t Q_VTD = (size_t)T * 3200;
constexpr size_t Q_MERGED = 0;
constexpr size_t Q_Y = (size_t)T * KP1;

struct Params {
  const float* x_prompt; const float* x_sample; const float* norm_g; const float* w_in;
  const float* a_qk_norm; const float* b_sink; const float* c_q_norm; const float* c_kv_norm;
  const float* c_w_uq; const float* c_w_ukv; const float* d_lambda; const float* d_subln;
  const float* w_branch; const float* w_out; const float* ffn_wi; const float* ffn_wo;
  float* out; char* ws;
  int phase_lo; int phase_hi; int coop; int pad0;
};

DI unsigned pk2(float a, float b) {
  f32x2_t v = {a, b};
  bf16x2_t r = __builtin_convertvector(v, bf16x2_t);
  return __builtin_bit_cast(unsigned, r);
}
DI u16 f2bf(float a) { return (u16)(pk2(a, 0.f) & 0xffffu); }
DI float bf2f(unsigned bits16) { return __uint_as_float(bits16 << 16); }
DI int crow(int v, int h) { return (v & 3) + 8 * (v >> 2) + 4 * h; }
DI int pos_of(int tok) { return tok < SEQ0 ? tok : ((tok - SEQ0) & (DSEQ - 1)); }
#define MFMA32(a, b, c) __builtin_amdgcn_mfma_f32_32x32x16_bf16((a), (b), (c), 0, 0, 0)

typedef __attribute__((ext_vector_type(4))) unsigned u32x4;
DI u32x4 gld16(const void* p) { u32x4 r; asm volatile("global_load_dwordx4 %0, %1, off" : "=v"(r) : "v"(p)); return r; }
DI void wait_vm0(u32x4& a) { asm volatile("s_waitcnt vmcnt(0)" : "+v"(a) :: "memory"); }
DI void wait_vm0(u32x4& a, u32x4& b) { asm volatile("s_waitcnt vmcnt(0)" : "+v"(a), "+v"(b) :: "memory"); }
DI void wait_vm0(u32x4& a, u32x4& b, u32x4& c) { asm volatile("s_waitcnt vmcnt(0)" : "+v"(a), "+v"(b), "+v"(c) :: "memory"); }
DI void wait_vm0(u32x4& a, u32x4& b, u32x4& c, u32x4& d) { asm volatile("s_waitcnt vmcnt(0)" : "+v"(a), "+v"(b), "+v"(c), "+v"(d) :: "memory"); }
DI u32x4 gld16s(unsigned voff, const void* sbase) { u32x4 r; asm volatile("global_load_dwordx4 %0, %1, %2" : "=v"(r) : "v"(voff), "s"(sbase)); return r; }
#define DEF_WAIT8(name, cnt) DI void name(u32x4& a, u32x4& b, u32x4& c, u32x4& d, u32x4& e, u32x4& f, u32x4& g, u32x4& h) { asm volatile("s_waitcnt vmcnt(" #cnt ")" : "+v"(a), "+v"(b), "+v"(c), "+v"(d), "+v"(e), "+v"(f), "+v"(g), "+v"(h) :: "memory"); }
#define DEF_WAIT6(name, cnt) DI void name(u32x4& a, u32x4& b, u32x4& c, u32x4& d, u32x4& e, u32x4& f) { asm volatile("s_waitcnt vmcnt(" #cnt ")" : "+v"(a), "+v"(b), "+v"(c), "+v"(d), "+v"(e), "+v"(f) :: "memory"); }
DEF_WAIT8(wait8_vm8, 8)
DEF_WAIT8(wait8_vm0, 0)
DEF_WAIT6(wait6_vm6, 6)
DEF_WAIT6(wait6_vm0, 0)
DI int opaque_tid() { int t = threadIdx.x; asm volatile("" : "+v"(t)); return t; }
DI float wave_sum(float v) {
#pragma unroll
  for (int m = 32; m >= 1; m >>= 1) v += __shfl_xor(v, m);
  return v;
}

DI void rope32_blk(f32x16& a, const float2* __restrict__ tab, int h) {
#pragma unroll
  for (int v = 0; v < 8; ++v) {
    float2 cs = tab[crow(v, h)];
    float x1 = a[v], x2 = a[v + 8];
    a[v] = x1 * cs.x - x2 * cs.y;
    a[v + 8] = x2 * cs.x + x1 * cs.y;
  }
}
DI void rope64_blk(f32x16& a0, f32x16& a1, const float2* __restrict__ tab, int h) {
#pragma unroll
  for (int v = 0; v < 16; ++v) {
    float2 cs = tab[crow(v, h)];
    float x1 = a0[v], x2 = a1[v];
    a0[v] = x1 * cs.x - x2 * cs.y;
    a1[v] = x2 * cs.x + x1 * cs.y;
  }
}
DI void store_rows(u16* __restrict__ base, int ld, int col0, const f32x16& a, int tok, int h, float sc = 1.f) {
#pragma unroll
  for (int vq = 0; vq < 4; ++vq) {
    uint2 pk;
    pk.x = pk2(a[4 * vq] * sc, a[4 * vq + 1] * sc);
    pk.y = pk2(a[4 * vq + 2] * sc, a[4 * vq + 3] * sc);
    *(uint2*)(base + (size_t)tok * ld + col0 + 8 * vq + 4 * h) = pk;
  }
}
DI void store_T(u16* __restrict__ base, int row0, const f32x16& a, int tok, int h) {
  const int tp = (tok & ~12) | ((tok & 4) << 1) | ((tok & 8) >> 1);
#pragma unroll
  for (int v = 0; v < 16; ++v) base[(size_t)((row0 + crow(v, h)) >> 6) * 64 * T + (size_t)(tp >> 7) * 8192 + ((row0 + crow(v, h)) & 63) * 128 + (tp & 127)] = f2bf(a[v]);
}

enum { M_FFNUP = 0, M_Y = 1, M_PROJ = 2, M_CUQ = 3, M_CUKV = 4, M_MERGE = 5, M_GATE = 6 };

template <int MODE, int NJ>
DI void gemm_epilogue(f32x16 (&acc)[2][NJ], int fbase, int tbase, int r, int h, const Params& P, int layer) {
  char* ws = P.ws;
  u16* qkv = (u16*)(ws + OFF_QKV);
  const float2* R64 = (const float2*)(ws + OFF_R64);
  const float2* R32 = (const float2*)(ws + OFF_R32);
  float* SS = (float*)(ws + OFF_SS);
  if constexpr (MODE == M_FFNUP) {
    u16* H = (u16*)(ws + OFF_R2);
    const int hf0 = (fbase >> 6) * 32;
#pragma unroll
    for (int j = 0; j < NJ; ++j) {
      const int tok = tbase + j * 32 + r;
      f32x16 o;
#pragma unroll
      for (int v = 0; v < 16; ++v) {
        float g = acc[0][j][v], u = acc[1][j][v];
        o[v] = g * __builtin_amdgcn_rcpf(1.f + __builtin_amdgcn_exp2f(-1.4426950408889634f * g)) * u;
      }
      store_rows(H, KP2, hf0, o, tok, h);
    }
  } else if constexpr (MODE == M_Y) {
    u16* Yb = qkv + Q_Y;
#pragma unroll
    for (int j = 0; j < NJ; ++j) {
      const int tok = tbase + j * 32 + r;
      store_rows(Yb, KP1, fbase, acc[0][j], tok, h);
      store_rows(Yb, KP1, fbase + 32, acc[1][j], tok, h);
    }
  } else if constexpr (MODE == M_PROJ) {
    if (fbase < 384) {
      const bool isK = fbase >= 256;
      const float* g = P.a_qk_norm + layer * 128 + (isK ? 64 : 0);
      u16* dst = qkv + (isK ? Q_KA : Q_QA);
      const int ld = isK ? 128 : 256;
      const int c0 = isK ? fbase - 256 : fbase;
      float gv[2][16];
#pragma unroll
      for (int i = 0; i < 2; ++i)
#pragma unroll
        for (int v = 0; v < 16; ++v) gv[i][v] = g[i * 32 + crow(v, h)];
#pragma unroll
      for (int j = 0; j < NJ; ++j) {
        const int tok = tbase + j * 32 + r;
        const int pos = pos_of(tok);
        float ss = 0.f;
#pragma unroll
        for (int i = 0; i < 2; ++i)
#pragma unroll
          for (int v = 0; v < 16; ++v) ss += acc[i][j][v] * acc[i][j][v];
        ss += __shfl_xor(ss, 32);
        const float rs = rsqrtf(ss * (1.f / 64.f) + EPS);
#pragma unroll
        for (int i = 0; i < 2; ++i)
#pragma unroll
          for (int v = 0; v < 16; ++v) acc[i][j][v] *= rs * gv[i][v];
        rope32_blk(acc[0][j], R32 + (size_t)(pos >> 6) * 16, h);
        rope32_blk(acc[1][j], R32 + (size_t)(pos & 63) * 16, h);
        store_rows(dst, ld, c0, acc[0][j], tok, h);
        store_rows(dst, ld, c0 + 32, acc[1][j], tok, h);
      }
    } else if (fbase < 512) {
#pragma unroll
      for (int j = 0; j < NJ; ++j) {
        const int tok = tbase + j * 32 + r;
        store_T(qkv + Q_VTA, fbase - 384, acc[0][j], tok, h);
        store_T(qkv + Q_VTA, fbase - 384 + 32, acc[1][j], tok, h);
      }
    } else if (fbase < 896) {
      const bool isK = fbase >= 768;
      u16* dst = qkv + (isK ? Q_KB : Q_QB);
      const int ld = isK ? 128 : 256;
      const int c0 = isK ? fbase - 768 : fbase - 512;
#pragma unroll
      for (int j = 0; j < NJ; ++j) {
        const int tok = tbase + j * 32 + r;
        const int pos = pos_of(tok);
        rope64_blk(acc[0][j], acc[1][j], R64 + (size_t)pos * 32, h);
        store_rows(dst, ld, c0, acc[0][j], tok, h);
        store_rows(dst, ld, c0 + 32, acc[1][j], tok, h);
      }
    } else if (fbase < 1024) {
#pragma unroll
      for (int j = 0; j < NJ; ++j) {
        const int tok = tbase + j * 32 + r;
        store_T(qkv + Q_VTB, fbase - 896, acc[0][j], tok, h);
        store_T(qkv + Q_VTB, fbase - 896 + 32, acc[1][j], tok, h);
      }
    } else if (fbase < 1664) {
      const bool isKV = fbase >= 1408;
      u16* dst = qkv + (isKV ? Q_CKV : Q_CQ);
      const int ld = isKV ? 256 : 384;
      const int c0 = isKV ? fbase - 1408 : fbase - 1024;
      const int sb = (isKV ? 12 : 0) + (c0 >> 5);
#pragma unroll
      for (int j = 0; j < NJ; ++j) {
        const int tok = tbase + j * 32 + r;
#pragma unroll
        for (int i = 0; i < 2; ++i) {
          float ss = 0.f;
#pragma unroll
          for (int v = 0; v < 16; ++v) ss += acc[i][j][v] * acc[i][j][v];
          ss += __shfl_xor(ss, 32);
          if (h == 0) SS[(size_t)tok * 20 + sb + i] = ss;
          store_rows(dst, ld, c0 + i * 32, acc[i][j], tok, h);
        }
      }
    } else if (fbase < 2176) {
      const bool isK = fbase >= 1920;
      u16* dst = qkv + (isK ? Q_KD : Q_QD);
      const int c0 = isK ? fbase - 1920 : fbase - 1664;
#pragma unroll
      for (int j = 0; j < NJ; ++j) {
        const int tok = tbase + j * 32 + r;
        const int pos = pos_of(tok);
#pragma unroll
        for (int i = 0; i < 2; ++i) {
          rope32_blk(acc[i][j], R32 + (size_t)pos * 16, h);
          store_rows(dst, 256, c0 + i * 32, acc[i][j], tok, h);
        }
      }
    } else if (fbase < 2432) {
#pragma unroll
      for (int j = 0; j < NJ; ++j) {
        const int tok = tbase + j * 32 + r;
        store_T(qkv + Q_VTD, fbase - 2176, acc[0][j], tok, h);
        store_T(qkv + Q_VTD, fbase - 2176 + 32, acc[1][j], tok, h);
      }
    } else if (fbase == 2432) {
#pragma unroll
      for (int j = 0; j < NJ; ++j) {
        const int tok = tbase + j * 32 + r;
        const int pos = pos_of(tok);
        rope32_blk(acc[0][j], R32 + (size_t)pos * 16, h);
#pragma unroll
        for (int hd = 0; hd < 4; ++hd) store_rows(qkv + Q_KC, 384, hd * 96 + 64, acc[0][j], tok, h);
      }
    }
  } else if constexpr (MODE == M_GATE) {
    unsigned char* G8 = (unsigned char*)(ws + OFF_R2);
#pragma unroll
    for (int j = 0; j < NJ; ++j) {
      const int tok = tbase + j * 32 + r;
#pragma unroll
      for (int i = 0; i < 2; ++i)
#pragma unroll
        for (int vq = 0; vq < 4; ++vq) {
          unsigned pk = 0u;
#pragma unroll
          for (int e = 0; e < 4; ++e) {
            const float o = __builtin_amdgcn_rcpf(1.f + __builtin_amdgcn_exp2f(-1.4426950408889634f * acc[i][j][4 * vq + e]));
            pk |= (unsigned)(o * 255.f + 0.5f) << (8 * e);
          }
          *(unsigned*)(G8 + (size_t)tok * GP + fbase + i * 32 + 8 * vq + 4 * h) = pk;
        }
    }
  } else if constexpr (MODE == M_CUQ) {
    if (fbase >= 384) return;
    float cn = 0.f;
#pragma unroll
    for (int j = 0; j < NJ; ++j) {
      const int tok = tbase + j * 32 + r;
      const int pos = pos_of(tok);
      float ss = 0.f;
#pragma unroll
      for (int b = 0; b < 12; ++b) ss += SS[(size_t)tok * 20 + b];
      const float rs = rsqrtf(ss * (1.f / 384.f) + EPS);
#pragma unroll
      for (int i = 0; i < 2; ++i) {
        const int blk = (fbase >> 5) + i;
        float hs = 0.f;
#pragma unroll
        for (int v = 0; v < 16; ++v) { acc[i][j][v] *= rs; hs += acc[i][j][v] * acc[i][j][v]; }
        cn = fmaxf(cn, hs);
        if (blk % 3 == 2) rope32_blk(acc[i][j], R32 + (size_t)pos * 16, h);
        store_rows(qkv + Q_QC, 384, blk * 32, acc[i][j], tok, h, 0.10206207261596577f * 1.4426950408889634f);
      }
    }
    {
      float v = cn * 2.f;
#pragma unroll
      for (int mk = 32; mk >= 1; mk >>= 1) v = fmaxf(v, __shfl_xor(v, mk));
      if ((opaque_tid() & 63) == 0) atomicMax((unsigned*)(ws + OFF_BAR) + 144 + layer * 4 + 0, __float_as_uint(v));
    }
  } else if constexpr (MODE == M_CUKV) {
    float cn = 0.f;
#pragma unroll
    for (int j = 0; j < NJ; ++j) {
      const int tok = tbase + j * 32 + r;
      float ss = 0.f;
#pragma unroll
      for (int b = 0; b < 8; ++b) ss += SS[(size_t)tok * 20 + 12 + b];
      const float rs = rsqrtf(ss * (1.f / 256.f) + EPS);
#pragma unroll
      for (int i = 0; i < 2; ++i) {
        const int blk = (fbase >> 5) + i;
        const int hd = blk >> 2, q = blk & 3;
#pragma unroll
        for (int v = 0; v < 16; ++v) acc[i][j][v] *= rs;
        if (q < 2) {
          float hs = 0.f;
#pragma unroll
          for (int v = 0; v < 16; ++v) hs += acc[i][j][v] * acc[i][j][v];
          cn = fmaxf(cn, hs);
          store_rows(qkv + Q_KC, 384, hd * 96 + q * 32, acc[i][j], tok, h);
        } else store_T(qkv + Q_VTC, hd * 64 + (q - 2) * 32, acc[i][j], tok, h);
      }
    }
    {
      float v = cn * 2.f;
#pragma unroll
      for (int mk = 32; mk >= 1; mk >>= 1) v = fmaxf(v, __shfl_xor(v, mk));
      if ((opaque_tid() & 63) == 0) atomicMax((unsigned*)(ws + OFF_BAR) + 144 + layer * 4 + 1, __float_as_uint(v));
    }
  } else if constexpr (MODE == M_MERGE) {
#pragma unroll
    for (int j = 0; j < NJ; ++j) {
      const int tok = tbase + j * 32 + r;
      store_rows(qkv + Q_MERGED, KP1, fbase, acc[0][j], tok, h);
      store_rows(qkv + Q_MERGED, KP1, fbase + 32, acc[1][j], tok, h);
    }
  }
}

typedef __attribute__((address_space(3))) unsigned lds_u32_t;
typedef __attribute__((address_space(1))) const unsigned glb_u32_t;
template <int MODE, int NJ>
DI void gemm_tile(const u16* __restrict__ Wt, int ldw, const u16* __restrict__ X, int ldx, int K, int f0, int t0, char* smem,
                  const Params& P, int layer) {
  constexpr int XROWS = NJ * 64;
  constexpr int WSTG = 256 * 64, XSTG = XROWS * 64;
  u16* sW = (u16*)smem;
  u16* sX = sW + 2 * WSTG;
  const int tid = opaque_tid(), lane = tid & 63, wave = tid >> 6, r = lane & 31, h = lane >> 5;
  const int wf = wave & 3, wt = wave >> 2;
  f32x16 acc[2][NJ];
  f32x16 tot[2][MODE == M_MERGE ? NJ : 1];
#pragma unroll
  for (int i = 0; i < 2; ++i)
#pragma unroll
    for (int j = 0; j < NJ; ++j)
#pragma unroll
      for (int v = 0; v < 16; ++v) acc[i][j][v] = 0.f;
  if constexpr (MODE == M_MERGE) {
#pragma unroll
    for (int i = 0; i < 2; ++i)
#pragma unroll
      for (int j = 0; j < NJ; ++j)
#pragma unroll
        for (int v = 0; v < 16; ++v) tot[i][j][v] = 0.f;
  }
  const int nk = K >> 6;
  const int srow = tid >> 3;
  const int schunk = (tid & 7) ^ ((tid >> 4) & 7);
  const u16* wp = Wt + (size_t)(f0 + srow) * ldw + schunk * 8;
  const u16* xp = X + (size_t)(t0 + srow) * ldx + schunk * 8;
  const int fbase = f0 + wf * 64, tbase = t0 + wt * (NJ * 32);

  auto issue = [&](int kt, int buf) {
#pragma unroll
    for (int i = 0; i < 4; ++i)
      __builtin_amdgcn_global_load_lds((glb_u32_t*)(wp + (size_t)(i * 64) * ldw + kt * 64),
                                       (lds_u32_t*)(sW + buf * WSTG + i * 4096 + tid * 8), 16, 0, 0);
#pragma unroll
    for (int i = 0; i < NJ; ++i)
      __builtin_amdgcn_global_load_lds((glb_u32_t*)(xp + (size_t)(i * 64) * ldx + kt * 64),
                                       (lds_u32_t*)(sX + buf * XSTG + i * 4096 + tid * 8), 16, 0, 0);
  };
  const int swz = (r >> 1) & 7;
  auto compute = [&](int buf, int kt) {
    const u16* aW = sW + buf * WSTG + (wf * 64 + r) * 64;
    const u16* aX = sX + buf * XSTG + (wt * (NJ * 32) + r) * 64;
#pragma unroll
    for (int ks = 0; ks < 4; ++ks) {
      const int co = ((2 * ks + h) ^ swz) * 8;
      bf16x8 wfrag[2], xfrag[NJ];
#pragma unroll
      for (int i = 0; i < 2; ++i) wfrag[i] = *(const bf16x8*)(aW + i * 32 * 64 + co);
#pragma unroll
      for (int j = 0; j < NJ; ++j) xfrag[j] = *(const bf16x8*)(aX + j * 32 * 64 + co);
#pragma unroll
      for (int i = 0; i < 2; ++i)
#pragma unroll
        for (int j = 0; j < NJ; ++j) acc[i][j] = MFMA32(wfrag[i], xfrag[j], acc[i][j]);
    }
    if constexpr (MODE == M_MERGE) {
      if ((kt & 3) == 3) {
        const int br = kt >> 2;
        const unsigned char* G8 = (const unsigned char*)(P.ws + OFF_R2);
#pragma unroll
        for (int j = 0; j < NJ; ++j) {
          const int tok = tbase + j * 32 + r;
#pragma unroll
          for (int i = 0; i < 2; ++i)
#pragma unroll
            for (int vq = 0; vq < 4; ++vq) {
              const unsigned gp = *(const unsigned*)(G8 + (size_t)tok * GP + br * 1024 + fbase + i * 32 + 8 * vq + 4 * h);
              tot[i][j][4 * vq + 0] += (float)(gp & 0xffu) * (1.f / 255.f) * acc[i][j][4 * vq + 0];
              tot[i][j][4 * vq + 1] += (float)((gp >> 8) & 0xffu) * (1.f / 255.f) * acc[i][j][4 * vq + 1];
              tot[i][j][4 * vq + 2] += (float)((gp >> 16) & 0xffu) * (1.f / 255.f) * acc[i][j][4 * vq + 2];
              tot[i][j][4 * vq + 3] += (float)(gp >> 24) * (1.f / 255.f) * acc[i][j][4 * vq + 3];
              acc[i][j][4 * vq + 0] = 0.f; acc[i][j][4 * vq + 1] = 0.f;
              acc[i][j][4 * vq + 2] = 0.f; acc[i][j][4 * vq + 3] = 0.f;
            }
        }
      }
    }
  };

  issue(0, 0);
  asm volatile("s_waitcnt vmcnt(0)" ::: "memory");
  __syncthreads();
  for (int kt = 0; kt < nk; ++kt) {
    const int buf = kt & 1;
    if (kt + 1 < nk) issue(kt + 1, buf ^ 1);
    compute(buf, kt);
    asm volatile("s_waitcnt vmcnt(0) lgkmcnt(0)" ::: "memory");
    __syncthreads();
  }
  if constexpr (MODE == M_MERGE) gemm_epilogue<MODE, NJ>(tot, fbase, tbase, r, h, P, layer);
  else gemm_epilogue<MODE, NJ>(acc, fbase, tbase, r, h, P, layer);
}

template <int MODE, int NJ>
DI void gemm_phase(const u16* Wt, int ldw, const u16* X, int ldx, int K, int nF, char* smem, const Params& P, int layer) {
  constexpr int TT = NJ * 64;
  const int nT = T / TT;
  const int ntiles = nF * nT;
  for (int idx = blockIdx.x; idx < ntiles; idx += gridDim.x) {
    const int tt_lo = idx & 15;
    const int rest = idx >> 4;
    const int ft = rest % nF;
    const int tt = (rest / nF) * 16 + tt_lo;
    gemm_tile<MODE, NJ>(Wt, ldw, X, ldx, K, ft * 256, tt * TT, smem, P, layer);
  }
}

namespace pg8 {
#define PG8_LAS __attribute__((address_space(3)))
typedef unsigned short bf16_t;
typedef short bf16x8 __attribute__((ext_vector_type(8)));
typedef float f32x4 __attribute__((ext_vector_type(4)));
typedef unsigned u32x4 __attribute__((ext_vector_type(4)));
constexpr int BM = 256, BK = 64, HALF = 128, HTB = HALF * BK * 2  , STAGE_BYTES = 8 * HTB, NXCD = 8, WGM = 8;

__host__ __device__ __forceinline__ int lds_byte(int r, int c) { const int st = (r >> 4) * 2 + (c >> 5), rr = r & 15, cc = c & 31, ob = rr * 64 + cc * 2; return st * 1024 + (ob ^ (((ob >> 9) & 1) << 5)); }
__host__ __device__ __forceinline__ void stage_rc(int b, int& R, int& C) { const int st = b / 1024, sb = b % 1024, swz = sb ^ (((sb >> 9) & 1) << 5); R = (st >> 1) * 16 + swz / 64; C = (st & 1) * 32 + (swz % 64) / 2; }
__host__ __device__ __forceinline__ int perm32(int rho) { const int n = rho >> 4, i = rho & 15; return 8 * (i >> 2) + 4 * n + (i & 3); }

struct Unit { int pm, pn; };
struct Gemm { const bf16_t* A; const bf16_t* Bt; int M, N, K, ld; };

struct StaticOrder {
    int nM, nN, nwg, G, c;
    __host__ __device__ void init(int M, int N, int G_, int c_) { nM = M / BM; nN = N / BM; nwg = nM * nN; G = G_; c = c_; }
    __host__ __device__ bool next(int i, Unit& u) const {
        const long L = (long)i * G + c; if (L >= nwg) return false;
        int wgid = (int)L; { const int q = nwg / NXCD, r = nwg % NXCD, xcd = wgid % NXCD, off = wgid / NXCD; wgid = (xcd < r ? xcd * (q + 1) : r * (q + 1) + (xcd - r) * q) + off; }
        const int nig = WGM * nN, gid = wgid / nig, fm = gid * WGM, gsz = (nM - fm) < WGM ? (nM - fm) : WGM;
        u.pm = fm + ((wgid % nig) % gsz); u.pn = (wgid % nig) / gsz; return true;
    }
    __device__ __forceinline__ void a_ready(const Unit&) const {}
    __device__ __forceinline__ void done(const Unit&) const {}
};

template <class Epi, class Sched, bool STAMP, int KC, int LDC>
__device__ __forceinline__ void gemm_phase(PG8_LAS unsigned char* lds, const Gemm g, const Sched& S, const Epi& E, unsigned long long* stamps) {
    const int tid = opaque_tid(), wid = __builtin_amdgcn_readfirstlane(tid >> 6), lane = tid & 63, wr = wid >> 2, wc = wid & 3, fr = lane & 15, fq = lane >> 4;
    constexpr int K = KC, nt = K / BK;
    int ts_lo = 0, ts_hi = 0, nts = 0; const unsigned long long rt_entry = STAMP ? (unsigned long long)wall_clock64() : 0ull;
#define PG8_STAMP() do { if (STAMP && wid == 0 && nts < 64) { const unsigned long long _c = (unsigned long long)clock64(); \
        ts_lo = (lane == nts) ? (int)(unsigned)_c : ts_lo; ts_hi = (lane == nts) ? (int)(unsigned)(_c >> 32) : ts_hi; ++nts; } } while (0)
    PG8_STAMP();
    unsigned voffA[2], voffB[2];
#pragma unroll
    for (int i = 0; i < 2; ++i) { int R, C; stage_rc(tid * 16 + i * 8192, R, C); const int Rb = Epi::PERM ? ((R & ~31) + perm32(R & 31)) : R;
        voffA[i] = (unsigned)(R * LDC + C) * 2u; voffB[i] = (unsigned)(Rb * LDC + C) * 2u; }
    const size_t kstep = (size_t)(BK * 2);
    constexpr size_t hstep = (size_t)HALF * LDC * 2;
    const size_t tstep = 2 * hstep;
    const unsigned ldsw = (unsigned)wid * 1024u;
    const int aoff = lds_byte(wr * 64 + fr, fq * 8), boff = lds_byte(wc * 32 + fr, fq * 8);
#define PG8_SA(b, h) (((b) * 2 + (h)) * HTB)
#define PG8_SB(b, h) ((4 + (b) * 2 + (h)) * HTB)
#define PG8_STAGE(bufoff, gbase, voff) do { _Pragma("unroll") for (int _i = 0; _i < 2; ++_i) \
        __builtin_amdgcn_global_load_lds((const unsigned*)((const char*)(gbase) + (voff)[_i]), (PG8_LAS unsigned*)(lds + (bufoff) + ldsw + _i * 8192), 16, 0, 0); } while (0)
#define PG8_LDA(dst, b, h) do { _Pragma("unroll") for (int m = 0; m < 4; ++m) _Pragma("unroll") for (int k = 0; k < 2; ++k) dst[m][k] = *(const PG8_LAS bf16x8*)(lds + PG8_SA(b, h) + aoff + m * 2048 + k * 1024); } while (0)
#define PG8_LDB(dst, b, h) do { _Pragma("unroll") for (int n = 0; n < 2; ++n) _Pragma("unroll") for (int k = 0; k < 2; ++k) dst[n][k] = *(const PG8_LAS bf16x8*)(lds + PG8_SB(b, h) + boff + n * 2048 + k * 1024); } while (0)
#define PG8_MMA(ai, bj, At, Bt) do { __builtin_amdgcn_s_setprio(1); _Pragma("unroll") for (int m = 0; m < 4; ++m) _Pragma("unroll") for (int n = 0; n < 2; ++n) _Pragma("unroll") for (int k = 0; k < 2; ++k) \
        acc[ai][bj][m][n] = __builtin_amdgcn_mfma_f32_16x16x32_bf16(Bt[n][k], At[m][k], acc[ai][bj][m][n], 0, 0, 0); __builtin_amdgcn_s_setprio(0); } while (0)
#define PG8_WAIT_V(n) asm volatile("s_waitcnt vmcnt(" #n ")" ::: "memory")
#define PG8_WAIT_L(n) asm volatile("s_waitcnt lgkmcnt(" #n ")" ::: "memory")
#define PG8_BAR __builtin_amdgcn_s_barrier()
#define PG8_SCHED __builtin_amdgcn_sched_barrier(0)
    Unit cur, nxt; int ui = 0;
    if (!S.next(0, cur)) return;
    f32x4 acc[2][2][4][2];
#pragma unroll
    for (int a = 0; a < 2; ++a)
#pragma unroll
        for (int b = 0; b < 2; ++b)
#pragma unroll
            for (int m = 0; m < 4; ++m)
#pragma unroll
                for (int n = 0; n < 2; ++n) acc[a][b][m][n] = (f32x4){0.f, 0.f, 0.f, 0.f};
    bf16x8 At[4][2], B0[2][2], B1[2][2];
    const char* cA = (const char*)g.A + (size_t)cur.pm * tstep; const char* cB = (const char*)g.Bt + (size_t)cur.pn * tstep;
    S.a_ready(cur);
    PG8_STAGE(PG8_SB(0, 0), cB, voffB); PG8_STAGE(PG8_SA(0, 0), cA, voffA); PG8_STAGE(PG8_SB(0, 1), cB + hstep, voffB); PG8_STAGE(PG8_SA(0, 1), cA + hstep, voffA);
    if (wr == 1) PG8_BAR;
    PG8_WAIT_V(4); PG8_BAR;
    PG8_STAGE(PG8_SB(1, 0), cB + kstep, voffB); PG8_STAGE(PG8_SA(1, 0), cA + kstep, voffA); PG8_STAGE(PG8_SB(1, 1), cB + hstep + kstep, voffB);
    PG8_WAIT_V(6); PG8_BAR;
    PG8_STAMP();
    for (;;) {
        const bool has_next = S.next(ui + 1, nxt);
        const char* nA = has_next ? (const char*)g.A + (size_t)nxt.pm * tstep : cA; const char* nB = has_next ? (const char*)g.Bt + (size_t)nxt.pn * tstep : cB;
        for (int t = 0; t < nt; t += 2) {
            const bool last = (t == nt - 2);
            const char* a1 = cA + (size_t)(t + 1) * kstep;
            const char* a2 = last ? nA : cA + (size_t)(t + 2) * kstep; const char* b2 = last ? nB : cB + (size_t)(t + 2) * kstep;
            const char* a3 = a2 + kstep; const char* b3 = b2 + kstep;
            if (last && has_next) S.a_ready(nxt);
            PG8_LDB(B0, 0, 0); PG8_SCHED; PG8_LDA(At, 0, 0); PG8_STAGE(PG8_SA(1, 1), a1 + hstep, voffA);
            PG8_WAIT_L(8); PG8_BAR; PG8_WAIT_L(0); PG8_MMA(0, 0, At, B0); PG8_BAR; PG8_SCHED;
            PG8_LDB(B1, 0, 1); PG8_STAGE(PG8_SB(0, 0), b2, voffB);
            PG8_BAR; PG8_WAIT_L(0); PG8_MMA(0, 1, At, B1); PG8_BAR;
            PG8_LDA(At, 0, 1); PG8_STAGE(PG8_SA(0, 0), a2, voffA);
            PG8_BAR; PG8_WAIT_L(0); PG8_MMA(1, 0, At, B0); PG8_BAR; PG8_SCHED;
            PG8_STAGE(PG8_SB(0, 1), b2 + hstep, voffB);
            PG8_WAIT_V(6); PG8_BAR; PG8_MMA(1, 1, At, B1); PG8_BAR;
            PG8_LDB(B0, 1, 0); PG8_SCHED; PG8_LDA(At, 1, 0); PG8_STAGE(PG8_SA(0, 1), a2 + hstep, voffA);
            PG8_WAIT_L(8); PG8_BAR; PG8_WAIT_L(0); PG8_MMA(0, 0, At, B0); PG8_BAR; PG8_SCHED;
            PG8_LDB(B1, 1, 1); PG8_STAGE(PG8_SB(1, 0), b3, voffB);
            PG8_BAR; PG8_WAIT_L(0); PG8_MMA(0, 1, At, B1); PG8_BAR;
            PG8_LDA(At, 1, 1); PG8_STAGE(PG8_SA(1, 0), a3, voffA);
            PG8_BAR; PG8_WAIT_L(0); PG8_MMA(1, 0, At, B0); PG8_BAR; PG8_SCHED;
            PG8_STAGE(PG8_SB(1, 1), b3 + hstep, voffB);
            PG8_WAIT_V(6); PG8_BAR; PG8_MMA(1, 1, At, B1); PG8_BAR;
        }
        PG8_STAMP();
        if constexpr (!Epi::AFTER_DRAIN) { E(acc, cur, wr, wc, fr, fq); S.done(cur); }
        PG8_STAMP();
        if (!has_next) break;
#pragma unroll
        for (int a = 0; a < 2; ++a)
#pragma unroll
            for (int b = 0; b < 2; ++b)
#pragma unroll
                for (int m = 0; m < 4; ++m)
#pragma unroll
                    for (int n = 0; n < 2; ++n) acc[a][b][m][n] = (f32x4){0.f, 0.f, 0.f, 0.f};
        cur = nxt; cA = nA; cB = nB; ++ui;
    }
    PG8_WAIT_V(0);
    if (wr == 0) PG8_BAR;
    PG8_BAR;
    if constexpr (Epi::AFTER_DRAIN) { E.fused(acc, cur, wr, wc, fr, fq, lds, wid, lane); S.done(cur); }
    PG8_STAMP();
    if (STAMP && wid == 0) { stamps[lane] = lane < nts ? (((unsigned long long)(unsigned)ts_hi << 32) | (unsigned)ts_lo) : 0ull;
        if (lane == 62) stamps[62] = rt_entry; if (lane == 63) stamps[63] = (unsigned long long)wall_clock64(); }
#undef PG8_STAMP
#undef PG8_SA
#undef PG8_SB
#undef PG8_STAGE
#undef PG8_LDA
#undef PG8_LDB
#undef PG8_MMA
#undef PG8_WAIT_V
#undef PG8_WAIT_L
#undef PG8_BAR
#undef PG8_SCHED
}
}

struct EpiY8 {
  static constexpr bool PERM = true, AFTER_DRAIN = false;
  u16* O;
  DI void operator()(const pg8::f32x4 (&acc)[2][2][4][2], const pg8::Unit& u, int wr, int wc, int fr, int fq) const {
    const int row0 = u.pm * 256 + wr * 64 + fr, col0 = u.pn * 256 + wc * 32 + 8 * fq;
#pragma unroll
    for (int ai = 0; ai < 2; ++ai)
#pragma unroll
      for (int m = 0; m < 4; ++m) {
        u16* rowp = O + (size_t)(row0 + ai * 128 + m * 16) * KP1 + col0;
#pragma unroll
        for (int bj = 0; bj < 2; ++bj) {
          const pg8::f32x4 v0 = acc[ai][bj][m][0], v1 = acc[ai][bj][m][1];
          u32x4 w; w.x = pk2(v0[0], v0[1]); w.y = pk2(v0[2], v0[3]); w.z = pk2(v1[0], v1[1]); w.w = pk2(v1[2], v1[3]);
          *(u32x4*)(rowp + bj * 128) = w;
        }
      }
  }
};
struct EpiFfnUp8 {
  static constexpr bool PERM = true, AFTER_DRAIN = false;
  u16* H;
  DI void operator()(const pg8::f32x4 (&acc)[2][2][4][2], const pg8::Unit& u, int wr, int wc, int fr, int fq) const {
    const int row0 = u.pm * 256 + wr * 64 + fr, col0 = u.pn * 128 + wc * 32 + 8 * fq;
#pragma unroll
    for (int ai = 0; ai < 2; ++ai)
#pragma unroll
      for (int m = 0; m < 4; ++m) {
        float o[8];
#pragma unroll
        for (int n = 0; n < 2; ++n)
#pragma unroll
          for (int j = 0; j < 4; ++j) {
            const float g = acc[ai][0][m][n][j], up = acc[ai][1][m][n][j];
            o[n * 4 + j] = g * __builtin_amdgcn_rcpf(1.f + __builtin_amdgcn_exp2f(-1.4426950408889634f * g)) * up;
          }
        u32x4 w; w.x = pk2(o[0], o[1]); w.y = pk2(o[2], o[3]); w.z = pk2(o[4], o[5]); w.w = pk2(o[6], o[7]);
        *(u32x4*)(H + (size_t)(row0 + ai * 128 + m * 16) * KP2 + col0) = w;
      }
  }
};
struct EpiGate8 {
  static constexpr bool PERM = true, AFTER_DRAIN = false;
  unsigned char* G8;
  DI void operator()(const pg8::f32x4 (&acc)[2][2][4][2], const pg8::Unit& u, int wr, int wc, int fr, int fq) const {
    const int row0 = u.pm * 256 + wr * 64 + fr, col0 = u.pn * 256 + wc * 32 + 8 * fq;
#pragma unroll
    for (int ai = 0; ai < 2; ++ai)
#pragma unroll
      for (int m = 0; m < 4; ++m)
#pragma unroll
        for (int bj = 0; bj < 2; ++bj) {
          uint2 pk = {0u, 0u};
#pragma unroll
          for (int j = 0; j < 4; ++j) {
            const float a = __builtin_amdgcn_rcpf(1.f + __builtin_amdgcn_exp2f(-1.4426950408889634f * acc[ai][bj][m][0][j]));
            const float b = __builtin_amdgcn_rcpf(1.f + __builtin_amdgcn_exp2f(-1.4426950408889634f * acc[ai][bj][m][1][j]));
            pk.x |= (unsigned)(a * 255.f + 0.5f) << (8 * j);
            pk.y |= (unsigned)(b * 255.f + 0.5f) << (8 * j);
          }
          *(uint2*)(G8 + (size_t)(row0 + ai * 128 + m * 16) * GP + col0 + bj * 128) = pk;
        }
  }
};
struct EpiProj8 {
  static constexpr bool PERM = false, AFTER_DRAIN = false;
  const Params* Pp; int layer;
  static DI void rope32q(float (&b)[8], const float2* __restrict__ tab, int fq) {
#pragma unroll
    for (int j = 0; j < 4; ++j) {
      const float2 cs = tab[4 * fq + j];
      const float x1 = b[j], x2 = b[4 + j];
      b[j] = x1 * cs.x - x2 * cs.y;
      b[4 + j] = x2 * cs.x + x1 * cs.y;
    }
  }
  static DI void st8(u16* __restrict__ base, int ld, int col0, const float (&b)[8], int tok, int fq) {
#pragma unroll
    for (int n = 0; n < 2; ++n) {
      uint2 pk; pk.x = pk2(b[4 * n], b[4 * n + 1]); pk.y = pk2(b[4 * n + 2], b[4 * n + 3]);
      *(uint2*)(base + (size_t)tok * ld + col0 + 16 * n + 4 * fq) = pk;
    }
  }
  static DI void stT8(u16* __restrict__ base, int row0, const float (&b)[8], int tok, int fq) {
    const int tp = (tok & ~12) | ((tok & 4) << 1) | ((tok & 8) >> 1);
#pragma unroll
    for (int n = 0; n < 2; ++n)
#pragma unroll
      for (int j = 0; j < 4; ++j) {
        const int row = row0 + 16 * n + 4 * fq + j;
        base[(size_t)(row >> 6) * 64 * T + (size_t)(tp >> 7) * 8192 + (row & 63) * 128 + (tp & 127)] = f2bf(b[4 * n + j]);
      }
  }
  DI void operator()(const pg8::f32x4 (&acc)[2][2][4][2], const pg8::Unit& u, int wr, int wc, int fr, int fq_in) const {
    const Params& P = *Pp;
    char* ws = P.ws;
    u16* qkv = (u16*)(ws + OFF_QKV);
    const float2* R64 = (const float2*)(ws + OFF_R64);
    const float2* R32 = (const float2*)(ws + OFF_R32);
    float* SS = (float*)(ws + OFF_SS);
    const int fbase = u.pn * 256 + wc * 64;
    if (fbase >= 2496) return;
    float penorm = 0.f;
    float dnorm = 0.f;
#pragma unroll
    for (int ai = 0; ai < 2; ++ai)
#pragma unroll
      for (int m = 0; m < 4; ++m) {
        int fqv = fq_in; asm volatile("" : "+v"(fqv));
        const int fq = fqv;
        const int tok = u.pm * 256 + ai * 128 + wr * 64 + m * 16 + fr;
        const int pos = pos_of(tok);
        float b0[8], b1[8];
#pragma unroll
        for (int n = 0; n < 2; ++n)
#pragma unroll
          for (int j = 0; j < 4; ++j) { b0[4 * n + j] = acc[ai][0][m][n][j]; b1[4 * n + j] = acc[ai][1][m][n][j]; }
        if (fbase < 384) {
          const bool isK = fbase >= 256;
          const float* g = P.a_qk_norm + layer * 128 + (isK ? 64 : 0);
          float ss = 0.f;
#pragma unroll
          for (int k = 0; k < 8; ++k) ss += b0[k] * b0[k] + b1[k] * b1[k];
          ss += __shfl_xor(ss, 16);
          ss += __shfl_xor(ss, 32);
          const float rs = rsqrtf(ss * (1.f / 64.f) + EPS) * (isK ? 1.f : 0.125f * 1.4426950408889634f);
#pragma unroll
          for (int n = 0; n < 2; ++n)
#pragma unroll
            for (int j = 0; j < 4; ++j) {
              b0[4 * n + j] *= rs * g[16 * n + 4 * fq + j];
              b1[4 * n + j] *= rs * g[32 + 16 * n + 4 * fq + j];
            }
          rope32q(b0, R32 + (size_t)(pos >> 6) * 16, fq);
          rope32q(b1, R32 + (size_t)(pos & 63) * 16, fq);
          u16* dst = qkv + (isK ? Q_KA : Q_QA);
          const int ld = isK ? 128 : 256, c0 = isK ? fbase - 256 : fbase;
          st8(dst, ld, c0, b0, tok, fq);
          st8(dst, ld, c0 + 32, b1, tok, fq);
        } else if (fbase < 512) {
          stT8(qkv + Q_VTA, fbase - 384, b0, tok, fq);
          stT8(qkv + Q_VTA, fbase - 384 + 32, b1, tok, fq);
        } else if (fbase < 896) {
          const bool isK = fbase >= 768;
          const float2* tab = R64 + (size_t)pos * 32;
#pragma unroll
          for (int n = 0; n < 2; ++n)
#pragma unroll
            for (int j = 0; j < 4; ++j) {
              const float2 cs = tab[16 * n + 4 * fq + j];
              const float x1 = b0[4 * n + j], x2 = b1[4 * n + j];
              b0[4 * n + j] = x1 * cs.x - x2 * cs.y;
              b1[4 * n + j] = x2 * cs.x + x1 * cs.y;
            }
          u16* dst = qkv + (isK ? Q_KB : Q_QB);
          const int ld = isK ? 128 : 256, c0 = isK ? fbase - 768 : fbase - 512;
          st8(dst, ld, c0, b0, tok, fq);
          st8(dst, ld, c0 + 32, b1, tok, fq);
        } else if (fbase < 1024) {
          stT8(qkv + Q_VTB, fbase - 896, b0, tok, fq);
          stT8(qkv + Q_VTB, fbase - 896 + 32, b1, tok, fq);
        } else if (fbase < 1664) {
          const bool isKV = fbase >= 1408;
          u16* dst = qkv + (isKV ? Q_CKV : Q_CQ);
          const int ld = isKV ? 256 : 384, c0 = isKV ? fbase - 1408 : fbase - 1024;
          const int sb = (isKV ? 12 : 0) + (c0 >> 5);
          float s0 = 0.f, s1 = 0.f;
#pragma unroll
          for (int k = 0; k < 8; ++k) { s0 += b0[k] * b0[k]; s1 += b1[k] * b1[k]; }
          s0 += __shfl_xor(s0, 16); s0 += __shfl_xor(s0, 32);
          s1 += __shfl_xor(s1, 16); s1 += __shfl_xor(s1, 32);
          if (fq == 0) { SS[(size_t)tok * 20 + sb] = s0; SS[(size_t)tok * 20 + sb + 1] = s1; }
          st8(dst, ld, c0, b0, tok, fq);
          st8(dst, ld, c0 + 32, b1, tok, fq);
        } else if (fbase < 2176) {
          const bool isK = fbase >= 1920;
          u16* dst = qkv + (isK ? Q_KD : Q_QD);
          const int c0 = isK ? fbase - 1920 : fbase - 1664;
          rope32q(b0, R32 + (size_t)pos * 16, fq);
          rope32q(b1, R32 + (size_t)pos * 16, fq);
          float s0 = 0.f, s1 = 0.f;
#pragma unroll
          for (int k = 0; k < 8; ++k) { s0 += b0[k] * b0[k]; s1 += b1[k] * b1[k]; }
          dnorm = fmaxf(dnorm, fmaxf(s0, s1));
          if (!isK) {
#pragma unroll
            for (int k = 0; k < 8; ++k) { b0[k] *= 0.17677669529663687f * 1.4426950408889634f; b1[k] *= 0.17677669529663687f * 1.4426950408889634f; }
          }
          st8(dst, 256, c0, b0, tok, fq);
          st8(dst, 256, c0 + 32, b1, tok, fq);
        } else if (fbase < 2432) {
          stT8(qkv + Q_VTD, fbase - 2176, b0, tok, fq);
          stT8(qkv + Q_VTD, fbase - 2176 + 32, b1, tok, fq);
        } else {
          rope32q(b0, R32 + (size_t)pos * 16, fq);
          { float s0 = 0.f;
#pragma unroll
            for (int k = 0; k < 8; ++k) s0 += b0[k] * b0[k];
            penorm = fmaxf(penorm, s0); }
#pragma unroll
          for (int hd = 0; hd < 4; ++hd) st8(qkv + Q_KC, 384, hd * 96 + 64, b0, tok, fq);
        }
        __builtin_amdgcn_sched_barrier(0);
      }
    if (fbase == 2432) {
      float v = penorm * 4.f;
#pragma unroll
      for (int mk = 32; mk >= 1; mk >>= 1) v = fmaxf(v, __shfl_xor(v, mk));
      if ((opaque_tid() & 63) == 0) atomicMax((unsigned*)(ws + OFF_BAR) + 144 + layer * 4 + 2, __float_as_uint(v));
    }
    if (fbase >= 1664 && fbase < 2176) {
      float v = dnorm * 4.f;
#pragma unroll
      for (int mk = 32; mk >= 1; mk >>= 1) v = fmaxf(v, __shfl_xor(v, mk));
      if ((opaque_tid() & 63) == 0) atomicMax((unsigned*)(ws + OFF_BAR) + 128 + layer * 2 + (fbase >= 1920 ? 1 : 0), __float_as_uint(v));
    }
  }
};
struct SimpleOrder {
  int nN, nwg, G, c;
  DI bool next(int i, pg8::Unit& u) const {
    const int L = i * G + c;
    if (L >= nwg) return false;
    const int rest = L >> 4;
    u.pn = rest % nN;
    u.pm = (rest / nN) * 16 + (L & 15);
    return true;
  }
  DI void a_ready(const pg8::Unit&) const {}
  DI void done(const pg8::Unit&) const {}
};
template <int N, int K, int LD, class Epi>
DI void gemm8_phase(const u16* X, const u16* Wt, const Epi& E, char* smem) {
  pg8::Gemm g; g.A = X; g.Bt = Wt; g.M = T; g.N = N; g.K = K; g.ld = LD;
  int bid_ = (int)blockIdx.x; asm volatile("" : "+s"(bid_));
  SimpleOrder S; S.nN = N / 256; S.nwg = (T / 256) * (N / 256); S.G = (int)gridDim.x; S.c = bid_;
  pg8::gemm_phase<Epi, SimpleOrder, false, K, LD>((PG8_LAS unsigned char*)smem, g, S, E, nullptr);
}

template <int DQK, int NCOMP, bool BAND, int EPI, bool NOMAX = false, bool GQA2 = false>
DI void attn_item(const u16* __restrict__ Q, int ldq, const u16* __restrict__ Kp, int ldk, const u16* __restrict__ Vt,
                  int qtok0, int kbeg, int kend, float sc_l2, float sink_l2, float lam, float onorm,
                  const float* __restrict__ subg, u16* __restrict__ O, float* __restrict__ DS, char* smem) {
  constexpr int DC = DQK / NCOMP;
  constexpr int KS = DC / 16;
  constexpr int KEYS = (NCOMP == 1) ? 128 : 64;
  constexpr int KSTR = DQK + 8, VSTR = KEYS + 8;
  constexpr int KCH = DQK / 8, VCH = KEYS / 8;
  constexpr int NKC = KEYS * KCH / NTHR, NVC = 64 * VCH / NTHR;
  constexpr int KSLOT = KEYS * KSTR, VSLOT = 64 * VSTR;
  u16* sK = (u16*)smem;
  u16* sV = sK + 3 * KSLOT;
  const int tid = opaque_tid(), lane = tid & 63, wave = tid >> 6, r = lane & 31, h = lane >> 5;
  const int qtok = qtok0 + (GQA2 ? (wave & 3) : wave) * 32 + r;
  if constexpr (GQA2) { Q += (wave >> 2) * 64; O += (wave >> 2) * 64; }

  bf16x8 qf[NCOMP][KS];
#pragma unroll
  for (int c = 0; c < NCOMP; ++c)
#pragma unroll
    for (int ks = 0; ks < KS; ++ks) qf[c][ks] = *(const bf16x8*)(Q + (size_t)qtok * ldq + c * DC + ks * 16 + 8 * h);

  f32x16 Oa[NCOMP][2];
  float m[NCOMP], l[NCOMP];
#pragma unroll
  for (int c = 0; c < NCOMP; ++c) {
#pragma unroll
    for (int d = 0; d < 2; ++d)
#pragma unroll
      for (int v = 0; v < 16; ++v) Oa[c][d][v] = 0.f;
    m[c] = BAND ? sink_l2 : -1e30f;
    l[c] = (BAND && h == 0) ? 1.f : 0.f;
  }

  const u16* kg[NKC]; int kso[NKC];
#pragma unroll
  for (int i = 0; i < NKC; ++i) {
    const int c = tid + i * NTHR;
    const int row = c / KCH, cc = c % KCH;
    kg[i] = Kp + (size_t)(kbeg + row) * ldk + cc * 8;
    kso[i] = row * KSTR + cc * 8;
  }
  const u16* vg[NVC]; int vso[NVC];
#pragma unroll
  for (int i = 0; i < NVC; ++i) {
    const int c = tid + i * NTHR;
    const int row = c / VCH, cc = c % VCH;
    vg[i] = Vt + (size_t)(kbeg >> 7) * 8192 + row * 128 + cc * 8;
    vso[i] = row * VSTR + cc * 8;
  }
  u32x4 kreg[NKC], vreg[NVC];
  auto loadK = [&](int t) {
#pragma unroll
    for (int i = 0; i < NKC; ++i) kreg[i] = gld16(kg[i] + (size_t)t * KEYS * ldk);
  };
  auto loadV = [&](int t) {
#pragma unroll
    for (int i = 0; i < NVC; ++i) vreg[i] = gld16(vg[i] + (size_t)t * 8192);
  };
  auto waitK = [&]() {
    if constexpr (NKC == 1) wait_vm0(kreg[0]);
    else if constexpr (NKC == 2) wait_vm0(kreg[0], kreg[1]);
    else wait_vm0(kreg[0], kreg[1], kreg[2]);
  };
  auto waitV = [&]() {
    if constexpr (NVC == 1) wait_vm0(vreg[0]);
    else wait_vm0(vreg[0], vreg[1]);
  };
  auto storeK = [&](int slot) {
#pragma unroll
    for (int i = 0; i < NKC; ++i) *(u32x4*)(sK + slot * KSLOT + kso[i]) = kreg[i];
  };
  auto storeV = [&](int slot) {
#pragma unroll
    for (int i = 0; i < NVC; ++i) *(u32x4*)(sV + slot * VSLOT + vso[i]) = vreg[i];
  };

  f32x16 S0[2], S1[2];
  bf16x8 pfA[2][2], pfB[2][2];
  float alpha_pend = 1.f;
  bool need_pend = false;

  auto att_S = [&](auto uu_t, f32x16 (&S)[2], int slot) {
    constexpr int UU = decltype(uu_t)::value;
    constexpr int C = (NCOMP == 2) ? UU : 0;
    const u16* base = sK + slot * KSLOT + ((NCOMP == 1 ? UU * 64 : 0) + r) * KSTR + (NCOMP == 2 ? UU * DC : 0) + 8 * h;
#pragma unroll
    for (int kb = 0; kb < 2; ++kb) {
#pragma unroll
      for (int v = 0; v < 16; ++v) S[kb][v] = 0.f;
#pragma unroll
      for (int ks = 0; ks < KS; ++ks) {
        bf16x8 kf = *(const bf16x8*)(base + kb * 32 * KSTR + ks * 16);
        S[kb] = MFMA32(kf, qf[C][ks], S[kb]);
      }
    }
  };
  auto att_PV = [&](auto uu_t, const bf16x8 (&pf)[2][2], int slot) {
    constexpr int UU = decltype(uu_t)::value;
    constexpr int C = (NCOMP == 2) ? UU : 0;
    const u16* base = sV + slot * VSLOT + r * VSTR + (NCOMP == 1 ? UU * 64 : 0) + 8 * h;
#pragma unroll
    for (int d = 0; d < 2; ++d)
#pragma unroll
      for (int kb = 0; kb < 2; ++kb)
#pragma unroll
        for (int s = 0; s < 2; ++s) {
          bf16x8 vf = *(const bf16x8*)(base + d * 32 * VSTR + kb * 32 + 16 * s);
          Oa[C][d] = MFMA32(vf, pf[kb][s], Oa[C][d]);
        }
  };
  auto att_rescale = [&](auto uu_t) {
    constexpr int UU = decltype(uu_t)::value;
    constexpr int C = (NCOMP == 2) ? UU : 0;
    if (need_pend) {
#pragma unroll
      for (int d = 0; d < 2; ++d)
#pragma unroll
        for (int v = 0; v < 16; ++v) Oa[C][d][v] *= alpha_pend;
    }
  };
  auto att_softmax = [&](auto uu_t, f32x16 (&S)[2], bf16x8 (&pf)[2][2], int kpos0) {
    constexpr int UU = decltype(uu_t)::value;
    constexpr int C = (NCOMP == 2) ? UU : 0;
    if constexpr (BAND) {
#pragma unroll
      for (int kb = 0; kb < 2; ++kb)
#pragma unroll
        for (int v = 0; v < 16; ++v) {
          const int d = kpos0 + kb * 32 + crow(v, h) - qtok;
          if (d > 128 || d < -128) S[kb][v] = -1e30f;
        }
    }
    if constexpr (NOMAX) {
      float rsum = 0.f;
#pragma unroll
      for (int kb = 0; kb < 2; ++kb)
#pragma unroll
        for (int v = 0; v < 16; ++v) {
          float p = __builtin_amdgcn_exp2f(S[kb][v]);
          S[kb][v] = p;
          rsum += p;
        }
      l[C] += rsum;
      need_pend = false;
#pragma unroll
      for (int kb = 0; kb < 2; ++kb)
#pragma unroll
        for (int s = 0; s < 2; ++s) {
          u32x4 pk;
          pk.x = pk2(S[kb][8 * s + 0], S[kb][8 * s + 1]);
          pk.y = pk2(S[kb][8 * s + 2], S[kb][8 * s + 3]);
          pk.z = pk2(S[kb][8 * s + 4], S[kb][8 * s + 5]);
          pk.w = pk2(S[kb][8 * s + 6], S[kb][8 * s + 7]);
          pf[kb][s] = __builtin_bit_cast(bf16x8, pk);
        }
      return;
    }
    float mx = S[0][0];
#pragma unroll
    for (int kb = 0; kb < 2; ++kb)
#pragma unroll
      for (int v = 0; v < 16; ++v) mx = fmaxf(mx, S[kb][v]);
    {
      const unsigned mu = __float_as_uint(mx);
      const auto sw = __builtin_amdgcn_permlane32_swap(mu, mu, false, false);
      mx = fmaxf(__uint_as_float(sw[0]), __uint_as_float(sw[1]));
    }
    const float mold = m[C];
    const float mcand = fmaxf(mold, mx * sc_l2);
    const bool grow = __builtin_amdgcn_ballot_w64(mcand > mold + 6.0f) != 0;
    const float mnew = grow ? mcand : mold;
    need_pend = grow;
    alpha_pend = __builtin_amdgcn_exp2f(mold - mnew);
    m[C] = mnew;
    float rsum = 0.f;
#pragma unroll
    for (int kb = 0; kb < 2; ++kb)
#pragma unroll
      for (int v = 0; v < 16; ++v) {
        float p = __builtin_amdgcn_exp2f(__builtin_fmaf(S[kb][v], sc_l2, -mnew));
        S[kb][v] = p;
        rsum += p;
      }
    l[C] = l[C] * alpha_pend + rsum;
#pragma unroll
    for (int kb = 0; kb < 2; ++kb)
#pragma unroll
      for (int s = 0; s < 2; ++s) {
        u32x4 pk;
        pk.x = pk2(S[kb][8 * s + 0], S[kb][8 * s + 1]);
        pk.y = pk2(S[kb][8 * s + 2], S[kb][8 * s + 3]);
        pk.z = pk2(S[kb][8 * s + 4], S[kb][8 * s + 5]);
        pk.w = pk2(S[kb][8 * s + 6], S[kb][8 * s + 7]);
        pf[kb][s] = __builtin_bit_cast(bf16x8, pk);
      }
  };
  using U0 = std::integral_constant<int, 0>;
  using U1 = std::integral_constant<int, 1>;

  const int ntl = (kend - kbeg) / KEYS;
  auto step = [&](auto first_t, auto lk_t, auto lv_t, int t, int sa, int sb, int sc) {
    constexpr bool FIRST = decltype(first_t)::value, LK = decltype(lk_t)::value, LV = decltype(lv_t)::value;
    if constexpr (LK) loadK(t + 2);
    if constexpr (LV) loadV(t + 1);
    if constexpr (!FIRST) att_rescale(U1{});
    att_S(U1{}, S1, sa);
    if constexpr (!FIRST) att_PV(U1{}, pfB, sc);
    att_softmax(U0{}, S0, pfA, kbeg + t * KEYS);
    att_rescale(U0{});
    if constexpr (LV) att_S(U0{}, S0, sb);
    att_PV(U0{}, pfA, sa);
    att_softmax(U1{}, S1, pfB, kbeg + t * KEYS + 64);
    if constexpr (LK) { waitK(); storeK(sc); }
    if constexpr (LV) { waitV(); storeV(sb); }
    __syncthreads();
  };
  using TT = std::true_type;
  using FF = std::false_type;

  loadK(0); loadV(0);
  waitK(); waitV();
  storeK(0); storeV(0);
  loadK(1);
  waitK();
  storeK(1);
  __syncthreads();
  att_S(U0{}, S0, 0);
  int sa = 0, sb = 1, sc = 2;
  step(TT{}, TT{}, TT{}, 0, sa, sb, sc);
  { int tmp = sa; sa = sb; sb = sc; sc = tmp; }
  for (int t = 1; t < ntl - 2; ++t) {
    step(FF{}, TT{}, TT{}, t, sa, sb, sc);
    int tmp = sa; sa = sb; sb = sc; sc = tmp;
  }
  step(FF{}, FF{}, TT{}, ntl - 2, sa, sb, sc);
  { int tmp = sa; sa = sb; sb = sc; sc = tmp; }
  step(FF{}, FF{}, FF{}, ntl - 1, sa, sb, sc);
  att_rescale(U1{});
  att_PV(U1{}, pfB, sa);

  float inv[NCOMP];
#pragma unroll
  for (int c = 0; c < NCOMP; ++c) {
    float lt = l[c] + __shfl_xor(l[c], 32);
    inv[c] = 1.f / lt;
  }
  if constexpr (EPI == 1) {
#pragma unroll
    for (int d = 0; d < 2; ++d)
#pragma unroll
      for (int vq = 0; vq < 4; ++vq) {
        float4 o = {Oa[0][d][4 * vq] * inv[0], Oa[0][d][4 * vq + 1] * inv[0], Oa[0][d][4 * vq + 2] * inv[0], Oa[0][d][4 * vq + 3] * inv[0]};
        *(float4*)(DS + (size_t)qtok * 256 + d * 32 + 8 * vq + 4 * h) = o;
      }
  } else {
    if constexpr (EPI == 2) {
      float ss = 0.f;
#pragma unroll
      for (int d = 0; d < 2; ++d)
#pragma unroll
        for (int vq = 0; vq < 4; ++vq) {
          const float4 o1 = *(const float4*)(DS + (size_t)qtok * 256 + d * 32 + 8 * vq + 4 * h);
          const float a0 = o1.x - lam * Oa[0][d][4 * vq] * inv[0];
          const float a1 = o1.y - lam * Oa[0][d][4 * vq + 1] * inv[0];
          const float a2 = o1.z - lam * Oa[0][d][4 * vq + 2] * inv[0];
          const float a3 = o1.w - lam * Oa[0][d][4 * vq + 3] * inv[0];
          Oa[0][d][4 * vq] = a0; Oa[0][d][4 * vq + 1] = a1; Oa[0][d][4 * vq + 2] = a2; Oa[0][d][4 * vq + 3] = a3;
          ss += a0 * a0 + a1 * a1 + a2 * a2 + a3 * a3;
        }
      ss += __shfl_xor(ss, 32);
      const float rs = rsqrtf(ss * (1.f / 64.f) + EPS) * onorm;
#pragma unroll
      for (int d = 0; d < 2; ++d)
#pragma unroll
        for (int v = 0; v < 16; ++v) Oa[0][d][v] *= rs * subg[d * 32 + crow(v, h)];
    } else {
#pragma unroll
      for (int d = 0; d < 2; ++d)
#pragma unroll
        for (int v = 0; v < 16; ++v) Oa[0][d][v] *= inv[0];
    }
    store_rows(O, KP1, 0, Oa[0][0], qtok, h);
    store_rows(O, KP1, 32, Oa[0][1], qtok, h);
  }
  __syncthreads();
}

DI void attn_phase(const Params& P, int layer, char* smem) {
  char* ws = P.ws;
  u16* qkv = (u16*)(ws + OFF_QKV);
  u16* BR = (u16*)(ws + OFF_XN);
  const float L2E = 1.4426950408889634f;
  const float lambda_init = 0.8f - 0.6f * __expf(-0.3f * (float)layer);
  float lam;
  {
    const float* dl = P.d_lambda + layer * 128;
    float s1 = 0.f, s2 = 0.f;
    for (int i = 0; i < 32; ++i) { s1 += dl[i] * dl[32 + i]; s2 += dl[64 + i] * dl[96 + i]; }
    lam = __expf(s1) - __expf(s2) + lambda_init;
    lam = __int_as_float(__builtin_amdgcn_readfirstlane(__float_as_int(lam)));
  }
  const float onorm_u = __int_as_float(__builtin_amdgcn_readfirstlane(__float_as_int(1.f - lambda_init)));
  bool a_nomax;
  {
    const float* ag = P.a_qk_norm + layer * 128;
    float gq = 0.f, gk = 0.f;
    for (int i = 0; i < 64; ++i) { gq = fmaxf(gq, fabsf(ag[i])); gk = fmaxf(gk, fabsf(ag[64 + i])); }
    const float bound = 64.f * gq * gk * (0.125f * L2E);
    a_nomax = __builtin_amdgcn_readfirstlane((int)(bound < 60.f)) != 0;
  }
  bool c_nomax;
  {
    const unsigned* nb = (const unsigned*)(ws + OFF_BAR) + 144 + layer * 4;
    const float qb = __uint_as_float(__hip_atomic_load(nb, __ATOMIC_RELAXED, __HIP_MEMORY_SCOPE_AGENT));
    const float kb = __uint_as_float(__hip_atomic_load(nb + 1, __ATOMIC_RELAXED, __HIP_MEMORY_SCOPE_AGENT));
    const float pe = __uint_as_float(__hip_atomic_load(nb + 2, __ATOMIC_RELAXED, __HIP_MEMORY_SCOPE_AGENT));
    const float bound = sqrtf(3.f * qb * (2.f * kb + pe)) * (0.10206207261596577f * L2E);
    c_nomax = __builtin_amdgcn_readfirstlane((int)(bound < 60.f)) != 0;
  }
  bool d_nomax;
  {
    const unsigned* nb = (const unsigned*)(ws + OFF_BAR) + 128 + layer * 2;
    const float q2 = __uint_as_float(__hip_atomic_load(nb, __ATOMIC_RELAXED, __HIP_MEMORY_SCOPE_AGENT));
    const float k2 = __uint_as_float(__hip_atomic_load(nb + 1, __ATOMIC_RELAXED, __HIP_MEMORY_SCOPE_AGENT));
    const float bound = sqrtf(q2 * k2) * (0.17677669529663687f * L2E);
    d_nomax = __builtin_amdgcn_readfirstlane((int)(bound < 60.f)) != 0;
  }
  for (int it = blockIdx.x; it < 2048; it += gridDim.x) {
    const int cls = it >> 8;
    if (cls < 6) {
      const int idx = it & 255;
      const int head = (idx & 7) >> 1;
      const int qb = ((idx >> 3) << 1) + (idx & 1);
      int qtok0, kbeg, kend;
      if (cls < 3) { qtok0 = qb * 256; kbeg = 0; kend = SEQ0; }
      else { const int s = qb >> 3; kbeg = SEQ0 + s * DSEQ; kend = kbeg + DSEQ; qtok0 = kbeg + (qb & 7) * 256; }
      const int typ = cls % 3;
      if (typ == 0) {
        float* DS = (float*)(ws + OFF_DS) + head * 64;
        if (d_nomax) {
          attn_item<32, 1, false, 1, true>(qkv + Q_QD + head * 64, 256, qkv + Q_KD + head * 64, 256,
                                           qkv + Q_VTD + (size_t)head * 64 * T, qtok0, kbeg, kend,
                                           1.f, 0.f, lam, onorm_u, P.d_subln + layer * 64, BR + 768 + head * 64, DS, smem);
          attn_item<32, 1, false, 2, true>(qkv + Q_QD + head * 64 + 32, 256, qkv + Q_KD + head * 64 + 32, 256,
                                           qkv + Q_VTD + (size_t)head * 64 * T, qtok0, kbeg, kend,
                                           1.f, 0.f, lam, onorm_u, P.d_subln + layer * 64, BR + 768 + head * 64, DS, smem);
        } else {
          attn_item<32, 1, false, 1, false>(qkv + Q_QD + head * 64, 256, qkv + Q_KD + head * 64, 256,
                                            qkv + Q_VTD + (size_t)head * 64 * T, qtok0, kbeg, kend,
                                            1.f, 0.f, lam, onorm_u, P.d_subln + layer * 64, BR + 768 + head * 64, DS, smem);
          attn_item<32, 1, false, 2, false>(qkv + Q_QD + head * 64 + 32, 256, qkv + Q_KD + head * 64 + 32, 256,
                                            qkv + Q_VTD + (size_t)head * 64 * T, qtok0, kbeg, kend,
                                            1.f, 0.f, lam, onorm_u, P.d_subln + layer * 64, BR + 768 + head * 64, DS, smem);
        }
      } else if (typ == 1) {
        if (c_nomax)
          attn_item<96, 1, false, 0, true>(qkv + Q_QC + head * 96, 384, qkv + Q_KC + head * 96, 384,
                                           qkv + Q_VTC + (size_t)head * 64 * T, qtok0, kbeg, kend,
                                           1.f, 0.f, 0.f, 1.f, nullptr, BR + 512 + head * 64, nullptr, smem);
        else
          attn_item<96, 1, false, 0, false>(qkv + Q_QC + head * 96, 384, qkv + Q_KC + head * 96, 384,
                                            qkv + Q_VTC + (size_t)head * 64 * T, qtok0, kbeg, kend,
                                            1.f, 0.f, 0.f, 1.f, nullptr, BR + 512 + head * 64, nullptr, smem);
      } else {
        if (a_nomax) {
          const int kvh = (idx & 7) >> 2;
          const int qb128 = ((idx >> 3) << 2) + (idx & 3);
          int q0 = qb128 * 128, kb0 = kbeg, ke0 = kend;
          if (cls >= 3) { const int s2 = qb128 >> 4; kb0 = SEQ0 + s2 * DSEQ; ke0 = kb0 + DSEQ; q0 = kb0 + (qb128 & 15) * 128; }
          attn_item<64, 1, false, 0, true, true>(qkv + Q_QA + kvh * 128, 256, qkv + Q_KA + kvh * 64, 128,
                                                 qkv + Q_VTA + (size_t)kvh * 64 * T, q0, kb0, ke0,
                                                 1.f, 0.f, 0.f, 1.f, nullptr, BR + kvh * 128, nullptr, smem);
        } else
          attn_item<64, 1, false, 0, false>(qkv + Q_QA + head * 64, 256, qkv + Q_KA + (head >> 1) * 64, 128,
                                            qkv + Q_VTA + (size_t)(head >> 1) * 64 * T, qtok0, kbeg, kend,
                                            1.f, 0.f, 0.f, 1.f, nullptr, BR + head * 64, nullptr, smem);
      }
    } else {
      const int idx = it - 1536;
      const int head = (idx & 7) >> 1;
      const int qbg = ((idx >> 3) << 1) + (idx & 1);
      const int qtok0 = qbg * 256;
      int sb, se;
      if (qtok0 < SEQ0) { sb = 0; se = SEQ0; }
      else { sb = SEQ0 + ((qtok0 - SEQ0) / DSEQ) * DSEQ; se = sb + DSEQ; }
      const int kbeg = max(sb, qtok0 - 128), kend = min(se, qtok0 + 256 + 128);
      const float sink = P.b_sink[layer * 4 + head];
      attn_item<64, 1, true, 0>(qkv + Q_QB + head * 64, 256, qkv + Q_KB + (head >> 1) * 64, 128,
                                    qkv + Q_VTB + (size_t)(head >> 1) * 64 * T, qtok0, kbeg, kend,
                                    0.125f * L2E, sink * L2E, 0.f, 1.f, nullptr, BR + 256 + head * 64, nullptr, smem);
    }
  }
}

DI void ew_phase(const Params& P, const u16* __restrict__ Y, float coef, const float* __restrict__ gpost,
                 const float* __restrict__ gnext, bool from_inputs) {
  const int tid = opaque_tid();
  const int lane = tid & 63, wave = tid >> 6;
  u16* XN = (u16*)(P.ws + OFF_XN);
  u16* XB = (u16*)(P.ws + OFF_XB);
  for (int tok = blockIdx.x * 8 + wave; tok < T; tok += gridDim.x * 8) {
    float4 x[4];
    if (from_inputs) {
      const float* xs = tok < SEQ0 ? P.x_prompt + (size_t)tok * DM : P.x_sample + (size_t)(tok - SEQ0) * DM;
#pragma unroll
      for (int i = 0; i < 4; ++i) x[i] = *(const float4*)(xs + (i * 64 + lane) * 4);
    } else {
#pragma unroll
      for (int i = 0; i < 4; ++i) {
        const uint2 xb = *(const uint2*)(XB + (size_t)tok * DM + (i * 64 + lane) * 4);
        x[i] = make_float4(bf2f(xb.x & 0xffffu), bf2f(xb.x >> 16), bf2f(xb.y & 0xffffu), bf2f(xb.y >> 16));
      }
    }
    if (Y) {
      float4 y[4];
      float ss = 0.f;
#pragma unroll
      for (int i = 0; i < 4; ++i) {
        const uint2 yb = *(const uint2*)(Y + (size_t)tok * KP1 + (i * 64 + lane) * 4);
        y[i] = make_float4(bf2f(yb.x & 0xffffu), bf2f(yb.x >> 16), bf2f(yb.y & 0xffffu), bf2f(yb.y >> 16));
        ss += y[i].x * y[i].x + y[i].y * y[i].y + y[i].z * y[i].z + y[i].w * y[i].w;
      }
      ss = wave_sum(ss);
      const float rs = rsqrtf(ss * (1.f / 1024.f) + EPS) * coef;
#pragma unroll
      for (int i = 0; i < 4; ++i) {
        float4 g = *(const float4*)(gpost + (i * 64 + lane) * 4);
        x[i].x += y[i].x * rs * g.x; x[i].y += y[i].y * rs * g.y;
        x[i].z += y[i].z * rs * g.z; x[i].w += y[i].w * rs * g.w;
      }
    }
    if (!gnext) {
#pragma unroll
      for (int i = 0; i < 4; ++i) *(float4*)(P.out + (size_t)tok * DM + (i * 64 + lane) * 4) = x[i];
    } else {
#pragma unroll
      for (int i = 0; i < 4; ++i) {
        uint2 pk;
        pk.x = pk2(x[i].x, x[i].y);
        pk.y = pk2(x[i].z, x[i].w);
        *(uint2*)(XB + (size_t)tok * DM + (i * 64 + lane) * 4) = pk;
      }
    }
    if (gnext) {
      float ss = 0.f;
#pragma unroll
      for (int i = 0; i < 4; ++i) ss += x[i].x * x[i].x + x[i].y * x[i].y + x[i].z * x[i].z + x[i].w * x[i].w;
      ss = wave_sum(ss);
      const float rs = rsqrtf(ss * (1.f / 1024.f) + EPS);
#pragma unroll
      for (int i = 0; i < 4; ++i) {
        float4 g = *(const float4*)(gnext + (i * 64 + lane) * 4);
        uint2 pk;
        pk.x = pk2(x[i].x * rs * g.x, x[i].y * rs * g.y);
        pk.y = pk2(x[i].z * rs * g.z, x[i].w * rs * g.w);
        *(uint2*)(XN + (size_t)tok * KP1 + (i * 64 + lane) * 4) = pk;
      }
    }
  }
}

DI int colmap(int mode, int n, int nsrc) {
  if (mode == 1) { return ((n >> 7) & 1) * DFF + (n >> 8) * 128 + (n & 127); }
  if (mode == 2) {
    if (n < 2560) {
      const int w = n & 255;
      n = (n & ~255) + ((w >> 5) & 3) * 64 + (w >> 7) * 32 + (w & 31);
    }
    if (n < 1664) return n;
    if (n < 2432) return n + 32;
    if (n < 2464) return n - 2432 + 1664;
    if (n < 2560) return -1;
    return n - 96;
  }
  return n < nsrc ? n : -1;
}
DI void conv_job(u16* __restrict__ dst, int ldd, const float* __restrict__ src, int Nd, int K, int lds, int mode,
                 const float* __restrict__ kscale) {
  const int total = Nd * (K >> 3);
  const int gthreads = gridDim.x * NTHR;
  for (int idx = blockIdx.x * NTHR + opaque_tid(); idx < total; idx += gthreads) {
    const int n = idx % Nd, k8 = idx / Nd;
    const int col = colmap(mode, n, lds);
    float v[8];
#pragma unroll
    for (int j = 0; j < 8; ++j) {
      float x = 0.f;
      if (col >= 0) {
        x = src[(size_t)(k8 * 8 + j) * lds + col];
        if (kscale) x *= kscale[k8 * 8 + j];
      }
      v[j] = x;
    }
    uint4 pk = {pk2(v[0], v[1]), pk2(v[2], v[3]), pk2(v[4], v[5]), pk2(v[6], v[7])};
    *(uint4*)(dst + (size_t)n * ldd + k8 * 8) = pk;
  }
}
DI void convert_layer(const Params& P, int l) {
  u16* W = (u16*)(P.ws + OFF_W);
  for (int s = 0; s < 2; ++s) {
    conv_job(W + W_WI + (size_t)s * 5632 * KP1, KP1, P.ffn_wi + ((size_t)l * 2 + s) * 1024 * 5632, 5632, 1024, 5632, 1, nullptr);
    conv_job(W + W_WO + (size_t)s * 1024 * KP2, KP2, P.ffn_wo + ((size_t)l * 2 + s) * 2816 * 1024, 1024, 2816, 1024, 0, nullptr);
  }
  conv_job(W + W_WIN, KP1, P.w_in + (size_t)l * 1024 * NPROJ, 6656, 1024, NPROJ, 2, nullptr);
  conv_job(W + W_WUQ, 384, P.c_w_uq + (size_t)l * 384 * 384, 512, 384, 384, 0, P.c_q_norm + l * 384);
  conv_job(W + W_WUKV, 256, P.c_w_ukv + (size_t)l * 256 * 512, 512, 256, 512, 0, P.c_kv_norm + l * 256);
  conv_job(W + W_WB, KP1, P.w_branch + (size_t)l * 1024 * 1024, 1024, 1024, 1024, 0, nullptr);
  conv_job(W + W_WOUT, KP1, P.w_out + (size_t)l * 1024 * 1024, 1024, 1024, 1024, 0, nullptr);
}
DI void rope_tables(const Params& P) {
  float2* R64 = (float2*)(P.ws + OFF_R64);
  float2* R32 = (float2*)(P.ws + OFF_R32);
  const int gthreads = gridDim.x * NTHR;
  for (int idx = blockIdx.x * NTHR + opaque_tid(); idx < 16384 * 48; idx += gthreads) {
    int pos, f; double base; float2* dst;
    if (idx < 16384 * 32) { pos = idx >> 5; f = idx & 31; base = 0.7498942093324559; dst = R64 + idx; }
    else { const int i2 = idx - 16384 * 32; pos = i2 >> 4; f = i2 & 15; base = 0.5623413251903491; dst = R32 + i2; }
    double inv = 1.0;
    for (int k = 0; k < f; ++k) inv *= base;
    const float ang = (float)pos * (float)inv;
    double tr = (double)ang * 0.15915494309189535;
    tr -= rint(tr);
    const float tf = (float)tr;
    *dst = make_float2(__builtin_amdgcn_cosf(tf), __builtin_amdgcn_sinf(tf));
  }
}

DI void fast_grid_barrier(unsigned* bar, unsigned nblk) {
  asm volatile("s_waitcnt vmcnt(0) lgkmcnt(0)" ::: "memory");
  __syncthreads();
  if (threadIdx.x == 0) {
    __builtin_amdgcn_fence(__ATOMIC_RELEASE, "agent");
    asm volatile("s_waitcnt vmcnt(0) lgkmcnt(0)" ::: "memory");
    const unsigned gen = __hip_atomic_load(&bar[64], __ATOMIC_RELAXED, __HIP_MEMORY_SCOPE_AGENT);
    const unsigned old = __hip_atomic_fetch_add(&bar[0], 1u, __ATOMIC_RELAXED, __HIP_MEMORY_SCOPE_AGENT);
    if (old == nblk - 1u) {
      __hip_atomic_store(&bar[0], 0u, __ATOMIC_RELAXED, __HIP_MEMORY_SCOPE_AGENT);
      __hip_atomic_fetch_add(&bar[64], 1u, __ATOMIC_RELEASE, __HIP_MEMORY_SCOPE_AGENT);
    } else {
      while (__hip_atomic_load(&bar[64], __ATOMIC_RELAXED, __HIP_MEMORY_SCOPE_AGENT) == gen) __builtin_amdgcn_s_sleep(1);
    }
    __builtin_amdgcn_fence(__ATOMIC_ACQUIRE, "agent");
    asm volatile("s_waitcnt vmcnt(0) lgkmcnt(0)" ::: "memory");
  }
  __syncthreads();
}

__global__ void __launch_bounds__(NTHR) __attribute__((amdgpu_waves_per_eu(2, 2))) mega(Params P) {
  extern __shared__ __attribute__((aligned(16))) char smem[];
  cg::grid_group grid = cg::this_grid();
  int phase = 0;
#if MULTI_LAUNCH
#define ACTIVE() (phase >= P.phase_lo && phase < P.phase_hi)
#define SEAM() do { ++phase; } while (0)
#else
#define ACTIVE() (true)
#define SEAM() do { ++phase; if (phase == 1) grid.sync(); else fast_grid_barrier((unsigned*)(P.ws + OFF_BAR), gridDim.x); } while (0)
#endif
  u16* W = (u16*)(P.ws + OFF_W);
  u16* XN = (u16*)(P.ws + OFF_XN);
  u16* R2 = (u16*)(P.ws + OFF_R2);
  u16* qkv = (u16*)(P.ws + OFF_QKV);
  const u16* Y = qkv + Q_Y;
#define PTRS

  if (ACTIVE()) { PTRS
    rope_tables(P);
    convert_layer(P, 0);
    ew_phase(P, nullptr, 0.f, nullptr, P.norm_g, true);
  }
  SEAM();
  for (int l = 0; l < 4; ++l) {
    const float* g = P.norm_g + (size_t)l * 6 * DM;
    if (ACTIVE()) { PTRS gemm8_phase<5632, DM, KP1>(XN, W + W_WI, EpiFfnUp8{R2}, smem); }
    SEAM();
    if (ACTIVE()) { PTRS gemm8_phase<1024, DFF, KP2>(R2, W + W_WO, EpiY8{qkv + Q_Y}, smem); }
    SEAM();
    if (ACTIVE()) { PTRS ew_phase(P, Y, 0.5f, g + DM, g + 2 * DM, false); }
    SEAM();
    if (ACTIVE()) { PTRS
      gemm8_phase<2560, DM, KP1>(XN, W + W_WIN, EpiProj8{&P, l}, smem);
      gemm8_phase<4096, DM, KP1>(XN, W + W_WIN + 2560ull * KP1, EpiGate8{(unsigned char*)R2}, smem);
    }
    SEAM();
    if (ACTIVE()) { PTRS
      gemm_phase<M_CUQ, 4>(W + W_WUQ, 384, qkv + Q_CQ, 384, 384, 2, smem, P, l);
      gemm_phase<M_CUKV, 4>(W + W_WUKV, 256, qkv + Q_CKV, 256, 256, 2, smem, P, l);
    }
    SEAM();
    if (ACTIVE()) { PTRS attn_phase(P, l, smem); }
    SEAM();
    if (ACTIVE()) { PTRS gemm_phase<M_MERGE, 2>(W + W_WB, KP1, XN, KP1, DM, 4, smem, P, l); }
    SEAM();
    if (ACTIVE()) { PTRS gemm8_phase<1024, DM, KP1>(qkv + Q_MERGED, W + W_WOUT, EpiY8{qkv + Q_Y}, smem); }
    SEAM();
    if (ACTIVE()) { PTRS ew_phase(P, Y, 1.0f, g + 3 * DM, g + 4 * DM, false); }
    SEAM();
    if (ACTIVE()) { PTRS gemm8_phase<5632, DM, KP1>(XN, W + W_WI + 5632ull * KP1, EpiFfnUp8{R2}, smem); }
    SEAM();
    if (ACTIVE()) { PTRS gemm8_phase<1024, DFF, KP2>(R2, W + W_WO + 1024ull * KP2, EpiY8{qkv + Q_Y}, smem); }
    SEAM();
    if (ACTIVE()) { PTRS
      ew_phase(P, Y, 0.5f, g + 5 * DM, l < 3 ? g + 6 * DM : nullptr, false);
      if (l < 3) convert_layer(P, l + 1);
    }
    SEAM();
  }
}

constexpr int N_PHASES = 1 + 12 * 4;

extern "C" void kernel_launch(void* const* d_in, const int* in_sizes, int n_in, void* d_out, int out_size, void* d_ws,
                              size_t ws_size, hipStream_t stream) {
  static int grid_blocks = 0;
  if (!grid_blocks) {
    int dev = 0, cus = 0, per_cu = 0;
    hipGetDevice(&dev);
    hipDeviceGetAttribute(&cus, hipDeviceAttributeMultiprocessorCount, dev);
    hipFuncSetAttribute((const void*)mega, hipFuncAttributeMaxDynamicSharedMemorySize, SMEM_BYTES);
    hipOccupancyMaxActiveBlocksPerMultiprocessor(&per_cu, mega, NTHR, SMEM_BYTES);
    if (per_cu < 1) per_cu = 1;
    grid_blocks = cus * per_cu;
  }
  if (ws_size < WS_NEEDED) fprintf(stderr, "workspace too small: %zu < %zu\n", ws_size, (size_t)WS_NEEDED);
  Params P{};
  P.x_prompt = (const float*)d_in[0]; P.x_sample = (const float*)d_in[1]; P.norm_g = (const float*)d_in[2];
  P.w_in = (const float*)d_in[3]; P.a_qk_norm = (const float*)d_in[4]; P.b_sink = (const float*)d_in[5];
  P.c_q_norm = (const float*)d_in[6]; P.c_kv_norm = (const float*)d_in[7]; P.c_w_uq = (const float*)d_in[8];
  P.c_w_ukv = (const float*)d_in[9]; P.d_lambda = (const float*)d_in[10]; P.d_subln = (const float*)d_in[11];
  P.w_branch = (const float*)d_in[12]; P.w_out = (const float*)d_in[13]; P.ffn_wi = (const float*)d_in[14];
  P.ffn_wo = (const float*)d_in[15];
  P.out = (float*)d_out; P.ws = (char*)d_ws;
#if MULTI_LAUNCH
  for (int ph = 0; ph < N_PHASES; ++ph) {
    P.phase_lo = ph; P.phase_hi = ph + 1; P.coop = 0; P.pad0 = 0;
    hipLaunchKernelGGL(mega, dim3(grid_blocks), dim3(NTHR), SMEM_BYTES, stream, P);
  }
#else
  P.phase_lo = 0; P.phase_hi = 1 << 30; P.coop = 1; P.pad0 = 0;
  hipMemsetAsync((char*)d_ws + OFF_BAR, 0, 1024, stream);
  void* args[] = {&P};
  hipError_t e = hipLaunchCooperativeKernel((const void*)mega, dim3(grid_blocks), dim3(NTHR), args, SMEM_BYTES, stream);
  if (e != hipSuccess) fprintf(stderr, "cooperative launch failed: %s (grid %d)\n", hipGetErrorString(e), grid_blocks);
#endif
}
```

```cpp
#include <hip/hip_runtime.h>
#include <hip/hip_cooperative_groups.h>
#include <cstdio>
#include <cstdint>
#include <type_traits>
namespace cg = cooperative_groups;

#ifndef MULTI_LAUNCH
#define MULTI_LAUNCH 0
#endif

#define DI __device__ __forceinline__
typedef unsigned short u16;
typedef __attribute__((ext_vector_type(8))) short bf16x8;
typedef __attribute__((ext_vector_type(16))) float f32x16;
typedef __attribute__((ext_vector_type(2))) float f32x2_t;
typedef __attribute__((ext_vector_type(2))) __bf16 bf16x2_t;

constexpr int T = 32768;
constexpr int DM = 1024;
constexpr int DFF = 2816;
constexpr int KP1 = 1088;
constexpr int KP2 = 2880;
constexpr int GP = 4160;
constexpr int YP = 1040;
constexpr int NPROJ = 6560;
constexpr int SEQ0 = 16384;
constexpr int DSEQ = 2048;
constexpr float EPS = 1e-6f;
constexpr int NTHR = 512;
constexpr int LSTR = 72;
constexpr int SMEM_BYTES = 2 * 2 * 256 * LSTR * 2;

constexpr size_t W_WI = 0;
constexpr size_t W_WO = W_WI + 2ull * 5632 * KP1;
constexpr size_t W_WIN = W_WO + 2ull * 1024 * KP2;
constexpr size_t W_WUQ = W_WIN + 6656ull * KP1;
constexpr size_t W_WUKV = W_WUQ + 512ull * 384;
constexpr size_t W_WB = W_WUKV + 512ull * 256;
constexpr size_t W_WOUT = W_WB + 1024ull * KP1;
constexpr size_t W_TOTAL = W_WOUT + 1024ull * KP1;

constexpr size_t OFF_W = 0;
constexpr size_t OFF_XN = OFF_W + W_TOTAL * 2;
constexpr size_t OFF_R2 = OFF_XN + (size_t)T * KP1 * 2;
constexpr size_t OFF_QKV = OFF_R2 + (size_t)T * KP2 * 2;
constexpr size_t OFF_SS = OFF_QKV + (size_t)T * 3456 * 2;
constexpr size_t OFF_R64 = OFF_SS + (size_t)T * 20 * 4;
constexpr size_t OFF_R32 = OFF_R64 + 16384ull * 32 * 8;
constexpr size_t OFF_DS = OFF_R32 + 16384ull * 16 * 8;
constexpr size_t OFF_BAR = OFF_DS + (size_t)T * 256 * 4;
constexpr size_t OFF_XB = OFF_BAR + 1024;
constexpr size_t WS_NEEDED = OFF_XB + (size_t)T * 1024 * 2;

constexpr size_t Q_QA = 0;
constexpr size_t Q_KA = (size_t)T * 256;
constexpr size_t Q_VTA = (size_t)T * 384;
constexpr size_t Q_QB = (size_t)T * 512;
constexpr size_t Q_KB = (size_t)T * 768;
constexpr size_t Q_VTB = (size_t)T * 896;
constexpr size_t Q_CQ = (size_t)T * 1024;
constexpr size_t Q_CKV = (size_t)T * 1408;
constexpr size_t Q_QC = (size_t)T * 1664;
constexpr size_t Q_KC = (size_t)T * 2048;
constexpr size_t Q_VTC = (size_t)T * 2432;
constexpr size_t Q_QD = (size_t)T * 2688;
constexpr size_t Q_KD = (size_t)T * 2944;
constexpr size_t Q_VTD = (size_t)T * 3200;
constexpr size_t Q_MERGED = 0;
constexpr size_t Q_Y = (size_t)T * KP1;

struct Params {
  const float* x_prompt; const float* x_sample; const float* norm_g; const float* w_in;
  const float* a_qk_norm; const float* b_sink; const float* c_q_norm; const float* c_kv_norm;
  const float* c_w_uq; const float* c_w_ukv; const float* d_lambda; const float* d_subln;
  const float* w_branch; const float* w_out; const float* ffn_wi; const float* ffn_wo;
  float* out; char* ws;
  int phase_lo; int phase_hi; int coop; int pad0;
};

DI unsigned pk2(float a, float b) {
  f32x2_t v = {a, b};
  bf16x2_t r = __builtin_convertvector(v, bf16x2_t);
  return __builtin_bit_cast(unsigned, r);
}
DI u16 f2bf(float a) { return (u16)(pk2(a, 0.f) & 0xffffu); }
DI float bf2f(unsigned bits16) { return __uint_as_float(bits16 << 16); }
DI int crow(int v, int h) { return (v & 3) + 8 * (v >> 2) + 4 * h; }
DI int pos_of(int tok) { return tok < SEQ0 ? tok : ((tok - SEQ0) & (DSEQ - 1)); }
#define MFMA32(a, b, c) __builtin_amdgcn_mfma_f32_32x32x16_bf16((a), (b), (c), 0, 0, 0)

typedef __attribute__((ext_vector_type(4))) unsigned u32x4;
DI u32x4 gld16(const void* p) { u32x4 r; asm volatile("global_load_dwordx4 %0, %1, off" : "=v"(r) : "v"(p)); return r; }
DI void wait_vm0(u32x4& a) { asm volatile("s_waitcnt vmcnt(0)" : "+v"(a) :: "memory"); }
DI void wait_vm0(u32x4& a, u32x4& b) { asm volatile("s_waitcnt vmcnt(0)" : "+v"(a), "+v"(b) :: "memory"); }
DI void wait_vm0(u32x4& a, u32x4& b, u32x4& c) { asm volatile("s_waitcnt vmcnt(0)" : "+v"(a), "+v"(b), "+v"(c) :: "memory"); }
DI void wait_vm0(u32x4& a, u32x4& b, u32x4& c, u32x4& d) { asm volatile("s_waitcnt vmcnt(0)" : "+v"(a), "+v"(b), "+v"(c), "+v"(d) :: "memory"); }
DI u32x4 gld16s(unsigned voff, const void* sbase) { u32x4 r; asm volatile("global_load_dwordx4 %0, %1, %2" : "=v"(r) : "v"(voff), "s"(sbase)); return r; }
#define DEF_WAIT8(name, cnt) DI void name(u32x4& a, u32x4& b, u32x4& c, u32x4& d, u32x4& e, u32x4& f, u32x4& g, u32x4& h) { asm volatile("s_waitcnt vmcnt(" #cnt ")" : "+v"(a), "+v"(b), "+v"(c), "+v"(d), "+v"(e), "+v"(f), "+v"(g), "+v"(h) :: "memory"); }
#define DEF_WAIT6(name, cnt) DI void name(u32x4& a, u32x4& b, u32x4& c, u32x4& d, u32x4& e, u32x4& f) { asm volatile("s_waitcnt vmcnt(" #cnt ")" : "+v"(a), "+v"(b), "+v"(c), "+v"(d), "+v"(e), "+v"(f) :: "memory"); }
DEF_WAIT8(wait8_vm8, 8)
DEF_WAIT8(wait8_vm0, 0)
DEF_WAIT6(wait6_vm6, 6)
DEF_WAIT6(wait6_vm0, 0)
DI int opaque_tid() { int t = threadIdx.x; asm volatile("" : "+v"(t)); return t; }
DI float wave_sum(float v) {
#pragma unroll
  for (int m = 32; m >= 1; m >>= 1) v += __shfl_xor(v, m);
  return v;
}

DI void rope32_blk(f32x16& a, const float2* __restrict__ tab, int h) {
#pragma unroll
  for (int v = 0; v < 8; ++v) {
    float2 cs = tab[crow(v, h)];
    float x1 = a[v], x2 = a[v + 8];
    a[v] = x1 * cs.x - x2 * cs.y;
    a[v + 8] = x2 * cs.x + x1 * cs.y;
  }
}
DI void rope64_blk(f32x16& a0, f32x16& a1, const float2* __restrict__ tab, int h) {
#pragma unroll
  for (int v = 0; v < 16; ++v) {
    float2 cs = tab[crow(v, h)];
    float x1 = a0[v], x2 = a1[v];
    a0[v] = x1 * cs.x - x2 * cs.y;
    a1[v] = x2 * cs.x + x1 * cs.y;
  }
}
DI void store_rows(u16* __restrict__ base, int ld, int col0, const f32x16& a, int tok, int h, float sc = 1.f) {
#pragma unroll
  for (int vq = 0; vq < 4; ++vq) {
    uint2 pk;
    pk.x = pk2(a[4 * vq] * sc, a[4 * vq + 1] * sc);
    pk.y = pk2(a[4 * vq + 2] * sc, a[4 * vq + 3] * sc);
    *(uint2*)(base + (size_t)tok * ld + col0 + 8 * vq + 4 * h) = pk;
  }
}
DI void store_T(u16* __restrict__ base, int row0, const f32x16& a, int tok, int h) {
  const int tp = (tok & ~12) | ((tok & 4) << 1) | ((tok & 8) >> 1);
#pragma unroll
  for (int v = 0; v < 16; ++v) base[(size_t)((row0 + crow(v, h)) >> 6) * 64 * T + (size_t)(tp >> 7) * 8192 + ((row0 + crow(v, h)) & 63) * 128 + (tp & 127)] = f2bf(a[v]);
}

enum { M_FFNUP = 0, M_Y = 1, M_PROJ = 2, M_CUQ = 3, M_CUKV = 4, M_MERGE = 5, M_GATE = 6 };

template <int MODE, int NJ>
DI void gemm_epilogue(f32x16 (&acc)[2][NJ], int fbase, int tbase, int r, int h, const Params& P, int layer) {
  char* ws = P.ws;
  u16* qkv = (u16*)(ws + OFF_QKV);
  const float2* R64 = (const float2*)(ws + OFF_R64);
  const float2* R32 = (const float2*)(ws + OFF_R32);
  float* SS = (float*)(ws + OFF_SS);
  if constexpr (MODE == M_FFNUP) {
    u16* H = (u16*)(ws + OFF_R2);
    const int hf0 = (fbase >> 6) * 32;
#pragma unroll
    for (int j = 0; j < NJ; ++j) {
      const int tok = tbase + j * 32 + r;
      f32x16 o;
#pragma unroll
      for (int v = 0; v < 16; ++v) {
        float g = acc[0][j][v], u = acc[1][j][v];
        o[v] = g * __builtin_amdgcn_rcpf(1.f + __builtin_amdgcn_exp2f(-1.4426950408889634f * g)) * u;
      }
      store_rows(H, KP2, hf0, o, tok, h);
    }
  } else if constexpr (MODE == M_Y) {
    u16* Yb = qkv + Q_Y;
#pragma unroll
    for (int j = 0; j < NJ; ++j) {
      const int tok = tbase + j * 32 + r;
      store_rows(Yb, KP1, fbase, acc[0][j], tok, h);
      store_rows(Yb, KP1, fbase + 32, acc[1][j], tok, h);
    }
  } else if constexpr (MODE == M_PROJ) {
    if (fbase < 384) {
      const bool isK = fbase >= 256;
      const float* g = P.a_qk_norm + layer * 128 + (isK ? 64 : 0);
      u16* dst = qkv + (isK ? Q_KA : Q_QA);
      const int ld = isK ? 128 : 256;
      const int c0 = isK ? fbase - 256 : fbase;
      float gv[2][16];
#pragma unroll
      for (int i = 0; i < 2; ++i)
#pragma unroll
        for (int v = 0; v < 16; ++v) gv[i][v] = g[i * 32 + crow(v, h)];
#pragma unroll
      for (int j = 0; j < NJ; ++j) {
        const int tok = tbase + j * 32 + r;
        const int pos = pos_of(tok);
        float ss = 0.f;
#pragma unroll
        for (int i = 0; i < 2; ++i)
#pragma unroll
          for (int v = 0; v < 16; ++v) ss += acc[i][j][v] * acc[i][j][v];
        ss += __shfl_xor(ss, 32);
        const float rs = rsqrtf(ss * (1.f / 64.f) + EPS);
#pragma unroll
        for (int i = 0; i < 2; ++i)
#pragma unroll
          for (int v = 0; v < 16; ++v) acc[i][j][v] *= rs * gv[i][v];
        rope32_blk(acc[0][j], R32 + (size_t)(pos >> 6) * 16, h);
        rope32_blk(acc[1][j], R32 + (size_t)(pos & 63) * 16, h);
        store_rows(dst, ld, c0, acc[0][j], tok, h);
        store_rows(dst, ld, c0 + 32, acc[1][j], tok, h);
      }
    } else if (fbase < 512) {
#pragma unroll
      for (int j = 0; j < NJ; ++j) {
        const int tok = tbase + j * 32 + r;
        store_T(qkv + Q_VTA, fbase - 384, acc[0][j], tok, h);
        store_T(qkv + Q_VTA, fbase - 384 + 32, acc[1][j], tok, h);
      }
    } else if (fbase < 896) {
      const bool isK = fbase >= 768;
      u16* dst = qkv + (isK ? Q_KB : Q_QB);
      const int ld = isK ? 128 : 256;
      const int c0 = isK ? fbase - 768 : fbase - 512;
#pragma unroll
      for (int j = 0; j < NJ; ++j) {
        const int tok = tbase + j * 32 + r;
        const int pos = pos_of(tok);
        rope64_blk(acc[0][j], acc[1][j], R64 + (size_t)pos * 32, h);
        store_rows(dst, ld, c0, acc[0][j], tok, h);
        store_rows(dst, ld, c0 + 32, acc[1][j], tok, h);
      }
    } else if (fbase < 1024) {
#pragma unroll
      for (int j = 0; j < NJ; ++j) {
        const int tok = tbase + j * 32 + r;
        store_T(qkv + Q_VTB, fbase - 896, acc[0][j], tok, h);
        store_T(qkv + Q_VTB, fbase - 896 + 32, acc[1][j], tok, h);
      }
    } else if (fbase < 1664) {
      const bool isKV = fbase >= 1408;
      u16* dst = qkv + (isKV ? Q_CKV : Q_CQ);
      const int ld = isKV ? 256 : 384;
      const int c0 = isKV ? fbase - 1408 : fbase - 1024;
      const int sb = (isKV ? 12 : 0) + (c0 >> 5);
#pragma unroll
      for (int j = 0; j < NJ; ++j) {
        const int tok = tbase + j * 32 + r;
#pragma unroll
        for (int i = 0; i < 2; ++i) {
          float ss = 0.f;
#pragma unroll
          for (int v = 0; v < 16; ++v) ss += acc[i][j][v] * acc[i][j][v];
          ss += __shfl_xor(ss, 32);
          if (h == 0) SS[(size_t)tok * 20 + sb + i] = ss;
          store_rows(dst, ld, c0 + i * 32, acc[i][j], tok, h);
        }
      }
    } else if (fbase < 2176) {
      const bool isK = fbase >= 1920;
      u16* dst = qkv + (isK ? Q_KD : Q_QD);
      const int c0 = isK ? fbase - 1920 : fbase - 1664;
#pragma unroll
      for (int j = 0; j < NJ; ++j) {
        const int tok = tbase + j * 32 + r;
        const int pos = pos_of(tok);
#pragma unroll
        for (int i = 0; i < 2; ++i) {
          rope32_blk(acc[i][j], R32 + (size_t)pos * 16, h);
          store_rows(dst, 256, c0 + i * 32, acc[i][j], tok, h);
        }
      }
    } else if (fbase < 2432) {
#pragma unroll
      for (int j = 0; j < NJ; ++j) {
        const int tok = tbase + j * 32 + r;
        store_T(qkv + Q_VTD, fbase - 2176, acc[0][j], tok, h);
        store_T(qkv + Q_VTD, fbase - 2176 + 32, acc[1][j], tok, h);
      }
    } else if (fbase == 2432) {
#pragma unroll
      for (int j = 0; j < NJ; ++j) {
        const int tok = tbase + j * 32 + r;
        const int pos = pos_of(tok);
        rope32_blk(acc[0][j], R32 + (size_t)pos * 16, h);
#pragma unroll
        for (int hd = 0; hd < 4; ++hd) store_rows(qkv + Q_KC, 384, hd * 96 + 64, acc[0][j], tok, h);
      }
    }
  } else if constexpr (MODE == M_GATE) {
    unsigned char* G8 = (unsigned char*)(ws + OFF_R2);
#pragma unroll
    for (int j = 0; j < NJ; ++j) {
      const int tok = tbase + j * 32 + r;
#pragma unroll
      for (int i = 0; i < 2; ++i)
#pragma unroll
        for (int vq = 0; vq < 4; ++vq) {
          unsigned pk = 0u;
#pragma unroll
          for (int e = 0; e < 4; ++e) {
            const float o = __builtin_amdgcn_rcpf(1.f + __builtin_amdgcn_exp2f(-1.4426950408889634f * acc[i][j][4 * vq + e]));
            pk |= (unsigned)(o * 255.f + 0.5f) << (8 * e);
          }
          *(unsigned*)(G8 + (size_t)tok * GP + fbase + i * 32 + 8 * vq + 4 * h) = pk;
        }
    }
  } else if constexpr (MODE == M_CUQ) {
    if (fbase >= 384) return;
    float cn = 0.f;
#pragma unroll
    for (int j = 0; j < NJ; ++j) {
      const int tok = tbase + j * 32 + r;
      const int pos = pos_of(tok);
      float ss = 0.f;
#pragma unroll
      for (int b = 0; b < 12; ++b) ss += SS[(size_t)tok * 20 + b];
      const float rs = rsqrtf(ss * (1.f / 384.f) + EPS);
#pragma unroll
      for (int i = 0; i < 2; ++i) {
        const int blk = (fbase >> 5) + i;
        float hs = 0.f;
#pragma unroll
        for (int v = 0; v < 16; ++v) { acc[i][j][v] *= rs; hs += acc[i][j][v] * acc[i][j][v]; }
        cn = fmaxf(cn, hs);
        if (blk % 3 == 2) rope32_blk(acc[i][j], R32 + (size_t)pos * 16, h);
        store_rows(qkv + Q_QC, 384, blk * 32, acc[i][j], tok, h, 0.10206207261596577f * 1.4426950408889634f);
      }
    }
    {
      float v = cn * 2.f;
#pragma unroll
      for (int mk = 32; mk >= 1; mk >>= 1) v = fmaxf(v, __shfl_xor(v, mk));
      if ((opaque_tid() & 63) == 0) atomicMax((unsigned*)(ws + OFF_BAR) + 144 + layer * 4 + 0, __float_as_uint(v));
    }
  } else if constexpr (MODE == M_CUKV) {
    float cn = 0.f;
#pragma unroll
    for (int j = 0; j < NJ; ++j) {
      const int tok = tbase + j * 32 + r;
      float ss = 0.f;
#pragma unroll
      for (int b = 0; b < 8; ++b) ss += SS[(size_t)tok * 20 + 12 + b];
      const float rs = rsqrtf(ss * (1.f / 256.f) + EPS);
#pragma unroll
      for (int i = 0; i < 2; ++i) {
        const int blk = (fbase >> 5) + i;
        const int hd = blk >> 2, q = blk & 3;
#pragma unroll
        for (int v = 0; v < 16; ++v) acc[i][j][v] *= rs;
        if (q < 2) {
          float hs = 0.f;
#pragma unroll
          for (int v = 0; v < 16; ++v) hs += acc[i][j][v] * acc[i][j][v];
          cn = fmaxf(cn, hs);
          store_rows(qkv + Q_KC, 384, hd * 96 + q * 32, acc[i][j], tok, h);
        } else store_T(qkv + Q_VTC, hd * 64 + (q - 2) * 32, acc[i][j], tok, h);
      }
    }
    {
      float v = cn * 2.f;
#pragma unroll
      for (int mk = 32; mk >= 1; mk >>= 1) v = fmaxf(v, __shfl_xor(v, mk));
      if ((opaque_tid() & 63) == 0) atomicMax((unsigned*)(ws + OFF_BAR) + 144 + layer * 4 + 1, __float_as_uint(v));
    }
  } else if constexpr (MODE == M_MERGE) {
#pragma unroll
    for (int j = 0; j < NJ; ++j) {
      const int tok = tbase + j * 32 + r;
      store_rows(qkv + Q_MERGED, KP1, fbase, acc[0][j], tok, h);
      store_rows(qkv + Q_MERGED, KP1, fbase + 32, acc[1][j], tok, h);
    }
  }
}

typedef __attribute__((address_space(3))) unsigned lds_u32_t;
typedef __attribute__((address_space(1))) const unsigned glb_u32_t;
template <int MODE, int NJ>
DI void gemm_tile(const u16* __restrict__ Wt, int ldw, const u16* __restrict__ X, int ldx, int K, int f0, int t0, char* smem,
                  const Params& P, int layer) {
  constexpr int XROWS = NJ * 64;
  constexpr int WSTG = 256 * 64, XSTG = XROWS * 64;
  u16* sW = (u16*)smem;
  u16* sX = sW + 2 * WSTG;
  const int tid = opaque_tid(), lane = tid & 63, wave = tid >> 6, r = lane & 31, h = lane >> 5;
  const int wf = wave & 3, wt = wave >> 2;
  f32x16 acc[2][NJ];
  f32x16 tot[2][MODE == M_MERGE ? NJ : 1];
#pragma unroll
  for (int i = 0; i < 2; ++i)
#pragma unroll
    for (int j = 0; j < NJ; ++j)
#pragma unroll
      for (int v = 0; v < 16; ++v) acc[i][j][v] = 0.f;
  if constexpr (MODE == M_MERGE) {
#pragma unroll
    for (int i = 0; i < 2; ++i)
#pragma unroll
      for (int j = 0; j < NJ; ++j)
#pragma unroll
        for (int v = 0; v < 16; ++v) tot[i][j][v] = 0.f;
  }
  const int nk = K >> 6;
  const int srow = tid >> 3;
  const int schunk = (tid & 7) ^ ((tid >> 4) & 7);
  const u16* wp = Wt + (size_t)(f0 + srow) * ldw + schunk * 8;
  const u16* xp = X + (size_t)(t0 + srow) * ldx + schunk * 8;
  const int fbase = f0 + wf * 64, tbase = t0 + wt * (NJ * 32);

  auto issue = [&](int kt, int buf) {
#pragma unroll
    for (int i = 0; i < 4; ++i)
      __builtin_amdgcn_global_load_lds((glb_u32_t*)(wp + (size_t)(i * 64) * ldw + kt * 64),
                                       (lds_u32_t*)(sW + buf * WSTG + i * 4096 + tid * 8), 16, 0, 0);
#pragma unroll
    for (int i = 0; i < NJ; ++i)
      __builtin_amdgcn_global_load_lds((glb_u32_t*)(xp + (size_t)(i * 64) * ldx + kt * 64),
                                       (lds_u32_t*)(sX + buf * XSTG + i * 4096 + tid * 8), 16, 0, 0);
  };
  const int swz = (r >> 1) & 7;
  auto compute = [&](int buf, int kt) {
    const u16* aW = sW + buf * WSTG + (wf * 64 + r) * 64;
    const u16* aX = sX + buf * XSTG + (wt * (NJ * 32) + r) * 64;
#pragma unroll
    for (int ks = 0; ks < 4; ++ks) {
      const int co = ((2 * ks + h) ^ swz) * 8;
      bf16x8 wfrag[2], xfrag[NJ];
#pragma unroll
      for (int i = 0; i < 2; ++i) wfrag[i] = *(const bf16x8*)(aW + i * 32 * 64 + co);
#pragma unroll
      for (int j = 0; j < NJ; ++j) xfrag[j] = *(const bf16x8*)(aX + j * 32 * 64 + co);
#pragma unroll
      for (int i = 0; i < 2; ++i)
#pragma unroll
        for (int j = 0; j < NJ; ++j) acc[i][j] = MFMA32(wfrag[i], xfrag[j], acc[i][j]);
    }
    if constexpr (MODE == M_MERGE) {
      if ((kt & 3) == 3) {
        const int br = kt >> 2;
        const unsigned char* G8 = (const unsigned char*)(P.ws + OFF_R2);
#pragma unroll
        for (int j = 0; j < NJ; ++j) {
          const int tok = tbase + j * 32 + r;
#pragma unroll
          for (int i = 0; i < 2; ++i)
#pragma unroll
            for (int vq = 0; vq < 4; ++vq) {
              const unsigned gp = *(const unsigned*)(G8 + (size_t)tok * GP + br * 1024 + fbase + i * 32 + 8 * vq + 4 * h);
              tot[i][j][4 * vq + 0] += (float)(gp & 0xffu) * (1.f / 255.f) * acc[i][j][4 * vq + 0];
              tot[i][j][4 * vq + 1] += (float)((gp >> 8) & 0xffu) * (1.f / 255.f) * acc[i][j][4 * vq + 1];
              tot[i][j][4 * vq + 2] += (float)((gp >> 16) & 0xffu) * (1.f / 255.f) * acc[i][j][4 * vq + 2];
              tot[i][j][4 * vq + 3] += (float)(gp >> 24) * (1.f / 255.f) * acc[i][j][4 * vq + 3];
              acc[i][j][4 * vq + 0] = 0.f; acc[i][j][4 * vq + 1] = 0.f;
              acc[i][j][4 * vq + 2] = 0.f; acc[i][j][4 * vq + 3] = 0.f;
            }
        }
      }
    }
  };

  issue(0, 0);
  asm volatile("s_waitcnt vmcnt(0)" ::: "memory");
  __syncthreads();
  for (int kt = 0; kt < nk; ++kt) {
    const int buf = kt & 1;
    if (kt + 1 < nk) issue(kt + 1, buf ^ 1);
    compute(buf, kt);
    asm volatile("s_waitcnt vmcnt(0) lgkmcnt(0)" ::: "memory");
    __syncthreads();
  }
  if constexpr (MODE == M_MERGE) gemm_epilogue<MODE, NJ>(tot, fbase, tbase, r, h, P, layer);
  else gemm_epilogue<MODE, NJ>(acc, fbase, tbase, r, h, P, layer);
}

template <int MODE, int NJ>
DI void gemm_phase(const u16* Wt, int ldw, const u16* X, int ldx, int K, int nF, char* smem, const Params& P, int layer) {
  constexpr int TT = NJ * 64;
  const int nT = T / TT;
  const int ntiles = nF * nT;
  for (int idx = blockIdx.x; idx < ntiles; idx += gridDim.x) {
    const int tt_lo = idx & 15;
    const int rest = idx >> 4;
    const int ft = rest % nF;
    const int tt = (rest / nF) * 16 + tt_lo;
    gemm_tile<MODE, NJ>(Wt, ldw, X, ldx, K, ft * 256, tt * TT, smem, P, layer);
  }
}

namespace pg8 {
#define PG8_LAS __attribute__((address_space(3)))
typedef unsigned short bf16_t;
typedef short bf16x8 __attribute__((ext_vector_type(8)));
typedef float f32x4 __attribute__((ext_vector_type(4)));
typedef unsigned u32x4 __attribute__((ext_vector_type(4)));
constexpr int BM = 256, BK = 64, HALF = 128, HTB = HALF * BK * 2  , STAGE_BYTES = 8 * HTB, NXCD = 8, WGM = 8;

__host__ __device__ __forceinline__ int lds_byte(int r, int c) { const int st = (r >> 4) * 2 + (c >> 5), rr = r & 15, cc = c & 31, ob = rr * 64 + cc * 2; return st * 1024 + (ob ^ (((ob >> 9) & 1) << 5)); }
__host__ __device__ __forceinline__ void stage_rc(int b, int& R, int& C) { const int st = b / 1024, sb = b % 1024, swz = sb ^ (((sb >> 9) & 1) << 5); R = (st >> 1) * 16 + swz / 64; C = (st & 1) * 32 + (swz % 64) / 2; }
__host__ __device__ __forceinline__ int perm32(int rho) { const int n = rho >> 4, i = rho & 15; return 8 * (i >> 2) + 4 * n + (i & 3); }

struct Unit { int pm, pn; };
struct Gemm { const bf16_t* A; const bf16_t* Bt; int M, N, K, ld; };

struct StaticOrder {
    int nM, nN, nwg, G, c;
    __host__ __device__ void init(int M, int N, int G_, int c_) { nM = M / BM; nN = N / BM; nwg = nM * nN; G = G_; c = c_; }
    __host__ __device__ bool next(int i, Unit& u) const {
        const long L = (long)i * G + c; if (L >= nwg) return false;
        int wgid = (int)L; { const int q = nwg / NXCD, r = nwg % NXCD, xcd = wgid % NXCD, off = wgid / NXCD; wgid = (xcd < r ? xcd * (q + 1) : r * (q + 1) + (xcd - r) * q) + off; }
        const int nig = WGM * nN, gid = wgid / nig, fm = gid * WGM, gsz = (nM - fm) < WGM ? (nM - fm) : WGM;
        u.pm = fm + ((wgid % nig) % gsz); u.pn = (wgid % nig) / gsz; return true;
    }
    __device__ __forceinline__ void a_ready(const Unit&) const {}
    __device__ __forceinline__ void done(const Unit&) const {}
};

template <class Epi, class Sched, bool STAMP, int KC, int LDC>
__device__ __forceinline__ void gemm_phase(PG8_LAS unsigned char* lds, const Gemm g, const Sched& S, const Epi& E, unsigned long long* stamps) {
    const int tid = opaque_tid(), wid = __builtin_amdgcn_readfirstlane(tid >> 6), lane = tid & 63, wr = wid >> 2, wc = wid & 3, fr = lane & 15, fq = lane >> 4;
    constexpr int K = KC, nt = K / BK;
    int ts_lo = 0, ts_hi = 0, nts = 0; const unsigned long long rt_entry = STAMP ? (unsigned long long)wall_clock64() : 0ull;
#define PG8_STAMP() do { if (STAMP && wid == 0 && nts < 64) { const unsigned long long _c = (unsigned long long)clock64(); \
        ts_lo = (lane == nts) ? (int)(unsigned)_c : ts_lo; ts_hi = (lane == nts) ? (int)(unsigned)(_c >> 32) : ts_hi; ++nts; } } while (0)
    PG8_STAMP();
    unsigned voffA[2], voffB[2];
#pragma unroll
    for (int i = 0; i < 2; ++i) { int R, C; stage_rc(tid * 16 + i * 8192, R, C); const int Rb = Epi::PERM ? ((R & ~31) + perm32(R & 31)) : R;
        voffA[i] = (unsigned)(R * LDC + C) * 2u; voffB[i] = (unsigned)(Rb * LDC + C) * 2u; }
    const size_t kstep = (size_t)(BK * 2);
    constexpr size_t hstep = (size_t)HALF * LDC * 2;
    const size_t tstep = 2 * hstep;
    const unsigned ldsw = (unsigned)wid * 1024u;
    const int aoff = lds_byte(wr * 64 + fr, fq * 8), boff = lds_byte(wc * 32 + fr, fq * 8);
#define PG8_SA(b, h) (((b) * 2 + (h)) * HTB)
#define PG8_SB(b, h) ((4 + (b) * 2 + (h)) * HTB)
#define PG8_STAGE(bufoff, gbase, voff) do { _Pragma("unroll") for (int _i = 0; _i < 2; ++_i) \
        __builtin_amdgcn_global_load_lds((const unsigned*)((const char*)(gbase) + (voff)[_i]), (PG8_LAS unsigned*)(lds + (bufoff) + ldsw + _i * 8192), 16, 0, 0); } while (0)
#define PG8_LDA(dst, b, h) do { _Pragma("unroll") for (int m = 0; m < 4; ++m) _Pragma("unroll") for (int k = 0; k < 2; ++k) dst[m][k] = *(const PG8_LAS bf16x8*)(lds + PG8_SA(b, h) + aoff + m * 2048 + k * 1024); } while (0)
#define PG8_LDB(dst, b, h) do { _Pragma("unroll") for (int n = 0; n < 2; ++n) _Pragma("unroll") for (int k = 0; k < 2; ++k) dst[n][k] = *(const PG8_LAS bf16x8*)(lds + PG8_SB(b, h) + boff + n * 2048 + k * 1024); } while (0)
#define PG8_MMA(ai, bj, At, Bt) do { __builtin_amdgcn_s_setprio(1); _Pragma("unroll") for (int m = 0; m < 4; ++m) _Pragma("unroll") for (int n = 0; n < 2; ++n) _Pragma("unroll") for (int k = 0; k < 2; ++k) \
        acc[ai][bj][m][n] = __builtin_amdgcn_mfma_f32_16x16x32_bf16(Bt[n][k], At[m][k], acc[ai][bj][m][n], 0, 0, 0); __builtin_amdgcn_s_setprio(0); } while (0)
#define PG8_WAIT_V(n) asm volatile("s_waitcnt vmcnt(" #n ")" ::: "memory")
#define PG8_WAIT_L(n) asm volatile("s_waitcnt lgkmcnt(" #n ")" ::: "memory")
#define PG8_BAR __builtin_amdgcn_s_barrier()
#define PG8_SCHED __builtin_amdgcn_sched_barrier(0)
    Unit cur, nxt; int ui = 0;
    if (!S.next(0, cur)) return;
    f32x4 acc[2][2][4][2];
#pragma unroll
    for (int a = 0; a < 2; ++a)
#pragma unroll
        for (int b = 0; b < 2; ++b)
#pragma unroll
            for (int m = 0; m < 4; ++m)
#pragma unroll
                for (int n = 0; n < 2; ++n) acc[a][b][m][n] = (f32x4){0.f, 0.f, 0.f, 0.f};
    bf16x8 At[4][2], B0[2][2], B1[2][2];
    const char* cA = (const char*)g.A + (size_t)cur.pm * tstep; const char* cB = (const char*)g.Bt + (size_t)cur.pn * tstep;
    S.a_ready(cur);
    PG8_STAGE(PG8_SB(0, 0), cB, voffB); PG8_STAGE(PG8_SA(0, 0), cA, voffA); PG8_STAGE(PG8_SB(0, 1), cB + hstep, voffB); PG8_STAGE(PG8_SA(0, 1), cA + hstep, voffA);
    if (wr == 1) PG8_BAR;
    PG8_WAIT_V(4); PG8_BAR;
    PG8_STAGE(PG8_SB(1, 0), cB + kstep, voffB); PG8_STAGE(PG8_SA(1, 0), cA + kstep, voffA); PG8_STAGE(PG8_SB(1, 1), cB + hstep + kstep, voffB);
    PG8_WAIT_V(6); PG8_BAR;
    PG8_STAMP();
    for (;;) {
        const bool has_next = S.next(ui + 1, nxt);
        const char* nA = has_next ? (const char*)g.A + (size_t)nxt.pm * tstep : cA; const char* nB = has_next ? (const char*)g.Bt + (size_t)nxt.pn * tstep : cB;
        for (int t = 0; t < nt; t += 2) {
            const bool last = (t == nt - 2);
            const char* a1 = cA + (size_t)(t + 1) * kstep;
            const char* a2 = last ? nA : cA + (size_t)(t + 2) * kstep; const char* b2 = last ? nB : cB + (size_t)(t + 2) * kstep;
            const char* a3 = a2 + kstep; const char* b3 = b2 + kstep;
            if (last && has_next) S.a_ready(nxt);
            PG8_LDB(B0, 0, 0); PG8_SCHED; PG8_LDA(At, 0, 0); PG8_STAGE(PG8_SA(1, 1), a1 + hstep, voffA);
            PG8_WAIT_L(8); PG8_BAR; PG8_WAIT_L(0); PG8_MMA(0, 0, At, B0); PG8_BAR; PG8_SCHED;
            PG8_LDB(B1, 0, 1); PG8_STAGE(PG8_SB(0, 0), b2, voffB);
            PG8_BAR; PG8_WAIT_L(0); PG8_MMA(0, 1, At, B1); PG8_BAR;
            PG8_LDA(At, 0, 1); PG8_STAGE(PG8_SA(0, 0), a2, voffA);
            PG8_BAR; PG8_WAIT_L(0); PG8_MMA(1, 0, At, B0); PG8_BAR; PG8_SCHED;
            PG8_STAGE(PG8_SB(0, 1), b2 + hstep, voffB);
            PG8_WAIT_V(6); PG8_BAR; PG8_MMA(1, 1, At, B1); PG8_BAR;
            PG8_LDB(B0, 1, 0); PG8_SCHED; PG8_LDA(At, 1, 0); PG8_STAGE(PG8_SA(0, 1), a2 + hstep, voffA);
            PG8_WAIT_L(8); PG8_BAR; PG8_WAIT_L(0); PG8_MMA(0, 0, At, B0); PG8_BAR; PG8_SCHED;
            PG8_LDB(B1, 1, 1); PG8_STAGE(PG8_SB(1, 0), b3, voffB);
            PG8_BAR; PG8_WAIT_L(0); PG8_MMA(0, 1, At, B1); PG8_BAR;
            PG8_LDA(At, 1, 1); PG8_STAGE(PG8_SA(1, 0), a3, voffA);
            PG8_BAR; PG8_WAIT_L(0); PG8_MMA(1, 0, At, B0); PG8_BAR; PG8_SCHED;
            PG8_STAGE(PG8_SB(1, 1), b3 + hstep, voffB);
            PG8_WAIT_V(6); PG8_BAR; PG8_MMA(1, 1, At, B1); PG8_BAR;
        }
        PG8_STAMP();
        if constexpr (!Epi::AFTER_DRAIN) { E(acc, cur, wr, wc, fr, fq); S.done(cur); }
        PG8_STAMP();
        if (!has_next) break;
#pragma unroll
        for (int a = 0; a < 2; ++a)
#pragma unroll
            for (int b = 0; b < 2; ++b)
#pragma unroll
                for (int m = 0; m < 4; ++m)
#pragma unroll
                    for (int n = 0; n < 2; ++n) acc[a][b][m][n] = (f32x4){0.f, 0.f, 0.f, 0.f};
        cur = nxt; cA = nA; cB = nB; ++ui;
    }
    PG8_WAIT_V(0);
    if (wr == 0) PG8_BAR;
    PG8_BAR;
    if constexpr (Epi::AFTER_DRAIN) { E.fused(acc, cur, wr, wc, fr, fq, lds, wid, lane); S.done(cur); }
    PG8_STAMP();
    if (STAMP && wid == 0) { stamps[lane] = lane < nts ? (((unsigned long long)(unsigned)ts_hi << 32) | (unsigned)ts_lo) : 0ull;
        if (lane == 62) stamps[62] = rt_entry; if (lane == 63) stamps[63] = (unsigned long long)wall_clock64(); }
#undef PG8_STAMP
#undef PG8_SA
#undef PG8_SB
#undef PG8_STAGE
#undef PG8_LDA
#undef PG8_LDB
#undef PG8_MMA
#undef PG8_WAIT_V
#undef PG8_WAIT_L
#undef PG8_BAR
#undef PG8_SCHED
}
}

struct EpiY8 {
  static constexpr bool PERM = true, AFTER_DRAIN = false;
  u16* O;
  DI void operator()(const pg8::f32x4 (&acc)[2][2][4][2], const pg8::Unit& u, int wr, int wc, int fr, int fq) const {
    const int row0 = u.pm * 256 + wr * 64 + fr, col0 = u.pn * 256 + wc * 32 + 8 * fq;
#pragma unroll
    for (int ai = 0; ai < 2; ++ai)
#pragma unroll
      for (int m = 0; m < 4; ++m) {
        u16* rowp = O + (size_t)(row0 + ai * 128 + m * 16) * KP1 + col0;
#pragma unroll
        for (int bj = 0; bj < 2; ++bj) {
          const pg8::f32x4 v0 = acc[ai][bj][m][0], v1 = acc[ai][bj][m][1];
          u32x4 w; w.x = pk2(v0[0], v0[1]); w.y = pk2(v0[2], v0[3]); w.z = pk2(v1[0], v1[1]); w.w = pk2(v1[2], v1[3]);
          *(u32x4*)(rowp + bj * 128) = w;
        }
      }
  }
};
struct EpiFfnUp8 {
  static constexpr bool PERM = true, AFTER_DRAIN = false;
  u16* H;
  DI void operator()(const pg8::f32x4 (&acc)[2][2][4][2], const pg8::Unit& u, int wr, int wc, int fr, int fq) const {
    const int row0 = u.pm * 256 + wr * 64 + fr, col0 = u.pn * 128 + wc * 32 + 8 * fq;
#pragma unroll
    for (int ai = 0; ai < 2; ++ai)
#pragma unroll
      for (int m = 0; m < 4; ++m) {
        float o[8];
#pragma unroll
        for (int n = 0; n < 2; ++n)
#pragma unroll
          for (int j = 0; j < 4; ++j) {
            const float g = acc[ai][0][m][n][j], up = acc[ai][1][m][n][j];
            o[n * 4 + j] = g * __builtin_amdgcn_rcpf(1.f + __builtin_amdgcn_exp2f(-1.4426950408889634f * g)) * up;
          }
        u32x4 w; w.x = pk2(o[0], o[1]); w.y = pk2(o[2], o[3]); w.z = pk2(o[4], o[5]); w.w = pk2(o[6], o[7]);
        *(u32x4*)(H + (size_t)(row0 + ai * 128 + m * 16) * KP2 + col0) = w;
      }
  }
};
struct EpiGate8 {
  static constexpr bool PERM = true, AFTER_DRAIN = false;
  unsigned char* G8;
  DI void operator()(const pg8::f32x4 (&acc)[2][2][4][2], const pg8::Unit& u, int wr, int wc, int fr, int fq) const {
    const int row0 = u.pm * 256 + wr * 64 + fr, col0 = u.pn * 256 + wc * 32 + 8 * fq;
#pragma unroll
    for (int ai = 0; ai < 2; ++ai)
#pragma unroll
      for (int m = 0; m < 4; ++m)
#pragma unroll
        for (int bj = 0; bj < 2; ++bj) {
          uint2 pk = {0u, 0u};
#pragma unroll
          for (int j = 0; j < 4; ++j) {
            const float a = __builtin_amdgcn_rcpf(1.f + __builtin_amdgcn_exp2f(-1.4426950408889634f * acc[ai][bj][m][0][j]));
            const float b = __builtin_amdgcn_rcpf(1.f + __builtin_amdgcn_exp2f(-1.4426950408889634f * acc[ai][bj][m][1][j]));
            pk.x |= (unsigned)(a * 255.f + 0.5f) << (8 * j);
            pk.y |= (unsigned)(b * 255.f + 0.5f) << (8 * j);
          }
          *(uint2*)(G8 + (size_t)(row0 + ai * 128 + m * 16) * GP + col0 + bj * 128) = pk;
        }
  }
};
struct EpiProj8 {
  static constexpr bool PERM = false, AFTER_DRAIN = false;
  const Params* Pp; int layer;
  static DI void rope32q(float (&b)[8], const float2* __restrict__ tab, int fq) {
#pragma unroll
    for (int j = 0; j < 4; ++j) {
      const float2 cs = tab[4 * fq + j];
      const float x1 = b[j], x2 = b[4 + j];
      b[j] = x1 * cs.x - x2 * cs.y;
      b[4 + j] = x2 * cs.x + x1 * cs.y;
    }
  }
  static DI void st8(u16* __restrict__ base, int ld, int col0, const float (&b)[8], int tok, int fq) {
#pragma unroll
    for (int n = 0; n < 2; ++n) {
      uint2 pk; pk.x = pk2(b[4 * n], b[4 * n + 1]); pk.y = pk2(b[4 * n + 2], b[4 * n + 3]);
      *(uint2*)(base + (size_t)tok * ld + col0 + 16 * n + 4 * fq) = pk;
    }
  }
  static DI void stT8(u16* __restrict__ base, int row0, const float (&b)[8], int tok, int fq) {
    const int tp = (tok & ~12) | ((tok & 4) << 1) | ((tok & 8) >> 1);
#pragma unroll
    for (int n = 0; n < 2; ++n)
#pragma unroll
      for (int j = 0; j < 4; ++j) {
        const int row = row0 + 16 * n + 4 * fq + j;
        base[(size_t)(row >> 6) * 64 * T + (size_t)(tp >> 7) * 8192 + (row & 63) * 128 + (tp & 127)] = f2bf(b[4 * n + j]);
      }
  }
  DI void operator()(const pg8::f32x4 (&acc)[2][2][4][2], const pg8::Unit& u, int wr, int wc, int fr, int fq_in) const {
    const Params& P = *Pp;
    char* ws = P.ws;
    u16* qkv = (u16*)(ws + OFF_QKV);
    const float2* R64 = (const float2*)(ws + OFF_R64);
    const float2* R32 = (const float2*)(ws + OFF_R32);
    float* SS = (float*)(ws + OFF_SS);
    const int fbase = u.pn * 256 + wc * 64;
    if (fbase >= 2496) return;
    float penorm = 0.f;
    float dnorm = 0.f;
#pragma unroll
    for (int ai = 0; ai < 2; ++ai)
#pragma unroll
      for (int m = 0; m < 4; ++m) {
        int fqv = fq_in; asm volatile("" : "+v"(fqv));
        const int fq = fqv;
        const int tok = u.pm * 256 + ai * 128 + wr * 64 + m * 16 + fr;
        const int pos = pos_of(tok);
        float b0[8], b1[8];
#pragma unroll
        for (int n = 0; n < 2; ++n)
#pragma unroll
          for (int j = 0; j < 4; ++j) { b0[4 * n + j] = acc[ai][0][m][n][j]; b1[4 * n + j] = acc[ai][1][m][n][j]; }
        if (fbase < 384) {
          const bool isK = fbase >= 256;
          const float* g = P.a_qk_norm + layer * 128 + (isK ? 64 : 0);
          float ss = 0.f;
#pragma unroll
          for (int k = 0; k < 8; ++k) ss += b0[k] * b0[k] + b1[k] * b1[k];
          ss += __shfl_xor(ss, 16);
          ss += __shfl_xor(ss, 32);
          const float rs = rsqrtf(ss * (1.f / 64.f) + EPS) * (isK ? 1.f : 0.125f * 1.4426950408889634f);
#pragma unroll
          for (int n = 0; n < 2; ++n)
#pragma unroll
            for (int j = 0; j < 4; ++j) {
              b0[4 * n + j] *= rs * g[16 * n + 4 * fq + j];
              b1[4 * n + j] *= rs * g[32 + 16 * n + 4 * fq + j];
            }
          rope32q(b0, R32 + (size_t)(pos >> 6) * 16, fq);
          rope32q(b1, R32 + (size_t)(pos & 63) * 16, fq);
          u16* dst = qkv + (isK ? Q_KA : Q_QA);
          const int ld = isK ? 128 : 256, c0 = isK ? fbase - 256 : fbase;
          st8(dst, ld, c0, b0, tok, fq);
          st8(dst, ld, c0 + 32, b1, tok, fq);
        } else if (fbase < 512) {
          stT8(qkv + Q_VTA, fbase - 384, b0, tok, fq);
          stT8(qkv + Q_VTA, fbase - 384 + 32, b1, tok, fq);
        } else if (fbase < 896) {
          const bool isK = fbase >= 768;
          const float2* tab = R64 + (size_t)pos * 32;
#pragma unroll
          for (int n = 0; n < 2; ++n)
#pragma unroll
            for (int j = 0; j < 4; ++j) {
              const float2 cs = tab[16 * n + 4 * fq + j];
              const float x1 = b0[4 * n + j], x2 = b1[4 * n + j];
              b0[4 * n + j] = x1 * cs.x - x2 * cs.y;
              b1[4 * n + j] = x2 * cs.x + x1 * cs.y;
            }
          u16* dst = qkv + (isK ? Q_KB : Q_QB);
          const int ld = isK ? 128 : 256, c0 = isK ? fbase - 768 : fbase - 512;
          st8(dst, ld, c0, b0, tok, fq);
          st8(dst, ld, c0 + 32, b1, tok, fq);
        } else if (fbase < 1024) {
          stT8(qkv + Q_VTB, fbase - 896, b0, tok, fq);
          stT8(qkv + Q_VTB, fbase - 896 + 32, b1, tok, fq);
        } else if (fbase < 1664) {
          const bool isKV = fbase >= 1408;
          u16* dst = qkv + (isKV ? Q_CKV : Q_CQ);
          const int ld = isKV ? 256 : 384, c0 = isKV ? fbase - 1408 : fbase - 1024;
          const int sb = (isKV ? 12 : 0) + (c0 >> 5);
          float s0 = 0.f, s1 = 0.f;
#pragma unroll
          for (int k = 0; k < 8; ++k) { s0 += b0[k] * b0[k]; s1 += b1[k] * b1[k]; }
          s0 += __shfl_xor(s0, 16); s0 += __shfl_xor(s0, 32);
          s1 += __shfl_xor(s1, 16); s1 += __shfl_xor(s1, 32);
          if (fq == 0) { SS[(size_t)tok * 20 + sb] = s0; SS[(size_t)tok * 20 + sb + 1] = s1; }
          st8(dst, ld, c0, b0, tok, fq);
          st8(dst, ld, c0 + 32, b1, tok, fq);
        } else if (fbase < 2176) {
          const bool isK = fbase >= 1920;
          u16* dst = qkv + (isK ? Q_KD : Q_QD);
          const int c0 = isK ? fbase - 1920 : fbase - 1664;
          rope32q(b0, R32 + (size_t)pos * 16, fq);
          rope32q(b1, R32 + (size_t)pos * 16, fq);
          float s0 = 0.f, s1 = 0.f;
#pragma unroll
          for (int k = 0; k < 8; ++k) { s0 += b0[k] * b0[k]; s1 += b1[k] * b1[k]; }
          dnorm = fmaxf(dnorm, fmaxf(s0, s1));
          if (!isK) {
#pragma unroll
            for (int k = 0; k < 8; ++k) { b0[k] *= 0.17677669529663687f * 1.4426950408889634f; b1[k] *= 0.17677669529663687f * 1.4426950408889634f; }
          }
          st8(dst, 256, c0, b0, tok, fq);
          st8(dst, 256, c0 + 32, b1, tok, fq);
        } else if (fbase < 2432) {
          stT8(qkv + Q_VTD, fbase - 2176, b0, tok, fq);
          stT8(qkv + Q_VTD, fbase - 2176 + 32, b1, tok, fq);
        } else {
          rope32q(b0, R32 + (size_t)pos * 16, fq);
          { float s0 = 0.f;
#pragma unroll
            for (int k = 0; k < 8; ++k) s0 += b0[k] * b0[k];
            penorm = fmaxf(penorm, s0); }
#pragma unroll
          for (int hd = 0; hd < 4; ++hd) st8(qkv + Q_KC, 384, hd * 96 + 64, b0, tok, fq);
        }
        __builtin_amdgcn_sched_barrier(0);
      }
    if (fbase == 2432) {
      float v = penorm * 4.f;
#pragma unroll
      for (int mk = 32; mk >= 1; mk >>= 1) v = fmaxf(v, __shfl_xor(v, mk));
      if ((opaque_tid() & 63) == 0) atomicMax((unsigned*)(ws + OFF_BAR) + 144 + layer * 4 + 2, __float_as_uint(v));
    }
    if (fbase >= 1664 && fbase < 2176) {
      float v = dnorm * 4.f;
#pragma unroll
      for (int mk = 32; mk >= 1; mk >>= 1) v = fmaxf(v, __shfl_xor(v, mk));
      if ((opaque_tid() & 63) == 0) atomicMax((unsigned*)(ws + OFF_BAR) + 128 + layer * 2 + (fbase >= 1920 ? 1 : 0), __float_as_uint(v));
    }
  }
};
struct SimpleOrder {
  int nN, nwg, G, c;
  DI bool next(int i, pg8::Unit& u) const {
    const int L = i * G + c;
    if (L >= nwg) return false;
    const int rest = L >> 4;
    u.pn = rest % nN;
    u.pm = (rest / nN) * 16 + (L & 15);
    return true;
  }
  DI void a_ready(const pg8::Unit&) const {}
  DI void done(const pg8::Unit&) const {}
};
template <int N, int K, int LD, class Epi>
DI void gemm8_phase(const u16* X, const u16* Wt, const Epi& E, char* smem) {
  pg8::Gemm g; g.A = X; g.Bt = Wt; g.M = T; g.N = N; g.K = K; g.ld = LD;
  int bid_ = (int)blockIdx.x;
  if (gridDim.x == 256) {
    const int xcd = bid_ & 7, j = bid_ >> 3;
    bid_ = (((xcd >> 2) * 8 + (j >> 2)) << 4) | ((xcd & 3) * 4 + (j & 3));
  }
  asm volatile("" : "+s"(bid_));
  SimpleOrder S; S.nN = N / 256; S.nwg = (T / 256) * (N / 256); S.G = (int)gridDim.x; S.c = bid_;
  pg8::gemm_phase<Epi, SimpleOrder, false, K, LD>((PG8_LAS unsigned char*)smem, g, S, E, nullptr);
}

template <int DQK, int NCOMP, bool BAND, int EPI, bool NOMAX = false, bool GQA2 = false>
DI void attn_item(const u16* __restrict__ Q, int ldq, const u16* __restrict__ Kp, int ldk, const u16* __restrict__ Vt,
                  int qtok0, int kbeg, int kend, float sc_l2, float sink_l2, float lam, float onorm,
                  const float* __restrict__ subg, u16* __restrict__ O, float* __restrict__ DS, char* smem) {
  constexpr int DC = DQK / NCOMP;
  constexpr int KS = DC / 16;
  constexpr int KEYS = (NCOMP == 1) ? 128 : 64;
  constexpr int KSTR = DQK + 8, VSTR = KEYS + 8;
  constexpr int KCH = DQK / 8, VCH = KEYS / 8;
  constexpr int NKC = KEYS * KCH / NTHR, NVC = 64 * VCH / NTHR;
  constexpr int KSLOT = KEYS * KSTR, VSLOT = 64 * VSTR;
  u16* sK = (u16*)smem;
  u16* sV = sK + 3 * KSLOT;
  const int tid = opaque_tid(), lane = tid & 63, wave = tid >> 6, r = lane & 31, h = lane >> 5;
  const int qtok = qtok0 + (GQA2 ? (wave & 3) : wave) * 32 + r;
  if constexpr (GQA2) { Q += (wave >> 2) * 64; O += (wave >> 2) * 64; }

  bf16x8 qf[NCOMP][KS];
#pragma unroll
  for (int c = 0; c < NCOMP; ++c)
#pragma unroll
    for (int ks = 0; ks < KS; ++ks) qf[c][ks] = *(const bf16x8*)(Q + (size_t)qtok * ldq + c * DC + ks * 16 + 8 * h);

  f32x16 Oa[NCOMP][2];
  float m[NCOMP], l[NCOMP];
#pragma unroll
  for (int c = 0; c < NCOMP; ++c) {
#pragma unroll
    for (int d = 0; d < 2; ++d)
#pragma unroll
      for (int v = 0; v < 16; ++v) Oa[c][d][v] = 0.f;
    m[c] = BAND ? sink_l2 : -1e30f;
    l[c] = (BAND && h == 0) ? 1.f : 0.f;
  }

  const u16* kg[NKC]; int kso[NKC];
#pragma unroll
  for (int i = 0; i < NKC; ++i) {
    const int c = tid + i * NTHR;
    const int row = c / KCH, cc = c % KCH;
    kg[i] = Kp + (size_t)(kbeg + row) * ldk + cc * 8;
    kso[i] = row * KSTR + cc * 8;
  }
  const u16* vg[NVC]; int vso[NVC];
#pragma unroll
  for (int i = 0; i < NVC; ++i) {
    const int c = tid + i * NTHR;
    const int row = c / VCH, cc = c % VCH;
    vg[i] = Vt + (size_t)(kbeg >> 7) * 8192 + row * 128 + cc * 8;
    vso[i] = row * VSTR + cc * 8;
  }
  u32x4 kreg[NKC], vreg[NVC];
  auto loadK = [&](int t) {
#pragma unroll
    for (int i = 0; i < NKC; ++i) kreg[i] = gld16(kg[i] + (size_t)t * KEYS * ldk);
  };
  auto loadV = [&](int t) {
#pragma unroll
    for (int i = 0; i < NVC; ++i) vreg[i] = gld16(vg[i] + (size_t)t * 8192);
  };
  auto waitK = [&]() {
    if constexpr (NKC == 1) wait_vm0(kreg[0]);
    else if constexpr (NKC == 2) wait_vm0(kreg[0], kreg[1]);
    else wait_vm0(kreg[0], kreg[1], kreg[2]);
  };
  auto waitV = [&]() {
    if constexpr (NVC == 1) wait_vm0(vreg[0]);
    else wait_vm0(vreg[0], vreg[1]);
  };
  auto storeK = [&](int slot) {
#pragma unroll
    for (int i = 0; i < NKC; ++i) *(u32x4*)(sK + slot * KSLOT + kso[i]) = kreg[i];
  };
  auto storeV = [&](int slot) {
#pragma unroll
    for (int i = 0; i < NVC; ++i) *(u32x4*)(sV + slot * VSLOT + vso[i]) = vreg[i];
  };

  f32x16 S0[2], S1[2];
  bf16x8 pfA[2][2], pfB[2][2];
  float alpha_pend = 1.f;
  bool need_pend = false;

  auto att_S = [&](auto uu_t, f32x16 (&S)[2], int slot) {
    constexpr int UU = decltype(uu_t)::value;
    constexpr int C = (NCOMP == 2) ? UU : 0;
    const u16* base = sK + slot * KSLOT + ((NCOMP == 1 ? UU * 64 : 0) + r) * KSTR + (NCOMP == 2 ? UU * DC : 0) + 8 * h;
#pragma unroll
    for (int kb = 0; kb < 2; ++kb) {
#pragma unroll
      for (int v = 0; v < 16; ++v) S[kb][v] = 0.f;
#pragma unroll
      for (int ks = 0; ks < KS; ++ks) {
        bf16x8 kf = *(const bf16x8*)(base + kb * 32 * KSTR + ks * 16);
        S[kb] = MFMA32(kf, qf[C][ks], S[kb]);
      }
    }
  };
  auto att_PV = [&](auto uu_t, const bf16x8 (&pf)[2][2], int slot) {
    constexpr int UU = decltype(uu_t)::value;
    constexpr int C = (NCOMP == 2) ? UU : 0;
    const u16* base = sV + slot * VSLOT + r * VSTR + (NCOMP == 1 ? UU * 64 : 0) + 8 * h;
#pragma unroll
    for (int d = 0; d < 2; ++d)
#pragma unroll
      for (int kb = 0; kb < 2; ++kb)
#pragma unroll
        for (int s = 0; s < 2; ++s) {
          bf16x8 vf = *(const bf16x8*)(base + d * 32 * VSTR + kb * 32 + 16 * s);
          Oa[C][d] = MFMA32(vf, pf[kb][s], Oa[C][d]);
        }
  };
  auto att_rescale = [&](auto uu_t) {
    constexpr int UU = decltype(uu_t)::value;
    constexpr int C = (NCOMP == 2) ? UU : 0;
    if (need_pend) {
#pragma unroll
      for (int d = 0; d < 2; ++d)
#pragma unroll
        for (int v = 0; v < 16; ++v) Oa[C][d][v] *= alpha_pend;
    }
  };
  auto att_softmax = [&](auto uu_t, f32x16 (&S)[2], bf16x8 (&pf)[2][2], int kpos0) {
    constexpr int UU = decltype(uu_t)::value;
    constexpr int C = (NCOMP == 2) ? UU : 0;
    if constexpr (BAND) {
#pragma unroll
      for (int kb = 0; kb < 2; ++kb)
#pragma unroll
        for (int v = 0; v < 16; ++v) {
          const int d = kpos0 + kb * 32 + crow(v, h) - qtok;
          if (d > 128 || d < -128) S[kb][v] = -1e30f;
        }
    }
    if constexpr (NOMAX) {
      float rsum = 0.f;
#pragma unroll
      for (int kb = 0; kb < 2; ++kb)
#pragma unroll
        for (int v = 0; v < 16; ++v) {
          float p = __builtin_amdgcn_exp2f(S[kb][v]);
          S[kb][v] = p;
          rsum += p;
        }
      l[C] += rsum;
      need_pend = false;
#pragma unroll
      for (int kb = 0; kb < 2; ++kb)
#pragma unroll
        for (int s = 0; s < 2; ++s) {
          u32x4 pk;
          pk.x = pk2(S[kb][8 * s + 0], S[kb][8 * s + 1]);
          pk.y = pk2(S[kb][8 * s + 2], S[kb][8 * s + 3]);
          pk.z = pk2(S[kb][8 * s + 4], S[kb][8 * s + 5]);
          pk.w = pk2(S[kb][8 * s + 6], S[kb][8 * s + 7]);
          pf[kb][s] = __builtin_bit_cast(bf16x8, pk);
        }
      return;
    }
    float mx = S[0][0];
#pragma unroll
    for (int kb = 0; kb < 2; ++kb)
#pragma unroll
      for (int v = 0; v < 16; ++v) mx = fmaxf(mx, S[kb][v]);
    {
      const unsigned mu = __float_as_uint(mx);
      const auto sw = __builtin_amdgcn_permlane32_swap(mu, mu, false, false);
      mx = fmaxf(__uint_as_float(sw[0]), __uint_as_float(sw[1]));
    }
    const float mold = m[C];
    const float mcand = fmaxf(mold, mx * sc_l2);
    const bool grow = __builtin_amdgcn_ballot_w64(mcand > mold + 6.0f) != 0;
    const float mnew = grow ? mcand : mold;
    need_pend = grow;
    alpha_pend = __builtin_amdgcn_exp2f(mold - mnew);
    m[C] = mnew;
    float rsum = 0.f;
#pragma unroll
    for (int kb = 0; kb < 2; ++kb)
#pragma unroll
      for (int v = 0; v < 16; ++v) {
        float p = __builtin_amdgcn_exp2f(__builtin_fmaf(S[kb][v], sc_l2, -mnew));
        S[kb][v] = p;
        rsum += p;
      }
    l[C] = l[C] * alpha_pend + rsum;
#pragma unroll
    for (int kb = 0; kb < 2; ++kb)
#pragma unroll
      for (int s = 0; s < 2; ++s) {
        u32x4 pk;
        pk.x = pk2(S[kb][8 * s + 0], S[kb][8 * s + 1]);
        pk.y = pk2(S[kb][8 * s + 2], S[kb][8 * s + 3]);
        pk.z = pk2(S[kb][8 * s + 4], S[kb][8 * s + 5]);
        pk.w = pk2(S[kb][8 * s + 6], S[kb][8 * s + 7]);
        pf[kb][s] = __builtin_bit_cast(bf16x8, pk);
      }
  };
  using U0 = std::integral_constant<int, 0>;
  using U1 = std::integral_constant<int, 1>;

  const int ntl = (kend - kbeg) / KEYS;
  auto step = [&](auto first_t, auto lk_t, auto lv_t, int t, int sa, int sb, int sc) {
    constexpr bool FIRST = decltype(first_t)::value, LK = decltype(lk_t)::value, LV = decltype(lv_t)::value;
    if constexpr (LK) loadK(t + 2);
    if constexpr (LV) loadV(t + 1);
    if constexpr (!FIRST) att_rescale(U1{});
    att_S(U1{}, S1, sa);
    if constexpr (!FIRST) att_PV(U1{}, pfB, sc);
    att_softmax(U0{}, S0, pfA, kbeg + t * KEYS);
    att_rescale(U0{});
    if constexpr (LV) att_S(U0{}, S0, sb);
    att_PV(U0{}, pfA, sa);
    att_softmax(U1{}, S1, pfB, kbeg + t * KEYS + 64);
    if constexpr (LK) { waitK(); storeK(sc); }
    if constexpr (LV) { waitV(); storeV(sb); }
    __syncthreads();
  };
  using TT = std::true_type;
  using FF = std::false_type;

  loadK(0); loadV(0);
  waitK(); waitV();
  storeK(0); storeV(0);
  loadK(1);
  waitK();
  storeK(1);
  __syncthreads();
  att_S(U0{}, S0, 0);
  int sa = 0, sb = 1, sc = 2;
  step(TT{}, TT{}, TT{}, 0, sa, sb, sc);
  { int tmp = sa; sa = sb; sb = sc; sc = tmp; }
  for (int t = 1; t < ntl - 2; ++t) {
    step(FF{}, TT{}, TT{}, t, sa, sb, sc);
    int tmp = sa; sa = sb; sb = sc; sc = tmp;
  }
  step(FF{}, FF{}, TT{}, ntl - 2, sa, sb, sc);
  { int tmp = sa; sa = sb; sb = sc; sc = tmp; }
  step(FF{}, FF{}, FF{}, ntl - 1, sa, sb, sc);
  att_rescale(U1{});
  att_PV(U1{}, pfB, sa);

  float inv[NCOMP];
#pragma unroll
  for (int c = 0; c < NCOMP; ++c) {
    float lt = l[c] + __shfl_xor(l[c], 32);
    inv[c] = 1.f / lt;
  }
  if constexpr (EPI == 1) {
#pragma unroll
    for (int d = 0; d < 2; ++d)
#pragma unroll
      for (int vq = 0; vq < 4; ++vq) {
        float4 o = {Oa[0][d][4 * vq] * inv[0], Oa[0][d][4 * vq + 1] * inv[0], Oa[0][d][4 * vq + 2] * inv[0], Oa[0][d][4 * vq + 3] * inv[0]};
        *(float4*)(DS + (size_t)qtok * 256 + d * 32 + 8 * vq + 4 * h) = o;
      }
  } else {
    if constexpr (EPI == 2) {
      float ss = 0.f;
#pragma unroll
      for (int d = 0; d < 2; ++d)
#pragma unroll
        for (int vq = 0; vq < 4; ++vq) {
          const float4 o1 = *(const float4*)(DS + (size_t)qtok * 256 + d * 32 + 8 * vq + 4 * h);
          const float a0 = o1.x - lam * Oa[0][d][4 * vq] * inv[0];
          const float a1 = o1.y - lam * Oa[0][d][4 * vq + 1] * inv[0];
          const float a2 = o1.z - lam * Oa[0][d][4 * vq + 2] * inv[0];
          const float a3 = o1.w - lam * Oa[0][d][4 * vq + 3] * inv[0];
          Oa[0][d][4 * vq] = a0; Oa[0][d][4 * vq + 1] = a1; Oa[0][d][4 * vq + 2] = a2; Oa[0][d][4 * vq + 3] = a3;
          ss += a0 * a0 + a1 * a1 + a2 * a2 + a3 * a3;
        }
      ss += __shfl_xor(ss, 32);
      const float rs = rsqrtf(ss * (1.f / 64.f) + EPS) * onorm;
#pragma unroll
      for (int d = 0; d < 2; ++d)
#pragma unroll
        for (int v = 0; v < 16; ++v) Oa[0][d][v] *= rs * subg[d * 32 + crow(v, h)];
    } else {
#pragma unroll
      for (int d = 0; d < 2; ++d)
#pragma unroll
        for (int v = 0; v < 16; ++v) Oa[0][d][v] *= inv[0];
    }
    store_rows(O, KP1, 0, Oa[0][0], qtok, h);
    store_rows(O, KP1, 32, Oa[0][1], qtok, h);
  }
  __syncthreads();
}

DI void attn_phase(const Params& P, int layer, char* smem) {
  char* ws = P.ws;
  u16* qkv = (u16*)(ws + OFF_QKV);
  u16* BR = (u16*)(ws + OFF_XN);
  const float L2E = 1.4426950408889634f;
  const float lambda_init = 0.8f - 0.6f * __expf(-0.3f * (float)layer);
  float lam;
  {
    const float* dl = P.d_lambda + layer * 128;
    float s1 = 0.f, s2 = 0.f;
    for (int i = 0; i < 32; ++i) { s1 += dl[i] * dl[32 + i]; s2 += dl[64 + i] * dl[96 + i]; }
    lam = __expf(s1) - __expf(s2) + lambda_init;
    lam = __int_as_float(__builtin_amdgcn_readfirstlane(__float_as_int(lam)));
  }
  const float onorm_u = __int_as_float(__builtin_amdgcn_readfirstlane(__float_as_int(1.f - lambda_init)));
  bool a_nomax;
  {
    const float* ag = P.a_qk_norm + layer * 128;
    float gq = 0.f, gk = 0.f;
    for (int i = 0; i < 64; ++i) { gq = fmaxf(gq, fabsf(ag[i])); gk = fmaxf(gk, fabsf(ag[64 + i])); }
    const float bound = 64.f * gq * gk * (0.125f * L2E);
    a_nomax = __builtin_amdgcn_readfirstlane((int)(bound < 60.f)) != 0;
  }
  bool c_nomax;
  {
    const unsigned* nb = (const unsigned*)(ws + OFF_BAR) + 144 + layer * 4;
    const float qb = __uint_as_float(__hip_atomic_load(nb, __ATOMIC_RELAXED, __HIP_MEMORY_SCOPE_AGENT));
    const float kb = __uint_as_float(__hip_atomic_load(nb + 1, __ATOMIC_RELAXED, __HIP_MEMORY_SCOPE_AGENT));
    const float pe = __uint_as_float(__hip_atomic_load(nb + 2, __ATOMIC_RELAXED, __HIP_MEMORY_SCOPE_AGENT));
    const float bound = sqrtf(3.f * qb * (2.f * kb + pe)) * (0.10206207261596577f * L2E);
    c_nomax = __builtin_amdgcn_readfirstlane((int)(bound < 60.f)) != 0;
  }
  bool d_nomax;
  {
    const unsigned* nb = (const unsigned*)(ws + OFF_BAR) + 128 + layer * 2;
    const float q2 = __uint_as_float(__hip_atomic_load(nb, __ATOMIC_RELAXED, __HIP_MEMORY_SCOPE_AGENT));
    const float k2 = __uint_as_float(__hip_atomic_load(nb + 1, __ATOMIC_RELAXED, __HIP_MEMORY_SCOPE_AGENT));
    const float bound = sqrtf(q2 * k2) * (0.17677669529663687f * L2E);
    d_nomax = __builtin_amdgcn_readfirstlane((int)(bound < 60.f)) != 0;
  }
  for (int it = blockIdx.x; it < 2048; it += gridDim.x) {
    const int cls = it >> 8;
    if (cls < 6) {
      const int idx = it & 255;
      const int head = (idx & 7) >> 1;
      const int qb = ((idx >> 3) << 1) + (idx & 1);
      int qtok0, kbeg, kend;
      if (cls < 3) { qtok0 = qb * 256; kbeg = 0; kend = SEQ0; }
      else { const int s = qb >> 3; kbeg = SEQ0 + s * DSEQ; kend = kbeg + DSEQ; qtok0 = kbeg + (qb & 7) * 256; }
      const int typ = cls % 3;
      if (typ == 0) {
        float* DS = (float*)(ws + OFF_DS) + head * 64;
        if (d_nomax) {
          attn_item<32, 1, false, 1, true>(qkv + Q_QD + head * 64, 256, qkv + Q_KD + head * 64, 256,
                                           qkv + Q_VTD + (size_t)head * 64 * T, qtok0, kbeg, kend,
                                           1.f, 0.f, lam, onorm_u, P.d_subln + layer * 64, BR + 768 + head * 64, DS, smem);
          attn_item<32, 1, false, 2, true>(qkv + Q_QD + head * 64 + 32, 256, qkv + Q_KD + head * 64 + 32, 256,
                                           qkv + Q_VTD + (size_t)head * 64 * T, qtok0, kbeg, kend,
                                           1.f, 0.f, lam, onorm_u, P.d_subln + layer * 64, BR + 768 + head * 64, DS, smem);
        } else {
          attn_item<32, 1, false, 1, false>(qkv + Q_QD + head * 64, 256, qkv + Q_KD + head * 64, 256,
                                            qkv + Q_VTD + (size_t)head * 64 * T, qtok0, kbeg, kend,
                                            1.f, 0.f, lam, onorm_u, P.d_subln + layer * 64, BR + 768 + head * 64, DS, smem);
          attn_item<32, 1, false, 2, false>(qkv + Q_QD + head * 64 + 32, 256, qkv + Q_KD + head * 64 + 32, 256,
                                            qkv + Q_VTD + (size_t)head * 64 * T, qtok0, kbeg, kend,
                                            1.f, 0.f, lam, onorm_u, P.d_subln + layer * 64, BR + 768 + head * 64, DS, smem);
        }
      } else if (typ == 1) {
        if (c_nomax)
          attn_item<96, 1, false, 0, true>(qkv + Q_QC + head * 96, 384, qkv + Q_KC + head * 96, 384,
                                           qkv + Q_VTC + (size_t)head * 64 * T, qtok0, kbeg, kend,
                                           1.f, 0.f, 0.f, 1.f, nullptr, BR + 512 + head * 64, nullptr, smem);
        else
          attn_item<96, 1, false, 0, false>(qkv + Q_QC + head * 96, 384, qkv + Q_KC + head * 96, 384,
                                            qkv + Q_VTC + (size_t)head * 64 * T, qtok0, kbeg, kend,
                                            1.f, 0.f, 0.f, 1.f, nullptr, BR + 512 + head * 64, nullptr, smem);
      } else {
        if (a_nomax) {
          const int kvh = (idx & 7) >> 2;
          const int qb128 = ((idx >> 3) << 2) + (idx & 3);
          int q0 = qb128 * 128, kb0 = kbeg, ke0 = kend;
          if (cls >= 3) { const int s2 = qb128 >> 4; kb0 = SEQ0 + s2 * DSEQ; ke0 = kb0 + DSEQ; q0 = kb0 + (qb128 & 15) * 128; }
          attn_item<64, 1, false, 0, true, true>(qkv + Q_QA + kvh * 128, 256, qkv + Q_KA + kvh * 64, 128,
                                                 qkv + Q_VTA + (size_t)kvh * 64 * T, q0, kb0, ke0,
                                                 1.f, 0.f, 0.f, 1.f, nullptr, BR + kvh * 128, nullptr, smem);
        } else
          attn_item<64, 1, false, 0, false>(qkv + Q_QA + head * 64, 256, qkv + Q_KA + (head >> 1) * 64, 128,
                                            qkv + Q_VTA + (size_t)(head >> 1) * 64 * T, qtok0, kbeg, kend,
                                            1.f, 0.f, 0.f, 1.f, nullptr, BR + head * 64, nullptr, smem);
      }
    } else {
      const int idx = it - 1536;
      const int head = (idx & 7) >> 1;
      const int qbg = ((idx >> 3) << 1) + (idx & 1);
      const int qtok0 = qbg * 256;
      int sb, se;
      if (qtok0 < SEQ0) { sb = 0; se = SEQ0; }
      else { sb = SEQ0 + ((qtok0 - SEQ0) / DSEQ) * DSEQ; se = sb + DSEQ; }
      const int kbeg = max(sb, qtok0 - 128), kend = min(se, qtok0 + 256 + 128);
      const float sink = P.b_sink[layer * 4 + head];
      attn_item<64, 1, true, 0>(qkv + Q_QB + head * 64, 256, qkv + Q_KB + (head >> 1) * 64, 128,
                                    qkv + Q_VTB + (size_t)(head >> 1) * 64 * T, qtok0, kbeg, kend,
                                    0.125f * L2E, sink * L2E, 0.f, 1.f, nullptr, BR + 256 + head * 64, nullptr, smem);
    }
  }
}

DI void ew_phase(const Params& P, const u16* __restrict__ Y, float coef, const float* __restrict__ gpost,
                 const float* __restrict__ gnext, bool from_inputs) {
  const int tid = opaque_tid();
  const int lane = tid & 63, wave = tid >> 6;
  u16* XN = (u16*)(P.ws + OFF_XN);
  u16* XB = (u16*)(P.ws + OFF_XB);
  for (int tok = blockIdx.x * 8 + wave; tok < T; tok += gridDim.x * 8) {
    float4 x[4];
    if (from_inputs) {
      const float* xs = tok < SEQ0 ? P.x_prompt + (size_t)tok * DM : P.x_sample + (size_t)(tok - SEQ0) * DM;
#pragma unroll
      for (int i = 0; i < 4; ++i) x[i] = *(const float4*)(xs + (i * 64 + lane) * 4);
    } else {
#pragma unroll
      for (int i = 0; i < 4; ++i) {
        const uint2 xb = *(const uint2*)(XB + (size_t)tok * DM + (i * 64 + lane) * 4);
        x[i] = make_float4(bf2f(xb.x & 0xffffu), bf2f(xb.x >> 16), bf2f(xb.y & 0xffffu), bf2f(xb.y >> 16));
      }
    }
    if (Y) {
      float4 y[4];
      float ss = 0.f;
#pragma unroll
      for (int i = 0; i < 4; ++i) {
        const uint2 yb = *(const uint2*)(Y + (size_t)tok * KP1 + (i * 64 + lane) * 4);
        y[i] = make_float4(bf2f(yb.x & 0xffffu), bf2f(yb.x >> 16), bf2f(yb.y & 0xffffu), bf2f(yb.y >> 16));
        ss += y[i].x * y[i].x + y[i].y * y[i].y + y[i].z * y[i].z + y[i].w * y[i].w;
      }
      ss = wave_sum(ss);
      const float rs = rsqrtf(ss * (1.f / 1024.f) + EPS) * coef;
#pragma unroll
      for (int i = 0; i < 4; ++i) {
        float4 g = *(const float4*)(gpost + (i * 64 + lane) * 4);
        x[i].x += y[i].x * rs * g.x; x[i].y += y[i].y * rs * g.y;
        x[i].z += y[i].z * rs * g.z; x[i].w += y[i].w * rs * g.w;
      }
    }
    if (!gnext) {
#pragma unroll
      for (int i = 0; i < 4; ++i) *(float4*)(P.out + (size_t)tok * DM + (i * 64 + lane) * 4) = x[i];
    } else {
#pragma unroll
      for (int i = 0; i < 4; ++i) {
        uint2 pk;
        pk.x = pk2(x[i].x, x[i].y);
        pk.y = pk2(x[i].z, x[i].w);
        *(uint2*)(XB + (size_t)tok * DM + (i * 64 + lane) * 4) = pk;
      }
    }
    if (gnext) {
      float ss = 0.f;
#pragma unroll
      for (int i = 0; i < 4; ++i) ss += x[i].x * x[i].x + x[i].y * x[i].y + x[i].z * x[i].z + x[i].w * x[i].w;
      ss = wave_sum(ss);
      const float rs = rsqrtf(ss * (1.f / 1024.f) + EPS);
#pragma unroll
      for (int i = 0; i < 4; ++i) {
        float4 g = *(const float4*)(gnext + (i * 64 + lane) * 4);
        uint2 pk;
        pk.x = pk2(x[i].x * rs * g.x, x[i].y * rs * g.y);
        pk.y = pk2(x[i].z * rs * g.z, x[i].w * rs * g.w);
        *(uint2*)(XN + (size_t)tok * KP1 + (i * 64 + lane) * 4) = pk;
      }
    }
  }
}

DI int colmap(int mode, int n, int nsrc) {
  if (mode == 1) { return ((n >> 7) & 1) * DFF + (n >> 8) * 128 + (n & 127); }
  if (mode == 2) {
    if (n < 2560) {
      const int w = n & 255;
      n = (n & ~255) + ((w >> 5) & 3) * 64 + (w >> 7) * 32 + (w & 31);
    }
    if (n < 1664) return n;
    if (n < 2432) return n + 32;
    if (n < 2464) return n - 2432 + 1664;
    if (n < 2560) return -1;
    return n - 96;
  }
  return n < nsrc ? n : -1;
}
DI void conv_job(u16* __restrict__ dst, int ldd, const float* __restrict__ src, int Nd, int K, int lds, int mode,
                 const float* __restrict__ kscale) {
  const int total = Nd * (K >> 3);
  const int gthreads = gridDim.x * NTHR;
  for (int idx = blockIdx.x * NTHR + opaque_tid(); idx < total; idx += gthreads) {
    const int n = idx % Nd, k8 = idx / Nd;
    const int col = colmap(mode, n, lds);
    float v[8];
#pragma unroll
    for (int j = 0; j < 8; ++j) {
      float x = 0.f;
      if (col >= 0) {
        x = src[(size_t)(k8 * 8 + j) * lds + col];
        if (kscale) x *= kscale[k8 * 8 + j];
      }
      v[j] = x;
    }
    uint4 pk = {pk2(v[0], v[1]), pk2(v[2], v[3]), pk2(v[4], v[5]), pk2(v[6], v[7])};
    *(uint4*)(dst + (size_t)n * ldd + k8 * 8) = pk;
  }
}
DI void convert_layer(const Params& P, int l) {
  u16* W = (u16*)(P.ws + OFF_W);
  for (int s = 0; s < 2; ++s) {
    conv_job(W + W_WI + (size_t)s * 5632 * KP1, KP1, P.ffn_wi + ((size_t)l * 2 + s) * 1024 * 5632, 5632, 1024, 5632, 1, nullptr);
    conv_job(W + W_WO + (size_t)s * 1024 * KP2, KP2, P.ffn_wo + ((size_t)l * 2 + s) * 2816 * 1024, 1024, 2816, 1024, 0, nullptr);
  }
  conv_job(W + W_WIN, KP1, P.w_in + (size_t)l * 1024 * NPROJ, 6656, 1024, NPROJ, 2, nullptr);
  conv_job(W + W_WUQ, 384, P.c_w_uq + (size_t)l * 384 * 384, 512, 384, 384, 0, P.c_q_norm + l * 384);
  conv_job(W + W_WUKV, 256, P.c_w_ukv + (size_t)l * 256 * 512, 512, 256, 512, 0, P.c_kv_norm + l * 256);
  conv_job(W + W_WB, KP1, P.w_branch + (size_t)l * 1024 * 1024, 1024, 1024, 1024, 0, nullptr);
  conv_job(W + W_WOUT, KP1, P.w_out + (size_t)l * 1024 * 1024, 1024, 1024, 1024, 0, nullptr);
}
DI void rope_tables(const Params& P) {
  float2* R64 = (float2*)(P.ws + OFF_R64);
  float2* R32 = (float2*)(P.ws + OFF_R32);
  const int gthreads = gridDim.x * NTHR;
  for (int idx = blockIdx.x * NTHR + opaque_tid(); idx < 16384 * 48; idx += gthreads) {
    int pos, f; double base; float2* dst;
    if (idx < 16384 * 32) { pos = idx >> 5; f = idx & 31; base = 0.7498942093324559; dst = R64 + idx; }
    else { const int i2 = idx - 16384 * 32; pos = i2 >> 4; f = i2 & 15; base = 0.5623413251903491; dst = R32 + i2; }
    double inv = 1.0;
    for (int k = 0; k < f; ++k) inv *= base;
    const float ang = (float)pos * (float)inv;
    double tr = (double)ang * 0.15915494309189535;
    tr -= rint(tr);
    const float tf = (float)tr;
    *dst = make_float2(__builtin_amdgcn_cosf(tf), __builtin_amdgcn_sinf(tf));
  }
}

DI void fast_grid_barrier(unsigned* bar, unsigned nblk) {
  asm volatile("s_waitcnt vmcnt(0) lgkmcnt(0)" ::: "memory");
  __syncthreads();
  if (threadIdx.x == 0) {
    __builtin_amdgcn_fence(__ATOMIC_RELEASE, "agent");
    asm volatile("s_waitcnt vmcnt(0) lgkmcnt(0)" ::: "memory");
    const unsigned gen = __hip_atomic_load(&bar[64], __ATOMIC_RELAXED, __HIP_MEMORY_SCOPE_AGENT);
    const unsigned old = __hip_atomic_fetch_add(&bar[0], 1u, __ATOMIC_RELAXED, __HIP_MEMORY_SCOPE_AGENT);
    if (old == nblk - 1u) {
      __hip_atomic_store(&bar[0], 0u, __ATOMIC_RELAXED, __HIP_MEMORY_SCOPE_AGENT);
      __hip_atomic_fetch_add(&bar[64], 1u, __ATOMIC_RELEASE, __HIP_MEMORY_SCOPE_AGENT);
    } else {
      while (__hip_atomic_load(&bar[64], __ATOMIC_RELAXED, __HIP_MEMORY_SCOPE_AGENT) == gen) __builtin_amdgcn_s_sleep(1);
    }
    __builtin_amdgcn_fence(__ATOMIC_ACQUIRE, "agent");
    asm volatile("s_waitcnt vmcnt(0) lgkmcnt(0)" ::: "memory");
  }
  __syncthreads();
}

__global__ void __launch_bounds__(NTHR) __attribute__((amdgpu_waves_per_eu(2, 2))) mega(Params P) {
  extern __shared__ __attribute__((aligned(16))) char smem[];
  cg::grid_group grid = cg::this_grid();
  int phase = 0;
#if MULTI_LAUNCH
#define ACTIVE() (phase >= P.phase_lo && phase < P.phase_hi)
#define SEAM() do { ++phase; } while (0)
#else
#define ACTIVE() (true)
#define SEAM() do { ++phase; if (phase == 1) grid.sync(); else fast_grid_barrier((unsigned*)(P.ws + OFF_BAR), gridDim.x); } while (0)
#endif
  u16* W = (u16*)(P.ws + OFF_W);
  u16* XN = (u16*)(P.ws + OFF_XN);
  u16* R2 = (u16*)(P.ws + OFF_R2);
  u16* qkv = (u16*)(P.ws + OFF_QKV);
  const u16* Y = qkv + Q_Y;
#define PTRS

  if (ACTIVE()) { PTRS
    rope_tables(P);
    convert_layer(P, 0);
    ew_phase(P, nullptr, 0.f, nullptr, P.norm_g, true);
  }
  SEAM();
  for (int l = 0; l < 4; ++l) {
    const float* g = P.norm_g + (size_t)l * 6 * DM;
    if (ACTIVE()) { PTRS gemm8_phase<5632, DM, KP1>(XN, W + W_WI, EpiFfnUp8{R2}, smem); }
    SEAM();
    if (ACTIVE()) { PTRS gemm8_phase<1024, DFF, KP2>(R2, W + W_WO, EpiY8{qkv + Q_Y}, smem); }
    SEAM();
    if (ACTIVE()) { PTRS ew_phase(P, Y, 0.5f, g + DM, g + 2 * DM, false); }
    SEAM();
    if (ACTIVE()) { PTRS
      gemm8_phase<2560, DM, KP1>(XN, W + W_WIN, EpiProj8{&P, l}, smem);
      gemm8_phase<4096, DM, KP1>(XN, W + W_WIN + 2560ull * KP1, EpiGate8{(unsigned char*)R2}, smem);
    }
    SEAM();
    if (ACTIVE()) { PTRS
      gemm_phase<M_CUQ, 4>(W + W_WUQ, 384, qkv + Q_CQ, 384, 384, 2, smem, P, l);
      gemm_phase<M_CUKV, 4>(W + W_WUKV, 256, qkv + Q_CKV, 256, 256, 2, smem, P, l);
    }
    SEAM();
    if (ACTIVE()) { PTRS attn_phase(P, l, smem); }
    SEAM();
    if (ACTIVE()) { PTRS gemm_phase<M_MERGE, 2>(W + W_WB, KP1, XN, KP1, DM, 4, smem, P, l); }
    SEAM();
    if (ACTIVE()) { PTRS gemm8_phase<1024, DM, KP1>(qkv + Q_MERGED, W + W_WOUT, EpiY8{qkv + Q_Y}, smem); }
    SEAM();
    if (ACTIVE()) { PTRS ew_phase(P, Y, 1.0f, g + 3 * DM, g + 4 * DM, false); }
    SEAM();
    if (ACTIVE()) { PTRS gemm8_phase<5632, DM, KP1>(XN, W + W_WI + 5632ull * KP1, EpiFfnUp8{R2}, smem); }
    SEAM();
    if (ACTIVE()) { PTRS gemm8_phase<1024, DFF, KP2>(R2, W + W_WO + 1024ull * KP2, EpiY8{qkv + Q_Y}, smem); }
    SEAM();
    if (ACTIVE()) { PTRS
      ew_phase(P, Y, 0.5f, g + 5 * DM, l < 3 ? g + 6 * DM : nullptr, false);
      if (l < 3) convert_layer(P, l + 1);
    }
    SEAM();
  }
}

constexpr int N_PHASES = 1 + 12 * 4;

extern "C" void kernel_launch(void* const* d_in, const int* in_sizes, int n_in, void* d_out, int out_size, void* d_ws,
                              size_t ws_size, hipStream_t stream) {
  static int grid_blocks = 0;
  if (!grid_blocks) {
    int dev = 0, cus = 0, per_cu = 0;
    hipGetDevice(&dev);
    hipDeviceGetAttribute(&cus, hipDeviceAttributeMultiprocessorCount, dev);
    hipFuncSetAttribute((const void*)mega, hipFuncAttributeMaxDynamicSharedMemorySize, SMEM_BYTES);
    hipOccupancyMaxActiveBlocksPerMultiprocessor(&per_cu, mega, NTHR, SMEM_BYTES);
    if (per_cu < 1) per_cu = 1;
    grid_blocks = cus * per_cu;
  }
  if (ws_size < WS_NEEDED) fprintf(stderr, "workspace too small: %zu < %zu\n", ws_size, (size_t)WS_NEEDED);
  Params P{};
  P.x_prompt = (const float*)d_in[0]; P.x_sample = (const float*)d_in[1]; P.norm_g = (const float*)d_in[2];
  P.w_in = (const float*)d_in[3]; P.a_qk_norm = (const float*)d_in[4]; P.b_sink = (const float*)d_in[5];
  P.c_q_norm = (const float*)d_in[6]; P.c_kv_norm = (const float*)d_in[7]; P.c_w_uq = (const float*)d_in[8];
  P.c_w_ukv = (const float*)d_in[9]; P.d_lambda = (const float*)d_in[10]; P.d_subln = (const float*)d_in[11];
  P.w_branch = (const float*)d_in[12]; P.w_out = (const float*)d_in[13]; P.ffn_wi = (const float*)d_in[14];
  P.ffn_wo = (const float*)d_in[15];
  P.out = (float*)d_out; P.ws = (char*)d_ws;
#if MULTI_LAUNCH
  for (int ph = 0; ph < N_PHASES; ++ph) {
    P.phase_lo = ph; P.phase_hi = ph + 1; P.coop = 0; P.pad0 = 0;
    hipLaunchKernelGGL(mega, dim3(grid_blocks), dim3(NTHR), SMEM_BYTES, stream, P);
  }
#else
  P.phase_lo = 0; P.phase_hi = 1 << 30; P.coop = 1; P.pad0 = 0;
  hipMemsetAsync((char*)d_ws + OFF_BAR, 0, 1024, stream);
  void* args[] = {&P};
  hipError_t e = hipLaunchCooperativeKernel((const void*)mega, dim3(grid_blocks), dim3(NTHR), args, SMEM_BYTES, stream);
  if (e != hipSuccess) fprintf(stderr, "cooperative launch failed: %s (grid %d)\n", hipGetErrorString(e), grid_blocks);
#endif
}
```

```cpp
#include <hip/hip_runtime.h>
#include <hip/hip_cooperative_groups.h>
#include <cstdio>
#include <cstdint>
#include <type_traits>
namespace cg = cooperative_groups;

#ifndef MULTI_LAUNCH
#define MULTI_LAUNCH 0
#endif

#define DI __device__ __forceinline__
typedef unsigned short u16;
typedef __attribute__((ext_vector_type(8))) short bf16x8;
typedef __attribute__((ext_vector_type(16))) float f32x16;
typedef __attribute__((ext_vector_type(2))) float f32x2_t;
typedef __attribute__((ext_vector_type(2))) __bf16 bf16x2_t;

constexpr int T = 32768;
constexpr int DM = 1024;
constexpr int DFF = 2816;
constexpr int KP1 = 1088;
constexpr int KP2 = 2880;
constexpr int GP = 4160;
constexpr int YP = 1040;
constexpr int NPROJ = 6560;
constexpr int SEQ0 = 16384;
constexpr int DSEQ = 2048;
constexpr float EPS = 1e-6f;
constexpr int NTHR = 512;
constexpr int LSTR = 72;
constexpr int SMEM_BYTES = 2 * 2 * 256 * LSTR * 2;

constexpr size_t W_WI = 0;
constexpr size_t W_WO = W_WI + 2ull * 5632 * KP1;
constexpr size_t W_WIN = W_WO + 2ull * 1024 * KP2;
constexpr size_t W_WUQ = W_WIN + 6656ull * KP1;
constexpr size_t W_WUKV = W_WUQ + 512ull * 384;
constexpr size_t W_WB = W_WUKV + 512ull * 256;
constexpr size_t W_WOUT = W_WB + 1024ull * KP1;
constexpr size_t W_TOTAL = W_WOUT + 1024ull * KP1;

constexpr size_t OFF_W = 0;
constexpr size_t OFF_XN = OFF_W + W_TOTAL * 2;
constexpr size_t OFF_R2 = OFF_XN + (size_t)T * KP1 * 2;
constexpr size_t OFF_QKV = OFF_R2 + (size_t)T * KP2 * 2;
constexpr size_t OFF_SS = OFF_QKV + (size_t)T * 3456 * 2;
constexpr size_t OFF_R64 = OFF_SS + (size_t)T * 20 * 4;
constexpr size_t OFF_R32 = OFF_R64 + 16384ull * 32 * 8;
constexpr size_t OFF_DS = OFF_R32 + 16384ull * 16 * 8;
constexpr size_t OFF_BAR = OFF_DS + (size_t)T * 256 * 4;
constexpr size_t OFF_XB = OFF_BAR + 1024;
constexpr size_t WS_NEEDED = OFF_XB + (size_t)T * 1024 * 2;

constexpr size_t Q_QA = 0;
constexpr size_t Q_KA = (size_t)T * 256;
constexpr size_t Q_VTA = (size_t)T * 384;
constexpr size_t Q_QB = (size_t)T * 512;
constexpr size_t Q_KB = (size_t)T * 768;
constexpr size_t Q_VTB = (size_t)T * 896;
constexpr size_t Q_CQ = (size_t)T * 1024;
constexpr size_t Q_CKV = (size_t)T * 1408;
constexpr size_t Q_QC = (size_t)T * 1664;
constexpr size_t Q_KC = (size_t)T * 2048;
constexpr size_t Q_VTC = (size_t)T * 2432;
constexpr size_t Q_QD = (size_t)T * 2688;
constexpr size_t Q_KD = (size_t)T * 2944;
constexpr size_t Q_VTD = (size_t)T * 3200;
constexpr size_t Q_MERGED = 0;
constexpr size_t Q_Y = (size_t)T * KP1;

struct Params {
  const float* x_prompt; const float* x_sample; const float* norm_g; const float* w_in;
  const float* a_qk_norm; const float* b_sink; const float* c_q_norm; const float* c_kv_norm;
  const float* c_w_uq; const float* c_w_ukv; const float* d_lambda; const float* d_subln;
  const float* w_branch; const float* w_out; const float* ffn_wi; const float* ffn_wo;
  float* out; char* ws;
  int phase_lo; int phase_hi; int coop; int pad0;
};

DI unsigned pk2(float a, float b) {
  f32x2_t v = {a, b};
  bf16x2_t r = __builtin_convertvector(v, bf16x2_t);
  return __builtin_bit_cast(unsigned, r);
}
DI u16 f2bf(float a) { return (u16)(pk2(a, 0.f) & 0xffffu); }
DI float bf2f(unsigned bits16) { return __uint_as_float(bits16 << 16); }
DI int crow(int v, int h) { return (v & 3) + 8 * (v >> 2) + 4 * h; }
DI int pos_of(int tok) { return tok < SEQ0 ? tok : ((tok - SEQ0) & (DSEQ - 1)); }
#define MFMA32(a, b, c) __builtin_amdgcn_mfma_f32_32x32x16_bf16((a), (b), (c), 0, 0, 0)

typedef __attribute__((ext_vector_type(4))) unsigned u32x4;
DI u32x4 gld16(const void* p) { u32x4 r; asm volatile("global_load_dwordx4 %0, %1, off" : "=v"(r) : "v"(p)); return r; }
DI void wait_vm0(u32x4& a) { asm volatile("s_waitcnt vmcnt(0)" : "+v"(a) :: "memory"); }
DI void wait_vm0(u32x4& a, u32x4& b) { asm volatile("s_waitcnt vmcnt(0)" : "+v"(a), "+v"(b) :: "memory"); }
DI void wait_vm0(u32x4& a, u32x4& b, u32x4& c) { asm volatile("s_waitcnt vmcnt(0)" : "+v"(a), "+v"(b), "+v"(c) :: "memory"); }
DI void wait_vm0(u32x4& a, u32x4& b, u32x4& c, u32x4& d) { asm volatile("s_waitcnt vmcnt(0)" : "+v"(a), "+v"(b), "+v"(c), "+v"(d) :: "memory"); }
DI u32x4 gld16s(unsigned voff, const void* sbase) { u32x4 r; asm volatile("global_load_dwordx4 %0, %1, %2" : "=v"(r) : "v"(voff), "s"(sbase)); return r; }
#define DEF_WAIT8(name, cnt) DI void name(u32x4& a, u32x4& b, u32x4& c, u32x4& d, u32x4& e, u32x4& f, u32x4& g, u32x4& h) { asm volatile("s_waitcnt vmcnt(" #cnt ")" : "+v"(a), "+v"(b), "+v"(c), "+v"(d), "+v"(e), "+v"(f), "+v"(g), "+v"(h) :: "memory"); }
#define DEF_WAIT6(name, cnt) DI void name(u32x4& a, u32x4& b, u32x4& c, u32x4& d, u32x4& e, u32x4& f) { asm volatile("s_waitcnt vmcnt(" #cnt ")" : "+v"(a), "+v"(b), "+v"(c), "+v"(d), "+v"(e), "+v"(f) :: "memory"); }
DEF_WAIT8(wait8_vm8, 8)
DEF_WAIT8(wait8_vm0, 0)
DEF_WAIT6(wait6_vm6, 6)
DEF_WAIT6(wait6_vm0, 0)
DI int opaque_tid() { int t = threadIdx.x; asm volatile("" : "+v"(t)); return t; }
DI float wave_sum(float v) {
#pragma unroll
  for (int m = 32; m >= 1; m >>= 1) v += __shfl_xor(v, m);
  return v;
}

DI void rope32_blk(f32x16& a, const float2* __restrict__ tab, int h) {
#pragma unroll
  for (int v = 0; v < 8; ++v) {
    float2 cs = tab[crow(v, h)];
    float x1 = a[v], x2 = a[v + 8];
    a[v] = x1 * cs.x - x2 * cs.y;
    a[v + 8] = x2 * cs.x + x1 * cs.y;
  }
}
DI void rope64_blk(f32x16& a0, f32x16& a1, const float2* __restrict__ tab, int h) {
#pragma unroll
  for (int v = 0; v < 16; ++v) {
    float2 cs = tab[crow(v, h)];
    float x1 = a0[v], x2 = a1[v];
    a0[v] = x1 * cs.x - x2 * cs.y;
    a1[v] = x2 * cs.x + x1 * cs.y;
  }
}
DI void store_rows(u16* __restrict__ base, int ld, int col0, const f32x16& a, int tok, int h, float sc = 1.f) {
#pragma unroll
  for (int vq = 0; vq < 4; ++vq) {
    uint2 pk;
    pk.x = pk2(a[4 * vq] * sc, a[4 * vq + 1] * sc);
    pk.y = pk2(a[4 * vq + 2] * sc, a[4 * vq + 3] * sc);
    *(uint2*)(base + (size_t)tok * ld + col0 + 8 * vq + 4 * h) = pk;
  }
}
DI void store_T(u16* __restrict__ base, int row0, const f32x16& a, int tok, int h) {
  const int tp = (tok & ~12) | ((tok & 4) << 1) | ((tok & 8) >> 1);
#pragma unroll
  for (int v = 0; v < 16; ++v) base[(size_t)((row0 + crow(v, h)) >> 6) * 64 * T + (size_t)(tp >> 7) * 8192 + ((row0 + crow(v, h)) & 63) * 128 + (tp & 127)] = f2bf(a[v]);
}

enum { M_FFNUP = 0, M_Y = 1, M_PROJ = 2, M_CUQ = 3, M_CUKV = 4, M_MERGE = 5, M_GATE = 6 };

template <int MODE, int NJ>
DI void gemm_epilogue(f32x16 (&acc)[2][NJ], int fbase, int tbase, int r, int h, const Params& P, int layer) {
  char* ws = P.ws;
  u16* qkv = (u16*)(ws + OFF_QKV);
  const float2* R64 = (const float2*)(ws + OFF_R64);
  const float2* R32 = (const float2*)(ws + OFF_R32);
  float* SS = (float*)(ws + OFF_SS);
  if constexpr (MODE == M_FFNUP) {
    u16* H = (u16*)(ws + OFF_R2);
    const int hf0 = (fbase >> 6) * 32;
#pragma unroll
    for (int j = 0; j < NJ; ++j) {
      const int tok = tbase + j * 32 + r;
      f32x16 o;
#pragma unroll
      for (int v = 0; v < 16; ++v) {
        float g = acc[0][j][v], u = acc[1][j][v];
        o[v] = g * __builtin_amdgcn_rcpf(1.f + __builtin_amdgcn_exp2f(-1.4426950408889634f * g)) * u;
      }
      store_rows(H, KP2, hf0, o, tok, h);
    }
  } else if constexpr (MODE == M_Y) {
    u16* Yb = qkv + Q_Y;
#pragma unroll
    for (int j = 0; j < NJ; ++j) {
      const int tok = tbase + j * 32 + r;
      store_rows(Yb, KP1, fbase, acc[0][j], tok, h);
      store_rows(Yb, KP1, fbase + 32, acc[1][j], tok, h);
    }
  } else if constexpr (MODE == M_PROJ) {
    if (fbase < 384) {
      const bool isK = fbase >= 256;
      const float* g = P.a_qk_norm + layer * 128 + (isK ? 64 : 0);
      u16* dst = qkv + (isK ? Q_KA : Q_QA);
      const int ld = isK ? 128 : 256;
      const int c0 = isK ? fbase - 256 : fbase;
      float gv[2][16];
#pragma unroll
      for (int i = 0; i < 2; ++i)
#pragma unroll
        for (int v = 0; v < 16; ++v) gv[i][v] = g[i * 32 + crow(v, h)];
#pragma unroll
      for (int j = 0; j < NJ; ++j) {
        const int tok = tbase + j * 32 + r;
        const int pos = pos_of(tok);
        float ss = 0.f;
#pragma unroll
        for (int i = 0; i < 2; ++i)
#pragma unroll
          for (int v = 0; v < 16; ++v) ss += acc[i][j][v] * acc[i][j][v];
        ss += __shfl_xor(ss, 32);
        const float rs = rsqrtf(ss * (1.f / 64.f) + EPS);
#pragma unroll
        for (int i = 0; i < 2; ++i)
#pragma unroll
          for (int v = 0; v < 16; ++v) acc[i][j][v] *= rs * gv[i][v];
        rope32_blk(acc[0][j], R32 + (size_t)(pos >> 6) * 16, h);
        rope32_blk(acc[1][j], R32 + (size_t)(pos & 63) * 16, h);
        store_rows(dst, ld, c0, acc[0][j], tok, h);
        store_rows(dst, ld, c0 + 32, acc[1][j], tok, h);
      }
    } else if (fbase < 512) {
#pragma unroll
      for (int j = 0; j < NJ; ++j) {
        const int tok = tbase + j * 32 + r;
        store_T(qkv + Q_VTA, fbase - 384, acc[0][j], tok, h);
        store_T(qkv + Q_VTA, fbase - 384 + 32, acc[1][j], tok, h);
      }
    } else if (fbase < 896) {
      const bool isK = fbase >= 768;
      u16* dst = qkv + (isK ? Q_KB : Q_QB);
      const int ld = isK ? 128 : 256;
      const int c0 = isK ? fbase - 768 : fbase - 512;
#pragma unroll
      for (int j = 0; j < NJ; ++j) {
        const int tok = tbase + j * 32 + r;
        const int pos = pos_of(tok);
        rope64_blk(acc[0][j], acc[1][j], R64 + (size_t)pos * 32, h);
        store_rows(dst, ld, c0, acc[0][j], tok, h);
        store_rows(dst, ld, c0 + 32, acc[1][j], tok, h);
      }
    } else if (fbase < 1024) {
#pragma unroll
      for (int j = 0; j < NJ; ++j) {
        const int tok = tbase + j * 32 + r;
        store_T(qkv + Q_VTB, fbase - 896, acc[0][j], tok, h);
        store_T(qkv + Q_VTB, fbase - 896 + 32, acc[1][j], tok, h);
      }
    } else if (fbase < 1664) {
      const bool isKV = fbase >= 1408;
      u16* dst = qkv + (isKV ? Q_CKV : Q_CQ);
      const int ld = isKV ? 256 : 384;
      const int c0 = isKV ? fbase - 1408 : fbase - 1024;
      const int sb = (isKV ? 12 : 0) + (c0 >> 5);
#pragma unroll
      for (int j = 0; j < NJ; ++j) {
        const int tok = tbase + j * 32 + r;
#pragma unroll
        for (int i = 0; i < 2; ++i) {
          float ss = 0.f;
#pragma unroll
          for (int v = 0; v < 16; ++v) ss += acc[i][j][v] * acc[i][j][v];
          ss += __shfl_xor(ss, 32);
          if (h == 0) SS[(size_t)tok * 20 + sb + i] = ss;
          store_rows(dst, ld, c0 + i * 32, acc[i][j], tok, h);
        }
      }
    } else if (fbase < 2176) {
      const bool isK = fbase >= 1920;
      u16* dst = qkv + (isK ? Q_KD : Q_QD);
      const int c0 = isK ? fbase - 1920 : fbase - 1664;
#pragma unroll
      for (int j = 0; j < NJ; ++j) {
        const int tok = tbase + j * 32 + r;
        const int pos = pos_of(tok);
#pragma unroll
        for (int i = 0; i < 2; ++i) {
          rope32_blk(acc[i][j], R32 + (size_t)pos * 16, h);
          store_rows(dst, 256, c0 + i * 32, acc[i][j], tok, h);
        }
      }
    } else if (fbase < 2432) {
#pragma unroll
      for (int j = 0; j < NJ; ++j) {
        const int tok = tbase + j * 32 + r;
        store_T(qkv + Q_VTD, fbase - 2176, acc[0][j], tok, h);
        store_T(qkv + Q_VTD, fbase - 2176 + 32, acc[1][j], tok, h);
      }
    } else if (fbase == 2432) {
#pragma unroll
      for (int j = 0; j < NJ; ++j) {
        const int tok = tbase + j * 32 + r;
        const int pos = pos_of(tok);
        rope32_blk(acc[0][j], R32 + (size_t)pos * 16, h);
#pragma unroll
        for (int hd = 0; hd < 4; ++hd) store_rows(qkv + Q_KC, 384, hd * 96 + 64, acc[0][j], tok, h);
      }
    }
  } else if constexpr (MODE == M_GATE) {
    unsigned char* G8 = (unsigned char*)(ws + OFF_R2);
#pragma unroll
    for (int j = 0; j < NJ; ++j) {
      const int tok = tbase + j * 32 + r;
#pragma unroll
      for (int i = 0; i < 2; ++i)
#pragma unroll
        for (int vq = 0; vq < 4; ++vq) {
          unsigned pk = 0u;
#pragma unroll
          for (int e = 0; e < 4; ++e) {
            const float o = __builtin_amdgcn_rcpf(1.f + __builtin_amdgcn_exp2f(-1.4426950408889634f * acc[i][j][4 * vq + e]));
            pk |= (unsigned)(o * 255.f + 0.5f) << (8 * e);
          }
          *(unsigned*)(G8 + (size_t)tok * GP + fbase + i * 32 + 8 * vq + 4 * h) = pk;
        }
    }
  } else if constexpr (MODE == M_CUQ) {
    if (fbase >= 384) return;
    float cn = 0.f;
#pragma unroll
    for (int j = 0; j < NJ; ++j) {
      const int tok = tbase + j * 32 + r;
      const int pos = pos_of(tok);
      float ss = 0.f;
#pragma unroll
      for (int b = 0; b < 12; ++b) ss += SS[(size_t)tok * 20 + b];
      const float rs = rsqrtf(ss * (1.f / 384.f) + EPS);
#pragma unroll
      for (int i = 0; i < 2; ++i) {
        const int blk = (fbase >> 5) + i;
        float hs = 0.f;
#pragma unroll
        for (int v = 0; v < 16; ++v) { acc[i][j][v] *= rs; hs += acc[i][j][v] * acc[i][j][v]; }
        cn = fmaxf(cn, hs);
        if (blk % 3 == 2) rope32_blk(acc[i][j], R32 + (size_t)pos * 16, h);
        store_rows(qkv + Q_QC, 384, blk * 32, acc[i][j], tok, h, 0.10206207261596577f * 1.4426950408889634f);
      }
    }
    {
      float v = cn * 2.f;
#pragma unroll
      for (int mk = 32; mk >= 1; mk >>= 1) v = fmaxf(v, __shfl_xor(v, mk));
      if ((opaque_tid() & 63) == 0) atomicMax((unsigned*)(ws + OFF_BAR) + 144 + layer * 4 + 0, __float_as_uint(v));
    }
  } else if constexpr (MODE == M_CUKV) {
    float cn = 0.f;
#pragma unroll
    for (int j = 0; j < NJ; ++j) {
      const int tok = tbase + j * 32 + r;
      float ss = 0.f;
#pragma unroll
      for (int b = 0; b < 8; ++b) ss += SS[(size_t)tok * 20 + 12 + b];
      const float rs = rsqrtf(ss * (1.f / 256.f) + EPS);
#pragma unroll
      for (int i = 0; i < 2; ++i) {
        const int blk = (fbase >> 5) + i;
        const int hd = blk >> 2, q = blk & 3;
#pragma unroll
        for (int v = 0; v < 16; ++v) acc[i][j][v] *= rs;
        if (q < 2) {
          float hs = 0.f;
#pragma unroll
          for (int v = 0; v < 16; ++v) hs += acc[i][j][v] * acc[i][j][v];
          cn = fmaxf(cn, hs);
          store_rows(qkv + Q_KC, 384, hd * 96 + q * 32, acc[i][j], tok, h);
        } else store_T(qkv + Q_VTC, hd * 64 + (q - 2) * 32, acc[i][j], tok, h);
      }
    }
    {
      float v = cn * 2.f;
#pragma unroll
      for (int mk = 32; mk >= 1; mk >>= 1) v = fmaxf(v, __shfl_xor(v, mk));
      if ((opaque_tid() & 63) == 0) atomicMax((unsigned*)(ws + OFF_BAR) + 144 + layer * 4 + 1, __float_as_uint(v));
    }
  } else if constexpr (MODE == M_MERGE) {
#pragma unroll
    for (int j = 0; j < NJ; ++j) {
      const int tok = tbase + j * 32 + r;
      store_rows(qkv + Q_MERGED, KP1, fbase, acc[0][j], tok, h);
      store_rows(qkv + Q_MERGED, KP1, fbase + 32, acc[1][j], tok, h);
    }
  }
}

typedef __attribute__((address_space(3))) unsigned lds_u32_t;
typedef __attribute__((address_space(1))) const unsigned glb_u32_t;
template <int MODE, int NJ>
DI void gemm_tile(const u16* __restrict__ Wt, int ldw, const u16* __restrict__ X, int ldx, int K, int f0, int t0, char* smem,
                  const Params& P, int layer) {
  constexpr int XROWS = NJ * 64;
  constexpr int WSTG = 256 * 64, XSTG = XROWS * 64;
  u16* sW = (u16*)smem;
  u16* sX = sW + 2 * WSTG;
  const int tid = opaque_tid(), lane = tid & 63, wave = tid >> 6, r = lane & 31, h = lane >> 5;
  const int wf = wave & 3, wt = wave >> 2;
  f32x16 acc[2][NJ];
  f32x16 tot[2][MODE == M_MERGE ? NJ : 1];
#pragma unroll
  for (int i = 0; i < 2; ++i)
#pragma unroll
    for (int j = 0; j < NJ; ++j)
#pragma unroll
      for (int v = 0; v < 16; ++v) acc[i][j][v] = 0.f;
  if constexpr (MODE == M_MERGE) {
#pragma unroll
    for (int i = 0; i < 2; ++i)
#pragma unroll
      for (int j = 0; j < NJ; ++j)
#pragma unroll
        for (int v = 0; v < 16; ++v) tot[i][j][v] = 0.f;
  }
  const int nk = K >> 6;
  const int srow = tid >> 3;
  const int schunk = (tid & 7) ^ ((tid >> 4) & 7);
  const u16* wp = Wt + (size_t)(f0 + srow) * ldw + schunk * 8;
  const u16* xp = X + (size_t)(t0 + srow) * ldx + schunk * 8;
  const int fbase = f0 + wf * 64, tbase = t0 + wt * (NJ * 32);

  auto issue = [&](int kt, int buf) {
#pragma unroll
    for (int i = 0; i < 4; ++i)
      __builtin_amdgcn_global_load_lds((glb_u32_t*)(wp + (size_t)(i * 64) * ldw + kt * 64),
                                       (lds_u32_t*)(sW + buf * WSTG + i * 4096 + tid * 8), 16, 0, 0);
#pragma unroll
    for (int i = 0; i < NJ; ++i)
      __builtin_amdgcn_global_load_lds((glb_u32_t*)(xp + (size_t)(i * 64) * ldx + kt * 64),
                                       (lds_u32_t*)(sX + buf * XSTG + i * 4096 + tid * 8), 16, 0, 0);
  };
  const int swz = (r >> 1) & 7;
  auto compute = [&](int buf, int kt) {
    const u16* aW = sW + buf * WSTG + (wf * 64 + r) * 64;
    const u16* aX = sX + buf * XSTG + (wt * (NJ * 32) + r) * 64;
#pragma unroll
    for (int ks = 0; ks < 4; ++ks) {
      const int co = ((2 * ks + h) ^ swz) * 8;
      bf16x8 wfrag[2], xfrag[NJ];
#pragma unroll
      for (int i = 0; i < 2; ++i) wfrag[i] = *(const bf16x8*)(aW + i * 32 * 64 + co);
#pragma unroll
      for (int j = 0; j < NJ; ++j) xfrag[j] = *(const bf16x8*)(aX + j * 32 * 64 + co);
#pragma unroll
      for (int i = 0; i < 2; ++i)
#pragma unroll
        for (int j = 0; j < NJ; ++j) acc[i][j] = MFMA32(wfrag[i], xfrag[j], acc[i][j]);
    }
    if constexpr (MODE == M_MERGE) {
      if ((kt & 3) == 3) {
        const int br = kt >> 2;
        const unsigned char* G8 = (const unsigned char*)(P.ws + OFF_R2);
#pragma unroll
        for (int j = 0; j < NJ; ++j) {
          const int tok = tbase + j * 32 + r;
#pragma unroll
          for (int i = 0; i < 2; ++i)
#pragma unroll
            for (int vq = 0; vq < 4; ++vq) {
              const unsigned gp = *(const unsigned*)(G8 + (size_t)tok * GP + br * 1024 + fbase + i * 32 + 8 * vq + 4 * h);
              tot[i][j][4 * vq + 0] += (float)(gp & 0xffu) * (1.f / 255.f) * acc[i][j][4 * vq + 0];
              tot[i][j][4 * vq + 1] += (float)((gp >> 8) & 0xffu) * (1.f / 255.f) * acc[i][j][4 * vq + 1];
              tot[i][j][4 * vq + 2] += (float)((gp >> 16) & 0xffu) * (1.f / 255.f) * acc[i][j][4 * vq + 2];
              tot[i][j][4 * vq + 3] += (float)(gp >> 24) * (1.f / 255.f) * acc[i][j][4 * vq + 3];
              acc[i][j][4 * vq + 0] = 0.f; acc[i][j][4 * vq + 1] = 0.f;
              acc[i][j][4 * vq + 2] = 0.f; acc[i][j][4 * vq + 3] = 0.f;
            }
        }
      }
    }
  };

  issue(0, 0);
  asm volatile("s_waitcnt vmcnt(0)" ::: "memory");
  __syncthreads();
  for (int kt = 0; kt < nk; ++kt) {
    const int buf = kt & 1;
    if (kt + 1 < nk) issue(kt + 1, buf ^ 1);
    compute(buf, kt);
    asm volatile("s_waitcnt vmcnt(0) lgkmcnt(0)" ::: "memory");
    __syncthreads();
  }
  if constexpr (MODE == M_MERGE) gemm_epilogue<MODE, NJ>(tot, fbase, tbase, r, h, P, layer);
  else gemm_epilogue<MODE, NJ>(acc, fbase, tbase, r, h, P, layer);
}

template <int MODE, int NJ>
DI void gemm_phase(const u16* Wt, int ldw, const u16* X, int ldx, int K, int nF, char* smem, const Params& P, int layer) {
  constexpr int TT = NJ * 64;
  const int nT = T / TT;
  const int ntiles = nF * nT;
  for (int idx = blockIdx.x; idx < ntiles; idx += gridDim.x) {
    const int tt_lo = idx & 15;
    const int rest = idx >> 4;
    const int ft = rest % nF;
    const int tt = (rest / nF) * 16 + tt_lo;
    gemm_tile<MODE, NJ>(Wt, ldw, X, ldx, K, ft * 256, tt * TT, smem, P, layer);
  }
}

namespace pg8 {
#define PG8_LAS __attribute__((address_space(3)))
typedef unsigned short bf16_t;
typedef short bf16x8 __attribute__((ext_vector_type(8)));
typedef float f32x4 __attribute__((ext_vector_type(4)));
typedef unsigned u32x4 __attribute__((ext_vector_type(4)));
constexpr int BM = 256, BK = 64, HALF = 128, HTB = HALF * BK * 2  , STAGE_BYTES = 8 * HTB, NXCD = 8, WGM = 8;

__host__ __device__ __forceinline__ int lds_byte(int r, int c) { const int st = (r >> 4) * 2 + (c >> 5), rr = r & 15, cc = c & 31, ob = rr * 64 + cc * 2; return st * 1024 + (ob ^ (((ob >> 9) & 1) << 5)); }
__host__ __device__ __forceinline__ void stage_rc(int b, int& R, int& C) { const int st = b / 1024, sb = b % 1024, swz = sb ^ (((sb >> 9) & 1) << 5); R = (st >> 1) * 16 + swz / 64; C = (st & 1) * 32 + (swz % 64) / 2; }
__host__ __device__ __forceinline__ int perm32(int rho) { const int n = rho >> 4, i = rho & 15; return 8 * (i >> 2) + 4 * n + (i & 3); }

struct Unit { int pm, pn; };
struct Gemm { const bf16_t* A; const bf16_t* Bt; int M, N, K, ld; };

struct StaticOrder {
    int nM, nN, nwg, G, c;
    __host__ __device__ void init(int M, int N, int G_, int c_) { nM = M / BM; nN = N / BM; nwg = nM * nN; G = G_; c = c_; }
    __host__ __device__ bool next(int i, Unit& u) const {
        const long L = (long)i * G + c; if (L >= nwg) return false;
        int wgid = (int)L; { const int q = nwg / NXCD, r = nwg % NXCD, xcd = wgid % NXCD, off = wgid / NXCD; wgid = (xcd < r ? xcd * (q + 1) : r * (q + 1) + (xcd - r) * q) + off; }
        const int nig = WGM * nN, gid = wgid / nig, fm = gid * WGM, gsz = (nM - fm) < WGM ? (nM - fm) : WGM;
        u.pm = fm + ((wgid % nig) % gsz); u.pn = (wgid % nig) / gsz; return true;
    }
    __device__ __forceinline__ void a_ready(const Unit&) const {}
    __device__ __forceinline__ void done(const Unit&) const {}
};

template <class Epi, class Sched, bool STAMP, int KC, int LDC>
__device__ __forceinline__ void gemm_phase(PG8_LAS unsigned char* lds, const Gemm g, const Sched& S, const Epi& E, unsigned long long* stamps) {
    const int tid = opaque_tid(), wid = __builtin_amdgcn_readfirstlane(tid >> 6), lane = tid & 63, wr = wid >> 2, wc = wid & 3, fr = lane & 15, fq = lane >> 4;
    constexpr int K = KC, nt = K / BK;
    int ts_lo = 0, ts_hi = 0, nts = 0; const unsigned long long rt_entry = STAMP ? (unsigned long long)wall_clock64() : 0ull;
#define PG8_STAMP() do { if (STAMP && wid == 0 && nts < 64) { const unsigned long long _c = (unsigned long long)clock64(); \
        ts_lo = (lane == nts) ? (int)(unsigned)_c : ts_lo; ts_hi = (lane == nts) ? (int)(unsigned)(_c >> 32) : ts_hi; ++nts; } } while (0)
    PG8_STAMP();
    unsigned voffA[2], voffB[2];
#pragma unroll
    for (int i = 0; i < 2; ++i) { int R, C; stage_rc(tid * 16 + i * 8192, R, C); const int Rb = Epi::PERM ? ((R & ~31) + perm32(R & 31)) : R;
        voffA[i] = (unsigned)(R * LDC + C) * 2u; voffB[i] = (unsigned)(Rb * LDC + C) * 2u; }
    const size_t kstep = (size_t)(BK * 2);
    constexpr size_t hstep = (size_t)HALF * LDC * 2;
    const size_t tstep = 2 * hstep;
    const unsigned ldsw = (unsigned)wid * 1024u;
    const int aoff = lds_byte(wr * 64 + fr, fq * 8), boff = lds_byte(wc * 32 + fr, fq * 8);
#define PG8_SA(b, h) (((b) * 2 + (h)) * HTB)
#define PG8_SB(b, h) ((4 + (b) * 2 + (h)) * HTB)
#define PG8_STAGE(bufoff, gbase, voff) do { _Pragma("unroll") for (int _i = 0; _i < 2; ++_i) \
        __builtin_amdgcn_global_load_lds((const unsigned*)((const char*)(gbase) + (voff)[_i]), (PG8_LAS unsigned*)(lds + (bufoff) + ldsw + _i * 8192), 16, 0, 0); } while (0)
#define PG8_LDA(dst, b, h) do { _Pragma("unroll") for (int m = 0; m < 4; ++m) _Pragma("unroll") for (int k = 0; k < 2; ++k) dst[m][k] = *(const PG8_LAS bf16x8*)(lds + PG8_SA(b, h) + aoff + m * 2048 + k * 1024); } while (0)
#define PG8_LDB(dst, b, h) do { _Pragma("unroll") for (int n = 0; n < 2; ++n) _Pragma("unroll") for (int k = 0; k < 2; ++k) dst[n][k] = *(const PG8_LAS bf16x8*)(lds + PG8_SB(b, h) + boff + n * 2048 + k * 1024); } while (0)
#define PG8_MMA(ai, bj, At, Bt) do { __builtin_amdgcn_s_setprio(1); _Pragma("unroll") for (int m = 0; m < 4; ++m) _Pragma("unroll") for (int n = 0; n < 2; ++n) _Pragma("unroll") for (int k = 0; k < 2; ++k) \
        acc[ai][bj][m][n] = __builtin_amdgcn_mfma_f32_16x16x32_bf16(Bt[n][k], At[m][k], acc[ai][bj][m][n], 0, 0, 0); __builtin_amdgcn_s_setprio(0); } while (0)
#define PG8_WAIT_V(n) asm volatile("s_waitcnt vmcnt(" #n ")" ::: "memory")
#define PG8_WAIT_L(n) asm volatile("s_waitcnt lgkmcnt(" #n ")" ::: "memory")
#define PG8_BAR __builtin_amdgcn_s_barrier()
#define PG8_SCHED __builtin_amdgcn_sched_barrier(0)
    Unit cur, nxt; int ui = 0;
    if (!S.next(0, cur)) return;
    f32x4 acc[2][2][4][2];
#pragma unroll
    for (int a = 0; a < 2; ++a)
#pragma unroll
        for (int b = 0; b < 2; ++b)
#pragma unroll
            for (int m = 0; m < 4; ++m)
#pragma unroll
                for (int n = 0; n < 2; ++n) acc[a][b][m][n] = (f32x4){0.f, 0.f, 0.f, 0.f};
    bf16x8 At[4][2], B0[2][2], B1[2][2];
    const char* cA = (const char*)g.A + (size_t)cur.pm * tstep; const char* cB = (const char*)g.Bt + (size_t)cur.pn * tstep;
    S.a_ready(cur);
    PG8_STAGE(PG8_SB(0, 0), cB, voffB); PG8_STAGE(PG8_SA(0, 0), cA, voffA); PG8_STAGE(PG8_SB(0, 1), cB + hstep, voffB); PG8_STAGE(PG8_SA(0, 1), cA + hstep, voffA);
    if (wr == 1) PG8_BAR;
    PG8_WAIT_V(4); PG8_BAR;
    PG8_STAGE(PG8_SB(1, 0), cB + kstep, voffB); PG8_STAGE(PG8_SA(1, 0), cA + kstep, voffA); PG8_STAGE(PG8_SB(1, 1), cB + hstep + kstep, voffB);
    PG8_WAIT_V(6); PG8_BAR;
    PG8_STAMP();
    for (;;) {
        const bool has_next = S.next(ui + 1, nxt);
        const char* nA = has_next ? (const char*)g.A + (size_t)nxt.pm * tstep : cA; const char* nB = has_next ? (const char*)g.Bt + (size_t)nxt.pn * tstep : cB;
        for (int t = 0; t < nt; t += 2) {
            const bool last = (t == nt - 2);
            const char* a1 = cA + (size_t)(t + 1) * kstep;
            const char* a2 = last ? nA : cA + (size_t)(t + 2) * kstep; const char* b2 = last ? nB : cB + (size_t)(t + 2) * kstep;
            const char* a3 = a2 + kstep; const char* b3 = b2 + kstep;
            if (last && has_next) S.a_ready(nxt);
            PG8_LDB(B0, 0, 0); PG8_SCHED; PG8_LDA(At, 0, 0); PG8_STAGE(PG8_SA(1, 1), a1 + hstep, voffA);
            PG8_WAIT_L(8); PG8_BAR; PG8_WAIT_L(0); PG8_MMA(0, 0, At, B0); PG8_BAR; PG8_SCHED;
            PG8_LDB(B1, 0, 1); PG8_STAGE(PG8_SB(0, 0), b2, voffB);
            PG8_BAR; PG8_WAIT_L(0); PG8_MMA(0, 1, At, B1); PG8_BAR;
            PG8_LDA(At, 0, 1); PG8_STAGE(PG8_SA(0, 0), a2, voffA);
            PG8_BAR; PG8_WAIT_L(0); PG8_MMA(1, 0, At, B0); PG8_BAR; PG8_SCHED;
            PG8_STAGE(PG8_SB(0, 1), b2 + hstep, voffB);
            PG8_WAIT_V(6); PG8_BAR; PG8_MMA(1, 1, At, B1); PG8_BAR;
            PG8_LDB(B0, 1, 0); PG8_SCHED; PG8_LDA(At, 1, 0); PG8_STAGE(PG8_SA(0, 1), a2 + hstep, voffA);
            PG8_WAIT_L(8); PG8_BAR; PG8_WAIT_L(0); PG8_MMA(0, 0, At, B0); PG8_BAR; PG8_SCHED;
            PG8_LDB(B1, 1, 1); PG8_STAGE(PG8_SB(1, 0), b3, voffB);
            PG8_BAR; PG8_WAIT_L(0); PG8_MMA(0, 1, At, B1); PG8_BAR;
            PG8_LDA(At, 1, 1); PG8_STAGE(PG8_SA(1, 0), a3, voffA);
            PG8_BAR; PG8_WAIT_L(0); PG8_MMA(1, 0, At, B0); PG8_BAR; PG8_SCHED;
            PG8_STAGE(PG8_SB(1, 1), b3 + hstep, voffB);
            PG8_WAIT_V(6); PG8_BAR; PG8_MMA(1, 1, At, B1); PG8_BAR;
        }
        PG8_STAMP();
        if constexpr (!Epi::AFTER_DRAIN) { E(acc, cur, wr, wc, fr, fq); S.done(cur); }
        PG8_STAMP();
        if (!has_next) break;
#pragma unroll
        for (int a = 0; a < 2; ++a)
#pragma unroll
            for (int b = 0; b < 2; ++b)
#pragma unroll
                for (int m = 0; m < 4; ++m)
#pragma unroll
                    for (int n = 0; n < 2; ++n) acc[a][b][m][n] = (f32x4){0.f, 0.f, 0.f, 0.f};
        cur = nxt; cA = nA; cB = nB; ++ui;
    }
    PG8_WAIT_V(0);
    if (wr == 0) PG8_BAR;
    PG8_BAR;
    if constexpr (Epi::AFTER_DRAIN) { E.fused(acc, cur, wr, wc, fr, fq, lds, wid, lane); S.done(cur); }
    PG8_STAMP();
    if (STAMP && wid == 0) { stamps[lane] = lane < nts ? (((unsigned long long)(unsigned)ts_hi << 32) | (unsigned)ts_lo) : 0ull;
        if (lane == 62) stamps[62] = rt_entry; if (lane == 63) stamps[63] = (unsigned long long)wall_clock64(); }
#undef PG8_STAMP
#undef PG8_SA
#undef PG8_SB
#undef PG8_STAGE
#undef PG8_LDA
#undef PG8_LDB
#undef PG8_MMA
#undef PG8_WAIT_V
#undef PG8_WAIT_L
#undef PG8_BAR
#undef PG8_SCHED
}
}

struct EpiY8 {
  static constexpr bool PERM = true, AFTER_DRAIN = false;
  u16* O;
  DI void operator()(const pg8::f32x4 (&acc)[2][2][4][2], const pg8::Unit& u, int wr, int wc, int fr, int fq) const {
    const int row0 = u.pm * 256 + wr * 64 + fr, col0 = u.pn * 256 + wc * 32 + 8 * fq;
#pragma unroll
    for (int ai = 0; ai < 2; ++ai)
#pragma unroll
      for (int m = 0; m < 4; ++m) {
        u16* rowp = O + (size_t)(row0 + ai * 128 + m * 16) * KP1 + col0;
#pragma unroll
        for (int bj = 0; bj < 2; ++bj) {
          const pg8::f32x4 v0 = acc[ai][bj][m][0], v1 = acc[ai][bj][m][1];
          u32x4 w; w.x = pk2(v0[0], v0[1]); w.y = pk2(v0[2], v0[3]); w.z = pk2(v1[0], v1[1]); w.w = pk2(v1[2], v1[3]);
          *(u32x4*)(rowp + bj * 128) = w;
        }
      }
  }
};
struct EpiFfnUp8 {
  static constexpr bool PERM = true, AFTER_DRAIN = false;
  u16* H;
  DI void operator()(const pg8::f32x4 (&acc)[2][2][4][2], const pg8::Unit& u, int wr, int wc, int fr, int fq) const {
    const int row0 = u.pm * 256 + wr * 64 + fr, col0 = u.pn * 128 + wc * 32 + 8 * fq;
#pragma unroll
    for (int ai = 0; ai < 2; ++ai)
#pragma unroll
      for (int m = 0; m < 4; ++m) {
        float o[8];
#pragma unroll
        for (int n = 0; n < 2; ++n)
#pragma unroll
          for (int j = 0; j < 4; ++j) {
            const float g = acc[ai][0][m][n][j], up = acc[ai][1][m][n][j];
            o[n * 4 + j] = g * __builtin_amdgcn_rcpf(1.f + __builtin_amdgcn_exp2f(-1.4426950408889634f * g)) * up;
          }
        u32x4 w; w.x = pk2(o[0], o[1]); w.y = pk2(o[2], o[3]); w.z = pk2(o[4], o[5]); w.w = pk2(o[6], o[7]);
        *(u32x4*)(H + (size_t)(row0 + ai * 128 + m * 16) * KP2 + col0) = w;
      }
  }
};
struct EpiGate8 {
  static constexpr bool PERM = true, AFTER_DRAIN = false;
  unsigned char* G8;
  DI void operator()(const pg8::f32x4 (&acc)[2][2][4][2], const pg8::Unit& u, int wr, int wc, int fr, int fq) const {
    const int row0 = u.pm * 256 + wr * 64 + fr, col0 = u.pn * 256 + wc * 32 + 8 * fq;
#pragma unroll
    for (int ai = 0; ai < 2; ++ai)
#pragma unroll
      for (int m = 0; m < 4; ++m)
#pragma unroll
        for (int bj = 0; bj < 2; ++bj) {
          uint2 pk = {0u, 0u};
#pragma unroll
          for (int j = 0; j < 4; ++j) {
            const float a = __builtin_amdgcn_rcpf(1.f + __builtin_amdgcn_exp2f(-1.4426950408889634f * acc[ai][bj][m][0][j]));
            const float b = __builtin_amdgcn_rcpf(1.f + __builtin_amdgcn_exp2f(-1.4426950408889634f * acc[ai][bj][m][1][j]));
            pk.x |= (unsigned)(a * 255.f + 0.5f) << (8 * j);
            pk.y |= (unsigned)(b * 255.f + 0.5f) << (8 * j);
          }
          *(uint2*)(G8 + (size_t)(row0 + ai * 128 + m * 16) * GP + col0 + bj * 128) = pk;
        }
  }
};
struct EpiProj8 {
  static constexpr bool PERM = false, AFTER_DRAIN = false;
  const Params* Pp; int layer;
  static DI void rope32q(float (&b)[8], const float2* __restrict__ tab, int fq) {
#pragma unroll
    for (int j = 0; j < 4; ++j) {
      const float2 cs = tab[4 * fq + j];
      const float x1 = b[j], x2 = b[4 + j];
      b[j] = x1 * cs.x - x2 * cs.y;
      b[4 + j] = x2 * cs.x + x1 * cs.y;
    }
  }
  static DI void st8(u16* __restrict__ base, int ld, int col0, const float (&b)[8], int tok, int fq) {
#pragma unroll
    for (int n = 0; n < 2; ++n) {
      uint2 pk; pk.x = pk2(b[4 * n], b[4 * n + 1]); pk.y = pk2(b[4 * n + 2], b[4 * n + 3]);
      *(uint2*)(base + (size_t)tok * ld + col0 + 16 * n + 4 * fq) = pk;
    }
  }
  static DI void stT8(u16* __restrict__ base, int row0, const float (&b)[8], int tok, int fq) {
    const int tp = (tok & ~12) | ((tok & 4) << 1) | ((tok & 8) >> 1);
#pragma unroll
    for (int n = 0; n < 2; ++n)
#pragma unroll
      for (int j = 0; j < 4; ++j) {
        const int row = row0 + 16 * n + 4 * fq + j;
        base[(size_t)(row >> 6) * 64 * T + (size_t)(tp >> 7) * 8192 + (row & 63) * 128 + (tp & 127)] = f2bf(b[4 * n + j]);
      }
  }
  DI void operator()(const pg8::f32x4 (&acc)[2][2][4][2], const pg8::Unit& u, int wr, int wc, int fr, int fq_in) const {
    const Params& P = *Pp;
    char* ws = P.ws;
    u16* qkv = (u16*)(ws + OFF_QKV);
    const float2* R64 = (const float2*)(ws + OFF_R64);
    const float2* R32 = (const float2*)(ws + OFF_R32);
    float* SS = (float*)(ws + OFF_SS);
    const int fbase = u.pn * 256 + wc * 64;
    if (fbase >= 2496) return;
    float penorm = 0.f;
    float dnorm = 0.f;
#pragma unroll
    for (int ai = 0; ai < 2; ++ai)
#pragma unroll
      for (int m = 0; m < 4; ++m) {
        int fqv = fq_in; asm volatile("" : "+v"(fqv));
        const int fq = fqv;
        const int tok = u.pm * 256 + ai * 128 + wr * 64 + m * 16 + fr;
        const int pos = pos_of(tok);
        float b0[8], b1[8];
#pragma unroll
        for (int n = 0; n < 2; ++n)
#pragma unroll
          for (int j = 0; j < 4; ++j) { b0[4 * n + j] = acc[ai][0][m][n][j]; b1[4 * n + j] = acc[ai][1][m][n][j]; }
        if (fbase < 384) {
          const bool isK = fbase >= 256;
          const float* g = P.a_qk_norm + layer * 128 + (isK ? 64 : 0);
          float ss = 0.f;
#pragma unroll
          for (int k = 0; k < 8; ++k) ss += b0[k] * b0[k] + b1[k] * b1[k];
          ss += __shfl_xor(ss, 16);
          ss += __shfl_xor(ss, 32);
          const float rs = rsqrtf(ss * (1.f / 64.f) + EPS) * (isK ? 1.f : 0.125f * 1.4426950408889634f);
#pragma unroll
          for (int n = 0; n < 2; ++n)
#pragma unroll
            for (int j = 0; j < 4; ++j) {
              b0[4 * n + j] *= rs * g[16 * n + 4 * fq + j];
              b1[4 * n + j] *= rs * g[32 + 16 * n + 4 * fq + j];
            }
          rope32q(b0, R32 + (size_t)(pos >> 6) * 16, fq);
          rope32q(b1, R32 + (size_t)(pos & 63) * 16, fq);
          u16* dst = qkv + (isK ? Q_KA : Q_QA);
          const int ld = isK ? 128 : 256, c0 = isK ? fbase - 256 : fbase;
          st8(dst, ld, c0, b0, tok, fq);
          st8(dst, ld, c0 + 32, b1, tok, fq);
        } else if (fbase < 512) {
          stT8(qkv + Q_VTA, fbase - 384, b0, tok, fq);
          stT8(qkv + Q_VTA, fbase - 384 + 32, b1, tok, fq);
        } else if (fbase < 896) {
          const bool isK = fbase >= 768;
          const float2* tab = R64 + (size_t)pos * 32;
#pragma unroll
          for (int n = 0; n < 2; ++n)
#pragma unroll
            for (int j = 0; j < 4; ++j) {
              const float2 cs = tab[16 * n + 4 * fq + j];
              const float x1 = b0[4 * n + j], x2 = b1[4 * n + j];
              b0[4 * n + j] = x1 * cs.x - x2 * cs.y;
              b1[4 * n + j] = x2 * cs.x + x1 * cs.y;
            }
          u16* dst = qkv + (isK ? Q_KB : Q_QB);
          const int ld = isK ? 128 : 256, c0 = isK ? fbase - 768 : fbase - 512;
          st8(dst, ld, c0, b0, tok, fq);
          st8(dst, ld, c0 + 32, b1, tok, fq);
        } else if (fbase < 1024) {
          stT8(qkv + Q_VTB, fbase - 896, b0, tok, fq);
          stT8(qkv + Q_VTB, fbase - 896 + 32, b1, tok, fq);
        } else if (fbase < 1664) {
          const bool isKV = fbase >= 1408;
          u16* dst = qkv + (isKV ? Q_CKV : Q_CQ);
          const int ld = isKV ? 256 : 384, c0 = isKV ? fbase - 1408 : fbase - 1024;
          const int sb = (isKV ? 12 : 0) + (c0 >> 5);
          float s0 = 0.f, s1 = 0.f;
#pragma unroll
          for (int k = 0; k < 8; ++k) { s0 += b0[k] * b0[k]; s1 += b1[k] * b1[k]; }
          s0 += __shfl_xor(s0, 16); s0 += __shfl_xor(s0, 32);
          s1 += __shfl_xor(s1, 16); s1 += __shfl_xor(s1, 32);
          if (fq == 0) { SS[(size_t)tok * 20 + sb] = s0; SS[(size_t)tok * 20 + sb + 1] = s1; }
          st8(dst, ld, c0, b0, tok, fq);
          st8(dst, ld, c0 + 32, b1, tok, fq);
        } else if (fbase < 2176) {
          const bool isK = fbase >= 1920;
          u16* dst = qkv + (isK ? Q_KD : Q_QD);
          const int c0 = isK ? fbase - 1920 : fbase - 1664;
          rope32q(b0, R32 + (size_t)pos * 16, fq);
          rope32q(b1, R32 + (size_t)pos * 16, fq);
          float s0 = 0.f, s1 = 0.f;
#pragma unroll
          for (int k = 0; k < 8; ++k) { s0 += b0[k] * b0[k]; s1 += b1[k] * b1[k]; }
          dnorm = fmaxf(dnorm, fmaxf(s0, s1));
          if (!isK) {
#pragma unroll
            for (int k = 0; k < 8; ++k) { b0[k] *= 0.17677669529663687f * 1.4426950408889634f; b1[k] *= 0.17677669529663687f * 1.4426950408889634f; }
          }
          st8(dst, 256, c0, b0, tok, fq);
          st8(dst, 256, c0 + 32, b1, tok, fq);
        } else if (fbase < 2432) {
          stT8(qkv + Q_VTD, fbase - 2176, b0, tok, fq);
          stT8(qkv + Q_VTD, fbase - 2176 + 32, b1, tok, fq);
        } else {
          rope32q(b0, R32 + (size_t)pos * 16, fq);
          { float s0 = 0.f;
#pragma unroll
            for (int k = 0; k < 8; ++k) s0 += b0[k] * b0[k];
            penorm = fmaxf(penorm, s0); }
#pragma unroll
          for (int hd = 0; hd < 4; ++hd) st8(qkv + Q_KC, 384, hd * 96 + 64, b0, tok, fq);
        }
        __builtin_amdgcn_sched_barrier(0);
      }
    if (fbase == 2432) {
      float v = penorm * 4.f;
#pragma unroll
      for (int mk = 32; mk >= 1; mk >>= 1) v = fmaxf(v, __shfl_xor(v, mk));
      if ((opaque_tid() & 63) == 0) atomicMax((unsigned*)(ws + OFF_BAR) + 144 + layer * 4 + 2, __float_as_uint(v));
    }
    if (fbase >= 1664 && fbase < 2176) {
      float v = dnorm * 4.f;
#pragma unroll
      for (int mk = 32; mk >= 1; mk >>= 1) v = fmaxf(v, __shfl_xor(v, mk));
      if ((opaque_tid() & 63) == 0) atomicMax((unsigned*)(ws + OFF_BAR) + 128 + layer * 2 + (fbase >= 1920 ? 1 : 0), __float_as_uint(v));
    }
  }
};
struct SimpleOrder {
  int nN, nwg, G, c;
  DI bool next(int i, pg8::Unit& u) const {
    const int L = i * G + c;
    if (L >= nwg) return false;
    const int rest = L >> 4;
    u.pn = rest % nN;
    u.pm = (rest / nN) * 16 + (L & 15);
    return true;
  }
  DI void a_ready(const pg8::Unit&) const {}
  DI void done(const pg8::Unit&) const {}
};
template <int N, int K, int LD, class Epi>
DI void gemm8_phase(const u16* X, const u16* Wt, const Epi& E, char* smem) {
  pg8::Gemm g; g.A = X; g.Bt = Wt; g.M = T; g.N = N; g.K = K; g.ld = LD;
  int bid_ = (int)blockIdx.x;
  if (gridDim.x == 256) {
    const int xcd = bid_ & 7, j = bid_ >> 3;
    bid_ = (((xcd >> 1) * 4 + (j >> 3)) << 4) | ((xcd & 1) * 8 + (j & 7));
  }
  asm volatile("" : "+s"(bid_));
  SimpleOrder S; S.nN = N / 256; S.nwg = (T / 256) * (N / 256); S.G = (int)gridDim.x; S.c = bid_;
  pg8::gemm_phase<Epi, SimpleOrder, false, K, LD>((PG8_LAS unsigned char*)smem, g, S, E, nullptr);
}

template <int DQK, int NCOMP, bool BAND, int EPI, bool NOMAX = false, bool GQA2 = false>
DI void attn_item(const u16* __restrict__ Q, int ldq, const u16* __restrict__ Kp, int ldk, const u16* __restrict__ Vt,
                  int qtok0, int kbeg, int kend, float sc_l2, float sink_l2, float lam, float onorm,
                  const float* __restrict__ subg, u16* __restrict__ O, float* __restrict__ DS, char* smem) {
  constexpr int DC = DQK / NCOMP;
  constexpr int KS = DC / 16;
  constexpr int KEYS = (NCOMP == 1) ? 128 : 64;
  constexpr int KSTR = DQK + 8, VSTR = KEYS + 8;
  constexpr int KCH = DQK / 8, VCH = KEYS / 8;
  constexpr int NKC = KEYS * KCH / NTHR, NVC = 64 * VCH / NTHR;
  constexpr int KSLOT = KEYS * KSTR, VSLOT = 64 * VSTR;
  u16* sK = (u16*)smem;
  u16* sV = sK + 3 * KSLOT;
  const int tid = opaque_tid(), lane = tid & 63, wave = tid >> 6, r = lane & 31, h = lane >> 5;
  const int qtok = qtok0 + (GQA2 ? (wave & 3) : wave) * 32 + r;
  if constexpr (GQA2) { Q += (wave >> 2) * 64; O += (wave >> 2) * 64; }

  bf16x8 qf[NCOMP][KS];
#pragma unroll
  for (int c = 0; c < NCOMP; ++c)
#pragma unroll
    for (int ks = 0; ks < KS; ++ks) qf[c][ks] = *(const bf16x8*)(Q + (size_t)qtok * ldq + c * DC + ks * 16 + 8 * h);

  f32x16 Oa[NCOMP][2];
  float m[NCOMP], l[NCOMP];
#pragma unroll
  for (int c = 0; c < NCOMP; ++c) {
#pragma unroll
    for (int d = 0; d < 2; ++d)
#pragma unroll
      for (int v = 0; v < 16; ++v) Oa[c][d][v] = 0.f;
    m[c] = BAND ? sink_l2 : -1e30f;
    l[c] = (BAND && h == 0) ? 1.f : 0.f;
  }

  const u16* kg[NKC]; int kso[NKC];
#pragma unroll
  for (int i = 0; i < NKC; ++i) {
    const int c = tid + i * NTHR;
    const int row = c / KCH, cc = c % KCH;
    kg[i] = Kp + (size_t)(kbeg + row) * ldk + cc * 8;
    kso[i] = row * KSTR + cc * 8;
  }
  const u16* vg[NVC]; int vso[NVC];
#pragma unroll
  for (int i = 0; i < NVC; ++i) {
    const int c = tid + i * NTHR;
    const int row = c / VCH, cc = c % VCH;
    vg[i] = Vt + (size_t)(kbeg >> 7) * 8192 + row * 128 + cc * 8;
    vso[i] = row * VSTR + cc * 8;
  }
  u32x4 kreg[NKC], vreg[NVC];
  auto loadK = [&](int t) {
#pragma unroll
    for (int i = 0; i < NKC; ++i) kreg[i] = gld16(kg[i] + (size_t)t * KEYS * ldk);
  };
  auto loadV = [&](int t) {
#pragma unroll
    for (int i = 0; i < NVC; ++i) vreg[i] = gld16(vg[i] + (size_t)t * 8192);
  };
  auto waitK = [&]() {
    if constexpr (NKC == 1) wait_vm0(kreg[0]);
    else if constexpr (NKC == 2) wait_vm0(kreg[0], kreg[1]);
    else wait_vm0(kreg[0], kreg[1], kreg[2]);
  };
  auto waitV = [&]() {
    if constexpr (NVC == 1) wait_vm0(vreg[0]);
    else wait_vm0(vreg[0], vreg[1]);
  };
  auto storeK = [&](int slot) {
#pragma unroll
    for (int i = 0; i < NKC; ++i) *(u32x4*)(sK + slot * KSLOT + kso[i]) = kreg[i];
  };
  auto storeV = [&](int slot) {
#pragma unroll
    for (int i = 0; i < NVC; ++i) *(u32x4*)(sV + slot * VSLOT + vso[i]) = vreg[i];
  };

  f32x16 S0[2], S1[2];
  bf16x8 pfA[2][2], pfB[2][2];
  float alpha_pend = 1.f;
  bool need_pend = false;

  auto att_S = [&](auto uu_t, f32x16 (&S)[2], int slot) {
    constexpr int UU = decltype(uu_t)::value;
    constexpr int C = (NCOMP == 2) ? UU : 0;
    const u16* base = sK + slot * KSLOT + ((NCOMP == 1 ? UU * 64 : 0) + r) * KSTR + (NCOMP == 2 ? UU * DC : 0) + 8 * h;
#pragma unroll
    for (int kb = 0; kb < 2; ++kb) {
#pragma unroll
      for (int v = 0; v < 16; ++v) S[kb][v] = 0.f;
#pragma unroll
      for (int ks = 0; ks < KS; ++ks) {
        bf16x8 kf = *(const bf16x8*)(base + kb * 32 * KSTR + ks * 16);
        S[kb] = MFMA32(kf, qf[C][ks], S[kb]);
      }
    }
  };
  auto att_PV = [&](auto uu_t, const bf16x8 (&pf)[2][2], int slot) {
    constexpr int UU = decltype(uu_t)::value;
    constexpr int C = (NCOMP == 2) ? UU : 0;
    const u16* base = sV + slot * VSLOT + r * VSTR + (NCOMP == 1 ? UU * 64 : 0) + 8 * h;
#pragma unroll
    for (int d = 0; d < 2; ++d)
#pragma unroll
      for (int kb = 0; kb < 2; ++kb)
#pragma unroll
        for (int s = 0; s < 2; ++s) {
          bf16x8 vf = *(const bf16x8*)(base + d * 32 * VSTR + kb * 32 + 16 * s);
          Oa[C][d] = MFMA32(vf, pf[kb][s], Oa[C][d]);
        }
  };
  auto att_rescale = [&](auto uu_t) {
    constexpr int UU = decltype(uu_t)::value;
    constexpr int C = (NCOMP == 2) ? UU : 0;
    if (need_pend) {
#pragma unroll
      for (int d = 0; d < 2; ++d)
#pragma unroll
        for (int v = 0; v < 16; ++v) Oa[C][d][v] *= alpha_pend;
    }
  };
  auto att_softmax = [&](auto uu_t, f32x16 (&S)[2], bf16x8 (&pf)[2][2], int kpos0) {
    constexpr int UU = decltype(uu_t)::value;
    constexpr int C = (NCOMP == 2) ? UU : 0;
    if constexpr (BAND) {
#pragma unroll
      for (int kb = 0; kb < 2; ++kb)
#pragma unroll
        for (int v = 0; v < 16; ++v) {
          const int d = kpos0 + kb * 32 + crow(v, h) - qtok;
          if (d > 128 || d < -128) S[kb][v] = -1e30f;
        }
    }
    if constexpr (NOMAX) {
      float rsum = 0.f;
#pragma unroll
      for (int kb = 0; kb < 2; ++kb)
#pragma unroll
        for (int v = 0; v < 16; ++v) {
          float p = __builtin_amdgcn_exp2f(S[kb][v]);
          S[kb][v] = p;
          rsum += p;
        }
      l[C] += rsum;
      need_pend = false;
#pragma unroll
      for (int kb = 0; kb < 2; ++kb)
#pragma unroll
        for (int s = 0; s < 2; ++s) {
          u32x4 pk;
          pk.x = pk2(S[kb][8 * s + 0], S[kb][8 * s + 1]);
          pk.y = pk2(S[kb][8 * s + 2], S[kb][8 * s + 3]);
          pk.z = pk2(S[kb][8 * s + 4], S[kb][8 * s + 5]);
          pk.w = pk2(S[kb][8 * s + 6], S[kb][8 * s + 7]);
          pf[kb][s] = __builtin_bit_cast(bf16x8, pk);
        }
      return;
    }
    float mx = S[0][0];
#pragma unroll
    for (int kb = 0; kb < 2; ++kb)
#pragma unroll
      for (int v = 0; v < 16; ++v) mx = fmaxf(mx, S[kb][v]);
    {
      const unsigned mu = __float_as_uint(mx);
      const auto sw = __builtin_amdgcn_permlane32_swap(mu, mu, false, false);
      mx = fmaxf(__uint_as_float(sw[0]), __uint_as_float(sw[1]));
    }
    const float mold = m[C];
    const float mcand = fmaxf(mold, mx * sc_l2);
    const bool grow = __builtin_amdgcn_ballot_w64(mcand > mold + 6.0f) != 0;
    const float mnew = grow ? mcand : mold;
    need_pend = grow;
    alpha_pend = __builtin_amdgcn_exp2f(mold - mnew);
    m[C] = mnew;
    float rsum = 0.f;
#pragma unroll
    for (int kb = 0; kb < 2; ++kb)
#pragma unroll
      for (int v = 0; v < 16; ++v) {
        float p = __builtin_amdgcn_exp2f(__builtin_fmaf(S[kb][v], sc_l2, -mnew));
        S[kb][v] = p;
        rsum += p;
      }
    l[C] = l[C] * alpha_pend + rsum;
#pragma unroll
    for (int kb = 0; kb < 2; ++kb)
#pragma unroll
      for (int s = 0; s < 2; ++s) {
        u32x4 pk;
        pk.x = pk2(S[kb][8 * s + 0], S[kb][8 * s + 1]);
        pk.y = pk2(S[kb][8 * s + 2], S[kb][8 * s + 3]);
        pk.z = pk2(S[kb][8 * s + 4], S[kb][8 * s + 5]);
        pk.w = pk2(S[kb][8 * s + 6], S[kb][8 * s + 7]);
        pf[kb][s] = __builtin_bit_cast(bf16x8, pk);
      }
  };
  using U0 = std::integral_constant<int, 0>;
  using U1 = std::integral_constant<int, 1>;

  const int ntl = (kend - kbeg) / KEYS;
  auto step = [&](auto first_t, auto lk_t, auto lv_t, int t, int sa, int sb, int sc) {
    constexpr bool FIRST = decltype(first_t)::value, LK = decltype(lk_t)::value, LV = decltype(lv_t)::value;
    if constexpr (LK) loadK(t + 2);
    if constexpr (LV) loadV(t + 1);
    if constexpr (!FIRST) att_rescale(U1{});
    att_S(U1{}, S1, sa);
    if constexpr (!FIRST) att_PV(U1{}, pfB, sc);
    att_softmax(U0{}, S0, pfA, kbeg + t * KEYS);
    att_rescale(U0{});
    if constexpr (LV) att_S(U0{}, S0, sb);
    att_PV(U0{}, pfA, sa);
    att_softmax(U1{}, S1, pfB, kbeg + t * KEYS + 64);
    if constexpr (LK) { waitK(); storeK(sc); }
    if constexpr (LV) { waitV(); storeV(sb); }
    __syncthreads();
  };
  using TT = std::true_type;
  using FF = std::false_type;

  loadK(0); loadV(0);
  waitK(); waitV();
  storeK(0); storeV(0);
  loadK(1);
  waitK();
  storeK(1);
  __syncthreads();
  att_S(U0{}, S0, 0);
  int sa = 0, sb = 1, sc = 2;
  step(TT{}, TT{}, TT{}, 0, sa, sb, sc);
  { int tmp = sa; sa = sb; sb = sc; sc = tmp; }
  for (int t = 1; t < ntl - 2; ++t) {
    step(FF{}, TT{}, TT{}, t, sa, sb, sc);
    int tmp = sa; sa = sb; sb = sc; sc = tmp;
  }
  step(FF{}, FF{}, TT{}, ntl - 2, sa, sb, sc);
  { int tmp = sa; sa = sb; sb = sc; sc = tmp; }
  step(FF{}, FF{}, FF{}, ntl - 1, sa, sb, sc);
  att_rescale(U1{});
  att_PV(U1{}, pfB, sa);

  float inv[NCOMP];
#pragma unroll
  for (int c = 0; c < NCOMP; ++c) {
    float lt = l[c] + __shfl_xor(l[c], 32);
    inv[c] = 1.f / lt;
  }
  if constexpr (EPI == 1) {
#pragma unroll
    for (int d = 0; d < 2; ++d)
#pragma unroll
      for (int vq = 0; vq < 4; ++vq) {
        float4 o = {Oa[0][d][4 * vq] * inv[0], Oa[0][d][4 * vq + 1] * inv[0], Oa[0][d][4 * vq + 2] * inv[0], Oa[0][d][4 * vq + 3] * inv[0]};
        *(float4*)(DS + (size_t)qtok * 256 + d * 32 + 8 * vq + 4 * h) = o;
      }
  } else {
    if constexpr (EPI == 2) {
      float ss = 0.f;
#pragma unroll
      for (int d = 0; d < 2; ++d)
#pragma unroll
        for (int vq = 0; vq < 4; ++vq) {
          const float4 o1 = *(const float4*)(DS + (size_t)qtok * 256 + d * 32 + 8 * vq + 4 * h);
          const float a0 = o1.x - lam * Oa[0][d][4 * vq] * inv[0];
          const float a1 = o1.y - lam * Oa[0][d][4 * vq + 1] * inv[0];
          const float a2 = o1.z - lam * Oa[0][d][4 * vq + 2] * inv[0];
          const float a3 = o1.w - lam * Oa[0][d][4 * vq + 3] * inv[0];
          Oa[0][d][4 * vq] = a0; Oa[0][d][4 * vq + 1] = a1; Oa[0][d][4 * vq + 2] = a2; Oa[0][d][4 * vq + 3] = a3;
          ss += a0 * a0 + a1 * a1 + a2 * a2 + a3 * a3;
        }
      ss += __shfl_xor(ss, 32);
      const float rs = rsqrtf(ss * (1.f / 64.f) + EPS) * onorm;
#pragma unroll
      for (int d = 0; d < 2; ++d)
#pragma unroll
        for (int v = 0; v < 16; ++v) Oa[0][d][v] *= rs * subg[d * 32 + crow(v, h)];
    } else {
#pragma unroll
      for (int d = 0; d < 2; ++d)
#pragma unroll
        for (int v = 0; v < 16; ++v) Oa[0][d][v] *= inv[0];
    }
    store_rows(O, KP1, 0, Oa[0][0], qtok, h);
    store_rows(O, KP1, 32, Oa[0][1], qtok, h);
  }
  __syncthreads();
}

DI void attn_phase(const Params& P, int layer, char* smem) {
  char* ws = P.ws;
  u16* qkv = (u16*)(ws + OFF_QKV);
  u16* BR = (u16*)(ws + OFF_XN);
  const float L2E = 1.4426950408889634f;
  const float lambda_init = 0.8f - 0.6f * __expf(-0.3f * (float)layer);
  float lam;
  {
    const float* dl = P.d_lambda + layer * 128;
    float s1 = 0.f, s2 = 0.f;
    for (int i = 0; i < 32; ++i) { s1 += dl[i] * dl[32 + i]; s2 += dl[64 + i] * dl[96 + i]; }
    lam = __expf(s1) - __expf(s2) + lambda_init;
    lam = __int_as_float(__builtin_amdgcn_readfirstlane(__float_as_int(lam)));
  }
  const float onorm_u = __int_as_float(__builtin_amdgcn_readfirstlane(__float_as_int(1.f - lambda_init)));
  bool a_nomax;
  {
    const float* ag = P.a_qk_norm + layer * 128;
    float gq = 0.f, gk = 0.f;
    for (int i = 0; i < 64; ++i) { gq = fmaxf(gq, fabsf(ag[i])); gk = fmaxf(gk, fabsf(ag[64 + i])); }
    const float bound = 64.f * gq * gk * (0.125f * L2E);
    a_nomax = __builtin_amdgcn_readfirstlane((int)(bound < 60.f)) != 0;
  }
  bool c_nomax;
  {
    const unsigned* nb = (const unsigned*)(ws + OFF_BAR) + 144 + layer * 4;
    const float qb = __uint_as_float(__hip_atomic_load(nb, __ATOMIC_RELAXED, __HIP_MEMORY_SCOPE_AGENT));
    const float kb = __uint_as_float(__hip_atomic_load(nb + 1, __ATOMIC_RELAXED, __HIP_MEMORY_SCOPE_AGENT));
    const float pe = __uint_as_float(__hip_atomic_load(nb + 2, __ATOMIC_RELAXED, __HIP_MEMORY_SCOPE_AGENT));
    const float bound = sqrtf(3.f * qb * (2.f * kb + pe)) * (0.10206207261596577f * L2E);
    c_nomax = __builtin_amdgcn_readfirstlane((int)(bound < 60.f)) != 0;
  }
  bool d_nomax;
  {
    const unsigned* nb = (const unsigned*)(ws + OFF_BAR) + 128 + layer * 2;
    const float q2 = __uint_as_float(__hip_atomic_load(nb, __ATOMIC_RELAXED, __HIP_MEMORY_SCOPE_AGENT));
    const float k2 = __uint_as_float(__hip_atomic_load(nb + 1, __ATOMIC_RELAXED, __HIP_MEMORY_SCOPE_AGENT));
    const float bound = sqrtf(q2 * k2) * (0.17677669529663687f * L2E);
    d_nomax = __builtin_amdgcn_readfirstlane((int)(bound < 60.f)) != 0;
  }
  for (int it = blockIdx.x; it < 2048; it += gridDim.x) {
    const int cls = it >> 8;
    if (cls < 6) {
      const int idx = it & 255;
      const int head = (idx & 7) >> 1;
      const int qb = ((idx >> 3) << 1) + (idx & 1);
      int qtok0, kbeg, kend;
      if (cls < 3) { qtok0 = qb * 256; kbeg = 0; kend = SEQ0; }
      else { const int s = qb >> 3; kbeg = SEQ0 + s * DSEQ; kend = kbeg + DSEQ; qtok0 = kbeg + (qb & 7) * 256; }
      const int typ = cls % 3;
      if (typ == 0) {
        float* DS = (float*)(ws + OFF_DS) + head * 64;
        if (d_nomax) {
          attn_item<32, 1, false, 1, true>(qkv + Q_QD + head * 64, 256, qkv + Q_KD + head * 64, 256,
                                           qkv + Q_VTD + (size_t)head * 64 * T, qtok0, kbeg, kend,
                                           1.f, 0.f, lam, onorm_u, P.d_subln + layer * 64, BR + 768 + head * 64, DS, smem);
          attn_item<32, 1, false, 2, true>(qkv + Q_QD + head * 64 + 32, 256, qkv + Q_KD + head * 64 + 32, 256,
                                           qkv + Q_VTD + (size_t)head * 64 * T, qtok0, kbeg, kend,
                                           1.f, 0.f, lam, onorm_u, P.d_subln + layer * 64, BR + 768 + head * 64, DS, smem);
        } else {
          attn_item<32, 1, false, 1, false>(qkv + Q_QD + head * 64, 256, qkv + Q_KD + head * 64, 256,
                                            qkv + Q_VTD + (size_t)head * 64 * T, qtok0, kbeg, kend,
                                            1.f, 0.f, lam, onorm_u, P.d_subln + layer * 64, BR + 768 + head * 64, DS, smem);
          attn_item<32, 1, false, 2, false>(qkv + Q_QD + head * 64 + 32, 256, qkv + Q_KD + head * 64 + 32, 256,
                                            qkv + Q_VTD + (size_t)head * 64 * T, qtok0, kbeg, kend,
                                            1.f, 0.f, lam, onorm_u, P.d_subln + layer * 64, BR + 768 + head * 64, DS, smem);
        }
      } else if (typ == 1) {
        if (c_nomax)
          attn_item<96, 1, false, 0, true>(qkv + Q_QC + head * 96, 384, qkv + Q_KC + head * 96, 384,
                                           qkv + Q_VTC + (size_t)head * 64 * T, qtok0, kbeg, kend,
                                           1.f, 0.f, 0.f, 1.f, nullptr, BR + 512 + head * 64, nullptr, smem);
        else
          attn_item<96, 1, false, 0, false>(qkv + Q_QC + head * 96, 384, qkv + Q_KC + head * 96, 384,
                                            qkv + Q_VTC + (size_t)head * 64 * T, qtok0, kbeg, kend,
                                            1.f, 0.f, 0.f, 1.f, nullptr, BR + 512 + head * 64, nullptr, smem);
      } else {
        if (a_nomax) {
          const int kvh = (idx & 7) >> 2;
          const int qb128 = ((idx >> 3) << 2) + (idx & 3);
          int q0 = qb128 * 128, kb0 = kbeg, ke0 = kend;
          if (cls >= 3) { const int s2 = qb128 >> 4; kb0 = SEQ0 + s2 * DSEQ; ke0 = kb0 + DSEQ; q0 = kb0 + (qb128 & 15) * 128; }
          attn_item<64, 1, false, 0, true, true>(qkv + Q_QA + kvh * 128, 256, qkv + Q_KA + kvh * 64, 128,
                                                 qkv + Q_VTA + (size_t)kvh * 64 * T, q0, kb0, ke0,
                                                 1.f, 0.f, 0.f, 1.f, nullptr, BR + kvh * 128, nullptr, smem);
        } else
          attn_item<64, 1, false, 0, false>(qkv + Q_QA + head * 64, 256, qkv + Q_KA + (head >> 1) * 64, 128,
                                            qkv + Q_VTA + (size_t)(head >> 1) * 64 * T, qtok0, kbeg, kend,
                                            1.f, 0.f, 0.f, 1.f, nullptr, BR + head * 64, nullptr, smem);
      }
    } else {
      const int idx = it - 1536;
      const int head = (idx & 7) >> 1;
      const int qbg = ((idx >> 3) << 1) + (idx & 1);
      const int qtok0 = qbg * 256;
      int sb, se;
      if (qtok0 < SEQ0) { sb = 0; se = SEQ0; }
      else { sb = SEQ0 + ((qtok0 - SEQ0) / DSEQ) * DSEQ; se = sb + DSEQ; }
      const int kbeg = max(sb, qtok0 - 128), kend = min(se, qtok0 + 256 + 128);
      const float sink = P.b_sink[layer * 4 + head];
      attn_item<64, 1, true, 0>(qkv + Q_QB + head * 64, 256, qkv + Q_KB + (head >> 1) * 64, 128,
                                    qkv + Q_VTB + (size_t)(head >> 1) * 64 * T, qtok0, kbeg, kend,
                                    0.125f * L2E, sink * L2E, 0.f, 1.f, nullptr, BR + 256 + head * 64, nullptr, smem);
    }
  }
}

DI void ew_phase(const Params& P, const u16* __restrict__ Y, float coef, const float* __restrict__ gpost,
                 const float* __restrict__ gnext, bool from_inputs) {
  const int tid = opaque_tid();
  const int lane = tid & 63, wave = tid >> 6;
  u16* XN = (u16*)(P.ws + OFF_XN);
  u16* XB = (u16*)(P.ws + OFF_XB);
  for (int tok = blockIdx.x * 8 + wave; tok < T; tok += gridDim.x * 8) {
    float4 x[4];
    if (from_inputs) {
      const float* xs = tok < SEQ0 ? P.x_prompt + (size_t)tok * DM : P.x_sample + (size_t)(tok - SEQ0) * DM;
#pragma unroll
      for (int i = 0; i < 4; ++i) x[i] = *(const float4*)(xs + (i * 64 + lane) * 4);
    } else {
#pragma unroll
      for (int i = 0; i < 4; ++i) {
        const uint2 xb = *(const uint2*)(XB + (size_t)tok * DM + (i * 64 + lane) * 4);
        x[i] = make_float4(bf2f(xb.x & 0xffffu), bf2f(xb.x >> 16), bf2f(xb.y & 0xffffu), bf2f(xb.y >> 16));
      }
    }
    if (Y) {
      float4 y[4];
      float ss = 0.f;
#pragma unroll
      for (int i = 0; i < 4; ++i) {
        const uint2 yb = *(const uint2*)(Y + (size_t)tok * KP1 + (i * 64 + lane) * 4);
        y[i] = make_float4(bf2f(yb.x & 0xffffu), bf2f(yb.x >> 16), bf2f(yb.y & 0xffffu), bf2f(yb.y >> 16));
        ss += y[i].x * y[i].x + y[i].y * y[i].y + y[i].z * y[i].z + y[i].w * y[i].w;
      }
      ss = wave_sum(ss);
      const float rs = rsqrtf(ss * (1.f / 1024.f) + EPS) * coef;
#pragma unroll
      for (int i = 0; i < 4; ++i) {
        float4 g = *(const float4*)(gpost + (i * 64 + lane) * 4);
        x[i].x += y[i].x * rs * g.x; x[i].y += y[i].y * rs * g.y;
        x[i].z += y[i].z * rs * g.z; x[i].w += y[i].w * rs * g.w;
      }
    }
    if (!gnext) {
#pragma unroll
      for (int i = 0; i < 4; ++i) *(float4*)(P.out + (size_t)tok * DM + (i * 64 + lane) * 4) = x[i];
    } else {
#pragma unroll
      for (int i = 0; i < 4; ++i) {
        uint2 pk;
        pk.x = pk2(x[i].x, x[i].y);
        pk.y = pk2(x[i].z, x[i].w);
        *(uint2*)(XB + (size_t)tok * DM + (i * 64 + lane) * 4) = pk;
      }
    }
    if (gnext) {
      float ss = 0.f;
#pragma unroll
      for (int i = 0; i < 4; ++i) ss += x[i].x * x[i].x + x[i].y * x[i].y + x[i].z * x[i].z + x[i].w * x[i].w;
      ss = wave_sum(ss);
      const float rs = rsqrtf(ss * (1.f / 1024.f) + EPS);
#pragma unroll
      for (int i = 0; i < 4; ++i) {
        float4 g = *(const float4*)(gnext + (i * 64 + lane) * 4);
        uint2 pk;
        pk.x = pk2(x[i].x * rs * g.x, x[i].y * rs * g.y);
        pk.y = pk2(x[i].z * rs * g.z, x[i].w * rs * g.w);
        *(uint2*)(XN + (size_t)tok * KP1 + (i * 64 + lane) * 4) = pk;
      }
    }
  }
}

DI int colmap(int mode, int n, int nsrc) {
  if (mode == 1) { return ((n >> 7) & 1) * DFF + (n >> 8) * 128 + (n & 127); }
  if (mode == 2) {
    if (n < 2560) {
      const int w = n & 255;
      n = (n & ~255) + ((w >> 5) & 3) * 64 + (w >> 7) * 32 + (w & 31);
    }
    if (n < 1664) return n;
    if (n < 2432) return n + 32;
    if (n < 2464) return n - 2432 + 1664;
    if (n < 2560) return -1;
    return n - 96;
  }
  return n < nsrc ? n : -1;
}
DI void conv_job(u16* __restrict__ dst, int ldd, const float* __restrict__ src, int Nd, int K, int lds, int mode,
                 const float* __restrict__ kscale) {
  const int total = Nd * (K >> 3);
  const int gthreads = gridDim.x * NTHR;
  for (int idx = blockIdx.x * NTHR + opaque_tid(); idx < total; idx += gthreads) {
    const int n = idx % Nd, k8 = idx / Nd;
    const int col = colmap(mode, n, lds);
    float v[8];
#pragma unroll
    for (int j = 0; j < 8; ++j) {
      float x = 0.f;
      if (col >= 0) {
        x = src[(size_t)(k8 * 8 + j) * lds + col];
        if (kscale) x *= kscale[k8 * 8 + j];
      }
      v[j] = x;
    }
    uint4 pk = {pk2(v[0], v[1]), pk2(v[2], v[3]), pk2(v[4], v[5]), pk2(v[6], v[7])};
    *(uint4*)(dst + (size_t)n * ldd + k8 * 8) = pk;
  }
}
DI void convert_layer(const Params& P, int l) {
  u16* W = (u16*)(P.ws + OFF_W);
  for (int s = 0; s < 2; ++s) {
    conv_job(W + W_WI + (size_t)s * 5632 * KP1, KP1, P.ffn_wi + ((size_t)l * 2 + s) * 1024 * 5632, 5632, 1024, 5632, 1, nullptr);
    conv_job(W + W_WO + (size_t)s * 1024 * KP2, KP2, P.ffn_wo + ((size_t)l * 2 + s) * 2816 * 1024, 1024, 2816, 1024, 0, nullptr);
  }
  conv_job(W + W_WIN, KP1, P.w_in + (size_t)l * 1024 * NPROJ, 6656, 1024, NPROJ, 2, nullptr);
  conv_job(W + W_WUQ, 384, P.c_w_uq + (size_t)l * 384 * 384, 512, 384, 384, 0, P.c_q_norm + l * 384);
  conv_job(W + W_WUKV, 256, P.c_w_ukv + (size_t)l * 256 * 512, 512, 256, 512, 0, P.c_kv_norm + l * 256);
  conv_job(W + W_WB, KP1, P.w_branch + (size_t)l * 1024 * 1024, 1024, 1024, 1024, 0, nullptr);
  conv_job(W + W_WOUT, KP1, P.w_out + (size_t)l * 1024 * 1024, 1024, 1024, 1024, 0, nullptr);
}
DI void rope_tables(const Params& P) {
  float2* R64 = (float2*)(P.ws + OFF_R64);
  float2* R32 = (float2*)(P.ws + OFF_R32);
  const int gthreads = gridDim.x * NTHR;
  for (int idx = blockIdx.x * NTHR + opaque_tid(); idx < 16384 * 48; idx += gthreads) {
    int pos, f; double base; float2* dst;
    if (idx < 16384 * 32) { pos = idx >> 5; f = idx & 31; base = 0.7498942093324559; dst = R64 + idx; }
    else { const int i2 = idx - 16384 * 32; pos = i2 >> 4; f = i2 & 15; base = 0.5623413251903491; dst = R32 + i2; }
    double inv = 1.0;
    for (int k = 0; k < f; ++k) inv *= base;
    const float ang = (float)pos * (float)inv;
    double tr = (double)ang * 0.15915494309189535;
    tr -= rint(tr);
    const float tf = (float)tr;
    *dst = make_float2(__builtin_amdgcn_cosf(tf), __builtin_amdgcn_sinf(tf));
  }
}

DI void fast_grid_barrier(unsigned* bar, unsigned nblk) {
  asm volatile("s_waitcnt vmcnt(0) lgkmcnt(0)" ::: "memory");
  __syncthreads();
  if (threadIdx.x == 0) {
    __builtin_amdgcn_fence(__ATOMIC_RELEASE, "agent");
    asm volatile("s_waitcnt vmcnt(0) lgkmcnt(0)" ::: "memory");
    const unsigned gen = __hip_atomic_load(&bar[64], __ATOMIC_RELAXED, __HIP_MEMORY_SCOPE_AGENT);
    const unsigned old = __hip_atomic_fetch_add(&bar[0], 1u, __ATOMIC_RELAXED, __HIP_MEMORY_SCOPE_AGENT);
    if (old == nblk - 1u) {
      __hip_atomic_store(&bar[0], 0u, __ATOMIC_RELAXED, __HIP_MEMORY_SCOPE_AGENT);
      __hip_atomic_fetch_add(&bar[64], 1u, __ATOMIC_RELEASE, __HIP_MEMORY_SCOPE_AGENT);
    } else {
      while (__hip_atomic_load(&bar[64], __ATOMIC_RELAXED, __HIP_MEMORY_SCOPE_AGENT) == gen) __builtin_amdgcn_s_sleep(1);
    }
    __builtin_amdgcn_fence(__ATOMIC_ACQUIRE, "agent");
    asm volatile("s_waitcnt vmcnt(0) lgkmcnt(0)" ::: "memory");
  }
  __syncthreads();
}

__global__ void __launch_bounds__(NTHR) __attribute__((amdgpu_waves_per_eu(2, 2))) mega(Params P) {
  extern __shared__ __attribute__((aligned(16))) char smem[];
  cg::grid_group grid = cg::this_grid();
  int phase = 0;
#if MULTI_LAUNCH
#define ACTIVE() (phase >= P.phase_lo && phase < P.phase_hi)
#define SEAM() do { ++phase; } while (0)
#else
#define ACTIVE() (true)
#define SEAM() do { ++phase; if (phase == 1) grid.sync(); else fast_grid_barrier((unsigned*)(P.ws + OFF_BAR), gridDim.x); } while (0)
#endif
  u16* W = (u16*)(P.ws + OFF_W);
  u16* XN = (u16*)(P.ws + OFF_XN);
  u16* R2 = (u16*)(P.ws + OFF_R2);
  u16* qkv = (u16*)(P.ws + OFF_QKV);
  const u16* Y = qkv + Q_Y;
#define PTRS

  if (ACTIVE()) { PTRS
    rope_tables(P);
    convert_layer(P, 0);
    ew_phase(P, nullptr, 0.f, nullptr, P.norm_g, true);
  }
  SEAM();
  for (int l = 0; l < 4; ++l) {
    const float* g = P.norm_g + (size_t)l * 6 * DM;
    if (ACTIVE()) { PTRS gemm8_phase<5632, DM, KP1>(XN, W + W_WI, EpiFfnUp8{R2}, smem); }
    SEAM();
    if (ACTIVE()) { PTRS gemm8_phase<1024, DFF, KP2>(R2, W + W_WO, EpiY8{qkv + Q_Y}, smem); }
    SEAM();
    if (ACTIVE()) { PTRS ew_phase(P, Y, 0.5f, g + DM, g + 2 * DM, false); }
    SEAM();
    if (ACTIVE()) { PTRS
      gemm8_phase<2560, DM, KP1>(XN, W + W_WIN, EpiProj8{&P, l}, smem);
      gemm8_phase<4096, DM, KP1>(XN, W + W_WIN + 2560ull * KP1, EpiGate8{(unsigned char*)R2}, smem);
    }
    SEAM();
    if (ACTIVE()) { PTRS
      gemm_phase<M_CUQ, 4>(W + W_WUQ, 384, qkv + Q_CQ, 384, 384, 2, smem, P, l);
      gemm_phase<M_CUKV, 4>(W + W_WUKV, 256, qkv + Q_CKV, 256, 256, 2, smem, P, l);
    }
    SEAM();
    if (ACTIVE()) { PTRS attn_phase(P, l, smem); }
    SEAM();
    if (ACTIVE()) { PTRS gemm_phase<M_MERGE, 2>(W + W_WB, KP1, XN, KP1, DM, 4, smem, P, l); }
    SEAM();
    if (ACTIVE()) { PTRS gemm8_phase<1024, DM, KP1>(qkv + Q_MERGED, W + W_WOUT, EpiY8{qkv + Q_Y}, smem); }
    SEAM();
    if (ACTIVE()) { PTRS ew_phase(P, Y, 1.0f, g + 3 * DM, g + 4 * DM, false); }
    SEAM();
    if (ACTIVE()) { PTRS gemm8_phase<5632, DM, KP1>(XN, W + W_WI + 5632ull * KP1, EpiFfnUp8{R2}, smem); }
    SEAM();
    if (ACTIVE()) { PTRS gemm8_phase<1024, DFF, KP2>(R2, W + W_WO + 1024ull * KP2, EpiY8{qkv + Q_Y}, smem); }
    SEAM();
    if (ACTIVE()) { PTRS
      ew_phase(P, Y, 0.5f, g + 5 * DM, l < 3 ? g + 6 * DM : nullptr, false);
      if (l < 3) convert_layer(P, l + 1);
    }
    SEAM();
  }
}

constexpr int N_PHASES = 1 + 12 * 4;

extern "C" void kernel_launch(void* const* d_in, const int* in_sizes, int n_in, void* d_out, int out_size, void* d_ws,
                              size_t ws_size, hipStream_t stream) {
  static int grid_blocks = 0;
  if (!grid_blocks) {
    int dev = 0, cus = 0, per_cu = 0;
    hipGetDevice(&dev);
    hipDeviceGetAttribute(&cus, hipDeviceAttributeMultiprocessorCount, dev);
    hipFuncSetAttribute((const void*)mega, hipFuncAttributeMaxDynamicSharedMemorySize, SMEM_BYTES);
    hipOccupancyMaxActiveBlocksPerMultiprocessor(&per_cu, mega, NTHR, SMEM_BYTES);
    if (per_cu < 1) per_cu = 1;
    grid_blocks = cus * per_cu;
  }
  if (ws_size < WS_NEEDED) fprintf(stderr, "workspace too small: %zu < %zu\n", ws_size, (size_t)WS_NEEDED);
  Params P{};
  P.x_prompt = (const float*)d_in[0]; P.x_sample = (const float*)d_in[1]; P.norm_g = (const float*)d_in[2];
  P.w_in = (const float*)d_in[3]; P.a_qk_norm = (const float*)d_in[4]; P.b_sink = (const float*)d_in[5];
  P.c_q_norm = (const float*)d_in[6]; P.c_kv_norm = (const float*)d_in[7]; P.c_w_uq = (const float*)d_in[8];
  P.c_w_ukv = (const float*)d_in[9]; P.d_lambda = (const float*)d_in[10]; P.d_subln = (const float*)d_in[11];
  P.w_branch = (const float*)d_in[12]; P.w_out = (const float*)d_in[13]; P.ffn_wi = (const float*)d_in[14];
  P.ffn_wo = (const float*)d_in[15];
  P.out = (float*)d_out; P.ws = (char*)d_ws;
#if MULTI_LAUNCH
  for (int ph = 0; ph < N_PHASES; ++ph) {
    P.phase_lo = ph; P.phase_hi = ph + 1; P.coop = 0; P.pad0 = 0;
    hipLaunchKernelGGL(mega, dim3(grid_blocks), dim3(NTHR), SMEM_BYTES, stream, P);
  }
#else
  P.phase_lo = 0; P.phase_hi = 1 << 30; P.coop = 1; P.pad0 = 0;
  hipMemsetAsync((char*)d_ws + OFF_BAR, 0, 1024, stream);
  void* args[] = {&P};
  hipError_t e = hipLaunchCooperativeKernel((const void*)mega, dim3(grid_blocks), dim3(NTHR), args, SMEM_BYTES, stream);
  if (e != hipSuccess) fprintf(stderr, "cooperative launch failed: %s (grid %d)\n", hipGetErrorString(e), grid_blocks);
#endif
}
```

```cpp
#include <hip/hip_runtime.h>
#include <hip/hip_cooperative_groups.h>
#include <cstdio>
#include <cstdint>
#include <type_traits>
namespace cg = cooperative_groups;

#ifndef MULTI_LAUNCH
#define MULTI_LAUNCH 0
#endif

#define DI __device__ __forceinline__
typedef unsigned short u16;
typedef __attribute__((ext_vector_type(8))) short bf16x8;
typedef __attribute__((ext_vector_type(16))) float f32x16;
typedef __attribute__((ext_vector_type(2))) float f32x2_t;
typedef __attribute__((ext_vector_type(2))) __bf16 bf16x2_t;

constexpr int T = 32768;
constexpr int DM = 1024;
constexpr int DFF = 2816;
constexpr int KP1 = 1088;
constexpr int KP2 = 2880;
constexpr int GP = 4160;
constexpr int YP = 1040;
constexpr int NPROJ = 6560;
constexpr int SEQ0 = 16384;
constexpr int DSEQ = 2048;
constexpr float EPS = 1e-6f;
constexpr int NTHR = 512;
constexpr int LSTR = 72;
constexpr int SMEM_BYTES = 2 * 2 * 256 * LSTR * 2;

constexpr size_t W_WI = 0;
constexpr size_t W_WO = W_WI + 2ull * 5632 * KP1;
constexpr size_t W_WIN = W_WO + 2ull * 1024 * KP2;
constexpr size_t W_WUQ = W_WIN + 6656ull * KP1;
constexpr size_t W_WUKV = W_WUQ + 512ull * 384;
constexpr size_t W_WB = W_WUKV + 512ull * 256;
constexpr size_t W_WOUT = W_WB + 1024ull * KP1;
constexpr size_t W_TOTAL = W_WOUT + 1024ull * KP1;

constexpr size_t OFF_W = 0;
constexpr size_t OFF_XN = OFF_W + W_TOTAL * 2;
constexpr size_t OFF_R2 = OFF_XN + (size_t)T * KP1 * 2;
constexpr size_t OFF_QKV = OFF_R2 + (size_t)T * KP2 * 2;
constexpr size_t OFF_SS = OFF_QKV + (size_t)T * 3456 * 2;
constexpr size_t OFF_R64 = OFF_SS + (size_t)T * 20 * 4;
constexpr size_t OFF_R32 = OFF_R64 + 16384ull * 32 * 8;
constexpr size_t OFF_DS = OFF_R32 + 16384ull * 16 * 8;
constexpr size_t OFF_BAR = OFF_DS + (size_t)T * 256 * 4;
constexpr size_t OFF_XB = OFF_BAR + 1024;
constexpr size_t WS_NEEDED = OFF_XB + (size_t)T * 1024 * 2;

constexpr size_t Q_QA = 0;
constexpr size_t Q_KA = (size_t)T * 256;
constexpr size_t Q_VTA = (size_t)T * 384;
constexpr size_t Q_QB = (size_t)T * 512;
constexpr size_t Q_KB = (size_t)T * 768;
constexpr size_t Q_VTB = (size_t)T * 896;
constexpr size_t Q_CQ = (size_t)T * 1024;
constexpr size_t Q_CKV = (size_t)T * 1408;
constexpr size_t Q_QC = (size_t)T * 1664;
constexpr size_t Q_KC = (size_t)T * 2048;
constexpr size_t Q_VTC = (size_t)T * 2432;
constexpr size_t Q_QD = (size_t)T * 2688;
constexpr size_t Q_KD = (size_t)T * 2944;
constexpr size_t Q_VTD = (size_t)T * 3200;
constexpr size_t Q_MERGED = 0;
constexpr size_t Q_Y = (size_t)T * KP1;

struct Params {
  const float* x_prompt; const float* x_sample; const float* norm_g; const float* w_in;
  const float* a_qk_norm; const float* b_sink; const float* c_q_norm; const float* c_kv_norm;
  const float* c_w_uq; const float* c_w_ukv; const float* d_lambda; const float* d_subln;
  const float* w_branch; const float* w_out; const float* ffn_wi; const float* ffn_wo;
  float* out; char* ws;
  int phase_lo; int phase_hi; int coop; int pad0;
};

DI unsigned pk2(float a, float b) {
  f32x2_t v = {a, b};
  bf16x2_t r = __builtin_convertvector(v, bf16x2_t);
  return __builtin_bit_cast(unsigned, r);
}
DI u16 f2bf(float a) { return (u16)(pk2(a, 0.f) & 0xffffu); }
DI float bf2f(unsigned bits16) { return __uint_as_float(bits16 << 16); }
DI int crow(int v, int h) { return (v & 3) + 8 * (v >> 2) + 4 * h; }
DI int pos_of(int tok) { return tok < SEQ0 ? tok : ((tok - SEQ0) & (DSEQ - 1)); }
#define MFMA32(a, b, c) __builtin_amdgcn_mfma_f32_32x32x16_bf16((a), (b), (c), 0, 0, 0)

typedef __attribute__((ext_vector_type(4))) unsigned u32x4;
DI u32x4 gld16(const void* p) { u32x4 r; asm volatile("global_load_dwordx4 %0, %1, off" : "=v"(r) : "v"(p)); return r; }
DI void wait_vm0(u32x4& a) { asm volatile("s_waitcnt vmcnt(0)" : "+v"(a) :: "memory"); }
DI void wait_vm0(u32x4& a, u32x4& b) { asm volatile("s_waitcnt vmcnt(0)" : "+v"(a), "+v"(b) :: "memory"); }
DI void wait_vm0(u32x4& a, u32x4& b, u32x4& c) { asm volatile("s_waitcnt vmcnt(0)" : "+v"(a), "+v"(b), "+v"(c) :: "memory"); }
DI void wait_vm0(u32x4& a, u32x4& b, u32x4& c, u32x4& d) { asm volatile("s_waitcnt vmcnt(0)" : "+v"(a), "+v"(b), "+v"(c), "+v"(d) :: "memory"); }
DI u32x4 gld16s(unsigned voff, const void* sbase) { u32x4 r; asm volatile("global_load_dwordx4 %0, %1, %2" : "=v"(r) : "v"(voff), "s"(sbase)); return r; }
#define DEF_WAIT8(name, cnt) DI void name(u32x4& a, u32x4& b, u32x4& c, u32x4& d, u32x4& e, u32x4& f, u32x4& g, u32x4& h) { asm volatile("s_waitcnt vmcnt(" #cnt ")" : "+v"(a), "+v"(b), "+v"(c), "+v"(d), "+v"(e), "+v"(f), "+v"(g), "+v"(h) :: "memory"); }
#define DEF_WAIT6(name, cnt) DI void name(u32x4& a, u32x4& b, u32x4& c, u32x4& d, u32x4& e, u32x4& f) { asm volatile("s_waitcnt vmcnt(" #cnt ")" : "+v"(a), "+v"(b), "+v"(c), "+v"(d), "+v"(e), "+v"(f) :: "memory"); }
DEF_WAIT8(wait8_vm8, 8)
DEF_WAIT8(wait8_vm0, 0)
DEF_WAIT6(wait6_vm6, 6)
DEF_WAIT6(wait6_vm0, 0)
DI int opaque_tid() { int t = threadIdx.x; asm volatile("" : "+v"(t)); return t; }
DI float wave_sum(float v) {
#pragma unroll
  for (int m = 32; m >= 1; m >>= 1) v += __shfl_xor(v, m);
  return v;
}

DI void rope32_blk(f32x16& a, const float2* __restrict__ tab, int h) {
#pragma unroll
  for (int v = 0; v < 8; ++v) {
    float2 cs = tab[crow(v, h)];
    float x1 = a[v], x2 = a[v + 8];
    a[v] = x1 * cs.x - x2 * cs.y;
    a[v + 8] = x2 * cs.x + x1 * cs.y;
  }
}
DI void rope64_blk(f32x16& a0, f32x16& a1, const float2* __restrict__ tab, int h) {
#pragma unroll
  for (int v = 0; v < 16; ++v) {
    float2 cs = tab[crow(v, h)];
    float x1 = a0[v], x2 = a1[v];
    a0[v] = x1 * cs.x - x2 * cs.y;
    a1[v] = x2 * cs.x + x1 * cs.y;
  }
}
DI void store_rows(u16* __restrict__ base, int ld, int col0, const f32x16& a, int tok, int h, float sc = 1.f) {
#pragma unroll
  for (int vq = 0; vq < 4; ++vq) {
    uint2 pk;
    pk.x = pk2(a[4 * vq] * sc, a[4 * vq + 1] * sc);
    pk.y = pk2(a[4 * vq + 2] * sc, a[4 * vq + 3] * sc);
    *(uint2*)(base + (size_t)tok * ld + col0 + 8 * vq + 4 * h) = pk;
  }
}
DI void store_T(u16* __restrict__ base, int row0, const f32x16& a, int tok, int h) {
  const int tp = (tok & ~12) | ((tok & 4) << 1) | ((tok & 8) >> 1);
#pragma unroll
  for (int v = 0; v < 16; ++v) base[(size_t)((row0 + crow(v, h)) >> 6) * 64 * T + (size_t)(tp >> 7) * 8192 + ((row0 + crow(v, h)) & 63) * 128 + (tp & 127)] = f2bf(a[v]);
}

enum { M_FFNUP = 0, M_Y = 1, M_PROJ = 2, M_CUQ = 3, M_CUKV = 4, M_MERGE = 5, M_GATE = 6 };

template <int MODE, int NJ>
DI void gemm_epilogue(f32x16 (&acc)[2][NJ], int fbase, int tbase, int r, int h, const Params& P, int layer) {
  char* ws = P.ws;
  u16* qkv = (u16*)(ws + OFF_QKV);
  const float2* R64 = (const float2*)(ws + OFF_R64);
  const float2* R32 = (const float2*)(ws + OFF_R32);
  float* SS = (float*)(ws + OFF_SS);
  if constexpr (MODE == M_FFNUP) {
    u16* H = (u16*)(ws + OFF_R2);
    const int hf0 = (fbase >> 6) * 32;
#pragma unroll
    for (int j = 0; j < NJ; ++j) {
      const int tok = tbase + j * 32 + r;
      f32x16 o;
#pragma unroll
      for (int v = 0; v < 16; ++v) {
        float g = acc[0][j][v], u = acc[1][j][v];
        o[v] = g * __builtin_amdgcn_rcpf(1.f + __builtin_amdgcn_exp2f(-1.4426950408889634f * g)) * u;
      }
      store_rows(H, KP2, hf0, o, tok, h);
    }
  } else if constexpr (MODE == M_Y) {
    u16* Yb = qkv + Q_Y;
#pragma unroll
    for (int j = 0; j < NJ; ++j) {
      const int tok = tbase + j * 32 + r;
      store_rows(Yb, KP1, fbase, acc[0][j], tok, h);
      store_rows(Yb, KP1, fbase + 32, acc[1][j], tok, h);
    }
  } else if constexpr (MODE == M_PROJ) {
    if (fbase < 384) {
      const bool isK = fbase >= 256;
      const float* g = P.a_qk_norm + layer * 128 + (isK ? 64 : 0);
      u16* dst = qkv + (isK ? Q_KA : Q_QA);
      const int ld = isK ? 128 : 256;
      const int c0 = isK ? fbase - 256 : fbase;
      float gv[2][16];
#pragma unroll
      for (int i = 0; i < 2; ++i)
#pragma unroll
        for (int v = 0; v < 16; ++v) gv[i][v] = g[i * 32 + crow(v, h)];
#pragma unroll
      for (int j = 0; j < NJ; ++j) {
        const int tok = tbase + j * 32 + r;
        const int pos = pos_of(tok);
        float ss = 0.f;
#pragma unroll
        for (int i = 0; i < 2; ++i)
#pragma unroll
          for (int v = 0; v < 16; ++v) ss += acc[i][j][v] * acc[i][j][v];
        ss += __shfl_xor(ss, 32);
        const float rs = rsqrtf(ss * (1.f / 64.f) + EPS);
#pragma unroll
        for (int i = 0; i < 2; ++i)
#pragma unroll
          for (int v = 0; v < 16; ++v) acc[i][j][v] *= rs * gv[i][v];
        rope32_blk(acc[0][j], R32 + (size_t)(pos >> 6) * 16, h);
        rope32_blk(acc[1][j], R32 + (size_t)(pos & 63) * 16, h);
        store_rows(dst, ld, c0, acc[0][j], tok, h);
        store_rows(dst, ld, c0 + 32, acc[1][j], tok, h);
      }
    } else if (fbase < 512) {
#pragma unroll
      for (int j = 0; j < NJ; ++j) {
        const int tok = tbase + j * 32 + r;
        store_T(qkv + Q_VTA, fbase - 384, acc[0][j], tok, h);
        store_T(qkv + Q_VTA, fbase - 384 + 32, acc[1][j], tok, h);
      }
    } else if (fbase < 896) {
      const bool isK = fbase >= 768;
      u16* dst = qkv + (isK ? Q_KB : Q_QB);
      const int ld = isK ? 128 : 256;
      const int c0 = isK ? fbase - 768 : fbase - 512;
#pragma unroll
      for (int j = 0; j < NJ; ++j) {
        const int tok = tbase + j * 32 + r;
        const int pos = pos_of(tok);
        rope64_blk(acc[0][j], acc[1][j], R64 + (size_t)pos * 32, h);
        store_rows(dst, ld, c0, acc[0][j], tok, h);
        store_rows(dst, ld, c0 + 32, acc[1][j], tok, h);
      }
    } else if (fbase < 1024) {
#pragma unroll
      for (int j = 0; j < NJ; ++j) {
        const int tok = tbase + j * 32 + r;
        store_T(qkv + Q_VTB, fbase - 896, acc[0][j], tok, h);
        store_T(qkv + Q_VTB, fbase - 896 + 32, acc[1][j], tok, h);
      }
    } else if (fbase < 1664) {
      const bool isKV = fbase >= 1408;
      u16* dst = qkv + (isKV ? Q_CKV : Q_CQ);
      const int ld = isKV ? 256 : 384;
      const int c0 = isKV ? fbase - 1408 : fbase - 1024;
      const int sb = (isKV ? 12 : 0) + (c0 >> 5);
#pragma unroll
      for (int j = 0; j < NJ; ++j) {
        const int tok = tbase + j * 32 + r;
#pragma unroll
        for (int i = 0; i < 2; ++i) {
          float ss = 0.f;
#pragma unroll
          for (int v = 0; v < 16; ++v) ss += acc[i][j][v] * acc[i][j][v];
          ss += __shfl_xor(ss, 32);
          if (h == 0) SS[(size_t)tok * 20 + sb + i] = ss;
          store_rows(dst, ld, c0 + i * 32, acc[i][j], tok, h);
        }
      }
    } else if (fbase < 2176) {
      const bool isK = fbase >= 1920;
      u16* dst = qkv + (isK ? Q_KD : Q_QD);
      const int c0 = isK ? fbase - 1920 : fbase - 1664;
#pragma unroll
      for (int j = 0; j < NJ; ++j) {
        const int tok = tbase + j * 32 + r;
        const int pos = pos_of(tok);
#pragma unroll
        for (int i = 0; i < 2; ++i) {
          rope32_blk(acc[i][j], R32 + (size_t)pos * 16, h);
          store_rows(dst, 256, c0 + i * 32, acc[i][j], tok, h);
        }
      }
    } else if (fbase < 2432) {
#pragma unroll
      for (int j = 0; j < NJ; ++j) {
        const int tok = tbase + j * 32 + r;
        store_T(qkv + Q_VTD, fbase - 2176, acc[0][j], tok, h);
        store_T(qkv + Q_VTD, fbase - 2176 + 32, acc[1][j], tok, h);
      }
    } else if (fbase == 2432) {
#pragma unroll
      for (int j = 0; j < NJ; ++j) {
        const int tok = tbase + j * 32 + r;
        const int pos = pos_of(tok);
        rope32_blk(acc[0][j], R32 + (size_t)pos * 16, h);
#pragma unroll
        for (int hd = 0; hd < 4; ++hd) store_rows(qkv + Q_KC, 384, hd * 96 + 64, acc[0][j], tok, h);
      }
    }
  } else if constexpr (MODE == M_GATE) {
    unsigned char* G8 = (unsigned char*)(ws + OFF_R2);
#pragma unroll
    for (int j = 0; j < NJ; ++j) {
      const int tok = tbase + j * 32 + r;
#pragma unroll
      for (int i = 0; i < 2; ++i)
#pragma unroll
        for (int vq = 0; vq < 4; ++vq) {
          unsigned pk = 0u;
#pragma unroll
          for (int e = 0; e < 4; ++e) {
            const float o = __builtin_amdgcn_rcpf(1.f + __builtin_amdgcn_exp2f(-1.4426950408889634f * acc[i][j][4 * vq + e]));
            pk |= (unsigned)(o * 255.f + 0.5f) << (8 * e);
          }
          *(unsigned*)(G8 + (size_t)tok * GP + fbase + i * 32 + 8 * vq + 4 * h) = pk;
        }
    }
  } else if constexpr (MODE == M_CUQ) {
    if (fbase >= 384) return;
    float cn = 0.f;
#pragma unroll
    for (int j = 0; j < NJ; ++j) {
      const int tok = tbase + j * 32 + r;
      const int pos = pos_of(tok);
      float ss = 0.f;
#pragma unroll
      for (int b = 0; b < 12; ++b) ss += SS[(size_t)tok * 20 + b];
      const float rs = rsqrtf(ss * (1.f / 384.f) + EPS);
#pragma unroll
      for (int i = 0; i < 2; ++i) {
        const int blk = (fbase >> 5) + i;
        float hs = 0.f;
#pragma unroll
        for (int v = 0; v < 16; ++v) { acc[i][j][v] *= rs; hs += acc[i][j][v] * acc[i][j][v]; }
        cn = fmaxf(cn, hs);
        if (blk % 3 == 2) rope32_blk(acc[i][j], R32 + (size_t)pos * 16, h);
        store_rows(qkv + Q_QC, 384, blk * 32, acc[i][j], tok, h, 0.10206207261596577f * 1.4426950408889634f);
      }
    }
    {
      float v = cn * 2.f;
#pragma unroll
      for (int mk = 32; mk >= 1; mk >>= 1) v = fmaxf(v, __shfl_xor(v, mk));
      if ((opaque_tid() & 63) == 0) atomicMax((unsigned*)(ws + OFF_BAR) + 144 + layer * 4 + 0, __float_as_uint(v));
    }
  } else if constexpr (MODE == M_CUKV) {
    float cn = 0.f;
#pragma unroll
    for (int j = 0; j < NJ; ++j) {
      const int tok = tbase + j * 32 + r;
      float ss = 0.f;
#pragma unroll
      for (int b = 0; b < 8; ++b) ss += SS[(size_t)tok * 20 + 12 + b];
      const float rs = rsqrtf(ss * (1.f / 256.f) + EPS);
#pragma unroll
      for (int i = 0; i < 2; ++i) {
        const int blk = (fbase >> 5) + i;
        const int hd = blk >> 2, q = blk & 3;
#pragma unroll
        for (int v = 0; v < 16; ++v) acc[i][j][v] *= rs;
        if (q < 2) {
          float hs = 0.f;
#pragma unroll
          for (int v = 0; v < 16; ++v) hs += acc[i][j][v] * acc[i][j][v];
          cn = fmaxf(cn, hs);
          store_rows(qkv + Q_KC, 384, hd * 96 + q * 32, acc[i][j], tok, h);
        } else store_T(qkv + Q_VTC, hd * 64 + (q - 2) * 32, acc[i][j], tok, h);
      }
    }
    {
      float v = cn * 2.f;
#pragma unroll
      for (int mk = 32; mk >= 1; mk >>= 1) v = fmaxf(v, __shfl_xor(v, mk));
      if ((opaque_tid() & 63) == 0) atomicMax((unsigned*)(ws + OFF_BAR) + 144 + layer * 4 + 1, __float_as_uint(v));
    }
  } else if constexpr (MODE == M_MERGE) {
#pragma unroll
    for (int j = 0; j < NJ; ++j) {
      const int tok = tbase + j * 32 + r;
      store_rows(qkv + Q_MERGED, KP1, fbase, acc[0][j], tok, h);
      store_rows(qkv + Q_MERGED, KP1, fbase + 32, acc[1][j], tok, h);
    }
  }
}

typedef __attribute__((address_space(3))) unsigned lds_u32_t;
typedef __attribute__((address_space(1))) const unsigned glb_u32_t;
template <int MODE, int NJ>
DI void gemm_tile(const u16* __restrict__ Wt, int ldw, const u16* __restrict__ X, int ldx, int K, int f0, int t0, char* smem,
                  const Params& P, int layer) {
  constexpr int XROWS = NJ * 64;
  constexpr int WSTG = 256 * 64, XSTG = XROWS * 64;
  u16* sW = (u16*)smem;
  u16* sX = sW + 2 * WSTG;
  const int tid = opaque_tid(), lane = tid & 63, wave = tid >> 6, r = lane & 31, h = lane >> 5;
  const int wf = wave & 3, wt = wave >> 2;
  f32x16 acc[2][NJ];
  f32x16 tot[2][MODE == M_MERGE ? NJ : 1];
#pragma unroll
  for (int i = 0; i < 2; ++i)
#pragma unroll
    for (int j = 0; j < NJ; ++j)
#pragma unroll
      for (int v = 0; v < 16; ++v) acc[i][j][v] = 0.f;
  if constexpr (MODE == M_MERGE) {
#pragma unroll
    for (int i = 0; i < 2; ++i)
#pragma unroll
      for (int j = 0; j < NJ; ++j)
#pragma unroll
        for (int v = 0; v < 16; ++v) tot[i][j][v] = 0.f;
  }
  const int nk = K >> 6;
  const int srow = tid >> 3;
  const int schunk = (tid & 7) ^ ((tid >> 4) & 7);
  const u16* wp = Wt + (size_t)(f0 + srow) * ldw + schunk * 8;
  const u16* xp = X + (size_t)(t0 + srow) * ldx + schunk * 8;
  const int fbase = f0 + wf * 64, tbase = t0 + wt * (NJ * 32);

  auto issue = [&](int kt, int buf) {
#pragma unroll
    for (int i = 0; i < 4; ++i)
      __builtin_amdgcn_global_load_lds((glb_u32_t*)(wp + (size_t)(i * 64) * ldw + kt * 64),
                                       (lds_u32_t*)(sW + buf * WSTG + i * 4096 + tid * 8), 16, 0, 0);
#pragma unroll
    for (int i = 0; i < NJ; ++i)
      __builtin_amdgcn_global_load_lds((glb_u32_t*)(xp + (size_t)(i * 64) * ldx + kt * 64),
                                       (lds_u32_t*)(sX + buf * XSTG + i * 4096 + tid * 8), 16, 0, 0);
  };
  const int swz = (r >> 1) & 7;
  auto compute = [&](int buf, int kt) {
    const u16* aW = sW + buf * WSTG + (wf * 64 + r) * 64;
    const u16* aX = sX + buf * XSTG + (wt * (NJ * 32) + r) * 64;
#pragma unroll
    for (int ks = 0; ks < 4; ++ks) {
      const int co = ((2 * ks + h) ^ swz) * 8;
      bf16x8 wfrag[2], xfrag[NJ];
#pragma unroll
      for (int i = 0; i < 2; ++i) wfrag[i] = *(const bf16x8*)(aW + i * 32 * 64 + co);
#pragma unroll
      for (int j = 0; j < NJ; ++j) xfrag[j] = *(const bf16x8*)(aX + j * 32 * 64 + co);
#pragma unroll
      for (int i = 0; i < 2; ++i)
#pragma unroll
        for (int j = 0; j < NJ; ++j) acc[i][j] = MFMA32(wfrag[i], xfrag[j], acc[i][j]);
    }
    if constexpr (MODE == M_MERGE) {
      if ((kt & 3) == 3) {
        const int br = kt >> 2;
        const unsigned char* G8 = (const unsigned char*)(P.ws + OFF_R2);
#pragma unroll
        for (int j = 0; j < NJ; ++j) {
          const int tok = tbase + j * 32 + r;
#pragma unroll
          for (int i = 0; i < 2; ++i)
#pragma unroll
            for (int vq = 0; vq < 4; ++vq) {
              const unsigned gp = *(const unsigned*)(G8 + (size_t)tok * GP + br * 1024 + fbase + i * 32 + 8 * vq + 4 * h);
              tot[i][j][4 * vq + 0] += (float)(gp & 0xffu) * (1.f / 255.f) * acc[i][j][4 * vq + 0];
              tot[i][j][4 * vq + 1] += (float)((gp >> 8) & 0xffu) * (1.f / 255.f) * acc[i][j][4 * vq + 1];
              tot[i][j][4 * vq + 2] += (float)((gp >> 16) & 0xffu) * (1.f / 255.f) * acc[i][j][4 * vq + 2];
              tot[i][j][4 * vq + 3] += (float)(gp >> 24) * (1.f / 255.f) * acc[i][j][4 * vq + 3];
              acc[i][j][4 * vq + 0] = 0.f; acc[i][j][4 * vq + 1] = 0.f;
              acc[i][j][4 * vq + 2] = 0.f; acc[i][j][4 * vq + 3] = 0.f;
            }
        }
      }
    }
  };

  issue(0, 0);
  asm volatile("s_waitcnt vmcnt(0)" ::: "memory");
  __syncthreads();
  for (int kt = 0; kt < nk; ++kt) {
    const int buf = kt & 1;
    if (kt + 1 < nk) issue(kt + 1, buf ^ 1);
    compute(buf, kt);
    asm volatile("s_waitcnt vmcnt(0) lgkmcnt(0)" ::: "memory");
    __syncthreads();
  }
  if constexpr (MODE == M_MERGE) gemm_epilogue<MODE, NJ>(tot, fbase, tbase, r, h, P, layer);
  else gemm_epilogue<MODE, NJ>(acc, fbase, tbase, r, h, P, layer);
}

template <int MODE, int NJ>
DI void gemm_phase(const u16* Wt, int ldw, const u16* X, int ldx, int K, int nF, char* smem, const Params& P, int layer) {
  constexpr int TT = NJ * 64;
  const int nT = T / TT;
  const int ntiles = nF * nT;
  int bperm = blockIdx.x;
  if (gridDim.x == 256 && (ntiles & 255) == 0) {
    const int xcd = bperm & 7, j = bperm >> 3;
    bperm = (((xcd >> 2) * 8 + (j >> 2)) << 4) | ((xcd & 3) * 4 + (j & 3));
  }
  for (int idx0 = blockIdx.x; idx0 < ntiles; idx0 += gridDim.x) {
    const int idx = idx0 - (int)blockIdx.x + bperm;
    const int tt_lo = idx & 15;
    const int rest = idx >> 4;
    const int ft = rest % nF;
    const int tt = (rest / nF) * 16 + tt_lo;
    gemm_tile<MODE, NJ>(Wt, ldw, X, ldx, K, ft * 256, tt * TT, smem, P, layer);
  }
}

namespace pg8 {
#define PG8_LAS __attribute__((address_space(3)))
typedef unsigned short bf16_t;
typedef short bf16x8 __attribute__((ext_vector_type(8)));
typedef float f32x4 __attribute__((ext_vector_type(4)));
typedef unsigned u32x4 __attribute__((ext_vector_type(4)));
constexpr int BM = 256, BK = 64, HALF = 128, HTB = HALF * BK * 2  , STAGE_BYTES = 8 * HTB, NXCD = 8, WGM = 8;

__host__ __device__ __forceinline__ int lds_byte(int r, int c) { const int st = (r >> 4) * 2 + (c >> 5), rr = r & 15, cc = c & 31, ob = rr * 64 + cc * 2; return st * 1024 + (ob ^ (((ob >> 9) & 1) << 5)); }
__host__ __device__ __forceinline__ void stage_rc(int b, int& R, int& C) { const int st = b / 1024, sb = b % 1024, swz = sb ^ (((sb >> 9) & 1) << 5); R = (st >> 1) * 16 + swz / 64; C = (st & 1) * 32 + (swz % 64) / 2; }
__host__ __device__ __forceinline__ int perm32(int rho) { const int n = rho >> 4, i = rho & 15; return 8 * (i >> 2) + 4 * n + (i & 3); }

struct Unit { int pm, pn; };
struct Gemm { const bf16_t* A; const bf16_t* Bt; int M, N, K, ld; };

struct StaticOrder {
    int nM, nN, nwg, G, c;
    __host__ __device__ void init(int M, int N, int G_, int c_) { nM = M / BM; nN = N / BM; nwg = nM * nN; G = G_; c = c_; }
    __host__ __device__ bool next(int i, Unit& u) const {
        const long L = (long)i * G + c; if (L >= nwg) return false;
        int wgid = (int)L; { const int q = nwg / NXCD, r = nwg % NXCD, xcd = wgid % NXCD, off = wgid / NXCD; wgid = (xcd < r ? xcd * (q + 1) : r * (q + 1) + (xcd - r) * q) + off; }
        const int nig = WGM * nN, gid = wgid / nig, fm = gid * WGM, gsz = (nM - fm) < WGM ? (nM - fm) : WGM;
        u.pm = fm + ((wgid % nig) % gsz); u.pn = (wgid % nig) / gsz; return true;
    }
    __device__ __forceinline__ void a_ready(const Unit&) const {}
    __device__ __forceinline__ void done(const Unit&) const {}
};

template <class Epi, class Sched, bool STAMP, int KC, int LDC>
__device__ __forceinline__ void gemm_phase(PG8_LAS unsigned char* lds, const Gemm g, const Sched& S, const Epi& E, unsigned long long* stamps) {
    const int tid = opaque_tid(), wid = __builtin_amdgcn_readfirstlane(tid >> 6), lane = tid & 63, wr = wid >> 2, wc = wid & 3, fr = lane & 15, fq = lane >> 4;
    constexpr int K = KC, nt = K / BK;
    int ts_lo = 0, ts_hi = 0, nts = 0; const unsigned long long rt_entry = STAMP ? (unsigned long long)wall_clock64() : 0ull;
#define PG8_STAMP() do { if (STAMP && wid == 0 && nts < 64) { const unsigned long long _c = (unsigned long long)clock64(); \
        ts_lo = (lane == nts) ? (int)(unsigned)_c : ts_lo; ts_hi = (lane == nts) ? (int)(unsigned)(_c >> 32) : ts_hi; ++nts; } } while (0)
    PG8_STAMP();
    unsigned voffA[2], voffB[2];
#pragma unroll
    for (int i = 0; i < 2; ++i) { int R, C; stage_rc(tid * 16 + i * 8192, R, C); const int Rb = Epi::PERM ? ((R & ~31) + perm32(R & 31)) : R;
        voffA[i] = (unsigned)(R * LDC + C) * 2u; voffB[i] = (unsigned)(Rb * LDC + C) * 2u; }
    const size_t kstep = (size_t)(BK * 2);
    constexpr size_t hstep = (size_t)HALF * LDC * 2;
    const size_t tstep = 2 * hstep;
    const unsigned ldsw = (unsigned)wid * 1024u;
    const int aoff = lds_byte(wr * 64 + fr, fq * 8), boff = lds_byte(wc * 32 + fr, fq * 8);
#define PG8_SA(b, h) (((b) * 2 + (h)) * HTB)
#define PG8_SB(b, h) ((4 + (b) * 2 + (h)) * HTB)
#define PG8_STAGE(bufoff, gbase, voff) do { _Pragma("unroll") for (int _i = 0; _i < 2; ++_i) \
        __builtin_amdgcn_global_load_lds((const unsigned*)((const char*)(gbase) + (voff)[_i]), (PG8_LAS unsigned*)(lds + (bufoff) + ldsw + _i * 8192), 16, 0, 0); } while (0)
#define PG8_LDA(dst, b, h) do { _Pragma("unroll") for (int m = 0; m < 4; ++m) _Pragma("unroll") for (int k = 0; k < 2; ++k) dst[m][k] = *(const PG8_LAS bf16x8*)(lds + PG8_SA(b, h) + aoff + m * 2048 + k * 1024); } while (0)
#define PG8_LDB(dst, b, h) do { _Pragma("unroll") for (int n = 0; n < 2; ++n) _Pragma("unroll") for (int k = 0; k < 2; ++k) dst[n][k] = *(const PG8_LAS bf16x8*)(lds + PG8_SB(b, h) + boff + n * 2048 + k * 1024); } while (0)
#define PG8_MMA(ai, bj, At, Bt) do { __builtin_amdgcn_s_setprio(1); _Pragma("unroll") for (int m = 0; m < 4; ++m) _Pragma("unroll") for (int n = 0; n < 2; ++n) _Pragma("unroll") for (int k = 0; k < 2; ++k) \
        acc[ai][bj][m][n] = __builtin_amdgcn_mfma_f32_16x16x32_bf16(Bt[n][k], At[m][k], acc[ai][bj][m][n], 0, 0, 0); __builtin_amdgcn_s_setprio(0); } while (0)
#define PG8_WAIT_V(n) asm volatile("s_waitcnt vmcnt(" #n ")" ::: "memory")
#define PG8_WAIT_L(n) asm volatile("s_waitcnt lgkmcnt(" #n ")" ::: "memory")
#define PG8_BAR __builtin_amdgcn_s_barrier()
#define PG8_SCHED __builtin_amdgcn_sched_barrier(0)
    Unit cur, nxt; int ui = 0;
    if (!S.next(0, cur)) return;
    f32x4 acc[2][2][4][2];
#pragma unroll
    for (int a = 0; a < 2; ++a)
#pragma unroll
        for (int b = 0; b < 2; ++b)
#pragma unroll
            for (int m = 0; m < 4; ++m)
#pragma unroll
                for (int n = 0; n < 2; ++n) acc[a][b][m][n] = (f32x4){0.f, 0.f, 0.f, 0.f};
    bf16x8 At[4][2], B0[2][2], B1[2][2];
    const char* cA = (const char*)g.A + (size_t)cur.pm * tstep; const char* cB = (const char*)g.Bt + (size_t)cur.pn * tstep;
    S.a_ready(cur);
    PG8_STAGE(PG8_SB(0, 0), cB, voffB); PG8_STAGE(PG8_SA(0, 0), cA, voffA); PG8_STAGE(PG8_SB(0, 1), cB + hstep, voffB); PG8_STAGE(PG8_SA(0, 1), cA + hstep, voffA);
    if (wr == 1) PG8_BAR;
    PG8_WAIT_V(4); PG8_BAR;
    PG8_STAGE(PG8_SB(1, 0), cB + kstep, voffB); PG8_STAGE(PG8_SA(1, 0), cA + kstep, voffA); PG8_STAGE(PG8_SB(1, 1), cB + hstep + kstep, voffB);
    PG8_WAIT_V(6); PG8_BAR;
    PG8_STAMP();
    for (;;) {
        const bool has_next = S.next(ui + 1, nxt);
        const char* nA = has_next ? (const char*)g.A + (size_t)nxt.pm * tstep : cA; const char* nB = has_next ? (const char*)g.Bt + (size_t)nxt.pn * tstep : cB;
        for (int t = 0; t < nt; t += 2) {
            const bool last = (t == nt - 2);
            const char* a1 = cA + (size_t)(t + 1) * kstep;
            const char* a2 = last ? nA : cA + (size_t)(t + 2) * kstep; const char* b2 = last ? nB : cB + (size_t)(t + 2) * kstep;
            const char* a3 = a2 + kstep; const char* b3 = b2 + kstep;
            if (last && has_next) S.a_ready(nxt);
            PG8_LDB(B0, 0, 0); PG8_SCHED; PG8_LDA(At, 0, 0); PG8_STAGE(PG8_SA(1, 1), a1 + hstep, voffA);
            PG8_WAIT_L(8); PG8_BAR; PG8_WAIT_L(0); PG8_MMA(0, 0, At, B0); PG8_BAR; PG8_SCHED;
            PG8_LDB(B1, 0, 1); PG8_STAGE(PG8_SB(0, 0), b2, voffB);
            PG8_BAR; PG8_WAIT_L(0); PG8_MMA(0, 1, At, B1); PG8_BAR;
            PG8_LDA(At, 0, 1); PG8_STAGE(PG8_SA(0, 0), a2, voffA);
            PG8_BAR; PG8_WAIT_L(0); PG8_MMA(1, 0, At, B0); PG8_BAR; PG8_SCHED;
            PG8_STAGE(PG8_SB(0, 1), b2 + hstep, voffB);
            PG8_WAIT_V(6); PG8_BAR; PG8_MMA(1, 1, At, B1); PG8_BAR;
            PG8_LDB(B0, 1, 0); PG8_SCHED; PG8_LDA(At, 1, 0); PG8_STAGE(PG8_SA(0, 1), a2 + hstep, voffA);
            PG8_WAIT_L(8); PG8_BAR; PG8_WAIT_L(0); PG8_MMA(0, 0, At, B0); PG8_BAR; PG8_SCHED;
            PG8_LDB(B1, 1, 1); PG8_STAGE(PG8_SB(1, 0), b3, voffB);
            PG8_BAR; PG8_WAIT_L(0); PG8_MMA(0, 1, At, B1); PG8_BAR;
            PG8_LDA(At, 1, 1); PG8_STAGE(PG8_SA(1, 0), a3, voffA);
            PG8_BAR; PG8_WAIT_L(0); PG8_MMA(1, 0, At, B0); PG8_BAR; PG8_SCHED;
            PG8_STAGE(PG8_SB(1, 1), b3 + hstep, voffB);
            PG8_WAIT_V(6); PG8_BAR; PG8_MMA(1, 1, At, B1); PG8_BAR;
        }
        PG8_STAMP();
        if constexpr (!Epi::AFTER_DRAIN) { E(acc, cur, wr, wc, fr, fq); S.done(cur); }
        PG8_STAMP();
        if (!has_next) break;
#pragma unroll
        for (int a = 0; a < 2; ++a)
#pragma unroll
            for (int b = 0; b < 2; ++b)
#pragma unroll
                for (int m = 0; m < 4; ++m)
#pragma unroll
                    for (int n = 0; n < 2; ++n) acc[a][b][m][n] = (f32x4){0.f, 0.f, 0.f, 0.f};
        cur = nxt; cA = nA; cB = nB; ++ui;
    }
    PG8_WAIT_V(0);
    if (wr == 0) PG8_BAR;
    PG8_BAR;
    if constexpr (Epi::AFTER_DRAIN) { E.fused(acc, cur, wr, wc, fr, fq, lds, wid, lane); S.done(cur); }
    PG8_STAMP();
    if (STAMP && wid == 0) { stamps[lane] = lane < nts ? (((unsigned long long)(unsigned)ts_hi << 32) | (unsigned)ts_lo) : 0ull;
        if (lane == 62) stamps[62] = rt_entry; if (lane == 63) stamps[63] = (unsigned long long)wall_clock64(); }
#undef PG8_STAMP
#undef PG8_SA
#undef PG8_SB
#undef PG8_STAGE
#undef PG8_LDA
#undef PG8_LDB
#undef PG8_MMA
#undef PG8_WAIT_V
#undef PG8_WAIT_L
#undef PG8_BAR
#undef PG8_SCHED
}
}

struct EpiY8 {
  static constexpr bool PERM = true, AFTER_DRAIN = false;
  u16* O;
  DI void operator()(const pg8::f32x4 (&acc)[2][2][4][2], const pg8::Unit& u, int wr, int wc, int fr, int fq) const {
    const int row0 = u.pm * 256 + wr * 64 + fr, col0 = u.pn * 256 + wc * 32 + 8 * fq;
#pragma unroll
    for (int ai = 0; ai < 2; ++ai)
#pragma unroll
      for (int m = 0; m < 4; ++m) {
        u16* rowp = O + (size_t)(row0 + ai * 128 + m * 16) * KP1 + col0;
#pragma unroll
        for (int bj = 0; bj < 2; ++bj) {
          const pg8::f32x4 v0 = acc[ai][bj][m][0], v1 = acc[ai][bj][m][1];
          u32x4 w; w.x = pk2(v0[0], v0[1]); w.y = pk2(v0[2], v0[3]); w.z = pk2(v1[0], v1[1]); w.w = pk2(v1[2], v1[3]);
          *(u32x4*)(rowp + bj * 128) = w;
        }
      }
  }
};
struct EpiFfnUp8 {
  static constexpr bool PERM = true, AFTER_DRAIN = false;
  u16* H;
  DI void operator()(const pg8::f32x4 (&acc)[2][2][4][2], const pg8::Unit& u, int wr, int wc, int fr, int fq) const {
    const int row0 = u.pm * 256 + wr * 64 + fr, col0 = u.pn * 128 + wc * 32 + 8 * fq;
#pragma unroll
    for (int ai = 0; ai < 2; ++ai)
#pragma unroll
      for (int m = 0; m < 4; ++m) {
        float o[8];
#pragma unroll
        for (int n = 0; n < 2; ++n)
#pragma unroll
          for (int j = 0; j < 4; ++j) {
            const float g = acc[ai][0][m][n][j], up = acc[ai][1][m][n][j];
            o[n * 4 + j] = g * __builtin_amdgcn_rcpf(1.f + __builtin_amdgcn_exp2f(-1.4426950408889634f * g)) * up;
          }
        u32x4 w; w.x = pk2(o[0], o[1]); w.y = pk2(o[2], o[3]); w.z = pk2(o[4], o[5]); w.w = pk2(o[6], o[7]);
        *(u32x4*)(H + (size_t)(row0 + ai * 128 + m * 16) * KP2 + col0) = w;
      }
  }
};
struct EpiGate8 {
  static constexpr bool PERM = true, AFTER_DRAIN = false;
  unsigned char* G8;
  DI void operator()(const pg8::f32x4 (&acc)[2][2][4][2], const pg8::Unit& u, int wr, int wc, int fr, int fq) const {
    const int row0 = u.pm * 256 + wr * 64 + fr, col0 = u.pn * 256 + wc * 32 + 8 * fq;
#pragma unroll
    for (int ai = 0; ai < 2; ++ai)
#pragma unroll
      for (int m = 0; m < 4; ++m)
#pragma unroll
        for (int bj = 0; bj < 2; ++bj) {
          uint2 pk = {0u, 0u};
#pragma unroll
          for (int j = 0; j < 4; ++j) {
            const float a = __builtin_amdgcn_rcpf(1.f + __builtin_amdgcn_exp2f(-1.4426950408889634f * acc[ai][bj][m][0][j]));
            const float b = __builtin_amdgcn_rcpf(1.f + __builtin_amdgcn_exp2f(-1.4426950408889634f * acc[ai][bj][m][1][j]));
            pk.x |= (unsigned)(a * 255.f + 0.5f) << (8 * j);
            pk.y |= (unsigned)(b * 255.f + 0.5f) << (8 * j);
          }
          *(uint2*)(G8 + (size_t)(row0 + ai * 128 + m * 16) * GP + col0 + bj * 128) = pk;
        }
  }
};
struct EpiProj8 {
  static constexpr bool PERM = false, AFTER_DRAIN = false;
  const Params* Pp; int layer;
  static DI void rope32q(float (&b)[8], const float2* __restrict__ tab, int fq) {
#pragma unroll
    for (int j = 0; j < 4; ++j) {
      const float2 cs = tab[4 * fq + j];
      const float x1 = b[j], x2 = b[4 + j];
      b[j] = x1 * cs.x - x2 * cs.y;
      b[4 + j] = x2 * cs.x + x1 * cs.y;
    }
  }
  static DI void st8(u16* __restrict__ base, int ld, int col0, const float (&b)[8], int tok, int fq) {
#pragma unroll
    for (int n = 0; n < 2; ++n) {
      uint2 pk; pk.x = pk2(b[4 * n], b[4 * n + 1]); pk.y = pk2(b[4 * n + 2], b[4 * n + 3]);
      *(uint2*)(base + (size_t)tok * ld + col0 + 16 * n + 4 * fq) = pk;
    }
  }
  static DI void stT8(u16* __restrict__ base, int row0, const float (&b)[8], int tok, int fq) {
    const int tp = (tok & ~12) | ((tok & 4) << 1) | ((tok & 8) >> 1);
#pragma unroll
    for (int n = 0; n < 2; ++n)
#pragma unroll
      for (int j = 0; j < 4; ++j) {
        const int row = row0 + 16 * n + 4 * fq + j;
        base[(size_t)(row >> 6) * 64 * T + (size_t)(tp >> 7) * 8192 + (row & 63) * 128 + (tp & 127)] = f2bf(b[4 * n + j]);
      }
  }
  DI void operator()(const pg8::f32x4 (&acc)[2][2][4][2], const pg8::Unit& u, int wr, int wc, int fr, int fq_in) const {
    const Params& P = *Pp;
    char* ws = P.ws;
    u16* qkv = (u16*)(ws + OFF_QKV);
    const float2* R64 = (const float2*)(ws + OFF_R64);
    const float2* R32 = (const float2*)(ws + OFF_R32);
    float* SS = (float*)(ws + OFF_SS);
    const int fbase = u.pn * 256 + wc * 64;
    if (fbase >= 2496) return;
    float penorm = 0.f;
    float dnorm = 0.f;
#pragma unroll
    for (int ai = 0; ai < 2; ++ai)
#pragma unroll
      for (int m = 0; m < 4; ++m) {
        int fqv = fq_in; asm volatile("" : "+v"(fqv));
        const int fq = fqv;
        const int tok = u.pm * 256 + ai * 128 + wr * 64 + m * 16 + fr;
        const int pos = pos_of(tok);
        float b0[8], b1[8];
#pragma unroll
        for (int n = 0; n < 2; ++n)
#pragma unroll
          for (int j = 0; j < 4; ++j) { b0[4 * n + j] = acc[ai][0][m][n][j]; b1[4 * n + j] = acc[ai][1][m][n][j]; }
        if (fbase < 384) {
          const bool isK = fbase >= 256;
          const float* g = P.a_qk_norm + layer * 128 + (isK ? 64 : 0);
          float ss = 0.f;
#pragma unroll
          for (int k = 0; k < 8; ++k) ss += b0[k] * b0[k] + b1[k] * b1[k];
          ss += __shfl_xor(ss, 16);
          ss += __shfl_xor(ss, 32);
          const float rs = rsqrtf(ss * (1.f / 64.f) + EPS) * (isK ? 1.f : 0.125f * 1.4426950408889634f);
#pragma unroll
          for (int n = 0; n < 2; ++n)
#pragma unroll
            for (int j = 0; j < 4; ++j) {
              b0[4 * n + j] *= rs * g[16 * n + 4 * fq + j];
              b1[4 * n + j] *= rs * g[32 + 16 * n + 4 * fq + j];
            }
          rope32q(b0, R32 + (size_t)(pos >> 6) * 16, fq);
          rope32q(b1, R32 + (size_t)(pos & 63) * 16, fq);
          u16* dst = qkv + (isK ? Q_KA : Q_QA);
          const int ld = isK ? 128 : 256, c0 = isK ? fbase - 256 : fbase;
          st8(dst, ld, c0, b0, tok, fq);
          st8(dst, ld, c0 + 32, b1, tok, fq);
        } else if (fbase < 512) {
          stT8(qkv + Q_VTA, fbase - 384, b0, tok, fq);
          stT8(qkv + Q_VTA, fbase - 384 + 32, b1, tok, fq);
        } else if (fbase < 896) {
          const bool isK = fbase >= 768;
          const float2* tab = R64 + (size_t)pos * 32;
#pragma unroll
          for (int n = 0; n < 2; ++n)
#pragma unroll
            for (int j = 0; j < 4; ++j) {
              const float2 cs = tab[16 * n + 4 * fq + j];
              const float x1 = b0[4 * n + j], x2 = b1[4 * n + j];
              b0[4 * n + j] = x1 * cs.x - x2 * cs.y;
              b1[4 * n + j] = x2 * cs.x + x1 * cs.y;
            }
          u16* dst = qkv + (isK ? Q_KB : Q_QB);
          const int ld = isK ? 128 : 256, c0 = isK ? fbase - 768 : fbase - 512;
          st8(dst, ld, c0, b0, tok, fq);
          st8(dst, ld, c0 + 32, b1, tok, fq);
        } else if (fbase < 1024) {
          stT8(qkv + Q_VTB, fbase - 896, b0, tok, fq);
          stT8(qkv + Q_VTB, fbase - 896 + 32, b1, tok, fq);
        } else if (fbase < 1664) {
          const bool isKV = fbase >= 1408;
          u16* dst = qkv + (isKV ? Q_CKV : Q_CQ);
          const int ld = isKV ? 256 : 384, c0 = isKV ? fbase - 1408 : fbase - 1024;
          const int sb = (isKV ? 12 : 0) + (c0 >> 5);
          float s0 = 0.f, s1 = 0.f;
#pragma unroll
          for (int k = 0; k < 8; ++k) { s0 += b0[k] * b0[k]; s1 += b1[k] * b1[k]; }
          s0 += __shfl_xor(s0, 16); s0 += __shfl_xor(s0, 32);
          s1 += __shfl_xor(s1, 16); s1 += __shfl_xor(s1, 32);
          if (fq == 0) { SS[(size_t)tok * 20 + sb] = s0; SS[(size_t)tok * 20 + sb + 1] = s1; }
          st8(dst, ld, c0, b0, tok, fq);
          st8(dst, ld, c0 + 32, b1, tok, fq);
        } else if (fbase < 2176) {
          const bool isK = fbase >= 1920;
          u16* dst = qkv + (isK ? Q_KD : Q_QD);
          const int c0 = isK ? fbase - 1920 : fbase - 1664;
          rope32q(b0, R32 + (size_t)pos * 16, fq);
          rope32q(b1, R32 + (size_t)pos * 16, fq);
          float s0 = 0.f, s1 = 0.f;
#pragma unroll
          for (int k = 0; k < 8; ++k) { s0 += b0[k] * b0[k]; s1 += b1[k] * b1[k]; }
          dnorm = fmaxf(dnorm, fmaxf(s0, s1));
          if (!isK) {
#pragma unroll
            for (int k = 0; k < 8; ++k) { b0[k] *= 0.17677669529663687f * 1.4426950408889634f; b1[k] *= 0.17677669529663687f * 1.4426950408889634f; }
          }
          st8(dst, 256, c0, b0, tok, fq);
          st8(dst, 256, c0 + 32, b1, tok, fq);
        } else if (fbase < 2432) {
          stT8(qkv + Q_VTD, fbase - 2176, b0, tok, fq);
          stT8(qkv + Q_VTD, fbase - 2176 + 32, b1, tok, fq);
        } else {
          rope32q(b0, R32 + (size_t)pos * 16, fq);
          { float s0 = 0.f;
#pragma unroll
            for (int k = 0; k < 8; ++k) s0 += b0[k] * b0[k];
            penorm = fmaxf(penorm, s0); }
#pragma unroll
          for (int hd = 0; hd < 4; ++hd) st8(qkv + Q_KC, 384, hd * 96 + 64, b0, tok, fq);
        }
        __builtin_amdgcn_sched_barrier(0);
      }
    if (fbase == 2432) {
      float v = penorm * 4.f;
#pragma unroll
      for (int mk = 32; mk >= 1; mk >>= 1) v = fmaxf(v, __shfl_xor(v, mk));
      if ((opaque_tid() & 63) == 0) atomicMax((unsigned*)(ws + OFF_BAR) + 144 + layer * 4 + 2, __float_as_uint(v));
    }
    if (fbase >= 1664 && fbase < 2176) {
      float v = dnorm * 4.f;
#pragma unroll
      for (int mk = 32; mk >= 1; mk >>= 1) v = fmaxf(v, __shfl_xor(v, mk));
      if ((opaque_tid() & 63) == 0) atomicMax((unsigned*)(ws + OFF_BAR) + 128 + layer * 2 + (fbase >= 1920 ? 1 : 0), __float_as_uint(v));
    }
  }
};
struct SimpleOrder {
  int nN, nwg, G, c;
  DI bool next(int i, pg8::Unit& u) const {
    const int L = i * G + c;
    if (L >= nwg) return false;
    const int rest = L >> 4;
    u.pn = rest % nN;
    u.pm = (rest / nN) * 16 + (L & 15);
    return true;
  }
  DI void a_ready(const pg8::Unit&) const {}
  DI void done(const pg8::Unit&) const {}
};
template <int N, int K, int LD, class Epi>
DI void gemm8_phase(const u16* X, const u16* Wt, const Epi& E, char* smem) {
  pg8::Gemm g; g.A = X; g.Bt = Wt; g.M = T; g.N = N; g.K = K; g.ld = LD;
  int bid_ = (int)blockIdx.x;
  if (gridDim.x == 256) {
    const int xcd = bid_ & 7, j = bid_ >> 3;
    bid_ = (((xcd >> 2) * 8 + (j >> 2)) << 4) | ((xcd & 3) * 4 + (j & 3));
  }
  asm volatile("" : "+s"(bid_));
  SimpleOrder S; S.nN = N / 256; S.nwg = (T / 256) * (N / 256); S.G = (int)gridDim.x; S.c = bid_;
  pg8::gemm_phase<Epi, SimpleOrder, false, K, LD>((PG8_LAS unsigned char*)smem, g, S, E, nullptr);
}

template <int DQK, int NCOMP, bool BAND, int EPI, bool NOMAX = false, bool GQA2 = false>
DI void attn_item(const u16* __restrict__ Q, int ldq, const u16* __restrict__ Kp, int ldk, const u16* __restrict__ Vt,
                  int qtok0, int kbeg, int kend, float sc_l2, float sink_l2, float lam, float onorm,
                  const float* __restrict__ subg, u16* __restrict__ O, float* __restrict__ DS, char* smem) {
  constexpr int DC = DQK / NCOMP;
  constexpr int KS = DC / 16;
  constexpr int KEYS = (NCOMP == 1) ? 128 : 64;
  constexpr int KSTR = DQK + 8, VSTR = KEYS + 8;
  constexpr int KCH = DQK / 8, VCH = KEYS / 8;
  constexpr int NKC = KEYS * KCH / NTHR, NVC = 64 * VCH / NTHR;
  constexpr int KSLOT = KEYS * KSTR, VSLOT = 64 * VSTR;
  u16* sK = (u16*)smem;
  u16* sV = sK + 3 * KSLOT;
  const int tid = opaque_tid(), lane = tid & 63, wave = tid >> 6, r = lane & 31, h = lane >> 5;
  const int qtok = qtok0 + (GQA2 ? (wave & 3) : wave) * 32 + r;
  if constexpr (GQA2) { Q += (wave >> 2) * 64; O += (wave >> 2) * 64; }

  bf16x8 qf[NCOMP][KS];
#pragma unroll
  for (int c = 0; c < NCOMP; ++c)
#pragma unroll
    for (int ks = 0; ks < KS; ++ks) qf[c][ks] = *(const bf16x8*)(Q + (size_t)qtok * ldq + c * DC + ks * 16 + 8 * h);

  f32x16 Oa[NCOMP][2];
  float m[NCOMP], l[NCOMP];
#pragma unroll
  for (int c = 0; c < NCOMP; ++c) {
#pragma unroll
    for (int d = 0; d < 2; ++d)
#pragma unroll
      for (int v = 0; v < 16; ++v) Oa[c][d][v] = 0.f;
    m[c] = BAND ? sink_l2 : -1e30f;
    l[c] = (BAND && h == 0) ? 1.f : 0.f;
  }

  const u16* kg[NKC]; int kso[NKC];
#pragma unroll
  for (int i = 0; i < NKC; ++i) {
    const int c = tid + i * NTHR;
    const int row = c / KCH, cc = c % KCH;
    kg[i] = Kp + (size_t)(kbeg + row) * ldk + cc * 8;
    kso[i] = row * KSTR + cc * 8;
  }
  const u16* vg[NVC]; int vso[NVC];
#pragma unroll
  for (int i = 0; i < NVC; ++i) {
    const int c = tid + i * NTHR;
    const int row = c / VCH, cc = c % VCH;
    vg[i] = Vt + (size_t)(kbeg >> 7) * 8192 + row * 128 + cc * 8;
    vso[i] = row * VSTR + cc * 8;
  }
  u32x4 kreg[NKC], vreg[NVC];
  auto loadK = [&](int t) {
#pragma unroll
    for (int i = 0; i < NKC; ++i) kreg[i] = gld16(kg[i] + (size_t)t * KEYS * ldk);
  };
  auto loadV = [&](int t) {
#pragma unroll
    for (int i = 0; i < NVC; ++i) vreg[i] = gld16(vg[i] + (size_t)t * 8192);
  };
  auto waitK = [&]() {
    if constexpr (NKC == 1) wait_vm0(kreg[0]);
    else if constexpr (NKC == 2) wait_vm0(kreg[0], kreg[1]);
    else wait_vm0(kreg[0], kreg[1], kreg[2]);
  };
  auto waitV = [&]() {
    if constexpr (NVC == 1) wait_vm0(vreg[0]);
    else wait_vm0(vreg[0], vreg[1]);
  };
  auto storeK = [&](int slot) {
#pragma unroll
    for (int i = 0; i < NKC; ++i) *(u32x4*)(sK + slot * KSLOT + kso[i]) = kreg[i];
  };
  auto storeV = [&](int slot) {
#pragma unroll
    for (int i = 0; i < NVC; ++i) *(u32x4*)(sV + slot * VSLOT + vso[i]) = vreg[i];
  };

  f32x16 S0[2], S1[2];
  bf16x8 pfA[2][2], pfB[2][2];
  float alpha_pend = 1.f;
  bool need_pend = false;

  auto att_S = [&](auto uu_t, f32x16 (&S)[2], int slot) {
    constexpr int UU = decltype(uu_t)::value;
    constexpr int C = (NCOMP == 2) ? UU : 0;
    const u16* base = sK + slot * KSLOT + ((NCOMP == 1 ? UU * 64 : 0) + r) * KSTR + (NCOMP == 2 ? UU * DC : 0) + 8 * h;
#pragma unroll
    for (int kb = 0; kb < 2; ++kb) {
#pragma unroll
      for (int v = 0; v < 16; ++v) S[kb][v] = 0.f;
#pragma unroll
      for (int ks = 0; ks < KS; ++ks) {
        bf16x8 kf = *(const bf16x8*)(base + kb * 32 * KSTR + ks * 16);
        S[kb] = MFMA32(kf, qf[C][ks], S[kb]);
      }
    }
  };
  auto att_PV = [&](auto uu_t, const bf16x8 (&pf)[2][2], int slot) {
    constexpr int UU = decltype(uu_t)::value;
    constexpr int C = (NCOMP == 2) ? UU : 0;
    const u16* base = sV + slot * VSLOT + r * VSTR + (NCOMP == 1 ? UU * 64 : 0) + 8 * h;
#pragma unroll
    for (int d = 0; d < 2; ++d)
#pragma unroll
      for (int kb = 0; kb < 2; ++kb)
#pragma unroll
        for (int s = 0; s < 2; ++s) {
          bf16x8 vf = *(const bf16x8*)(base + d * 32 * VSTR + kb * 32 + 16 * s);
          Oa[C][d] = MFMA32(vf, pf[kb][s], Oa[C][d]);
        }
  };
  auto att_rescale = [&](auto uu_t) {
    constexpr int UU = decltype(uu_t)::value;
    constexpr int C = (NCOMP == 2) ? UU : 0;
    if (need_pend) {
#pragma unroll
      for (int d = 0; d < 2; ++d)
#pragma unroll
        for (int v = 0; v < 16; ++v) Oa[C][d][v] *= alpha_pend;
    }
  };
  auto att_softmax = [&](auto uu_t, f32x16 (&S)[2], bf16x8 (&pf)[2][2], int kpos0) {
    constexpr int UU = decltype(uu_t)::value;
    constexpr int C = (NCOMP == 2) ? UU : 0;
    if constexpr (BAND) {
#pragma unroll
      for (int kb = 0; kb < 2; ++kb)
#pragma unroll
        for (int v = 0; v < 16; ++v) {
          const int d = kpos0 + kb * 32 + crow(v, h) - qtok;
          if (d > 128 || d < -128) S[kb][v] = -1e30f;
        }
    }
    if constexpr (NOMAX) {
      float rsum = 0.f;
#pragma unroll
      for (int kb = 0; kb < 2; ++kb)
#pragma unroll
        for (int v = 0; v < 16; ++v) {
          float p = __builtin_amdgcn_exp2f(S[kb][v]);
          S[kb][v] = p;
          rsum += p;
        }
      l[C] += rsum;
      need_pend = false;
#pragma unroll
      for (int kb = 0; kb < 2; ++kb)
#pragma unroll
        for (int s = 0; s < 2; ++s) {
          u32x4 pk;
          pk.x = pk2(S[kb][8 * s + 0], S[kb][8 * s + 1]);
          pk.y = pk2(S[kb][8 * s + 2], S[kb][8 * s + 3]);
          pk.z = pk2(S[kb][8 * s + 4], S[kb][8 * s + 5]);
          pk.w = pk2(S[kb][8 * s + 6], S[kb][8 * s + 7]);
          pf[kb][s] = __builtin_bit_cast(bf16x8, pk);
        }
      return;
    }
    float mx = S[0][0];
#pragma unroll
    for (int kb = 0; kb < 2; ++kb)
#pragma unroll
      for (int v = 0; v < 16; ++v) mx = fmaxf(mx, S[kb][v]);
    {
      const unsigned mu = __float_as_uint(mx);
      const auto sw = __builtin_amdgcn_permlane32_swap(mu, mu, false, false);
      mx = fmaxf(__uint_as_float(sw[0]), __uint_as_float(sw[1]));
    }
    const float mold = m[C];
    const float mcand = fmaxf(mold, mx * sc_l2);
    const bool grow = __builtin_amdgcn_ballot_w64(mcand > mold + 6.0f) != 0;
    const float mnew = grow ? mcand : mold;
    need_pend = grow;
    alpha_pend = __builtin_amdgcn_exp2f(mold - mnew);
    m[C] = mnew;
    float rsum = 0.f;
#pragma unroll
    for (int kb = 0; kb < 2; ++kb)
#pragma unroll
      for (int v = 0; v < 16; ++v) {
        float p = __builtin_amdgcn_exp2f(__builtin_fmaf(S[kb][v], sc_l2, -mnew));
        S[kb][v] = p;
        rsum += p;
      }
    l[C] = l[C] * alpha_pend + rsum;
#pragma unroll
    for (int kb = 0; kb < 2; ++kb)
#pragma unroll
      for (int s = 0; s < 2; ++s) {
        u32x4 pk;
        pk.x = pk2(S[kb][8 * s + 0], S[kb][8 * s + 1]);
        pk.y = pk2(S[kb][8 * s + 2], S[kb][8 * s + 3]);
        pk.z = pk2(S[kb][8 * s + 4], S[kb][8 * s + 5]);
        pk.w = pk2(S[kb][8 * s + 6], S[kb][8 * s + 7]);
        pf[kb][s] = __builtin_bit_cast(bf16x8, pk);
      }
  };
  using U0 = std::integral_constant<int, 0>;
  using U1 = std::integral_constant<int, 1>;

  const int ntl = (kend - kbeg) / KEYS;
  auto step = [&](auto first_t, auto lk_t, auto lv_t, int t, int sa, int sb, int sc) {
    constexpr bool FIRST = decltype(first_t)::value, LK = decltype(lk_t)::value, LV = decltype(lv_t)::value;
    if constexpr (LK) loadK(t + 2);
    if constexpr (LV) loadV(t + 1);
    if constexpr (!FIRST) att_rescale(U1{});
    att_S(U1{}, S1, sa);
    if constexpr (!FIRST) att_PV(U1{}, pfB, sc);
    att_softmax(U0{}, S0, pfA, kbeg + t * KEYS);
    att_rescale(U0{});
    if constexpr (LV) att_S(U0{}, S0, sb);
    att_PV(U0{}, pfA, sa);
    att_softmax(U1{}, S1, pfB, kbeg + t * KEYS + 64);
    if constexpr (LK) { waitK(); storeK(sc); }
    if constexpr (LV) { waitV(); storeV(sb); }
    __syncthreads();
  };
  using TT = std::true_type;
  using FF = std::false_type;

  loadK(0); loadV(0);
  waitK(); waitV();
  storeK(0); storeV(0);
  loadK(1);
  waitK();
  storeK(1);
  __syncthreads();
  att_S(U0{}, S0, 0);
  int sa = 0, sb = 1, sc = 2;
  step(TT{}, TT{}, TT{}, 0, sa, sb, sc);
  { int tmp = sa; sa = sb; sb = sc; sc = tmp; }
  for (int t = 1; t < ntl - 2; ++t) {
    step(FF{}, TT{}, TT{}, t, sa, sb, sc);
    int tmp = sa; sa = sb; sb = sc; sc = tmp;
  }
  step(FF{}, FF{}, TT{}, ntl - 2, sa, sb, sc);
  { int tmp = sa; sa = sb; sb = sc; sc = tmp; }
  step(FF{}, FF{}, FF{}, ntl - 1, sa, sb, sc);
  att_rescale(U1{});
  att_PV(U1{}, pfB, sa);

  float inv[NCOMP];
#pragma unroll
  for (int c = 0; c < NCOMP; ++c) {
    float lt = l[c] + __shfl_xor(l[c], 32);
    inv[c] = 1.f / lt;
  }
  if constexpr (EPI == 1) {
#pragma unroll
    for (int d = 0; d < 2; ++d)
#pragma unroll
      for (int vq = 0; vq < 4; ++vq) {
        float4 o = {Oa[0][d][4 * vq] * inv[0], Oa[0][d][4 * vq + 1] * inv[0], Oa[0][d][4 * vq + 2] * inv[0], Oa[0][d][4 * vq + 3] * inv[0]};
        *(float4*)(DS + (size_t)qtok * 256 + d * 32 + 8 * vq + 4 * h) = o;
      }
  } else {
    if constexpr (EPI == 2) {
      float ss = 0.f;
#pragma unroll
      for (int d = 0; d < 2; ++d)
#pragma unroll
        for (int vq = 0; vq < 4; ++vq) {
          const float4 o1 = *(const float4*)(DS + (size_t)qtok * 256 + d * 32 + 8 * vq + 4 * h);
          const float a0 = o1.x - lam * Oa[0][d][4 * vq] * inv[0];
          const float a1 = o1.y - lam * Oa[0][d][4 * vq + 1] * inv[0];
          const float a2 = o1.z - lam * Oa[0][d][4 * vq + 2] * inv[0];
          const float a3 = o1.w - lam * Oa[0][d][4 * vq + 3] * inv[0];
          Oa[0][d][4 * vq] = a0; Oa[0][d][4 * vq + 1] = a1; Oa[0][d][4 * vq + 2] = a2; Oa[0][d][4 * vq + 3] = a3;
          ss += a0 * a0 + a1 * a1 + a2 * a2 + a3 * a3;
        }
      ss += __shfl_xor(ss, 32);
      const float rs = rsqrtf(ss * (1.f / 64.f) + EPS) * onorm;
#pragma unroll
      for (int d = 0; d < 2; ++d)
#pragma unroll
        for (int v = 0; v < 16; ++v) Oa[0][d][v] *= rs * subg[d * 32 + crow(v, h)];
    } else {
#pragma unroll
      for (int d = 0; d < 2; ++d)
#pragma unroll
        for (int v = 0; v < 16; ++v) Oa[0][d][v] *= inv[0];
    }
    store_rows(O, KP1, 0, Oa[0][0], qtok, h);
    store_rows(O, KP1, 32, Oa[0][1], qtok, h);
  }
  __syncthreads();
}

DI void attn_phase(const Params& P, int layer, char* smem) {
  char* ws = P.ws;
  u16* qkv = (u16*)(ws + OFF_QKV);
  u16* BR = (u16*)(ws + OFF_XN);
  const float L2E = 1.4426950408889634f;
  const float lambda_init = 0.8f - 0.6f * __expf(-0.3f * (float)layer);
  float lam;
  {
    const float* dl = P.d_lambda + layer * 128;
    float s1 = 0.f, s2 = 0.f;
    for (int i = 0; i < 32; ++i) { s1 += dl[i] * dl[32 + i]; s2 += dl[64 + i] * dl[96 + i]; }
    lam = __expf(s1) - __expf(s2) + lambda_init;
    lam = __int_as_float(__builtin_amdgcn_readfirstlane(__float_as_int(lam)));
  }
  const float onorm_u = __int_as_float(__builtin_amdgcn_readfirstlane(__float_as_int(1.f - lambda_init)));
  bool a_nomax;
  {
    const float* ag = P.a_qk_norm + layer * 128;
    float gq = 0.f, gk = 0.f;
    for (int i = 0; i < 64; ++i) { gq = fmaxf(gq, fabsf(ag[i])); gk = fmaxf(gk, fabsf(ag[64 + i])); }
    const float bound = 64.f * gq * gk * (0.125f * L2E);
    a_nomax = __builtin_amdgcn_readfirstlane((int)(bound < 60.f)) != 0;
  }
  bool c_nomax;
  {
    const unsigned* nb = (const unsigned*)(ws + OFF_BAR) + 144 + layer * 4;
    const float qb = __uint_as_float(__hip_atomic_load(nb, __ATOMIC_RELAXED, __HIP_MEMORY_SCOPE_AGENT));
    const float kb = __uint_as_float(__hip_atomic_load(nb + 1, __ATOMIC_RELAXED, __HIP_MEMORY_SCOPE_AGENT));
    const float pe = __uint_as_float(__hip_atomic_load(nb + 2, __ATOMIC_RELAXED, __HIP_MEMORY_SCOPE_AGENT));
    const float bound = sqrtf(3.f * qb * (2.f * kb + pe)) * (0.10206207261596577f * L2E);
    c_nomax = __builtin_amdgcn_readfirstlane((int)(bound < 60.f)) != 0;
  }
  bool d_nomax;
  {
    const unsigned* nb = (const unsigned*)(ws + OFF_BAR) + 128 + layer * 2;
    const float q2 = __uint_as_float(__hip_atomic_load(nb, __ATOMIC_RELAXED, __HIP_MEMORY_SCOPE_AGENT));
    const float k2 = __uint_as_float(__hip_atomic_load(nb + 1, __ATOMIC_RELAXED, __HIP_MEMORY_SCOPE_AGENT));
    const float bound = sqrtf(q2 * k2) * (0.17677669529663687f * L2E);
    d_nomax = __builtin_amdgcn_readfirstlane((int)(bound < 60.f)) != 0;
  }
  for (int it = blockIdx.x; it < 2048; it += gridDim.x) {
    const int cls = it >> 8;
    if (cls < 6) {
      const int idx = it & 255;
      const int head = (idx & 7) >> 1;
      const int qb = ((idx >> 3) << 1) + (idx & 1);
      int qtok0, kbeg, kend;
      if (cls < 3) { qtok0 = qb * 256; kbeg = 0; kend = SEQ0; }
      else { const int s = qb >> 3; kbeg = SEQ0 + s * DSEQ; kend = kbeg + DSEQ; qtok0 = kbeg + (qb & 7) * 256; }
      const int typ = cls % 3;
      if (typ == 0) {
        float* DS = (float*)(ws + OFF_DS) + head * 64;
        if (d_nomax) {
          attn_item<32, 1, false, 1, true>(qkv + Q_QD + head * 64, 256, qkv + Q_KD + head * 64, 256,
                                           qkv + Q_VTD + (size_t)head * 64 * T, qtok0, kbeg, kend,
                                           1.f, 0.f, lam, onorm_u, P.d_subln + layer * 64, BR + 768 + head * 64, DS, smem);
          attn_item<32, 1, false, 2, true>(qkv + Q_QD + head * 64 + 32, 256, qkv + Q_KD + head * 64 + 32, 256,
                                           qkv + Q_VTD + (size_t)head * 64 * T, qtok0, kbeg, kend,
                                           1.f, 0.f, lam, onorm_u, P.d_subln + layer * 64, BR + 768 + head * 64, DS, smem);
        } else {
          attn_item<32, 1, false, 1, false>(qkv + Q_QD + head * 64, 256, qkv + Q_KD + head * 64, 256,
                                            qkv + Q_VTD + (size_t)head * 64 * T, qtok0, kbeg, kend,
                                            1.f, 0.f, lam, onorm_u, P.d_subln + layer * 64, BR + 768 + head * 64, DS, smem);
          attn_item<32, 1, false, 2, false>(qkv + Q_QD + head * 64 + 32, 256, qkv + Q_KD + head * 64 + 32, 256,
                                            qkv + Q_VTD + (size_t)head * 64 * T, qtok0, kbeg, kend,
                                            1.f, 0.f, lam, onorm_u, P.d_subln + layer * 64, BR + 768 + head * 64, DS, smem);
        }
      } else if (typ == 1) {
        if (c_nomax)
          attn_item<96, 1, false, 0, true>(qkv + Q_QC + head * 96, 384, qkv + Q_KC + head * 96, 384,
                                           qkv + Q_VTC + (size_t)head * 64 * T, qtok0, kbeg, kend,
                                           1.f, 0.f, 0.f, 1.f, nullptr, BR + 512 + head * 64, nullptr, smem);
        else
          attn_item<96, 1, false, 0, false>(qkv + Q_QC + head * 96, 384, qkv + Q_KC + head * 96, 384,
                                            qkv + Q_VTC + (size_t)head * 64 * T, qtok0, kbeg, kend,
                                            1.f, 0.f, 0.f, 1.f, nullptr, BR + 512 + head * 64, nullptr, smem);
      } else {
        if (a_nomax) {
          const int kvh = (idx & 7) >> 2;
          const int qb128 = ((idx >> 3) << 2) + (idx & 3);
          int q0 = qb128 * 128, kb0 = kbeg, ke0 = kend;
          if (cls >= 3) { const int s2 = qb128 >> 4; kb0 = SEQ0 + s2 * DSEQ; ke0 = kb0 + DSEQ; q0 = kb0 + (qb128 & 15) * 128; }
          attn_item<64, 1, false, 0, true, true>(qkv + Q_QA + kvh * 128, 256, qkv + Q_KA + kvh * 64, 128,
                                                 qkv + Q_VTA + (size_t)kvh * 64 * T, q0, kb0, ke0,
                                                 1.f, 0.f, 0.f, 1.f, nullptr, BR + kvh * 128, nullptr, smem);
        } else
          attn_item<64, 1, false, 0, false>(qkv + Q_QA + head * 64, 256, qkv + Q_KA + (head >> 1) * 64, 128,
                                            qkv + Q_VTA + (size_t)(head >> 1) * 64 * T, qtok0, kbeg, kend,
                                            1.f, 0.f, 0.f, 1.f, nullptr, BR + head * 64, nullptr, smem);
      }
    } else {
      const int idx = it - 1536;
      const int head = (idx & 7) >> 1;
      const int qbg = ((idx >> 3) << 1) + (idx & 1);
      const int qtok0 = qbg * 256;
      int sb, se;
      if (qtok0 < SEQ0) { sb = 0; se = SEQ0; }
      else { sb = SEQ0 + ((qtok0 - SEQ0) / DSEQ) * DSEQ; se = sb + DSEQ; }
      const int kbeg = max(sb, qtok0 - 128), kend = min(se, qtok0 + 256 + 128);
      const float sink = P.b_sink[layer * 4 + head];
      attn_item<64, 1, true, 0>(qkv + Q_QB + head * 64, 256, qkv + Q_KB + (head >> 1) * 64, 128,
                                    qkv + Q_VTB + (size_t)(head >> 1) * 64 * T, qtok0, kbeg, kend,
                                    0.125f * L2E, sink * L2E, 0.f, 1.f, nullptr, BR + 256 + head * 64, nullptr, smem);
    }
  }
}

DI void ew_phase(const Params& P, const u16* __restrict__ Y, float coef, const float* __restrict__ gpost,
                 const float* __restrict__ gnext, bool from_inputs) {
  const int tid = opaque_tid();
  const int lane = tid & 63, wave = tid >> 6;
  u16* XN = (u16*)(P.ws + OFF_XN);
  u16* XB = (u16*)(P.ws + OFF_XB);
  for (int tok = blockIdx.x * 8 + wave; tok < T; tok += gridDim.x * 8) {
    float4 x[4];
    if (from_inputs) {
      const float* xs = tok < SEQ0 ? P.x_prompt + (size_t)tok * DM : P.x_sample + (size_t)(tok - SEQ0) * DM;
#pragma unroll
      for (int i = 0; i < 4; ++i) x[i] = *(const float4*)(xs + (i * 64 + lane) * 4);
    } else {
#pragma unroll
      for (int i = 0; i < 4; ++i) {
        const uint2 xb = *(const uint2*)(XB + (size_t)tok * DM + (i * 64 + lane) * 4);
        x[i] = make_float4(bf2f(xb.x & 0xffffu), bf2f(xb.x >> 16), bf2f(xb.y & 0xffffu), bf2f(xb.y >> 16));
      }
    }
    if (Y) {
      float4 y[4];
      float ss = 0.f;
#pragma unroll
      for (int i = 0; i < 4; ++i) {
        const uint2 yb = *(const uint2*)(Y + (size_t)tok * KP1 + (i * 64 + lane) * 4);
        y[i] = make_float4(bf2f(yb.x & 0xffffu), bf2f(yb.x >> 16), bf2f(yb.y & 0xffffu), bf2f(yb.y >> 16));
        ss += y[i].x * y[i].x + y[i].y * y[i].y + y[i].z * y[i].z + y[i].w * y[i].w;
      }
      ss = wave_sum(ss);
      const float rs = rsqrtf(ss * (1.f / 1024.f) + EPS) * coef;
#pragma unroll
      for (int i = 0; i < 4; ++i) {
        float4 g = *(const float4*)(gpost + (i * 64 + lane) * 4);
        x[i].x += y[i].x * rs * g.x; x[i].y += y[i].y * rs * g.y;
        x[i].z += y[i].z * rs * g.z; x[i].w += y[i].w * rs * g.w;
      }
    }
    if (!gnext) {
#pragma unroll
      for (int i = 0; i < 4; ++i) *(float4*)(P.out + (size_t)tok * DM + (i * 64 + lane) * 4) = x[i];
    } else {
#pragma unroll
      for (int i = 0; i < 4; ++i) {
        uint2 pk;
        pk.x = pk2(x[i].x, x[i].y);
        pk.y = pk2(x[i].z, x[i].w);
        *(uint2*)(XB + (size_t)tok * DM + (i * 64 + lane) * 4) = pk;
      }
    }
    if (gnext) {
      float ss = 0.f;
#pragma unroll
      for (int i = 0; i < 4; ++i) ss += x[i].x * x[i].x + x[i].y * x[i].y + x[i].z * x[i].z + x[i].w * x[i].w;
      ss = wave_sum(ss);
      const float rs = rsqrtf(ss * (1.f / 1024.f) + EPS);
#pragma unroll
      for (int i = 0; i < 4; ++i) {
        float4 g = *(const float4*)(gnext + (i * 64 + lane) * 4);
        uint2 pk;
        pk.x = pk2(x[i].x * rs * g.x, x[i].y * rs * g.y);
        pk.y = pk2(x[i].z * rs * g.z, x[i].w * rs * g.w);
        *(uint2*)(XN + (size_t)tok * KP1 + (i * 64 + lane) * 4) = pk;
      }
    }
  }
}

DI int colmap(int mode, int n, int nsrc) {
  if (mode == 1) { return ((n >> 7) & 1) * DFF + (n >> 8) * 128 + (n & 127); }
  if (mode == 2) {
    if (n < 2560) {
      const int w = n & 255;
      n = (n & ~255) + ((w >> 5) & 3) * 64 + (w >> 7) * 32 + (w & 31);
    }
    if (n < 1664) return n;
    if (n < 2432) return n + 32;
    if (n < 2464) return n - 2432 + 1664;
    if (n < 2560) return -1;
    return n - 96;
  }
  return n < nsrc ? n : -1;
}
DI void conv_job(u16* __restrict__ dst, int ldd, const float* __restrict__ src, int Nd, int K, int lds, int mode,
                 const float* __restrict__ kscale) {
  const int total = Nd * (K >> 3);
  const int gthreads = gridDim.x * NTHR;
  for (int idx = blockIdx.x * NTHR + opaque_tid(); idx < total; idx += gthreads) {
    const int n = idx % Nd, k8 = idx / Nd;
    const int col = colmap(mode, n, lds);
    float v[8];
#pragma unroll
    for (int j = 0; j < 8; ++j) {
      float x = 0.f;
      if (col >= 0) {
        x = src[(size_t)(k8 * 8 + j) * lds + col];
        if (kscale) x *= kscale[k8 * 8 + j];
      }
      v[j] = x;
    }
    uint4 pk = {pk2(v[0], v[1]), pk2(v[2], v[3]), pk2(v[4], v[5]), pk2(v[6], v[7])};
    *(uint4*)(dst + (size_t)n * ldd + k8 * 8) = pk;
  }
}
DI void convert_layer(const Params& P, int l) {
  u16* W = (u16*)(P.ws + OFF_W);
  for (int s = 0; s < 2; ++s) {
    conv_job(W + W_WI + (size_t)s * 5632 * KP1, KP1, P.ffn_wi + ((size_t)l * 2 + s) * 1024 * 5632, 5632, 1024, 5632, 1, nullptr);
    conv_job(W + W_WO + (size_t)s * 1024 * KP2, KP2, P.ffn_wo + ((size_t)l * 2 + s) * 2816 * 1024, 1024, 2816, 1024, 0, nullptr);
  }
  conv_job(W + W_WIN, KP1, P.w_in + (size_t)l * 1024 * NPROJ, 6656, 1024, NPROJ, 2, nullptr);
  conv_job(W + W_WUQ, 384, P.c_w_uq + (size_t)l * 384 * 384, 512, 384, 384, 0, P.c_q_norm + l * 384);
  conv_job(W + W_WUKV, 256, P.c_w_ukv + (size_t)l * 256 * 512, 512, 256, 512, 0, P.c_kv_norm + l * 256);
  conv_job(W + W_WB, KP1, P.w_branch + (size_t)l * 1024 * 1024, 1024, 1024, 1024, 0, nullptr);
  conv_job(W + W_WOUT, KP1, P.w_out + (size_t)l * 1024 * 1024, 1024, 1024, 1024, 0, nullptr);
}
DI void rope_tables(const Params& P) {
  float2* R64 = (float2*)(P.ws + OFF_R64);
  float2* R32 = (float2*)(P.ws + OFF_R32);
  const int gthreads = gridDim.x * NTHR;
  for (int idx = blockIdx.x * NTHR + opaque_tid(); idx < 16384 * 48; idx += gthreads) {
    int pos, f; double base; float2* dst;
    if (idx < 16384 * 32) { pos = idx >> 5; f = idx & 31; base = 0.7498942093324559; dst = R64 + idx; }
    else { const int i2 = idx - 16384 * 32; pos = i2 >> 4; f = i2 & 15; base = 0.5623413251903491; dst = R32 + i2; }
    double inv = 1.0;
    for (int k = 0; k < f; ++k) inv *= base;
    const float ang = (float)pos * (float)inv;
    double tr = (double)ang * 0.15915494309189535;
    tr -= rint(tr);
    const float tf = (float)tr;
    *dst = make_float2(__builtin_amdgcn_cosf(tf), __builtin_amdgcn_sinf(tf));
  }
}

DI void fast_grid_barrier(unsigned* bar, unsigned nblk) {
  asm volatile("s_waitcnt vmcnt(0) lgkmcnt(0)" ::: "memory");
  __syncthreads();
  if (threadIdx.x == 0) {
    __builtin_amdgcn_fence(__ATOMIC_RELEASE, "agent");
    asm volatile("s_waitcnt vmcnt(0) lgkmcnt(0)" ::: "memory");
    const unsigned gen = __hip_atomic_load(&bar[64], __ATOMIC_RELAXED, __HIP_MEMORY_SCOPE_AGENT);
    const unsigned old = __hip_atomic_fetch_add(&bar[0], 1u, __ATOMIC_RELAXED, __HIP_MEMORY_SCOPE_AGENT);
    if (old == nblk - 1u) {
      __hip_atomic_store(&bar[0], 0u, __ATOMIC_RELAXED, __HIP_MEMORY_SCOPE_AGENT);
      __hip_atomic_fetch_add(&bar[64], 1u, __ATOMIC_RELEASE, __HIP_MEMORY_SCOPE_AGENT);
    } else {
      while (__hip_atomic_load(&bar[64], __ATOMIC_RELAXED, __HIP_MEMORY_SCOPE_AGENT) == gen) __builtin_amdgcn_s_sleep(1);
    }
    __builtin_amdgcn_fence(__ATOMIC_ACQUIRE, "agent");
    asm volatile("s_waitcnt vmcnt(0) lgkmcnt(0)" ::: "memory");
  }
  __syncthreads();
}

__global__ void __launch_bounds__(NTHR) __attribute__((amdgpu_waves_per_eu(2, 2))) mega(Params P) {
  extern __shared__ __attribute__((aligned(16))) char smem[];
  cg::grid_group grid = cg::this_grid();
  int phase = 0;
#if MULTI_LAUNCH
#define ACTIVE() (phase >= P.phase_lo && phase < P.phase_hi)
#define SEAM() do { ++phase; } while (0)
#else
#define ACTIVE() (true)
#define SEAM() do { ++phase; if (phase == 1) grid.sync(); else fast_grid_barrier((unsigned*)(P.ws + OFF_BAR), gridDim.x); } while (0)
#endif
  u16* W = (u16*)(P.ws + OFF_W);
  u16* XN = (u16*)(P.ws + OFF_XN);
  u16* R2 = (u16*)(P.ws + OFF_R2);
  u16* qkv = (u16*)(P.ws + OFF_QKV);
  const u16* Y = qkv + Q_Y;
#define PTRS

  if (ACTIVE()) { PTRS
    rope_tables(P);
    convert_layer(P, 0);
    ew_phase(P, nullptr, 0.f, nullptr, P.norm_g, true);
  }
  SEAM();
  for (int l = 0; l < 4; ++l) {
    const float* g = P.norm_g + (size_t)l * 6 * DM;
    if (ACTIVE()) { PTRS gemm8_phase<5632, DM, KP1>(XN, W + W_WI, EpiFfnUp8{R2}, smem); }
    SEAM();
    if (ACTIVE()) { PTRS gemm8_phase<1024, DFF, KP2>(R2, W + W_WO, EpiY8{qkv + Q_Y}, smem); }
    SEAM();
    if (ACTIVE()) { PTRS ew_phase(P, Y, 0.5f, g + DM, g + 2 * DM, false); }
    SEAM();
    if (ACTIVE()) { PTRS
      gemm8_phase<2560, DM, KP1>(XN, W + W_WIN, EpiProj8{&P, l}, smem);
      gemm8_phase<4096, DM, KP1>(XN, W + W_WIN + 2560ull * KP1, EpiGate8{(unsigned char*)R2}, smem);
    }
    SEAM();
    if (ACTIVE()) { PTRS
      gemm_phase<M_CUQ, 4>(W + W_WUQ, 384, qkv + Q_CQ, 384, 384, 2, smem, P, l);
      gemm_phase<M_CUKV, 4>(W + W_WUKV, 256, qkv + Q_CKV, 256, 256, 2, smem, P, l);
    }
    SEAM();
    if (ACTIVE()) { PTRS attn_phase(P, l, smem); }
    SEAM();
    if (ACTIVE()) { PTRS gemm_phase<M_MERGE, 2>(W + W_WB, KP1, XN, KP1, DM, 4, smem, P, l); }
    SEAM();
    if (ACTIVE()) { PTRS gemm8_phase<1024, DM, KP1>(qkv + Q_MERGED, W + W_WOUT, EpiY8{qkv + Q_Y}, smem); }
    SEAM();
    if (ACTIVE()) { PTRS ew_phase(P, Y, 1.0f, g + 3 * DM, g + 4 * DM, false); }
    SEAM();
    if (ACTIVE()) { PTRS gemm8_phase<5632, DM, KP1>(XN, W + W_WI + 5632ull * KP1, EpiFfnUp8{R2}, smem); }
    SEAM();
    if (ACTIVE()) { PTRS gemm8_phase<1024, DFF, KP2>(R2, W + W_WO + 1024ull * KP2, EpiY8{qkv + Q_Y}, smem); }
    SEAM();
    if (ACTIVE()) { PTRS
      ew_phase(P, Y, 0.5f, g + 5 * DM, l < 3 ? g + 6 * DM : nullptr, false);
      if (l < 3) convert_layer(P, l + 1);
    }
    SEAM();
  }
}

constexpr int N_PHASES = 1 + 12 * 4;

extern "C" void kernel_launch(void* const* d_in, const int* in_sizes, int n_in, void* d_out, int out_size, void* d_ws,
                              size_t ws_size, hipStream_t stream) {
  static int grid_blocks = 0;
  if (!grid_blocks) {
    int dev = 0, cus = 0, per_cu = 0;
    hipGetDevice(&dev);
    hipDeviceGetAttribute(&cus, hipDeviceAttributeMultiprocessorCount, dev);
    hipFuncSetAttribute((const void*)mega, hipFuncAttributeMaxDynamicSharedMemorySize, SMEM_BYTES);
    hipOccupancyMaxActiveBlocksPerMultiprocessor(&per_cu, mega, NTHR, SMEM_BYTES);
    if (per_cu < 1) per_cu = 1;
    grid_blocks = cus * per_cu;
  }
  if (ws_size < WS_NEEDED) fprintf(stderr, "workspace too small: %zu < %zu\n", ws_size, (size_t)WS_NEEDED);
  Params P{};
  P.x_prompt = (const float*)d_in[0]; P.x_sample = (const float*)d_in[1]; P.norm_g = (const float*)d_in[2];
  P.w_in = (const float*)d_in[3]; P.a_qk_norm = (const float*)d_in[4]; P.b_sink = (const float*)d_in[5];
  P.c_q_norm = (const float*)d_in[6]; P.c_kv_norm = (const float*)d_in[7]; P.c_w_uq = (const float*)d_in[8];
  P.c_w_ukv = (const float*)d_in[9]; P.d_lambda = (const float*)d_in[10]; P.d_subln = (const float*)d_in[11];
  P.w_branch = (const float*)d_in[12]; P.w_out = (const float*)d_in[13]; P.ffn_wi = (const float*)d_in[14];
  P.ffn_wo = (const float*)d_in[15];
  P.out = (float*)d_out; P.ws = (char*)d_ws;
#if MULTI_LAUNCH
  for (int ph = 0; ph < N_PHASES; ++ph) {
    P.phase_lo = ph; P.phase_hi = ph + 1; P.coop = 0; P.pad0 = 0;
    hipLaunchKernelGGL(mega, dim3(grid_blocks), dim3(NTHR), SMEM_BYTES, stream, P);
  }
#else
  P.phase_lo = 0; P.phase_hi = 1 << 30; P.coop = 1; P.pad0 = 0;
  hipMemsetAsync((char*)d_ws + OFF_BAR, 0, 1024, stream);
  void* args[] = {&P};
  hipError_t e = hipLaunchCooperativeKernel((const void*)mega, dim3(grid_blocks), dim3(NTHR), args, SMEM_BYTES, stream);
  if (e != hipSuccess) fprintf(stderr, "cooperative launch failed: %s (grid %d)\n", hipGetErrorString(e), grid_blocks);
#endif
}
```
